# Optimizing an MI355X kernel written in HIP

```python
import jax, jax.numpy as jnp
from jax import lax
import numpy as np

D_MODEL = 2048
BATCH = 2
SEQ = 8192
DEPTH = 4

A_HEADS = 8
A_DK = 128
A_DV = 128
A_WIDTH = A_HEADS * A_DK
B_HEADS = 8
B_HEAD_DIM = 128
B_WIDTH = B_HEADS * B_HEAD_DIM
AB_IN = 4 * A_WIDTH + 4 * B_WIDTH + B_HEADS
AB_CAT = A_HEADS * A_DV + B_WIDTH
C_HEADS = 4
C_DK = 256
C_DV = 512
C_KW = C_HEADS * C_DK
C_VW = C_HEADS * C_DV
C_GATE_RANK = 16
C_GATE_NORMALIZER = 16.0
C_IN = 2 * C_KW + 2 * C_VW + C_GATE_RANK
D_FF = 256 * (-(-8 * D_MODEL // (3 * 256)))
N_AB = (DEPTH + 1) // 2
N_C = DEPTH // 2
CHUNK = 64
Q_BLOCK = 128
EPS = 1e-6
MASK_VALUE = -1e30
MIN_FORGET = 1e-30

kernel_name = "hybrid_hgrn2_fox_gla_adaln_trunk"


def rms_norm(x, gain):
    xf = x.astype(jnp.float32)
    y = xf * lax.rsqrt(jnp.mean(xf * xf, axis=-1, keepdims=True) + EPS)
    return (y * gain.astype(jnp.float32)).astype(x.dtype)


def modulate(x, shift, scale):
    return x * (1 + scale[:, None, :]) + shift[:, None, :]


def split_heads(x, n_heads):
    b, t, _ = x.shape
    return x.reshape(b, t, n_heads, -1).transpose(0, 2, 1, 3)


def merge_heads(x):
    b, h, t, d = x.shape
    return x.transpose(0, 2, 1, 3).reshape(b, t, h * d)


def chunk_gated_linear_recurrence(q, k, v, log_g):
    b, h, t, dk = q.shape
    dv = v.shape[-1]
    n = t // CHUNK

    def to_chunks(a):
        return jnp.moveaxis(a.astype(jnp.float32).reshape(b, h, n, CHUNK, a.shape[-1]), 2, 0)

    causal = jnp.tril(jnp.ones((CHUNK, CHUNK), dtype=bool))[:, :, None]

    def step(state, inp):
        qc, kc, vc, gc = inp
        cum = jnp.cumsum(gc, axis=-2)
        o_inter = jnp.einsum('bhtd,bhde->bhte', qc * jnp.exp(cum), state)
        diff = cum[..., :, None, :] - cum[..., None, :, :]
        decay = jnp.where(causal, jnp.exp(jnp.where(causal, diff, 0.0)), 0.0)
        scores = jnp.einsum('bhtd,bhsd,bhtsd->bhts', qc, kc, decay)
        o_intra = jnp.einsum('bhts,bhse->bhte', scores, vc)
        last = cum[..., -1:, :]
        state = jnp.exp(last[..., 0, :])[..., None] * state + jnp.einsum(
            'bhsd,bhse->bhde', kc * jnp.exp(last - cum), vc)
        return state, o_inter + o_intra

    state0 = jnp.zeros((b, h, dk, dv), jnp.float32)
    _, o = lax.scan(step, state0, (to_chunks(q), to_chunks(k), to_chunks(v), to_chunks(log_g)))
    return jnp.moveaxis(o, 0, 2).reshape(b, h, t, dv)


def forgetting_attention(q, k, v, log_f):
    b, h, t, d = q.shape
    nb = t // Q_BLOCK
    cum_f = jnp.cumsum(log_f.astype(jnp.float32), axis=-1)
    qf = q.astype(jnp.float32) * (d ** -0.5)
    kf = k.astype(jnp.float32)
    vf = v.astype(jnp.float32)
    q_blocks = jnp.moveaxis(qf.reshape(b, h, nb, Q_BLOCK, d), 2, 0)
    f_blocks = jnp.moveaxis(cum_f.reshape(b, h, nb, Q_BLOCK), 2, 0)
    key_pos = jnp.arange(t)

    def block(args):
        qb, fb, start = args
        s = jnp.einsum('bhqd,bhkd->bhqk', qb, kf) + fb[..., :, None] - cum_f[..., None, :]
        q_pos = start + jnp.arange(Q_BLOCK)
        s = jnp.where(key_pos[None, :] <= q_pos[:, None], s, MASK_VALUE)
        p = jax.nn.softmax(s, axis=-1)
        return jnp.einsum('bhqk,bhkd->bhqd', p, vf)

    o = lax.map(block, (q_blocks, f_blocks, jnp.arange(nb) * Q_BLOCK))
    return jnp.moveaxis(o, 0, 2).reshape(b, h, t, d)


def hgrn2_fox_mixer(h, w_in, w_out, lower_bound, a_out_gain, q_gain, k_gain, f_bias):
    proj = h @ w_in
    cuts = [A_WIDTH, 2 * A_WIDTH, 3 * A_WIDTH, 4 * A_WIDTH,
            4 * A_WIDTH + B_WIDTH, 4 * A_WIDTH + 2 * B_WIDTH,
            4 * A_WIDTH + 3 * B_WIDTH, 4 * A_WIDTH + 4 * B_WIDTH]
    qa, fa, ia, ga, qb, kb, vb, gb, fb = jnp.split(proj, cuts, axis=-1)
    z = split_heads(fa, A_HEADS).astype(jnp.float32)
    lb = lower_bound.astype(jnp.float32).reshape(A_HEADS, 1, A_DK)
    sig = jax.nn.sigmoid(z)
    forget = lb + (1 - lb) * sig
    log_forget = jnp.log(jnp.maximum(forget, MIN_FORGET))
    key = (1 - lb) * (1 - sig)
    o_a = chunk_gated_linear_recurrence(jax.nn.silu(split_heads(qa, A_HEADS)), key,
                                        split_heads(ia, A_HEADS), log_forget)
    o_a = rms_norm(o_a, a_out_gain[:, None, :])
    o_a = merge_heads(o_a).astype(h.dtype) * jax.nn.silu(ga)
    q = rms_norm(split_heads(qb, B_HEADS), q_gain)
    k = rms_norm(split_heads(kb, B_HEADS), k_gain)
    log_f = jax.nn.log_sigmoid(fb.astype(jnp.float32) + f_bias).transpose(0, 2, 1)
    o_b = forgetting_attention(q, k, split_heads(vb, B_HEADS), log_f)
    o_b = merge_heads(o_b).astype(h.dtype) * jax.nn.sigmoid(gb)
    return jnp.concatenate([o_a, o_b], axis=-1) @ w_out


def gla_mixer(h, w_in, w_gate_up, b_gate, out_gain, w_out):
    proj = h @ w_in
    cuts = [C_KW, 2 * C_KW, 2 * C_KW + C_VW, 2 * C_KW + 2 * C_VW]
    q, k, v, g, g_low = jnp.split(proj, cuts, axis=-1)
    log_alpha = jax.nn.log_sigmoid((g_low @ w_gate_up).astype(jnp.float32) + b_gate) / C_GATE_NORMALIZER
    o = chunk_gated_linear_recurrence(split_heads(q, C_HEADS) * (C_DK ** -0.5),
                                      split_heads(k, C_HEADS), split_heads(v, C_HEADS),
                                      split_heads(log_alpha, C_HEADS))
    o = rms_norm(o, out_gain)
    o = merge_heads(o).astype(h.dtype) * jax.nn.silu(g)
    return o @ w_out


def swiglu(h, w_in, w_out):
    a, u = jnp.split(h @ w_in, 2, axis=-1)
    return (jax.nn.silu(a) * u) @ w_out


def setup_inputs(seed: int = 0) -> dict:
    key = jax.random.key(seed)
    ks = jax.random.split(key, 24)

    def normal(k, shape, std):
        return jax.random.normal(k, shape, jnp.float32) * std

    def gain(k, shape):
        return 1.0 + normal(k, shape, 0.02)

    return {
        "x": normal(ks[0], (BATCH, SEQ, D_MODEL), 1.0),
        "c": normal(ks[1], (BATCH, D_MODEL), 1.0),
        "mod_w": normal(ks[2], (DEPTH, D_MODEL, 6 * D_MODEL), 0.5 * D_MODEL ** -0.5),
        "mod_b": normal(ks[3], (DEPTH, 6 * D_MODEL), 0.02),
        "norm_mix_gain": gain(ks[4], (DEPTH, D_MODEL)),
        "norm_ffn_gain": gain(ks[5], (DEPTH, D_MODEL)),
        "ab_w_in": normal(ks[6], (N_AB, D_MODEL, AB_IN), D_MODEL ** -0.5),
        "ab_w_out": normal(ks[7], (N_AB, AB_CAT, D_MODEL), AB_CAT ** -0.5),
        "hgrn_lb_logits": normal(ks[8], (N_AB, A_WIDTH), 1.0),
        "hgrn_out_gain": gain(ks[9], (N_AB, A_HEADS, A_DV)),
        "fox_q_gain": gain(ks[10], (N_AB, B_HEAD_DIM)),
        "fox_k_gain": gain(ks[11], (N_AB, B_HEAD_DIM)),
        "fox_f_bias": jax.random.uniform(ks[12], (N_AB, B_HEADS), jnp.float32, 1.0, 4.0),
        "gla_w_in": normal(ks[13], (N_C, D_MODEL, C_IN), D_MODEL ** -0.5),
        "gla_w_gate_up": normal(ks[14], (N_C, C_GATE_RANK, C_KW), C_GATE_RANK ** -0.5),
        "gla_b_gate": normal(ks[15], (N_C, C_KW), 0.02),
        "gla_out_gain": gain(ks[16], (N_C, C_DV)),
        "gla_w_out": normal(ks[17], (N_C, C_VW, D_MODEL), C_VW ** -0.5),
        "ffn_w_in": normal(ks[18], (DEPTH, D_MODEL, 2 * D_FF), D_MODEL ** -0.5),
        "ffn_w_out": normal(ks[19], (DEPTH, D_FF, D_MODEL), D_FF ** -0.5),
    }


def reference(x, c, mod_w, mod_b, norm_mix_gain, norm_ffn_gain, ab_w_in, ab_w_out,
              hgrn_lb_logits, hgrn_out_gain, fox_q_gain, fox_k_gain, fox_f_bias,
              gla_w_in, gla_w_gate_up, gla_b_gate, gla_out_gain, gla_w_out,
              ffn_w_in, ffn_w_out):
    probs = jax.nn.softmax(hgrn_lb_logits.astype(jnp.float32), axis=0)
    lower_bounds = jnp.concatenate(
        [jnp.zeros_like(probs[:1]), jnp.cumsum(probs[1:], axis=0)], axis=0)[:N_AB]
    lower_bounds = jnp.clip(lower_bounds, 0.0, 1.0 - 1e-6)
    silu_c = jax.nn.silu(c)
    for layer in range(DEPTH):
        mod = silu_c @ mod_w[layer] + mod_b[layer]
        sh1, sc1, g1, sh2, sc2, g2 = jnp.split(mod, 6, axis=-1)
        h = modulate(rms_norm(x, norm_mix_gain[layer]), sh1, sc1)
        if layer % 2 == 0:
            i = layer // 2
            y = hgrn2_fox_mixer(h, ab_w_in[i], ab_w_out[i], lower_bounds[i], hgrn_out_gain[i],
                                fox_q_gain[i], fox_k_gain[i], fox_f_bias[i])
        else:
            j = layer // 2
            y = gla_mixer(h, gla_w_in[j], gla_w_gate_up[j], gla_b_gate[j], gla_out_gain[j], gla_w_out[j])
        x = x + g1[:, None, :] * y
        h = modulate(rms_norm(x, norm_ffn_gain[layer]), sh2, sc2)
        x = x + g2[:, None, :] * swiglu(h, ffn_w_in[layer], ffn_w_out[layer])
    return x
```

```cpp
#include <hip/hip_runtime.h>
#include <hip/hip_bf16.h>
#include <cstdio>
#include <cstdint>
__device__ __forceinline__ int opq_tid(int wave_s) {
    int t; asm volatile("v_mbcnt_lo_u32_b32 %0, -1, 0\n\tv_mbcnt_hi_u32_b32 %0, -1, %0\n\tv_lshl_add_u32 %0, %1, 6, %0" : "=&v"(t) : "s"(wave_s)); return t; }
__device__ __forceinline__ int opq_bid() { int t = blockIdx.x; asm volatile("" : "+s"(t)); return t; }
template <int MASK> __device__ __forceinline__ float xsum(float v) {
    if constexpr (MASK < 32) { return v + __builtin_bit_cast(float, __builtin_amdgcn_ds_swizzle(__builtin_bit_cast(int, v), (MASK << 10) | 0x1f)); }
    else { auto rr = __builtin_amdgcn_permlane32_swap(__float_as_uint(v), __float_as_uint(v), false, false);
           const unsigned r0 = rr[0], r1 = rr[1];
           return __uint_as_float(r0) + __uint_as_float(r1); }
}
__device__ __forceinline__ float xor1_get(float v) { return __builtin_bit_cast(float, __builtin_amdgcn_ds_swizzle(__builtin_bit_cast(int, v), (1 << 10) | 0x1f)); }
namespace pg8 {
#define PG8_LAS __attribute__((address_space(3)))
typedef unsigned short bf16_t;
typedef short bf16x8 __attribute__((ext_vector_type(8)));
typedef float f32x4 __attribute__((ext_vector_type(4)));
typedef unsigned u32x4 __attribute__((ext_vector_type(4)));
constexpr int BM = 256, BK = 64, HALF = 128, HTB = HALF * BK * 2  , STAGE_BYTES = 8 * HTB, NXCD = 8, WGM = 8;

__host__ __device__ __forceinline__ int lds_byte(int r, int c) { const int st = (r >> 4) * 2 + (c >> 5), rr = r & 15, cc = c & 31, ob = rr * 64 + cc * 2; return st * 1024 + (ob ^ (((ob >> 9) & 1) << 5)); }
__host__ __device__ __forceinline__ void stage_rc(int b, int& R, int& C) { const int st = b / 1024, sb = b % 1024, swz = sb ^ (((sb >> 9) & 1) << 5); R = (st >> 1) * 16 + swz / 64; C = (st & 1) * 32 + (swz % 64) / 2; }
__host__ __device__ __forceinline__ int perm32(int rho) { const int n = rho >> 4, i = rho & 15; return 8 * (i >> 2) + 4 * n + (i & 3); }

struct Unit { int pm, pn; };
struct Gemm { const bf16_t* A; const bf16_t* Bt; int M, N, K; };

struct StaticOrder {
    int nM, nN, nwg, G, c;
    __host__ __device__ void init(int M, int N, int G_, int c_) { nM = M / BM; nN = N / BM; nwg = nM * nN; G = G_; c = c_; }
    __host__ __device__ bool next(int i, Unit& u) const {
        const long L = (long)i * G + c; if (L >= nwg) return false;
        int wgid = (int)L; { const int q = nwg / NXCD, r = nwg % NXCD, xcd = wgid % NXCD, off = wgid / NXCD; wgid = (xcd < r ? xcd * (q + 1) : r * (q + 1) + (xcd - r) * q) + off; }
        const int nig = WGM * nN, gid = wgid / nig, fm = gid * WGM, gsz = (nM - fm) < WGM ? (nM - fm) : WGM;
        u.pm = fm + ((wgid % nig) % gsz); u.pn = (wgid % nig) / gsz; return true;
    }
    __device__ __forceinline__ void a_ready(const Unit&) const {}
    __device__ __forceinline__ void done(const Unit&) const {}
};

__device__ __forceinline__ unsigned cvt_pk_bf16(float lo, float hi) { unsigned r; asm volatile("v_cvt_pk_bf16_f32 %0, %1, %2" : "=v"(r) : "v"(lo), "v"(hi)); return r; }
typedef float f32x2 __attribute__((ext_vector_type(2)));

struct EpiBf16 {
    static constexpr bool PERM = true, AFTER_DRAIN = false;
    bf16_t* O; int ldc;
    __device__ __forceinline__ void operator()(const f32x4 (&acc)[2][2][4][2], const Unit& u, int wr, int wc, int fr, int fq) const {
        const int row0 = u.pm * BM + wr * 64 + fr; const int col0 = u.pn * BM + wc * 32 + 8 * fq;
#pragma unroll
        for (int ai = 0; ai < 2; ++ai)
#pragma unroll
            for (int m = 0; m < 4; ++m) { bf16_t* rowp = O + (size_t)(row0 + ai * HALF + m * 16) * ldc + col0;
#pragma unroll
                for (int bj = 0; bj < 2; ++bj) { const f32x4 v0 = acc[ai][bj][m][0], v1 = acc[ai][bj][m][1];
                    u32x4 w; w.x = cvt_pk_bf16(v0[0], v0[1]); w.y = cvt_pk_bf16(v0[2], v0[3]); w.z = cvt_pk_bf16(v1[0], v1[1]); w.w = cvt_pk_bf16(v1[2], v1[3]);
                    *(u32x4*)(rowp + bj * HALF) = w; } }
    }
};
__device__ __forceinline__ float silu_f(float a) { return a * __builtin_amdgcn_rcpf(1.0f + __builtin_amdgcn_exp2f(-1.4426950408889634f * a)); }
struct EpiSwiglu {
    static constexpr bool PERM = true, AFTER_DRAIN = false;
    bf16_t* O; int ldc;
    __device__ __forceinline__ void operator()(const f32x4 (&acc)[2][2][4][2], const Unit& u, int wr, int wc, int fr, int fq) const {
        const int row0 = u.pm * BM + wr * 64 + fr; const int col0 = u.pn * HALF + wc * 32 + 8 * fq;
#pragma unroll
        for (int ai = 0; ai < 2; ++ai)
#pragma unroll
            for (int m = 0; m < 4; ++m) { bf16_t* rowp = O + (size_t)(row0 + ai * HALF + m * 16) * ldc + col0;
                const f32x4 a0 = acc[ai][0][m][0], a1 = acc[ai][0][m][1], u0 = acc[ai][1][m][0], u1 = acc[ai][1][m][1];
                u32x4 w;
                w.x = cvt_pk_bf16(silu_f(a0[0]) * u0[0], silu_f(a0[1]) * u0[1]); w.y = cvt_pk_bf16(silu_f(a0[2]) * u0[2], silu_f(a0[3]) * u0[3]);
                w.z = cvt_pk_bf16(silu_f(a1[0]) * u1[0], silu_f(a1[1]) * u1[1]); w.w = cvt_pk_bf16(silu_f(a1[2]) * u1[2], silu_f(a1[3]) * u1[3]);
                *(u32x4*)rowp = w; }
    }
};
struct EpiResid {
    static constexpr bool PERM = false, AFTER_DRAIN = false;
    const float* base; float* out; int ldc; const float* gate0; const float* gate1; int pm_split;
    __device__ __forceinline__ void operator()(const f32x4 (&acc)[2][2][4][2], const Unit& u, int wr, int wc, int fr, int fq) const {
        const int col0 = u.pn * BM + wc * 32 + 4 * fq; const float* g = (u.pm >= pm_split) ? gate1 : gate0;
        f32x4 gv[2][2];
#pragma unroll
        for (int bj = 0; bj < 2; ++bj)
#pragma unroll
            for (int n = 0; n < 2; ++n) gv[bj][n] = *(const f32x4*)(g + col0 + bj * HALF + n * 16);
#pragma unroll
        for (int ai = 0; ai < 2; ++ai) { f32x4 bs[4][2][2];
#pragma unroll
            for (int m = 0; m < 4; ++m) { const size_t off = (size_t)(u.pm * BM + ai * HALF + wr * 64 + m * 16 + fr) * ldc + col0;
#pragma unroll
                for (int bj = 0; bj < 2; ++bj)
#pragma unroll
                    for (int n = 0; n < 2; ++n) bs[m][bj][n] = *(const f32x4*)(base + off + bj * HALF + n * 16); }
#pragma unroll
            for (int m = 0; m < 4; ++m) { const size_t off = (size_t)(u.pm * BM + ai * HALF + wr * 64 + m * 16 + fr) * ldc + col0;
#pragma unroll
                for (int bj = 0; bj < 2; ++bj)
#pragma unroll
                    for (int n = 0; n < 2; ++n) *(f32x4*)(out + off + bj * HALF + n * 16) = bs[m][bj][n] + gv[bj][n] * acc[ai][bj][m][n]; }
            asm volatile("" ::: "memory"); }
    }
};

template <class Epi, class Sched, bool ALIGN_EPI = false, bool SP2 = false>
__device__ __forceinline__ void gemm_phase(PG8_LAS unsigned char* lds, const Gemm g, const Sched& S, const Epi& E, const int tid) {
    const int wid = __builtin_amdgcn_readfirstlane(tid >> 6), lane = tid & 63, wr = wid >> 2, wc = wid & 3, fr = lane & 15, fq = lane >> 4;
    const int K = g.K, nt = K / BK;
    unsigned voffA[2], voffB[2];
#pragma unroll
    for (int i = 0; i < 2; ++i) { int R, C; stage_rc(tid * 16 + i * 8192, R, C); const int Rb = Epi::PERM ? ((R & ~31) + perm32(R & 31)) : R;
        voffA[i] = (unsigned)(R * K + C) * 2u; voffB[i] = (unsigned)(Rb * K + C) * 2u; }
    const size_t kstep = (size_t)(BK * 2);
    const size_t hstep = (size_t)HALF * K * 2;
    const size_t tstep = 2 * hstep;
    const unsigned ldsw = (unsigned)wid * 1024u;
    const int aoff = lds_byte(wr * 64 + fr, fq * 8), boff = lds_byte(wc * 32 + fr, fq * 8);
#define PG8_SA(b, h) (((b) * 2 + (h)) * HTB)
#define PG8_SB(b, h) ((4 + (b) * 2 + (h)) * HTB)
#define PG8_STAGE(bufoff, gbase, voff) do { _Pragma("unroll") for (int _i = 0; _i < 2; ++_i) \
        __builtin_amdgcn_global_load_lds((const unsigned*)((const char*)(gbase) + (voff)[_i]), (PG8_LAS unsigned*)(lds + (bufoff) + ldsw + _i * 8192), 16, 0, 0); } while (0)
#define PG8_LDA(dst, b, h) do { _Pragma("unroll") for (int m = 0; m < 4; ++m) _Pragma("unroll") for (int k = 0; k < 2; ++k) dst[m][k] = *(const PG8_LAS bf16x8*)(lds + PG8_SA(b, h) + aoff + m * 2048 + k * 1024); } while (0)
#define PG8_LDB(dst, b, h) do { _Pragma("unroll") for (int n = 0; n < 2; ++n) _Pragma("unroll") for (int k = 0; k < 2; ++k) dst[n][k] = *(const PG8_LAS bf16x8*)(lds + PG8_SB(b, h) + boff + n * 2048 + k * 1024); } while (0)
#define PG8_MMA(ai, bj, At, Bt) do { __builtin_amdgcn_s_setprio(1); _Pragma("unroll") for (int m = 0; m < 4; ++m) _Pragma("unroll") for (int n = 0; n < 2; ++n) _Pragma("unroll") for (int k = 0; k < 2; ++k) \
        acc[ai][bj][m][n] = __builtin_amdgcn_mfma_f32_16x16x32_bf16(Bt[n][k], At[m][k], acc[ai][bj][m][n], 0, 0, 0); __builtin_amdgcn_s_setprio(0); } while (0)
#define PG8_WAIT_V(n) asm volatile("s_waitcnt vmcnt(" #n ")" ::: "memory")
#define PG8_WAIT_L(n) asm volatile("s_waitcnt lgkmcnt(" #n ")" ::: "memory")
#define PG8_BAR __builtin_amdgcn_s_barrier()
#define PG8_SCHED __builtin_amdgcn_sched_barrier(0)
    Unit cur, nxt; int ui = 0;
    if (!S.next(0, cur)) return;
    f32x4 acc[2][2][4][2];
#pragma unroll
    for (int a = 0; a < 2; ++a)
#pragma unroll
        for (int b = 0; b < 2; ++b)
#pragma unroll
            for (int m = 0; m < 4; ++m)
#pragma unroll
                for (int n = 0; n < 2; ++n) acc[a][b][m][n] = (f32x4){0.f, 0.f, 0.f, 0.f};
    bf16x8 At[4][2], B0[2][2], B1[2][2];
    const char* cA = (const char*)g.A + (size_t)cur.pm * tstep; const char* cB = (const char*)g.Bt + (size_t)cur.pn * tstep;
    S.a_ready(cur);
    if constexpr (SP2) {
        PG8_STAGE(PG8_SB(0, 0), cB, voffB); PG8_STAGE(PG8_SB(0, 1), cB + hstep, voffB); PG8_STAGE(PG8_SA(0, 0), cA, voffA); PG8_STAGE(PG8_SA(0, 1), cA + hstep, voffA);
        if (wr == 1) PG8_BAR;
        PG8_WAIT_V(2); PG8_BAR;
        PG8_STAGE(PG8_SB(1, 0), cB + kstep, voffB); PG8_STAGE(PG8_SA(1, 0), cA + kstep, voffA); PG8_STAGE(PG8_SB(1, 1), cB + hstep + kstep, voffB);
        PG8_WAIT_V(6); PG8_BAR;
    } else {
        PG8_STAGE(PG8_SB(0, 0), cB, voffB); PG8_STAGE(PG8_SA(0, 0), cA, voffA); PG8_STAGE(PG8_SB(0, 1), cB + hstep, voffB); PG8_STAGE(PG8_SA(0, 1), cA + hstep, voffA);
        if (wr == 1) PG8_BAR;
        PG8_WAIT_V(4); PG8_BAR;
        PG8_STAGE(PG8_SB(1, 0), cB + kstep, voffB); PG8_STAGE(PG8_SA(1, 0), cA + kstep, voffA); PG8_STAGE(PG8_SB(1, 1), cB + hstep + kstep, voffB);
        PG8_WAIT_V(6); PG8_BAR;
    }
    for (;;) {
        const bool has_next = S.next(ui + 1, nxt);
        const char* nA = has_next ? (const char*)g.A + (size_t)nxt.pm * tstep : cA; const char* nB = has_next ? (const char*)g.Bt + (size_t)nxt.pn * tstep : cB;
        for (int t = 0; t < nt; t += 2) {
            const bool last = (t == nt - 2);
            const char* a1 = cA + (size_t)(t + 1) * kstep;
            const char* a2 = last ? nA : cA + (size_t)(t + 2) * kstep; const char* b2 = last ? nB : cB + (size_t)(t + 2) * kstep;
            const char* a3 = a2 + kstep; const char* b3 = b2 + kstep;
            if (last && has_next) S.a_ready(nxt);
            if constexpr (SP2) {
            PG8_LDB(B0, 0, 0); PG8_LDB(B1, 0, 1); PG8_SCHED; PG8_LDA(At, 0, 0); PG8_STAGE(PG8_SA(1, 1), a1 + hstep, voffA);
            PG8_WAIT_V(8); PG8_WAIT_L(0); PG8_BAR; PG8_MMA(0, 0, At, B0); PG8_MMA(0, 1, At, B1); PG8_BAR; PG8_SCHED;
            PG8_LDA(At, 0, 1); PG8_STAGE(PG8_SB(0, 0), b2, voffB); PG8_STAGE(PG8_SB(0, 1), b2 + hstep, voffB); PG8_STAGE(PG8_SA(0, 0), a2, voffA);
            PG8_WAIT_V(8); PG8_WAIT_L(0); PG8_BAR; PG8_MMA(1, 0, At, B0); PG8_MMA(1, 1, At, B1); PG8_BAR; PG8_SCHED;
            PG8_LDB(B0, 1, 0); PG8_LDB(B1, 1, 1); PG8_SCHED; PG8_LDA(At, 1, 0); PG8_STAGE(PG8_SA(0, 1), a2 + hstep, voffA);
            PG8_WAIT_V(8); PG8_WAIT_L(0); PG8_BAR; PG8_MMA(0, 0, At, B0); PG8_MMA(0, 1, At, B1); PG8_BAR; PG8_SCHED;
            PG8_LDA(At, 1, 1); PG8_STAGE(PG8_SB(1, 0), b3, voffB); PG8_STAGE(PG8_SB(1, 1), b3 + hstep, voffB); PG8_STAGE(PG8_SA(1, 0), a3, voffA);
            PG8_WAIT_V(8); PG8_WAIT_L(0); PG8_BAR; PG8_MMA(1, 0, At, B0); PG8_MMA(1, 1, At, B1); PG8_BAR; PG8_SCHED;
            } else {
            PG8_LDB(B0, 0, 0); PG8_SCHED; PG8_LDA(At, 0, 0); PG8_STAGE(PG8_SA(1, 1), a1 + hstep, voffA);
            PG8_WAIT_L(8); PG8_BAR; PG8_WAIT_L(0); PG8_MMA(0, 0, At, B0); PG8_BAR; PG8_SCHED;
            PG8_LDB(B1, 0, 1); PG8_STAGE(PG8_SB(0, 0), b2, voffB);
            PG8_BAR; PG8_WAIT_L(0); PG8_MMA(0, 1, At, B1); PG8_BAR;
            PG8_LDA(At, 0, 1); PG8_STAGE(PG8_SA(0, 0), a2, voffA);
            PG8_BAR; PG8_WAIT_L(0); PG8_MMA(1, 0, At, B0); PG8_BAR; PG8_SCHED;
            PG8_STAGE(PG8_SB(0, 1), b2 + hstep, voffB);
            PG8_WAIT_V(6); PG8_BAR; PG8_MMA(1, 1, At, B1); PG8_BAR;
            PG8_LDB(B0, 1, 0); PG8_SCHED; PG8_LDA(At, 1, 0); PG8_STAGE(PG8_SA(0, 1), a2 + hstep, voffA);
            PG8_WAIT_L(8); PG8_BAR; PG8_WAIT_L(0); PG8_MMA(0, 0, At, B0); PG8_BAR; PG8_SCHED;
            PG8_LDB(B1, 1, 1); PG8_STAGE(PG8_SB(1, 0), b3, voffB);
            PG8_BAR; PG8_WAIT_L(0); PG8_MMA(0, 1, At, B1); PG8_BAR;
            PG8_LDA(At, 1, 1); PG8_STAGE(PG8_SA(1, 0), a3, voffA);
            PG8_BAR; PG8_WAIT_L(0); PG8_MMA(1, 0, At, B0); PG8_BAR; PG8_SCHED;
            PG8_STAGE(PG8_SB(1, 1), b3 + hstep, voffB);
            PG8_WAIT_V(6); PG8_BAR; PG8_MMA(1, 1, At, B1); PG8_BAR;
            }
        }
        if constexpr (ALIGN_EPI) { if (wr == 0) PG8_BAR; }
        if constexpr (!Epi::AFTER_DRAIN) { E(acc, cur, wr, wc, fr, fq); S.done(cur); }
        if (!has_next) break;
#pragma unroll
        for (int a = 0; a < 2; ++a)
#pragma unroll
            for (int b = 0; b < 2; ++b)
#pragma unroll
                for (int m = 0; m < 4; ++m)
#pragma unroll
                    for (int n = 0; n < 2; ++n) acc[a][b][m][n] = (f32x4){0.f, 0.f, 0.f, 0.f};
        cur = nxt; cA = nA; cB = nB; ++ui;
        if constexpr (ALIGN_EPI) { if (wr == 1) PG8_BAR; }
    }
    PG8_WAIT_V(0);
    if constexpr (!ALIGN_EPI) { if (wr == 0) PG8_BAR; }
    PG8_BAR;
    if constexpr (Epi::AFTER_DRAIN) { E.fused(acc, cur, wr, wc, fr, fq, lds, wid, lane); S.done(cur); }
#undef PG8_SA
#undef PG8_SB
#undef PG8_STAGE
#undef PG8_LDA
#undef PG8_LDB
#undef PG8_MMA
#undef PG8_WAIT_V
#undef PG8_WAIT_L
#undef PG8_BAR
#undef PG8_SCHED
}
}
namespace fox {
constexpr int D = 128, PITCH = 8192, OPITCH = 2048, SKV = 8192, GATE_OFF = 3072;
constexpr float THR = 8.f;
constexpr float SCALE = 0.08838834764831845f;
constexpr int NW = 8, QBLK = 32, KVBLK = 64, QB = NW * QBLK;
constexpr int SHM_V = KVBLK * D * 2, SHM_K = KVBLK * D * 2;
constexpr int BIAS_OFF = 2 * SHM_V + 2 * SHM_K + NW * 64 * 4;
constexpr int LDS_BYTES = BIAS_OFF + SKV * 4;

using bf16 = __hip_bfloat16;
typedef short bf16x8 __attribute__((ext_vector_type(8)));
typedef short s16x4 __attribute__((ext_vector_type(4)));
typedef float f32x16 __attribute__((ext_vector_type(16)));
typedef float f32x4 __attribute__((ext_vector_type(4)));
typedef unsigned u32x4 __attribute__((ext_vector_type(4)));

#define KSWZ(row, colB) ((row) * 256 + ((colB) ^ (((row) & 7) << 4)))
#define SBAR() __builtin_amdgcn_sched_barrier(0)
__device__ __forceinline__ int v_st(int k, int c) { const int kk = (k & ~0xC) | ((k & 4) << 1) | ((k & 8) >> 1); return ((kk >> 3) * 4 + (c >> 5)) * 512 + ((kk & 7) * 32 + (c & 31)) * 2; }
__device__ __forceinline__ int v_rd_base(int lane) { return ((lane & 3) << 3) | (((lane >> 2) & 3) << 6) | (((lane >> 4) & 1) << 5) | (((lane >> 5) & 1) << 8); }
constexpr int v_rd_off(int d0, int ks, int half) { return d0 * 512 + ks * 4096 + half * 2048; }
__device__ __forceinline__ int crow(int r, int hi) { return (r & 3) + 8 * (r >> 2) + 4 * hi; }
__device__ __forceinline__ unsigned cvtpk(float lo, float hi) {
    unsigned r; asm volatile("v_cvt_pk_bf16_f32 %0, %1, %2" : "=v"(r) : "v"(lo), "v"(hi)); return r;
}
__device__ __forceinline__ bf16x8 load8(const bf16* p) { return *reinterpret_cast<const bf16x8*>(p); }
__device__ __forceinline__ void mask_tile(f32x16& p0, f32x16& p1, int dq, unsigned W) {
    const float NEG = -__builtin_inff();
#pragma unroll
    for (int r = 0; r < 16; ++r) {
        const int c = (r & 3) + 8 * (r >> 2);
        if ((unsigned)(dq - c) >= W) p0[r] = NEG;
        if ((unsigned)(dq - c - 32) >= W) p1[r] = NEG;
    }
}
__device__ __forceinline__ void partialSM(f32x16& p0, f32x16& p1, float& m_reg, float& mn, float& alpha) {
    float pmax = p0[0]; for (int r = 1; r < 16; ++r) pmax = fmaxf(pmax, p0[r]); for (int r = 0; r < 16; ++r) pmax = fmaxf(pmax, p1[r]);
    { auto rr = __builtin_amdgcn_permlane32_swap(__float_as_uint(pmax), __float_as_uint(pmax), false, false);
      pmax = fmaxf(__uint_as_float(rr[0]), __uint_as_float(rr[1])); }
    constexpr float C2 = 1.4426950408889634f * SCALE;
    if (__builtin_expect(__all((pmax - m_reg) * SCALE <= THR), 1)) { mn = m_reg; alpha = 1.f; }
    else { mn = fmaxf(m_reg, pmax); alpha = __builtin_amdgcn_exp2f((m_reg - mn) * C2); m_reg = mn; }
    const float mnL = -mn * C2;
    for (int r = 0; r < 16; ++r) p0[r] = fmaf(p0[r], C2, mnL); for (int r = 0; r < 16; ++r) p1[r] = fmaf(p1[r], C2, mnL);
    for (int r = 0; r < 16; ++r) p0[r] = __builtin_amdgcn_exp2f(p0[r]);
}
__device__ __forceinline__ void finishSM(f32x16& p0, f32x16& p1, float alpha, float& l_reg, bf16x8& pa0, bf16x8& pa1, bf16x8& pa2, bf16x8& pa3) {
    for (int r = 0; r < 16; ++r) p1[r] = __builtin_amdgcn_exp2f(p1[r]);
    float ps = 0; for (int r = 0; r < 16; ++r) ps += p0[r]; for (int r = 0; r < 16; ++r) ps += p1[r];
    { auto rr = __builtin_amdgcn_permlane32_swap(__float_as_uint(ps), __float_as_uint(ps), false, false);
      ps = __uint_as_float(rr[0]) + __uint_as_float(rr[1]); }
    l_reg = l_reg * alpha + ps;
#define PK4(P, B_, OUT) do { unsigned a0 = cvtpk(P[B_+0], P[B_+1]), a1 = cvtpk(P[B_+2], P[B_+3]);                          \
        unsigned b0 = cvtpk(P[B_+4], P[B_+5]), b1 = cvtpk(P[B_+6], P[B_+7]);                                             \
        auto r0 = __builtin_amdgcn_permlane32_swap(a0, b0, false, false); auto r1 = __builtin_amdgcn_permlane32_swap(a1, b1, false, false); \
        u32x4 w = {r0[0], r1[0], r0[1], r1[1]}; OUT = *reinterpret_cast<bf16x8*>(&w); } while (0)
    PK4(p0, 0, pa0); PK4(p0, 8, pa1); PK4(p1, 0, pa2); PK4(p1, 8, pa3);
#undef PK4
}
template <int KB>
__device__ __forceinline__ void qkt(f32x16& p0, f32x16& p1, const char* K_lds, const float* bt, int r32, int hi, const bf16x8* qr) {
#pragma unroll
    for (int j = 0; j < 4; ++j) { const f32x4 a = *(const f32x4*)(bt + 8 * j), b = *(const f32x4*)(bt + 32 + 8 * j);
        p0[4 * j + 0] = a[0]; p0[4 * j + 1] = a[1]; p0[4 * j + 2] = a[2]; p0[4 * j + 3] = a[3];
        p1[4 * j + 0] = b[0]; p1[4 * j + 1] = b[1]; p1[4 * j + 2] = b[2]; p1[4 * j + 3] = b[3]; }
    const char* kb[4];
#pragma unroll
    for (int dd = 0; dd < 4; ++dd) kb[dd] = K_lds + KB * SHM_K + KSWZ(r32, (dd * 16 + hi * 8) * 2);
#pragma unroll
    for (int d0 = 0; d0 < 8; ++d0) { const char* a = kb[d0 & 3] + (d0 >> 2) * 128;
        bf16x8 b0 = *reinterpret_cast<const bf16x8*>(a);
        bf16x8 b1 = *reinterpret_cast<const bf16x8*>(a + 32 * 256);
        p0 = __builtin_amdgcn_mfma_f32_32x32x16_bf16(b0, qr[d0], p0, 0, 0, 0);
        p1 = __builtin_amdgcn_mfma_f32_32x32x16_bf16(b1, qr[d0], p1, 0, 0, 0); }
}
template <int VB>
__device__ __forceinline__ void pv_tile(f32x16* o, int vb0, bf16x8 pa0, bf16x8 pa1, bf16x8 pa2, bf16x8 pa3) {
#define TRRD(dst, off) asm volatile("ds_read_b64_tr_b16 %0, %1 offset:%2" : "=&v"(dst) : "v"(vb0), "i"(off) : "memory")
#define PV_D0(d0) do { s16x4 l0, l1, l2, l3, h0, h1, h2, h3; constexpr int b_ = VB * SHM_V + v_rd_off(d0, 0, 0);     \
        TRRD(l0, b_); TRRD(h0, b_ + 2048); TRRD(l1, b_ + 4096); TRRD(h1, b_ + 6144); TRRD(l2, b_ + 8192); TRRD(h2, b_ + 10240); TRRD(l3, b_ + 12288); TRRD(h3, b_ + 14336); \
        asm volatile("s_waitcnt lgkmcnt(0)" ::: "memory"); SBAR();                 \
        o[d0] = __builtin_amdgcn_mfma_f32_32x32x16_bf16(pa0, (bf16x8){l0[0], l0[1], l0[2], l0[3], h0[0], h0[1], h0[2], h0[3]}, o[d0], 0, 0, 0);   \
        o[d0] = __builtin_amdgcn_mfma_f32_32x32x16_bf16(pa1, (bf16x8){l1[0], l1[1], l1[2], l1[3], h1[0], h1[1], h1[2], h1[3]}, o[d0], 0, 0, 0);   \
        o[d0] = __builtin_amdgcn_mfma_f32_32x32x16_bf16(pa2, (bf16x8){l2[0], l2[1], l2[2], l2[3], h2[0], h2[1], h2[2], h2[3]}, o[d0], 0, 0, 0);   \
        o[d0] = __builtin_amdgcn_mfma_f32_32x32x16_bf16(pa3, (bf16x8){l3[0], l3[1], l3[2], l3[3], h3[0], h3[1], h3[2], h3[3]}, o[d0], 0, 0, 0); } while (0)
    PV_D0(0); PV_D0(1); PV_D0(2); PV_D0(3);
#undef PV_D0
#undef TRRD
}

struct BlockRef { const bf16* Q; const bf16* K; const bf16* V; bf16* O; const float* Bias; int P0; float THp; };
struct Seam { bf16x8 qr[8]; bf16x8 st_v0, st_v1, st_k0, st_k1; };
#define ROW(p, k0, rr) ((const bf16*)((const char*)(p) + (size_t)(k0) * (PITCH * 2) + (unsigned)(voff + (unsigned)(rr) * (PITCH * 2u))))
#define VMW() asm volatile("s_waitcnt vmcnt(0)" ::: "memory")
#define VMWN(n) asm volatile("s_waitcnt vmcnt(%0)" :: "i"(n) : "memory")
#define SLOAD_H(Kp, Vp, k0) do { S.st_v0 = load8(ROW(Vp, k0, 0)); S.st_v1 = load8(ROW(Vp, k0, 32));              \
                         S.st_k0 = load8(ROW(Kp, k0, 0)); S.st_k1 = load8(ROW(Kp, k0, 32)); } while (0)
#define SWRITE_HK(bf) do { *(bf16x8*)(K_lds + (bf) * SHM_K + kws) = S.st_k0; *(bf16x8*)(K_lds + (bf) * SHM_K + kws + 32 * 256) = S.st_k1; } while (0)
#define SWRITE_HV(bf) do { *(bf16x8*)(V_lds + (bf) * SHM_V + vst0) = S.st_v0; *(bf16x8*)(V_lds + (bf) * SHM_V + vst1) = S.st_v1; } while (0)
#define SWRITE_H(bf) do { SWRITE_HV(bf); SWRITE_HK(bf); } while (0)
__device__ __forceinline__ void fox_prime(const BlockRef& cur, char* lds, Seam& S, const int tid) {
    const int wid = __builtin_amdgcn_readfirstlane(tid >> 6), lane = tid & 63, r32 = lane & 31, hi = lane >> 5;
    const int sr = tid >> 4, sc = (tid & 15) * 8, kws = KSWZ(sr, sc * 2); char* K_lds = lds + 2 * SHM_V;
    const unsigned voff = (unsigned)(sr * PITCH + sc) * 2u, qoff = (unsigned)((wid * QBLK + r32) * PITCH + hi * 8) * 2u;
    for (int d0 = 0; d0 < 8; ++d0) S.qr[d0] = load8((const bf16*)((const char*)cur.Q + (qoff + d0 * 32)));
    (void)kws; (void)K_lds; (void)voff;
    __syncthreads();
}
__device__ __forceinline__ void fox_block(const BlockRef& cur, const BlockRef& nxt, char* lds, Seam& S, const int tid) {
    const int wid = __builtin_amdgcn_readfirstlane(tid >> 6), lane = tid & 63, r32 = lane & 31, hi = lane >> 5;
    const int W = SKV;
    const int NTF = (cur.P0 + QB - 1) / KVBLK + 1;
    const int qlo = cur.P0 + wid * QBLK, qm = qlo + r32 - 4 * hi;
    char* V_lds = lds; char* K_lds = lds + 2 * SHM_V;
    float* ws = (float*)(lds + 2 * SHM_V + 2 * SHM_K) + wid * 64; float* li_l = ws, * al_l = ws + 32;
    float* biasL = (float*)(lds + BIAS_OFF);
    { const int nk = cur.P0 + QB;
      int t4 = tid * 4; asm volatile("" : "+v"(t4));
      f32x4 bv[4];
#pragma unroll
      for (int k = 0; k < 4; ++k) { const int i = t4 + k * (NW * 64 * 4); if (i < nk) bv[k] = *(const f32x4*)((const char*)cur.Bias + (unsigned)(i * 4)); }
#pragma unroll
      for (int k = 0; k < 4; ++k) { const int i = t4 + k * (NW * 64 * 4); if (i < nk) *(f32x4*)(biasL + i) = bv[k]; }
      __syncthreads(); }
    int j_lo; { int lo_ = 0, hi_ = cur.P0 / KVBLK; const float bref = biasL[cur.P0] - cur.THp;
        while (lo_ < hi_) { const int mid = (lo_ + hi_) >> 1; if (biasL[mid * KVBLK + KVBLK - 1] < bref) lo_ = mid + 1; else hi_ = mid; }
        j_lo = __builtin_amdgcn_readfirstlane(lo_); }
    const int NT = NTF - j_lo;
    const float* bl = biasL + 4 * hi;
    float m_reg = -1e30f, l_reg = 0; f32x16 o[4] = {};
    const int sr = tid >> 4, sc = (tid & 15) * 8, vst0 = v_st(sr, sc), vst1 = v_st(32 + sr, sc), kws = KSWZ(sr, sc * 2);
    const unsigned voff = (unsigned)(sr * PITCH + sc) * 2u, qoff = (unsigned)((wid * QBLK + r32) * PITCH + hi * 8) * 2u;
    const int vb0 = (int)(uintptr_t)V_lds + v_rd_base(lane);
    const bf16* Kh = cur.K; const bf16* Vh = cur.V;
#define RESC(a) do { if (__any((a) < 1.f)) { if (hi == 0) al_l[r32] = (a); asm volatile("s_waitcnt lgkmcnt(0)" ::: "memory");              \
                     for (int d_ = 0; d_ < 4; ++d_) for (int r = 0; r < 16; ++r) o[d_][r] *= al_l[crow(r, hi)]; } } while (0)
#define KBASE(t) ((j_lo + (NT - 1 - (t))) * KVBLK)
#define MASKT(P0_, P1_, t) do { const int kb_ = KBASE(t); if (kb_ + KVBLK - 1 > qlo) mask_tile(P0_, P1_, qm - kb_, (unsigned)W); } while (0)
    constexpr int NQL = 8;
#define SEAM_K0() do { VMWN(NQL); SWRITE_HK(0); SBAR(); } while (0)
    f32x16 pA0, pA1, pB0, pB1; float mnA, mnB, alA, alB; bf16x8 pa0, pa1, pa2, pa3;
    SLOAD_H(Kh, Vh, KBASE(0)); VMW(); SWRITE_HK(0); SWRITE_HV(0); __syncthreads();
    SBAR();
    if (NT > 1) { SLOAD_H(Kh, Vh, KBASE(1)); }
    SBAR(); qkt<0>(pA0, pA1, K_lds, bl + KBASE(0), r32, hi, S.qr);
    MASKT(pA0, pA1, 0); partialSM(pA0, pA1, m_reg, mnA, alA);
    if (NT > 1) { VMW(); SWRITE_H(1); }
    __syncthreads();
#define HALF_STEP(PX0, PX1, mnX, alX, PY0, PY1, alY, t, KB, VB, SB) do {                                                      \
        SBAR(); qkt<KB>(PX0, PX1, K_lds, bl + KBASE(t), r32, hi, S.qr);                                             \
        finishSM(PY0, PY1, alY, l_reg, pa0, pa1, pa2, pa3); SBAR();                                                           \
        if ((t) + 1 < NT) { SLOAD_H(Kh, Vh, KBASE((t) + 1)); SBAR(); }                                               \
        pv_tile<VB>(o, vb0, pa0, pa1, pa2, pa3); MASKT(PX0, PX1, (t)); partialSM(PX0, PX1, m_reg, mnX, alX);                                        \
        __syncthreads();                                                                                                      \
        if ((t) + 1 < NT) { VMW(); SWRITE_H(SB); }                                                                          \
        RESC(alX); __syncthreads(); } while (0)
    for (int t = 1; t + 1 < NT; t += 2) {
        HALF_STEP(pB0, pB1, mnB, alB, pA0, pA1, alA, t, 1, 0, 0);
        HALF_STEP(pA0, pA1, mnA, alA, pB0, pB1, alB, t + 1, 0, 1, 1);
    }
    const bool even = (NT & 1) == 0;
    if (even) { SBAR(); qkt<1>(pB0, pB1, K_lds, bl + KBASE(NT - 1), r32, hi, S.qr); SBAR(); }
#pragma unroll
    for (int d0 = 0; d0 < 8; ++d0) S.qr[d0] = load8((const bf16*)((const char*)nxt.Q + (qoff + d0 * 32)));
    SBAR();
    finishSM(pA0, pA1, alA, l_reg, pa0, pa1, pa2, pa3); SBAR();
    pv_tile<0>(o, vb0, pa0, pa1, pa2, pa3);
    if (even) { MASKT(pB0, pB1, NT - 1); partialSM(pB0, pB1, m_reg, mnB, alB); __syncthreads(); RESC(alB);
        finishSM(pB0, pB1, alB, l_reg, pa0, pa1, pa2, pa3); SBAR(); pv_tile<1>(o, vb0, pa0, pa1, pa2, pa3); }
    SBAR();
    if (hi == 0) li_l[r32] = l_reg; asm volatile("s_waitcnt lgkmcnt(0)" ::: "memory");
    float rli[16];
#pragma unroll
    for (int r = 0; r < 16; ++r) rli[r] = __builtin_amdgcn_rcpf(li_l[crow(r, hi)]);
    char* Ow = (char*)cur.O; const unsigned ooff = (unsigned)((wid * QBLK + 4 * hi) * OPITCH + r32) * 2u;
    const char* Gq = (const char*)cur.Q + GATE_OFF * 2; const unsigned goff = (unsigned)((wid * QBLK + 4 * hi) * PITCH + r32) * 2u;
    unsigned short gq[16][4];
#pragma unroll
    for (int r = 0; r < 16; ++r)
#pragma unroll
        for (int d0 = 0; d0 < 4; ++d0) gq[r][d0] = *(const unsigned short*)(Gq + (goff + (unsigned)(((r & 3) + 8 * (r >> 2)) * PITCH + d0 * 32) * 2u));
#pragma unroll
    for (int r = 0; r < 16; ++r) {
#pragma unroll
        for (int d0 = 0; d0 < 4; ++d0) { const unsigned short gw = gq[r][d0];
            const float gl = __builtin_bit_cast(float, (unsigned)gw << 16);
            const float v = o[d0][r] * rli[r] * __builtin_amdgcn_rcpf(1.0f + __builtin_amdgcn_exp2f(-1.4426950408889634f * gl));
            const float vn = xor1_get(v);
            if ((r32 & 1) == 0) *(unsigned*)(Ow + (ooff + (unsigned)(((r & 3) + 8 * (r >> 2)) * OPITCH + d0 * 32) * 2u)) = cvtpk(v, vn); } }
    __syncthreads();
#undef RESC
#undef KBASE
#undef MASKT
#undef SEAM_K0
#undef HALF_STEP
}
#undef ROW
#undef VMW
#undef VMWN
#undef SLOAD_H
#undef SWRITE_HK
#undef SWRITE_HV
#undef SWRITE_H
#undef KSWZ
#undef SBAR
}

constexpr int NWAVES = 8, NTHREADS = NWAVES * 64;
constexpr int DM = 2048, BATCH = 2, T = 8192, M = BATCH * T, DEPTH = 4;
constexpr int AB_IN = 8200, AB_N = 8192;
constexpr int C_IN = 6160, C_N = 6144;
constexpr int FF = 5632, FF2 = 2 * FF;
constexpr float EPS = 1e-6f;
enum PhaseKind { K_NORM1 = 0, K_MIXIN, K_PREP, K_REC, K_POST, K_MIXOUT, K_NORM2, K_FFIN, K_FFOUT, K_PRO };
constexpr int phase_base(int layer) { return 1 + 9 * layer; }
constexpr int N_PHASES = phase_base(DEPTH) + 1;
constexpr int CW_QUEUE = 8192;
inline int phase_kind(int p, int& layer) { if (p == 0) { layer = 0; return K_PRO; } for (layer = DEPTH - 1; phase_base(layer) > p; --layer) {} return p - phase_base(layer); }
constexpr size_t MiB = 1u << 20;
constexpr size_t WS_CTL = 0, CTL_ZERO_BYTES = 1 * MiB;
constexpr size_t WS_MOD = 1 * MiB;
constexpr size_t WS_LOGF = 2 * MiB;
constexpr size_t WS_BIAS = 3 * MiB;
constexpr size_t WS_GLOW = 4 * MiB;
constexpr size_t WS_W_ABIN = 8 * MiB, WS_W_ABOUT = 72 * MiB, WS_W_GLIN = 88 * MiB, WS_W_GLOUT = 136 * MiB, WS_W_FFIN = 152 * MiB, WS_W_FFOUT = 328 * MiB;
constexpr size_t WS_H = 416 * MiB, WS_CAT = 480 * MiB, WS_PROJ = 544 * MiB, WS_FFH = WS_PROJ, WS_O = 800 * MiB, WS_REC = 928 * MiB, WS_Y = 1064 * MiB, WS_XB = 1128 * MiB, WS_END = 1192 * MiB;
constexpr int CW_BAR = 4096;
constexpr int RING_OFF = 0, RING_BYTES = 139264;
constexpr int LDSCTL_OFF = RING_BYTES, MISC_OFF = LDSCTL_OFF + 320;
constexpr int LDS_BYTES = 155648;
static_assert(fox::LDS_BYTES <= RING_BYTES, "attention LDS");

#define GAS __attribute__((address_space(1)))
#define LAS __attribute__((address_space(3)))
typedef unsigned short bf16;
typedef unsigned v4u __attribute__((ext_vector_type(4)));
typedef unsigned v2u __attribute__((ext_vector_type(2)));
typedef float f32x4 __attribute__((ext_vector_type(4)));
typedef GAS unsigned gu32;
#define RLX_AGENT __ATOMIC_RELAXED, __HIP_MEMORY_SCOPE_AGENT
#define LDS_WAIT() asm volatile("s_waitcnt lgkmcnt(0)" ::: "memory")
__device__ __forceinline__ unsigned pk2(float lo, float hi) { unsigned r; asm("v_cvt_pk_bf16_f32 %0, %1, %2" : "=v"(r) : "v"(lo), "v"(hi)); return r; }
__device__ __forceinline__ unsigned f2bf(float f) { return pk2(f, f) & 0xffffu; }
__device__ __forceinline__ float bf_lo(unsigned w) { return __builtin_bit_cast(float, w << 16); }
__device__ __forceinline__ float bf_hi(unsigned w) { return __builtin_bit_cast(float, w & 0xffff0000u); }
__device__ __forceinline__ float bf1(bf16 h) { return __builtin_bit_cast(float, (unsigned)h << 16); }
__device__ __forceinline__ float sigmoid_f(float x) { return __builtin_amdgcn_rcpf(1.0f + __expf(-x)); }
__device__ __forceinline__ float silu_x(float x) { return x * __builtin_amdgcn_rcpf(1.0f + __expf(-x)); }
__device__ __forceinline__ float log_sigmoid_f(float x) { return fminf(x, 0.f) - log1pf(__expf(-fabsf(x))); }
__device__ __forceinline__ float log_sigmoid_fast(float x) { return fminf(x, 0.f) - __logf(1.0f + __expf(-fabsf(x))); }
__device__ __forceinline__ float wave_sum(float v) {
    v = xsum<1>(v); v = xsum<2>(v); v = xsum<4>(v); v = xsum<8>(v); v = xsum<16>(v); v = xsum<32>(v);
    return v;
}

#define XB_TMO      128
#define XB_XCNT(j)  (256  + 64 * (j))
#define XB_XSUB(j)  (1280 + 64 * (j))
#define XB_XGEN(j)  (2304 + 64 * (j))
#define XB_TOP      3328
#define XB_TOPGEN   3392
#define XCD_BAR_WORDS 3456
#define XB_SPIN_CAP (1u << 18)
__device__ __forceinline__ unsigned xb_ld(unsigned* p)              { return __hip_atomic_load(p, __ATOMIC_RELAXED, __HIP_MEMORY_SCOPE_AGENT); }
__device__ __forceinline__ unsigned xb_add(unsigned* p, unsigned v) { return __hip_atomic_fetch_add(p, v, __ATOMIC_RELAXED, __HIP_MEMORY_SCOPE_AGENT); }
__device__ __forceinline__ unsigned xb_xcc_id() { return (unsigned)__builtin_amdgcn_s_getreg((3 << 11) | 20) & 0xFu; }
#define XB_SPIN(cond, bar) do { unsigned _sp = 0; while (cond) { __builtin_amdgcn_s_sleep(1); \
    if ((++_sp & 255u) == 0u) { if (xb_ld(&(bar)[XB_TMO])) break; if (_sp > XB_SPIN_CAP) { atomicAdd(&(bar)[XB_TMO], 1u); break; } } } } while (0)
struct XcdBarrier { unsigned* bar; unsigned x; volatile LAS unsigned* st; };
__device__ __forceinline__ XcdBarrier xcd_barrier_post(unsigned* bar, volatile LAS unsigned* st, bool tid0) {
    XcdBarrier b; b.bar = bar; b.x = xb_xcc_id(); b.st = st;
    if (tid0) (void)xb_add(&bar[XB_XCNT(b.x)], 1u);
    return b;
}
__device__ __forceinline__ void xcd_barrier_complete(unsigned* bar, unsigned x, unsigned& nloc, unsigned& nx) {
    const unsigned G = gridDim.x * gridDim.y * gridDim.z;
    unsigned sum, cnt, mine, sp = 0u;
    for (;;) {
        sum = 0u; cnt = 0u; mine = 0u;
#pragma unroll
        for (unsigned j = 0; j < 16; ++j) { const unsigned c = xb_ld(&bar[XB_XCNT(j)]); sum += c; cnt += (c > 0u) ? 1u : 0u; mine = (j == x) ? c : mine; }
        if (sum == G) break;
        __builtin_amdgcn_s_sleep(1);
        if ((++sp & 255u) == 0u) { if (xb_ld(&bar[XB_TMO])) break; if (sp > XB_SPIN_CAP) { atomicAdd(&bar[XB_TMO], 1u); break; } }
    }
    nloc = mine > 0u ? mine : 1u; nx = cnt > 0u ? cnt : 1u;
}
template <bool FIRST>
__device__ __forceinline__ void xcd_barrier(const XcdBarrier& b, bool tid0) {
    asm volatile("s_waitcnt vmcnt(0)" ::: "memory");
    __syncthreads();
    if (tid0) {
        unsigned* bar = b.bar;
        __builtin_amdgcn_s_waitcnt(0);
        unsigned nloc = b.st[0], nx = b.st[1];
        if (FIRST) { if (nloc == 0u) { xcd_barrier_complete(bar, b.x, nloc, nx); b.st[0] = nloc; b.st[1] = nx; } }
        else { if (nloc == 0u) nloc = 1u; if (nx == 0u) nx = 1u; }
        const unsigned old = xb_add(&bar[XB_XSUB(b.x)], 1u);
        const unsigned gen = old / nloc;
        if (old + 1u == (gen + 1u) * nloc) {
            __builtin_amdgcn_fence(__ATOMIC_RELEASE, "agent");
            asm volatile("s_waitcnt vmcnt(0)" ::: "memory");
            const unsigned og = xb_add(&bar[XB_TOP], 1u);
            const unsigned tg = og / nx;
            if (og + 1u == (tg + 1u) * nx) xb_add(&bar[XB_TOPGEN], 1u);
            else XB_SPIN(xb_ld(&bar[XB_TOPGEN]) == tg, bar);
            __builtin_amdgcn_fence(__ATOMIC_ACQUIRE, "agent");
            xb_add(&bar[XB_XGEN(b.x)], 1u);
            asm volatile("s_waitcnt vmcnt(0)" ::: "memory");
        } else {
            XB_SPIN(xb_ld(&bar[XB_XGEN(b.x)]) == gen, bar);
            __builtin_amdgcn_fence(__ATOMIC_ACQUIRE, "agent");
            asm volatile("s_waitcnt vmcnt(0)" ::: "memory");
        }
    }
    __syncthreads();
}

struct Args { const float* in[20]; float* out; unsigned char* ws; int ph_lo, ph_hi, use_bar, pad; };
typedef const Args __attribute__((address_space(4))) CArgs;
__device__ __forceinline__ CArgs* opq_args() { CArgs* p = (CArgs*)__builtin_amdgcn_kernarg_segment_ptr(); asm volatile("" : "+s"(p)); return p; }
struct Frame {
    LAS unsigned char* lds;
    int tid, lane, wave, G, bid;
};

__device__ __forceinline__ void transpose_item(const float* W, int ldn, int K, bf16* WT, int k0, int n0, int drow0, LAS float* scr, int lane) {
    f32x4 v[16];
    const float* src = W + (size_t)(k0 + (lane >> 4)) * ldn + n0 + 4 * (lane & 15);
#pragma unroll
    for (int i = 0; i < 16; ++i) v[i] = *(const f32x4*)(src + (size_t)(4 * i) * ldn);
#pragma unroll
    for (int i = 0; i < 16; ++i) { LAS float* d = scr + (4 * i + (lane >> 4)) * 65 + 4 * (lane & 15); d[0] = v[i].x; d[1] = v[i].y; d[2] = v[i].z; d[3] = v[i].w; }
    LDS_WAIT(); asm volatile("" ::: "memory");
    const int c = lane & 7, r = lane >> 3;
#pragma unroll
    for (int j = 0; j < 8; ++j) { const int n = r + 8 * j; const LAS float* s = scr + (8 * c) * 65 + n;
        v4u o; o.x = pg8::cvt_pk_bf16(s[0 * 65], s[1 * 65]); o.y = pg8::cvt_pk_bf16(s[2 * 65], s[3 * 65]); o.z = pg8::cvt_pk_bf16(s[4 * 65], s[5 * 65]); o.w = pg8::cvt_pk_bf16(s[6 * 65], s[7 * 65]);
        *(GAS v4u*)(WT + (size_t)(drow0 + n) * K + k0 + 8 * c) = o; }
    LDS_WAIT(); asm volatile("" ::: "memory");
}
template <int MODE>
__device__ __forceinline__ void transpose_matrix(const float* W, int nmat, int K, int ldn, int ncols, bf16* WT, LAS float* scr, int gw, int NGW, int lane) {
    const int nblk = ncols / 64, kblk = K / 64, per = nblk * kblk, total = per * nmat;
    for (int it = gw; it < total; it += NGW) {
        const int mat = it / per, r = it - mat * per, kb = r / nblk, nb = r - kb * nblk, n0 = 64 * nb;
        int drow0 = n0;
        if (MODE == 1) { if (n0 < FF) drow0 = (n0 / 128) * 256 + (n0 % 128); else { const int n1 = n0 - FF; drow0 = (n1 / 128) * 256 + 128 + (n1 % 128); } }
        if (MODE == 2) drow0 = n0 < 3072 ? n0 : (n0 < 4096 ? n0 + 4096 : n0 - 1024);
        transpose_item(W + (size_t)mat * K * ldn, ldn, K, WT + (size_t)mat * ncols * K, 64 * kb, n0, drow0, scr, lane);
    }
}
template <int SET>
__device__ __forceinline__ void convert_weights(CArgs* ap, LAS float* scr, int gw, int NGW, int lane) {
    unsigned char* ws = ap->ws;
    bf16* abin = (bf16*)(ws + WS_W_ABIN); bf16* about = (bf16*)(ws + WS_W_ABOUT); bf16* glin = (bf16*)(ws + WS_W_GLIN); bf16* glout = (bf16*)(ws + WS_W_GLOUT); bf16* ffin = (bf16*)(ws + WS_W_FFIN); bf16* ffout = (bf16*)(ws + WS_W_FFOUT);
    constexpr size_t S_ABIN_W = (size_t)DM * AB_IN, S_ABIN_T = (size_t)AB_N * DM, S_SQ = (size_t)DM * DM, S_GLIN_W = (size_t)DM * C_IN, S_GLIN_T = (size_t)C_N * DM, S_FFIN = (size_t)DM * FF2, S_FFOUT = (size_t)FF * DM;
    if (SET == 0) {
        transpose_matrix<2>(ap->in[6], 1, DM, AB_IN, AB_N, abin, scr, gw, NGW, lane);
        transpose_matrix<0>(ap->in[7], 1, DM, DM, DM, about, scr, gw, NGW, lane);
        transpose_matrix<1>(ap->in[18], 1, DM, FF2, FF2, ffin, scr, gw, NGW, lane);
        transpose_matrix<0>(ap->in[19], 1, FF, DM, DM, ffout, scr, gw, NGW, lane);
        transpose_matrix<0>(ap->in[13], 1, DM, C_IN, C_N, glin, scr, gw, NGW, lane);
    } else if (SET == 1) {
        transpose_matrix<0>(ap->in[17], 1, DM, DM, DM, glout, scr, gw, NGW, lane);
        transpose_matrix<1>(ap->in[18] + S_FFIN, 2, DM, FF2, FF2, ffin + S_FFIN, scr, gw, NGW, lane);
        transpose_matrix<0>(ap->in[19] + S_FFOUT, 2, FF, DM, DM, ffout + S_FFOUT, scr, gw, NGW, lane);
        transpose_matrix<2>(ap->in[6] + S_ABIN_W, 1, DM, AB_IN, AB_N, abin + S_ABIN_T, scr, gw, NGW, lane);
        transpose_matrix<0>(ap->in[7] + S_SQ, 1, DM, DM, DM, about + S_SQ, scr, gw, NGW, lane);
        transpose_matrix<0>(ap->in[13] + S_GLIN_W, 1, DM, C_IN, C_N, glin + S_GLIN_T, scr, gw, NGW, lane);
    } else {
        transpose_matrix<0>(ap->in[17] + S_SQ, 1, DM, DM, DM, glout + S_SQ, scr, gw, NGW, lane);
        transpose_matrix<1>(ap->in[18] + 3 * S_FFIN, 1, DM, FF2, FF2, ffin + 3 * S_FFIN, scr, gw, NGW, lane);
        transpose_matrix<0>(ap->in[19] + 3 * S_FFOUT, 1, FF, DM, DM, ffout + 3 * S_FFOUT, scr, gw, NGW, lane);
    }
}
__device__ __forceinline__ void p0_prologue(Frame& F, CArgs* ap) {
    unsigned char* ws = ap->ws;
    {
        LAS float* sc = (LAS float*)(F.lds);
        LAS float* part = (LAS float*)(F.lds + 16384);
        const float* c = ap->in[1];
        for (int i = F.tid; i < 2 * DM; i += NTHREADS) sc[i] = silu_x(c[i]);
        __syncthreads();
        const float* mw = ap->in[2]; const float* mb = ap->in[3]; float* mod = (float*)(ws + WS_MOD);
        constexpr int NU = DEPTH * (6 * DM / 64);
        for (int u = F.bid; u < NU; u += F.G) {
            const int layer = u / (6 * DM / 64), colb = (u % (6 * DM / 64)) * 64, kk = F.lane >> 4, c4 = F.lane & 15;
            const float* wp = mw + ((size_t)layer * DM + F.wave * 256 + kk) * (6 * DM) + colb + 4 * c4;
            f32x4 a0 = {0.f, 0.f, 0.f, 0.f}, a1 = {0.f, 0.f, 0.f, 0.f};
            for (int i0 = 0; i0 < 64; i0 += 16) { f32x4 wv[16];
#pragma unroll
                for (int i = 0; i < 16; ++i) wv[i] = *(const f32x4*)(wp + (size_t)(4 * (i0 + i)) * (6 * DM));
#pragma unroll
                for (int i = 0; i < 16; ++i) { const int k = F.wave * 256 + 4 * (i0 + i) + kk; a0 = a0 + wv[i] * sc[k]; a1 = a1 + wv[i] * sc[DM + k]; } }
            a0.x = xsum<16>(a0.x); a0.x = xsum<32>(a0.x); a0.y = xsum<16>(a0.y); a0.y = xsum<32>(a0.y); a0.z = xsum<16>(a0.z); a0.z = xsum<32>(a0.z); a0.w = xsum<16>(a0.w); a0.w = xsum<32>(a0.w);
            a1.x = xsum<16>(a1.x); a1.x = xsum<32>(a1.x); a1.y = xsum<16>(a1.y); a1.y = xsum<32>(a1.y); a1.z = xsum<16>(a1.z); a1.z = xsum<32>(a1.z); a1.w = xsum<16>(a1.w); a1.w = xsum<32>(a1.w);
            if (F.lane < 16) { *(LAS f32x4*)(part + (F.wave * 2 + 0) * 64 + 4 * c4) = a0; *(LAS f32x4*)(part + (F.wave * 2 + 1) * 64 + 4 * c4) = a1; }
            __syncthreads();
            if (F.tid < 128) { const int b = F.tid >> 6, l = F.tid & 63; float s = 0.f;
#pragma unroll
                for (int w = 0; w < 8; ++w) s += part[(w * 2 + b) * 64 + l];
                const int cc = (u % (6 * DM / 64)) * 64 + l;
                mod[((size_t)layer * 2 + b) * (6 * DM) + cc] = s + mb[(size_t)layer * (6 * DM) + cc]; }
            __syncthreads();
        }
    }
    __syncthreads();
    LAS float* scr = (LAS float*)(F.lds + RING_OFF + F.wave * 16640);
    const int gw = F.bid * NWAVES + F.wave, NGW = F.G * NWAVES;
    convert_weights<0>(ap, scr, gw, NGW, F.lane);
}

template <int MASK> __device__ __forceinline__ float xget(float v) { return __builtin_bit_cast(float, __builtin_amdgcn_ds_swizzle(__builtin_bit_cast(int, v), (MASK << 10) | 0x1f)); }
template <int N> __device__ __forceinline__ float rs_reduce(float (&a)[N], int lane) {
    if (N == 16) {
#pragma unroll
        for (int i = 0; i < 8; ++i) { const bool up = lane & 1; const float keep = up ? a[i + 8] : a[i], send = up ? a[i] : a[i + 8]; a[i] = keep + xget<1>(send); } }
    if (N >= 8) {
#pragma unroll
        for (int i = 0; i < 4; ++i) { const bool up = lane & (N == 16 ? 2 : 1); const float keep = up ? a[i + 4] : a[i], send = up ? a[i] : a[i + 4]; a[i] = keep + (N == 16 ? xget<2>(send) : xget<1>(send)); } }
#pragma unroll
    for (int i = 0; i < 2; ++i) { const bool up = lane & (N == 16 ? 4 : 2); const float keep = up ? a[i + 2] : a[i], send = up ? a[i] : a[i + 2]; a[i] = keep + (N == 16 ? xget<4>(send) : xget<2>(send)); }
    { const bool up = lane & (N == 16 ? 8 : 4); const float keep = up ? a[1] : a[0], send = up ? a[0] : a[1]; a[0] = keep + (N == 16 ? xget<8>(send) : xget<4>(send)); }
    float r = a[0];
    if (N == 8) r = xsum<8>(r);
    r = xsum<16>(r); r = xsum<32>(r);
    return r;
}
template <int N> __device__ __forceinline__ int rs_col(int lane) { return N == 16 ? (((lane & 1) << 3) | ((lane & 2) << 1) | ((lane & 4) >> 1) | ((lane & 8) >> 3)) : (((lane & 1) << 2) | (lane & 2) | ((lane & 4) >> 2)); }
template <int NC, int MODE, bool RES, bool XF32>
__device__ __forceinline__ void norm_phase(Frame& F, const void* xin, const float* gain, const float* mod_sh, const float* mod_sc  ,
                                           bf16* hout, const float* Wsm, int ldn, const float* fbias, float* sout, const bf16* yres = nullptr, const float* rgate = nullptr, bf16* xb = nullptr) {
    LAS float* wl = (LAS float*)(F.lds);
    if (NC > 0) {
        for (int i = F.tid; i < NC * DM; i += NTHREADS) { const int k = i / NC, c = i % NC; wl[c * DM + k] = Wsm[(size_t)k * ldn + c]; }
        __syncthreads();
    }
    f32x4 gm[8], shv[8]; int bprev = -1;
    for (int mp = F.bid * NWAVES + F.wave; mp < M / 2; mp += F.G * NWAVES) {
        const int m0 = 2 * mp, b = m0 / T;
        if (b != bprev) { bprev = b; const f32x4* gp = (const f32x4*)gain + F.lane; const f32x4* shp = (const f32x4*)(mod_sh + (size_t)b * 6 * DM) + F.lane; const f32x4* scp = (const f32x4*)(mod_sc + (size_t)b * 6 * DM) + F.lane;
#pragma unroll
            for (int j = 0; j < 8; ++j) { gm[j] = gp[64 * j] * (scp[64 * j] + 1.0f); shv[j] = shp[64 * j]; } }
        f32x4 v[2][8]; float s0 = 0.f, s1 = 0.f;
        v2u yv[2][8];
        if (RES) { const GAS v2u* yr = (const GAS v2u*)(yres + (size_t)m0 * DM) + F.lane;
#pragma unroll
            for (int j = 0; j < 8; ++j) { yv[0][j] = yr[64 * j]; yv[1][j] = yr[512 + 64 * j]; } }
        if (XF32) { const GAS f32x4* xr = (const GAS f32x4*)((const float*)xin + (size_t)m0 * DM) + F.lane;
#pragma unroll
            for (int j = 0; j < 8; ++j) { v[0][j] = xr[64 * j]; v[1][j] = xr[512 + 64 * j]; } }
        else { const GAS v2u* xr = (const GAS v2u*)((const bf16*)xin + (size_t)m0 * DM) + F.lane; v2u xv[2][8];
#pragma unroll
            for (int j = 0; j < 8; ++j) { xv[0][j] = xr[64 * j]; xv[1][j] = xr[512 + 64 * j]; }
#pragma unroll
            for (int j = 0; j < 8; ++j) { v[0][j] = (f32x4){bf_lo(xv[0][j].x), bf_hi(xv[0][j].x), bf_lo(xv[0][j].y), bf_hi(xv[0][j].y)}; v[1][j] = (f32x4){bf_lo(xv[1][j].x), bf_hi(xv[1][j].x), bf_lo(xv[1][j].y), bf_hi(xv[1][j].y)}; } }
        if (RES) { const f32x4* rg = (const f32x4*)(rgate + (size_t)b * 6 * DM) + F.lane; GAS v2u* xo = (GAS v2u*)(xb + (size_t)m0 * DM) + F.lane;
#pragma unroll
            for (int j = 0; j < 8; ++j) { const f32x4 g = rg[64 * j];
                v[0][j] = v[0][j] + g * (f32x4){bf_lo(yv[0][j].x), bf_hi(yv[0][j].x), bf_lo(yv[0][j].y), bf_hi(yv[0][j].y)}; v[1][j] = v[1][j] + g * (f32x4){bf_lo(yv[1][j].x), bf_hi(yv[1][j].x), bf_lo(yv[1][j].y), bf_hi(yv[1][j].y)};
                v2u w; w.x = pk2(v[0][j].x, v[0][j].y); w.y = pk2(v[0][j].z, v[0][j].w); xo[64 * j] = w;
                w.x = pk2(v[1][j].x, v[1][j].y); w.y = pk2(v[1][j].z, v[1][j].w); xo[512 + 64 * j] = w; } }
#pragma unroll
        for (int j = 0; j < 8; ++j) { s0 += (v[0][j].x * v[0][j].x + v[0][j].y * v[0][j].y) + (v[0][j].z * v[0][j].z + v[0][j].w * v[0][j].w);
                                      s1 += (v[1][j].x * v[1][j].x + v[1][j].y * v[1][j].y) + (v[1][j].z * v[1][j].z + v[1][j].w * v[1][j].w); }
        const float rstd0 = __builtin_amdgcn_rsqf(wave_sum(s0) * (1.f / DM) + EPS), rstd1 = __builtin_amdgcn_rsqf(wave_sum(s1) * (1.f / DM) + EPS);
        GAS v2u* o8 = (GAS v2u*)(hout + (size_t)m0 * DM) + F.lane;
#pragma unroll
        for (int j = 0; j < 8; ++j) { const f32x4 g = gm[j], sh = shv[j];
            v[0][j] = (v[0][j] * rstd0) * g + sh; v[1][j] = (v[1][j] * rstd1) * g + sh;
            v2u w; w.x = pk2(v[0][j].x, v[0][j].y); w.y = pk2(v[0][j].z, v[0][j].w); o8[64 * j] = w;
            w.x = pk2(v[1][j].x, v[1][j].y); w.y = pk2(v[1][j].z, v[1][j].w); o8[512 + 64 * j] = w; }
        if constexpr (NC > 0) {
            float a0[NC], a1[NC];
#pragma unroll
            for (int c = 0; c < NC; ++c) { float acc0 = 0.f, acc1 = 0.f;
#pragma unroll
                for (int j = 0; j < 8; ++j) { const f32x4 w = *(const LAS f32x4*)(wl + c * DM + 256 * j + 4 * F.lane);
                    acc0 += (v[0][j].x * w.x + v[0][j].y * w.y) + (v[0][j].z * w.z + v[0][j].w * w.w); acc1 += (v[1][j].x * w.x + v[1][j].y * w.y) + (v[1][j].z * w.z + v[1][j].w * w.w); }
                a0[c] = acc0; a1[c] = acc1; __builtin_amdgcn_sched_barrier(0); }
            const float r0 = rs_reduce<NC>(a0, F.lane), r1 = rs_reduce<NC>(a1, F.lane); const int cc = rs_col<NC>(F.lane);
            if (MODE == 1) { const int t = m0 % T; if (F.lane < NC) { const float fb = fbias[cc]; sout[((size_t)b * 8 + cc) * T + t] = log_sigmoid_f(r0 + fb); sout[((size_t)b * 8 + cc) * T + t + 1] = log_sigmoid_f(r1 + fb); } }
            if (MODE == 2) { if (F.lane < NC) { sout[(size_t)m0 * 16 + cc] = r0; sout[(size_t)m0 * 16 + 16 + cc] = r1; } }
        }
    }
}

__device__ __forceinline__ void resid_final(Frame& F, const bf16* xb, const bf16* yres, const float* rgate, float* xout) {
    for (int mp = F.bid * NWAVES + F.wave; mp < M / 2; mp += F.G * NWAVES) {
        const int m0 = 2 * mp, b = m0 / T;
        const GAS v2u* xr = (const GAS v2u*)(xb + (size_t)m0 * DM) + F.lane; const GAS v2u* yr = (const GAS v2u*)(yres + (size_t)m0 * DM) + F.lane;
        const f32x4* rg = (const f32x4*)(rgate + (size_t)b * 6 * DM) + F.lane; GAS f32x4* xo = (GAS f32x4*)(xout + (size_t)m0 * DM) + F.lane;
        v2u xv[2][8], yv[2][8];
#pragma unroll
        for (int j = 0; j < 8; ++j) { xv[0][j] = xr[64 * j]; xv[1][j] = xr[512 + 64 * j]; yv[0][j] = yr[64 * j]; yv[1][j] = yr[512 + 64 * j]; }
#pragma unroll
        for (int j = 0; j < 8; ++j) { const f32x4 g = rg[64 * j];
            xo[64 * j] = (f32x4){bf_lo(xv[0][j].x), bf_hi(xv[0][j].x), bf_lo(xv[0][j].y), bf_hi(xv[0][j].y)} + g * (f32x4){bf_lo(yv[0][j].x), bf_hi(yv[0][j].x), bf_lo(yv[0][j].y), bf_hi(yv[0][j].y)};
            xo[512 + 64 * j] = (f32x4){bf_lo(xv[1][j].x), bf_hi(xv[1][j].x), bf_lo(xv[1][j].y), bf_hi(xv[1][j].y)} + g * (f32x4){bf_lo(yv[1][j].x), bf_hi(yv[1][j].x), bf_lo(yv[1][j].y), bf_hi(yv[1][j].y)}; }
    }
}

__device__ __forceinline__ void fox_prep(Frame& F, bf16* proj, const float* qg, const float* kg, const float* logf, float* bias) {
    const int gw = F.bid * NWAVES + F.wave, NGW = F.G * NWAVES;
    const f32x4 gq0 = *(const f32x4*)(qg + (F.lane & 15) * 8), gq1 = *(const f32x4*)(qg + (F.lane & 15) * 8 + 4), gk0 = *(const f32x4*)(kg + (F.lane & 15) * 8), gk1 = *(const f32x4*)(kg + (F.lane & 15) * 8 + 4);
    for (int m = gw; m < M; m += NGW) {
        GAS v4u* p = (GAS v4u*)(proj + (size_t)m * AB_N + 3072) + F.lane;
        v4u wv[4];
#pragma unroll
        for (int j = 0; j < 4; ++j) wv[j] = p[64 * j];
#pragma unroll
        for (int j = 0; j < 4; ++j) {
            const v4u w = wv[j];
            float e[8] = {bf_lo(w.x), bf_hi(w.x), bf_lo(w.y), bf_hi(w.y), bf_lo(w.z), bf_hi(w.z), bf_lo(w.w), bf_hi(w.w)};
            float s = 0.f;
#pragma unroll
            for (int i = 0; i < 8; ++i) s += e[i] * e[i];
            s = xsum<1>(s); s = xsum<2>(s); s = xsum<4>(s); s = xsum<8>(s);
            const float rstd = __builtin_amdgcn_rsqf(s * (1.f / 128.f) + EPS);
            const f32x4 g0 = j < 2 ? gq0 : gk0, g1 = j < 2 ? gq1 : gk1;
#pragma unroll
            for (int i = 0; i < 4; ++i) { e[i] = e[i] * rstd * g0[i]; e[4 + i] = e[4 + i] * rstd * g1[i]; }
            v4u o; o.x = pk2(e[0], e[1]); o.y = pk2(e[2], e[3]); o.z = pk2(e[4], e[5]); o.w = pk2(e[6], e[7]);
            p[64 * j] = o;
        }
    }
    if (F.bid < 16) {
        LAS double* tsum = (LAS double*)(F.lds);
        const float* lf = logf + (size_t)F.bid * T; float* bo = bias + (size_t)F.bid * T;
        double v[16]; double run = 0.0;
        const int i0 = F.tid * 16;
#pragma unroll
        for (int i = 0; i < 16; ++i) { run += (double)lf[i0 + i]; v[i] = run; }
        tsum[F.tid] = run;
        __syncthreads();
        LAS double* bsum = tsum + NTHREADS;
        if (F.tid < 8) { double s = 0.0; for (int w = 0; w < 64; ++w) s += tsum[F.tid * 64 + w]; bsum[F.tid] = s; }
        __syncthreads();
        double base = 0.0;
        for (int w = 0; w < F.wave; ++w) base += bsum[w];
        for (int w = 0; w < F.lane; ++w) base += tsum[F.wave * 64 + w];
        const double k = -11.313708498984761;
#pragma unroll
        for (int i = 0; i < 16; ++i) bo[i0 + i] = (float)((base + v[i]) * k);
        __syncthreads();
    }
}

#ifndef DBG_REC
#define DBG_REC 0
#endif
#if DBG_REC
template <bool GLA>
__device__ __forceinline__ void rec_naive(Frame& F, const bf16* proj, float* O, const float* lbl  , int lb_on,
                                          const float* glow, const float* wup  , const float* bgate  ) {
    constexpr int DK = GLA ? 256 : 128, DVH = GLA ? 512 : 128, NH = GLA ? 4 : 8, DVS = 32, NSL = DVH / DVS, TB = GLA ? 16 : 32;
    constexpr int PITCH = GLA ? C_N : AB_N, OPITCH = GLA ? 2048 : 1024;
    constexpr int R = DK / 16;
    constexpr int NPAIR = TB * DK / 2 / NTHREADS;
    constexpr int NUNITS = BATCH * NH * NSL;
    LAS float* sq = (LAS float*)(F.lds); LAS float* sf = sq + TB * DK; LAS float* sk = sf + TB * DK; LAS float* sv = sk + TB * DK; LAS float* part = sv + TB * DVS; LAS float* sgl = part + TB * 4 * DVS;
    const int lane = F.lane, e_l = lane & 15, dsub = lane >> 4, eg = F.wave & 1, dg = F.wave >> 1, e = eg * 16 + e_l, d0 = (dg * 4 + dsub) * R;
    for (int unit = F.bid; unit < NUNITS; unit += F.G) {
        const int sl = unit % NSL, h = (unit / NSL) % NH, b = unit / (NSL * NH);
        const bf16* pq = proj + (size_t)b * T * PITCH + h * DK;
        const bf16* pk = pq + 1024;
        const bf16* pv = proj + (size_t)b * T * PITCH + 2048 + h * DVH + sl * DVS;
        const int dp = 2 * (F.tid % (DK / 2)), tt0 = F.tid / (DK / 2); constexpr int TSTEP = NTHREADS / (DK / 2);
        float lb0 = 0.f, lb1 = 0.f; float wu0[16], wu1[16]; float bg0 = 0.f, bg1 = 0.f;
        if (!GLA) { if (lb_on) { const float l0a = lbl[h * DK + dp], l1a = lbl[1024 + h * DK + dp], l0b = lbl[h * DK + dp + 1], l1b = lbl[1024 + h * DK + dp + 1];
                                 lb0 = fminf(fmaxf(sigmoid_f(l1a - l0a), 0.f), 1.0f - 1e-6f); lb1 = fminf(fmaxf(sigmoid_f(l1b - l0b), 0.f), 1.0f - 1e-6f); } }
        else {
#pragma unroll
            for (int r = 0; r < 16; ++r) { wu0[r] = wup[r * 1024 + h * DK + dp]; wu1[r] = wup[r * 1024 + h * DK + dp + 1]; }
            bg0 = bgate[h * DK + dp]; bg1 = bgate[h * DK + dp + 1]; }
        const int vt = F.tid / 16, ve = 2 * (F.tid % 16); const bool vact = vt < TB;
        float S[R];
#pragma unroll
        for (int j = 0; j < R; ++j) S[j] = 0.f;
        unsigned rq[NPAIR], rk[NPAIR], rv = 0u; float rgl = 0.f;
#define REC_PREFETCH(t0) do { _Pragma("unroll") for (int i = 0; i < NPAIR; ++i) { const size_t row = (size_t)((t0) + tt0 + TSTEP * i); \
            rq[i] = *(const unsigned*)(pq + row * PITCH + dp); rk[i] = *(const unsigned*)(pk + row * PITCH + dp); \
            } \
            if (GLA && F.tid < TB * 16) rgl = glow[((size_t)b * T + (t0)) * 16 + F.tid]; \
            if (vact) rv = *(const unsigned*)(pv + (size_t)((t0) + vt) * PITCH + ve); } while (0)
        REC_PREFETCH(0);
        for (int t0 = 0; t0 < T; t0 += TB) {
            if (GLA) { if (F.tid < TB * 16) sgl[F.tid] = rgl; __syncthreads(); }
#pragma unroll
            for (int i = 0; i < NPAIR; ++i) { const int tt = tt0 + TSTEP * i; const float qa = bf_lo(rq[i]), qb = bf_hi(rq[i]), ka = bf_lo(rk[i]), kb = bf_hi(rk[i]);
                float q0, q1, f0, f1, k0, k1;
                if (!GLA) { q0 = silu_x(qa); q1 = silu_x(qb); const float s0 = sigmoid_f(ka), s1 = sigmoid_f(kb), n0 = sigmoid_f(-ka), n1 = sigmoid_f(-kb);
                    f0 = fmaxf(lb0 + (1.f - lb0) * s0, 1e-30f); f1 = fmaxf(lb1 + (1.f - lb1) * s1, 1e-30f); k0 = (1.f - lb0) * n0; k1 = (1.f - lb1) * n1; }
                else { q0 = qa * 0.0625f; q1 = qb * 0.0625f; k0 = ka; k1 = kb; float x0 = bg0, x1 = bg1;
#pragma unroll
                    for (int r = 0; r < 16; ++r) { const float g = sgl[tt * 16 + r]; x0 += g * wu0[r]; x1 += g * wu1[r]; }
                    f0 = __expf(log_sigmoid_f(x0) * 0.0625f); f1 = __expf(log_sigmoid_f(x1) * 0.0625f); }
                sq[tt * DK + dp] = q0; sq[tt * DK + dp + 1] = q1; sf[tt * DK + dp] = f0; sf[tt * DK + dp + 1] = f1; sk[tt * DK + dp] = k0; sk[tt * DK + dp + 1] = k1; }
            if (vact) { sv[vt * DVS + ve] = bf_lo(rv); sv[vt * DVS + ve + 1] = bf_hi(rv); }
            __syncthreads();
            if (t0 + TB < T) REC_PREFETCH(t0 + TB);
            for (int tt = 0; tt < TB; ++tt) {
                const float v = sv[tt * DVS + e]; float acc = 0.f;
#pragma unroll
                for (int g4 = 0; g4 < R / 4; ++g4) { const f32x4 f4 = *(const LAS f32x4*)(sf + tt * DK + d0 + 4 * g4), k4 = *(const LAS f32x4*)(sk + tt * DK + d0 + 4 * g4), q4 = *(const LAS f32x4*)(sq + tt * DK + d0 + 4 * g4);
#pragma unroll
                    for (int i = 0; i < 4; ++i) { S[4 * g4 + i] = f4[i] * S[4 * g4 + i] + k4[i] * v; acc += q4[i] * S[4 * g4 + i]; } }
                acc = xsum<16>(acc); acc = xsum<32>(acc);
                if (dsub == 0) part[(tt * 4 + dg) * DVS + e] = acc;
            }
            __syncthreads();
            for (int i = F.tid; i < TB * DVS; i += NTHREADS) { const int tt = i / DVS, ee = i % DVS;
                const float o = (part[(tt * 4 + 0) * DVS + ee] + part[(tt * 4 + 1) * DVS + ee]) + (part[(tt * 4 + 2) * DVS + ee] + part[(tt * 4 + 3) * DVS + ee]);
                O[((size_t)b * T + t0 + tt) * OPITCH + h * DVH + sl * DVS + ee] = o; }
        }
#undef REC_PREFETCH
        __syncthreads();
    }
}

#endif
#ifndef DBG_ZERO
#define DBG_ZERO 0
#endif
__device__ __forceinline__ void post_even(Frame& F, const bf16* O, const bf16* proj, const float* gain  , bf16* cat) {
    const int gw = F.bid * NWAVES + F.wave, NGW = F.G * NWAVES;
    f32x4 gn[4];
#pragma unroll
    for (int j = 0; j < 4; ++j) gn[j] = *((const f32x4*)gain + 64 * j + F.lane);
    for (int mp = gw; mp < M / 2; mp += NGW) {
        const int m = 2 * mp;
        const GAS v2u* op = (const GAS v2u*)(O + (size_t)m * 1024) + F.lane;
        const GAS v2u* ga = (const GAS v2u*)(proj + (size_t)m * AB_N + 7168) + F.lane;
        GAS v2u* cp = (GAS v2u*)(cat + (size_t)m * DM) + F.lane;
        v2u vr[2][4], gr[2][4];
#pragma unroll
        for (int r = 0; r < 2; ++r)
#pragma unroll
            for (int j = 0; j < 4; ++j) { vr[r][j] = op[r * 256 + 64 * j]; gr[r][j] = ga[r * (AB_N / 4) + 64 * j]; }
#pragma unroll
        for (int r = 0; r < 2; ++r)
#pragma unroll
        for (int j = 0; j < 4; ++j) {
            const f32x4 v = {bf_lo(vr[r][j].x), bf_hi(vr[r][j].x), bf_lo(vr[r][j].y), bf_hi(vr[r][j].y)}; float s = (v.x * v.x + v.y * v.y) + (v.z * v.z + v.w * v.w);
            s = xsum<1>(s); s = xsum<2>(s); s = xsum<4>(s); s = xsum<8>(s); s = xsum<16>(s);
            const float rstd = __builtin_amdgcn_rsqf(s * (1.f / 128.f) + EPS);
            const f32x4 g = gn[j];
            const v2u gw2 = gr[r][j];
            const float o0 = v.x * rstd * g.x * silu_x(bf_lo(gw2.x)), o1 = v.y * rstd * g.y * silu_x(bf_hi(gw2.x)), o2 = v.z * rstd * g.z * silu_x(bf_lo(gw2.y)), o3 = v.w * rstd * g.w * silu_x(bf_hi(gw2.y));
            v2u w; w.x = pk2(o0, o1); w.y = pk2(o2, o3); cp[r * 512 + 64 * j] = w;
        }
    }
}
__device__ __forceinline__ void post_odd(Frame& F, const bf16* O, const bf16* proj, const float* gain  , bf16* cat) {
    const int gw = F.bid * NWAVES + F.wave, NGW = F.G * NWAVES;
    const f32x4 gn0 = *((const f32x4*)gain + F.lane), gn1 = *((const f32x4*)gain + 64 + F.lane);
    for (int mp = gw; mp < M / 2; mp += NGW) {
        const int m = 2 * mp;
        const GAS v2u* op = (const GAS v2u*)(O + (size_t)m * DM) + F.lane;
        const GAS v2u* gg = (const GAS v2u*)(proj + (size_t)m * C_N + 4096) + F.lane;
        GAS v2u* cp = (GAS v2u*)(cat + (size_t)m * DM) + F.lane;
        v2u vr[2][8], gr[2][8];
#pragma unroll
        for (int r = 0; r < 2; ++r)
#pragma unroll
            for (int j = 0; j < 8; ++j) { vr[r][j] = op[r * 512 + 64 * j]; gr[r][j] = gg[r * (C_N / 4) + 64 * j]; }
#pragma unroll
        for (int r = 0; r < 2; ++r)
#pragma unroll
        for (int hh = 0; hh < 4; ++hh) {
            const v2u r0 = vr[r][2 * hh], r1 = vr[r][2 * hh + 1]; const f32x4 v0 = {bf_lo(r0.x), bf_hi(r0.x), bf_lo(r0.y), bf_hi(r0.y)}, v1 = {bf_lo(r1.x), bf_hi(r1.x), bf_lo(r1.y), bf_hi(r1.y)};
            float s = ((v0.x * v0.x + v0.y * v0.y) + (v0.z * v0.z + v0.w * v0.w)) + ((v1.x * v1.x + v1.y * v1.y) + (v1.z * v1.z + v1.w * v1.w));
            s = wave_sum(s);
            const float rstd = __builtin_amdgcn_rsqf(s * (1.f / 512.f) + EPS);
#pragma unroll
            for (int jj = 0; jj < 2; ++jj) { const f32x4 v = jj ? v1 : v0; const f32x4 g = jj ? gn1 : gn0; const v2u gw2 = gr[r][2 * hh + jj];
                const float o0 = v.x * rstd * g.x * silu_x(bf_lo(gw2.x)), o1 = v.y * rstd * g.y * silu_x(bf_hi(gw2.x)), o2 = v.z * rstd * g.z * silu_x(bf_lo(gw2.y)), o3 = v.w * rstd * g.w * silu_x(bf_hi(gw2.y));
                v2u w; w.x = pk2(o0, o1); w.y = pk2(o2, o3); cp[r * 512 + 64 * (2 * hh + jj)] = w; }
        }
    }
}

__device__ __forceinline__ fox::BlockRef fox_ref(int item, const bf16* proj, bf16* cat, const float* bias, float thp) {
    const int bh = item & 15, qb = 31 - (item >> 4), b = bh >> 3, h = bh & 7;
    fox::BlockRef r;
    const bf16* base = proj + (size_t)b * T * AB_N + h * 128;
    r.Q = (const fox::bf16*)(base + (size_t)qb * 256 * AB_N + 3072); r.K = (const fox::bf16*)(base + 4096); r.V = (const fox::bf16*)(base + 5120);
    r.O = (fox::bf16*)(cat + ((size_t)b * T + (size_t)qb * 256) * DM + 1024 + h * 128);
    r.Bias = bias + (size_t)bh * T; r.P0 = qb * 256; r.THp = thp;
    return r;
}
__device__ __forceinline__ int fox_fetch(Frame& F, unsigned* ctr, volatile LAS unsigned* slot) {
    if (F.tid == 0) *slot = __hip_atomic_fetch_add(ctr, 1u, __ATOMIC_RELAXED, __HIP_MEMORY_SCOPE_AGENT);
    __syncthreads();
    const int v = __builtin_amdgcn_readfirstlane((int)*slot);
    __syncthreads();
    return v;
}
__device__ __forceinline__ void fox_phase(Frame& F, char* lds, const bf16* proj, bf16* cat, const float* bias, unsigned* ctr, const float* qg, const float* kg) {
    constexpr int TOTAL = 512;
    float gqm = 0.f, gkm = 0.f;
    for (int i = 0; i < 128; ++i) { gqm = fmaxf(gqm, fabsf(qg[i])); gkm = fmaxf(gkm, fabsf(kg[i])); }
    const float thp = 2.0f * (128.0f * 1.02f * gqm * gkm) + (128.0f + 12.0f + 6.0f) / (1.4426950408889634f * fox::SCALE);
    volatile LAS unsigned* slot = (volatile LAS unsigned*)(F.lds + MISC_OFF) + 16;
    int ci = fox_fetch(F, ctr, slot); if (ci >= TOTAL) return;
    fox::BlockRef cur = fox_ref(ci, proj, cat, bias, thp);
    fox::Seam S;
    fox::fox_prime(cur, lds, S, F.tid);
    for (;;) {
        const int ni = fox_fetch(F, ctr, slot); const bool last = ni >= TOTAL;
        const fox::BlockRef nxt = last ? cur : fox_ref(ni, proj, cat, bias, thp);
        fox::fox_block(cur, nxt, lds, S, F.tid);
        if (last) break;
        cur = nxt;
    }
}

template <bool GLA> struct RecCfg {
    static constexpr int DK = GLA ? 256 : 128, DVH = GLA ? 512 : 128, NH = GLA ? 4 : 8, CH = 32, NCH = T / CH, PITCH = GLA ? C_N : AB_N, OPITCH = GLA ? 2048 : 1024;
    static constexpr int QP = DK + 8;
    static constexpr int QT_B = ((CH * QP * 2 + 1023) / 1024) * 1024, KT_B = DK * CH * 2, P_B = CH * CH * 2, A_B = 1024, VT_B = DVH * CH * 2;
    static constexpr int OFF_QT = 0, OFF_KT = QT_B, OFF_P = OFF_KT + KT_B, OFF_A = OFF_P + P_B, OFF_VT = OFF_A + A_B, UNIT_B = OFF_VT + VT_B;
    static constexpr int NSL = DVH / 128, BUF_B = OFF_VT + 8192, NP1 = OFF_VT / 1024, NP = NP1 + 8, NR = (NP + 7) / 8;
    static_assert(A_B >= DK * 4 && OFF_VT % 1024 == 0, "rec layout");
};
typedef short rbf16x8 __attribute__((ext_vector_type(8)));
__device__ __forceinline__ rbf16x8 rpack8(f32x4 a, f32x4 b) { v4u w; w.x = pg8::cvt_pk_bf16(a.x, a.y); w.y = pg8::cvt_pk_bf16(a.z, a.w); w.z = pg8::cvt_pk_bf16(b.x, b.y); w.w = pg8::cvt_pk_bf16(b.z, b.w); return __builtin_bit_cast(rbf16x8, w); }

template <bool GLA>
__device__ __forceinline__ void rec_prep(Frame& F, const bf16* proj, unsigned char* rec, const float* lbl, int lb_on, const float* glow, const float* wup, const float* bgate) {
    using C = RecCfg<GLA>;
    constexpr int DK = C::DK, DVH = C::DVH, NH = C::NH, CH = C::CH, NCH = C::NCH, PITCH = C::PITCH, QP = C::QP;
    constexpr int NSEG = NTHREADS / DK, TPS = CH / NSEG;
    constexpr int NSEGV = NTHREADS / DVH, TPV = CH / NSEGV;
    LAS float* segtot = (LAS float*)F.lds;
    LAS bf16* qm = (LAS bf16*)(F.lds + 2048);
    LAS bf16* km = qm + CH * QP;
    LAS float* sgl = (LAS float*)(F.lds + 2048 + 2 * CH * QP * 2);
    const int d = F.tid % DK, seg = F.tid / DK, lane = F.lane, el = lane & 15, q4 = lane >> 4;
    const int x = d & 31, y = x & 15, pos = (d & ~31) + 8 * (y >> 2) + (y & 3) + 4 * (x >> 4);
    constexpr int NUNITS = BATCH * NH * NCH, NBH = BATCH * NH;
    float lb = 0.f, bg = 0.f; float wu[16]; int hprev = -1;
    unsigned short rq[TPS], rk[TPS]; unsigned rvv[TPV / 2]; float rgl = 0.f;
    unsigned short rvr[GLA ? 1 : TPV];
    const int ev = F.tid % DVH, sv = F.tid / DVH;
    const unsigned toff = (unsigned)(seg * TPS) * (unsigned)(PITCH * 2) + (unsigned)d * 2u, voff = (unsigned)(sv * TPV) * (unsigned)(PITCH * 2) + (unsigned)ev * 2u;
#define PREP_LOAD(un) do { const int c_ = (un) / NBH, bh_ = (un) % NBH; const size_t row_ = (size_t)(bh_ / NH) * T + (size_t)c_ * CH; const int h_ = bh_ % NH; \
        const char* ubq_ = (const char*)(proj + row_ * PITCH + h_ * DK); const char* ubv_ = (const char*)(proj + row_ * PITCH + 2048 + h_ * DVH); (void)ubv_; \
        if (GLA) rgl = glow[row_ * 16 + F.tid];     \
        _Pragma("unroll") for (int i = 0; i < TPS; ++i) { const char* rb_ = ubq_ + (size_t)i * (PITCH * 2);     \
            rq[i] = *(const bf16*)(rb_ + toff); rk[i] = *(const bf16*)(rb_ + 2048 + toff); } \
        if (!GLA) { _Pragma("unroll") for (int i = 0; i < TPV; ++i) rvr[i] = *(const bf16*)((ubv_ + (size_t)i * (PITCH * 2)) + voff); } \
        } while (0)
    if (F.bid < NUNITS) PREP_LOAD(F.bid);
    for (int unit = F.bid; unit < NUNITS; unit += F.G) {
        const int c = unit / NBH, bh = unit % NBH, h = bh % NH, b = bh / NH;
        const size_t row0 = (size_t)b * T + (size_t)c * CH;
        if (h != hprev) { hprev = h;
            if (!GLA) { lb = 0.f; if (lb_on) lb = fminf(fmaxf(sigmoid_f(lbl[1024 + h * DK + d] - lbl[h * DK + d]), 0.f), 1.0f - 1e-6f); }
            else {
#pragma unroll
                for (int r = 0; r < 16; ++r) wu[r] = wup[r * 1024 + h * DK + d];
                bg = bgate[h * DK + d]; } }
        if (GLA) { sgl[F.tid] = rgl; __syncthreads(); }
        float qv[TPS], kv[TPS], G[TPS]; float run = 0.f;
#pragma unroll
        for (int i = 0; i < TPS; ++i) { const int t = seg * TPS + i; const float qa = bf1(rq[i]), ka = bf1(rk[i]); float g;
            if (!GLA) { qv[i] = silu_x(qa); const float ez = __expf(-fabsf(ka)), rz = __builtin_amdgcn_rcpf(1.0f + ez), big = rz, small = ez * rz;
                const float sg = ka >= 0.f ? big : small, ng = ka >= 0.f ? small : big; const float f = fmaxf(lb + (1.f - lb) * sg, 1e-30f); g = __logf(f); kv[i] = (1.f - lb) * ng; }
            else { qv[i] = qa * 0.0625f; kv[i] = ka; float xx = bg;
#pragma unroll
                for (int r = 0; r < 16; ++r) xx += sgl[t * 16 + r] * wu[r];
                g = log_sigmoid_fast(xx) * 0.0625f; }
            run += g; G[i] = run; }
        segtot[seg * DK + d] = run;
        __syncthreads();
        float off = 0.f, tot = 0.f, rmid = 0.f;
#pragma unroll
        for (int s = 0; s < NSEG; ++s) { const float v = segtot[s * DK + d]; tot += v; if (s < seg) off += v; if (s < 16 / TPS) rmid += v; }
        unsigned char* ub = rec + (size_t)(bh * NCH + c) * C::UNIT_B;
        bf16* QT = (bf16*)(ub + C::OFF_QT); bf16* KT = (bf16*)(ub + C::OFF_KT); bf16* Pb = (bf16*)(ub + C::OFF_P); float* Ab = (float*)(ub + C::OFF_A); bf16* VT = (bf16*)(ub + C::OFF_VT);
        unsigned kt[TPS / 2];
#pragma unroll
        for (int i = 0; i < TPS; i += 2) { float kh[2];
#pragma unroll
            for (int u = 0; u < 2; ++u) { const int t = seg * TPS + i + u; const float Gt = G[i + u] + off;
                QT[t * QP + pos] = (bf16)f2bf(qv[i + u] * __expf(Gt)); kh[u] = kv[i + u] * __expf(tot - Gt);
                qm[t * QP + d] = (bf16)f2bf(qv[i + u] * __expf(fminf(Gt - rmid, 80.f))); km[t * QP + d] = (bf16)f2bf(kv[i + u] * __expf(fminf(rmid - Gt, 80.f))); }
            kt[i / 2] = pk2(kh[0], kh[1]); }
#pragma unroll
        for (int j = 0; j < TPS / 8; ++j) { v4u w; w.x = kt[4 * j]; w.y = kt[4 * j + 1]; w.z = kt[4 * j + 2]; w.w = kt[4 * j + 3]; *(v4u*)(KT + d * CH + seg * TPS + 8 * j) = w; }
        if (seg == NSEG - 1) Ab[d] = __expf(tot);
        { bf16* vt_ = VT + ev * CH + sv * TPV;
          if (GLA) { const char* ubv_ = (const char*)(proj + row0 * PITCH + 2048 + h * DVH);
#pragma unroll
              for (int i = 0; i < TPV; i += 2) rvv[i / 2] = (unsigned)*(const bf16*)(ubv_ + (voff + (unsigned)i * (unsigned)(PITCH * 2))) | ((unsigned)*(const bf16*)(ubv_ + (voff + (unsigned)(i + 1) * (unsigned)(PITCH * 2))) << 16); }
          else {
#pragma unroll
              for (int i = 0; i < TPV; i += 2) rvv[i / 2] = (unsigned)rvr[i] | ((unsigned)rvr[i + 1] << 16); }
#pragma unroll
          for (int j = 0; j < TPV / 8; ++j) { v4u w; w.x = rvv[4 * j]; w.y = rvv[4 * j + 1]; w.z = rvv[4 * j + 2]; w.w = rvv[4 * j + 3];
              *(v4u*)(vt_ + 8 * j) = w; } }
        if (unit + F.G < NUNITS) PREP_LOAD(unit + F.G);
        __syncthreads();
        if (F.wave < 3) { const int tt = F.wave >= 1, st = F.wave == 2; f32x4 acc = {0.f, 0.f, 0.f, 0.f};
#pragma unroll
            for (int i = 0; i < DK / 32; ++i) { const rbf16x8 a = *(const LAS rbf16x8*)(km + (16 * st + el) * QP + 32 * i + 8 * q4), bq = *(const LAS rbf16x8*)(qm + (16 * tt + el) * QP + 32 * i + 8 * q4);
                acc = __builtin_amdgcn_mfma_f32_16x16x32_bf16(a, bq, acc, 0, 0, 0); }
            const int ta = 16 * tt + el, s0 = 16 * st + 4 * q4;
            const float p0 = s0 + 0 <= ta ? acc[0] : 0.f, p1 = s0 + 1 <= ta ? acc[1] : 0.f, p2 = s0 + 2 <= ta ? acc[2] : 0.f, p3 = s0 + 3 <= ta ? acc[3] : 0.f;
            v2u w; w.x = pk2(p0, p1); w.y = pk2(p2, p3); *(v2u*)(Pb + ta * CH + s0) = w; }
        else if (F.wave == 3) { v2u w; w.x = 0u; w.y = 0u; *(v2u*)(Pb + el * CH + 16 + 4 * q4) = w; }
        __syncthreads();
    }
#undef PREP_LOAD
}

template <bool GLA>
__device__ __forceinline__ void rec_seq(Frame& F, const unsigned char* rec, float* O, const bf16* proj, const float* gain, bf16* cat) {
    using C = RecCfg<GLA>;
    constexpr int DK = C::DK, DVH = C::DVH, NH = C::NH, CH = C::CH, NCH = C::NCH, QP = C::QP, NSL = C::NSL, NDT = DK / 16, NKS = DK / 32;
    constexpr int NBUF = 3, PF = NBUF - 1;
    constexpr int BUFG = C::BUF_B + (GLA ? 0 : 8192);
    constexpr int NWAIT = (PF - 1) * ((C::NR - 1) + (GLA ? 0 : 1) + 2);
    static_assert(NBUF * BUFG + 2048 <= RING_BYTES, "rec ring");
    constexpr int NUNITS = BATCH * NH * NSL;
    const int lane = F.lane, el = lane & 15, q4 = lane >> 4, wave = F.wave;
    for (int unit = F.bid; unit < NUNITS; unit += F.G) {
        const int sl = unit % NSL, h = (unit / NSL) % NH, b = unit / (NSL * NH);
        const unsigned char* ubase = rec + (size_t)((b * NH + h) * NCH) * C::UNIT_B;
#define REC_DMA(cc) do { const unsigned char* ub_ = ubase + (size_t)(cc) * C::UNIT_B; const int bufi_ = (cc) % NBUF; _Pragma("unroll") for (int r_ = 0; r_ < C::NR; ++r_) { const int p_ = r_ * 8 + wave; \
            if (p_ < C::NP) { const unsigned char* src_ = ub_ + (p_ < C::NP1 ? p_ * 1024 : C::OFF_VT + sl * 8192 + (p_ - C::NP1) * 1024) + lane * 16; \
                __builtin_amdgcn_global_load_lds((const unsigned*)src_, (LAS unsigned*)(F.lds + bufi_ * BUFG + p_ * 1024), 16, 0, 0); } } \
            if (!GLA) { const unsigned char* gsrc_ = (const unsigned char*)(proj + ((size_t)b * T + (size_t)(cc) * CH + 4 * wave + (lane >> 4)) * AB_N + 3072 + h * DVH) + (lane & 15) * 16; \
                __builtin_amdgcn_global_load_lds((const unsigned*)gsrc_, (LAS unsigned*)(F.lds + bufi_ * BUFG + C::BUF_B + wave * 1024), 16, 0, 0); } } while (0)
        f32x4 S[NDT];
#pragma unroll
        for (int i = 0; i < NDT; ++i) S[i] = (f32x4){0.f, 0.f, 0.f, 0.f};
#pragma unroll
        for (int cc = 0; cc < PF; ++cc) REC_DMA(cc);
        float* Ob = O + ((size_t)b * T) * C::OPITCH + h * DVH + sl * 128 + 16 * wave + 4 * q4;
        LAS float* ssq = (LAS float*)(F.lds + NBUF * BUFG);
        f32x4 oprev[2] = {{0.f, 0.f, 0.f, 0.f}, {0.f, 0.f, 0.f, 0.f}};
        v2u gsave[2] = {{0u, 0u}, {0u, 0u}};
        const unsigned ecol = (unsigned)(h * DVH + 16 * wave + 4 * q4);
        f32x4 gn4 = {1.f, 1.f, 1.f, 1.f}; if (!GLA) gn4 = *(const f32x4*)(gain + ecol);
#define REC_FINISH(cp) do { _Pragma("unroll") for (int tt = 0; tt < 2; ++tt) { const int tl = 16 * tt + el; float tot = 0.f; \
            _Pragma("unroll") for (int w_ = 0; w_ < 8; ++w_) tot += ssq[(((cp) & 1) * 8 + w_) * 32 + tl]; \
            const float rstd = 1.0f / sqrtf(tot * (1.f / 128.f) + EPS); const size_t row_ = (size_t)b * T + (size_t)(cp) * CH + tl; \
            const v2u gw_ = gsave[tt]; const f32x4 ov = oprev[tt]; \
            v2u w_o; w_o.x = pk2(ov.x * rstd * gn4.x * silu_x(bf_lo(gw_.x)), ov.y * rstd * gn4.y * silu_x(bf_hi(gw_.x))); \
            w_o.y = pk2(ov.z * rstd * gn4.z * silu_x(bf_lo(gw_.y)), ov.w * rstd * gn4.w * silu_x(bf_hi(gw_.y))); \
            *(v2u*)(cat + row_ * DM + ecol) = w_o; } } while (0)
        for (int c = 0; c < NCH; ++c) {
            if (c <= PF) asm volatile("s_waitcnt vmcnt(0)" ::: "memory"); else asm volatile("s_waitcnt vmcnt(%0)" :: "i"(NWAIT) : "memory");
            asm volatile("s_waitcnt lgkmcnt(0)" ::: "memory"); __builtin_amdgcn_s_barrier(); asm volatile("" ::: "memory");
            if (!GLA) {
                if (c > 0) REC_FINISH(c - 1);
                else { v2u z; z.x = 0u; z.y = 0u; *(v2u*)(cat + ((size_t)b * T + el) * DM + ecol) = z; *(v2u*)(cat + ((size_t)b * T + 16 + el) * DM + ecol) = z; }
            }
            if (c + PF < NCH) REC_DMA(c + PF); else REC_DMA(NCH - 1);
            const LAS unsigned char* L = F.lds + (c % NBUF) * BUFG;
            rbf16x8 sf[NKS];
#pragma unroll
            for (int i = 0; i < NKS; ++i) sf[i] = rpack8(S[2 * i], S[2 * i + 1]);
            f32x4 o[2];
#pragma unroll
            for (int tt = 0; tt < 2; ++tt) { o[tt] = (f32x4){0.f, 0.f, 0.f, 0.f};
#pragma unroll
                for (int i = 0; i < NKS; ++i) { const rbf16x8 qf = *(const LAS rbf16x8*)(L + C::OFF_QT + ((16 * tt + el) * QP + 32 * i + 8 * q4) * 2);
                    o[tt] = __builtin_amdgcn_mfma_f32_16x16x32_bf16(sf[i], qf, o[tt], 0, 0, 0); } }
            const rbf16x8 vf = *(const LAS rbf16x8*)(L + C::OFF_VT + ((16 * wave + el) * CH + 8 * q4) * 2);
#pragma unroll
            for (int tt = 0; tt < 2; ++tt) { const rbf16x8 pf = *(const LAS rbf16x8*)(L + C::OFF_P + ((16 * tt + el) * CH + 8 * q4) * 2);
                o[tt] = __builtin_amdgcn_mfma_f32_16x16x32_bf16(vf, pf, o[tt], 0, 0, 0); }
#pragma unroll
            for (int dt = 0; dt < NDT; ++dt) { const f32x4 a4 = *(const LAS f32x4*)(L + C::OFF_A + (16 * dt + 4 * q4) * 4); S[dt] = S[dt] * a4;
                const rbf16x8 kf = *(const LAS rbf16x8*)(L + C::OFF_KT + ((16 * dt + el) * CH + 8 * q4) * 2);
                S[dt] = __builtin_amdgcn_mfma_f32_16x16x32_bf16(kf, vf, S[dt], 0, 0, 0); }
            if (GLA) {
#pragma unroll
                for (int tt = 0; tt < 2; ++tt) *(f32x4*)(Ob + (size_t)(c * CH + 16 * tt + el) * C::OPITCH) = o[tt];
            } else {
#pragma unroll
                for (int tt = 0; tt < 2; ++tt) { float p = (o[tt].x * o[tt].x + o[tt].y * o[tt].y) + (o[tt].z * o[tt].z + o[tt].w * o[tt].w); p = xsum<16>(p); p = xsum<32>(p);
                    if (q4 == 0) ssq[((c & 1) * 8 + wave) * 32 + 16 * tt + el] = p; oprev[tt] = o[tt];
                    gsave[tt] = *(const LAS v2u*)(L + C::BUF_B + ((16 * tt + el) * 128 + 16 * wave + 4 * q4) * 2); }
            }
        }
        asm volatile("s_waitcnt vmcnt(0)" ::: "memory"); __syncthreads();
        if (!GLA) { REC_FINISH(NCH - 1); }
        __syncthreads();
#undef REC_FINISH
#undef REC_DMA
    }
}

template <bool GLA>
__device__ __forceinline__ void rec_seq2(Frame& F, const unsigned char* rec, bf16* O) {
    using C = RecCfg<GLA>;
    constexpr int DK = C::DK, DVH = C::DVH, NH = C::NH, CH = C::CH, NCH = C::NCH, QP = C::QP;
    constexpr int NDH = DK / 32, NKH = DK / 64;
    constexpr int ES = 64, NSL = DVH / ES, BUF2 = C::OFF_VT + ES * CH * 2, NP1 = C::OFF_VT / 1024, NP = NP1 + ES * CH * 2 / 1024, NR = NP / 8;
    constexpr int NBUF = GLA ? 3 : 5, PF = NBUF, NWAIT = (PF - 1) * (NR + 1) + 1;
    static_assert(NP % 8 == 0 && NBUF * BUF2 + 2 * 8 * 1024 <= RING_BYTES, "rec_seq2 ring");
    constexpr int NUNITS = BATCH * NH * NSL;
    const int lane = F.lane, el = lane & 15, q4 = lane >> 4, wave = F.wave, eg = wave & 3, dg = wave >> 2;
    LAS unsigned char* xch = F.lds + NBUF * BUF2;
    for (int unit = F.bid; unit < NUNITS; unit += F.G) {
        const int sl = unit % NSL, h = (unit / NSL) % NH, b = unit / (NSL * NH);
        const unsigned char* ubase = rec + (size_t)((b * NH + h) * NCH) * C::UNIT_B;
#define G2_DMA(cc) do { const unsigned char* ub_ = ubase + (size_t)(cc) * C::UNIT_B; const int bufi_ = (cc) % NBUF; _Pragma("unroll") for (int r_ = 0; r_ < NR; ++r_) { const int p_ = r_ * 8 + wave; \
            const unsigned char* src_ = ub_ + (p_ < NP1 ? p_ * 1024 : C::OFF_VT + sl * (ES * CH * 2) + (p_ - NP1) * 1024) + lane * 16; \
            __builtin_amdgcn_global_load_lds((const unsigned*)src_, (LAS unsigned*)(F.lds + bufi_ * BUF2 + p_ * 1024), 16, 0, 0); } } while (0)
        f32x4 S[NDH];
#pragma unroll
        for (int i = 0; i < NDH; ++i) S[i] = (f32x4){0.f, 0.f, 0.f, 0.f};
#pragma unroll
        for (int cc = 0; cc < PF; ++cc) G2_DMA(cc);
        bf16* Ob = O + ((size_t)b * T + 16 * dg + el) * C::OPITCH + h * DVH + sl * ES + 16 * eg + 4 * q4;
#define G2_ST(p_, v_) do { const f32x4 v4_ = (v_); v2u w2_; w2_.x = pg8::cvt_pk_bf16(v4_.x, v4_.y); w2_.y = pg8::cvt_pk_bf16(v4_.z, v4_.w); *(v2u*)(p_) = w2_; } while (0)
        f32x4 okeep = {0.f, 0.f, 0.f, 0.f};
        for (int c = 0; c < NCH; ++c) {
            if (c <= PF) asm volatile("s_waitcnt vmcnt(0)" ::: "memory"); else asm volatile("s_waitcnt vmcnt(%0)" :: "i"(NWAIT) : "memory");
            asm volatile("s_waitcnt lgkmcnt(0)" ::: "memory"); __builtin_amdgcn_s_barrier(); asm volatile("" ::: "memory");
            const LAS unsigned char* L = F.lds + (c % NBUF) * BUF2;
            rbf16x8 qf[2][NKH], kf[NDH]; f32x4 a4[NDH];
#pragma unroll
            for (int tt = 0; tt < 2; ++tt)
#pragma unroll
                for (int i = 0; i < NKH; ++i) qf[tt][i] = *(const LAS rbf16x8*)(L + C::OFF_QT + ((16 * tt + el) * QP + 32 * (NKH * dg + i) + 8 * q4) * 2);
            const rbf16x8 vf = *(const LAS rbf16x8*)(L + C::OFF_VT + ((16 * eg + el) * CH + 8 * q4) * 2);
            const rbf16x8 pf = *(const LAS rbf16x8*)(L + C::OFF_P + ((16 * dg + el) * CH + 8 * q4) * 2);
#pragma unroll
            for (int j = 0; j < NDH; ++j) { kf[j] = *(const LAS rbf16x8*)(L + C::OFF_KT + ((16 * (NDH * dg + j) + el) * CH + 8 * q4) * 2); a4[j] = *(const LAS f32x4*)(L + C::OFF_A + (16 * (NDH * dg + j) + 4 * q4) * 4); }
            asm volatile("s_waitcnt lgkmcnt(0)" ::: "memory"); __builtin_amdgcn_s_barrier(); asm volatile("" ::: "memory");
            if (c + PF < NCH) G2_DMA(c + PF); else G2_DMA(NCH - 1);
            rbf16x8 sf[NKH];
#pragma unroll
            for (int i = 0; i < NKH; ++i) sf[i] = rpack8(S[2 * i], S[2 * i + 1]);
            f32x4 o[2];
#pragma unroll
            for (int tt = 0; tt < 2; ++tt) { o[tt] = (f32x4){0.f, 0.f, 0.f, 0.f};
#pragma unroll
                for (int i = 0; i < NKH; ++i) o[tt] = __builtin_amdgcn_mfma_f32_16x16x32_bf16(sf[i], qf[tt][i], o[tt], 0, 0, 0); }
            if (dg == 0) o[0] = __builtin_amdgcn_mfma_f32_16x16x32_bf16(vf, pf, o[0], 0, 0, 0); else o[1] = __builtin_amdgcn_mfma_f32_16x16x32_bf16(vf, pf, o[1], 0, 0, 0);
#pragma unroll
            for (int j = 0; j < NDH; ++j) { S[j] = S[j] * a4[j]; S[j] = __builtin_amdgcn_mfma_f32_16x16x32_bf16(kf[j], vf, S[j], 0, 0, 0); }
            if (c > 0) { const f32x4 pr = *(const LAS f32x4*)(xch + ((((c - 1) & 1) * 8 + (wave ^ 4)) * 64 + lane) * 16);
                         G2_ST(Ob + (size_t)((c - 1) * CH) * C::OPITCH, okeep + pr); }
            else { G2_ST(Ob, okeep); }
            *(LAS f32x4*)(xch + (((c & 1) * 8 + wave) * 64 + lane) * 16) = dg == 0 ? o[1] : o[0];
            okeep = dg == 0 ? o[0] : o[1];
        }
        asm volatile("s_waitcnt vmcnt(0) lgkmcnt(0)" ::: "memory"); __syncthreads();
        { const f32x4 pr = *(const LAS f32x4*)(xch + ((((NCH - 1) & 1) * 8 + (wave ^ 4)) * 64 + lane) * 16); G2_ST(Ob + (size_t)((NCH - 1) * CH) * C::OPITCH, okeep + pr); }
        __syncthreads();
#undef G2_ST
#undef G2_DMA
    }
}
#define WSP(T_, off) ((T_*)(ws + (off)))
#define REFRAME() CArgs* ap = opq_args(); unsigned char* ws = ap->ws; (void)ws; \
    F.lds = (LAS unsigned char*)lds; F.tid = opq_tid(wave_s); F.lane = F.tid & 63; F.wave = __builtin_amdgcn_readfirstlane(F.tid >> 6); F.G = gridDim.x; F.bid = opq_bid()
#ifndef DBG_DOUBLE
#define DBG_DOUBLE 0
#endif
#define NREP(bit) ((DBG_DOUBLE & (bit)) ? 2 : 1)
#define REPBAR(rep, n) do { if ((rep) + 1 < (n)) xcd_barrier<false>(bar, F.tid == 0); } while (0)
#define IN(k) (lo <= (k) && (k) < hi)
#define SEAM(k) do { if (IN(k) && IN((k) + 1)) xcd_barrier<false>(bar, F.tid == 0); } while (0)
template <int layer>
__device__ __forceinline__ void layer_phases(unsigned char* lds, const int wave_s, const int lo, const int hi, const XcdBarrier& bar) {
    Frame F;

        constexpr int pb = phase_base(layer); constexpr bool odd = layer & 1; constexpr int li = layer >> 1;
        constexpr int P_NORM1 = pb, P_MIXIN = pb + 1, P_PREP = pb + 2, P_REC = pb + 3, P_POST = pb + 4, P_MIXOUT = pb + 5, P_NORM2 = P_MIXOUT + 1, P_FFIN = P_MIXOUT + 2, P_FFOUT = P_MIXOUT + 3;
#define MODL (WSP(float, WS_MOD) + (size_t)layer * 2 * 6 * DM)
#define XCUR (layer == 0 ? ap->in[0] : (const float*)ap->out)
        if (IN(P_NORM1)) { REFRAME();
            const float* modl = MODL;
            for (int rep = 0; rep < NREP(2); ++rep) {
            constexpr bool L0 = layer == 0; const float* g2p = WSP(float, WS_MOD) + (size_t)(L0 ? 0 : layer - 1) * 2 * 6 * DM + 5 * DM; const void* xin = L0 ? (const void*)ap->in[0] : (const void*)WSP(const bf16, WS_XB);
            if (!odd) norm_phase<8, 1, !L0, L0>(F, xin, ap->in[4] + (size_t)layer * DM, modl, modl + DM, WSP(bf16, WS_H), ap->in[6] + (size_t)li * DM * AB_IN + AB_N, AB_IN, ap->in[12] + li * 8, WSP(float, WS_LOGF), WSP(const bf16, WS_Y), g2p, WSP(bf16, WS_XB));
            else norm_phase<16, 2, !L0, L0>(F, xin, ap->in[4] + (size_t)layer * DM, modl, modl + DM, WSP(bf16, WS_H), ap->in[13] + (size_t)li * DM * C_IN + C_N, C_IN, nullptr, WSP(float, WS_GLOW), WSP(const bf16, WS_Y), g2p, WSP(bf16, WS_XB));
            REPBAR(rep, NREP(2)); }
            SEAM(P_NORM1);
        }
        if (IN(P_MIXIN)) { REFRAME();
            const int N = odd ? 4096 : AB_N, ldc = odd ? C_N : AB_N;
            const bf16* Wt = odd ? WSP(const bf16, WS_W_GLIN) + (size_t)li * C_N * DM : WSP(const bf16, WS_W_ABIN) + (size_t)li * AB_N * DM;
            pg8::Gemm g{WSP(const bf16, WS_H), Wt, M, N, DM}; pg8::StaticOrder S; S.init(M, N, F.G, F.bid);
            pg8::EpiBf16 E{WSP(bf16, WS_PROJ), ldc};
            for (int rep = 0; rep < NREP(1); ++rep) { pg8::gemm_phase<pg8::EpiBf16, pg8::StaticOrder, true, true>(F.lds + RING_OFF, g, S, E, F.tid); REPBAR(rep, NREP(1)); }
            SEAM(P_MIXIN);
        }
        if (IN(P_PREP)) { REFRAME();
            if (!odd) { fox_prep(F, WSP(bf16, WS_PROJ), ap->in[10] + li * 128, ap->in[11] + li * 128, WSP(float, WS_LOGF), WSP(float, WS_BIAS));
                        __syncthreads();
                        for (int rep = 0; rep < NREP(4); ++rep) { rec_prep<false>(F, WSP(const bf16, WS_PROJ), ws + WS_REC, ap->in[8], li, nullptr, nullptr, nullptr); REPBAR(rep, NREP(4)); } }
            else for (int rep = 0; rep < NREP(4); ++rep) { rec_prep<true>(F, WSP(const bf16, WS_PROJ), ws + WS_REC, nullptr, 0, WSP(float, WS_GLOW), ap->in[14] + (size_t)li * 16 * 1024, ap->in[15] + li * 1024); REPBAR(rep, NREP(4)); }
            SEAM(P_PREP);
        }
        if (IN(P_REC)) { REFRAME();
            for (int rep = 0; rep < (odd ? NREP(8) : 1); ++rep) {
            if (!odd) { rec_seq2<false>(F, ws + WS_REC, WSP(bf16, WS_O));
                        fox_phase(F, (char*)lds + RING_OFF, WSP(const bf16, WS_PROJ), WSP(bf16, WS_CAT), WSP(float, WS_BIAS), (unsigned*)(ws + WS_CTL) + CW_QUEUE + 64 * (li + 2 * rep), ap->in[10] + li * 128, ap->in[11] + li * 128); }
            else { rec_seq2<true>(F, ws + WS_REC, WSP(bf16, WS_O));
                   if (F.bid >= 64 && rep == 0) {
                       { pg8::Gemm g{WSP(const bf16, WS_H), WSP(const bf16, WS_W_GLIN) + (size_t)li * C_N * DM + (size_t)4096 * DM, M, 2048, DM}; pg8::StaticOrder S; S.init(M, 2048, F.G - 64, F.bid - 64);
                         pg8::EpiBf16 E{WSP(bf16, WS_PROJ) + 4096, C_N};
                         pg8::gemm_phase<pg8::EpiBf16, pg8::StaticOrder, true, true>(F.lds + RING_OFF, g, S, E, F.tid); }
                       LAS float* scr = (LAS float*)(F.lds + RING_OFF + F.wave * 16640);
                       convert_weights<(layer == 1 ? 1 : 2)>(ap, scr, (F.bid - 64) * NWAVES + F.wave, (F.G - 64) * NWAVES, F.lane); } }
            REPBAR(rep, (odd ? NREP(8) : 1)); }
            SEAM(P_REC);
        }
        if (IN(P_POST)) { REFRAME();
            if (!odd) post_even(F, WSP(const bf16, WS_O), WSP(const bf16, WS_PROJ), ap->in[9] + li * 1024, WSP(bf16, WS_CAT));
            else for (int rep = 0; rep < NREP(16); ++rep) { post_odd(F, WSP(const bf16, WS_O), WSP(const bf16, WS_PROJ), ap->in[16] + li * 512, WSP(bf16, WS_CAT)); REPBAR(rep, NREP(16)); }
            SEAM(P_POST);
        }
        if (IN(P_MIXOUT)) { REFRAME();
            const float* modl = MODL;
            const bf16* Wt = odd ? WSP(const bf16, WS_W_GLOUT) + (size_t)li * DM * DM : WSP(const bf16, WS_W_ABOUT) + (size_t)li * DM * DM;
            pg8::Gemm g{WSP(const bf16, WS_CAT), Wt, M, DM, DM}; pg8::StaticOrder S; S.init(M, DM, F.G, F.bid);
            pg8::EpiBf16 E{WSP(bf16, WS_Y), DM};
            pg8::gemm_phase<pg8::EpiBf16, pg8::StaticOrder, true, true>(F.lds + RING_OFF, g, S, E, F.tid);
            SEAM(P_MIXOUT);
        }
        if (IN(P_NORM2)) { REFRAME();
            const float* modl = MODL;
            { constexpr bool L0 = layer == 0; const void* xin = L0 ? (const void*)ap->in[0] : (const void*)WSP(const bf16, WS_XB);
              norm_phase<0, 0, true, L0>(F, xin, ap->in[5] + (size_t)layer * DM, modl + 3 * DM, modl + 4 * DM, WSP(bf16, WS_H), nullptr, 0, nullptr, nullptr, WSP(const bf16, WS_Y), modl + 2 * DM, WSP(bf16, WS_XB)); }
            SEAM(P_NORM2);
        }
        if (IN(P_FFIN)) { REFRAME();
            pg8::Gemm g{WSP(const bf16, WS_H), WSP(const bf16, WS_W_FFIN) + (size_t)layer * FF2 * DM, M, FF2, DM}; pg8::StaticOrder S; S.init(M, FF2, F.G, F.bid);
            pg8::EpiSwiglu E{WSP(bf16, WS_FFH), FF};
            for (int rep = 0; rep < NREP(1 | 128); ++rep) { pg8::gemm_phase<pg8::EpiSwiglu, pg8::StaticOrder, true, true>(F.lds + RING_OFF, g, S, E, F.tid); REPBAR(rep, NREP(1 | 128)); }
            SEAM(P_FFIN);
        }
        if (IN(P_FFOUT)) { REFRAME();
            const float* modl = MODL;
            pg8::Gemm g{WSP(const bf16, WS_FFH), WSP(const bf16, WS_W_FFOUT) + (size_t)layer * DM * FF, M, DM, FF}; pg8::StaticOrder S; S.init(M, DM, F.G, F.bid);
            pg8::EpiBf16 E{WSP(bf16, WS_Y), DM};
            pg8::gemm_phase<pg8::EpiBf16, pg8::StaticOrder, true, true>(F.lds + RING_OFF, g, S, E, F.tid);
            SEAM(P_FFOUT);
        }
    }
__global__ void __launch_bounds__(NTHREADS, 2) trunk_fwd(Args args_unused) {
    extern __shared__ __attribute__((aligned(16))) unsigned char lds[];
    Frame F;
    const int wave_s = __builtin_amdgcn_readfirstlane(threadIdx.x >> 6);
    int lo, hi, use_bar; XcdBarrier bar;
    {
        REFRAME();
        volatile LAS unsigned* MISC = (volatile LAS unsigned*)(F.lds + MISC_OFF);
        for (int u = F.tid; u < (LDS_BYTES - LDSCTL_OFF) / 4; u += NTHREADS) ((LAS unsigned*)(F.lds + LDSCTL_OFF))[u] = 0u;
        __syncthreads();
        lo = ap->ph_lo; hi = ap->ph_hi; use_bar = ap->use_bar;
        bar.bar = (unsigned*)(ws + WS_CTL) + CW_BAR; bar.x = 0; bar.st = MISC + 8;
        if (use_bar) bar = xcd_barrier_post((unsigned*)(ws + WS_CTL) + CW_BAR, MISC + 8, F.tid == 0);
    }

    if (IN(0)) { REFRAME(); p0_prologue(F, ap); if (IN(1)) xcd_barrier<true>(bar, F.tid == 0);
        if (DBG_DOUBLE & 32) { p0_prologue(F, ap); xcd_barrier<false>(bar, F.tid == 0); } }

    layer_phases<0>(lds, wave_s, lo, hi, bar);
    layer_phases<1>(lds, wave_s, lo, hi, bar);
    layer_phases<2>(lds, wave_s, lo, hi, bar);
    layer_phases<3>(lds, wave_s, lo, hi, bar);
    if (IN(phase_base(DEPTH))) { REFRAME(); resid_final(F, WSP(const bf16, WS_XB), WSP(const bf16, WS_Y), WSP(float, WS_MOD) + (size_t)(DEPTH - 1) * 2 * 6 * DM + 5 * DM, ap->out); }
#undef IN
#undef SEAM
}

#ifndef DBG_CHECK
#define DBG_CHECK 0
#endif
#if DBG_CHECK
#ifndef DBG_REPORT_ERR
#define DBG_REPORT_ERR 1
#endif
constexpr size_t WS_DBG = 5 * MiB;
constexpr size_t WS_DBG_OLD = 1072 * MiB;
__device__ __forceinline__ unsigned dbg_hash(unsigned x) { x ^= x >> 16; x *= 0x7feb352dU; x ^= x >> 15; x *= 0x846ca68bU; x ^= x >> 16; return x; }
__device__ __forceinline__ float dbg_bfr(float f) { return __builtin_bit_cast(float, f2bf(f) << 16); }
__device__ __forceinline__ void dbg_cmp(unsigned* dbg, unsigned code, float got, float ref, float rtol, float atol) {
    const float err = fabsf(got - ref); const bool bad = !(err <= atol + rtol * fabsf(ref));
    if (bad) { atomicMin(dbg, code); atomicMax(dbg + 1 + (code & 255u), __float_as_uint(err)); }
}
__global__ void dbg_gemm(unsigned* dbg, unsigned code, int mode, const bf16* A, int K, const float* W, int ldw, int N, const void* C, int ldc, const float* old, const float* gate0, const float* gate1) {
    const unsigned s = blockIdx.x * blockDim.x + threadIdx.x; const unsigned hsh = dbg_hash(s * 2654435761u + code);
    const int m = hsh % M, n = dbg_hash(hsh) % N;
    float d0 = 0.f, d1 = 0.f;
    for (int k = 0; k < K; ++k) { const float a = bf1(A[(size_t)m * K + k]); d0 += a * dbg_bfr(W[(size_t)k * ldw + n]); if (mode == 1) d1 += a * dbg_bfr(W[(size_t)k * ldw + FF + n]); }
    float got, ref;
    if (mode == 0) { got = bf1(((const bf16*)C)[(size_t)m * ldc + n]); ref = d0; }
    else if (mode == 1) { got = bf1(((const bf16*)C)[(size_t)m * ldc + n]); ref = d0 / (1.f + expf(-d0)) * d1; }
    else { got = ((const float*)C)[(size_t)m * ldc + n]; ref = old[(size_t)m * ldc + n] + (m >= T ? gate1 : gate0)[n] * d0; }
    dbg_cmp(dbg, code, got, ref, 0.02f, 0.03f);
}
__global__ void dbg_norm(unsigned* dbg, unsigned code, const float* x, const float* gain, const float* sh, const float* sc, const bf16* h) {
    const unsigned s = blockIdx.x * blockDim.x + threadIdx.x; const unsigned hsh = dbg_hash(s * 2654435761u + code);
    const int m = hsh % M, k = dbg_hash(hsh) % DM, b = m / T;
    double ss = 0.0; for (int i = 0; i < DM; ++i) { const double v = x[(size_t)m * DM + i]; ss += v * v; }
    const float rstd = (float)(1.0 / sqrt(ss / DM + 1e-6));
    const float ref = x[(size_t)m * DM + k] * rstd * gain[k] * (1.f + sc[(size_t)b * 6 * DM + k]) + sh[(size_t)b * 6 * DM + k];
    dbg_cmp(dbg, code, bf1(h[(size_t)m * DM + k]), ref, 0.01f, 0.01f);
}
__global__ void dbg_mod(unsigned* dbg, unsigned code, const float* c, const float* mw, const float* mb, const float* mod) {
    const unsigned s = blockIdx.x * blockDim.x + threadIdx.x; const unsigned hsh = dbg_hash(s * 2654435761u + code);
    const int layer = hsh % DEPTH, b = (hsh >> 8) & 1, j = dbg_hash(hsh) % (6 * DM);
    double acc = mb[(size_t)layer * 6 * DM + j];
    for (int k = 0; k < DM; ++k) { const double cv = c[b * DM + k]; acc += cv / (1.0 + exp(-cv)) * mw[((size_t)layer * DM + k) * (6 * DM) + j]; }
    dbg_cmp(dbg, code, mod[((size_t)layer * 2 + b) * 6 * DM + j], (float)acc, 1e-3f, 1e-4f);
}
__global__ void dbg_small(unsigned* dbg, unsigned code, int mode, const bf16* h, const float* W, int ldw, const float* fbias, const float* sout) {
    const unsigned s = blockIdx.x * blockDim.x + threadIdx.x; const unsigned hsh = dbg_hash(s * 2654435761u + code);
    const int m = hsh % M, cc = dbg_hash(hsh) % (mode == 1 ? 8 : 16), b = m / T, t = m % T;
    double acc = 0.0; for (int k = 0; k < DM; ++k) acc += (double)bf1(h[(size_t)m * DM + k]) * W[(size_t)k * ldw + cc];
    if (mode == 1) { const double xx = acc + fbias[cc]; const double ref = (xx < 0 ? xx : 0.0) - log1p(exp(-fabs(xx))); dbg_cmp(dbg, code, sout[((size_t)b * 8 + cc) * T + t], (float)ref, 0.02f, 0.02f); }
    else dbg_cmp(dbg, code, sout[(size_t)m * 16 + cc], (float)acc, 0.02f, 0.02f);
}
__global__ void dbg_cmpbuf(unsigned* dbg, unsigned code, const float* a, const float* b, size_t n) {
    for (size_t i = (size_t)blockIdx.x * blockDim.x + threadIdx.x; i < n; i += (size_t)gridDim.x * blockDim.x * 61) dbg_cmp(dbg, code, b[i], a[i], 0.05f, 0.1f);
}
__global__ void dbg_report(const unsigned* dbg, float* out) {
    if (threadIdx.x == 0 && blockIdx.x == 0) { const unsigned code = dbg[0]; if (code != 0xffffffffu) { out[0] = DBG_REPORT_ERR ? 1000.f * __uint_as_float(dbg[1 + (code & 255u)]) : 1000.f * (float)(code & 255u); } }
}
#endif
#ifndef N_LAUNCH_MODE
#define N_LAUNCH_MODE 1
#endif
extern "C" void kernel_launch(void* const* d_in, const int* in_sizes, int n_in, void* d_out, int out_size, void* d_ws, size_t ws_size, hipStream_t stream) {
    static int grid = 0;
    if (grid == 0) {
        if (n_in != 20 || out_size != M * DM || ws_size < WS_END) { fprintf(stderr, "kernel_launch: unexpected shapes (n_in %d out %d ws %zu)\n", n_in, out_size, ws_size); grid = -1; return; }
        int dev = 0, cus = 0, per_cu = 0;
        if (hipGetDevice(&dev) != hipSuccess || hipDeviceGetAttribute(&cus, hipDeviceAttributeMultiprocessorCount, dev) != hipSuccess) { grid = -1; return; }
        if (hipFuncSetAttribute((const void*)trunk_fwd, hipFuncAttributeMaxDynamicSharedMemorySize, LDS_BYTES) != hipSuccess) { fprintf(stderr, "kernel_launch: hipFuncSetAttribute failed\n"); grid = -1; return; }
        if (hipOccupancyMaxActiveBlocksPerMultiprocessor(&per_cu, (const void*)trunk_fwd, NTHREADS, LDS_BYTES) != hipSuccess || per_cu < 1)
            fprintf(stderr, "kernel_launch: occupancy query reports %d workgroups per CU\n", per_cu);
        (void)hipGetLastError();
        grid = cus;
    }
    if (grid < 0) return;
    if (hipMemsetAsync((char*)d_ws + WS_CTL, 0, CTL_ZERO_BYTES, stream) != hipSuccess) return;
    Args a{};
    for (int i = 0; i < 20; ++i) a.in[i] = (const float*)d_in[i];
    a.out = (float*)d_out; a.ws = (unsigned char*)d_ws; a.pad = 0;
#if N_LAUNCH_MODE == 1
    a.ph_lo = 0; a.ph_hi = N_PHASES; a.use_bar = 1;
    hipLaunchKernelGGL(trunk_fwd, dim3(grid), dim3(NTHREADS), LDS_BYTES, stream, a);
#else
    a.use_bar = 0;
#if DBG_CHECK
    unsigned char* wsb = (unsigned char*)d_ws; unsigned* dbg = (unsigned*)(wsb + WS_DBG);
    hipMemsetAsync(dbg, 0xFF, 4, stream); hipMemsetAsync(dbg + 1, 0, 1024, stream);
    const float* const* in = (const float* const*)a.in; float* outp = (float*)d_out; float* oldp = (float*)(wsb + WS_DBG_OLD);
    bf16* hbuf = (bf16*)(wsb + WS_H); bf16* catb = (bf16*)(wsb + WS_CAT); bf16* projb = (bf16*)(wsb + WS_PROJ); bf16* ffhb = (bf16*)(wsb + WS_FFH);
#endif
    for (int p = 0; p < N_PHASES; ++p) {
        int layer = 0; const int q = phase_kind(p, layer); const int li = layer >> 1; const bool odd = layer & 1; (void)li; (void)odd; (void)q;
#if DBG_CHECK
        const float* modl = (const float*)(wsb + WS_MOD) + (size_t)layer * 2 * 6 * DM; const float* xcur = layer == 0 ? in[0] : outp;
        if (q == K_MIXOUT) hipMemcpyAsync(oldp, xcur, (size_t)M * DM * 4, hipMemcpyDeviceToDevice, stream);
        if (q == K_FFOUT) hipMemcpyAsync(oldp, outp, (size_t)M * DM * 4, hipMemcpyDeviceToDevice, stream);
#endif
        a.ph_lo = p; a.ph_hi = p + 1;
        hipLaunchKernelGGL(trunk_fwd, dim3(grid), dim3(NTHREADS), LDS_BYTES, stream, a);
#if DBG_CHECK
        const unsigned code = 1 + p;
        if (q == K_PRO) dbg_mod<<<16, 256, 0, stream>>>(dbg, code, in[1], in[2], in[3], (const float*)(wsb + WS_MOD));
        if (q == K_NORM1) { dbg_norm<<<16, 256, 0, stream>>>(dbg, code, xcur, in[4] + (size_t)layer * DM, modl, modl + DM, hbuf);
            if (!odd) dbg_small<<<16, 256, 0, stream>>>(dbg, code | 0x100, 1, hbuf, in[6] + (size_t)li * DM * AB_IN + AB_N, AB_IN, in[12] + li * 8, (const float*)(wsb + WS_LOGF));
            else dbg_small<<<16, 256, 0, stream>>>(dbg, code | 0x100, 2, hbuf, in[13] + (size_t)li * DM * C_IN + C_N, C_IN, nullptr, (const float*)(wsb + WS_GLOW)); }
        if (q == K_MIXIN) { if (!odd) dbg_gemm<<<16, 256, 0, stream>>>(dbg, code, 0, hbuf, DM, in[6] + (size_t)li * DM * AB_IN, AB_IN, AB_N, projb, AB_N, nullptr, nullptr, nullptr);
            else dbg_gemm<<<16, 256, 0, stream>>>(dbg, code, 0, hbuf, DM, in[13] + (size_t)li * DM * C_IN, C_IN, C_N, projb, C_N, nullptr, nullptr, nullptr); }
#if DBG_REC
        if (q == K_REC) dbg_cmpbuf<<<256, 256, 0, stream>>>(dbg, code, (const float*)(wsb + WS_O), (const float*)(wsb + 1200 * MiB), odd ? (size_t)M * 2048 : (size_t)M * 1024);
#endif
        if (q == K_MIXOUT) dbg_gemm<<<16, 256, 0, stream>>>(dbg, code, 2, catb, DM, (odd ? in[17] : in[7]) + (size_t)li * DM * DM, DM, DM, outp, DM, oldp, modl + 2 * DM, modl + 6 * DM + 2 * DM);
        if (q == K_NORM2) dbg_norm<<<16, 256, 0, stream>>>(dbg, code, outp, in[5] + (size_t)layer * DM, modl + 3 * DM, modl + 4 * DM, hbuf);
        if (q == K_FFIN) dbg_gemm<<<16, 256, 0, stream>>>(dbg, code, 1, hbuf, DM, in[18] + (size_t)layer * DM * FF2, FF2, FF, ffhb, FF, nullptr, nullptr, nullptr);
        if (q == K_FFOUT) dbg_gemm<<<16, 256, 0, stream>>>(dbg, code, 2, ffhb, FF, in[19] + (size_t)layer * FF * DM, DM, DM, outp, DM, oldp, modl + 5 * DM, modl + 6 * DM + 5 * DM);
#endif
    }
#if DBG_CHECK
    dbg_report<<<1, 64, 0, stream>>>(dbg, outp);
#endif
#endif
}
```

```cpp
#include <hip/hip_runtime.h>
#include <hip/hip_bf16.h>
#include <cstdio>
#include <cstdint>
__device__ __forceinline__ int opq_tid(int wave_s) {
    int t; asm volatile("v_mbcnt_lo_u32_b32 %0, -1, 0\n\tv_mbcnt_hi_u32_b32 %0, -1, %0\n\tv_lshl_add_u32 %0, %1, 6, %0" : "=&v"(t) : "s"(wave_s)); return t; }
__device__ __forceinline__ int opq_bid() { int t = blockIdx.x; asm volatile("" : "+s"(t)); return t; }
template <int MASK> __device__ __forceinline__ float xsum(float v) {
    if constexpr (MASK < 32) { return v + __builtin_bit_cast(float, __builtin_amdgcn_ds_swizzle(__builtin_bit_cast(int, v), (MASK << 10) | 0x1f)); }
    else { auto rr = __builtin_amdgcn_permlane32_swap(__float_as_uint(v), __float_as_uint(v), false, false);
           const unsigned r0 = rr[0], r1 = rr[1];
           return __uint_as_float(r0) + __uint_as_float(r1); }
}
__device__ __forceinline__ float xor1_get(float v) { return __builtin_bit_cast(float, __builtin_amdgcn_ds_swizzle(__builtin_bit_cast(int, v), (1 << 10) | 0x1f)); }
namespace pg8 {
#define PG8_LAS __attribute__((address_space(3)))
typedef unsigned short bf16_t;
typedef short bf16x8 __attribute__((ext_vector_type(8)));
typedef float f32x4 __attribute__((ext_vector_type(4)));
typedef unsigned u32x4 __attribute__((ext_vector_type(4)));
constexpr int BM = 256, BK = 64, HALF = 128, HTB = HALF * BK * 2  , STAGE_BYTES = 8 * HTB, NXCD = 8, WGM = 8;

__host__ __device__ __forceinline__ int lds_byte(int r, int c) { const int st = (r >> 4) * 2 + (c >> 5), rr = r & 15, cc = c & 31, ob = rr * 64 + cc * 2; return st * 1024 + (ob ^ (((ob >> 9) & 1) << 5)); }
__host__ __device__ __forceinline__ void stage_rc(int b, int& R, int& C) { const int st = b / 1024, sb = b % 1024, swz = sb ^ (((sb >> 9) & 1) << 5); R = (st >> 1) * 16 + swz / 64; C = (st & 1) * 32 + (swz % 64) / 2; }
__host__ __device__ __forceinline__ int perm32(int rho) { const int n = rho >> 4, i = rho & 15; return 8 * (i >> 2) + 4 * n + (i & 3); }

struct Unit { int pm, pn; };
struct Gemm { const bf16_t* A; const bf16_t* Bt; int M, N, K; };

struct StaticOrder {
    int nM, nN, nwg, G, c;
    __host__ __device__ void init(int M, int N, int G_, int c_) { nM = M / BM; nN = N / BM; nwg = nM * nN; G = G_; c = c_; }
    __host__ __device__ bool next(int i, Unit& u) const {
        const long L = (long)i * G + c; if (L >= nwg) return false;
        int wgid = (int)L; { const int q = nwg / NXCD, r = nwg % NXCD, xcd = wgid % NXCD, off = wgid / NXCD; wgid = (xcd < r ? xcd * (q + 1) : r * (q + 1) + (xcd - r) * q) + off; }
        const int nig = WGM * nN, gid = wgid / nig, fm = gid * WGM, gsz = (nM - fm) < WGM ? (nM - fm) : WGM;
        u.pm = fm + ((wgid % nig) % gsz); u.pn = (wgid % nig) / gsz; return true;
    }
    __device__ __forceinline__ void a_ready(const Unit&) const {}
    __device__ __forceinline__ void done(const Unit&) const {}
};

__device__ __forceinline__ unsigned cvt_pk_bf16(float lo, float hi) { unsigned r; asm volatile("v_cvt_pk_bf16_f32 %0, %1, %2" : "=v"(r) : "v"(lo), "v"(hi)); return r; }
typedef float f32x2 __attribute__((ext_vector_type(2)));

struct EpiBf16 {
    static constexpr bool PERM = true, AFTER_DRAIN = false;
    bf16_t* O; int ldc;
    __device__ __forceinline__ void operator()(const f32x4 (&acc)[2][2][4][2], const Unit& u, int wr, int wc, int fr, int fq) const {
        const int row0 = u.pm * BM + wr * 64 + fr; const int col0 = u.pn * BM + wc * 32 + 8 * fq;
#pragma unroll
        for (int ai = 0; ai < 2; ++ai)
#pragma unroll
            for (int m = 0; m < 4; ++m) { bf16_t* rowp = O + (size_t)(row0 + ai * HALF + m * 16) * ldc + col0;
#pragma unroll
                for (int bj = 0; bj < 2; ++bj) { const f32x4 v0 = acc[ai][bj][m][0], v1 = acc[ai][bj][m][1];
                    u32x4 w; w.x = cvt_pk_bf16(v0[0], v0[1]); w.y = cvt_pk_bf16(v0[2], v0[3]); w.z = cvt_pk_bf16(v1[0], v1[1]); w.w = cvt_pk_bf16(v1[2], v1[3]);
                    *(u32x4*)(rowp + bj * HALF) = w; } }
    }
};
__device__ __forceinline__ float silu_f(float a) { return a * __builtin_amdgcn_rcpf(1.0f + __builtin_amdgcn_exp2f(-1.4426950408889634f * a)); }
struct EpiSwiglu {
    static constexpr bool PERM = true, AFTER_DRAIN = false;
    bf16_t* O; int ldc;
    __device__ __forceinline__ void operator()(const f32x4 (&acc)[2][2][4][2], const Unit& u, int wr, int wc, int fr, int fq) const {
        const int row0 = u.pm * BM + wr * 64 + fr; const int col0 = u.pn * HALF + wc * 32 + 8 * fq;
#pragma unroll
        for (int ai = 0; ai < 2; ++ai)
#pragma unroll
            for (int m = 0; m < 4; ++m) { bf16_t* rowp = O + (size_t)(row0 + ai * HALF + m * 16) * ldc + col0;
                const f32x4 a0 = acc[ai][0][m][0], a1 = acc[ai][0][m][1], u0 = acc[ai][1][m][0], u1 = acc[ai][1][m][1];
                u32x4 w;
                w.x = cvt_pk_bf16(silu_f(a0[0]) * u0[0], silu_f(a0[1]) * u0[1]); w.y = cvt_pk_bf16(silu_f(a0[2]) * u0[2], silu_f(a0[3]) * u0[3]);
                w.z = cvt_pk_bf16(silu_f(a1[0]) * u1[0], silu_f(a1[1]) * u1[1]); w.w = cvt_pk_bf16(silu_f(a1[2]) * u1[2], silu_f(a1[3]) * u1[3]);
                *(u32x4*)rowp = w; }
    }
};
struct EpiResid {
    static constexpr bool PERM = false, AFTER_DRAIN = false;
    const float* base; float* out; int ldc; const float* gate0; const float* gate1; int pm_split;
    __device__ __forceinline__ void operator()(const f32x4 (&acc)[2][2][4][2], const Unit& u, int wr, int wc, int fr, int fq) const {
        const int col0 = u.pn * BM + wc * 32 + 4 * fq; const float* g = (u.pm >= pm_split) ? gate1 : gate0;
        f32x4 gv[2][2];
#pragma unroll
        for (int bj = 0; bj < 2; ++bj)
#pragma unroll
            for (int n = 0; n < 2; ++n) gv[bj][n] = *(const f32x4*)(g + col0 + bj * HALF + n * 16);
#pragma unroll
        for (int ai = 0; ai < 2; ++ai) { f32x4 bs[4][2][2];
#pragma unroll
            for (int m = 0; m < 4; ++m) { const size_t off = (size_t)(u.pm * BM + ai * HALF + wr * 64 + m * 16 + fr) * ldc + col0;
#pragma unroll
                for (int bj = 0; bj < 2; ++bj)
#pragma unroll
                    for (int n = 0; n < 2; ++n) bs[m][bj][n] = *(const f32x4*)(base + off + bj * HALF + n * 16); }
#pragma unroll
            for (int m = 0; m < 4; ++m) { const size_t off = (size_t)(u.pm * BM + ai * HALF + wr * 64 + m * 16 + fr) * ldc + col0;
#pragma unroll
                for (int bj = 0; bj < 2; ++bj)
#pragma unroll
                    for (int n = 0; n < 2; ++n) *(f32x4*)(out + off + bj * HALF + n * 16) = bs[m][bj][n] + gv[bj][n] * acc[ai][bj][m][n]; }
            asm volatile("" ::: "memory"); }
    }
};

template <class Epi, class Sched, bool ALIGN_EPI = false, bool SP2 = false>
__device__ __forceinline__ void gemm_phase(PG8_LAS unsigned char* lds, const Gemm g, const Sched& S, const Epi& E, const int tid) {
    const int wid = __builtin_amdgcn_readfirstlane(tid >> 6), lane = tid & 63, wr = wid >> 2, wc = wid & 3, fr = lane & 15, fq = lane >> 4;
    const int K = g.K, nt = K / BK;
    unsigned voffA[2], voffB[2];
#pragma unroll
    for (int i = 0; i < 2; ++i) { int R, C; stage_rc(tid * 16 + i * 8192, R, C); const int Rb = Epi::PERM ? ((R & ~31) + perm32(R & 31)) : R;
        voffA[i] = (unsigned)(R * K + C) * 2u; voffB[i] = (unsigned)(Rb * K + C) * 2u; }
    const size_t kstep = (size_t)(BK * 2);
    const size_t hstep = (size_t)HALF * K * 2;
    const size_t tstep = 2 * hstep;
    const unsigned ldsw = (unsigned)wid * 1024u;
    const int aoff = lds_byte(wr * 64 + fr, fq * 8), boff = lds_byte(wc * 32 + fr, fq * 8);
#define PG8_SA(b, h) (((b) * 2 + (h)) * HTB)
#define PG8_SB(b, h) ((4 + (b) * 2 + (h)) * HTB)
#define PG8_STAGE(bufoff, gbase, voff) do { _Pragma("unroll") for (int _i = 0; _i < 2; ++_i) \
        __builtin_amdgcn_global_load_lds((const unsigned*)((const char*)(gbase) + (voff)[_i]), (PG8_LAS unsigned*)(lds + (bufoff) + ldsw + _i * 8192), 16, 0, 0); } while (0)
#define PG8_LDA(dst, b, h) do { _Pragma("unroll") for (int m = 0; m < 4; ++m) _Pragma("unroll") for (int k = 0; k < 2; ++k) dst[m][k] = *(const PG8_LAS bf16x8*)(lds + PG8_SA(b, h) + aoff + m * 2048 + k * 1024); } while (0)
#define PG8_LDB(dst, b, h) do { _Pragma("unroll") for (int n = 0; n < 2; ++n) _Pragma("unroll") for (int k = 0; k < 2; ++k) dst[n][k] = *(const PG8_LAS bf16x8*)(lds + PG8_SB(b, h) + boff + n * 2048 + k * 1024); } while (0)
#define PG8_MMA(ai, bj, At, Bt) do { __builtin_amdgcn_s_setprio(1); _Pragma("unroll") for (int m = 0; m < 4; ++m) _Pragma("unroll") for (int n = 0; n < 2; ++n) _Pragma("unroll") for (int k = 0; k < 2; ++k) \
        acc[ai][bj][m][n] = __builtin_amdgcn_mfma_f32_16x16x32_bf16(Bt[n][k], At[m][k], acc[ai][bj][m][n], 0, 0, 0); __builtin_amdgcn_s_setprio(0); } while (0)
#define PG8_WAIT_V(n) asm volatile("s_waitcnt vmcnt(" #n ")" ::: "memory")
#define PG8_WAIT_L(n) asm volatile("s_waitcnt lgkmcnt(" #n ")" ::: "memory")
#define PG8_BAR __builtin_amdgcn_s_barrier()
#define PG8_SCHED __builtin_amdgcn_sched_barrier(0)
    Unit cur, nxt; int ui = 0;
    if (!S.next(0, cur)) return;
    f32x4 acc[2][2][4][2];
#pragma unroll
    for (int a = 0; a < 2; ++a)
#pragma unroll
        for (int b = 0; b < 2; ++b)
#pragma unroll
            for (int m = 0; m < 4; ++m)
#pragma unroll
                for (int n = 0; n < 2; ++n) acc[a][b][m][n] = (f32x4){0.f, 0.f, 0.f, 0.f};
    bf16x8 At[4][2], B0[2][2], B1[2][2];
    const char* cA = (const char*)g.A + (size_t)cur.pm * tstep; const char* cB = (const char*)g.Bt + (size_t)cur.pn * tstep;
    S.a_ready(cur);
    if constexpr (SP2) {
        PG8_STAGE(PG8_SB(0, 0), cB, voffB); PG8_STAGE(PG8_SB(0, 1), cB + hstep, voffB); PG8_STAGE(PG8_SA(0, 0), cA, voffA); PG8_STAGE(PG8_SA(0, 1), cA + hstep, voffA);
        if (wr == 1) PG8_BAR;
        PG8_WAIT_V(2); PG8_BAR;
        PG8_STAGE(PG8_SB(1, 0), cB + kstep, voffB); PG8_STAGE(PG8_SA(1, 0), cA + kstep, voffA); PG8_STAGE(PG8_SB(1, 1), cB + hstep + kstep, voffB);
        PG8_WAIT_V(6); PG8_BAR;
    } else {
        PG8_STAGE(PG8_SB(0, 0), cB, voffB); PG8_STAGE(PG8_SA(0, 0), cA, voffA); PG8_STAGE(PG8_SB(0, 1), cB + hstep, voffB); PG8_STAGE(PG8_SA(0, 1), cA + hstep, voffA);
        if (wr == 1) PG8_BAR;
        PG8_WAIT_V(4); PG8_BAR;
        PG8_STAGE(PG8_SB(1, 0), cB + kstep, voffB); PG8_STAGE(PG8_SA(1, 0), cA + kstep, voffA); PG8_STAGE(PG8_SB(1, 1), cB + hstep + kstep, voffB);
        PG8_WAIT_V(6); PG8_BAR;
    }
    for (;;) {
        const bool has_next = S.next(ui + 1, nxt);
        const char* nA = has_next ? (const char*)g.A + (size_t)nxt.pm * tstep : cA; const char* nB = has_next ? (const char*)g.Bt + (size_t)nxt.pn * tstep : cB;
        for (int t = 0; t < nt; t += 2) {
            const bool last = (t == nt - 2);
            const char* a1 = cA + (size_t)(t + 1) * kstep;
            const char* a2 = last ? nA : cA + (size_t)(t + 2) * kstep; const char* b2 = last ? nB : cB + (size_t)(t + 2) * kstep;
            const char* a3 = a2 + kstep; const char* b3 = b2 + kstep;
            if (last && has_next) S.a_ready(nxt);
            if constexpr (SP2) {
            PG8_LDB(B0, 0, 0); PG8_LDB(B1, 0, 1); PG8_SCHED; PG8_LDA(At, 0, 0); PG8_STAGE(PG8_SA(1, 1), a1 + hstep, voffA);
            PG8_WAIT_V(8); PG8_WAIT_L(0); PG8_BAR; PG8_MMA(0, 0, At, B0); PG8_MMA(0, 1, At, B1); PG8_BAR; PG8_SCHED;
            PG8_LDA(At, 0, 1); PG8_STAGE(PG8_SB(0, 0), b2, voffB); PG8_STAGE(PG8_SB(0, 1), b2 + hstep, voffB); PG8_STAGE(PG8_SA(0, 0), a2, voffA);
            PG8_WAIT_V(8); PG8_WAIT_L(0); PG8_BAR; PG8_MMA(1, 0, At, B0); PG8_MMA(1, 1, At, B1); PG8_BAR; PG8_SCHED;
            PG8_LDB(B0, 1, 0); PG8_LDB(B1, 1, 1); PG8_SCHED; PG8_LDA(At, 1, 0); PG8_STAGE(PG8_SA(0, 1), a2 + hstep, voffA);
            PG8_WAIT_V(8); PG8_WAIT_L(0); PG8_BAR; PG8_MMA(0, 0, At, B0); PG8_MMA(0, 1, At, B1); PG8_BAR; PG8_SCHED;
            PG8_LDA(At, 1, 1); PG8_STAGE(PG8_SB(1, 0), b3, voffB); PG8_STAGE(PG8_SB(1, 1), b3 + hstep, voffB); PG8_STAGE(PG8_SA(1, 0), a3, voffA);
            PG8_WAIT_V(8); PG8_WAIT_L(0); PG8_BAR; PG8_MMA(1, 0, At, B0); PG8_MMA(1, 1, At, B1); PG8_BAR; PG8_SCHED;
            } else {
            PG8_LDB(B0, 0, 0); PG8_SCHED; PG8_LDA(At, 0, 0); PG8_STAGE(PG8_SA(1, 1), a1 + hstep, voffA);
            PG8_WAIT_L(8); PG8_BAR; PG8_WAIT_L(0); PG8_MMA(0, 0, At, B0); PG8_BAR; PG8_SCHED;
            PG8_LDB(B1, 0, 1); PG8_STAGE(PG8_SB(0, 0), b2, voffB);
            PG8_BAR; PG8_WAIT_L(0); PG8_MMA(0, 1, At, B1); PG8_BAR;
            PG8_LDA(At, 0, 1); PG8_STAGE(PG8_SA(0, 0), a2, voffA);
            PG8_BAR; PG8_WAIT_L(0); PG8_MMA(1, 0, At, B0); PG8_BAR; PG8_SCHED;
            PG8_STAGE(PG8_SB(0, 1), b2 + hstep, voffB);
            PG8_WAIT_V(6); PG8_BAR; PG8_MMA(1, 1, At, B1); PG8_BAR;
            PG8_LDB(B0, 1, 0); PG8_SCHED; PG8_LDA(At, 1, 0); PG8_STAGE(PG8_SA(0, 1), a2 + hstep, voffA);
            PG8_WAIT_L(8); PG8_BAR; PG8_WAIT_L(0); PG8_MMA(0, 0, At, B0); PG8_BAR; PG8_SCHED;
            PG8_LDB(B1, 1, 1); PG8_STAGE(PG8_SB(1, 0), b3, voffB);
            PG8_BAR; PG8_WAIT_L(0); PG8_MMA(0, 1, At, B1); PG8_BAR;
            PG8_LDA(At, 1, 1); PG8_STAGE(PG8_SA(1, 0), a3, voffA);
            PG8_BAR; PG8_WAIT_L(0); PG8_MMA(1, 0, At, B0); PG8_BAR; PG8_SCHED;
            PG8_STAGE(PG8_SB(1, 1), b3 + hstep, voffB);
            PG8_WAIT_V(6); PG8_BAR; PG8_MMA(1, 1, At, B1); PG8_BAR;
            }
        }
        if constexpr (ALIGN_EPI) { if (wr == 0) PG8_BAR; }
        if constexpr (!Epi::AFTER_DRAIN) { E(acc, cur, wr, wc, fr, fq); S.done(cur); }
        if (!has_next) break;
#pragma unroll
        for (int a = 0; a < 2; ++a)
#pragma unroll
            for (int b = 0; b < 2; ++b)
#pragma unroll
                for (int m = 0; m < 4; ++m)
#pragma unroll
                    for (int n = 0; n < 2; ++n) acc[a][b][m][n] = (f32x4){0.f, 0.f, 0.f, 0.f};
        cur = nxt; cA = nA; cB = nB; ++ui;
        if constexpr (ALIGN_EPI) { if (wr == 1) PG8_BAR; }
    }
    PG8_WAIT_V(0);
    if constexpr (!ALIGN_EPI) { if (wr == 0) PG8_BAR; }
    PG8_BAR;
    if constexpr (Epi::AFTER_DRAIN) { E.fused(acc, cur, wr, wc, fr, fq, lds, wid, lane); S.done(cur); }
#undef PG8_SA
#undef PG8_SB
#undef PG8_STAGE
#undef PG8_LDA
#undef PG8_LDB
#undef PG8_MMA
#undef PG8_WAIT_V
#undef PG8_WAIT_L
#undef PG8_BAR
#undef PG8_SCHED
}
}
namespace fox {
constexpr int D = 128, PITCH = 8192, OPITCH = 2048, SKV = 8192, GATE_OFF = 3072;
constexpr float THR = 8.f;
constexpr float SCALE = 0.08838834764831845f;
constexpr int NW = 8, QBLK = 32, KVBLK = 64, QB = NW * QBLK;
constexpr int SHM_V = KVBLK * D * 2, SHM_K = KVBLK * D * 2;
constexpr int BIAS_OFF = 2 * SHM_V + 2 * SHM_K + NW * 64 * 4;
constexpr int LDS_BYTES = BIAS_OFF + SKV * 4;

using bf16 = __hip_bfloat16;
typedef short bf16x8 __attribute__((ext_vector_type(8)));
typedef short s16x4 __attribute__((ext_vector_type(4)));
typedef float f32x16 __attribute__((ext_vector_type(16)));
typedef float f32x4 __attribute__((ext_vector_type(4)));
typedef unsigned u32x4 __attribute__((ext_vector_type(4)));

#define KSWZ(row, colB) ((row) * 256 + ((colB) ^ (((row) & 7) << 4)))
#define SBAR() __builtin_amdgcn_sched_barrier(0)
__device__ __forceinline__ int v_st(int k, int c) { const int kk = (k & ~0xC) | ((k & 4) << 1) | ((k & 8) >> 1); return ((kk >> 3) * 4 + (c >> 5)) * 512 + ((kk & 7) * 32 + (c & 31)) * 2; }
__device__ __forceinline__ int v_rd_base(int lane) { return ((lane & 3) << 3) | (((lane >> 2) & 3) << 6) | (((lane >> 4) & 1) << 5) | (((lane >> 5) & 1) << 8); }
constexpr int v_rd_off(int d0, int ks, int half) { return d0 * 512 + ks * 4096 + half * 2048; }
__device__ __forceinline__ int crow(int r, int hi) { return (r & 3) + 8 * (r >> 2) + 4 * hi; }
__device__ __forceinline__ unsigned cvtpk(float lo, float hi) {
    unsigned r; asm volatile("v_cvt_pk_bf16_f32 %0, %1, %2" : "=v"(r) : "v"(lo), "v"(hi)); return r;
}
__device__ __forceinline__ bf16x8 load8(const bf16* p) { return *reinterpret_cast<const bf16x8*>(p); }
__device__ __forceinline__ void mask_tile(f32x16& p0, f32x16& p1, int dq, unsigned W) {
    const float NEG = -__builtin_inff();
#pragma unroll
    for (int r = 0; r < 16; ++r) {
        const int c = (r & 3) + 8 * (r >> 2);
        if ((unsigned)(dq - c) >= W) p0[r] = NEG;
        if ((unsigned)(dq - c - 32) >= W) p1[r] = NEG;
    }
}
__device__ __forceinline__ void partialSM(f32x16& p0, f32x16& p1, float& m_reg, float& mn, float& alpha) {
    float pmax = p0[0]; for (int r = 1; r < 16; ++r) pmax = fmaxf(pmax, p0[r]); for (int r = 0; r < 16; ++r) pmax = fmaxf(pmax, p1[r]);
    { auto rr = __builtin_amdgcn_permlane32_swap(__float_as_uint(pmax), __float_as_uint(pmax), false, false);
      pmax = fmaxf(__uint_as_float(rr[0]), __uint_as_float(rr[1])); }
    constexpr float C2 = 1.4426950408889634f * SCALE;
    if (__builtin_expect(__all((pmax - m_reg) * SCALE <= THR), 1)) { mn = m_reg; alpha = 1.f; }
    else { mn = fmaxf(m_reg, pmax); alpha = __builtin_amdgcn_exp2f((m_reg - mn) * C2); m_reg = mn; }
    const float mnL = -mn * C2;
    for (int r = 0; r < 16; ++r) p0[r] = fmaf(p0[r], C2, mnL); for (int r = 0; r < 16; ++r) p1[r] = fmaf(p1[r], C2, mnL);
    for (int r = 0; r < 16; ++r) p0[r] = __builtin_amdgcn_exp2f(p0[r]);
}
__device__ __forceinline__ void finishSM(f32x16& p0, f32x16& p1, float alpha, float& l_reg, bf16x8& pa0, bf16x8& pa1, bf16x8& pa2, bf16x8& pa3) {
    for (int r = 0; r < 16; ++r) p1[r] = __builtin_amdgcn_exp2f(p1[r]);
    float ps = 0; for (int r = 0; r < 16; ++r) ps += p0[r]; for (int r = 0; r < 16; ++r) ps += p1[r];
    { auto rr = __builtin_amdgcn_permlane32_swap(__float_as_uint(ps), __float_as_uint(ps), false, false);
      ps = __uint_as_float(rr[0]) + __uint_as_float(rr[1]); }
    l_reg = l_reg * alpha + ps;
#define PK4(P, B_, OUT) do { unsigned a0 = cvtpk(P[B_+0], P[B_+1]), a1 = cvtpk(P[B_+2], P[B_+3]);                          \
        unsigned b0 = cvtpk(P[B_+4], P[B_+5]), b1 = cvtpk(P[B_+6], P[B_+7]);                                             \
        auto r0 = __builtin_amdgcn_permlane32_swap(a0, b0, false, false); auto r1 = __builtin_amdgcn_permlane32_swap(a1, b1, false, false); \
        u32x4 w = {r0[0], r1[0], r0[1], r1[1]}; OUT = *reinterpret_cast<bf16x8*>(&w); } while (0)
    PK4(p0, 0, pa0); PK4(p0, 8, pa1); PK4(p1, 0, pa2); PK4(p1, 8, pa3);
#undef PK4
}
template <int KB>
__device__ __forceinline__ void qkt(f32x16& p0, f32x16& p1, const char* K_lds, const float* bt, int r32, int hi, const bf16x8* qr) {
#pragma unroll
    for (int j = 0; j < 4; ++j) { const f32x4 a = *(const f32x4*)(bt + 8 * j), b = *(const f32x4*)(bt + 32 + 8 * j);
        p0[4 * j + 0] = a[0]; p0[4 * j + 1] = a[1]; p0[4 * j + 2] = a[2]; p0[4 * j + 3] = a[3];
        p1[4 * j + 0] = b[0]; p1[4 * j + 1] = b[1]; p1[4 * j + 2] = b[2]; p1[4 * j + 3] = b[3]; }
    const char* kb[4];
#pragma unroll
    for (int dd = 0; dd < 4; ++dd) kb[dd] = K_lds + KB * SHM_K + KSWZ(r32, (dd * 16 + hi * 8) * 2);
#pragma unroll
    for (int d0 = 0; d0 < 8; ++d0) { const char* a = kb[d0 & 3] + (d0 >> 2) * 128;
        bf16x8 b0 = *reinterpret_cast<const bf16x8*>(a);
        bf16x8 b1 = *reinterpret_cast<const bf16x8*>(a + 32 * 256);
        p0 = __builtin_amdgcn_mfma_f32_32x32x16_bf16(b0, qr[d0], p0, 0, 0, 0);
        p1 = __builtin_amdgcn_mfma_f32_32x32x16_bf16(b1, qr[d0], p1, 0, 0, 0); }
}
template <int VB>
__device__ __forceinline__ void pv_tile(f32x16* o, int vb0, bf16x8 pa0, bf16x8 pa1, bf16x8 pa2, bf16x8 pa3) {
#define TRRD(dst, off) asm volatile("ds_read_b64_tr_b16 %0, %1 offset:%2" : "=&v"(dst) : "v"(vb0), "i"(off) : "memory")
#define PV_D0(d0) do { s16x4 l0, l1, l2, l3, h0, h1, h2, h3; constexpr int b_ = VB * SHM_V + v_rd_off(d0, 0, 0);     \
        TRRD(l0, b_); TRRD(h0, b_ + 2048); TRRD(l1, b_ + 4096); TRRD(h1, b_ + 6144); TRRD(l2, b_ + 8192); TRRD(h2, b_ + 10240); TRRD(l3, b_ + 12288); TRRD(h3, b_ + 14336); \
        asm volatile("s_waitcnt lgkmcnt(0)" ::: "memory"); SBAR();                 \
        o[d0] = __builtin_amdgcn_mfma_f32_32x32x16_bf16(pa0, (bf16x8){l0[0], l0[1], l0[2], l0[3], h0[0], h0[1], h0[2], h0[3]}, o[d0], 0, 0, 0);   \
        o[d0] = __builtin_amdgcn_mfma_f32_32x32x16_bf16(pa1, (bf16x8){l1[0], l1[1], l1[2], l1[3], h1[0], h1[1], h1[2], h1[3]}, o[d0], 0, 0, 0);   \
        o[d0] = __builtin_amdgcn_mfma_f32_32x32x16_bf16(pa2, (bf16x8){l2[0], l2[1], l2[2], l2[3], h2[0], h2[1], h2[2], h2[3]}, o[d0], 0, 0, 0);   \
        o[d0] = __builtin_amdgcn_mfma_f32_32x32x16_bf16(pa3, (bf16x8){l3[0], l3[1], l3[2], l3[3], h3[0], h3[1], h3[2], h3[3]}, o[d0], 0, 0, 0); } while (0)
    PV_D0(0); PV_D0(1); PV_D0(2); PV_D0(3);
#undef PV_D0
#undef TRRD
}

struct BlockRef { const bf16* Q; const bf16* K; const bf16* V; bf16* O; const float* Bias; int P0; float THp; };
struct Seam { bf16x8 qr[8]; bf16x8 st_v0, st_v1, st_k0, st_k1; };
#define ROW(p, k0, rr) ((const bf16*)((const char*)(p) + (size_t)(k0) * (PITCH * 2) + (unsigned)(voff + (unsigned)(rr) * (PITCH * 2u))))
#define VMW() asm volatile("s_waitcnt vmcnt(0)" ::: "memory")
#define VMWN(n) asm volatile("s_waitcnt vmcnt(%0)" :: "i"(n) : "memory")
#define SLOAD_H(Kp, Vp, k0) do { S.st_v0 = load8(ROW(Vp, k0, 0)); S.st_v1 = load8(ROW(Vp, k0, 32));              \
                         S.st_k0 = load8(ROW(Kp, k0, 0)); S.st_k1 = load8(ROW(Kp, k0, 32)); } while (0)
#define SWRITE_HK(bf) do { *(bf16x8*)(K_lds + (bf) * SHM_K + kws) = S.st_k0; *(bf16x8*)(K_lds + (bf) * SHM_K + kws + 32 * 256) = S.st_k1; } while (0)
#define SWRITE_HV(bf) do { *(bf16x8*)(V_lds + (bf) * SHM_V + vst0) = S.st_v0; *(bf16x8*)(V_lds + (bf) * SHM_V + vst1) = S.st_v1; } while (0)
#define SWRITE_H(bf) do { SWRITE_HV(bf); SWRITE_HK(bf); } while (0)
__device__ __forceinline__ void fox_prime(const BlockRef& cur, char* lds, Seam& S, const int tid) {
    const int wid = __builtin_amdgcn_readfirstlane(tid >> 6), lane = tid & 63, r32 = lane & 31, hi = lane >> 5;
    const int sr = tid >> 4, sc = (tid & 15) * 8, kws = KSWZ(sr, sc * 2); char* K_lds = lds + 2 * SHM_V;
    const unsigned voff = (unsigned)(sr * PITCH + sc) * 2u, qoff = (unsigned)((wid * QBLK + r32) * PITCH + hi * 8) * 2u;
    for (int d0 = 0; d0 < 8; ++d0) S.qr[d0] = load8((const bf16*)((const char*)cur.Q + (qoff + d0 * 32)));
    (void)kws; (void)K_lds; (void)voff;
    __syncthreads();
}
__device__ __forceinline__ void fox_block(const BlockRef& cur, const BlockRef& nxt, char* lds, Seam& S, const int tid) {
    const int wid = __builtin_amdgcn_readfirstlane(tid >> 6), lane = tid & 63, r32 = lane & 31, hi = lane >> 5;
    const int W = SKV;
    const int NTF = (cur.P0 + QB - 1) / KVBLK + 1;
    const int qlo = cur.P0 + wid * QBLK, qm = qlo + r32 - 4 * hi;
    char* V_lds = lds; char* K_lds = lds + 2 * SHM_V;
    float* ws = (float*)(lds + 2 * SHM_V + 2 * SHM_K) + wid * 64; float* li_l = ws, * al_l = ws + 32;
    float* biasL = (float*)(lds + BIAS_OFF);
    { const int nk = cur.P0 + QB;
      int t4 = tid * 4; asm volatile("" : "+v"(t4));
      f32x4 bv[4];
#pragma unroll
      for (int k = 0; k < 4; ++k) { const int i = t4 + k * (NW * 64 * 4); if (i < nk) bv[k] = *(const f32x4*)((const char*)cur.Bias + (unsigned)(i * 4)); }
#pragma unroll
      for (int k = 0; k < 4; ++k) { const int i = t4 + k * (NW * 64 * 4); if (i < nk) *(f32x4*)(biasL + i) = bv[k]; }
      __syncthreads(); }
    int j_lo; { int lo_ = 0, hi_ = cur.P0 / KVBLK; const float bref = biasL[cur.P0] - cur.THp;
        while (lo_ < hi_) { const int mid = (lo_ + hi_) >> 1; if (biasL[mid * KVBLK + KVBLK - 1] < bref) lo_ = mid + 1; else hi_ = mid; }
        j_lo = __builtin_amdgcn_readfirstlane(lo_); }
    const int NT = NTF - j_lo;
    const float* bl = biasL + 4 * hi;
    float m_reg = -1e30f, l_reg = 0; f32x16 o[4] = {};
    const int sr = tid >> 4, sc = (tid & 15) * 8, vst0 = v_st(sr, sc), vst1 = v_st(32 + sr, sc), kws = KSWZ(sr, sc * 2);
    const unsigned voff = (unsigned)(sr * PITCH + sc) * 2u, qoff = (unsigned)((wid * QBLK + r32) * PITCH + hi * 8) * 2u;
    const int vb0 = (int)(uintptr_t)V_lds + v_rd_base(lane);
    const bf16* Kh = cur.K; const bf16* Vh = cur.V;
#define RESC(a) do { if (__any((a) < 1.f)) { if (hi == 0) al_l[r32] = (a); asm volatile("s_waitcnt lgkmcnt(0)" ::: "memory");              \
                     for (int d_ = 0; d_ < 4; ++d_) for (int r = 0; r < 16; ++r) o[d_][r] *= al_l[crow(r, hi)]; } } while (0)
#define KBASE(t) ((j_lo + (NT - 1 - (t))) * KVBLK)
#define MASKT(P0_, P1_, t) do { const int kb_ = KBASE(t); if (kb_ + KVBLK - 1 > qlo) mask_tile(P0_, P1_, qm - kb_, (unsigned)W); } while (0)
    constexpr int NQL = 8;
#define SEAM_K0() do { VMWN(NQL); SWRITE_HK(0); SBAR(); } while (0)
    f32x16 pA0, pA1, pB0, pB1; float mnA, mnB, alA, alB; bf16x8 pa0, pa1, pa2, pa3;
    SLOAD_H(Kh, Vh, KBASE(0)); VMW(); SWRITE_HK(0); SWRITE_HV(0); __syncthreads();
    SBAR();
    if (NT > 1) { SLOAD_H(Kh, Vh, KBASE(1)); }
    SBAR(); qkt<0>(pA0, pA1, K_lds, bl + KBASE(0), r32, hi, S.qr);
    MASKT(pA0, pA1, 0); partialSM(pA0, pA1, m_reg, mnA, alA);
    if (NT > 1) { VMW(); SWRITE_H(1); }
    __syncthreads();
#define HALF_STEP(PX0, PX1, mnX, alX, PY0, PY1, alY, t, KB, VB, SB) do {                                                      \
        SBAR(); qkt<KB>(PX0, PX1, K_lds, bl + KBASE(t), r32, hi, S.qr);                                             \
        finishSM(PY0, PY1, alY, l_reg, pa0, pa1, pa2, pa3); SBAR();                                                           \
        if ((t) + 1 < NT) { SLOAD_H(Kh, Vh, KBASE((t) + 1)); SBAR(); }                                               \
        pv_tile<VB>(o, vb0, pa0, pa1, pa2, pa3); MASKT(PX0, PX1, (t)); partialSM(PX0, PX1, m_reg, mnX, alX);                                        \
        __syncthreads();                                                                                                      \
        if ((t) + 1 < NT) { VMW(); SWRITE_H(SB); }                                                                          \
        RESC(alX); __syncthreads(); } while (0)
    for (int t = 1; t + 1 < NT; t += 2) {
        HALF_STEP(pB0, pB1, mnB, alB, pA0, pA1, alA, t, 1, 0, 0);
        HALF_STEP(pA0, pA1, mnA, alA, pB0, pB1, alB, t + 1, 0, 1, 1);
    }
    const bool even = (NT & 1) == 0;
    if (even) { SBAR(); qkt<1>(pB0, pB1, K_lds, bl + KBASE(NT - 1), r32, hi, S.qr); SBAR(); }
#pragma unroll
    for (int d0 = 0; d0 < 8; ++d0) S.qr[d0] = load8((const bf16*)((const char*)nxt.Q + (qoff + d0 * 32)));
    SBAR();
    finishSM(pA0, pA1, alA, l_reg, pa0, pa1, pa2, pa3); SBAR();
    pv_tile<0>(o, vb0, pa0, pa1, pa2, pa3);
    if (even) { MASKT(pB0, pB1, NT - 1); partialSM(pB0, pB1, m_reg, mnB, alB); __syncthreads(); RESC(alB);
        finishSM(pB0, pB1, alB, l_reg, pa0, pa1, pa2, pa3); SBAR(); pv_tile<1>(o, vb0, pa0, pa1, pa2, pa3); }
    SBAR();
    if (hi == 0) li_l[r32] = l_reg; asm volatile("s_waitcnt lgkmcnt(0)" ::: "memory");
    float rli[16];
#pragma unroll
    for (int r = 0; r < 16; ++r) rli[r] = __builtin_amdgcn_rcpf(li_l[crow(r, hi)]);
    char* Ow = (char*)cur.O; const unsigned ooff = (unsigned)((wid * QBLK + 4 * hi) * OPITCH + r32) * 2u;
    const char* Gq = (const char*)cur.Q + GATE_OFF * 2; const unsigned goff = (unsigned)((wid * QBLK + 4 * hi) * PITCH + r32) * 2u;
    unsigned short gq[16][4];
#pragma unroll
    for (int r = 0; r < 16; ++r)
#pragma unroll
        for (int d0 = 0; d0 < 4; ++d0) gq[r][d0] = *(const unsigned short*)(Gq + (goff + (unsigned)(((r & 3) + 8 * (r >> 2)) * PITCH + d0 * 32) * 2u));
#pragma unroll
    for (int r = 0; r < 16; ++r) {
#pragma unroll
        for (int d0 = 0; d0 < 4; ++d0) { const unsigned short gw = gq[r][d0];
            const float gl = __builtin_bit_cast(float, (unsigned)gw << 16);
            const float v = o[d0][r] * rli[r] * __builtin_amdgcn_rcpf(1.0f + __builtin_amdgcn_exp2f(-1.4426950408889634f * gl));
            const float vn = xor1_get(v);
            if ((r32 & 1) == 0) *(unsigned*)(Ow + (ooff + (unsigned)(((r & 3) + 8 * (r >> 2)) * OPITCH + d0 * 32) * 2u)) = cvtpk(v, vn); } }
    __syncthreads();
#undef RESC
#undef KBASE
#undef MASKT
#undef SEAM_K0
#undef HALF_STEP
}
#undef ROW
#undef VMW
#undef VMWN
#undef SLOAD_H
#undef SWRITE_HK
#undef SWRITE_HV
#undef SWRITE_H
#undef KSWZ
#undef SBAR
}

constexpr int NWAVES = 8, NTHREADS = NWAVES * 64;
constexpr int DM = 2048, BATCH = 2, T = 8192, M = BATCH * T, DEPTH = 4;
constexpr int AB_IN = 8200, AB_N = 8192;
constexpr int C_IN = 6160, C_N = 6144;
constexpr int FF = 5632, FF2 = 2 * FF;
constexpr float EPS = 1e-6f;
enum PhaseKind { K_NORM1 = 0, K_MIXIN, K_PREP, K_REC, K_POST, K_MIXOUT, K_NORM2, K_FFIN, K_FFOUT, K_PRO };
constexpr int phase_base(int layer) { return 1 + 9 * layer; }
constexpr int N_PHASES = phase_base(DEPTH) + 1;
constexpr int CW_QUEUE = 8192;
inline int phase_kind(int p, int& layer) { if (p == 0) { layer = 0; return K_PRO; } for (layer = DEPTH - 1; phase_base(layer) > p; --layer) {} return p - phase_base(layer); }
constexpr size_t MiB = 1u << 20;
constexpr size_t WS_CTL = 0, CTL_ZERO_BYTES = 1 * MiB;
constexpr size_t WS_MOD = 1 * MiB;
constexpr size_t WS_LOGF = 2 * MiB;
constexpr size_t WS_BIAS = 3 * MiB;
constexpr size_t WS_GLOW = 4 * MiB;
constexpr size_t WS_W_ABIN = 8 * MiB, WS_W_ABOUT = 72 * MiB, WS_W_GLIN = 88 * MiB, WS_W_GLOUT = 136 * MiB, WS_W_FFIN = 152 * MiB, WS_W_FFOUT = 328 * MiB;
constexpr size_t WS_H = 416 * MiB, WS_CAT = 480 * MiB, WS_PROJ = 544 * MiB, WS_FFH = WS_PROJ, WS_O = 800 * MiB, WS_REC = 928 * MiB, WS_Y = 1064 * MiB, WS_XB = 1128 * MiB, WS_END = 1192 * MiB;
constexpr int CW_BAR = 4096;
constexpr int RING_OFF = 0, RING_BYTES = 139264;
constexpr int LDSCTL_OFF = RING_BYTES, MISC_OFF = LDSCTL_OFF + 320;
constexpr int LDS_BYTES = 155648;
static_assert(fox::LDS_BYTES <= RING_BYTES, "attention LDS");

#define GAS __attribute__((address_space(1)))
#define LAS __attribute__((address_space(3)))
typedef unsigned short bf16;
typedef unsigned v4u __attribute__((ext_vector_type(4)));
typedef unsigned v2u __attribute__((ext_vector_type(2)));
typedef float f32x4 __attribute__((ext_vector_type(4)));
typedef GAS unsigned gu32;
#define RLX_AGENT __ATOMIC_RELAXED, __HIP_MEMORY_SCOPE_AGENT
#define LDS_WAIT() asm volatile("s_waitcnt lgkmcnt(0)" ::: "memory")
__device__ __forceinline__ unsigned pk2(float lo, float hi) { unsigned r; asm("v_cvt_pk_bf16_f32 %0, %1, %2" : "=v"(r) : "v"(lo), "v"(hi)); return r; }
__device__ __forceinline__ unsigned f2bf(float f) { return pk2(f, f) & 0xffffu; }
__device__ __forceinline__ float bf_lo(unsigned w) { return __builtin_bit_cast(float, w << 16); }
__device__ __forceinline__ float bf_hi(unsigned w) { return __builtin_bit_cast(float, w & 0xffff0000u); }
__device__ __forceinline__ float bf1(bf16 h) { return __builtin_bit_cast(float, (unsigned)h << 16); }
__device__ __forceinline__ float sigmoid_f(float x) { return __builtin_amdgcn_rcpf(1.0f + __expf(-x)); }
__device__ __forceinline__ float silu_x(float x) { return x * __builtin_amdgcn_rcpf(1.0f + __expf(-x)); }
__device__ __forceinline__ float log_sigmoid_f(float x) { return fminf(x, 0.f) - log1pf(__expf(-fabsf(x))); }
__device__ __forceinline__ float log_sigmoid_fast(float x) { return fminf(x, 0.f) - __logf(1.0f + __expf(-fabsf(x))); }
__device__ __forceinline__ float wave_sum(float v) {
    v = xsum<1>(v); v = xsum<2>(v); v = xsum<4>(v); v = xsum<8>(v); v = xsum<16>(v); v = xsum<32>(v);
    return v;
}

#define XB_TMO      128
#define XB_XCNT(j)  (256  + 64 * (j))
#define XB_XSUB(j)  (1280 + 64 * (j))
#define XB_XGEN(j)  (2304 + 64 * (j))
#define XB_TOP      3328
#define XB_TOPGEN   3392
#define XCD_BAR_WORDS 3456
#define XB_SPIN_CAP (1u << 18)
__device__ __forceinline__ unsigned xb_ld(unsigned* p)              { return __hip_atomic_load(p, __ATOMIC_RELAXED, __HIP_MEMORY_SCOPE_AGENT); }
__device__ __forceinline__ unsigned xb_add(unsigned* p, unsigned v) { return __hip_atomic_fetch_add(p, v, __ATOMIC_RELAXED, __HIP_MEMORY_SCOPE_AGENT); }
__device__ __forceinline__ unsigned xb_xcc_id() { return (unsigned)__builtin_amdgcn_s_getreg((3 << 11) | 20) & 0xFu; }
#define XB_SPIN(cond, bar) do { unsigned _sp = 0; while (cond) { __builtin_amdgcn_s_sleep(1); \
    if ((++_sp & 255u) == 0u) { if (xb_ld(&(bar)[XB_TMO])) break; if (_sp > XB_SPIN_CAP) { atomicAdd(&(bar)[XB_TMO], 1u); break; } } } } while (0)
struct XcdBarrier { unsigned* bar; unsigned x; volatile LAS unsigned* st; };
__device__ __forceinline__ XcdBarrier xcd_barrier_post(unsigned* bar, volatile LAS unsigned* st, bool tid0) {
    XcdBarrier b; b.bar = bar; b.x = xb_xcc_id(); b.st = st;
    if (tid0) (void)xb_add(&bar[XB_XCNT(b.x)], 1u);
    return b;
}
__device__ __forceinline__ void xcd_barrier_complete(unsigned* bar, unsigned x, unsigned& nloc, unsigned& nx) {
    const unsigned G = gridDim.x * gridDim.y * gridDim.z;
    unsigned sum, cnt, mine, sp = 0u;
    for (;;) {
        sum = 0u; cnt = 0u; mine = 0u;
#pragma unroll
        for (unsigned j = 0; j < 16; ++j) { const unsigned c = xb_ld(&bar[XB_XCNT(j)]); sum += c; cnt += (c > 0u) ? 1u : 0u; mine = (j == x) ? c : mine; }
        if (sum == G) break;
        __builtin_amdgcn_s_sleep(1);
        if ((++sp & 255u) == 0u) { if (xb_ld(&bar[XB_TMO])) break; if (sp > XB_SPIN_CAP) { atomicAdd(&bar[XB_TMO], 1u); break; } }
    }
    nloc = mine > 0u ? mine : 1u; nx = cnt > 0u ? cnt : 1u;
}
template <bool FIRST>
__device__ __forceinline__ void xcd_barrier(const XcdBarrier& b, bool tid0) {
    asm volatile("s_waitcnt vmcnt(0)" ::: "memory");
    __syncthreads();
    if (tid0) {
        unsigned* bar = b.bar;
        __builtin_amdgcn_s_waitcnt(0);
        unsigned nloc = b.st[0], nx = b.st[1];
        if (FIRST) { if (nloc == 0u) { xcd_barrier_complete(bar, b.x, nloc, nx); b.st[0] = nloc; b.st[1] = nx; } }
        else { if (nloc == 0u) nloc = 1u; if (nx == 0u) nx = 1u; }
        const unsigned old = xb_add(&bar[XB_XSUB(b.x)], 1u);
        const unsigned gen = old / nloc;
        if (old + 1u == (gen + 1u) * nloc) {
            __builtin_amdgcn_fence(__ATOMIC_RELEASE, "agent");
            asm volatile("s_waitcnt vmcnt(0)" ::: "memory");
            const unsigned og = xb_add(&bar[XB_TOP], 1u);
            const unsigned tg = og / nx;
            if (og + 1u == (tg + 1u) * nx) xb_add(&bar[XB_TOPGEN], 1u);
            else XB_SPIN(xb_ld(&bar[XB_TOPGEN]) == tg, bar);
            __builtin_amdgcn_fence(__ATOMIC_ACQUIRE, "agent");
            xb_add(&bar[XB_XGEN(b.x)], 1u);
            asm volatile("s_waitcnt vmcnt(0)" ::: "memory");
        } else {
            XB_SPIN(xb_ld(&bar[XB_XGEN(b.x)]) == gen, bar);
            __builtin_amdgcn_fence(__ATOMIC_ACQUIRE, "agent");
            asm volatile("s_waitcnt vmcnt(0)" ::: "memory");
        }
    }
    __syncthreads();
}

struct Args { const float* in[20]; float* out; unsigned char* ws; int ph_lo, ph_hi, use_bar, pad; };
typedef const Args __attribute__((address_space(4))) CArgs;
__device__ __forceinline__ CArgs* opq_args() { CArgs* p = (CArgs*)__builtin_amdgcn_kernarg_segment_ptr(); asm volatile("" : "+s"(p)); return p; }
struct Frame {
    LAS unsigned char* lds;
    int tid, lane, wave, G, bid;
};

__device__ __forceinline__ void transpose_item(const float* W, int ldn, int K, bf16* WT, int k0, int n0, int drow0, LAS float* scr, int lane) {
    f32x4 v[16];
    const float* src = W + (size_t)(k0 + (lane >> 4)) * ldn + n0 + 4 * (lane & 15);
#pragma unroll
    for (int i = 0; i < 16; ++i) v[i] = *(const f32x4*)(src + (size_t)(4 * i) * ldn);
#pragma unroll
    for (int i = 0; i < 16; ++i) { LAS float* d = scr + (4 * i + (lane >> 4)) * 65 + 4 * (lane & 15); d[0] = v[i].x; d[1] = v[i].y; d[2] = v[i].z; d[3] = v[i].w; }
    LDS_WAIT(); asm volatile("" ::: "memory");
    const int c = lane & 7, r = lane >> 3;
#pragma unroll
    for (int j = 0; j < 8; ++j) { const int n = r + 8 * j; const LAS float* s = scr + (8 * c) * 65 + n;
        v4u o; o.x = pg8::cvt_pk_bf16(s[0 * 65], s[1 * 65]); o.y = pg8::cvt_pk_bf16(s[2 * 65], s[3 * 65]); o.z = pg8::cvt_pk_bf16(s[4 * 65], s[5 * 65]); o.w = pg8::cvt_pk_bf16(s[6 * 65], s[7 * 65]);
        *(GAS v4u*)(WT + (size_t)(drow0 + n) * K + k0 + 8 * c) = o; }
    LDS_WAIT(); asm volatile("" ::: "memory");
}
template <int MODE>
__device__ __forceinline__ void transpose_matrix(const float* W, int nmat, int K, int ldn, int ncols, bf16* WT, LAS float* scr, int gw, int NGW, int lane) {
    const int nblk = ncols / 64, kblk = K / 64, per = nblk * kblk, total = per * nmat;
    for (int it = gw; it < total; it += NGW) {
        const int mat = it / per, r = it - mat * per, kb = r / nblk, nb = r - kb * nblk, n0 = 64 * nb;
        int drow0 = n0;
        if (MODE == 1) { if (n0 < FF) drow0 = (n0 / 128) * 256 + (n0 % 128); else { const int n1 = n0 - FF; drow0 = (n1 / 128) * 256 + 128 + (n1 % 128); } }
        if (MODE == 2) drow0 = n0 < 3072 ? n0 : (n0 < 4096 ? n0 + 4096 : n0 - 1024);
        transpose_item(W + (size_t)mat * K * ldn, ldn, K, WT + (size_t)mat * ncols * K, 64 * kb, n0, drow0, scr, lane);
    }
}
template <int SET>
__device__ __forceinline__ void convert_weights(CArgs* ap, LAS float* scr, int gw, int NGW, int lane) {
    unsigned char* ws = ap->ws;
    bf16* abin = (bf16*)(ws + WS_W_ABIN); bf16* about = (bf16*)(ws + WS_W_ABOUT); bf16* glin = (bf16*)(ws + WS_W_GLIN); bf16* glout = (bf16*)(ws + WS_W_GLOUT); bf16* ffin = (bf16*)(ws + WS_W_FFIN); bf16* ffout = (bf16*)(ws + WS_W_FFOUT);
    constexpr size_t S_ABIN_W = (size_t)DM * AB_IN, S_ABIN_T = (size_t)AB_N * DM, S_SQ = (size_t)DM * DM, S_GLIN_W = (size_t)DM * C_IN, S_GLIN_T = (size_t)C_N * DM, S_FFIN = (size_t)DM * FF2, S_FFOUT = (size_t)FF * DM;
    if (SET == 0) {
        transpose_matrix<2>(ap->in[6], 1, DM, AB_IN, AB_N, abin, scr, gw, NGW, lane);
        transpose_matrix<0>(ap->in[7], 1, DM, DM, DM, about, scr, gw, NGW, lane);
        transpose_matrix<1>(ap->in[18], 1, DM, FF2, FF2, ffin, scr, gw, NGW, lane);
        transpose_matrix<0>(ap->in[19], 1, FF, DM, DM, ffout, scr, gw, NGW, lane);
        transpose_matrix<0>(ap->in[13], 1, DM, C_IN, C_N, glin, scr, gw, NGW, lane);
    } else if (SET == 1) {
        transpose_matrix<0>(ap->in[17], 1, DM, DM, DM, glout, scr, gw, NGW, lane);
        transpose_matrix<1>(ap->in[18] + S_FFIN, 2, DM, FF2, FF2, ffin + S_FFIN, scr, gw, NGW, lane);
        transpose_matrix<0>(ap->in[19] + S_FFOUT, 2, FF, DM, DM, ffout + S_FFOUT, scr, gw, NGW, lane);
        transpose_matrix<2>(ap->in[6] + S_ABIN_W, 1, DM, AB_IN, AB_N, abin + S_ABIN_T, scr, gw, NGW, lane);
        transpose_matrix<0>(ap->in[7] + S_SQ, 1, DM, DM, DM, about + S_SQ, scr, gw, NGW, lane);
        transpose_matrix<0>(ap->in[13] + S_GLIN_W, 1, DM, C_IN, C_N, glin + S_GLIN_T, scr, gw, NGW, lane);
    } else {
        transpose_matrix<0>(ap->in[17] + S_SQ, 1, DM, DM, DM, glout + S_SQ, scr, gw, NGW, lane);
        transpose_matrix<1>(ap->in[18] + 3 * S_FFIN, 1, DM, FF2, FF2, ffin + 3 * S_FFIN, scr, gw, NGW, lane);
        transpose_matrix<0>(ap->in[19] + 3 * S_FFOUT, 1, FF, DM, DM, ffout + 3 * S_FFOUT, scr, gw, NGW, lane);
    }
}
__device__ __forceinline__ void p0_prologue(Frame& F, CArgs* ap) {
    unsigned char* ws = ap->ws;
    {
        LAS float* sc = (LAS float*)(F.lds);
        LAS float* part = (LAS float*)(F.lds + 16384);
        const float* c = ap->in[1];
        for (int i = F.tid; i < 2 * DM; i += NTHREADS) sc[i] = silu_x(c[i]);
        __syncthreads();
        const float* mw = ap->in[2]; const float* mb = ap->in[3]; float* mod = (float*)(ws + WS_MOD);
        constexpr int NU = DEPTH * (6 * DM / 64);
        for (int u = F.bid; u < NU; u += F.G) {
            const int layer = u / (6 * DM / 64), colb = (u % (6 * DM / 64)) * 64, kk = F.lane >> 4, c4 = F.lane & 15;
            const float* wp = mw + ((size_t)layer * DM + F.wave * 256 + kk) * (6 * DM) + colb + 4 * c4;
            f32x4 a0 = {0.f, 0.f, 0.f, 0.f}, a1 = {0.f, 0.f, 0.f, 0.f};
            for (int i0 = 0; i0 < 64; i0 += 16) { f32x4 wv[16];
#pragma unroll
                for (int i = 0; i < 16; ++i) wv[i] = *(const f32x4*)(wp + (size_t)(4 * (i0 + i)) * (6 * DM));
#pragma unroll
                for (int i = 0; i < 16; ++i) { const int k = F.wave * 256 + 4 * (i0 + i) + kk; a0 = a0 + wv[i] * sc[k]; a1 = a1 + wv[i] * sc[DM + k]; } }
            a0.x = xsum<16>(a0.x); a0.x = xsum<32>(a0.x); a0.y = xsum<16>(a0.y); a0.y = xsum<32>(a0.y); a0.z = xsum<16>(a0.z); a0.z = xsum<32>(a0.z); a0.w = xsum<16>(a0.w); a0.w = xsum<32>(a0.w);
            a1.x = xsum<16>(a1.x); a1.x = xsum<32>(a1.x); a1.y = xsum<16>(a1.y); a1.y = xsum<32>(a1.y); a1.z = xsum<16>(a1.z); a1.z = xsum<32>(a1.z); a1.w = xsum<16>(a1.w); a1.w = xsum<32>(a1.w);
            if (F.lane < 16) { *(LAS f32x4*)(part + (F.wave * 2 + 0) * 64 + 4 * c4) = a0; *(LAS f32x4*)(part + (F.wave * 2 + 1) * 64 + 4 * c4) = a1; }
            __syncthreads();
            if (F.tid < 128) { const int b = F.tid >> 6, l = F.tid & 63; float s = 0.f;
#pragma unroll
                for (int w = 0; w < 8; ++w) s += part[(w * 2 + b) * 64 + l];
                const int cc = (u % (6 * DM / 64)) * 64 + l;
                mod[((size_t)layer * 2 + b) * (6 * DM) + cc] = s + mb[(size_t)layer * (6 * DM) + cc]; }
            __syncthreads();
        }
    }
    __syncthreads();
    LAS float* scr = (LAS float*)(F.lds + RING_OFF + F.wave * 16640);
    const int gw = F.bid * NWAVES + F.wave, NGW = F.G * NWAVES;
    convert_weights<0>(ap, scr, gw, NGW, F.lane);
}

template <int MASK> __device__ __forceinline__ float xget(float v) { return __builtin_bit_cast(float, __builtin_amdgcn_ds_swizzle(__builtin_bit_cast(int, v), (MASK << 10) | 0x1f)); }
template <int N> __device__ __forceinline__ float rs_reduce(float (&a)[N], int lane) {
    if (N == 16) {
#pragma unroll
        for (int i = 0; i < 8; ++i) { const bool up = lane & 1; const float keep = up ? a[i + 8] : a[i], send = up ? a[i] : a[i + 8]; a[i] = keep + xget<1>(send); } }
    if (N >= 8) {
#pragma unroll
        for (int i = 0; i < 4; ++i) { const bool up = lane & (N == 16 ? 2 : 1); const float keep = up ? a[i + 4] : a[i], send = up ? a[i] : a[i + 4]; a[i] = keep + (N == 16 ? xget<2>(send) : xget<1>(send)); } }
#pragma unroll
    for (int i = 0; i < 2; ++i) { const bool up = lane & (N == 16 ? 4 : 2); const float keep = up ? a[i + 2] : a[i], send = up ? a[i] : a[i + 2]; a[i] = keep + (N == 16 ? xget<4>(send) : xget<2>(send)); }
    { const bool up = lane & (N == 16 ? 8 : 4); const float keep = up ? a[1] : a[0], send = up ? a[0] : a[1]; a[0] = keep + (N == 16 ? xget<8>(send) : xget<4>(send)); }
    float r = a[0];
    if (N == 8) r = xsum<8>(r);
    r = xsum<16>(r); r = xsum<32>(r);
    return r;
}
template <int N> __device__ __forceinline__ int rs_col(int lane) { return N == 16 ? (((lane & 1) << 3) | ((lane & 2) << 1) | ((lane & 4) >> 1) | ((lane & 8) >> 3)) : (((lane & 1) << 2) | (lane & 2) | ((lane & 4) >> 2)); }
template <int NC, int MODE, bool RES, bool XF32>
__device__ __forceinline__ void norm_phase(Frame& F, const void* xin, const float* gain, const float* mod_sh, const float* mod_sc  ,
                                           bf16* hout, const float* Wsm, int ldn, const float* fbias, float* sout, const bf16* yres = nullptr, const float* rgate = nullptr, bf16* xb = nullptr) {
    LAS float* wl = (LAS float*)(F.lds);
    if (NC > 0) {
        for (int i = F.tid; i < NC * DM; i += NTHREADS) { const int k = i / NC, c = i % NC; wl[c * DM + k] = Wsm[(size_t)k * ldn + c]; }
        __syncthreads();
    }
    f32x4 gm[8], shv[8]; int bprev = -1;
    for (int mp = F.bid * NWAVES + F.wave; mp < M / 2; mp += F.G * NWAVES) {
        const int m0 = 2 * mp, b = m0 / T;
        if (b != bprev) { bprev = b; const f32x4* gp = (const f32x4*)gain + F.lane; const f32x4* shp = (const f32x4*)(mod_sh + (size_t)b * 6 * DM) + F.lane; const f32x4* scp = (const f32x4*)(mod_sc + (size_t)b * 6 * DM) + F.lane;
#pragma unroll
            for (int j = 0; j < 8; ++j) { gm[j] = gp[64 * j] * (scp[64 * j] + 1.0f); shv[j] = shp[64 * j]; } }
        f32x4 v[2][8]; float s0 = 0.f, s1 = 0.f;
        v2u yv[2][8];
        if (RES) { const GAS v2u* yr = (const GAS v2u*)(yres + (size_t)m0 * DM) + F.lane;
#pragma unroll
            for (int j = 0; j < 8; ++j) { yv[0][j] = yr[64 * j]; yv[1][j] = yr[512 + 64 * j]; } }
        if (XF32) { const GAS f32x4* xr = (const GAS f32x4*)((const float*)xin + (size_t)m0 * DM) + F.lane;
#pragma unroll
            for (int j = 0; j < 8; ++j) { v[0][j] = xr[64 * j]; v[1][j] = xr[512 + 64 * j]; } }
        else { const GAS v2u* xr = (const GAS v2u*)((const bf16*)xin + (size_t)m0 * DM) + F.lane; v2u xv[2][8];
#pragma unroll
            for (int j = 0; j < 8; ++j) { xv[0][j] = xr[64 * j]; xv[1][j] = xr[512 + 64 * j]; }
#pragma unroll
            for (int j = 0; j < 8; ++j) { v[0][j] = (f32x4){bf_lo(xv[0][j].x), bf_hi(xv[0][j].x), bf_lo(xv[0][j].y), bf_hi(xv[0][j].y)}; v[1][j] = (f32x4){bf_lo(xv[1][j].x), bf_hi(xv[1][j].x), bf_lo(xv[1][j].y), bf_hi(xv[1][j].y)}; } }
        if (RES) { const f32x4* rg = (const f32x4*)(rgate + (size_t)b * 6 * DM) + F.lane; GAS v2u* xo = (GAS v2u*)(xb + (size_t)m0 * DM) + F.lane;
#pragma unroll
            for (int j = 0; j < 8; ++j) { const f32x4 g = rg[64 * j];
                v[0][j] = v[0][j] + g * (f32x4){bf_lo(yv[0][j].x), bf_hi(yv[0][j].x), bf_lo(yv[0][j].y), bf_hi(yv[0][j].y)}; v[1][j] = v[1][j] + g * (f32x4){bf_lo(yv[1][j].x), bf_hi(yv[1][j].x), bf_lo(yv[1][j].y), bf_hi(yv[1][j].y)};
                v2u w; w.x = pk2(v[0][j].x, v[0][j].y); w.y = pk2(v[0][j].z, v[0][j].w); xo[64 * j] = w;
                w.x = pk2(v[1][j].x, v[1][j].y); w.y = pk2(v[1][j].z, v[1][j].w); xo[512 + 64 * j] = w; } }
#pragma unroll
        for (int j = 0; j < 8; ++j) { s0 += (v[0][j].x * v[0][j].x + v[0][j].y * v[0][j].y) + (v[0][j].z * v[0][j].z + v[0][j].w * v[0][j].w);
                                      s1 += (v[1][j].x * v[1][j].x + v[1][j].y * v[1][j].y) + (v[1][j].z * v[1][j].z + v[1][j].w * v[1][j].w); }
        const float rstd0 = __builtin_amdgcn_rsqf(wave_sum(s0) * (1.f / DM) + EPS), rstd1 = __builtin_amdgcn_rsqf(wave_sum(s1) * (1.f / DM) + EPS);
        GAS v2u* o8 = (GAS v2u*)(hout + (size_t)m0 * DM) + F.lane;
#pragma unroll
        for (int j = 0; j < 8; ++j) { const f32x4 g = gm[j], sh = shv[j];
            v[0][j] = (v[0][j] * rstd0) * g + sh; v[1][j] = (v[1][j] * rstd1) * g + sh;
            v2u w; w.x = pk2(v[0][j].x, v[0][j].y); w.y = pk2(v[0][j].z, v[0][j].w); o8[64 * j] = w;
            w.x = pk2(v[1][j].x, v[1][j].y); w.y = pk2(v[1][j].z, v[1][j].w); o8[512 + 64 * j] = w; }
        if constexpr (NC > 0) {
            float a0[NC], a1[NC];
#pragma unroll
            for (int c = 0; c < NC; ++c) { float acc0 = 0.f, acc1 = 0.f;
#pragma unroll
                for (int j = 0; j < 8; ++j) { const f32x4 w = *(const LAS f32x4*)(wl + c * DM + 256 * j + 4 * F.lane);
                    acc0 += (v[0][j].x * w.x + v[0][j].y * w.y) + (v[0][j].z * w.z + v[0][j].w * w.w); acc1 += (v[1][j].x * w.x + v[1][j].y * w.y) + (v[1][j].z * w.z + v[1][j].w * w.w); }
                a0[c] = acc0; a1[c] = acc1; __builtin_amdgcn_sched_barrier(0); }
            const float r0 = rs_reduce<NC>(a0, F.lane), r1 = rs_reduce<NC>(a1, F.lane); const int cc = rs_col<NC>(F.lane);
            if (MODE == 1) { const int t = m0 % T; if (F.lane < NC) { const float fb = fbias[cc]; sout[((size_t)b * 8 + cc) * T + t] = log_sigmoid_f(r0 + fb); sout[((size_t)b * 8 + cc) * T + t + 1] = log_sigmoid_f(r1 + fb); } }
            if (MODE == 2) { if (F.lane < NC) { sout[(size_t)m0 * 16 + cc] = r0; sout[(size_t)m0 * 16 + 16 + cc] = r1; } }
        }
    }
}

__device__ __forceinline__ void resid_final(Frame& F, const bf16* xb, const bf16* yres, const float* rgate, float* xout) {
    for (int mp = F.bid * NWAVES + F.wave; mp < M / 2; mp += F.G * NWAVES) {
        const int m0 = 2 * mp, b = m0 / T;
        const GAS v2u* xr = (const GAS v2u*)(xb + (size_t)m0 * DM) + F.lane; const GAS v2u* yr = (const GAS v2u*)(yres + (size_t)m0 * DM) + F.lane;
        const f32x4* rg = (const f32x4*)(rgate + (size_t)b * 6 * DM) + F.lane; GAS f32x4* xo = (GAS f32x4*)(xout + (size_t)m0 * DM) + F.lane;
        v2u xv[2][8], yv[2][8];
#pragma unroll
        for (int j = 0; j < 8; ++j) { xv[0][j] = xr[64 * j]; xv[1][j] = xr[512 + 64 * j]; yv[0][j] = yr[64 * j]; yv[1][j] = yr[512 + 64 * j]; }
#pragma unroll
        for (int j = 0; j < 8; ++j) { const f32x4 g = rg[64 * j];
            xo[64 * j] = (f32x4){bf_lo(xv[0][j].x), bf_hi(xv[0][j].x), bf_lo(xv[0][j].y), bf_hi(xv[0][j].y)} + g * (f32x4){bf_lo(yv[0][j].x), bf_hi(yv[0][j].x), bf_lo(yv[0][j].y), bf_hi(yv[0][j].y)};
            xo[512 + 64 * j] = (f32x4){bf_lo(xv[1][j].x), bf_hi(xv[1][j].x), bf_lo(xv[1][j].y), bf_hi(xv[1][j].y)} + g * (f32x4){bf_lo(yv[1][j].x), bf_hi(yv[1][j].x), bf_lo(yv[1][j].y), bf_hi(yv[1][j].y)}; }
    }
}

__device__ __forceinline__ void fox_prep(Frame& F, bf16* proj, const float* qg, const float* kg, const float* logf, float* bias) {
    const int gw = F.bid * NWAVES + F.wave, NGW = F.G * NWAVES;
    const f32x4 gq0 = *(const f32x4*)(qg + (F.lane & 15) * 8), gq1 = *(const f32x4*)(qg + (F.lane & 15) * 8 + 4), gk0 = *(const f32x4*)(kg + (F.lane & 15) * 8), gk1 = *(const f32x4*)(kg + (F.lane & 15) * 8 + 4);
    for (int m = gw; m < M; m += NGW) {
        GAS v4u* p = (GAS v4u*)(proj + (size_t)m * AB_N + 3072) + F.lane;
        v4u wv[4];
#pragma unroll
        for (int j = 0; j < 4; ++j) wv[j] = p[64 * j];
#pragma unroll
        for (int j = 0; j < 4; ++j) {
            const v4u w = wv[j];
            float e[8] = {bf_lo(w.x), bf_hi(w.x), bf_lo(w.y), bf_hi(w.y), bf_lo(w.z), bf_hi(w.z), bf_lo(w.w), bf_hi(w.w)};
            float s = 0.f;
#pragma unroll
            for (int i = 0; i < 8; ++i) s += e[i] * e[i];
            s = xsum<1>(s); s = xsum<2>(s); s = xsum<4>(s); s = xsum<8>(s);
            const float rstd = __builtin_amdgcn_rsqf(s * (1.f / 128.f) + EPS);
            const f32x4 g0 = j < 2 ? gq0 : gk0, g1 = j < 2 ? gq1 : gk1;
#pragma unroll
            for (int i = 0; i < 4; ++i) { e[i] = e[i] * rstd * g0[i]; e[4 + i] = e[4 + i] * rstd * g1[i]; }
            v4u o; o.x = pk2(e[0], e[1]); o.y = pk2(e[2], e[3]); o.z = pk2(e[4], e[5]); o.w = pk2(e[6], e[7]);
            p[64 * j] = o;
        }
    }
    if (F.bid < 16) {
        LAS double* tsum = (LAS double*)(F.lds);
        const float* lf = logf + (size_t)F.bid * T; float* bo = bias + (size_t)F.bid * T;
        double v[16]; double run = 0.0;
        const int i0 = F.tid * 16;
#pragma unroll
        for (int i = 0; i < 16; ++i) { run += (double)lf[i0 + i]; v[i] = run; }
        tsum[F.tid] = run;
        __syncthreads();
        LAS double* bsum = tsum + NTHREADS;
        if (F.tid < 8) { double s = 0.0; for (int w = 0; w < 64; ++w) s += tsum[F.tid * 64 + w]; bsum[F.tid] = s; }
        __syncthreads();
        double base = 0.0;
        for (int w = 0; w < F.wave; ++w) base += bsum[w];
        for (int w = 0; w < F.lane; ++w) base += tsum[F.wave * 64 + w];
        const double k = -11.313708498984761;
#pragma unroll
        for (int i = 0; i < 16; ++i) bo[i0 + i] = (float)((base + v[i]) * k);
        __syncthreads();
    }
}

#ifndef DBG_REC
#define DBG_REC 0
#endif
#if DBG_REC
template <bool GLA>
__device__ __forceinline__ void rec_naive(Frame& F, const bf16* proj, float* O, const float* lbl  , int lb_on,
                                          const float* glow, const float* wup  , const float* bgate  ) {
    constexpr int DK = GLA ? 256 : 128, DVH = GLA ? 512 : 128, NH = GLA ? 4 : 8, DVS = 32, NSL = DVH / DVS, TB = GLA ? 16 : 32;
    constexpr int PITCH = GLA ? C_N : AB_N, OPITCH = GLA ? 2048 : 1024;
    constexpr int R = DK / 16;
    constexpr int NPAIR = TB * DK / 2 / NTHREADS;
    constexpr int NUNITS = BATCH * NH * NSL;
    LAS float* sq = (LAS float*)(F.lds); LAS float* sf = sq + TB * DK; LAS float* sk = sf + TB * DK; LAS float* sv = sk + TB * DK; LAS float* part = sv + TB * DVS; LAS float* sgl = part + TB * 4 * DVS;
    const int lane = F.lane, e_l = lane & 15, dsub = lane >> 4, eg = F.wave & 1, dg = F.wave >> 1, e = eg * 16 + e_l, d0 = (dg * 4 + dsub) * R;
    for (int unit = F.bid; unit < NUNITS; unit += F.G) {
        const int sl = unit % NSL, h = (unit / NSL) % NH, b = unit / (NSL * NH);
        const bf16* pq = proj + (size_t)b * T * PITCH + h * DK;
        const bf16* pk = pq + 1024;
        const bf16* pv = proj + (size_t)b * T * PITCH + 2048 + h * DVH + sl * DVS;
        const int dp = 2 * (F.tid % (DK / 2)), tt0 = F.tid / (DK / 2); constexpr int TSTEP = NTHREADS / (DK / 2);
        float lb0 = 0.f, lb1 = 0.f; float wu0[16], wu1[16]; float bg0 = 0.f, bg1 = 0.f;
        if (!GLA) { if (lb_on) { const float l0a = lbl[h * DK + dp], l1a = lbl[1024 + h * DK + dp], l0b = lbl[h * DK + dp + 1], l1b = lbl[1024 + h * DK + dp + 1];
                                 lb0 = fminf(fmaxf(sigmoid_f(l1a - l0a), 0.f), 1.0f - 1e-6f); lb1 = fminf(fmaxf(sigmoid_f(l1b - l0b), 0.f), 1.0f - 1e-6f); } }
        else {
#pragma unroll
            for (int r = 0; r < 16; ++r) { wu0[r] = wup[r * 1024 + h * DK + dp]; wu1[r] = wup[r * 1024 + h * DK + dp + 1]; }
            bg0 = bgate[h * DK + dp]; bg1 = bgate[h * DK + dp + 1]; }
        const int vt = F.tid / 16, ve = 2 * (F.tid % 16); const bool vact = vt < TB;
        float S[R];
#pragma unroll
        for (int j = 0; j < R; ++j) S[j] = 0.f;
        unsigned rq[NPAIR], rk[NPAIR], rv = 0u; float rgl = 0.f;
#define REC_PREFETCH(t0) do { _Pragma("unroll") for (int i = 0; i < NPAIR; ++i) { const size_t row = (size_t)((t0) + tt0 + TSTEP * i); \
            rq[i] = *(const unsigned*)(pq + row * PITCH + dp); rk[i] = *(const unsigned*)(pk + row * PITCH + dp); \
            } \
            if (GLA && F.tid < TB * 16) rgl = glow[((size_t)b * T + (t0)) * 16 + F.tid]; \
            if (vact) rv = *(const unsigned*)(pv + (size_t)((t0) + vt) * PITCH + ve); } while (0)
        REC_PREFETCH(0);
        for (int t0 = 0; t0 < T; t0 += TB) {
            if (GLA) { if (F.tid < TB * 16) sgl[F.tid] = rgl; __syncthreads(); }
#pragma unroll
            for (int i = 0; i < NPAIR; ++i) { const int tt = tt0 + TSTEP * i; const float qa = bf_lo(rq[i]), qb = bf_hi(rq[i]), ka = bf_lo(rk[i]), kb = bf_hi(rk[i]);
                float q0, q1, f0, f1, k0, k1;
                if (!GLA) { q0 = silu_x(qa); q1 = silu_x(qb); const float s0 = sigmoid_f(ka), s1 = sigmoid_f(kb), n0 = sigmoid_f(-ka), n1 = sigmoid_f(-kb);
                    f0 = fmaxf(lb0 + (1.f - lb0) * s0, 1e-30f); f1 = fmaxf(lb1 + (1.f - lb1) * s1, 1e-30f); k0 = (1.f - lb0) * n0; k1 = (1.f - lb1) * n1; }
                else { q0 = qa * 0.0625f; q1 = qb * 0.0625f; k0 = ka; k1 = kb; float x0 = bg0, x1 = bg1;
#pragma unroll
                    for (int r = 0; r < 16; ++r) { const float g = sgl[tt * 16 + r]; x0 += g * wu0[r]; x1 += g * wu1[r]; }
                    f0 = __expf(log_sigmoid_f(x0) * 0.0625f); f1 = __expf(log_sigmoid_f(x1) * 0.0625f); }
                sq[tt * DK + dp] = q0; sq[tt * DK + dp + 1] = q1; sf[tt * DK + dp] = f0; sf[tt * DK + dp + 1] = f1; sk[tt * DK + dp] = k0; sk[tt * DK + dp + 1] = k1; }
            if (vact) { sv[vt * DVS + ve] = bf_lo(rv); sv[vt * DVS + ve + 1] = bf_hi(rv); }
            __syncthreads();
            if (t0 + TB < T) REC_PREFETCH(t0 + TB);
            for (int tt = 0; tt < TB; ++tt) {
                const float v = sv[tt * DVS + e]; float acc = 0.f;
#pragma unroll
                for (int g4 = 0; g4 < R / 4; ++g4) { const f32x4 f4 = *(const LAS f32x4*)(sf + tt * DK + d0 + 4 * g4), k4 = *(const LAS f32x4*)(sk + tt * DK + d0 + 4 * g4), q4 = *(const LAS f32x4*)(sq + tt * DK + d0 + 4 * g4);
#pragma unroll
                    for (int i = 0; i < 4; ++i) { S[4 * g4 + i] = f4[i] * S[4 * g4 + i] + k4[i] * v; acc += q4[i] * S[4 * g4 + i]; } }
                acc = xsum<16>(acc); acc = xsum<32>(acc);
                if (dsub == 0) part[(tt * 4 + dg) * DVS + e] = acc;
            }
            __syncthreads();
            for (int i = F.tid; i < TB * DVS; i += NTHREADS) { const int tt = i / DVS, ee = i % DVS;
                const float o = (part[(tt * 4 + 0) * DVS + ee] + part[(tt * 4 + 1) * DVS + ee]) + (part[(tt * 4 + 2) * DVS + ee] + part[(tt * 4 + 3) * DVS + ee]);
                O[((size_t)b * T + t0 + tt) * OPITCH + h * DVH + sl * DVS + ee] = o; }
        }
#undef REC_PREFETCH
        __syncthreads();
    }
}

#endif
#ifndef DBG_ZERO
#define DBG_ZERO 0
#endif
__device__ __forceinline__ void post_even(Frame& F, const bf16* O, const bf16* proj, const float* gain  , bf16* cat) {
    const int gw = F.bid * NWAVES + F.wave, NGW = F.G * NWAVES;
    f32x4 gn[4];
#pragma unroll
    for (int j = 0; j < 4; ++j) gn[j] = *((const f32x4*)gain + 64 * j + F.lane);
    for (int mp = gw; mp < M / 2; mp += NGW) {
        const int m = 2 * mp;
        const GAS v2u* op = (const GAS v2u*)(O + (size_t)m * 1024) + F.lane;
        const GAS v2u* ga = (const GAS v2u*)(proj + (size_t)m * AB_N + 7168) + F.lane;
        GAS v2u* cp = (GAS v2u*)(cat + (size_t)m * DM) + F.lane;
        v2u vr[2][4], gr[2][4];
#pragma unroll
        for (int r = 0; r < 2; ++r)
#pragma unroll
            for (int j = 0; j < 4; ++j) { vr[r][j] = op[r * 256 + 64 * j]; gr[r][j] = ga[r * (AB_N / 4) + 64 * j]; }
#pragma unroll
        for (int r = 0; r < 2; ++r)
#pragma unroll
        for (int j = 0; j < 4; ++j) {
            const f32x4 v = {bf_lo(vr[r][j].x), bf_hi(vr[r][j].x), bf_lo(vr[r][j].y), bf_hi(vr[r][j].y)}; float s = (v.x * v.x + v.y * v.y) + (v.z * v.z + v.w * v.w);
            s = xsum<1>(s); s = xsum<2>(s); s = xsum<4>(s); s = xsum<8>(s); s = xsum<16>(s);
            const float rstd = __builtin_amdgcn_rsqf(s * (1.f / 128.f) + EPS);
            const f32x4 g = gn[j];
            const v2u gw2 = gr[r][j];
            const float o0 = v.x * rstd * g.x * silu_x(bf_lo(gw2.x)), o1 = v.y * rstd * g.y * silu_x(bf_hi(gw2.x)), o2 = v.z * rstd * g.z * silu_x(bf_lo(gw2.y)), o3 = v.w * rstd * g.w * silu_x(bf_hi(gw2.y));
            v2u w; w.x = pk2(o0, o1); w.y = pk2(o2, o3); cp[r * 512 + 64 * j] = w;
        }
    }
}
__device__ __forceinline__ void post_odd(Frame& F, const bf16* O, const bf16* proj, const float* gain  , bf16* cat) {
    const int gw = F.bid * NWAVES + F.wave, NGW = F.G * NWAVES;
    const f32x4 gn0 = *((const f32x4*)gain + F.lane), gn1 = *((const f32x4*)gain + 64 + F.lane);
    for (int mp = gw; mp < M / 2; mp += NGW) {
        const int m = 2 * mp;
        const GAS v2u* op = (const GAS v2u*)(O + (size_t)m * DM) + F.lane;
        const GAS v2u* gg = (const GAS v2u*)(proj + (size_t)m * C_N + 4096) + F.lane;
        GAS v2u* cp = (GAS v2u*)(cat + (size_t)m * DM) + F.lane;
        v2u vr[2][8], gr[2][8];
#pragma unroll
        for (int r = 0; r < 2; ++r)
#pragma unroll
            for (int j = 0; j < 8; ++j) { vr[r][j] = op[r * 512 + 64 * j]; gr[r][j] = gg[r * (C_N / 4) + 64 * j]; }
#pragma unroll
        for (int r = 0; r < 2; ++r)
#pragma unroll
        for (int hh = 0; hh < 4; ++hh) {
            const v2u r0 = vr[r][2 * hh], r1 = vr[r][2 * hh + 1]; const f32x4 v0 = {bf_lo(r0.x), bf_hi(r0.x), bf_lo(r0.y), bf_hi(r0.y)}, v1 = {bf_lo(r1.x), bf_hi(r1.x), bf_lo(r1.y), bf_hi(r1.y)};
            float s = ((v0.x * v0.x + v0.y * v0.y) + (v0.z * v0.z + v0.w * v0.w)) + ((v1.x * v1.x + v1.y * v1.y) + (v1.z * v1.z + v1.w * v1.w));
            s = wave_sum(s);
            const float rstd = __builtin_amdgcn_rsqf(s * (1.f / 512.f) + EPS);
#pragma unroll
            for (int jj = 0; jj < 2; ++jj) { const f32x4 v = jj ? v1 : v0; const f32x4 g = jj ? gn1 : gn0; const v2u gw2 = gr[r][2 * hh + jj];
                const float o0 = v.x * rstd * g.x * silu_x(bf_lo(gw2.x)), o1 = v.y * rstd * g.y * silu_x(bf_hi(gw2.x)), o2 = v.z * rstd * g.z * silu_x(bf_lo(gw2.y)), o3 = v.w * rstd * g.w * silu_x(bf_hi(gw2.y));
                v2u w; w.x = pk2(o0, o1); w.y = pk2(o2, o3); cp[r * 512 + 64 * (2 * hh + jj)] = w; }
        }
    }
}

__device__ __forceinline__ fox::BlockRef fox_ref(int item, const bf16* proj, bf16* cat, const float* bias, float thp) {
    const int bh = item & 15, qb = 31 - (item >> 4), b = bh >> 3, h = bh & 7;
    fox::BlockRef r;
    const bf16* base = proj + (size_t)b * T * AB_N + h * 128;
    r.Q = (const fox::bf16*)(base + (size_t)qb * 256 * AB_N + 3072); r.K = (const fox::bf16*)(base + 4096); r.V = (const fox::bf16*)(base + 5120);
    r.O = (fox::bf16*)(cat + ((size_t)b * T + (size_t)qb * 256) * DM + 1024 + h * 128);
    r.Bias = bias + (size_t)bh * T; r.P0 = qb * 256; r.THp = thp;
    return r;
}
__device__ __forceinline__ int fox_fetch(Frame& F, unsigned* ctr, volatile LAS unsigned* slot) {
    if (F.tid == 0) *slot = __hip_atomic_fetch_add(ctr, 1u, __ATOMIC_RELAXED, __HIP_MEMORY_SCOPE_AGENT);
    __syncthreads();
    const int v = __builtin_amdgcn_readfirstlane((int)*slot);
    __syncthreads();
    return v;
}
__device__ __forceinline__ void fox_phase(Frame& F, char* lds, const bf16* proj, bf16* cat, const float* bias, unsigned* ctr, const float* qg, const float* kg) {
    constexpr int TOTAL = 512;
    float gqm = 0.f, gkm = 0.f;
    for (int i = 0; i < 128; ++i) { gqm = fmaxf(gqm, fabsf(qg[i])); gkm = fmaxf(gkm, fabsf(kg[i])); }
    const float thp = 2.0f * (128.0f * 1.02f * gqm * gkm) + (128.0f + 12.0f + 6.0f) / (1.4426950408889634f * fox::SCALE);
    volatile LAS unsigned* slot = (volatile LAS unsigned*)(F.lds + MISC_OFF) + 16;
    int ci = fox_fetch(F, ctr, slot); if (ci >= TOTAL) return;
    fox::BlockRef cur = fox_ref(ci, proj, cat, bias, thp);
    fox::Seam S;
    fox::fox_prime(cur, lds, S, F.tid);
    for (;;) {
        const int ni = fox_fetch(F, ctr, slot); const bool last = ni >= TOTAL;
        const fox::BlockRef nxt = last ? cur : fox_ref(ni, proj, cat, bias, thp);
        fox::fox_block(cur, nxt, lds, S, F.tid);
        if (last) break;
        cur = nxt;
    }
}

template <bool GLA> struct RecCfg {
    static constexpr int DK = GLA ? 256 : 128, DVH = GLA ? 512 : 128, NH = GLA ? 4 : 8, CH = 32, NCH = T / CH, PITCH = GLA ? C_N : AB_N, OPITCH = GLA ? 2048 : 1024;
    static constexpr int QP = DK + 16;
    static constexpr int QT_B = ((CH * QP * 2 + 1023) / 1024) * 1024, KT_B = DK * CH * 2, P_B = CH * CH * 2, A_B = 1024, VT_B = DVH * CH * 2;
    static constexpr int OFF_QT = 0, OFF_KT = QT_B, OFF_P = OFF_KT + KT_B, OFF_A = OFF_P + P_B, OFF_VT = OFF_A + A_B, UNIT_B = OFF_VT + VT_B;
    static constexpr int NSL = DVH / 128, BUF_B = OFF_VT + 8192, NP1 = OFF_VT / 1024, NP = NP1 + 8, NR = (NP + 7) / 8;
    static_assert(A_B >= DK * 4 && OFF_VT % 1024 == 0, "rec layout");
};
typedef short rbf16x8 __attribute__((ext_vector_type(8)));
__device__ __forceinline__ rbf16x8 rpack8(f32x4 a, f32x4 b) { v4u w; w.x = pg8::cvt_pk_bf16(a.x, a.y); w.y = pg8::cvt_pk_bf16(a.z, a.w); w.z = pg8::cvt_pk_bf16(b.x, b.y); w.w = pg8::cvt_pk_bf16(b.z, b.w); return __builtin_bit_cast(rbf16x8, w); }

template <bool GLA>
__device__ __forceinline__ void rec_prep(Frame& F, const bf16* proj, unsigned char* rec, const float* lbl, int lb_on, const float* glow, const float* wup, const float* bgate) {
    using C = RecCfg<GLA>;
    constexpr int DK = C::DK, DVH = C::DVH, NH = C::NH, CH = C::CH, NCH = C::NCH, PITCH = C::PITCH, QP = C::QP;
    constexpr int NSEG = NTHREADS / DK, TPS = CH / NSEG;
    constexpr int NSEGV = NTHREADS / DVH, TPV = CH / NSEGV;
    LAS float* segtot = (LAS float*)F.lds;
    LAS bf16* qm = (LAS bf16*)(F.lds + 2048);
    LAS bf16* km = qm + CH * QP;
    LAS float* sgl = (LAS float*)(F.lds + 2048 + 2 * CH * QP * 2);
    const int d = F.tid % DK, seg = F.tid / DK, lane = F.lane, el = lane & 15, q4 = lane >> 4;
    const int x = d & 31, y = x & 15, pos = (d & ~31) + 8 * (y >> 2) + (y & 3) + 4 * (x >> 4);
    constexpr int NUNITS = BATCH * NH * NCH, NBH = BATCH * NH;
    float lb = 0.f, bg = 0.f; float wu[16]; int hprev = -1;
    unsigned short rq[TPS], rk[TPS]; unsigned rvv[TPV / 2]; float rgl = 0.f;
    unsigned short rvr[GLA ? 1 : TPV];
    const int ev = F.tid % DVH, sv = F.tid / DVH;
    const unsigned toff = (unsigned)(seg * TPS) * (unsigned)(PITCH * 2) + (unsigned)d * 2u, voff = (unsigned)(sv * TPV) * (unsigned)(PITCH * 2) + (unsigned)ev * 2u;
#define PREP_LOAD(un) do { const int c_ = (un) / NBH, bh_ = (un) % NBH; const size_t row_ = (size_t)(bh_ / NH) * T + (size_t)c_ * CH; const int h_ = bh_ % NH; \
        const char* ubq_ = (const char*)(proj + row_ * PITCH + h_ * DK); const char* ubv_ = (const char*)(proj + row_ * PITCH + 2048 + h_ * DVH); (void)ubv_; \
        if (GLA) rgl = glow[row_ * 16 + F.tid];     \
        _Pragma("unroll") for (int i = 0; i < TPS; ++i) { const char* rb_ = ubq_ + (size_t)i * (PITCH * 2);     \
            rq[i] = *(const bf16*)(rb_ + toff); rk[i] = *(const bf16*)(rb_ + 2048 + toff); } \
        if (!GLA) { _Pragma("unroll") for (int i = 0; i < TPV; ++i) rvr[i] = *(const bf16*)((ubv_ + (size_t)i * (PITCH * 2)) + voff); } \
        } while (0)
    if (F.bid < NUNITS) PREP_LOAD(F.bid);
    for (int unit = F.bid; unit < NUNITS; unit += F.G) {
        const int c = unit / NBH, bh = unit % NBH, h = bh % NH, b = bh / NH;
        const size_t row0 = (size_t)b * T + (size_t)c * CH;
        if (h != hprev) { hprev = h;
            if (!GLA) { lb = 0.f; if (lb_on) lb = fminf(fmaxf(sigmoid_f(lbl[1024 + h * DK + d] - lbl[h * DK + d]), 0.f), 1.0f - 1e-6f); }
            else {
#pragma unroll
                for (int r = 0; r < 16; ++r) wu[r] = wup[r * 1024 + h * DK + d];
                bg = bgate[h * DK + d]; } }
        if (GLA) { sgl[F.tid] = rgl; __syncthreads(); }
        float qv[TPS], kv[TPS], G[TPS]; float run = 0.f;
#pragma unroll
        for (int i = 0; i < TPS; ++i) { const int t = seg * TPS + i; const float qa = bf1(rq[i]), ka = bf1(rk[i]); float g;
            if (!GLA) { qv[i] = silu_x(qa); const float ez = __expf(-fabsf(ka)), rz = __builtin_amdgcn_rcpf(1.0f + ez), big = rz, small = ez * rz;
                const float sg = ka >= 0.f ? big : small, ng = ka >= 0.f ? small : big; const float f = fmaxf(lb + (1.f - lb) * sg, 1e-30f); g = __logf(f); kv[i] = (1.f - lb) * ng; }
            else { qv[i] = qa * 0.0625f; kv[i] = ka; float xx = bg;
#pragma unroll
                for (int r = 0; r < 16; ++r) xx += sgl[t * 16 + r] * wu[r];
                g = log_sigmoid_fast(xx) * 0.0625f; }
            run += g; G[i] = run; }
        segtot[seg * DK + d] = run;
        __syncthreads();
        float off = 0.f, tot = 0.f, rmid = 0.f;
#pragma unroll
        for (int s = 0; s < NSEG; ++s) { const float v = segtot[s * DK + d]; tot += v; if (s < seg) off += v; if (s < 16 / TPS) rmid += v; }
        unsigned char* ub = rec + (size_t)(bh * NCH + c) * C::UNIT_B;
        bf16* QT = (bf16*)(ub + C::OFF_QT); bf16* KT = (bf16*)(ub + C::OFF_KT); bf16* Pb = (bf16*)(ub + C::OFF_P); float* Ab = (float*)(ub + C::OFF_A); bf16* VT = (bf16*)(ub + C::OFF_VT);
        unsigned kt[TPS / 2];
#pragma unroll
        for (int i = 0; i < TPS; i += 2) { float kh[2];
#pragma unroll
            for (int u = 0; u < 2; ++u) { const int t = seg * TPS + i + u; const float Gt = G[i + u] + off;
                QT[t * QP + pos] = (bf16)f2bf(qv[i + u] * __expf(Gt)); kh[u] = kv[i + u] * __expf(tot - Gt);
                qm[t * QP + d] = (bf16)f2bf(qv[i + u] * __expf(fminf(Gt - rmid, 80.f))); km[t * QP + d] = (bf16)f2bf(kv[i + u] * __expf(fminf(rmid - Gt, 80.f))); }
            kt[i / 2] = pk2(kh[0], kh[1]); }
#pragma unroll
        for (int j = 0; j < TPS / 8; ++j) { v4u w; w.x = kt[4 * j]; w.y = kt[4 * j + 1]; w.z = kt[4 * j + 2]; w.w = kt[4 * j + 3]; *(v4u*)(KT + d * CH + ((seg * TPS + 8 * j) ^ ((d & 8) << 1))) = w; }
        if (seg == NSEG - 1) Ab[d] = __expf(tot);
        { bf16* vt_ = VT + ev * CH;
          if (GLA) { const char* ubv_ = (const char*)(proj + row0 * PITCH + 2048 + h * DVH);
#pragma unroll
              for (int i = 0; i < TPV; i += 2) rvv[i / 2] = (unsigned)*(const bf16*)(ubv_ + (voff + (unsigned)i * (unsigned)(PITCH * 2))) | ((unsigned)*(const bf16*)(ubv_ + (voff + (unsigned)(i + 1) * (unsigned)(PITCH * 2))) << 16); }
          else {
#pragma unroll
              for (int i = 0; i < TPV; i += 2) rvv[i / 2] = (unsigned)rvr[i] | ((unsigned)rvr[i + 1] << 16); }
#pragma unroll
          for (int j = 0; j < TPV / 8; ++j) { v4u w; w.x = rvv[4 * j]; w.y = rvv[4 * j + 1]; w.z = rvv[4 * j + 2]; w.w = rvv[4 * j + 3];
              *(v4u*)(vt_ + ((sv * TPV + 8 * j) ^ ((ev & 8) << 1))) = w; } }
        if (unit + F.G < NUNITS) PREP_LOAD(unit + F.G);
        __syncthreads();
        if (F.wave < 3) { const int tt = F.wave >= 1, st = F.wave == 2; f32x4 acc = {0.f, 0.f, 0.f, 0.f};
#pragma unroll
            for (int i = 0; i < DK / 32; ++i) { const rbf16x8 a = *(const LAS rbf16x8*)(km + (16 * st + el) * QP + 32 * i + 8 * q4), bq = *(const LAS rbf16x8*)(qm + (16 * tt + el) * QP + 32 * i + 8 * q4);
                acc = __builtin_amdgcn_mfma_f32_16x16x32_bf16(a, bq, acc, 0, 0, 0); }
            const int ta = 16 * tt + el, s0 = 16 * st + 4 * q4;
            const float p0 = s0 + 0 <= ta ? acc[0] : 0.f, p1 = s0 + 1 <= ta ? acc[1] : 0.f, p2 = s0 + 2 <= ta ? acc[2] : 0.f, p3 = s0 + 3 <= ta ? acc[3] : 0.f;
            v2u w; w.x = pk2(p0, p1); w.y = pk2(p2, p3); *(v2u*)(Pb + ta * CH + (s0 ^ ((ta & 8) << 1))) = w; }
        else if (F.wave == 3) { v2u w; w.x = 0u; w.y = 0u; *(v2u*)(Pb + el * CH + ((16 + 4 * q4) ^ ((el & 8) << 1))) = w; }
        __syncthreads();
    }
#undef PREP_LOAD
}

template <bool GLA>
__device__ __forceinline__ void rec_seq(Frame& F, const unsigned char* rec, float* O, const bf16* proj, const float* gain, bf16* cat) {
    using C = RecCfg<GLA>;
    constexpr int DK = C::DK, DVH = C::DVH, NH = C::NH, CH = C::CH, NCH = C::NCH, QP = C::QP, NSL = C::NSL, NDT = DK / 16, NKS = DK / 32;
    constexpr int NBUF = 3, PF = NBUF - 1;
    constexpr int BUFG = C::BUF_B + (GLA ? 0 : 8192);
    constexpr int NWAIT = (PF - 1) * ((C::NR - 1) + (GLA ? 0 : 1) + 2);
    static_assert(NBUF * BUFG + 2048 <= RING_BYTES, "rec ring");
    constexpr int NUNITS = BATCH * NH * NSL;
    const int lane = F.lane, el = lane & 15, q4 = lane >> 4, wave = F.wave;
    for (int unit = F.bid; unit < NUNITS; unit += F.G) {
        const int sl = unit % NSL, h = (unit / NSL) % NH, b = unit / (NSL * NH);
        const unsigned char* ubase = rec + (size_t)((b * NH + h) * NCH) * C::UNIT_B;
#define REC_DMA(cc) do { const unsigned char* ub_ = ubase + (size_t)(cc) * C::UNIT_B; const int bufi_ = (cc) % NBUF; _Pragma("unroll") for (int r_ = 0; r_ < C::NR; ++r_) { const int p_ = r_ * 8 + wave; \
            if (p_ < C::NP) { const unsigned char* src_ = ub_ + (p_ < C::NP1 ? p_ * 1024 : C::OFF_VT + sl * 8192 + (p_ - C::NP1) * 1024) + lane * 16; \
                __builtin_amdgcn_global_load_lds((const unsigned*)src_, (LAS unsigned*)(F.lds + bufi_ * BUFG + p_ * 1024), 16, 0, 0); } } \
            if (!GLA) { const unsigned char* gsrc_ = (const unsigned char*)(proj + ((size_t)b * T + (size_t)(cc) * CH + 4 * wave + (lane >> 4)) * AB_N + 3072 + h * DVH) + (lane & 15) * 16; \
                __builtin_amdgcn_global_load_lds((const unsigned*)gsrc_, (LAS unsigned*)(F.lds + bufi_ * BUFG + C::BUF_B + wave * 1024), 16, 0, 0); } } while (0)
        f32x4 S[NDT];
#pragma unroll
        for (int i = 0; i < NDT; ++i) S[i] = (f32x4){0.f, 0.f, 0.f, 0.f};
#pragma unroll
        for (int cc = 0; cc < PF; ++cc) REC_DMA(cc);
        float* Ob = O + ((size_t)b * T) * C::OPITCH + h * DVH + sl * 128 + 16 * wave + 4 * q4;
        LAS float* ssq = (LAS float*)(F.lds + NBUF * BUFG);
        f32x4 oprev[2] = {{0.f, 0.f, 0.f, 0.f}, {0.f, 0.f, 0.f, 0.f}};
        v2u gsave[2] = {{0u, 0u}, {0u, 0u}};
        const unsigned ecol = (unsigned)(h * DVH + 16 * wave + 4 * q4);
        f32x4 gn4 = {1.f, 1.f, 1.f, 1.f}; if (!GLA) gn4 = *(const f32x4*)(gain + ecol);
#define REC_FINISH(cp) do { _Pragma("unroll") for (int tt = 0; tt < 2; ++tt) { const int tl = 16 * tt + el; float tot = 0.f; \
            _Pragma("unroll") for (int w_ = 0; w_ < 8; ++w_) tot += ssq[(((cp) & 1) * 8 + w_) * 32 + tl]; \
            const float rstd = 1.0f / sqrtf(tot * (1.f / 128.f) + EPS); const size_t row_ = (size_t)b * T + (size_t)(cp) * CH + tl; \
            const v2u gw_ = gsave[tt]; const f32x4 ov = oprev[tt]; \
            v2u w_o; w_o.x = pk2(ov.x * rstd * gn4.x * silu_x(bf_lo(gw_.x)), ov.y * rstd * gn4.y * silu_x(bf_hi(gw_.x))); \
            w_o.y = pk2(ov.z * rstd * gn4.z * silu_x(bf_lo(gw_.y)), ov.w * rstd * gn4.w * silu_x(bf_hi(gw_.y))); \
            *(v2u*)(cat + row_ * DM + ecol) = w_o; } } while (0)
        for (int c = 0; c < NCH; ++c) {
            if (c <= PF) asm volatile("s_waitcnt vmcnt(0)" ::: "memory"); else asm volatile("s_waitcnt vmcnt(%0)" :: "i"(NWAIT) : "memory");
            asm volatile("s_waitcnt lgkmcnt(0)" ::: "memory"); __builtin_amdgcn_s_barrier(); asm volatile("" ::: "memory");
            if (!GLA) {
                if (c > 0) REC_FINISH(c - 1);
                else { v2u z; z.x = 0u; z.y = 0u; *(v2u*)(cat + ((size_t)b * T + el) * DM + ecol) = z; *(v2u*)(cat + ((size_t)b * T + 16 + el) * DM + ecol) = z; }
            }
            if (c + PF < NCH) REC_DMA(c + PF); else REC_DMA(NCH - 1);
            const LAS unsigned char* L = F.lds + (c % NBUF) * BUFG;
            rbf16x8 sf[NKS];
#pragma unroll
            for (int i = 0; i < NKS; ++i) sf[i] = rpack8(S[2 * i], S[2 * i + 1]);
            f32x4 o[2];
#pragma unroll
            for (int tt = 0; tt < 2; ++tt) { o[tt] = (f32x4){0.f, 0.f, 0.f, 0.f};
#pragma unroll
                for (int i = 0; i < NKS; ++i) { const rbf16x8 qf = *(const LAS rbf16x8*)(L + C::OFF_QT + ((16 * tt + el) * QP + 32 * i + 8 * q4) * 2);
                    o[tt] = __builtin_amdgcn_mfma_f32_16x16x32_bf16(sf[i], qf, o[tt], 0, 0, 0); } }
            const rbf16x8 vf = *(const LAS rbf16x8*)(L + C::OFF_VT + ((16 * wave + el) * CH + 8 * q4) * 2);
#pragma unroll
            for (int tt = 0; tt < 2; ++tt) { const rbf16x8 pf = *(const LAS rbf16x8*)(L + C::OFF_P + ((16 * tt + el) * CH + 8 * q4) * 2);
                o[tt] = __builtin_amdgcn_mfma_f32_16x16x32_bf16(vf, pf, o[tt], 0, 0, 0); }
#pragma unroll
            for (int dt = 0; dt < NDT; ++dt) { const f32x4 a4 = *(const LAS f32x4*)(L + C::OFF_A + (16 * dt + 4 * q4) * 4); S[dt] = S[dt] * a4;
                const rbf16x8 kf = *(const LAS rbf16x8*)(L + C::OFF_KT + ((16 * dt + el) * CH + 8 * q4) * 2);
                S[dt] = __builtin_amdgcn_mfma_f32_16x16x32_bf16(kf, vf, S[dt], 0, 0, 0); }
            if (GLA) {
#pragma unroll
                for (int tt = 0; tt < 2; ++tt) *(f32x4*)(Ob + (size_t)(c * CH + 16 * tt + el) * C::OPITCH) = o[tt];
            } else {
#pragma unroll
                for (int tt = 0; tt < 2; ++tt) { float p = (o[tt].x * o[tt].x + o[tt].y * o[tt].y) + (o[tt].z * o[tt].z + o[tt].w * o[tt].w); p = xsum<16>(p); p = xsum<32>(p);
                    if (q4 == 0) ssq[((c & 1) * 8 + wave) * 32 + 16 * tt + el] = p; oprev[tt] = o[tt];
                    gsave[tt] = *(const LAS v2u*)(L + C::BUF_B + ((16 * tt + el) * 128 + 16 * wave + 4 * q4) * 2); }
            }
        }
        asm volatile("s_waitcnt vmcnt(0)" ::: "memory"); __syncthreads();
        if (!GLA) { REC_FINISH(NCH - 1); }
        __syncthreads();
#undef REC_FINISH
#undef REC_DMA
    }
}

template <bool GLA>
__device__ __forceinline__ void rec_seq2(Frame& F, const unsigned char* rec, bf16* O) {
    using C = RecCfg<GLA>;
    constexpr int DK = C::DK, DVH = C::DVH, NH = C::NH, CH = C::CH, NCH = C::NCH, QP = C::QP;
    constexpr int NDH = DK / 32, NKH = DK / 64;
    constexpr int ES = 64, NSL = DVH / ES, BUF2 = C::OFF_VT + ES * CH * 2, NP1 = C::OFF_VT / 1024, NP = NP1 + ES * CH * 2 / 1024, NR = NP / 8;
    constexpr int NBUF = GLA ? 3 : 5, PF = NBUF - 1, NWAIT = (PF - 1) * (NR + 1);
    static_assert(NP % 8 == 0 && NBUF * BUF2 + 2 * 8 * 1024 <= RING_BYTES, "rec_seq2 ring");
    constexpr int NUNITS = BATCH * NH * NSL;
    const int lane = F.lane, el = lane & 15, q4 = lane >> 4, wave = F.wave, eg = wave & 3, dg = wave >> 2;
    LAS unsigned char* xch = F.lds + NBUF * BUF2;
    for (int unit = F.bid; unit < NUNITS; unit += F.G) {
        const int sl = unit % NSL, h = (unit / NSL) % NH, b = unit / (NSL * NH);
        const unsigned char* ubase = rec + (size_t)((b * NH + h) * NCH) * C::UNIT_B;
#define G2_DMA(cc) do { const unsigned char* ub_ = ubase + (size_t)(cc) * C::UNIT_B; const int bufi_ = (cc) % NBUF; _Pragma("unroll") for (int r_ = 0; r_ < NR; ++r_) { const int p_ = r_ * 8 + wave; \
            const unsigned char* src_ = ub_ + (p_ < NP1 ? p_ * 1024 : C::OFF_VT + sl * (ES * CH * 2) + (p_ - NP1) * 1024) + lane * 16; \
            __builtin_amdgcn_global_load_lds((const unsigned*)src_, (LAS unsigned*)(F.lds + bufi_ * BUF2 + p_ * 1024), 16, 0, 0); } } while (0)
        f32x4 S[NDH];
#pragma unroll
        for (int i = 0; i < NDH; ++i) S[i] = (f32x4){0.f, 0.f, 0.f, 0.f};
#pragma unroll
        for (int cc = 0; cc < PF; ++cc) G2_DMA(cc);
        bf16* Ob = O + ((size_t)b * T + 16 * dg + el) * C::OPITCH + h * DVH + sl * ES + 16 * eg + 4 * q4;
#define G2_ST(p_, v_) do { const f32x4 v4_ = (v_); v2u w2_; w2_.x = pg8::cvt_pk_bf16(v4_.x, v4_.y); w2_.y = pg8::cvt_pk_bf16(v4_.z, v4_.w); *(v2u*)(p_) = w2_; } while (0)
        f32x4 okeep = {0.f, 0.f, 0.f, 0.f};
        for (int c = 0; c < NCH; ++c) {
            if (c <= PF) asm volatile("s_waitcnt vmcnt(0)" ::: "memory"); else asm volatile("s_waitcnt vmcnt(%0)" :: "i"(NWAIT) : "memory");
            asm volatile("s_waitcnt lgkmcnt(0)" ::: "memory"); __builtin_amdgcn_s_barrier(); asm volatile("" ::: "memory");
            if (c + PF < NCH) G2_DMA(c + PF); else G2_DMA(NCH - 1);
            const LAS unsigned char* L = F.lds + (c % NBUF) * BUF2;
            rbf16x8 qf[2][NKH], kf[NDH]; f32x4 a4[NDH];
#pragma unroll
            for (int tt = 0; tt < 2; ++tt)
#pragma unroll
                for (int i = 0; i < NKH; ++i) qf[tt][i] = *(const LAS rbf16x8*)(L + C::OFF_QT + ((16 * tt + el) * QP + 32 * (NKH * dg + i) + 8 * q4) * 2);
            const int sw8 = (8 * q4) ^ ((el & 8) << 1);
            const rbf16x8 vf = *(const LAS rbf16x8*)(L + C::OFF_VT + ((16 * eg + el) * CH + sw8) * 2);
            const rbf16x8 pf = *(const LAS rbf16x8*)(L + C::OFF_P + ((16 * dg + el) * CH + sw8) * 2);
#pragma unroll
            for (int j = 0; j < NDH; ++j) { kf[j] = *(const LAS rbf16x8*)(L + C::OFF_KT + ((16 * (NDH * dg + j) + el) * CH + sw8) * 2); a4[j] = *(const LAS f32x4*)(L + C::OFF_A + (16 * (NDH * dg + j) + 4 * q4) * 4); }
            rbf16x8 sf[NKH];
#pragma unroll
            for (int i = 0; i < NKH; ++i) sf[i] = rpack8(S[2 * i], S[2 * i + 1]);
            f32x4 o[2];
#pragma unroll
            for (int tt = 0; tt < 2; ++tt) { o[tt] = (f32x4){0.f, 0.f, 0.f, 0.f};
#pragma unroll
                for (int i = 0; i < NKH; ++i) o[tt] = __builtin_amdgcn_mfma_f32_16x16x32_bf16(sf[i], qf[tt][i], o[tt], 0, 0, 0); }
            if (dg == 0) o[0] = __builtin_amdgcn_mfma_f32_16x16x32_bf16(vf, pf, o[0], 0, 0, 0); else o[1] = __builtin_amdgcn_mfma_f32_16x16x32_bf16(vf, pf, o[1], 0, 0, 0);
#pragma unroll
            for (int j = 0; j < NDH; ++j) { S[j] = S[j] * a4[j]; S[j] = __builtin_amdgcn_mfma_f32_16x16x32_bf16(kf[j], vf, S[j], 0, 0, 0); }
            if (c > 0) { const f32x4 pr = *(const LAS f32x4*)(xch + ((((c - 1) & 1) * 8 + (wave ^ 4)) * 64 + lane) * 16);
                         G2_ST(Ob + (size_t)((c - 1) * CH) * C::OPITCH, okeep + pr); }
            else { G2_ST(Ob, okeep); }
            *(LAS f32x4*)(xch + (((c & 1) * 8 + wave) * 64 + lane) * 16) = dg == 0 ? o[1] : o[0];
            okeep = dg == 0 ? o[0] : o[1];
        }
        asm volatile("s_waitcnt vmcnt(0) lgkmcnt(0)" ::: "memory"); __syncthreads();
        { const f32x4 pr = *(const LAS f32x4*)(xch + ((((NCH - 1) & 1) * 8 + (wave ^ 4)) * 64 + lane) * 16); G2_ST(Ob + (size_t)((NCH - 1) * CH) * C::OPITCH, okeep + pr); }
        __syncthreads();
#undef G2_ST
#undef G2_DMA
    }
}
#define WSP(T_, off) ((T_*)(ws + (off)))
#define REFRAME() CArgs* ap = opq_args(); unsigned char* ws = ap->ws; (void)ws; \
    F.lds = (LAS unsigned char*)lds; F.tid = opq_tid(wave_s); F.lane = F.tid & 63; F.wave = __builtin_amdgcn_readfirstlane(F.tid >> 6); F.G = gridDim.x; F.bid = opq_bid()
#ifndef DBG_DOUBLE
#define DBG_DOUBLE 0
#endif
#define NREP(bit) ((DBG_DOUBLE & (bit)) ? 2 : 1)
#define REPBAR(rep, n) do { if ((rep) + 1 < (n)) xcd_barrier<false>(bar, F.tid == 0); } while (0)
#define IN(k) (lo <= (k) && (k) < hi)
#define SEAM(k) do { if (IN(k) && IN((k) + 1)) xcd_barrier<false>(bar, F.tid == 0); } while (0)
template <int layer>
__device__ __forceinline__ void layer_phases(unsigned char* lds, const int wave_s, const int lo, const int hi, const XcdBarrier& bar) {
    Frame F;

        constexpr int pb = phase_base(layer); constexpr bool odd = layer & 1; constexpr int li = layer >> 1;
        constexpr int P_NORM1 = pb, P_MIXIN = pb + 1, P_PREP = pb + 2, P_REC = pb + 3, P_POST = pb + 4, P_MIXOUT = pb + 5, P_NORM2 = P_MIXOUT + 1, P_FFIN = P_MIXOUT + 2, P_FFOUT = P_MIXOUT + 3;
#define MODL (WSP(float, WS_MOD) + (size_t)layer * 2 * 6 * DM)
#define XCUR (layer == 0 ? ap->in[0] : (const float*)ap->out)
        if (IN(P_NORM1)) { REFRAME();
            const float* modl = MODL;
            for (int rep = 0; rep < NREP(2); ++rep) {
            constexpr bool L0 = layer == 0; const float* g2p = WSP(float, WS_MOD) + (size_t)(L0 ? 0 : layer - 1) * 2 * 6 * DM + 5 * DM; const void* xin = L0 ? (const void*)ap->in[0] : (const void*)WSP(const bf16, WS_XB);
            if (!odd) norm_phase<8, 1, !L0, L0>(F, xin, ap->in[4] + (size_t)layer * DM, modl, modl + DM, WSP(bf16, WS_H), ap->in[6] + (size_t)li * DM * AB_IN + AB_N, AB_IN, ap->in[12] + li * 8, WSP(float, WS_LOGF), WSP(const bf16, WS_Y), g2p, WSP(bf16, WS_XB));
            else norm_phase<16, 2, !L0, L0>(F, xin, ap->in[4] + (size_t)layer * DM, modl, modl + DM, WSP(bf16, WS_H), ap->in[13] + (size_t)li * DM * C_IN + C_N, C_IN, nullptr, WSP(float, WS_GLOW), WSP(const bf16, WS_Y), g2p, WSP(bf16, WS_XB));
            REPBAR(rep, NREP(2)); }
            SEAM(P_NORM1);
        }
        if (IN(P_MIXIN)) { REFRAME();
            const int N = odd ? 4096 : AB_N, ldc = odd ? C_N : AB_N;
            const bf16* Wt = odd ? WSP(const bf16, WS_W_GLIN) + (size_t)li * C_N * DM : WSP(const bf16, WS_W_ABIN) + (size_t)li * AB_N * DM;
            pg8::Gemm g{WSP(const bf16, WS_H), Wt, M, N, DM}; pg8::StaticOrder S; S.init(M, N, F.G, F.bid);
            pg8::EpiBf16 E{WSP(bf16, WS_PROJ), ldc};
            for (int rep = 0; rep < NREP(1); ++rep) { pg8::gemm_phase<pg8::EpiBf16, pg8::StaticOrder, true, true>(F.lds + RING_OFF, g, S, E, F.tid); REPBAR(rep, NREP(1)); }
            SEAM(P_MIXIN);
        }
        if (IN(P_PREP)) { REFRAME();
            if (!odd) { fox_prep(F, WSP(bf16, WS_PROJ), ap->in[10] + li * 128, ap->in[11] + li * 128, WSP(float, WS_LOGF), WSP(float, WS_BIAS));
                        __syncthreads();
                        for (int rep = 0; rep < NREP(4); ++rep) { rec_prep<false>(F, WSP(const bf16, WS_PROJ), ws + WS_REC, ap->in[8], li, nullptr, nullptr, nullptr); REPBAR(rep, NREP(4)); } }
            else for (int rep = 0; rep < NREP(4); ++rep) { rec_prep<true>(F, WSP(const bf16, WS_PROJ), ws + WS_REC, nullptr, 0, WSP(float, WS_GLOW), ap->in[14] + (size_t)li * 16 * 1024, ap->in[15] + li * 1024); REPBAR(rep, NREP(4)); }
            SEAM(P_PREP);
        }
        if (IN(P_REC)) { REFRAME();
            for (int rep = 0; rep < (odd ? NREP(8) : 1); ++rep) {
            if (!odd) { rec_seq2<false>(F, ws + WS_REC, WSP(bf16, WS_O));
                        fox_phase(F, (char*)lds + RING_OFF, WSP(const bf16, WS_PROJ), WSP(bf16, WS_CAT), WSP(float, WS_BIAS), (unsigned*)(ws + WS_CTL) + CW_QUEUE + 64 * (li + 2 * rep), ap->in[10] + li * 128, ap->in[11] + li * 128); }
            else { rec_seq2<true>(F, ws + WS_REC, WSP(bf16, WS_O));
                   if (F.bid >= 64 && rep == 0) {
                       { pg8::Gemm g{WSP(const bf16, WS_H), WSP(const bf16, WS_W_GLIN) + (size_t)li * C_N * DM + (size_t)4096 * DM, M, 2048, DM}; pg8::StaticOrder S; S.init(M, 2048, F.G - 64, F.bid - 64);
                         pg8::EpiBf16 E{WSP(bf16, WS_PROJ) + 4096, C_N};
                         pg8::gemm_phase<pg8::EpiBf16, pg8::StaticOrder, true, true>(F.lds + RING_OFF, g, S, E, F.tid); }
                       LAS float* scr = (LAS float*)(F.lds + RING_OFF + F.wave * 16640);
                       convert_weights<(layer == 1 ? 1 : 2)>(ap, scr, (F.bid - 64) * NWAVES + F.wave, (F.G - 64) * NWAVES, F.lane); } }
            REPBAR(rep, (odd ? NREP(8) : 1)); }
            SEAM(P_REC);
        }
        if (IN(P_POST)) { REFRAME();
            if (!odd) post_even(F, WSP(const bf16, WS_O), WSP(const bf16, WS_PROJ), ap->in[9] + li * 1024, WSP(bf16, WS_CAT));
            else for (int rep = 0; rep < NREP(16); ++rep) { post_odd(F, WSP(const bf16, WS_O), WSP(const bf16, WS_PROJ), ap->in[16] + li * 512, WSP(bf16, WS_CAT)); REPBAR(rep, NREP(16)); }
            SEAM(P_POST);
        }
        if (IN(P_MIXOUT)) { REFRAME();
            const float* modl = MODL;
            const bf16* Wt = odd ? WSP(const bf16, WS_W_GLOUT) + (size_t)li * DM * DM : WSP(const bf16, WS_W_ABOUT) + (size_t)li * DM * DM;
            pg8::Gemm g{WSP(const bf16, WS_CAT), Wt, M, DM, DM}; pg8::StaticOrder S; S.init(M, DM, F.G, F.bid);
            pg8::EpiBf16 E{WSP(bf16, WS_Y), DM};
            pg8::gemm_phase<pg8::EpiBf16, pg8::StaticOrder, true, true>(F.lds + RING_OFF, g, S, E, F.tid);
            SEAM(P_MIXOUT);
        }
        if (IN(P_NORM2)) { REFRAME();
            const float* modl = MODL;
            { constexpr bool L0 = layer == 0; const void* xin = L0 ? (const void*)ap->in[0] : (const void*)WSP(const bf16, WS_XB);
              norm_phase<0, 0, true, L0>(F, xin, ap->in[5] + (size_t)layer * DM, modl + 3 * DM, modl + 4 * DM, WSP(bf16, WS_H), nullptr, 0, nullptr, nullptr, WSP(const bf16, WS_Y), modl + 2 * DM, WSP(bf16, WS_XB)); }
            SEAM(P_NORM2);
        }
        if (IN(P_FFIN)) { REFRAME();
            pg8::Gemm g{WSP(const bf16, WS_H), WSP(const bf16, WS_W_FFIN) + (size_t)layer * FF2 * DM, M, FF2, DM}; pg8::StaticOrder S; S.init(M, FF2, F.G, F.bid);
            pg8::EpiSwiglu E{WSP(bf16, WS_FFH), FF};
            for (int rep = 0; rep < NREP(1 | 128); ++rep) { pg8::gemm_phase<pg8::EpiSwiglu, pg8::StaticOrder, true, true>(F.lds + RING_OFF, g, S, E, F.tid); REPBAR(rep, NREP(1 | 128)); }
            SEAM(P_FFIN);
        }
        if (IN(P_FFOUT)) { REFRAME();
            const float* modl = MODL;
            pg8::Gemm g{WSP(const bf16, WS_FFH), WSP(const bf16, WS_W_FFOUT) + (size_t)layer * DM * FF, M, DM, FF}; pg8::StaticOrder S; S.init(M, DM, F.G, F.bid);
            pg8::EpiBf16 E{WSP(bf16, WS_Y), DM};
            pg8::gemm_phase<pg8::EpiBf16, pg8::StaticOrder, true, true>(F.lds + RING_OFF, g, S, E, F.tid);
            SEAM(P_FFOUT);
        }
    }
__global__ void __launch_bounds__(NTHREADS, 2) trunk_fwd(Args args_unused) {
    extern __shared__ __attribute__((aligned(16))) unsigned char lds[];
    Frame F;
    const int wave_s = __builtin_amdgcn_readfirstlane(threadIdx.x >> 6);
    int lo, hi, use_bar; XcdBarrier bar;
    {
        REFRAME();
        volatile LAS unsigned* MISC = (volatile LAS unsigned*)(F.lds + MISC_OFF);
        for (int u = F.tid; u < (LDS_BYTES - LDSCTL_OFF) / 4; u += NTHREADS) ((LAS unsigned*)(F.lds + LDSCTL_OFF))[u] = 0u;
        __syncthreads();
        lo = ap->ph_lo; hi = ap->ph_hi; use_bar = ap->use_bar;
        bar.bar = (unsigned*)(ws + WS_CTL) + CW_BAR; bar.x = 0; bar.st = MISC + 8;
        if (use_bar) bar = xcd_barrier_post((unsigned*)(ws + WS_CTL) + CW_BAR, MISC + 8, F.tid == 0);
    }

    if (IN(0)) { REFRAME(); p0_prologue(F, ap); if (IN(1)) xcd_barrier<true>(bar, F.tid == 0);
        if (DBG_DOUBLE & 32) { p0_prologue(F, ap); xcd_barrier<false>(bar, F.tid == 0); } }

    layer_phases<0>(lds, wave_s, lo, hi, bar);
    layer_phases<1>(lds, wave_s, lo, hi, bar);
    layer_phases<2>(lds, wave_s, lo, hi, bar);
    layer_phases<3>(lds, wave_s, lo, hi, bar);
    if (IN(phase_base(DEPTH))) { REFRAME(); resid_final(F, WSP(const bf16, WS_XB), WSP(const bf16, WS_Y), WSP(float, WS_MOD) + (size_t)(DEPTH - 1) * 2 * 6 * DM + 5 * DM, ap->out); }
#undef IN
#undef SEAM
}

#ifndef DBG_CHECK
#define DBG_CHECK 0
#endif
#if DBG_CHECK
#ifndef DBG_REPORT_ERR
#define DBG_REPORT_ERR 1
#endif
constexpr size_t WS_DBG = 5 * MiB;
constexpr size_t WS_DBG_OLD = 1072 * MiB;
__device__ __forceinline__ unsigned dbg_hash(unsigned x) { x ^= x >> 16; x *= 0x7feb352dU; x ^= x >> 15; x *= 0x846ca68bU; x ^= x >> 16; return x; }
__device__ __forceinline__ float dbg_bfr(float f) { return __builtin_bit_cast(float, f2bf(f) << 16); }
__device__ __forceinline__ void dbg_cmp(unsigned* dbg, unsigned code, float got, float ref, float rtol, float atol) {
    const float err = fabsf(got - ref); const bool bad = !(err <= atol + rtol * fabsf(ref));
    if (bad) { atomicMin(dbg, code); atomicMax(dbg + 1 + (code & 255u), __float_as_uint(err)); }
}
__global__ void dbg_gemm(unsigned* dbg, unsigned code, int mode, const bf16* A, int K, const float* W, int ldw, int N, const void* C, int ldc, const float* old, const float* gate0, const float* gate1) {
    const unsigned s = blockIdx.x * blockDim.x + threadIdx.x; const unsigned hsh = dbg_hash(s * 2654435761u + code);
    const int m = hsh % M, n = dbg_hash(hsh) % N;
    float d0 = 0.f, d1 = 0.f;
    for (int k = 0; k < K; ++k) { const float a = bf1(A[(size_t)m * K + k]); d0 += a * dbg_bfr(W[(size_t)k * ldw + n]); if (mode == 1) d1 += a * dbg_bfr(W[(size_t)k * ldw + FF + n]); }
    float got, ref;
    if (mode == 0) { got = bf1(((const bf16*)C)[(size_t)m * ldc + n]); ref = d0; }
    else if (mode == 1) { got = bf1(((const bf16*)C)[(size_t)m * ldc + n]); ref = d0 / (1.f + expf(-d0)) * d1; }
    else { got = ((const float*)C)[(size_t)m * ldc + n]; ref = old[(size_t)m * ldc + n] + (m >= T ? gate1 : gate0)[n] * d0; }
    dbg_cmp(dbg, code, got, ref, 0.02f, 0.03f);
}
__global__ void dbg_norm(unsigned* dbg, unsigned code, const float* x, const float* gain, const float* sh, const float* sc, const bf16* h) {
    const unsigned s = blockIdx.x * blockDim.x + threadIdx.x; const unsigned hsh = dbg_hash(s * 2654435761u + code);
    const int m = hsh % M, k = dbg_hash(hsh) % DM, b = m / T;
    double ss = 0.0; for (int i = 0; i < DM; ++i) { const double v = x[(size_t)m * DM + i]; ss += v * v; }
    const float rstd = (float)(1.0 / sqrt(ss / DM + 1e-6));
    const float ref = x[(size_t)m * DM + k] * rstd * gain[k] * (1.f + sc[(size_t)b * 6 * DM + k]) + sh[(size_t)b * 6 * DM + k];
    dbg_cmp(dbg, code, bf1(h[(size_t)m * DM + k]), ref, 0.01f, 0.01f);
}
__global__ void dbg_mod(unsigned* dbg, unsigned code, const float* c, const float* mw, const float* mb, const float* mod) {
    const unsigned s = blockIdx.x * blockDim.x + threadIdx.x; const unsigned hsh = dbg_hash(s * 2654435761u + code);
    const int layer = hsh % DEPTH, b = (hsh >> 8) & 1, j = dbg_hash(hsh) % (6 * DM);
    double acc = mb[(size_t)layer * 6 * DM + j];
    for (int k = 0; k < DM; ++k) { const double cv = c[b * DM + k]; acc += cv / (1.0 + exp(-cv)) * mw[((size_t)layer * DM + k) * (6 * DM) + j]; }
    dbg_cmp(dbg, code, mod[((size_t)layer * 2 + b) * 6 * DM + j], (float)acc, 1e-3f, 1e-4f);
}
__global__ void dbg_small(unsigned* dbg, unsigned code, int mode, const bf16* h, const float* W, int ldw, const float* fbias, const float* sout) {
    const unsigned s = blockIdx.x * blockDim.x + threadIdx.x; const unsigned hsh = dbg_hash(s * 2654435761u + code);
    const int m = hsh % M, cc = dbg_hash(hsh) % (mode == 1 ? 8 : 16), b = m / T, t = m % T;
    double acc = 0.0; for (int k = 0; k < DM; ++k) acc += (double)bf1(h[(size_t)m * DM + k]) * W[(size_t)k * ldw + cc];
    if (mode == 1) { const double xx = acc + fbias[cc]; const double ref = (xx < 0 ? xx : 0.0) - log1p(exp(-fabs(xx))); dbg_cmp(dbg, code, sout[((size_t)b * 8 + cc) * T + t], (float)ref, 0.02f, 0.02f); }
    else dbg_cmp(dbg, code, sout[(size_t)m * 16 + cc], (float)acc, 0.02f, 0.02f);
}
__global__ void dbg_cmpbuf(unsigned* dbg, unsigned code, const float* a, const float* b, size_t n) {
    for (size_t i = (size_t)blockIdx.x * blockDim.x + threadIdx.x; i < n; i += (size_t)gridDim.x * blockDim.x * 61) dbg_cmp(dbg, code, b[i], a[i], 0.05f, 0.1f);
}
__global__ void dbg_report(const unsigned* dbg, float* out) {
    if (threadIdx.x == 0 && blockIdx.x == 0) { const unsigned code = dbg[0]; if (code != 0xffffffffu) { out[0] = DBG_REPORT_ERR ? 1000.f * __uint_as_float(dbg[1 + (code & 255u)]) : 1000.f * (float)(code & 255u); } }
}
#endif
#ifndef N_LAUNCH_MODE
#define N_LAUNCH_MODE 1
#endif
extern "C" void kernel_launch(void* const* d_in, const int* in_sizes, int n_in, void* d_out, int out_size, void* d_ws, size_t ws_size, hipStream_t stream) {
    static int grid = 0;
    if (grid == 0) {
        if (n_in != 20 || out_size != M * DM || ws_size < WS_END) { fprintf(stderr, "kernel_launch: unexpected shapes (n_in %d out %d ws %zu)\n", n_in, out_size, ws_size); grid = -1; return; }
        int dev = 0, cus = 0, per_cu = 0;
        if (hipGetDevice(&dev) != hipSuccess || hipDeviceGetAttribute(&cus, hipDeviceAttributeMultiprocessorCount, dev) != hipSuccess) { grid = -1; return; }
        if (hipFuncSetAttribute((const void*)trunk_fwd, hipFuncAttributeMaxDynamicSharedMemorySize, LDS_BYTES) != hipSuccess) { fprintf(stderr, "kernel_launch: hipFuncSetAttribute failed\n"); grid = -1; return; }
        if (hipOccupancyMaxActiveBlocksPerMultiprocessor(&per_cu, (const void*)trunk_fwd, NTHREADS, LDS_BYTES) != hipSuccess || per_cu < 1)
            fprintf(stderr, "kernel_launch: occupancy query reports %d workgroups per CU\n", per_cu);
        (void)hipGetLastError();
        grid = cus;
    }
    if (grid < 0) return;
    if (hipMemsetAsync((char*)d_ws + WS_CTL, 0, CTL_ZERO_BYTES, stream) != hipSuccess) return;
    Args a{};
    for (int i = 0; i < 20; ++i) a.in[i] = (const float*)d_in[i];
    a.out = (float*)d_out; a.ws = (unsigned char*)d_ws; a.pad = 0;
#if N_LAUNCH_MODE == 1
    a.ph_lo = 0; a.ph_hi = N_PHASES; a.use_bar = 1;
    hipLaunchKernelGGL(trunk_fwd, dim3(grid), dim3(NTHREADS), LDS_BYTES, stream, a);
#else
    a.use_bar = 0;
#if DBG_CHECK
    unsigned char* wsb = (unsigned char*)d_ws; unsigned* dbg = (unsigned*)(wsb + WS_DBG);
    hipMemsetAsync(dbg, 0xFF, 4, stream); hipMemsetAsync(dbg + 1, 0, 1024, stream);
    const float* const* in = (const float* const*)a.in; float* outp = (float*)d_out; float* oldp = (float*)(wsb + WS_DBG_OLD);
    bf16* hbuf = (bf16*)(wsb + WS_H); bf16* catb = (bf16*)(wsb + WS_CAT); bf16* projb = (bf16*)(wsb + WS_PROJ); bf16* ffhb = (bf16*)(wsb + WS_FFH);
#endif
    for (int p = 0; p < N_PHASES; ++p) {
        int layer = 0; const int q = phase_kind(p, layer); const int li = layer >> 1; const bool odd = layer & 1; (void)li; (void)odd; (void)q;
#if DBG_CHECK
        const float* modl = (const float*)(wsb + WS_MOD) + (size_t)layer * 2 * 6 * DM; const float* xcur = layer == 0 ? in[0] : outp;
        if (q == K_MIXOUT) hipMemcpyAsync(oldp, xcur, (size_t)M * DM * 4, hipMemcpyDeviceToDevice, stream);
        if (q == K_FFOUT) hipMemcpyAsync(oldp, outp, (size_t)M * DM * 4, hipMemcpyDeviceToDevice, stream);
#endif
        a.ph_lo = p; a.ph_hi = p + 1;
        hipLaunchKernelGGL(trunk_fwd, dim3(grid), dim3(NTHREADS), LDS_BYTES, stream, a);
#if DBG_CHECK
        const unsigned code = 1 + p;
        if (q == K_PRO) dbg_mod<<<16, 256, 0, stream>>>(dbg, code, in[1], in[2], in[3], (const float*)(wsb + WS_MOD));
        if (q == K_NORM1) { dbg_norm<<<16, 256, 0, stream>>>(dbg, code, xcur, in[4] + (size_t)layer * DM, modl, modl + DM, hbuf);
            if (!odd) dbg_small<<<16, 256, 0, stream>>>(dbg, code | 0x100, 1, hbuf, in[6] + (size_t)li * DM * AB_IN + AB_N, AB_IN, in[12] + li * 8, (const float*)(wsb + WS_LOGF));
            else dbg_small<<<16, 256, 0, stream>>>(dbg, code | 0x100, 2, hbuf, in[13] + (size_t)li * DM * C_IN + C_N, C_IN, nullptr, (const float*)(wsb + WS_GLOW)); }
        if (q == K_MIXIN) { if (!odd) dbg_gemm<<<16, 256, 0, stream>>>(dbg, code, 0, hbuf, DM, in[6] + (size_t)li * DM * AB_IN, AB_IN, AB_N, projb, AB_N, nullptr, nullptr, nullptr);
            else dbg_gemm<<<16, 256, 0, stream>>>(dbg, code, 0, hbuf, DM, in[13] + (size_t)li * DM * C_IN, C_IN, C_N, projb, C_N, nullptr, nullptr, nullptr); }
#if DBG_REC
        if (q == K_REC) dbg_cmpbuf<<<256, 256, 0, stream>>>(dbg, code, (const float*)(wsb + WS_O), (const float*)(wsb + 1200 * MiB), odd ? (size_t)M * 2048 : (size_t)M * 1024);
#endif
        if (q == K_MIXOUT) dbg_gemm<<<16, 256, 0, stream>>>(dbg, code, 2, catb, DM, (odd ? in[17] : in[7]) + (size_t)li * DM * DM, DM, DM, outp, DM, oldp, modl + 2 * DM, modl + 6 * DM + 2 * DM);
        if (q == K_NORM2) dbg_norm<<<16, 256, 0, stream>>>(dbg, code, outp, in[5] + (size_t)layer * DM, modl + 3 * DM, modl + 4 * DM, hbuf);
        if (q == K_FFIN) dbg_gemm<<<16, 256, 0, stream>>>(dbg, code, 1, hbuf, DM, in[18] + (size_t)layer * DM * FF2, FF2, FF, ffhb, FF, nullptr, nullptr, nullptr);
        if (q == K_FFOUT) dbg_gemm<<<16, 256, 0, stream>>>(dbg, code, 2, ffhb, FF, in[19] + (size_t)layer * FF * DM, DM, DM, outp, DM, oldp, modl + 5 * DM, modl + 6 * DM + 5 * DM);
#endif
    }
#if DBG_CHECK
    dbg_report<<<1, 64, 0, stream>>>(dbg, outp);
#endif
#endif
}
```

```cpp
#include <hip/hip_runtime.h>
#include <hip/hip_bf16.h>
#include <cstdio>
#include <cstdint>
__device__ __forceinline__ int opq_tid(int wave_s) {
    int t; asm volatile("v_mbcnt_lo_u32_b32 %0, -1, 0\n\tv_mbcnt_hi_u32_b32 %0, -1, %0\n\tv_lshl_add_u32 %0, %1, 6, %0" : "=&v"(t) : "s"(wave_s)); return t; }
__device__ __forceinline__ int opq_bid() { int t = blockIdx.x; asm volatile("" : "+s"(t)); return t; }
template <int MASK> __device__ __forceinline__ float xsum(float v) {
    if constexpr (MASK < 32) { return v + __builtin_bit_cast(float, __builtin_amdgcn_ds_swizzle(__builtin_bit_cast(int, v), (MASK << 10) | 0x1f)); }
    else { auto rr = __builtin_amdgcn_permlane32_swap(__float_as_uint(v), __float_as_uint(v), false, false);
           const unsigned r0 = rr[0], r1 = rr[1];
           return __uint_as_float(r0) + __uint_as_float(r1); }
}
__device__ __forceinline__ float xor1_get(float v) { return __builtin_bit_cast(float, __builtin_amdgcn_ds_swizzle(__builtin_bit_cast(int, v), (1 << 10) | 0x1f)); }
namespace pg8 {
#define PG8_LAS __attribute__((address_space(3)))
typedef unsigned short bf16_t;
typedef short bf16x8 __attribute__((ext_vector_type(8)));
typedef float f32x4 __attribute__((ext_vector_type(4)));
typedef unsigned u32x4 __attribute__((ext_vector_type(4)));
constexpr int BM = 256, BK = 64, HALF = 128, HTB = HALF * BK * 2  , STAGE_BYTES = 8 * HTB, NXCD = 8, WGM = 8;

__host__ __device__ __forceinline__ int lds_byte(int r, int c) { const int st = (r >> 4) * 2 + (c >> 5), rr = r & 15, cc = c & 31, ob = rr * 64 + cc * 2; return st * 1024 + (ob ^ (((ob >> 9) & 1) << 5)); }
__host__ __device__ __forceinline__ void stage_rc(int b, int& R, int& C) { const int st = b / 1024, sb = b % 1024, swz = sb ^ (((sb >> 9) & 1) << 5); R = (st >> 1) * 16 + swz / 64; C = (st & 1) * 32 + (swz % 64) / 2; }
__host__ __device__ __forceinline__ int perm32(int rho) { const int n = rho >> 4, i = rho & 15; return 8 * (i >> 2) + 4 * n + (i & 3); }

struct Unit { int pm, pn; };
struct Gemm { const bf16_t* A; const bf16_t* Bt; int M, N, K; };

struct StaticOrder {
    int nM, nN, nwg, G, c;
    __host__ __device__ void init(int M, int N, int G_, int c_) { nM = M / BM; nN = N / BM; nwg = nM * nN; G = G_; c = c_; }
    __host__ __device__ bool next(int i, Unit& u) const {
        const long L = (long)i * G + c; if (L >= nwg) return false;
        int wgid = (int)L; { const int q = nwg / NXCD, r = nwg % NXCD, xcd = wgid % NXCD, off = wgid / NXCD; wgid = (xcd < r ? xcd * (q + 1) : r * (q + 1) + (xcd - r) * q) + off; }
        const int nig = WGM * nN, gid = wgid / nig, fm = gid * WGM, gsz = (nM - fm) < WGM ? (nM - fm) : WGM;
        u.pm = fm + ((wgid % nig) % gsz); u.pn = (wgid % nig) / gsz; return true;
    }
    __device__ __forceinline__ void a_ready(const Unit&) const {}
    __device__ __forceinline__ void done(const Unit&) const {}
};

__device__ __forceinline__ unsigned cvt_pk_bf16(float lo, float hi) { unsigned r; asm volatile("v_cvt_pk_bf16_f32 %0, %1, %2" : "=v"(r) : "v"(lo), "v"(hi)); return r; }
typedef float f32x2 __attribute__((ext_vector_type(2)));

struct EpiBf16 {
    static constexpr bool PERM = true, AFTER_DRAIN = false;
    bf16_t* O; int ldc;
    __device__ __forceinline__ void operator()(const f32x4 (&acc)[2][2][4][2], const Unit& u, int wr, int wc, int fr, int fq) const {
        const int row0 = u.pm * BM + wr * 64 + fr; const int col0 = u.pn * BM + wc * 32 + 8 * fq;
#pragma unroll
        for (int ai = 0; ai < 2; ++ai)
#pragma unroll
            for (int m = 0; m < 4; ++m) { bf16_t* rowp = O + (size_t)(row0 + ai * HALF + m * 16) * ldc + col0;
#pragma unroll
                for (int bj = 0; bj < 2; ++bj) { const f32x4 v0 = acc[ai][bj][m][0], v1 = acc[ai][bj][m][1];
                    u32x4 w; w.x = cvt_pk_bf16(v0[0], v0[1]); w.y = cvt_pk_bf16(v0[2], v0[3]); w.z = cvt_pk_bf16(v1[0], v1[1]); w.w = cvt_pk_bf16(v1[2], v1[3]);
                    *(u32x4*)(rowp + bj * HALF) = w; } }
    }
};
__device__ __forceinline__ float silu_f(float a) { return a * __builtin_amdgcn_rcpf(1.0f + __builtin_amdgcn_exp2f(-1.4426950408889634f * a)); }
struct EpiSwiglu {
    static constexpr bool PERM = true, AFTER_DRAIN = false;
    bf16_t* O; int ldc;
    __device__ __forceinline__ void operator()(const f32x4 (&acc)[2][2][4][2], const Unit& u, int wr, int wc, int fr, int fq) const {
        const int row0 = u.pm * BM + wr * 64 + fr; const int col0 = u.pn * HALF + wc * 32 + 8 * fq;
#pragma unroll
        for (int ai = 0; ai < 2; ++ai)
#pragma unroll
            for (int m = 0; m < 4; ++m) { bf16_t* rowp = O + (size_t)(row0 + ai * HALF + m * 16) * ldc + col0;
                const f32x4 a0 = acc[ai][0][m][0], a1 = acc[ai][0][m][1], u0 = acc[ai][1][m][0], u1 = acc[ai][1][m][1];
                u32x4 w;
                w.x = cvt_pk_bf16(silu_f(a0[0]) * u0[0], silu_f(a0[1]) * u0[1]); w.y = cvt_pk_bf16(silu_f(a0[2]) * u0[2], silu_f(a0[3]) * u0[3]);
                w.z = cvt_pk_bf16(silu_f(a1[0]) * u1[0], silu_f(a1[1]) * u1[1]); w.w = cvt_pk_bf16(silu_f(a1[2]) * u1[2], silu_f(a1[3]) * u1[3]);
                *(u32x4*)rowp = w; }
    }
};
struct EpiResid {
    static constexpr bool PERM = false, AFTER_DRAIN = false;
    const float* base; float* out; int ldc; const float* gate0; const float* gate1; int pm_split;
    __device__ __forceinline__ void operator()(const f32x4 (&acc)[2][2][4][2], const Unit& u, int wr, int wc, int fr, int fq) const {
        const int col0 = u.pn * BM + wc * 32 + 4 * fq; const float* g = (u.pm >= pm_split) ? gate1 : gate0;
        f32x4 gv[2][2];
#pragma unroll
        for (int bj = 0; bj < 2; ++bj)
#pragma unroll
            for (int n = 0; n < 2; ++n) gv[bj][n] = *(const f32x4*)(g + col0 + bj * HALF + n * 16);
#pragma unroll
        for (int ai = 0; ai < 2; ++ai) { f32x4 bs[4][2][2];
#pragma unroll
            for (int m = 0; m < 4; ++m) { const size_t off = (size_t)(u.pm * BM + ai * HALF + wr * 64 + m * 16 + fr) * ldc + col0;
#pragma unroll
                for (int bj = 0; bj < 2; ++bj)
#pragma unroll
                    for (int n = 0; n < 2; ++n) bs[m][bj][n] = *(const f32x4*)(base + off + bj * HALF + n * 16); }
#pragma unroll
            for (int m = 0; m < 4; ++m) { const size_t off = (size_t)(u.pm * BM + ai * HALF + wr * 64 + m * 16 + fr) * ldc + col0;
#pragma unroll
                for (int bj = 0; bj < 2; ++bj)
#pragma unroll
                    for (int n = 0; n < 2; ++n) *(f32x4*)(out + off + bj * HALF + n * 16) = bs[m][bj][n] + gv[bj][n] * acc[ai][bj][m][n]; }
            asm volatile("" ::: "memory"); }
    }
};

template <class Epi, class Sched, bool ALIGN_EPI = false, bool SP2 = false>
__device__ __forceinline__ void gemm_phase(PG8_LAS unsigned char* lds, const Gemm g, const Sched& S, const Epi& E, const int tid) {
    const int wid = __builtin_amdgcn_readfirstlane(tid >> 6), lane = tid & 63, wr = wid >> 2, wc = wid & 3, fr = lane & 15, fq = lane >> 4;
    const int K = g.K, nt = K / BK;
    unsigned voffA[2], voffB[2];
#pragma unroll
    for (int i = 0; i < 2; ++i) { int R, C; stage_rc(tid * 16 + i * 8192, R, C); const int Rb = Epi::PERM ? ((R & ~31) + perm32(R & 31)) : R;
        voffA[i] = (unsigned)(R * K + C) * 2u; voffB[i] = (unsigned)(Rb * K + C) * 2u; }
    const size_t kstep = (size_t)(BK * 2);
    const size_t hstep = (size_t)HALF * K * 2;
    const size_t tstep = 2 * hstep;
    const unsigned ldsw = (unsigned)wid * 1024u;
    const int aoff = lds_byte(wr * 64 + fr, fq * 8), boff = lds_byte(wc * 32 + fr, fq * 8);
#define PG8_SA(b, h) (((b) * 2 + (h)) * HTB)
#define PG8_SB(b, h) ((4 + (b) * 2 + (h)) * HTB)
#define PG8_STAGE(bufoff, gbase, voff) do { _Pragma("unroll") for (int _i = 0; _i < 2; ++_i) \
        __builtin_amdgcn_global_load_lds((const unsigned*)((const char*)(gbase) + (voff)[_i]), (PG8_LAS unsigned*)(lds + (bufoff) + ldsw + _i * 8192), 16, 0, 0); } while (0)
#define PG8_LDA(dst, b, h) do { _Pragma("unroll") for (int m = 0; m < 4; ++m) _Pragma("unroll") for (int k = 0; k < 2; ++k) dst[m][k] = *(const PG8_LAS bf16x8*)(lds + PG8_SA(b, h) + aoff + m * 2048 + k * 1024); } while (0)
#define PG8_LDB(dst, b, h) do { _Pragma("unroll") for (int n = 0; n < 2; ++n) _Pragma("unroll") for (int k = 0; k < 2; ++k) dst[n][k] = *(const PG8_LAS bf16x8*)(lds + PG8_SB(b, h) + boff + n * 2048 + k * 1024); } while (0)
#define PG8_MMA(ai, bj, At, Bt) do { __builtin_amdgcn_s_setprio(1); _Pragma("unroll") for (int m = 0; m < 4; ++m) _Pragma("unroll") for (int n = 0; n < 2; ++n) _Pragma("unroll") for (int k = 0; k < 2; ++k) \
        acc[ai][bj][m][n] = __builtin_amdgcn_mfma_f32_16x16x32_bf16(Bt[n][k], At[m][k], acc[ai][bj][m][n], 0, 0, 0); __builtin_amdgcn_s_setprio(0); } while (0)
#define PG8_WAIT_V(n) asm volatile("s_waitcnt vmcnt(" #n ")" ::: "memory")
#define PG8_WAIT_L(n) asm volatile("s_waitcnt lgkmcnt(" #n ")" ::: "memory")
#define PG8_BAR __builtin_amdgcn_s_barrier()
#define PG8_SCHED __builtin_amdgcn_sched_barrier(0)
    Unit cur, nxt; int ui = 0;
    if (!S.next(0, cur)) return;
    f32x4 acc[2][2][4][2];
#pragma unroll
    for (int a = 0; a < 2; ++a)
#pragma unroll
        for (int b = 0; b < 2; ++b)
#pragma unroll
            for (int m = 0; m < 4; ++m)
#pragma unroll
                for (int n = 0; n < 2; ++n) acc[a][b][m][n] = (f32x4){0.f, 0.f, 0.f, 0.f};
    bf16x8 At[4][2], B0[2][2], B1[2][2];
    const char* cA = (const char*)g.A + (size_t)cur.pm * tstep; const char* cB = (const char*)g.Bt + (size_t)cur.pn * tstep;
    S.a_ready(cur);
    if constexpr (SP2) {
        PG8_STAGE(PG8_SB(0, 0), cB, voffB); PG8_STAGE(PG8_SB(0, 1), cB + hstep, voffB); PG8_STAGE(PG8_SA(0, 0), cA, voffA); PG8_STAGE(PG8_SA(0, 1), cA + hstep, voffA);
        if (wr == 1) PG8_BAR;
        PG8_WAIT_V(2); PG8_BAR;
        PG8_STAGE(PG8_SB(1, 0), cB + kstep, voffB); PG8_STAGE(PG8_SA(1, 0), cA + kstep, voffA); PG8_STAGE(PG8_SB(1, 1), cB + hstep + kstep, voffB);
        PG8_WAIT_V(6); PG8_BAR;
    } else {
        PG8_STAGE(PG8_SB(0, 0), cB, voffB); PG8_STAGE(PG8_SA(0, 0), cA, voffA); PG8_STAGE(PG8_SB(0, 1), cB + hstep, voffB); PG8_STAGE(PG8_SA(0, 1), cA + hstep, voffA);
        if (wr == 1) PG8_BAR;
        PG8_WAIT_V(4); PG8_BAR;
        PG8_STAGE(PG8_SB(1, 0), cB + kstep, voffB); PG8_STAGE(PG8_SA(1, 0), cA + kstep, voffA); PG8_STAGE(PG8_SB(1, 1), cB + hstep + kstep, voffB);
        PG8_WAIT_V(6); PG8_BAR;
    }
    for (;;) {
        const bool has_next = S.next(ui + 1, nxt);
        const char* nA = has_next ? (const char*)g.A + (size_t)nxt.pm * tstep : cA; const char* nB = has_next ? (const char*)g.Bt + (size_t)nxt.pn * tstep : cB;
        for (int t = 0; t < nt; t += 2) {
            const bool last = (t == nt - 2);
            const char* a1 = cA + (size_t)(t + 1) * kstep;
            const char* a2 = last ? nA : cA + (size_t)(t + 2) * kstep; const char* b2 = last ? nB : cB + (size_t)(t + 2) * kstep;
            const char* a3 = a2 + kstep; const char* b3 = b2 + kstep;
            if (last && has_next) S.a_ready(nxt);
            if constexpr (SP2) {
            PG8_LDB(B0, 0, 0); PG8_LDB(B1, 0, 1); PG8_SCHED; PG8_LDA(At, 0, 0); PG8_STAGE(PG8_SA(1, 1), a1 + hstep, voffA);
            PG8_WAIT_V(8); PG8_WAIT_L(0); PG8_BAR; PG8_MMA(0, 0, At, B0); PG8_MMA(0, 1, At, B1); PG8_BAR; PG8_SCHED;
            PG8_LDA(At, 0, 1); PG8_STAGE(PG8_SB(0, 0), b2, voffB); PG8_STAGE(PG8_SB(0, 1), b2 + hstep, voffB); PG8_STAGE(PG8_SA(0, 0), a2, voffA);
            PG8_WAIT_V(8); PG8_WAIT_L(0); PG8_BAR; PG8_MMA(1, 0, At, B0); PG8_MMA(1, 1, At, B1); PG8_BAR; PG8_SCHED;
            PG8_LDB(B0, 1, 0); PG8_LDB(B1, 1, 1); PG8_SCHED; PG8_LDA(At, 1, 0); PG8_STAGE(PG8_SA(0, 1), a2 + hstep, voffA);
            PG8_WAIT_V(8); PG8_WAIT_L(0); PG8_BAR; PG8_MMA(0, 0, At, B0); PG8_MMA(0, 1, At, B1); PG8_BAR; PG8_SCHED;
            PG8_LDA(At, 1, 1); PG8_STAGE(PG8_SB(1, 0), b3, voffB); PG8_STAGE(PG8_SB(1, 1), b3 + hstep, voffB); PG8_STAGE(PG8_SA(1, 0), a3, voffA);
            PG8_WAIT_V(8); PG8_WAIT_L(0); PG8_BAR; PG8_MMA(1, 0, At, B0); PG8_MMA(1, 1, At, B1); PG8_BAR; PG8_SCHED;
            } else {
            PG8_LDB(B0, 0, 0); PG8_SCHED; PG8_LDA(At, 0, 0); PG8_STAGE(PG8_SA(1, 1), a1 + hstep, voffA);
            PG8_WAIT_L(8); PG8_BAR; PG8_WAIT_L(0); PG8_MMA(0, 0, At, B0); PG8_BAR; PG8_SCHED;
            PG8_LDB(B1, 0, 1); PG8_STAGE(PG8_SB(0, 0), b2, voffB);
            PG8_BAR; PG8_WAIT_L(0); PG8_MMA(0, 1, At, B1); PG8_BAR;
            PG8_LDA(At, 0, 1); PG8_STAGE(PG8_SA(0, 0), a2, voffA);
            PG8_BAR; PG8_WAIT_L(0); PG8_MMA(1, 0, At, B0); PG8_BAR; PG8_SCHED;
            PG8_STAGE(PG8_SB(0, 1), b2 + hstep, voffB);
            PG8_WAIT_V(6); PG8_BAR; PG8_MMA(1, 1, At, B1); PG8_BAR;
            PG8_LDB(B0, 1, 0); PG8_SCHED; PG8_LDA(At, 1, 0); PG8_STAGE(PG8_SA(0, 1), a2 + hstep, voffA);
            PG8_WAIT_L(8); PG8_BAR; PG8_WAIT_L(0); PG8_MMA(0, 0, At, B0); PG8_BAR; PG8_SCHED;
            PG8_LDB(B1, 1, 1); PG8_STAGE(PG8_SB(1, 0), b3, voffB);
            PG8_BAR; PG8_WAIT_L(0); PG8_MMA(0, 1, At, B1); PG8_BAR;
            PG8_LDA(At, 1, 1); PG8_STAGE(PG8_SA(1, 0), a3, voffA);
            PG8_BAR; PG8_WAIT_L(0); PG8_MMA(1, 0, At, B0); PG8_BAR; PG8_SCHED;
            PG8_STAGE(PG8_SB(1, 1), b3 + hstep, voffB);
            PG8_WAIT_V(6); PG8_BAR; PG8_MMA(1, 1, At, B1); PG8_BAR;
            }
        }
        if constexpr (ALIGN_EPI) { if (wr == 0) PG8_BAR; }
        if constexpr (!Epi::AFTER_DRAIN) { E(acc, cur, wr, wc, fr, fq); S.done(cur); }
        if (!has_next) break;
#pragma unroll
        for (int a = 0; a < 2; ++a)
#pragma unroll
            for (int b = 0; b < 2; ++b)
#pragma unroll
                for (int m = 0; m < 4; ++m)
#pragma unroll
                    for (int n = 0; n < 2; ++n) acc[a][b][m][n] = (f32x4){0.f, 0.f, 0.f, 0.f};
        cur = nxt; cA = nA; cB = nB; ++ui;
        if constexpr (ALIGN_EPI) { if (wr == 1) PG8_BAR; }
    }
    PG8_WAIT_V(0);
    if constexpr (!ALIGN_EPI) { if (wr == 0) PG8_BAR; }
    PG8_BAR;
    if constexpr (Epi::AFTER_DRAIN) { E.fused(acc, cur, wr, wc, fr, fq, lds, wid, lane); S.done(cur); }
#undef PG8_SA
#undef PG8_SB
#undef PG8_STAGE
#undef PG8_LDA
#undef PG8_LDB
#undef PG8_MMA
#undef PG8_WAIT_V
#undef PG8_WAIT_L
#undef PG8_BAR
#undef PG8_SCHED
}
}
namespace fox {
constexpr int D = 128, PITCH = 8192, OPITCH = 2048, SKV = 8192, GATE_OFF = 3072;
constexpr float THR = 8.f;
constexpr float SCALE = 0.08838834764831845f;
constexpr int NW = 8, QBLK = 32, KVBLK = 64, QB = NW * QBLK;
constexpr int SHM_V = KVBLK * D * 2, SHM_K = KVBLK * D * 2;
constexpr int BIAS_OFF = 2 * SHM_V + 2 * SHM_K + NW * 64 * 4;
constexpr int LDS_BYTES = BIAS_OFF + SKV * 4;

using bf16 = __hip_bfloat16;
typedef short bf16x8 __attribute__((ext_vector_type(8)));
typedef short s16x4 __attribute__((ext_vector_type(4)));
typedef float f32x16 __attribute__((ext_vector_type(16)));
typedef float f32x4 __attribute__((ext_vector_type(4)));
typedef unsigned u32x4 __attribute__((ext_vector_type(4)));

#define KSWZ(row, colB) ((row) * 256 + ((colB) ^ (((row) & 7) << 4)))
#define SBAR() __builtin_amdgcn_sched_barrier(0)
__device__ __forceinline__ int v_st(int k, int c) { const int kk = (k & ~0xC) | ((k & 4) << 1) | ((k & 8) >> 1); return ((kk >> 3) * 4 + (c >> 5)) * 512 + ((kk & 7) * 32 + (c & 31)) * 2; }
__device__ __forceinline__ int v_rd_base(int lane) { return ((lane & 3) << 3) | (((lane >> 2) & 3) << 6) | (((lane >> 4) & 1) << 5) | (((lane >> 5) & 1) << 8); }
constexpr int v_rd_off(int d0, int ks, int half) { return d0 * 512 + ks * 4096 + half * 2048; }
__device__ __forceinline__ int crow(int r, int hi) { return (r & 3) + 8 * (r >> 2) + 4 * hi; }
__device__ __forceinline__ unsigned cvtpk(float lo, float hi) {
    unsigned r; asm volatile("v_cvt_pk_bf16_f32 %0, %1, %2" : "=v"(r) : "v"(lo), "v"(hi)); return r;
}
__device__ __forceinline__ bf16x8 load8(const bf16* p) { return *reinterpret_cast<const bf16x8*>(p); }
__device__ __forceinline__ void mask_tile(f32x16& p0, f32x16& p1, int dq, unsigned W) {
    const float NEG = -__builtin_inff();
#pragma unroll
    for (int r = 0; r < 16; ++r) {
        const int c = (r & 3) + 8 * (r >> 2);
        if ((unsigned)(dq - c) >= W) p0[r] = NEG;
        if ((unsigned)(dq - c - 32) >= W) p1[r] = NEG;
    }
}
__device__ __forceinline__ void partialSM(f32x16& p0, f32x16& p1, float& m_reg, float& mn, float& alpha) {
    float pmax = p0[0]; for (int r = 1; r < 16; ++r) pmax = fmaxf(pmax, p0[r]); for (int r = 0; r < 16; ++r) pmax = fmaxf(pmax, p1[r]);
    { auto rr = __builtin_amdgcn_permlane32_swap(__float_as_uint(pmax), __float_as_uint(pmax), false, false);
      pmax = fmaxf(__uint_as_float(rr[0]), __uint_as_float(rr[1])); }
    constexpr float C2 = 1.4426950408889634f * SCALE;
    if (__builtin_expect(__all((pmax - m_reg) * SCALE <= THR), 1)) { mn = m_reg; alpha = 1.f; }
    else { mn = fmaxf(m_reg, pmax); alpha = __builtin_amdgcn_exp2f((m_reg - mn) * C2); m_reg = mn; }
    const float mnL = -mn * C2;
    for (int r = 0; r < 16; ++r) p0[r] = fmaf(p0[r], C2, mnL); for (int r = 0; r < 16; ++r) p1[r] = fmaf(p1[r], C2, mnL);
    for (int r = 0; r < 16; ++r) p0[r] = __builtin_amdgcn_exp2f(p0[r]);
}
__device__ __forceinline__ void finishSM(f32x16& p0, f32x16& p1, float alpha, float& l_reg, bf16x8& pa0, bf16x8& pa1, bf16x8& pa2, bf16x8& pa3) {
    for (int r = 0; r < 16; ++r) p1[r] = __builtin_amdgcn_exp2f(p1[r]);
    float ps = 0; for (int r = 0; r < 16; ++r) ps += p0[r]; for (int r = 0; r < 16; ++r) ps += p1[r];
    { auto rr = __builtin_amdgcn_permlane32_swap(__float_as_uint(ps), __float_as_uint(ps), false, false);
      ps = __uint_as_float(rr[0]) + __uint_as_float(rr[1]); }
    l_reg = l_reg * alpha + ps;
#define PK4(P, B_, OUT) do { unsigned a0 = cvtpk(P[B_+0], P[B_+1]), a1 = cvtpk(P[B_+2], P[B_+3]);                          \
        unsigned b0 = cvtpk(P[B_+4], P[B_+5]), b1 = cvtpk(P[B_+6], P[B_+7]);                                             \
        auto r0 = __builtin_amdgcn_permlane32_swap(a0, b0, false, false); auto r1 = __builtin_amdgcn_permlane32_swap(a1, b1, false, false); \
        u32x4 w = {r0[0], r1[0], r0[1], r1[1]}; OUT = *reinterpret_cast<bf16x8*>(&w); } while (0)
    PK4(p0, 0, pa0); PK4(p0, 8, pa1); PK4(p1, 0, pa2); PK4(p1, 8, pa3);
#undef PK4
}
template <int KB>
__device__ __forceinline__ void qkt(f32x16& p0, f32x16& p1, const char* K_lds, const float* bt, int r32, int hi, const bf16x8* qr) {
#pragma unroll
    for (int j = 0; j < 4; ++j) { const f32x4 a = *(const f32x4*)(bt + 8 * j), b = *(const f32x4*)(bt + 32 + 8 * j);
        p0[4 * j + 0] = a[0]; p0[4 * j + 1] = a[1]; p0[4 * j + 2] = a[2]; p0[4 * j + 3] = a[3];
        p1[4 * j + 0] = b[0]; p1[4 * j + 1] = b[1]; p1[4 * j + 2] = b[2]; p1[4 * j + 3] = b[3]; }
    const char* kb[4];
#pragma unroll
    for (int dd = 0; dd < 4; ++dd) kb[dd] = K_lds + KB * SHM_K + KSWZ(r32, (dd * 16 + hi * 8) * 2);
#pragma unroll
    for (int d0 = 0; d0 < 8; ++d0) { const char* a = kb[d0 & 3] + (d0 >> 2) * 128;
        bf16x8 b0 = *reinterpret_cast<const bf16x8*>(a);
        bf16x8 b1 = *reinterpret_cast<const bf16x8*>(a + 32 * 256);
        p0 = __builtin_amdgcn_mfma_f32_32x32x16_bf16(b0, qr[d0], p0, 0, 0, 0);
        p1 = __builtin_amdgcn_mfma_f32_32x32x16_bf16(b1, qr[d0], p1, 0, 0, 0); }
}
template <int VB>
__device__ __forceinline__ void pv_tile(f32x16* o, int vb0, bf16x8 pa0, bf16x8 pa1, bf16x8 pa2, bf16x8 pa3) {
#define TRRD(dst, off) asm volatile("ds_read_b64_tr_b16 %0, %1 offset:%2" : "=&v"(dst) : "v"(vb0), "i"(off) : "memory")
#define PV_D0(d0) do { s16x4 l0, l1, l2, l3, h0, h1, h2, h3; constexpr int b_ = VB * SHM_V + v_rd_off(d0, 0, 0);     \
        TRRD(l0, b_); TRRD(h0, b_ + 2048); TRRD(l1, b_ + 4096); TRRD(h1, b_ + 6144); TRRD(l2, b_ + 8192); TRRD(h2, b_ + 10240); TRRD(l3, b_ + 12288); TRRD(h3, b_ + 14336); \
        asm volatile("s_waitcnt lgkmcnt(0)" ::: "memory"); SBAR();                 \
        o[d0] = __builtin_amdgcn_mfma_f32_32x32x16_bf16(pa0, (bf16x8){l0[0], l0[1], l0[2], l0[3], h0[0], h0[1], h0[2], h0[3]}, o[d0], 0, 0, 0);   \
        o[d0] = __builtin_amdgcn_mfma_f32_32x32x16_bf16(pa1, (bf16x8){l1[0], l1[1], l1[2], l1[3], h1[0], h1[1], h1[2], h1[3]}, o[d0], 0, 0, 0);   \
        o[d0] = __builtin_amdgcn_mfma_f32_32x32x16_bf16(pa2, (bf16x8){l2[0], l2[1], l2[2], l2[3], h2[0], h2[1], h2[2], h2[3]}, o[d0], 0, 0, 0);   \
        o[d0] = __builtin_amdgcn_mfma_f32_32x32x16_bf16(pa3, (bf16x8){l3[0], l3[1], l3[2], l3[3], h3[0], h3[1], h3[2], h3[3]}, o[d0], 0, 0, 0); } while (0)
    PV_D0(0); PV_D0(1); PV_D0(2); PV_D0(3);
#undef PV_D0
#undef TRRD
}

struct BlockRef { const bf16* Q; const bf16* K; const bf16* V; bf16* O; const float* Bias; int P0; float THp; };
struct Seam { bf16x8 qr[8]; bf16x8 st_v0, st_v1, st_k0, st_k1; };
#define ROW(p, k0, rr) ((const bf16*)((const char*)(p) + (size_t)(k0) * (PITCH * 2) + (unsigned)(voff + (unsigned)(rr) * (PITCH * 2u))))
#define VMW() asm volatile("s_waitcnt vmcnt(0)" ::: "memory")
#define VMWN(n) asm volatile("s_waitcnt vmcnt(%0)" :: "i"(n) : "memory")
#define SLOAD_H(Kp, Vp, k0) do { S.st_v0 = load8(ROW(Vp, k0, 0)); S.st_v1 = load8(ROW(Vp, k0, 32));              \
                         S.st_k0 = load8(ROW(Kp, k0, 0)); S.st_k1 = load8(ROW(Kp, k0, 32)); } while (0)
#define SWRITE_HK(bf) do { *(bf16x8*)(K_lds + (bf) * SHM_K + kws) = S.st_k0; *(bf16x8*)(K_lds + (bf) * SHM_K + kws + 32 * 256) = S.st_k1; } while (0)
#define SWRITE_HV(bf) do { *(bf16x8*)(V_lds + (bf) * SHM_V + vst0) = S.st_v0; *(bf16x8*)(V_lds + (bf) * SHM_V + vst1) = S.st_v1; } while (0)
#define SWRITE_H(bf) do { SWRITE_HV(bf); SWRITE_HK(bf); } while (0)
__device__ __forceinline__ void fox_prime(const BlockRef& cur, char* lds, Seam& S, const int tid) {
    const int wid = __builtin_amdgcn_readfirstlane(tid >> 6), lane = tid & 63, r32 = lane & 31, hi = lane >> 5;
    const int sr = tid >> 4, sc = (tid & 15) * 8, kws = KSWZ(sr, sc * 2); char* K_lds = lds + 2 * SHM_V;
    const unsigned voff = (unsigned)(sr * PITCH + sc) * 2u, qoff = (unsigned)((wid * QBLK + r32) * PITCH + hi * 8) * 2u;
    for (int d0 = 0; d0 < 8; ++d0) S.qr[d0] = load8((const bf16*)((const char*)cur.Q + (qoff + d0 * 32)));
    (void)kws; (void)K_lds; (void)voff;
    __syncthreads();
}
__device__ __forceinline__ void fox_block(const BlockRef& cur, const BlockRef& nxt, char* lds, Seam& S, const int tid) {
    const int wid = __builtin_amdgcn_readfirstlane(tid >> 6), lane = tid & 63, r32 = lane & 31, hi = lane >> 5;
    const int W = SKV;
    const int NTF = (cur.P0 + QB - 1) / KVBLK + 1;
    const int qlo = cur.P0 + wid * QBLK, qm = qlo + r32 - 4 * hi;
    char* V_lds = lds; char* K_lds = lds + 2 * SHM_V;
    float* ws = (float*)(lds + 2 * SHM_V + 2 * SHM_K) + wid * 64; float* li_l = ws, * al_l = ws + 32;
    float* biasL = (float*)(lds + BIAS_OFF);
    { const int nk = cur.P0 + QB;
      int t4 = tid * 4; asm volatile("" : "+v"(t4));
      f32x4 bv[4];
#pragma unroll
      for (int k = 0; k < 4; ++k) { const int i = t4 + k * (NW * 64 * 4); if (i < nk) bv[k] = *(const f32x4*)((const char*)cur.Bias + (unsigned)(i * 4)); }
#pragma unroll
      for (int k = 0; k < 4; ++k) { const int i = t4 + k * (NW * 64 * 4); if (i < nk) *(f32x4*)(biasL + i) = bv[k]; }
      __syncthreads(); }
    int j_lo; { int lo_ = 0, hi_ = cur.P0 / KVBLK; const float bref = biasL[cur.P0] - cur.THp;
        while (lo_ < hi_) { const int mid = (lo_ + hi_) >> 1; if (biasL[mid * KVBLK + KVBLK - 1] < bref) lo_ = mid + 1; else hi_ = mid; }
        j_lo = __builtin_amdgcn_readfirstlane(lo_); }
    const int NT = NTF - j_lo;
    const float* bl = biasL + 4 * hi;
    float m_reg = -1e30f, l_reg = 0; f32x16 o[4] = {};
    const int sr = tid >> 4, sc = (tid & 15) * 8, vst0 = v_st(sr, sc), vst1 = v_st(32 + sr, sc), kws = KSWZ(sr, sc * 2);
    const unsigned voff = (unsigned)(sr * PITCH + sc) * 2u, qoff = (unsigned)((wid * QBLK + r32) * PITCH + hi * 8) * 2u;
    const int vb0 = (int)(uintptr_t)V_lds + v_rd_base(lane);
    const bf16* Kh = cur.K; const bf16* Vh = cur.V;
#define RESC(a) do { if (__any((a) < 1.f)) { if (hi == 0) al_l[r32] = (a); asm volatile("s_waitcnt lgkmcnt(0)" ::: "memory");              \
                     for (int d_ = 0; d_ < 4; ++d_) for (int r = 0; r < 16; ++r) o[d_][r] *= al_l[crow(r, hi)]; } } while (0)
#define KBASE(t) ((j_lo + (NT - 1 - (t))) * KVBLK)
#define MASKT(P0_, P1_, t) do { const int kb_ = KBASE(t); if (kb_ + KVBLK - 1 > qlo) mask_tile(P0_, P1_, qm - kb_, (unsigned)W); } while (0)
    constexpr int NQL = 8;
#define SEAM_K0() do { VMWN(NQL); SWRITE_HK(0); SBAR(); } while (0)
    f32x16 pA0, pA1, pB0, pB1; float mnA, mnB, alA, alB; bf16x8 pa0, pa1, pa2, pa3;
    SLOAD_H(Kh, Vh, KBASE(0)); VMW(); SWRITE_HK(0); SWRITE_HV(0); __syncthreads();
    SBAR();
    if (NT > 1) { SLOAD_H(Kh, Vh, KBASE(1)); }
    SBAR(); qkt<0>(pA0, pA1, K_lds, bl + KBASE(0), r32, hi, S.qr);
    MASKT(pA0, pA1, 0); partialSM(pA0, pA1, m_reg, mnA, alA);
    if (NT > 1) { VMW(); SWRITE_H(1); }
    __syncthreads();
#define HALF_STEP(PX0, PX1, mnX, alX, PY0, PY1, alY, t, KB, VB, SB) do {                                                      \
        SBAR(); qkt<KB>(PX0, PX1, K_lds, bl + KBASE(t), r32, hi, S.qr);                                             \
        finishSM(PY0, PY1, alY, l_reg, pa0, pa1, pa2, pa3); SBAR();                                                           \
        if ((t) + 1 < NT) { SLOAD_H(Kh, Vh, KBASE((t) + 1)); SBAR(); }                                               \
        pv_tile<VB>(o, vb0, pa0, pa1, pa2, pa3); MASKT(PX0, PX1, (t)); partialSM(PX0, PX1, m_reg, mnX, alX);                                        \
        __syncthreads();                                                                                                      \
        if ((t) + 1 < NT) { VMW(); SWRITE_H(SB); }                                                                          \
        RESC(alX); __syncthreads(); } while (0)
    for (int t = 1; t + 1 < NT; t += 2) {
        HALF_STEP(pB0, pB1, mnB, alB, pA0, pA1, alA, t, 1, 0, 0);
        HALF_STEP(pA0, pA1, mnA, alA, pB0, pB1, alB, t + 1, 0, 1, 1);
    }
    const bool even = (NT & 1) == 0;
    if (even) { SBAR(); qkt<1>(pB0, pB1, K_lds, bl + KBASE(NT - 1), r32, hi, S.qr); SBAR(); }
#pragma unroll
    for (int d0 = 0; d0 < 8; ++d0) S.qr[d0] = load8((const bf16*)((const char*)nxt.Q + (qoff + d0 * 32)));
    SBAR();
    finishSM(pA0, pA1, alA, l_reg, pa0, pa1, pa2, pa3); SBAR();
    pv_tile<0>(o, vb0, pa0, pa1, pa2, pa3);
    if (even) { MASKT(pB0, pB1, NT - 1); partialSM(pB0, pB1, m_reg, mnB, alB); __syncthreads(); RESC(alB);
        finishSM(pB0, pB1, alB, l_reg, pa0, pa1, pa2, pa3); SBAR(); pv_tile<1>(o, vb0, pa0, pa1, pa2, pa3); }
    SBAR();
    if (hi == 0) li_l[r32] = l_reg; asm volatile("s_waitcnt lgkmcnt(0)" ::: "memory");
    float rli[16];
#pragma unroll
    for (int r = 0; r < 16; ++r) rli[r] = __builtin_amdgcn_rcpf(li_l[crow(r, hi)]);
    char* Ow = (char*)cur.O; const unsigned ooff = (unsigned)((wid * QBLK + 4 * hi) * OPITCH + r32) * 2u;
    const char* Gq = (const char*)cur.Q + GATE_OFF * 2; const unsigned goff = (unsigned)((wid * QBLK + 4 * hi) * PITCH + r32) * 2u;
    unsigned short gq[16][4];
#pragma unroll
    for (int r = 0; r < 16; ++r)
#pragma unroll
        for (int d0 = 0; d0 < 4; ++d0) gq[r][d0] = *(const unsigned short*)(Gq + (goff + (unsigned)(((r & 3) + 8 * (r >> 2)) * PITCH + d0 * 32) * 2u));
#pragma unroll
    for (int r = 0; r < 16; ++r) {
#pragma unroll
        for (int d0 = 0; d0 < 4; ++d0) { const unsigned short gw = gq[r][d0];
            const float gl = __builtin_bit_cast(float, (unsigned)gw << 16);
            const float v = o[d0][r] * rli[r] * __builtin_amdgcn_rcpf(1.0f + __builtin_amdgcn_exp2f(-1.4426950408889634f * gl));
            const float vn = xor1_get(v);
            if ((r32 & 1) == 0) *(unsigned*)(Ow + (ooff + (unsigned)(((r & 3) + 8 * (r >> 2)) * OPITCH + d0 * 32) * 2u)) = cvtpk(v, vn); } }
    __syncthreads();
#undef RESC
#undef KBASE
#undef MASKT
#undef SEAM_K0
#undef HALF_STEP
}
#undef ROW
#undef VMW
#undef VMWN
#undef SLOAD_H
#undef SWRITE_HK
#undef SWRITE_HV
#undef SWRITE_H
#undef KSWZ
#undef SBAR
}

constexpr int NWAVES = 8, NTHREADS = NWAVES * 64;
constexpr int DM = 2048, BATCH = 2, T = 8192, M = BATCH * T, DEPTH = 4;
constexpr int AB_IN = 8200, AB_N = 8192;
constexpr int C_IN = 6160, C_N = 6144;
constexpr int FF = 5632, FF2 = 2 * FF;
constexpr float EPS = 1e-6f;
enum PhaseKind { K_NORM1 = 0, K_MIXIN, K_PREP, K_REC, K_POST, K_MIXOUT, K_NORM2, K_FFIN, K_FFOUT, K_PRO };
constexpr int phase_base(int layer) { return 1 + 9 * layer; }
constexpr int N_PHASES = phase_base(DEPTH) + 1;
constexpr int CW_QUEUE = 8192;
inline int phase_kind(int p, int& layer) { if (p == 0) { layer = 0; return K_PRO; } for (layer = DEPTH - 1; phase_base(layer) > p; --layer) {} return p - phase_base(layer); }
constexpr size_t MiB = 1u << 20;
constexpr size_t WS_CTL = 0, CTL_ZERO_BYTES = 1 * MiB;
constexpr size_t WS_MOD = 1 * MiB;
constexpr size_t WS_LOGF = 2 * MiB;
constexpr size_t WS_BIAS = 3 * MiB;
constexpr size_t WS_GLOW = 4 * MiB;
constexpr size_t WS_W_ABIN = 8 * MiB, WS_W_ABOUT = 72 * MiB, WS_W_GLIN = 88 * MiB, WS_W_GLOUT = 136 * MiB, WS_W_FFIN = 152 * MiB, WS_W_FFOUT = 328 * MiB;
constexpr size_t WS_H = 416 * MiB, WS_CAT = 480 * MiB, WS_PROJ = 544 * MiB, WS_FFH = WS_PROJ, WS_O = 800 * MiB, WS_REC = 928 * MiB, WS_Y = 1064 * MiB, WS_XB = 1128 * MiB, WS_END = 1192 * MiB;
constexpr int CW_BAR = 4096;
constexpr int RING_OFF = 0, RING_BYTES = 139264;
constexpr int LDSCTL_OFF = RING_BYTES, MISC_OFF = LDSCTL_OFF + 320;
constexpr int LDS_BYTES = 155648;
static_assert(fox::LDS_BYTES <= RING_BYTES, "attention LDS");

#define GAS __attribute__((address_space(1)))
#define LAS __attribute__((address_space(3)))
typedef unsigned short bf16;
typedef unsigned v4u __attribute__((ext_vector_type(4)));
typedef unsigned v2u __attribute__((ext_vector_type(2)));
typedef float f32x4 __attribute__((ext_vector_type(4)));
typedef GAS unsigned gu32;
#define RLX_AGENT __ATOMIC_RELAXED, __HIP_MEMORY_SCOPE_AGENT
#define LDS_WAIT() asm volatile("s_waitcnt lgkmcnt(0)" ::: "memory")
__device__ __forceinline__ unsigned pk2(float lo, float hi) { unsigned r; asm("v_cvt_pk_bf16_f32 %0, %1, %2" : "=v"(r) : "v"(lo), "v"(hi)); return r; }
__device__ __forceinline__ unsigned f2bf(float f) { return pk2(f, f) & 0xffffu; }
__device__ __forceinline__ float bf_lo(unsigned w) { return __builtin_bit_cast(float, w << 16); }
__device__ __forceinline__ float bf_hi(unsigned w) { return __builtin_bit_cast(float, w & 0xffff0000u); }
__device__ __forceinline__ float bf1(bf16 h) { return __builtin_bit_cast(float, (unsigned)h << 16); }
__device__ __forceinline__ float sigmoid_f(float x) { return __builtin_amdgcn_rcpf(1.0f + __expf(-x)); }
__device__ __forceinline__ float silu_x(float x) { return x * __builtin_amdgcn_rcpf(1.0f + __expf(-x)); }
__device__ __forceinline__ float log_sigmoid_f(float x) { return fminf(x, 0.f) - log1pf(__expf(-fabsf(x))); }
__device__ __forceinline__ float log_sigmoid_fast(float x) { return fminf(x, 0.f) - __logf(1.0f + __expf(-fabsf(x))); }
__device__ __forceinline__ float wave_sum(float v) {
    v = xsum<1>(v); v = xsum<2>(v); v = xsum<4>(v); v = xsum<8>(v); v = xsum<16>(v); v = xsum<32>(v);
    return v;
}

#define XB_TMO      128
#define XB_XCNT(j)  (256  + 64 * (j))
#define XB_XSUB(j)  (1280 + 64 * (j))
#define XB_XGEN(j)  (2304 + 64 * (j))
#define XB_TOP      3328
#define XB_TOPGEN   3392
#define XCD_BAR_WORDS 3456
#define XB_SPIN_CAP (1u << 18)
__device__ __forceinline__ unsigned xb_ld(unsigned* p)              { return __hip_atomic_load(p, __ATOMIC_RELAXED, __HIP_MEMORY_SCOPE_AGENT); }
__device__ __forceinline__ unsigned xb_add(unsigned* p, unsigned v) { return __hip_atomic_fetch_add(p, v, __ATOMIC_RELAXED, __HIP_MEMORY_SCOPE_AGENT); }
__device__ __forceinline__ unsigned xb_xcc_id() { return (unsigned)__builtin_amdgcn_s_getreg((3 << 11) | 20) & 0xFu; }
#define XB_SPIN(cond, bar) do { unsigned _sp = 0; while (cond) { __builtin_amdgcn_s_sleep(1); \
    if ((++_sp & 255u) == 0u) { if (xb_ld(&(bar)[XB_TMO])) break; if (_sp > XB_SPIN_CAP) { atomicAdd(&(bar)[XB_TMO], 1u); break; } } } } while (0)
struct XcdBarrier { unsigned* bar; unsigned x; volatile LAS unsigned* st; };
__device__ __forceinline__ XcdBarrier xcd_barrier_post(unsigned* bar, volatile LAS unsigned* st, bool tid0) {
    XcdBarrier b; b.bar = bar; b.x = xb_xcc_id(); b.st = st;
    if (tid0) (void)xb_add(&bar[XB_XCNT(b.x)], 1u);
    return b;
}
__device__ __forceinline__ void xcd_barrier_complete(unsigned* bar, unsigned x, unsigned& nloc, unsigned& nx) {
    const unsigned G = gridDim.x * gridDim.y * gridDim.z;
    unsigned sum, cnt, mine, sp = 0u;
    for (;;) {
        sum = 0u; cnt = 0u; mine = 0u;
#pragma unroll
        for (unsigned j = 0; j < 16; ++j) { const unsigned c = xb_ld(&bar[XB_XCNT(j)]); sum += c; cnt += (c > 0u) ? 1u : 0u; mine = (j == x) ? c : mine; }
        if (sum == G) break;
        __builtin_amdgcn_s_sleep(1);
        if ((++sp & 255u) == 0u) { if (xb_ld(&bar[XB_TMO])) break; if (sp > XB_SPIN_CAP) { atomicAdd(&bar[XB_TMO], 1u); break; } }
    }
    nloc = mine > 0u ? mine : 1u; nx = cnt > 0u ? cnt : 1u;
}
template <bool FIRST>
__device__ __forceinline__ void xcd_barrier(const XcdBarrier& b, bool tid0) {
    asm volatile("s_waitcnt vmcnt(0)" ::: "memory");
    __syncthreads();
    if (tid0) {
        unsigned* bar = b.bar;
        __builtin_amdgcn_s_waitcnt(0);
        unsigned nloc = b.st[0], nx = b.st[1];
        if (FIRST) { if (nloc == 0u) { xcd_barrier_complete(bar, b.x, nloc, nx); b.st[0] = nloc; b.st[1] = nx; } }
        else { if (nloc == 0u) nloc = 1u; if (nx == 0u) nx = 1u; }
        const unsigned old = xb_add(&bar[XB_XSUB(b.x)], 1u);
        const unsigned gen = old / nloc;
        if (old + 1u == (gen + 1u) * nloc) {
            __builtin_amdgcn_fence(__ATOMIC_RELEASE, "agent");
            asm volatile("s_waitcnt vmcnt(0)" ::: "memory");
            const unsigned og = xb_add(&bar[XB_TOP], 1u);
            const unsigned tg = og / nx;
            if (og + 1u == (tg + 1u) * nx) xb_add(&bar[XB_TOPGEN], 1u);
            else XB_SPIN(xb_ld(&bar[XB_TOPGEN]) == tg, bar);
            __builtin_amdgcn_fence(__ATOMIC_ACQUIRE, "agent");
            xb_add(&bar[XB_XGEN(b.x)], 1u);
            asm volatile("s_waitcnt vmcnt(0)" ::: "memory");
        } else {
            XB_SPIN(xb_ld(&bar[XB_XGEN(b.x)]) == gen, bar);
            __builtin_amdgcn_fence(__ATOMIC_ACQUIRE, "agent");
            asm volatile("s_waitcnt vmcnt(0)" ::: "memory");
        }
    }
    __syncthreads();
}

struct Args { const float* in[20]; float* out; unsigned char* ws; int ph_lo, ph_hi, use_bar, pad; };
typedef const Args __attribute__((address_space(4))) CArgs;
__device__ __forceinline__ CArgs* opq_args() { CArgs* p = (CArgs*)__builtin_amdgcn_kernarg_segment_ptr(); asm volatile("" : "+s"(p)); return p; }
struct Frame {
    LAS unsigned char* lds;
    int tid, lane, wave, G, bid;
};

__device__ __forceinline__ void transpose_item(const float* W, int ldn, int K, bf16* WT, int k0, int n0, int drow0, LAS float* scr, int lane) {
    f32x4 v[16];
    const float* src = W + (size_t)(k0 + (lane >> 4)) * ldn + n0 + 4 * (lane & 15);
#pragma unroll
    for (int i = 0; i < 16; ++i) v[i] = *(const f32x4*)(src + (size_t)(4 * i) * ldn);
#pragma unroll
    for (int i = 0; i < 16; ++i) { LAS float* d = scr + (4 * i + (lane >> 4)) * 65 + 4 * (lane & 15); d[0] = v[i].x; d[1] = v[i].y; d[2] = v[i].z; d[3] = v[i].w; }
    LDS_WAIT(); asm volatile("" ::: "memory");
    const int c = lane & 7, r = lane >> 3;
#pragma unroll
    for (int j = 0; j < 8; ++j) { const int n = r + 8 * j; const LAS float* s = scr + (8 * c) * 65 + n;
        v4u o; o.x = pg8::cvt_pk_bf16(s[0 * 65], s[1 * 65]); o.y = pg8::cvt_pk_bf16(s[2 * 65], s[3 * 65]); o.z = pg8::cvt_pk_bf16(s[4 * 65], s[5 * 65]); o.w = pg8::cvt_pk_bf16(s[6 * 65], s[7 * 65]);
        *(GAS v4u*)(WT + (size_t)(drow0 + n) * K + k0 + 8 * c) = o; }
    LDS_WAIT(); asm volatile("" ::: "memory");
}
template <int MODE>
__device__ __forceinline__ void transpose_matrix(const float* W, int nmat, int K, int ldn, int ncols, bf16* WT, LAS float* scr, int gw, int NGW, int lane) {
    const int nblk = ncols / 64, kblk = K / 64, per = nblk * kblk, total = per * nmat;
    for (int it = gw; it < total; it += NGW) {
        const int mat = it / per, r = it - mat * per, kb = r / nblk, nb = r - kb * nblk, n0 = 64 * nb;
        int drow0 = n0;
        if (MODE == 1) { if (n0 < FF) drow0 = (n0 / 128) * 256 + (n0 % 128); else { const int n1 = n0 - FF; drow0 = (n1 / 128) * 256 + 128 + (n1 % 128); } }
        if (MODE == 2) drow0 = n0 < 3072 ? n0 : (n0 < 4096 ? n0 + 4096 : n0 - 1024);
        transpose_item(W + (size_t)mat * K * ldn, ldn, K, WT + (size_t)mat * ncols * K, 64 * kb, n0, drow0, scr, lane);
    }
}
template <int SET>
__device__ __forceinline__ void convert_weights(CArgs* ap, LAS float* scr, int gw, int NGW, int lane) {
    unsigned char* ws = ap->ws;
    bf16* abin = (bf16*)(ws + WS_W_ABIN); bf16* about = (bf16*)(ws + WS_W_ABOUT); bf16* glin = (bf16*)(ws + WS_W_GLIN); bf16* glout = (bf16*)(ws + WS_W_GLOUT); bf16* ffin = (bf16*)(ws + WS_W_FFIN); bf16* ffout = (bf16*)(ws + WS_W_FFOUT);
    constexpr size_t S_ABIN_W = (size_t)DM * AB_IN, S_ABIN_T = (size_t)AB_N * DM, S_SQ = (size_t)DM * DM, S_GLIN_W = (size_t)DM * C_IN, S_GLIN_T = (size_t)C_N * DM, S_FFIN = (size_t)DM * FF2, S_FFOUT = (size_t)FF * DM;
    if (SET == 0) {
        transpose_matrix<2>(ap->in[6], 1, DM, AB_IN, AB_N, abin, scr, gw, NGW, lane);
        transpose_matrix<0>(ap->in[7], 1, DM, DM, DM, about, scr, gw, NGW, lane);
        transpose_matrix<1>(ap->in[18], 1, DM, FF2, FF2, ffin, scr, gw, NGW, lane);
        transpose_matrix<0>(ap->in[19], 1, FF, DM, DM, ffout, scr, gw, NGW, lane);
        transpose_matrix<0>(ap->in[13], 1, DM, C_IN, C_N, glin, scr, gw, NGW, lane);
    } else if (SET == 1) {
        transpose_matrix<0>(ap->in[17], 1, DM, DM, DM, glout, scr, gw, NGW, lane);
        transpose_matrix<1>(ap->in[18] + S_FFIN, 2, DM, FF2, FF2, ffin + S_FFIN, scr, gw, NGW, lane);
        transpose_matrix<0>(ap->in[19] + S_FFOUT, 2, FF, DM, DM, ffout + S_FFOUT, scr, gw, NGW, lane);
        transpose_matrix<2>(ap->in[6] + S_ABIN_W, 1, DM, AB_IN, AB_N, abin + S_ABIN_T, scr, gw, NGW, lane);
        transpose_matrix<0>(ap->in[7] + S_SQ, 1, DM, DM, DM, about + S_SQ, scr, gw, NGW, lane);
        transpose_matrix<0>(ap->in[13] + S_GLIN_W, 1, DM, C_IN, C_N, glin + S_GLIN_T, scr, gw, NGW, lane);
    } else {
        transpose_matrix<0>(ap->in[17] + S_SQ, 1, DM, DM, DM, glout + S_SQ, scr, gw, NGW, lane);
        transpose_matrix<1>(ap->in[18] + 3 * S_FFIN, 1, DM, FF2, FF2, ffin + 3 * S_FFIN, scr, gw, NGW, lane);
        transpose_matrix<0>(ap->in[19] + 3 * S_FFOUT, 1, FF, DM, DM, ffout + 3 * S_FFOUT, scr, gw, NGW, lane);
    }
}
__device__ __forceinline__ void p0_prologue(Frame& F, CArgs* ap) {
    unsigned char* ws = ap->ws;
    {
        LAS float* sc = (LAS float*)(F.lds);
        LAS float* part = (LAS float*)(F.lds + 16384);
        const float* c = ap->in[1];
        for (int i = F.tid; i < 2 * DM; i += NTHREADS) sc[i] = silu_x(c[i]);
        __syncthreads();
        const float* mw = ap->in[2]; const float* mb = ap->in[3]; float* mod = (float*)(ws + WS_MOD);
        constexpr int NU = DEPTH * (6 * DM / 64);
        for (int u = F.bid; u < NU; u += F.G) {
            const int layer = u / (6 * DM / 64), colb = (u % (6 * DM / 64)) * 64, kk = F.lane >> 4, c4 = F.lane & 15;
            const float* wp = mw + ((size_t)layer * DM + F.wave * 256 + kk) * (6 * DM) + colb + 4 * c4;
            f32x4 a0 = {0.f, 0.f, 0.f, 0.f}, a1 = {0.f, 0.f, 0.f, 0.f};
            for (int i0 = 0; i0 < 64; i0 += 16) { f32x4 wv[16];
#pragma unroll
                for (int i = 0; i < 16; ++i) wv[i] = *(const f32x4*)(wp + (size_t)(4 * (i0 + i)) * (6 * DM));
#pragma unroll
                for (int i = 0; i < 16; ++i) { const int k = F.wave * 256 + 4 * (i0 + i) + kk; a0 = a0 + wv[i] * sc[k]; a1 = a1 + wv[i] * sc[DM + k]; } }
            a0.x = xsum<16>(a0.x); a0.x = xsum<32>(a0.x); a0.y = xsum<16>(a0.y); a0.y = xsum<32>(a0.y); a0.z = xsum<16>(a0.z); a0.z = xsum<32>(a0.z); a0.w = xsum<16>(a0.w); a0.w = xsum<32>(a0.w);
            a1.x = xsum<16>(a1.x); a1.x = xsum<32>(a1.x); a1.y = xsum<16>(a1.y); a1.y = xsum<32>(a1.y); a1.z = xsum<16>(a1.z); a1.z = xsum<32>(a1.z); a1.w = xsum<16>(a1.w); a1.w = xsum<32>(a1.w);
            if (F.lane < 16) { *(LAS f32x4*)(part + (F.wave * 2 + 0) * 64 + 4 * c4) = a0; *(LAS f32x4*)(part + (F.wave * 2 + 1) * 64 + 4 * c4) = a1; }
            __syncthreads();
            if (F.tid < 128) { const int b = F.tid >> 6, l = F.tid & 63; float s = 0.f;
#pragma unroll
                for (int w = 0; w < 8; ++w) s += part[(w * 2 + b) * 64 + l];
                const int cc = (u % (6 * DM / 64)) * 64 + l;
                mod[((size_t)layer * 2 + b) * (6 * DM) + cc] = s + mb[(size_t)layer * (6 * DM) + cc]; }
            __syncthreads();
        }
    }
    __syncthreads();
    LAS float* scr = (LAS float*)(F.lds + RING_OFF + F.wave * 16640);
    const int gw = F.bid * NWAVES + F.wave, NGW = F.G * NWAVES;
    convert_weights<0>(ap, scr, gw, NGW, F.lane);
}

template <int MASK> __device__ __forceinline__ float xget(float v) { return __builtin_bit_cast(float, __builtin_amdgcn_ds_swizzle(__builtin_bit_cast(int, v), (MASK << 10) | 0x1f)); }
template <int N> __device__ __forceinline__ float rs_reduce(float (&a)[N], int lane) {
    if (N == 16) {
#pragma unroll
        for (int i = 0; i < 8; ++i) { const bool up = lane & 1; const float keep = up ? a[i + 8] : a[i], send = up ? a[i] : a[i + 8]; a[i] = keep + xget<1>(send); } }
    if (N >= 8) {
#pragma unroll
        for (int i = 0; i < 4; ++i) { const bool up = lane & (N == 16 ? 2 : 1); const float keep = up ? a[i + 4] : a[i], send = up ? a[i] : a[i + 4]; a[i] = keep + (N == 16 ? xget<2>(send) : xget<1>(send)); } }
#pragma unroll
    for (int i = 0; i < 2; ++i) { const bool up = lane & (N == 16 ? 4 : 2); const float keep = up ? a[i + 2] : a[i], send = up ? a[i] : a[i + 2]; a[i] = keep + (N == 16 ? xget<4>(send) : xget<2>(send)); }
    { const bool up = lane & (N == 16 ? 8 : 4); const float keep = up ? a[1] : a[0], send = up ? a[0] : a[1]; a[0] = keep + (N == 16 ? xget<8>(send) : xget<4>(send)); }
    float r = a[0];
    if (N == 8) r = xsum<8>(r);
    r = xsum<16>(r); r = xsum<32>(r);
    return r;
}
template <int N> __device__ __forceinline__ int rs_col(int lane) { return N == 16 ? (((lane & 1) << 3) | ((lane & 2) << 1) | ((lane & 4) >> 1) | ((lane & 8) >> 3)) : (((lane & 1) << 2) | (lane & 2) | ((lane & 4) >> 2)); }
template <int NC, int MODE, bool RES, bool XF32>
__device__ __forceinline__ void norm_phase(Frame& F, const void* xin, const float* gain, const float* mod_sh, const float* mod_sc  ,
                                           bf16* hout, const float* Wsm, int ldn, const float* fbias, float* sout, const bf16* yres = nullptr, const float* rgate = nullptr, bf16* xb = nullptr) {
    LAS float* wl = (LAS float*)(F.lds);
    if (NC > 0) {
        for (int i = F.tid; i < NC * DM; i += NTHREADS) { const int k = i / NC, c = i % NC; wl[c * DM + k] = Wsm[(size_t)k * ldn + c]; }
        __syncthreads();
    }
    f32x4 gm[8], shv[8]; int bprev = -1;
    for (int mp = F.bid * NWAVES + F.wave; mp < M / 2; mp += F.G * NWAVES) {
        const int m0 = 2 * mp, b = m0 / T;
        if (b != bprev) { bprev = b; const f32x4* gp = (const f32x4*)gain + F.lane; const f32x4* shp = (const f32x4*)(mod_sh + (size_t)b * 6 * DM) + F.lane; const f32x4* scp = (const f32x4*)(mod_sc + (size_t)b * 6 * DM) + F.lane;
#pragma unroll
            for (int j = 0; j < 8; ++j) { gm[j] = gp[64 * j] * (scp[64 * j] + 1.0f); shv[j] = shp[64 * j]; } }
        f32x4 v[2][8]; float s0 = 0.f, s1 = 0.f;
        v2u yv[2][8];
        if (RES) { const GAS v2u* yr = (const GAS v2u*)(yres + (size_t)m0 * DM) + F.lane;
#pragma unroll
            for (int j = 0; j < 8; ++j) { yv[0][j] = yr[64 * j]; yv[1][j] = yr[512 + 64 * j]; } }
        if (XF32) { const GAS f32x4* xr = (const GAS f32x4*)((const float*)xin + (size_t)m0 * DM) + F.lane;
#pragma unroll
            for (int j = 0; j < 8; ++j) { v[0][j] = xr[64 * j]; v[1][j] = xr[512 + 64 * j]; } }
        else { const GAS v2u* xr = (const GAS v2u*)((const bf16*)xin + (size_t)m0 * DM) + F.lane; v2u xv[2][8];
#pragma unroll
            for (int j = 0; j < 8; ++j) { xv[0][j] = xr[64 * j]; xv[1][j] = xr[512 + 64 * j]; }
#pragma unroll
            for (int j = 0; j < 8; ++j) { v[0][j] = (f32x4){bf_lo(xv[0][j].x), bf_hi(xv[0][j].x), bf_lo(xv[0][j].y), bf_hi(xv[0][j].y)}; v[1][j] = (f32x4){bf_lo(xv[1][j].x), bf_hi(xv[1][j].x), bf_lo(xv[1][j].y), bf_hi(xv[1][j].y)}; } }
        if (RES) { const f32x4* rg = (const f32x4*)(rgate + (size_t)b * 6 * DM) + F.lane; GAS v2u* xo = (GAS v2u*)(xb + (size_t)m0 * DM) + F.lane;
#pragma unroll
            for (int j = 0; j < 8; ++j) { const f32x4 g = rg[64 * j];
                v[0][j] = v[0][j] + g * (f32x4){bf_lo(yv[0][j].x), bf_hi(yv[0][j].x), bf_lo(yv[0][j].y), bf_hi(yv[0][j].y)}; v[1][j] = v[1][j] + g * (f32x4){bf_lo(yv[1][j].x), bf_hi(yv[1][j].x), bf_lo(yv[1][j].y), bf_hi(yv[1][j].y)};
                v2u w; w.x = pk2(v[0][j].x, v[0][j].y); w.y = pk2(v[0][j].z, v[0][j].w); xo[64 * j] = w;
                w.x = pk2(v[1][j].x, v[1][j].y); w.y = pk2(v[1][j].z, v[1][j].w); xo[512 + 64 * j] = w; } }
#pragma unroll
        for (int j = 0; j < 8; ++j) { s0 += (v[0][j].x * v[0][j].x + v[0][j].y * v[0][j].y) + (v[0][j].z * v[0][j].z + v[0][j].w * v[0][j].w);
                                      s1 += (v[1][j].x * v[1][j].x + v[1][j].y * v[1][j].y) + (v[1][j].z * v[1][j].z + v[1][j].w * v[1][j].w); }
        const float rstd0 = __builtin_amdgcn_rsqf(wave_sum(s0) * (1.f / DM) + EPS), rstd1 = __builtin_amdgcn_rsqf(wave_sum(s1) * (1.f / DM) + EPS);
        GAS v2u* o8 = (GAS v2u*)(hout + (size_t)m0 * DM) + F.lane;
#pragma unroll
        for (int j = 0; j < 8; ++j) { const f32x4 g = gm[j], sh = shv[j];
            v[0][j] = (v[0][j] * rstd0) * g + sh; v[1][j] = (v[1][j] * rstd1) * g + sh;
            v2u w; w.x = pk2(v[0][j].x, v[0][j].y); w.y = pk2(v[0][j].z, v[0][j].w); o8[64 * j] = w;
            w.x = pk2(v[1][j].x, v[1][j].y); w.y = pk2(v[1][j].z, v[1][j].w); o8[512 + 64 * j] = w; }
        if constexpr (NC > 0) {
            float a0[NC], a1[NC];
#pragma unroll
            for (int c = 0; c < NC; ++c) { float acc0 = 0.f, acc1 = 0.f;
#pragma unroll
                for (int j = 0; j < 8; ++j) { const f32x4 w = *(const LAS f32x4*)(wl + c * DM + 256 * j + 4 * F.lane);
                    acc0 += (v[0][j].x * w.x + v[0][j].y * w.y) + (v[0][j].z * w.z + v[0][j].w * w.w); acc1 += (v[1][j].x * w.x + v[1][j].y * w.y) + (v[1][j].z * w.z + v[1][j].w * w.w); }
                a0[c] = acc0; a1[c] = acc1; __builtin_amdgcn_sched_barrier(0); }
            const float r0 = rs_reduce<NC>(a0, F.lane), r1 = rs_reduce<NC>(a1, F.lane); const int cc = rs_col<NC>(F.lane);
            if (MODE == 1) { const int t = m0 % T; if (F.lane < NC) { const float fb = fbias[cc]; sout[((size_t)b * 8 + cc) * T + t] = log_sigmoid_f(r0 + fb); sout[((size_t)b * 8 + cc) * T + t + 1] = log_sigmoid_f(r1 + fb); } }
            if (MODE == 2) { if (F.lane < NC) { sout[(size_t)m0 * 16 + cc] = r0; sout[(size_t)m0 * 16 + 16 + cc] = r1; } }
        }
    }
}

__device__ __forceinline__ void resid_final(Frame& F, const bf16* xb, const bf16* yres, const float* rgate, float* xout) {
    for (int mp = F.bid * NWAVES + F.wave; mp < M / 2; mp += F.G * NWAVES) {
        const int m0 = 2 * mp, b = m0 / T;
        const GAS v2u* xr = (const GAS v2u*)(xb + (size_t)m0 * DM) + F.lane; const GAS v2u* yr = (const GAS v2u*)(yres + (size_t)m0 * DM) + F.lane;
        const f32x4* rg = (const f32x4*)(rgate + (size_t)b * 6 * DM) + F.lane; GAS f32x4* xo = (GAS f32x4*)(xout + (size_t)m0 * DM) + F.lane;
        v2u xv[2][8], yv[2][8];
#pragma unroll
        for (int j = 0; j < 8; ++j) { xv[0][j] = xr[64 * j]; xv[1][j] = xr[512 + 64 * j]; yv[0][j] = yr[64 * j]; yv[1][j] = yr[512 + 64 * j]; }
#pragma unroll
        for (int j = 0; j < 8; ++j) { const f32x4 g = rg[64 * j];
            xo[64 * j] = (f32x4){bf_lo(xv[0][j].x), bf_hi(xv[0][j].x), bf_lo(xv[0][j].y), bf_hi(xv[0][j].y)} + g * (f32x4){bf_lo(yv[0][j].x), bf_hi(yv[0][j].x), bf_lo(yv[0][j].y), bf_hi(yv[0][j].y)};
            xo[512 + 64 * j] = (f32x4){bf_lo(xv[1][j].x), bf_hi(xv[1][j].x), bf_lo(xv[1][j].y), bf_hi(xv[1][j].y)} + g * (f32x4){bf_lo(yv[1][j].x), bf_hi(yv[1][j].x), bf_lo(yv[1][j].y), bf_hi(yv[1][j].y)}; }
    }
}

__device__ __forceinline__ void fox_prep(Frame& F, bf16* proj, const float* qg, const float* kg, const float* logf, float* bias) {
    const int gw = F.bid * NWAVES + F.wave, NGW = F.G * NWAVES;
    const f32x4 gq0 = *(const f32x4*)(qg + (F.lane & 15) * 8), gq1 = *(const f32x4*)(qg + (F.lane & 15) * 8 + 4), gk0 = *(const f32x4*)(kg + (F.lane & 15) * 8), gk1 = *(const f32x4*)(kg + (F.lane & 15) * 8 + 4);
    for (int m = gw; m < M; m += NGW) {
        GAS v4u* p = (GAS v4u*)(proj + (size_t)m * AB_N + 3072) + F.lane;
        v4u wv[4];
#pragma unroll
        for (int j = 0; j < 4; ++j) wv[j] = p[64 * j];
#pragma unroll
        for (int j = 0; j < 4; ++j) {
            const v4u w = wv[j];
            float e[8] = {bf_lo(w.x), bf_hi(w.x), bf_lo(w.y), bf_hi(w.y), bf_lo(w.z), bf_hi(w.z), bf_lo(w.w), bf_hi(w.w)};
            float s = 0.f;
#pragma unroll
            for (int i = 0; i < 8; ++i) s += e[i] * e[i];
            s = xsum<1>(s); s = xsum<2>(s); s = xsum<4>(s); s = xsum<8>(s);
            const float rstd = __builtin_amdgcn_rsqf(s * (1.f / 128.f) + EPS);
            const f32x4 g0 = j < 2 ? gq0 : gk0, g1 = j < 2 ? gq1 : gk1;
#pragma unroll
            for (int i = 0; i < 4; ++i) { e[i] = e[i] * rstd * g0[i]; e[4 + i] = e[4 + i] * rstd * g1[i]; }
            v4u o; o.x = pk2(e[0], e[1]); o.y = pk2(e[2], e[3]); o.z = pk2(e[4], e[5]); o.w = pk2(e[6], e[7]);
            p[64 * j] = o;
        }
    }
    if (F.bid < 16) {
        LAS double* tsum = (LAS double*)(F.lds);
        const float* lf = logf + (size_t)F.bid * T; float* bo = bias + (size_t)F.bid * T;
        double v[16]; double run = 0.0;
        const int i0 = F.tid * 16;
#pragma unroll
        for (int i = 0; i < 16; ++i) { run += (double)lf[i0 + i]; v[i] = run; }
        tsum[F.tid] = run;
        __syncthreads();
        LAS double* bsum = tsum + NTHREADS;
        if (F.tid < 8) { double s = 0.0; for (int w = 0; w < 64; ++w) s += tsum[F.tid * 64 + w]; bsum[F.tid] = s; }
        __syncthreads();
        double base = 0.0;
        for (int w = 0; w < F.wave; ++w) base += bsum[w];
        for (int w = 0; w < F.lane; ++w) base += tsum[F.wave * 64 + w];
        const double k = -11.313708498984761;
#pragma unroll
        for (int i = 0; i < 16; ++i) bo[i0 + i] = (float)((base + v[i]) * k);
        __syncthreads();
    }
}

#ifndef DBG_REC
#define DBG_REC 0
#endif
#if DBG_REC
template <bool GLA>
__device__ __forceinline__ void rec_naive(Frame& F, const bf16* proj, float* O, const float* lbl  , int lb_on,
                                          const float* glow, const float* wup  , const float* bgate  ) {
    constexpr int DK = GLA ? 256 : 128, DVH = GLA ? 512 : 128, NH = GLA ? 4 : 8, DVS = 32, NSL = DVH / DVS, TB = GLA ? 16 : 32;
    constexpr int PITCH = GLA ? C_N : AB_N, OPITCH = GLA ? 2048 : 1024;
    constexpr int R = DK / 16;
    constexpr int NPAIR = TB * DK / 2 / NTHREADS;
    constexpr int NUNITS = BATCH * NH * NSL;
    LAS float* sq = (LAS float*)(F.lds); LAS float* sf = sq + TB * DK; LAS float* sk = sf + TB * DK; LAS float* sv = sk + TB * DK; LAS float* part = sv + TB * DVS; LAS float* sgl = part + TB * 4 * DVS;
    const int lane = F.lane, e_l = lane & 15, dsub = lane >> 4, eg = F.wave & 1, dg = F.wave >> 1, e = eg * 16 + e_l, d0 = (dg * 4 + dsub) * R;
    for (int unit = F.bid; unit < NUNITS; unit += F.G) {
        const int sl = unit % NSL, h = (unit / NSL) % NH, b = unit / (NSL * NH);
        const bf16* pq = proj + (size_t)b * T * PITCH + h * DK;
        const bf16* pk = pq + 1024;
        const bf16* pv = proj + (size_t)b * T * PITCH + 2048 + h * DVH + sl * DVS;
        const int dp = 2 * (F.tid % (DK / 2)), tt0 = F.tid / (DK / 2); constexpr int TSTEP = NTHREADS / (DK / 2);
        float lb0 = 0.f, lb1 = 0.f; float wu0[16], wu1[16]; float bg0 = 0.f, bg1 = 0.f;
        if (!GLA) { if (lb_on) { const float l0a = lbl[h * DK + dp], l1a = lbl[1024 + h * DK + dp], l0b = lbl[h * DK + dp + 1], l1b = lbl[1024 + h * DK + dp + 1];
                                 lb0 = fminf(fmaxf(sigmoid_f(l1a - l0a), 0.f), 1.0f - 1e-6f); lb1 = fminf(fmaxf(sigmoid_f(l1b - l0b), 0.f), 1.0f - 1e-6f); } }
        else {
#pragma unroll
            for (int r = 0; r < 16; ++r) { wu0[r] = wup[r * 1024 + h * DK + dp]; wu1[r] = wup[r * 1024 + h * DK + dp + 1]; }
            bg0 = bgate[h * DK + dp]; bg1 = bgate[h * DK + dp + 1]; }
        const int vt = F.tid / 16, ve = 2 * (F.tid % 16); const bool vact = vt < TB;
        float S[R];
#pragma unroll
        for (int j = 0; j < R; ++j) S[j] = 0.f;
        unsigned rq[NPAIR], rk[NPAIR], rv = 0u; float rgl = 0.f;
#define REC_PREFETCH(t0) do { _Pragma("unroll") for (int i = 0; i < NPAIR; ++i) { const size_t row = (size_t)((t0) + tt0 + TSTEP * i); \
            rq[i] = *(const unsigned*)(pq + row * PITCH + dp); rk[i] = *(const unsigned*)(pk + row * PITCH + dp); \
            } \
            if (GLA && F.tid < TB * 16) rgl = glow[((size_t)b * T + (t0)) * 16 + F.tid]; \
            if (vact) rv = *(const unsigned*)(pv + (size_t)((t0) + vt) * PITCH + ve); } while (0)
        REC_PREFETCH(0);
        for (int t0 = 0; t0 < T; t0 += TB) {
            if (GLA) { if (F.tid < TB * 16) sgl[F.tid] = rgl; __syncthreads(); }
#pragma unroll
            for (int i = 0; i < NPAIR; ++i) { const int tt = tt0 + TSTEP * i; const float qa = bf_lo(rq[i]), qb = bf_hi(rq[i]), ka = bf_lo(rk[i]), kb = bf_hi(rk[i]);
                float q0, q1, f0, f1, k0, k1;
                if (!GLA) { q0 = silu_x(qa); q1 = silu_x(qb); const float s0 = sigmoid_f(ka), s1 = sigmoid_f(kb), n0 = sigmoid_f(-ka), n1 = sigmoid_f(-kb);
                    f0 = fmaxf(lb0 + (1.f - lb0) * s0, 1e-30f); f1 = fmaxf(lb1 + (1.f - lb1) * s1, 1e-30f); k0 = (1.f - lb0) * n0; k1 = (1.f - lb1) * n1; }
                else { q0 = qa * 0.0625f; q1 = qb * 0.0625f; k0 = ka; k1 = kb; float x0 = bg0, x1 = bg1;
#pragma unroll
                    for (int r = 0; r < 16; ++r) { const float g = sgl[tt * 16 + r]; x0 += g * wu0[r]; x1 += g * wu1[r]; }
                    f0 = __expf(log_sigmoid_f(x0) * 0.0625f); f1 = __expf(log_sigmoid_f(x1) * 0.0625f); }
                sq[tt * DK + dp] = q0; sq[tt * DK + dp + 1] = q1; sf[tt * DK + dp] = f0; sf[tt * DK + dp + 1] = f1; sk[tt * DK + dp] = k0; sk[tt * DK + dp + 1] = k1; }
            if (vact) { sv[vt * DVS + ve] = bf_lo(rv); sv[vt * DVS + ve + 1] = bf_hi(rv); }
            __syncthreads();
            if (t0 + TB < T) REC_PREFETCH(t0 + TB);
            for (int tt = 0; tt < TB; ++tt) {
                const float v = sv[tt * DVS + e]; float acc = 0.f;
#pragma unroll
                for (int g4 = 0; g4 < R / 4; ++g4) { const f32x4 f4 = *(const LAS f32x4*)(sf + tt * DK + d0 + 4 * g4), k4 = *(const LAS f32x4*)(sk + tt * DK + d0 + 4 * g4), q4 = *(const LAS f32x4*)(sq + tt * DK + d0 + 4 * g4);
#pragma unroll
                    for (int i = 0; i < 4; ++i) { S[4 * g4 + i] = f4[i] * S[4 * g4 + i] + k4[i] * v; acc += q4[i] * S[4 * g4 + i]; } }
                acc = xsum<16>(acc); acc = xsum<32>(acc);
                if (dsub == 0) part[(tt * 4 + dg) * DVS + e] = acc;
            }
            __syncthreads();
            for (int i = F.tid; i < TB * DVS; i += NTHREADS) { const int tt = i / DVS, ee = i % DVS;
                const float o = (part[(tt * 4 + 0) * DVS + ee] + part[(tt * 4 + 1) * DVS + ee]) + (part[(tt * 4 + 2) * DVS + ee] + part[(tt * 4 + 3) * DVS + ee]);
                O[((size_t)b * T + t0 + tt) * OPITCH + h * DVH + sl * DVS + ee] = o; }
        }
#undef REC_PREFETCH
        __syncthreads();
    }
}

#endif
#ifndef DBG_ZERO
#define DBG_ZERO 0
#endif
__device__ __forceinline__ void post_even(Frame& F, const bf16* O, const bf16* proj, const float* gain  , bf16* cat) {
    const int gw = F.bid * NWAVES + F.wave, NGW = F.G * NWAVES;
    f32x4 gn[4];
#pragma unroll
    for (int j = 0; j < 4; ++j) gn[j] = *((const f32x4*)gain + 64 * j + F.lane);
    for (int mp = gw; mp < M / 2; mp += NGW) {
        const int m = 2 * mp;
        const GAS v2u* op = (const GAS v2u*)(O + (size_t)m * 1024) + F.lane;
        const GAS v2u* ga = (const GAS v2u*)(proj + (size_t)m * AB_N + 7168) + F.lane;
        GAS v2u* cp = (GAS v2u*)(cat + (size_t)m * DM) + F.lane;
        v2u vr[2][4], gr[2][4];
#pragma unroll
        for (int r = 0; r < 2; ++r)
#pragma unroll
            for (int j = 0; j < 4; ++j) { vr[r][j] = op[r * 256 + 64 * j]; gr[r][j] = ga[r * (AB_N / 4) + 64 * j]; }
#pragma unroll
        for (int r = 0; r < 2; ++r)
#pragma unroll
        for (int j = 0; j < 4; ++j) {
            const f32x4 v = {bf_lo(vr[r][j].x), bf_hi(vr[r][j].x), bf_lo(vr[r][j].y), bf_hi(vr[r][j].y)}; float s = (v.x * v.x + v.y * v.y) + (v.z * v.z + v.w * v.w);
            s = xsum<1>(s); s = xsum<2>(s); s = xsum<4>(s); s = xsum<8>(s); s = xsum<16>(s);
            const float rstd = __builtin_amdgcn_rsqf(s * (1.f / 128.f) + EPS);
            const f32x4 g = gn[j];
            const v2u gw2 = gr[r][j];
            const float o0 = v.x * rstd * g.x * silu_x(bf_lo(gw2.x)), o1 = v.y * rstd * g.y * silu_x(bf_hi(gw2.x)), o2 = v.z * rstd * g.z * silu_x(bf_lo(gw2.y)), o3 = v.w * rstd * g.w * silu_x(bf_hi(gw2.y));
            v2u w; w.x = pk2(o0, o1); w.y = pk2(o2, o3); cp[r * 512 + 64 * j] = w;
        }
    }
}
__device__ __forceinline__ void post_odd(Frame& F, const bf16* O, const bf16* proj, const float* gain  , bf16* cat) {
    const int gw = F.bid * NWAVES + F.wave, NGW = F.G * NWAVES;
    const f32x4 gn0 = *((const f32x4*)gain + F.lane), gn1 = *((const f32x4*)gain + 64 + F.lane);
    for (int mp = gw; mp < M / 2; mp += NGW) {
        const int m = 2 * mp;
        const GAS v2u* op = (const GAS v2u*)(O + (size_t)m * DM) + F.lane;
        const GAS v2u* gg = (const GAS v2u*)(proj + (size_t)m * C_N + 4096) + F.lane;
        GAS v2u* cp = (GAS v2u*)(cat + (size_t)m * DM) + F.lane;
        v2u vr[2][8], gr[2][8];
#pragma unroll
        for (int r = 0; r < 2; ++r)
#pragma unroll
            for (int j = 0; j < 8; ++j) { vr[r][j] = op[r * 512 + 64 * j]; gr[r][j] = gg[r * (C_N / 4) + 64 * j]; }
#pragma unroll
        for (int r = 0; r < 2; ++r)
#pragma unroll
        for (int hh = 0; hh < 4; ++hh) {
            const v2u r0 = vr[r][2 * hh], r1 = vr[r][2 * hh + 1]; const f32x4 v0 = {bf_lo(r0.x), bf_hi(r0.x), bf_lo(r0.y), bf_hi(r0.y)}, v1 = {bf_lo(r1.x), bf_hi(r1.x), bf_lo(r1.y), bf_hi(r1.y)};
            float s = ((v0.x * v0.x + v0.y * v0.y) + (v0.z * v0.z + v0.w * v0.w)) + ((v1.x * v1.x + v1.y * v1.y) + (v1.z * v1.z + v1.w * v1.w));
            s = wave_sum(s);
            const float rstd = __builtin_amdgcn_rsqf(s * (1.f / 512.f) + EPS);
#pragma unroll
            for (int jj = 0; jj < 2; ++jj) { const f32x4 v = jj ? v1 : v0; const f32x4 g = jj ? gn1 : gn0; const v2u gw2 = gr[r][2 * hh + jj];
                const float o0 = v.x * rstd * g.x * silu_x(bf_lo(gw2.x)), o1 = v.y * rstd * g.y * silu_x(bf_hi(gw2.x)), o2 = v.z * rstd * g.z * silu_x(bf_lo(gw2.y)), o3 = v.w * rstd * g.w * silu_x(bf_hi(gw2.y));
                v2u w; w.x = pk2(o0, o1); w.y = pk2(o2, o3); cp[r * 512 + 64 * (2 * hh + jj)] = w; }
        }
    }
}

__device__ __forceinline__ fox::BlockRef fox_ref(int item, const bf16* proj, bf16* cat, const float* bias, float thp) {
    const int bh = item & 15, qb = 31 - (item >> 4), b = bh >> 3, h = bh & 7;
    fox::BlockRef r;
    const bf16* base = proj + (size_t)b * T * AB_N + h * 128;
    r.Q = (const fox::bf16*)(base + (size_t)qb * 256 * AB_N + 3072); r.K = (const fox::bf16*)(base + 4096); r.V = (const fox::bf16*)(base + 5120);
    r.O = (fox::bf16*)(cat + ((size_t)b * T + (size_t)qb * 256) * DM + 1024 + h * 128);
    r.Bias = bias + (size_t)bh * T; r.P0 = qb * 256; r.THp = thp;
    return r;
}
__device__ __forceinline__ int fox_fetch(Frame& F, unsigned* ctr, volatile LAS unsigned* slot) {
    if (F.tid == 0) *slot = __hip_atomic_fetch_add(ctr, 1u, __ATOMIC_RELAXED, __HIP_MEMORY_SCOPE_AGENT);
    __syncthreads();
    const int v = __builtin_amdgcn_readfirstlane((int)*slot);
    __syncthreads();
    return v;
}
__device__ __forceinline__ void fox_phase(Frame& F, char* lds, const bf16* proj, bf16* cat, const float* bias, unsigned* ctr, const float* qg, const float* kg) {
    constexpr int TOTAL = 512;
    float gqm = 0.f, gkm = 0.f;
    for (int i = 0; i < 128; ++i) { gqm = fmaxf(gqm, fabsf(qg[i])); gkm = fmaxf(gkm, fabsf(kg[i])); }
    const float thp = 2.0f * (128.0f * 1.02f * gqm * gkm) + (128.0f + 12.0f + 6.0f) / (1.4426950408889634f * fox::SCALE);
    volatile LAS unsigned* slot = (volatile LAS unsigned*)(F.lds + MISC_OFF) + 16;
    int ci = fox_fetch(F, ctr, slot); if (ci >= TOTAL) return;
    fox::BlockRef cur = fox_ref(ci, proj, cat, bias, thp);
    fox::Seam S;
    fox::fox_prime(cur, lds, S, F.tid);
    for (;;) {
        const int ni = fox_fetch(F, ctr, slot); const bool last = ni >= TOTAL;
        const fox::BlockRef nxt = last ? cur : fox_ref(ni, proj, cat, bias, thp);
        fox::fox_block(cur, nxt, lds, S, F.tid);
        if (last) break;
        cur = nxt;
    }
}

template <bool GLA> struct RecCfg {
    static constexpr int DK = GLA ? 256 : 128, DVH = GLA ? 512 : 128, NH = GLA ? 4 : 8, CH = 32, NCH = T / CH, PITCH = GLA ? C_N : AB_N, OPITCH = GLA ? 2048 : 1024;
    static constexpr int QP = DK + 16;
    static constexpr int QT_B = ((CH * QP * 2 + 1023) / 1024) * 1024, KT_B = DK * CH * 2, P_B = CH * CH * 2, A_B = 1024, VT_B = DVH * CH * 2;
    static constexpr int OFF_QT = 0, OFF_KT = QT_B, OFF_P = OFF_KT + KT_B, OFF_A = OFF_P + P_B, OFF_VT = OFF_A + A_B, UNIT_B = OFF_VT + VT_B;
    static constexpr int NSL = DVH / 128, BUF_B = OFF_VT + 8192, NP1 = OFF_VT / 1024, NP = NP1 + 8, NR = (NP + 7) / 8;
    static_assert(A_B >= DK * 4 && OFF_VT % 1024 == 0, "rec layout");
};
typedef short rbf16x8 __attribute__((ext_vector_type(8)));
__device__ __forceinline__ rbf16x8 rpack8(f32x4 a, f32x4 b) { v4u w; w.x = pg8::cvt_pk_bf16(a.x, a.y); w.y = pg8::cvt_pk_bf16(a.z, a.w); w.z = pg8::cvt_pk_bf16(b.x, b.y); w.w = pg8::cvt_pk_bf16(b.z, b.w); return __builtin_bit_cast(rbf16x8, w); }

template <bool GLA>
__device__ __forceinline__ void rec_prep(Frame& F, const bf16* proj, unsigned char* rec, const float* lbl, int lb_on, const float* glow, const float* wup, const float* bgate) {
    using C = RecCfg<GLA>;
    constexpr int DK = C::DK, DVH = C::DVH, NH = C::NH, CH = C::CH, NCH = C::NCH, PITCH = C::PITCH, QP = C::QP;
    constexpr int NSEG = NTHREADS / DK, TPS = CH / NSEG;
    constexpr int NSEGV = NTHREADS / DVH, TPV = CH / NSEGV;
    LAS float* segtot = (LAS float*)F.lds;
    LAS bf16* qm = (LAS bf16*)(F.lds + 2048);
    LAS bf16* km = qm + CH * QP;
    LAS float* sgl = (LAS float*)(F.lds + 2048 + 2 * CH * QP * 2);
    const int d = F.tid % DK, seg = F.tid / DK, lane = F.lane, el = lane & 15, q4 = lane >> 4;
    const int x = d & 31, y = x & 15, pos = (d & ~31) + 8 * (y >> 2) + (y & 3) + 4 * (x >> 4);
    constexpr int NUNITS = BATCH * NH * NCH, NBH = BATCH * NH;
    float lb = 0.f, bg = 0.f; float wu[16]; int hprev = -1;
    unsigned short rq[TPS], rk[TPS]; unsigned rvv[TPV / 2]; float rgl = 0.f;
    unsigned short rvr[GLA ? 1 : TPV];
    const int ev = F.tid % DVH, sv = F.tid / DVH;
    const unsigned toff = (unsigned)(seg * TPS) * (unsigned)(PITCH * 2) + (unsigned)d * 2u, voff = (unsigned)(sv * TPV) * (unsigned)(PITCH * 2) + (unsigned)ev * 2u;
#define PREP_LOAD(un) do { const int c_ = (un) / NBH, bh_ = (un) % NBH; const size_t row_ = (size_t)(bh_ / NH) * T + (size_t)c_ * CH; const int h_ = bh_ % NH; \
        const char* ubq_ = (const char*)(proj + row_ * PITCH + h_ * DK); const char* ubv_ = (const char*)(proj + row_ * PITCH + 2048 + h_ * DVH); (void)ubv_; \
        if (GLA) rgl = glow[row_ * 16 + F.tid];     \
        _Pragma("unroll") for (int i = 0; i < TPS; ++i) { const char* rb_ = ubq_ + (size_t)i * (PITCH * 2);     \
            rq[i] = *(const bf16*)(rb_ + toff); rk[i] = *(const bf16*)(rb_ + 2048 + toff); } \
        if (!GLA) { _Pragma("unroll") for (int i = 0; i < TPV; ++i) rvr[i] = *(const bf16*)((ubv_ + (size_t)i * (PITCH * 2)) + voff); } \
        } while (0)
    if (F.bid < NUNITS) PREP_LOAD(F.bid);
    for (int unit = F.bid; unit < NUNITS; unit += F.G) {
        const int c = unit / NBH, bh = unit % NBH, h = bh % NH, b = bh / NH;
        const size_t row0 = (size_t)b * T + (size_t)c * CH;
        if (h != hprev) { hprev = h;
            if (!GLA) { lb = 0.f; if (lb_on) lb = fminf(fmaxf(sigmoid_f(lbl[1024 + h * DK + d] - lbl[h * DK + d]), 0.f), 1.0f - 1e-6f); }
            else {
#pragma unroll
                for (int r = 0; r < 16; ++r) wu[r] = wup[r * 1024 + h * DK + d];
                bg = bgate[h * DK + d]; } }
        if (GLA) { sgl[F.tid] = rgl; __syncthreads(); }
        float qv[TPS], kv[TPS], G[TPS]; float run = 0.f;
#pragma unroll
        for (int i = 0; i < TPS; ++i) { const int t = seg * TPS + i; const float qa = bf1(rq[i]), ka = bf1(rk[i]); float g;
            if (!GLA) { qv[i] = silu_x(qa); const float ez = __expf(-fabsf(ka)), rz = __builtin_amdgcn_rcpf(1.0f + ez), big = rz, small = ez * rz;
                const float sg = ka >= 0.f ? big : small, ng = ka >= 0.f ? small : big; const float f = fmaxf(lb + (1.f - lb) * sg, 1e-30f); g = __logf(f); kv[i] = (1.f - lb) * ng; }
            else { qv[i] = qa * 0.0625f; kv[i] = ka; float xx = bg;
#pragma unroll
                for (int r = 0; r < 16; ++r) xx += sgl[t * 16 + r] * wu[r];
                g = log_sigmoid_fast(xx) * 0.0625f; }
            run += g; G[i] = run; }
        segtot[seg * DK + d] = run;
        __syncthreads();
        float off = 0.f, tot = 0.f, rmid = 0.f;
#pragma unroll
        for (int s = 0; s < NSEG; ++s) { const float v = segtot[s * DK + d]; tot += v; if (s < seg) off += v; if (s < 16 / TPS) rmid += v; }
        unsigned char* ub = rec + (size_t)(bh * NCH + c) * C::UNIT_B;
        bf16* QT = (bf16*)(ub + C::OFF_QT); bf16* KT = (bf16*)(ub + C::OFF_KT); bf16* Pb = (bf16*)(ub + C::OFF_P); float* Ab = (float*)(ub + C::OFF_A); bf16* VT = (bf16*)(ub + C::OFF_VT);
        unsigned kt[TPS / 2];
#pragma unroll
        for (int i = 0; i < TPS; i += 2) { float kh[2];
#pragma unroll
            for (int u = 0; u < 2; ++u) { const int t = seg * TPS + i + u; const float Gt = G[i + u] + off;
                QT[t * QP + pos] = (bf16)f2bf(qv[i + u] * __expf(Gt)); kh[u] = kv[i + u] * __expf(tot - Gt);
                qm[t * QP + d] = (bf16)f2bf(qv[i + u] * __expf(fminf(Gt - rmid, 80.f))); km[t * QP + d] = (bf16)f2bf(kv[i + u] * __expf(fminf(rmid - Gt, 80.f))); }
            kt[i / 2] = pk2(kh[0], kh[1]); }
#pragma unroll
        for (int j = 0; j < TPS / 8; ++j) { v4u w; w.x = kt[4 * j]; w.y = kt[4 * j + 1]; w.z = kt[4 * j + 2]; w.w = kt[4 * j + 3]; *(v4u*)(KT + d * CH + ((seg * TPS + 8 * j) ^ ((d & 8) << 1))) = w; }
        if (seg == NSEG - 1) Ab[d] = __expf(tot);
        { bf16* vt_ = VT + ev * CH;
          if (GLA) { const char* ubv_ = (const char*)(proj + row0 * PITCH + 2048 + h * DVH);
#pragma unroll
              for (int i = 0; i < TPV; i += 2) rvv[i / 2] = (unsigned)*(const bf16*)(ubv_ + (voff + (unsigned)i * (unsigned)(PITCH * 2))) | ((unsigned)*(const bf16*)(ubv_ + (voff + (unsigned)(i + 1) * (unsigned)(PITCH * 2))) << 16); }
          else {
#pragma unroll
              for (int i = 0; i < TPV; i += 2) rvv[i / 2] = (unsigned)rvr[i] | ((unsigned)rvr[i + 1] << 16); }
#pragma unroll
          for (int j = 0; j < TPV / 8; ++j) { v4u w; w.x = rvv[4 * j]; w.y = rvv[4 * j + 1]; w.z = rvv[4 * j + 2]; w.w = rvv[4 * j + 3];
              *(v4u*)(vt_ + ((sv * TPV + 8 * j) ^ ((ev & 8) << 1))) = w; } }
        if (unit + F.G < NUNITS) PREP_LOAD(unit + F.G);
        __syncthreads();
        if (F.wave < 3) { const int tt = F.wave >= 1, st = F.wave == 2; f32x4 acc = {0.f, 0.f, 0.f, 0.f};
#pragma unroll
            for (int i = 0; i < DK / 32; ++i) { const rbf16x8 a = *(const LAS rbf16x8*)(km + (16 * st + el) * QP + 32 * i + 8 * q4), bq = *(const LAS rbf16x8*)(qm + (16 * tt + el) * QP + 32 * i + 8 * q4);
                acc = __builtin_amdgcn_mfma_f32_16x16x32_bf16(a, bq, acc, 0, 0, 0); }
            const int ta = 16 * tt + el, s0 = 16 * st + 4 * q4;
            const float p0 = s0 + 0 <= ta ? acc[0] : 0.f, p1 = s0 + 1 <= ta ? acc[1] : 0.f, p2 = s0 + 2 <= ta ? acc[2] : 0.f, p3 = s0 + 3 <= ta ? acc[3] : 0.f;
            v2u w; w.x = pk2(p0, p1); w.y = pk2(p2, p3); *(v2u*)(Pb + ta * CH + (s0 ^ ((ta & 8) << 1))) = w; }
        else if (F.wave == 3) { v2u w; w.x = 0u; w.y = 0u; *(v2u*)(Pb + el * CH + ((16 + 4 * q4) ^ ((el & 8) << 1))) = w; }
        __syncthreads();
    }
#undef PREP_LOAD
}

template <bool GLA>
__device__ __forceinline__ void rec_seq(Frame& F, const unsigned char* rec, float* O, const bf16* proj, const float* gain, bf16* cat) {
    using C = RecCfg<GLA>;
    constexpr int DK = C::DK, DVH = C::DVH, NH = C::NH, CH = C::CH, NCH = C::NCH, QP = C::QP, NSL = C::NSL, NDT = DK / 16, NKS = DK / 32;
    constexpr int NBUF = 3, PF = NBUF - 1;
    constexpr int BUFG = C::BUF_B + (GLA ? 0 : 8192);
    constexpr int NWAIT = (PF - 1) * ((C::NR - 1) + (GLA ? 0 : 1) + 2);
    static_assert(NBUF * BUFG + 2048 <= RING_BYTES, "rec ring");
    constexpr int NUNITS = BATCH * NH * NSL;
    const int lane = F.lane, el = lane & 15, q4 = lane >> 4, wave = F.wave;
    for (int unit = F.bid; unit < NUNITS; unit += F.G) {
        const int sl = unit % NSL, h = (unit / NSL) % NH, b = unit / (NSL * NH);
        const unsigned char* ubase = rec + (size_t)((b * NH + h) * NCH) * C::UNIT_B;
#define REC_DMA(cc) do { const unsigned char* ub_ = ubase + (size_t)(cc) * C::UNIT_B; const int bufi_ = (cc) % NBUF; _Pragma("unroll") for (int r_ = 0; r_ < C::NR; ++r_) { const int p_ = r_ * 8 + wave; \
            if (p_ < C::NP) { const unsigned char* src_ = ub_ + (p_ < C::NP1 ? p_ * 1024 : C::OFF_VT + sl * 8192 + (p_ - C::NP1) * 1024) + lane * 16; \
                __builtin_amdgcn_global_load_lds((const unsigned*)src_, (LAS unsigned*)(F.lds + bufi_ * BUFG + p_ * 1024), 16, 0, 0); } } \
            if (!GLA) { const unsigned char* gsrc_ = (const unsigned char*)(proj + ((size_t)b * T + (size_t)(cc) * CH + 4 * wave + (lane >> 4)) * AB_N + 3072 + h * DVH) + (lane & 15) * 16; \
                __builtin_amdgcn_global_load_lds((const unsigned*)gsrc_, (LAS unsigned*)(F.lds + bufi_ * BUFG + C::BUF_B + wave * 1024), 16, 0, 0); } } while (0)
        f32x4 S[NDT];
#pragma unroll
        for (int i = 0; i < NDT; ++i) S[i] = (f32x4){0.f, 0.f, 0.f, 0.f};
#pragma unroll
        for (int cc = 0; cc < PF; ++cc) REC_DMA(cc);
        float* Ob = O + ((size_t)b * T) * C::OPITCH + h * DVH + sl * 128 + 16 * wave + 4 * q4;
        LAS float* ssq = (LAS float*)(F.lds + NBUF * BUFG);
        f32x4 oprev[2] = {{0.f, 0.f, 0.f, 0.f}, {0.f, 0.f, 0.f, 0.f}};
        v2u gsave[2] = {{0u, 0u}, {0u, 0u}};
        const unsigned ecol = (unsigned)(h * DVH + 16 * wave + 4 * q4);
        f32x4 gn4 = {1.f, 1.f, 1.f, 1.f}; if (!GLA) gn4 = *(const f32x4*)(gain + ecol);
#define REC_FINISH(cp) do { _Pragma("unroll") for (int tt = 0; tt < 2; ++tt) { const int tl = 16 * tt + el; float tot = 0.f; \
            _Pragma("unroll") for (int w_ = 0; w_ < 8; ++w_) tot += ssq[(((cp) & 1) * 8 + w_) * 32 + tl]; \
            const float rstd = 1.0f / sqrtf(tot * (1.f / 128.f) + EPS); const size_t row_ = (size_t)b * T + (size_t)(cp) * CH + tl; \
            const v2u gw_ = gsave[tt]; const f32x4 ov = oprev[tt]; \
            v2u w_o; w_o.x = pk2(ov.x * rstd * gn4.x * silu_x(bf_lo(gw_.x)), ov.y * rstd * gn4.y * silu_x(bf_hi(gw_.x))); \
            w_o.y = pk2(ov.z * rstd * gn4.z * silu_x(bf_lo(gw_.y)), ov.w * rstd * gn4.w * silu_x(bf_hi(gw_.y))); \
            *(v2u*)(cat + row_ * DM + ecol) = w_o; } } while (0)
        for (int c = 0; c < NCH; ++c) {
            if (c <= PF) asm volatile("s_waitcnt vmcnt(0)" ::: "memory"); else asm volatile("s_waitcnt vmcnt(%0)" :: "i"(NWAIT) : "memory");
            asm volatile("s_waitcnt lgkmcnt(0)" ::: "memory"); __builtin_amdgcn_s_barrier(); asm volatile("" ::: "memory");
            if (!GLA) {
                if (c > 0) REC_FINISH(c - 1);
                else { v2u z; z.x = 0u; z.y = 0u; *(v2u*)(cat + ((size_t)b * T + el) * DM + ecol) = z; *(v2u*)(cat + ((size_t)b * T + 16 + el) * DM + ecol) = z; }
            }
            if (c + PF < NCH) REC_DMA(c + PF); else REC_DMA(NCH - 1);
            const LAS unsigned char* L = F.lds + (c % NBUF) * BUFG;
            rbf16x8 sf[NKS];
#pragma unroll
            for (int i = 0; i < NKS; ++i) sf[i] = rpack8(S[2 * i], S[2 * i + 1]);
            f32x4 o[2];
#pragma unroll
            for (int tt = 0; tt < 2; ++tt) { o[tt] = (f32x4){0.f, 0.f, 0.f, 0.f};
#pragma unroll
                for (int i = 0; i < NKS; ++i) { const rbf16x8 qf = *(const LAS rbf16x8*)(L + C::OFF_QT + ((16 * tt + el) * QP + 32 * i + 8 * q4) * 2);
                    o[tt] = __builtin_amdgcn_mfma_f32_16x16x32_bf16(sf[i], qf, o[tt], 0, 0, 0); } }
            const rbf16x8 vf = *(const LAS rbf16x8*)(L + C::OFF_VT + ((16 * wave + el) * CH + 8 * q4) * 2);
#pragma unroll
            for (int tt = 0; tt < 2; ++tt) { const rbf16x8 pf = *(const LAS rbf16x8*)(L + C::OFF_P + ((16 * tt + el) * CH + 8 * q4) * 2);
                o[tt] = __builtin_amdgcn_mfma_f32_16x16x32_bf16(vf, pf, o[tt], 0, 0, 0); }
#pragma unroll
            for (int dt = 0; dt < NDT; ++dt) { const f32x4 a4 = *(const LAS f32x4*)(L + C::OFF_A + (16 * dt + 4 * q4) * 4); S[dt] = S[dt] * a4;
                const rbf16x8 kf = *(const LAS rbf16x8*)(L + C::OFF_KT + ((16 * dt + el) * CH + 8 * q4) * 2);
                S[dt] = __builtin_amdgcn_mfma_f32_16x16x32_bf16(kf, vf, S[dt], 0, 0, 0); }
            if (GLA) {
#pragma unroll
                for (int tt = 0; tt < 2; ++tt) *(f32x4*)(Ob + (size_t)(c * CH + 16 * tt + el) * C::OPITCH) = o[tt];
            } else {
#pragma unroll
                for (int tt = 0; tt < 2; ++tt) { float p = (o[tt].x * o[tt].x + o[tt].y * o[tt].y) + (o[tt].z * o[tt].z + o[tt].w * o[tt].w); p = xsum<16>(p); p = xsum<32>(p);
                    if (q4 == 0) ssq[((c & 1) * 8 + wave) * 32 + 16 * tt + el] = p; oprev[tt] = o[tt];
                    gsave[tt] = *(const LAS v2u*)(L + C::BUF_B + ((16 * tt + el) * 128 + 16 * wave + 4 * q4) * 2); }
            }
        }
        asm volatile("s_waitcnt vmcnt(0)" ::: "memory"); __syncthreads();
        if (!GLA) { REC_FINISH(NCH - 1); }
        __syncthreads();
#undef REC_FINISH
#undef REC_DMA
    }
}

template <bool GLA>
__device__ __forceinline__ void rec_seq2(Frame& F, const unsigned char* rec, bf16* O) {
    using C = RecCfg<GLA>;
    constexpr int DK = C::DK, DVH = C::DVH, NH = C::NH, CH = C::CH, NCH = C::NCH, QP = C::QP;
    constexpr int NDH = DK / 32, NKH = DK / 64;
    constexpr int ES = 64, NSL = DVH / ES, BUF2 = C::OFF_VT + ES * CH * 2, NP1 = C::OFF_VT / 1024, NP = NP1 + ES * CH * 2 / 1024, NR = NP / 8;
    constexpr int NBUF = GLA ? 3 : 5, PF = NBUF - 1, NWAIT = (PF - 1) * (NR + 1);
    static_assert(NP % 8 == 0 && NBUF * BUF2 + 2 * 8 * 1024 <= RING_BYTES, "rec_seq2 ring");
    constexpr int NUNITS = BATCH * NH * NSL;
    const int lane = F.lane, el = lane & 15, q4 = lane >> 4, wave = F.wave, eg = wave & 3, dg = wave >> 2;
    LAS unsigned char* xch = F.lds + NBUF * BUF2;
    for (int unit = F.bid; unit < NUNITS; unit += F.G) {
        const int sl = unit % NSL, h = (unit / NSL) % NH, b = unit / (NSL * NH);
        const unsigned char* ubase = rec + (size_t)((b * NH + h) * NCH) * C::UNIT_B;
#define G2_DMA(cc) do { const unsigned char* ub_ = ubase + (size_t)(cc) * C::UNIT_B; const int bufi_ = (cc) % NBUF; _Pragma("unroll") for (int r_ = 0; r_ < NR; ++r_) { const int p_ = r_ * 8 + wave; \
            const unsigned char* src_ = ub_ + (p_ < NP1 ? p_ * 1024 : C::OFF_VT + sl * (ES * CH * 2) + (p_ - NP1) * 1024) + lane * 16; \
            __builtin_amdgcn_global_load_lds((const unsigned*)src_, (LAS unsigned*)(F.lds + bufi_ * BUF2 + p_ * 1024), 16, 0, 0); } } while (0)
        f32x4 S[NDH];
#pragma unroll
        for (int i = 0; i < NDH; ++i) S[i] = (f32x4){0.f, 0.f, 0.f, 0.f};
#pragma unroll
        for (int cc = 0; cc < PF; ++cc) G2_DMA(cc);
        bf16* Ob = O + ((size_t)b * T + 16 * dg + el) * C::OPITCH + h * DVH + sl * ES + 16 * eg + 4 * q4;
#define G2_ST(p_, v_) do { const f32x4 v4_ = (v_); v2u w2_; w2_.x = pg8::cvt_pk_bf16(v4_.x, v4_.y); w2_.y = pg8::cvt_pk_bf16(v4_.z, v4_.w); *(v2u*)(p_) = w2_; } while (0)
        f32x4 okeep = {0.f, 0.f, 0.f, 0.f};
        for (int c = 0; c < NCH; ++c) {
            if (c <= PF) asm volatile("s_waitcnt vmcnt(0)" ::: "memory"); else asm volatile("s_waitcnt vmcnt(%0)" :: "i"(NWAIT) : "memory");
            asm volatile("s_waitcnt lgkmcnt(0)" ::: "memory"); __builtin_amdgcn_s_barrier(); asm volatile("" ::: "memory");
            if (c + PF < NCH) G2_DMA(c + PF); else G2_DMA(NCH - 1);
            const LAS unsigned char* L = F.lds + (c % NBUF) * BUF2;
            rbf16x8 qf[2][NKH], kf[NDH]; f32x4 a4[NDH];
#pragma unroll
            for (int tt = 0; tt < 2; ++tt)
#pragma unroll
                for (int i = 0; i < NKH; ++i) qf[tt][i] = *(const LAS rbf16x8*)(L + C::OFF_QT + ((16 * tt + el) * QP + 32 * (NKH * dg + i) + 8 * q4) * 2);
            const int sw8 = (8 * q4) ^ ((el & 8) << 1);
            const rbf16x8 vf = *(const LAS rbf16x8*)(L + C::OFF_VT + ((16 * eg + el) * CH + sw8) * 2);
            const rbf16x8 pf = *(const LAS rbf16x8*)(L + C::OFF_P + ((16 * dg + el) * CH + sw8) * 2);
#pragma unroll
            for (int j = 0; j < NDH; ++j) { kf[j] = *(const LAS rbf16x8*)(L + C::OFF_KT + ((16 * (NDH * dg + j) + el) * CH + sw8) * 2); a4[j] = *(const LAS f32x4*)(L + C::OFF_A + (16 * (NDH * dg + j) + 4 * q4) * 4); }
            rbf16x8 sf[NKH];
#pragma unroll
            for (int i = 0; i < NKH; ++i) sf[i] = rpack8(S[2 * i], S[2 * i + 1]);
            f32x4 o[2];
#pragma unroll
            for (int tt = 0; tt < 2; ++tt) { o[tt] = (f32x4){0.f, 0.f, 0.f, 0.f};
#pragma unroll
                for (int i = 0; i < NKH; ++i) o[tt] = __builtin_amdgcn_mfma_f32_16x16x32_bf16(sf[i], qf[tt][i], o[tt], 0, 0, 0); }
            if (dg == 0) o[0] = __builtin_amdgcn_mfma_f32_16x16x32_bf16(vf, pf, o[0], 0, 0, 0); else o[1] = __builtin_amdgcn_mfma_f32_16x16x32_bf16(vf, pf, o[1], 0, 0, 0);
#pragma unroll
            for (int j = 0; j < NDH; ++j) { S[j] = S[j] * a4[j]; S[j] = __builtin_amdgcn_mfma_f32_16x16x32_bf16(kf[j], vf, S[j], 0, 0, 0); }
            if (c > 0) { const f32x4 pr = *(const LAS f32x4*)(xch + ((((c - 1) & 1) * 8 + (wave ^ 4)) * 64 + lane) * 16);
                         G2_ST(Ob + (size_t)((c - 1) * CH) * C::OPITCH, okeep + pr); }
            else { G2_ST(Ob, okeep); }
            *(LAS f32x4*)(xch + (((c & 1) * 8 + wave) * 64 + lane) * 16) = dg == 0 ? o[1] : o[0];
            okeep = dg == 0 ? o[0] : o[1];
        }
        asm volatile("s_waitcnt vmcnt(0) lgkmcnt(0)" ::: "memory"); __syncthreads();
        { const f32x4 pr = *(const LAS f32x4*)(xch + ((((NCH - 1) & 1) * 8 + (wave ^ 4)) * 64 + lane) * 16); G2_ST(Ob + (size_t)((NCH - 1) * CH) * C::OPITCH, okeep + pr); }
        __syncthreads();
#undef G2_ST
#undef G2_DMA
    }
}

template <bool GLA>
__device__ __forceinline__ void rec_seq3(Frame& F, const unsigned char* rec, bf16* O) {
    using C = RecCfg<GLA>;
    constexpr int DK = C::DK, DVH = C::DVH, NH = C::NH, CH = C::CH, NCH = C::NCH, QP = C::QP;
    constexpr int NDH = DK / 32, NKH = DK / 64;
    constexpr int ES = 64, NSL = DVH / ES, BUF2 = C::OFF_VT + ES * CH * 2, NP1 = C::OFF_VT / 1024, NP = NP1 + ES * CH * 2 / 1024, NRL = NP / 4;
    constexpr int NBUF = GLA ? 3 : 5, PF = NBUF - 1, NWAIT = (PF - 1) * NRL;
    static_assert(NP % 4 == 0 && NBUF * BUF2 + 2 * 8 * 1024 <= RING_BYTES && NWAIT < 64, "rec_seq3 ring");
    constexpr int NUNITS = BATCH * NH * NSL;
    const int lane = F.lane, el = lane & 15, q4 = lane >> 4, wave = F.wave;
    LAS unsigned char* xch = F.lds + NBUF * BUF2;
    for (int unit = F.bid; unit < NUNITS; unit += F.G) {
        const int sl = unit % NSL, h = (unit / NSL) % NH, b = unit / (NSL * NH);
        const unsigned char* ubase = rec + (size_t)((b * NH + h) * NCH) * C::UNIT_B;
        const int eg2 = wave & 1, dg = (wave >> 1) & 1;
        bf16* Ob = O + ((size_t)b * T + 16 * dg + el) * C::OPITCH + h * DVH + sl * ES + 32 * eg2 + 4 * q4;
        f32x4 okeep[2] = {{0.f, 0.f, 0.f, 0.f}, {0.f, 0.f, 0.f, 0.f}};
#define G3_ST(p_, v_) do { const f32x4 v4_ = (v_); v2u w2_; w2_.x = pg8::cvt_pk_bf16(v4_.x, v4_.y); w2_.y = pg8::cvt_pk_bf16(v4_.z, v4_.w); *(v2u*)(p_) = w2_; } while (0)
        if (wave >= 4) {
            const int lw = wave - 4;
#define G3_DMA(cc) do { const unsigned char* ub_ = ubase + (size_t)(cc) * C::UNIT_B; const int bufi_ = (cc) % NBUF; _Pragma("unroll") for (int r_ = 0; r_ < NRL; ++r_) { const int p_ = r_ * 4 + lw; \
            const unsigned char* src_ = ub_ + (p_ < NP1 ? p_ * 1024 : C::OFF_VT + sl * (ES * CH * 2) + (p_ - NP1) * 1024) + lane * 16; \
            __builtin_amdgcn_global_load_lds((const unsigned*)src_, (LAS unsigned*)(F.lds + bufi_ * BUF2 + p_ * 1024), 16, 0, 0); } } while (0)
#pragma unroll
            for (int cc = 0; cc < PF; ++cc) G3_DMA(cc);
            for (int c = 0; c < NCH; ++c) {
                asm volatile("s_waitcnt vmcnt(%0)" :: "i"(NWAIT) : "memory");
                __builtin_amdgcn_s_barrier(); asm volatile("" ::: "memory");
                if (c + PF < NCH) G3_DMA(c + PF); else G3_DMA(NCH - 1);
            }
            asm volatile("s_waitcnt vmcnt(0)" ::: "memory");
#undef G3_DMA
        } else {
            f32x4 S[NDH][2];
#pragma unroll
            for (int i = 0; i < NDH; ++i) { S[i][0] = (f32x4){0.f, 0.f, 0.f, 0.f}; S[i][1] = (f32x4){0.f, 0.f, 0.f, 0.f}; }
            const int sw8 = (8 * q4) ^ ((el & 8) << 1);
            for (int c = 0; c < NCH; ++c) {
                asm volatile("s_waitcnt lgkmcnt(0)" ::: "memory"); __builtin_amdgcn_s_barrier(); asm volatile("" ::: "memory");
                const LAS unsigned char* L = F.lds + (c % NBUF) * BUF2;
                rbf16x8 qf[2][NKH], kf[NDH], vf[2]; f32x4 a4[NDH];
#pragma unroll
                for (int tt = 0; tt < 2; ++tt)
#pragma unroll
                    for (int i = 0; i < NKH; ++i) qf[tt][i] = *(const LAS rbf16x8*)(L + C::OFF_QT + ((16 * tt + el) * QP + 32 * (NKH * dg + i) + 8 * q4) * 2);
#pragma unroll
                for (int et = 0; et < 2; ++et) vf[et] = *(const LAS rbf16x8*)(L + C::OFF_VT + ((32 * eg2 + 16 * et + el) * CH + sw8) * 2);
                const rbf16x8 pf = *(const LAS rbf16x8*)(L + C::OFF_P + ((16 * dg + el) * CH + sw8) * 2);
#pragma unroll
                for (int j = 0; j < NDH; ++j) { kf[j] = *(const LAS rbf16x8*)(L + C::OFF_KT + ((16 * (NDH * dg + j) + el) * CH + sw8) * 2); a4[j] = *(const LAS f32x4*)(L + C::OFF_A + (16 * (NDH * dg + j) + 4 * q4) * 4); }
                f32x4 o[2][2];
#pragma unroll
                for (int et = 0; et < 2; ++et) { rbf16x8 sf[NKH];
#pragma unroll
                    for (int i = 0; i < NKH; ++i) sf[i] = rpack8(S[2 * i][et], S[2 * i + 1][et]);
#pragma unroll
                    for (int tt = 0; tt < 2; ++tt) { o[tt][et] = (f32x4){0.f, 0.f, 0.f, 0.f};
#pragma unroll
                        for (int i = 0; i < NKH; ++i) o[tt][et] = __builtin_amdgcn_mfma_f32_16x16x32_bf16(sf[i], qf[tt][i], o[tt][et], 0, 0, 0); } }
#pragma unroll
                for (int et = 0; et < 2; ++et) { if (dg == 0) o[0][et] = __builtin_amdgcn_mfma_f32_16x16x32_bf16(vf[et], pf, o[0][et], 0, 0, 0); else o[1][et] = __builtin_amdgcn_mfma_f32_16x16x32_bf16(vf[et], pf, o[1][et], 0, 0, 0); }
#pragma unroll
                for (int j = 0; j < NDH; ++j)
#pragma unroll
                    for (int et = 0; et < 2; ++et) { S[j][et] = S[j][et] * a4[j]; S[j][et] = __builtin_amdgcn_mfma_f32_16x16x32_bf16(kf[j], vf[et], S[j][et], 0, 0, 0); }
                if (c > 0) {
#pragma unroll
                    for (int et = 0; et < 2; ++et) { const f32x4 pr = *(const LAS f32x4*)(xch + (((((c - 1) & 1) * 4 + (wave ^ 2)) * 2 + et) * 64 + lane) * 16);
                        G3_ST(Ob + (size_t)((c - 1) * CH) * C::OPITCH + 16 * et, okeep[et] + pr); } }
#pragma unroll
                for (int et = 0; et < 2; ++et) { *(LAS f32x4*)(xch + ((((c & 1) * 4 + wave) * 2 + et) * 64 + lane) * 16) = dg == 0 ? o[1][et] : o[0][et]; okeep[et] = dg == 0 ? o[0][et] : o[1][et]; }
            }
        }
        asm volatile("s_waitcnt vmcnt(0) lgkmcnt(0)" ::: "memory"); __syncthreads();
        if (wave < 4) {
#pragma unroll
            for (int et = 0; et < 2; ++et) { const f32x4 pr = *(const LAS f32x4*)(xch + (((((NCH - 1) & 1) * 4 + (wave ^ 2)) * 2 + et) * 64 + lane) * 16);
                G3_ST(Ob + (size_t)((NCH - 1) * CH) * C::OPITCH + 16 * et, okeep[et] + pr); } }
        __syncthreads();
#undef G3_ST
    }
}
#define WSP(T_, off) ((T_*)(ws + (off)))
#define REFRAME() CArgs* ap = opq_args(); unsigned char* ws = ap->ws; (void)ws; \
    F.lds = (LAS unsigned char*)lds; F.tid = opq_tid(wave_s); F.lane = F.tid & 63; F.wave = __builtin_amdgcn_readfirstlane(F.tid >> 6); F.G = gridDim.x; F.bid = opq_bid()
#ifndef DBG_DOUBLE
#define DBG_DOUBLE 0
#endif
#define NREP(bit) ((DBG_DOUBLE & (bit)) ? 2 : 1)
#define REPBAR(rep, n) do { if ((rep) + 1 < (n)) xcd_barrier<false>(bar, F.tid == 0); } while (0)
#define IN(k) (lo <= (k) && (k) < hi)
#define SEAM(k) do { if (IN(k) && IN((k) + 1)) xcd_barrier<false>(bar, F.tid == 0); } while (0)
template <int layer>
__device__ __forceinline__ void layer_phases(unsigned char* lds, const int wave_s, const int lo, const int hi, const XcdBarrier& bar) {
    Frame F;

        constexpr int pb = phase_base(layer); constexpr bool odd = layer & 1; constexpr int li = layer >> 1;
        constexpr int P_NORM1 = pb, P_MIXIN = pb + 1, P_PREP = pb + 2, P_REC = pb + 3, P_POST = pb + 4, P_MIXOUT = pb + 5, P_NORM2 = P_MIXOUT + 1, P_FFIN = P_MIXOUT + 2, P_FFOUT = P_MIXOUT + 3;
#define MODL (WSP(float, WS_MOD) + (size_t)layer * 2 * 6 * DM)
#define XCUR (layer == 0 ? ap->in[0] : (const float*)ap->out)
        if (IN(P_NORM1)) { REFRAME();
            const float* modl = MODL;
            for (int rep = 0; rep < NREP(2); ++rep) {
            constexpr bool L0 = layer == 0; const float* g2p = WSP(float, WS_MOD) + (size_t)(L0 ? 0 : layer - 1) * 2 * 6 * DM + 5 * DM; const void* xin = L0 ? (const void*)ap->in[0] : (const void*)WSP(const bf16, WS_XB);
            if (!odd) norm_phase<8, 1, !L0, L0>(F, xin, ap->in[4] + (size_t)layer * DM, modl, modl + DM, WSP(bf16, WS_H), ap->in[6] + (size_t)li * DM * AB_IN + AB_N, AB_IN, ap->in[12] + li * 8, WSP(float, WS_LOGF), WSP(const bf16, WS_Y), g2p, WSP(bf16, WS_XB));
            else norm_phase<16, 2, !L0, L0>(F, xin, ap->in[4] + (size_t)layer * DM, modl, modl + DM, WSP(bf16, WS_H), ap->in[13] + (size_t)li * DM * C_IN + C_N, C_IN, nullptr, WSP(float, WS_GLOW), WSP(const bf16, WS_Y), g2p, WSP(bf16, WS_XB));
            REPBAR(rep, NREP(2)); }
            SEAM(P_NORM1);
        }
        if (IN(P_MIXIN)) { REFRAME();
            const int N = odd ? 4096 : AB_N, ldc = odd ? C_N : AB_N;
            const bf16* Wt = odd ? WSP(const bf16, WS_W_GLIN) + (size_t)li * C_N * DM : WSP(const bf16, WS_W_ABIN) + (size_t)li * AB_N * DM;
            pg8::Gemm g{WSP(const bf16, WS_H), Wt, M, N, DM}; pg8::StaticOrder S; S.init(M, N, F.G, F.bid);
            pg8::EpiBf16 E{WSP(bf16, WS_PROJ), ldc};
            for (int rep = 0; rep < NREP(1); ++rep) { pg8::gemm_phase<pg8::EpiBf16, pg8::StaticOrder, true, true>(F.lds + RING_OFF, g, S, E, F.tid); REPBAR(rep, NREP(1)); }
            SEAM(P_MIXIN);
        }
        if (IN(P_PREP)) { REFRAME();
            if (!odd) { fox_prep(F, WSP(bf16, WS_PROJ), ap->in[10] + li * 128, ap->in[11] + li * 128, WSP(float, WS_LOGF), WSP(float, WS_BIAS));
                        __syncthreads();
                        for (int rep = 0; rep < NREP(4); ++rep) { rec_prep<false>(F, WSP(const bf16, WS_PROJ), ws + WS_REC, ap->in[8], li, nullptr, nullptr, nullptr); REPBAR(rep, NREP(4)); } }
            else for (int rep = 0; rep < NREP(4); ++rep) { rec_prep<true>(F, WSP(const bf16, WS_PROJ), ws + WS_REC, nullptr, 0, WSP(float, WS_GLOW), ap->in[14] + (size_t)li * 16 * 1024, ap->in[15] + li * 1024); REPBAR(rep, NREP(4)); }
            SEAM(P_PREP);
        }
        if (IN(P_REC)) { REFRAME();
            for (int rep = 0; rep < (odd ? NREP(8) : 1); ++rep) {
            if (!odd) { rec_seq3<false>(F, ws + WS_REC, WSP(bf16, WS_O));
                        fox_phase(F, (char*)lds + RING_OFF, WSP(const bf16, WS_PROJ), WSP(bf16, WS_CAT), WSP(float, WS_BIAS), (unsigned*)(ws + WS_CTL) + CW_QUEUE + 64 * (li + 2 * rep), ap->in[10] + li * 128, ap->in[11] + li * 128); }
            else { rec_seq3<true>(F, ws + WS_REC, WSP(bf16, WS_O));
                   if (F.bid >= 64 && rep == 0) {
                       { pg8::Gemm g{WSP(const bf16, WS_H), WSP(const bf16, WS_W_GLIN) + (size_t)li * C_N * DM + (size_t)4096 * DM, M, 2048, DM}; pg8::StaticOrder S; S.init(M, 2048, F.G - 64, F.bid - 64);
                         pg8::EpiBf16 E{WSP(bf16, WS_PROJ) + 4096, C_N};
                         pg8::gemm_phase<pg8::EpiBf16, pg8::StaticOrder, true, true>(F.lds + RING_OFF, g, S, E, F.tid); }
                       LAS float* scr = (LAS float*)(F.lds + RING_OFF + F.wave * 16640);
                       convert_weights<(layer == 1 ? 1 : 2)>(ap, scr, (F.bid - 64) * NWAVES + F.wave, (F.G - 64) * NWAVES, F.lane); } }
            REPBAR(rep, (odd ? NREP(8) : 1)); }
            SEAM(P_REC);
        }
        if (IN(P_POST)) { REFRAME();
            if (!odd) post_even(F, WSP(const bf16, WS_O), WSP(const bf16, WS_PROJ), ap->in[9] + li * 1024, WSP(bf16, WS_CAT));
            else for (int rep = 0; rep < NREP(16); ++rep) { post_odd(F, WSP(const bf16, WS_O), WSP(const bf16, WS_PROJ), ap->in[16] + li * 512, WSP(bf16, WS_CAT)); REPBAR(rep, NREP(16)); }
            SEAM(P_POST);
        }
        if (IN(P_MIXOUT)) { REFRAME();
            const float* modl = MODL;
            const bf16* Wt = odd ? WSP(const bf16, WS_W_GLOUT) + (size_t)li * DM * DM : WSP(const bf16, WS_W_ABOUT) + (size_t)li * DM * DM;
            pg8::Gemm g{WSP(const bf16, WS_CAT), Wt, M, DM, DM}; pg8::StaticOrder S; S.init(M, DM, F.G, F.bid);
            pg8::EpiBf16 E{WSP(bf16, WS_Y), DM};
            pg8::gemm_phase<pg8::EpiBf16, pg8::StaticOrder, true, true>(F.lds + RING_OFF, g, S, E, F.tid);
            SEAM(P_MIXOUT);
        }
        if (IN(P_NORM2)) { REFRAME();
            const float* modl = MODL;
            { constexpr bool L0 = layer == 0; const void* xin = L0 ? (const void*)ap->in[0] : (const void*)WSP(const bf16, WS_XB);
              norm_phase<0, 0, true, L0>(F, xin, ap->in[5] + (size_t)layer * DM, modl + 3 * DM, modl + 4 * DM, WSP(bf16, WS_H), nullptr, 0, nullptr, nullptr, WSP(const bf16, WS_Y), modl + 2 * DM, WSP(bf16, WS_XB)); }
            SEAM(P_NORM2);
        }
        if (IN(P_FFIN)) { REFRAME();
            pg8::Gemm g{WSP(const bf16, WS_H), WSP(const bf16, WS_W_FFIN) + (size_t)layer * FF2 * DM, M, FF2, DM}; pg8::StaticOrder S; S.init(M, FF2, F.G, F.bid);
            pg8::EpiSwiglu E{WSP(bf16, WS_FFH), FF};
            for (int rep = 0; rep < NREP(1 | 128); ++rep) { pg8::gemm_phase<pg8::EpiSwiglu, pg8::StaticOrder, true, true>(F.lds + RING_OFF, g, S, E, F.tid); REPBAR(rep, NREP(1 | 128)); }
            SEAM(P_FFIN);
        }
        if (IN(P_FFOUT)) { REFRAME();
            const float* modl = MODL;
            pg8::Gemm g{WSP(const bf16, WS_FFH), WSP(const bf16, WS_W_FFOUT) + (size_t)layer * DM * FF, M, DM, FF}; pg8::StaticOrder S; S.init(M, DM, F.G, F.bid);
            pg8::EpiBf16 E{WSP(bf16, WS_Y), DM};
            pg8::gemm_phase<pg8::EpiBf16, pg8::StaticOrder, true, true>(F.lds + RING_OFF, g, S, E, F.tid);
            SEAM(P_FFOUT);
        }
    }
__global__ void __launch_bounds__(NTHREADS, 2) trunk_fwd(Args args_unused) {
    extern __shared__ __attribute__((aligned(16))) unsigned char lds[];
    Frame F;
    const int wave_s = __builtin_amdgcn_readfirstlane(threadIdx.x >> 6);
    int lo, hi, use_bar; XcdBarrier bar;
    {
        REFRAME();
        volatile LAS unsigned* MISC = (volatile LAS unsigned*)(F.lds + MISC_OFF);
        for (int u = F.tid; u < (LDS_BYTES - LDSCTL_OFF) / 4; u += NTHREADS) ((LAS unsigned*)(F.lds + LDSCTL_OFF))[u] = 0u;
        __syncthreads();
        lo = ap->ph_lo; hi = ap->ph_hi; use_bar = ap->use_bar;
        bar.bar = (unsigned*)(ws + WS_CTL) + CW_BAR; bar.x = 0; bar.st = MISC + 8;
        if (use_bar) bar = xcd_barrier_post((unsigned*)(ws + WS_CTL) + CW_BAR, MISC + 8, F.tid == 0);
    }

    if (IN(0)) { REFRAME(); p0_prologue(F, ap); if (IN(1)) xcd_barrier<true>(bar, F.tid == 0);
        if (DBG_DOUBLE & 32) { p0_prologue(F, ap); xcd_barrier<false>(bar, F.tid == 0); } }

    layer_phases<0>(lds, wave_s, lo, hi, bar);
    layer_phases<1>(lds, wave_s, lo, hi, bar);
    layer_phases<2>(lds, wave_s, lo, hi, bar);
    layer_phases<3>(lds, wave_s, lo, hi, bar);
    if (IN(phase_base(DEPTH))) { REFRAME(); resid_final(F, WSP(const bf16, WS_XB), WSP(const bf16, WS_Y), WSP(float, WS_MOD) + (size_t)(DEPTH - 1) * 2 * 6 * DM + 5 * DM, ap->out); }
#undef IN
#undef SEAM
}

#ifndef DBG_CHECK
#define DBG_CHECK 0
#endif
#if DBG_CHECK
#ifndef DBG_REPORT_ERR
#define DBG_REPORT_ERR 1
#endif
constexpr size_t WS_DBG = 5 * MiB;
constexpr size_t WS_DBG_OLD = 1072 * MiB;
__device__ __forceinline__ unsigned dbg_hash(unsigned x) { x ^= x >> 16; x *= 0x7feb352dU; x ^= x >> 15; x *= 0x846ca68bU; x ^= x >> 16; return x; }
__device__ __forceinline__ float dbg_bfr(float f) { return __builtin_bit_cast(float, f2bf(f) << 16); }
__device__ __forceinline__ void dbg_cmp(unsigned* dbg, unsigned code, float got, float ref, float rtol, float atol) {
    const float err = fabsf(got - ref); const bool bad = !(err <= atol + rtol * fabsf(ref));
    if (bad) { atomicMin(dbg, code); atomicMax(dbg + 1 + (code & 255u), __float_as_uint(err)); }
}
__global__ void dbg_gemm(unsigned* dbg, unsigned code, int mode, const bf16* A, int K, const float* W, int ldw, int N, const void* C, int ldc, const float* old, const float* gate0, const float* gate1) {
    const unsigned s = blockIdx.x * blockDim.x + threadIdx.x; const unsigned hsh = dbg_hash(s * 2654435761u + code);
    const int m = hsh % M, n = dbg_hash(hsh) % N;
    float d0 = 0.f, d1 = 0.f;
    for (int k = 0; k < K; ++k) { const float a = bf1(A[(size_t)m * K + k]); d0 += a * dbg_bfr(W[(size_t)k * ldw + n]); if (mode == 1) d1 += a * dbg_bfr(W[(size_t)k * ldw + FF + n]); }
    float got, ref;
    if (mode == 0) { got = bf1(((const bf16*)C)[(size_t)m * ldc + n]); ref = d0; }
    else if (mode == 1) { got = bf1(((const bf16*)C)[(size_t)m * ldc + n]); ref = d0 / (1.f + expf(-d0)) * d1; }
    else { got = ((const float*)C)[(size_t)m * ldc + n]; ref = old[(size_t)m * ldc + n] + (m >= T ? gate1 : gate0)[n] * d0; }
    dbg_cmp(dbg, code, got, ref, 0.02f, 0.03f);
}
__global__ void dbg_norm(unsigned* dbg, unsigned code, const float* x, const float* gain, const float* sh, const float* sc, const bf16* h) {
    const unsigned s = blockIdx.x * blockDim.x + threadIdx.x; const unsigned hsh = dbg_hash(s * 2654435761u + code);
    const int m = hsh % M, k = dbg_hash(hsh) % DM, b = m / T;
    double ss = 0.0; for (int i = 0; i < DM; ++i) { const double v = x[(size_t)m * DM + i]; ss += v * v; }
    const float rstd = (float)(1.0 / sqrt(ss / DM + 1e-6));
    const float ref = x[(size_t)m * DM + k] * rstd * gain[k] * (1.f + sc[(size_t)b * 6 * DM + k]) + sh[(size_t)b * 6 * DM + k];
    dbg_cmp(dbg, code, bf1(h[(size_t)m * DM + k]), ref, 0.01f, 0.01f);
}
__global__ void dbg_mod(unsigned* dbg, unsigned code, const float* c, const float* mw, const float* mb, const float* mod) {
    const unsigned s = blockIdx.x * blockDim.x + threadIdx.x; const unsigned hsh = dbg_hash(s * 2654435761u + code);
    const int layer = hsh % DEPTH, b = (hsh >> 8) & 1, j = dbg_hash(hsh) % (6 * DM);
    double acc = mb[(size_t)layer * 6 * DM + j];
    for (int k = 0; k < DM; ++k) { const double cv = c[b * DM + k]; acc += cv / (1.0 + exp(-cv)) * mw[((size_t)layer * DM + k) * (6 * DM) + j]; }
    dbg_cmp(dbg, code, mod[((size_t)layer * 2 + b) * 6 * DM + j], (float)acc, 1e-3f, 1e-4f);
}
__global__ void dbg_small(unsigned* dbg, unsigned code, int mode, const bf16* h, const float* W, int ldw, const float* fbias, const float* sout) {
    const unsigned s = blockIdx.x * blockDim.x + threadIdx.x; const unsigned hsh = dbg_hash(s * 2654435761u + code);
    const int m = hsh % M, cc = dbg_hash(hsh) % (mode == 1 ? 8 : 16), b = m / T, t = m % T;
    double acc = 0.0; for (int k = 0; k < DM; ++k) acc += (double)bf1(h[(size_t)m * DM + k]) * W[(size_t)k * ldw + cc];
    if (mode == 1) { const double xx = acc + fbias[cc]; const double ref = (xx < 0 ? xx : 0.0) - log1p(exp(-fabs(xx))); dbg_cmp(dbg, code, sout[((size_t)b * 8 + cc) * T + t], (float)ref, 0.02f, 0.02f); }
    else dbg_cmp(dbg, code, sout[(size_t)m * 16 + cc], (float)acc, 0.02f, 0.02f);
}
__global__ void dbg_cmpbuf(unsigned* dbg, unsigned code, const float* a, const float* b, size_t n) {
    for (size_t i = (size_t)blockIdx.x * blockDim.x + threadIdx.x; i < n; i += (size_t)gridDim.x * blockDim.x * 61) dbg_cmp(dbg, code, b[i], a[i], 0.05f, 0.1f);
}
__global__ void dbg_report(const unsigned* dbg, float* out) {
    if (threadIdx.x == 0 && blockIdx.x == 0) { const unsigned code = dbg[0]; if (code != 0xffffffffu) { out[0] = DBG_REPORT_ERR ? 1000.f * __uint_as_float(dbg[1 + (code & 255u)]) : 1000.f * (float)(code & 255u); } }
}
#endif
#ifndef N_LAUNCH_MODE
#define N_LAUNCH_MODE 1
#endif
extern "C" void kernel_launch(void* const* d_in, const int* in_sizes, int n_in, void* d_out, int out_size, void* d_ws, size_t ws_size, hipStream_t stream) {
    static int grid = 0;
    if (grid == 0) {
        if (n_in != 20 || out_size != M * DM || ws_size < WS_END) { fprintf(stderr, "kernel_launch: unexpected shapes (n_in %d out %d ws %zu)\n", n_in, out_size, ws_size); grid = -1; return; }
        int dev = 0, cus = 0, per_cu = 0;
        if (hipGetDevice(&dev) != hipSuccess || hipDeviceGetAttribute(&cus, hipDeviceAttributeMultiprocessorCount, dev) != hipSuccess) { grid = -1; return; }
        if (hipFuncSetAttribute((const void*)trunk_fwd, hipFuncAttributeMaxDynamicSharedMemorySize, LDS_BYTES) != hipSuccess) { fprintf(stderr, "kernel_launch: hipFuncSetAttribute failed\n"); grid = -1; return; }
        if (hipOccupancyMaxActiveBlocksPerMultiprocessor(&per_cu, (const void*)trunk_fwd, NTHREADS, LDS_BYTES) != hipSuccess || per_cu < 1)
            fprintf(stderr, "kernel_launch: occupancy query reports %d workgroups per CU\n", per_cu);
        (void)hipGetLastError();
        grid = cus;
    }
    if (grid < 0) return;
    if (hipMemsetAsync((char*)d_ws + WS_CTL, 0, CTL_ZERO_BYTES, stream) != hipSuccess) return;
    Args a{};
    for (int i = 0; i < 20; ++i) a.in[i] = (const float*)d_in[i];
    a.out = (float*)d_out; a.ws = (unsigned char*)d_ws; a.pad = 0;
#if N_LAUNCH_MODE == 1
    a.ph_lo = 0; a.ph_hi = N_PHASES; a.use_bar = 1;
    hipLaunchKernelGGL(trunk_fwd, dim3(grid), dim3(NTHREADS), LDS_BYTES, stream, a);
#else
    a.use_bar = 0;
#if DBG_CHECK
    unsigned char* wsb = (unsigned char*)d_ws; unsigned* dbg = (unsigned*)(wsb + WS_DBG);
    hipMemsetAsync(dbg, 0xFF, 4, stream); hipMemsetAsync(dbg + 1, 0, 1024, stream);
    const float* const* in = (const float* const*)a.in; float* outp = (float*)d_out; float* oldp = (float*)(wsb + WS_DBG_OLD);
    bf16* hbuf = (bf16*)(wsb + WS_H); bf16* catb = (bf16*)(wsb + WS_CAT); bf16* projb = (bf16*)(wsb + WS_PROJ); bf16* ffhb = (bf16*)(wsb + WS_FFH);
#endif
    for (int p = 0; p < N_PHASES; ++p) {
        int layer = 0; const int q = phase_kind(p, layer); const int li = layer >> 1; const bool odd = layer & 1; (void)li; (void)odd; (void)q;
#if DBG_CHECK
        const float* modl = (const float*)(wsb + WS_MOD) + (size_t)layer * 2 * 6 * DM; const float* xcur = layer == 0 ? in[0] : outp;
        if (q == K_MIXOUT) hipMemcpyAsync(oldp, xcur, (size_t)M * DM * 4, hipMemcpyDeviceToDevice, stream);
        if (q == K_FFOUT) hipMemcpyAsync(oldp, outp, (size_t)M * DM * 4, hipMemcpyDeviceToDevice, stream);
#endif
        a.ph_lo = p; a.ph_hi = p + 1;
        hipLaunchKernelGGL(trunk_fwd, dim3(grid), dim3(NTHREADS), LDS_BYTES, stream, a);
#if DBG_CHECK
        const unsigned code = 1 + p;
        if (q == K_PRO) dbg_mod<<<16, 256, 0, stream>>>(dbg, code, in[1], in[2], in[3], (const float*)(wsb + WS_MOD));
        if (q == K_NORM1) { dbg_norm<<<16, 256, 0, stream>>>(dbg, code, xcur, in[4] + (size_t)layer * DM, modl, modl + DM, hbuf);
            if (!odd) dbg_small<<<16, 256, 0, stream>>>(dbg, code | 0x100, 1, hbuf, in[6] + (size_t)li * DM * AB_IN + AB_N, AB_IN, in[12] + li * 8, (const float*)(wsb + WS_LOGF));
            else dbg_small<<<16, 256, 0, stream>>>(dbg, code | 0x100, 2, hbuf, in[13] + (size_t)li * DM * C_IN + C_N, C_IN, nullptr, (const float*)(wsb + WS_GLOW)); }
        if (q == K_MIXIN) { if (!odd) dbg_gemm<<<16, 256, 0, stream>>>(dbg, code, 0, hbuf, DM, in[6] + (size_t)li * DM * AB_IN, AB_IN, AB_N, projb, AB_N, nullptr, nullptr, nullptr);
            else dbg_gemm<<<16, 256, 0, stream>>>(dbg, code, 0, hbuf, DM, in[13] + (size_t)li * DM * C_IN, C_IN, C_N, projb, C_N, nullptr, nullptr, nullptr); }
#if DBG_REC
        if (q == K_REC) dbg_cmpbuf<<<256, 256, 0, stream>>>(dbg, code, (const float*)(wsb + WS_O), (const float*)(wsb + 1200 * MiB), odd ? (size_t)M * 2048 : (size_t)M * 1024);
#endif
        if (q == K_MIXOUT) dbg_gemm<<<16, 256, 0, stream>>>(dbg, code, 2, catb, DM, (odd ? in[17] : in[7]) + (size_t)li * DM * DM, DM, DM, outp, DM, oldp, modl + 2 * DM, modl + 6 * DM + 2 * DM);
        if (q == K_NORM2) dbg_norm<<<16, 256, 0, stream>>>(dbg, code, outp, in[5] + (size_t)layer * DM, modl + 3 * DM, modl + 4 * DM, hbuf);
        if (q == K_FFIN) dbg_gemm<<<16, 256, 0, stream>>>(dbg, code, 1, hbuf, DM, in[18] + (size_t)layer * DM * FF2, FF2, FF, ffhb, FF, nullptr, nullptr, nullptr);
        if (q == K_FFOUT) dbg_gemm<<<16, 256, 0, stream>>>(dbg, code, 2, ffhb, FF, in[19] + (size_t)layer * FF * DM, DM, DM, outp, DM, oldp, modl + 5 * DM, modl + 6 * DM + 5 * DM);
#endif
    }
#if DBG_CHECK
    dbg_report<<<1, 64, 0, stream>>>(dbg, outp);
#endif
#endif
}
```

```cpp
#include <hip/hip_runtime.h>
#include <hip/hip_bf16.h>
#include <cstdio>
#include <cstdint>
__device__ __forceinline__ int opq_tid(int wave_s) {
    int t; asm volatile("v_mbcnt_lo_u32_b32 %0, -1, 0\n\tv_mbcnt_hi_u32_b32 %0, -1, %0\n\tv_lshl_add_u32 %0, %1, 6, %0" : "=&v"(t) : "s"(wave_s)); return t; }
__device__ __forceinline__ int opq_bid() { int t = blockIdx.x; asm volatile("" : "+s"(t)); return t; }
template <int MASK> __device__ __forceinline__ float xsum(float v) {
    if constexpr (MASK < 32) { return v + __builtin_bit_cast(float, __builtin_amdgcn_ds_swizzle(__builtin_bit_cast(int, v), (MASK << 10) | 0x1f)); }
    else { auto rr = __builtin_amdgcn_permlane32_swap(__float_as_uint(v), __float_as_uint(v), false, false);
           const unsigned r0 = rr[0], r1 = rr[1];
           return __uint_as_float(r0) + __uint_as_float(r1); }
}
__device__ __forceinline__ float xor1_get(float v) { return __builtin_bit_cast(float, __builtin_amdgcn_ds_swizzle(__builtin_bit_cast(int, v), (1 << 10) | 0x1f)); }
namespace pg8 {
#define PG8_LAS __attribute__((address_space(3)))
typedef unsigned short bf16_t;
typedef short bf16x8 __attribute__((ext_vector_type(8)));
typedef float f32x4 __attribute__((ext_vector_type(4)));
typedef unsigned u32x4 __attribute__((ext_vector_type(4)));
constexpr int BM = 256, BK = 64, HALF = 128, HTB = HALF * BK * 2  , STAGE_BYTES = 8 * HTB, NXCD = 8, WGM = 8;

__host__ __device__ __forceinline__ int lds_byte(int r, int c) { const int st = (r >> 4) * 2 + (c >> 5), rr = r & 15, cc = c & 31, ob = rr * 64 + cc * 2; return st * 1024 + (ob ^ (((ob >> 9) & 1) << 5)); }
__host__ __device__ __forceinline__ void stage_rc(int b, int& R, int& C) { const int st = b / 1024, sb = b % 1024, swz = sb ^ (((sb >> 9) & 1) << 5); R = (st >> 1) * 16 + swz / 64; C = (st & 1) * 32 + (swz % 64) / 2; }
__host__ __device__ __forceinline__ int perm32(int rho) { const int n = rho >> 4, i = rho & 15; return 8 * (i >> 2) + 4 * n + (i & 3); }

struct Unit { int pm, pn; };
struct Gemm { const bf16_t* A; const bf16_t* Bt; int M, N, K; };

struct StaticOrder {
    int nM, nN, nwg, G, c;
    __host__ __device__ void init(int M, int N, int G_, int c_) { nM = M / BM; nN = N / BM; nwg = nM * nN; G = G_; c = c_; }
    __host__ __device__ bool next(int i, Unit& u) const {
        const long L = (long)i * G + c; if (L >= nwg) return false;
        int wgid = (int)L; { const int q = nwg / NXCD, r = nwg % NXCD, xcd = wgid % NXCD, off = wgid / NXCD; wgid = (xcd < r ? xcd * (q + 1) : r * (q + 1) + (xcd - r) * q) + off; }
        const int nig = WGM * nN, gid = wgid / nig, fm = gid * WGM, gsz = (nM - fm) < WGM ? (nM - fm) : WGM;
        u.pm = fm + ((wgid % nig) % gsz); u.pn = (wgid % nig) / gsz; return true;
    }
    __device__ __forceinline__ void a_ready(const Unit&) const {}
    __device__ __forceinline__ void done(const Unit&) const {}
};

__device__ __forceinline__ unsigned cvt_pk_bf16(float lo, float hi) { unsigned r; asm volatile("v_cvt_pk_bf16_f32 %0, %1, %2" : "=v"(r) : "v"(lo), "v"(hi)); return r; }
typedef float f32x2 __attribute__((ext_vector_type(2)));

struct EpiBf16 {
    static constexpr bool PERM = true, AFTER_DRAIN = false;
    bf16_t* O; int ldc;
    __device__ __forceinline__ void operator()(const f32x4 (&acc)[2][2][4][2], const Unit& u, int wr, int wc, int fr, int fq) const {
        const int row0 = u.pm * BM + wr * 64 + fr; const int col0 = u.pn * BM + wc * 32 + 8 * fq;
#pragma unroll
        for (int ai = 0; ai < 2; ++ai)
#pragma unroll
            for (int m = 0; m < 4; ++m) { bf16_t* rowp = O + (size_t)(row0 + ai * HALF + m * 16) * ldc + col0;
#pragma unroll
                for (int bj = 0; bj < 2; ++bj) { const f32x4 v0 = acc[ai][bj][m][0], v1 = acc[ai][bj][m][1];
                    u32x4 w; w.x = cvt_pk_bf16(v0[0], v0[1]); w.y = cvt_pk_bf16(v0[2], v0[3]); w.z = cvt_pk_bf16(v1[0], v1[1]); w.w = cvt_pk_bf16(v1[2], v1[3]);
                    *(u32x4*)(rowp + bj * HALF) = w; } }
    }
};
__device__ __forceinline__ float silu_f(float a) { return a * __builtin_amdgcn_rcpf(1.0f + __builtin_amdgcn_exp2f(-1.4426950408889634f * a)); }
struct EpiSwiglu {
    static constexpr bool PERM = true, AFTER_DRAIN = false;
    bf16_t* O; int ldc;
    __device__ __forceinline__ void operator()(const f32x4 (&acc)[2][2][4][2], const Unit& u, int wr, int wc, int fr, int fq) const {
        const int row0 = u.pm * BM + wr * 64 + fr; const int col0 = u.pn * HALF + wc * 32 + 8 * fq;
#pragma unroll
        for (int ai = 0; ai < 2; ++ai)
#pragma unroll
            for (int m = 0; m < 4; ++m) { bf16_t* rowp = O + (size_t)(row0 + ai * HALF + m * 16) * ldc + col0;
                const f32x4 a0 = acc[ai][0][m][0], a1 = acc[ai][0][m][1], u0 = acc[ai][1][m][0], u1 = acc[ai][1][m][1];
                u32x4 w;
                w.x = cvt_pk_bf16(silu_f(a0[0]) * u0[0], silu_f(a0[1]) * u0[1]); w.y = cvt_pk_bf16(silu_f(a0[2]) * u0[2], silu_f(a0[3]) * u0[3]);
                w.z = cvt_pk_bf16(silu_f(a1[0]) * u1[0], silu_f(a1[1]) * u1[1]); w.w = cvt_pk_bf16(silu_f(a1[2]) * u1[2], silu_f(a1[3]) * u1[3]);
                *(u32x4*)rowp = w; }
    }
};
struct EpiResid {
    static constexpr bool PERM = false, AFTER_DRAIN = false;
    const float* base; float* out; int ldc; const float* gate0; const float* gate1; int pm_split;
    __device__ __forceinline__ void operator()(const f32x4 (&acc)[2][2][4][2], const Unit& u, int wr, int wc, int fr, int fq) const {
        const int col0 = u.pn * BM + wc * 32 + 4 * fq; const float* g = (u.pm >= pm_split) ? gate1 : gate0;
        f32x4 gv[2][2];
#pragma unroll
        for (int bj = 0; bj < 2; ++bj)
#pragma unroll
            for (int n = 0; n < 2; ++n) gv[bj][n] = *(const f32x4*)(g + col0 + bj * HALF + n * 16);
#pragma unroll
        for (int ai = 0; ai < 2; ++ai) { f32x4 bs[4][2][2];
#pragma unroll
            for (int m = 0; m < 4; ++m) { const size_t off = (size_t)(u.pm * BM + ai * HALF + wr * 64 + m * 16 + fr) * ldc + col0;
#pragma unroll
                for (int bj = 0; bj < 2; ++bj)
#pragma unroll
                    for (int n = 0; n < 2; ++n) bs[m][bj][n] = *(const f32x4*)(base + off + bj * HALF + n * 16); }
#pragma unroll
            for (int m = 0; m < 4; ++m) { const size_t off = (size_t)(u.pm * BM + ai * HALF + wr * 64 + m * 16 + fr) * ldc + col0;
#pragma unroll
                for (int bj = 0; bj < 2; ++bj)
#pragma unroll
                    for (int n = 0; n < 2; ++n) *(f32x4*)(out + off + bj * HALF + n * 16) = bs[m][bj][n] + gv[bj][n] * acc[ai][bj][m][n]; }
            asm volatile("" ::: "memory"); }
    }
};

template <class Epi, class Sched, bool ALIGN_EPI = false, bool SP2 = false>
__device__ __forceinline__ void gemm_phase(PG8_LAS unsigned char* lds, const Gemm g, const Sched& S, const Epi& E, const int tid) {
    const int wid = __builtin_amdgcn_readfirstlane(tid >> 6), lane = tid & 63, wr = wid >> 2, wc = wid & 3, fr = lane & 15, fq = lane >> 4;
    const int K = g.K, nt = K / BK;
    unsigned voffA[2], voffB[2];
#pragma unroll
    for (int i = 0; i < 2; ++i) { int R, C; stage_rc(tid * 16 + i * 8192, R, C); const int Rb = Epi::PERM ? ((R & ~31) + perm32(R & 31)) : R;
        voffA[i] = (unsigned)(R * K + C) * 2u; voffB[i] = (unsigned)(Rb * K + C) * 2u; }
    const size_t kstep = (size_t)(BK * 2);
    const size_t hstep = (size_t)HALF * K * 2;
    const size_t tstep = 2 * hstep;
    const unsigned ldsw = (unsigned)wid * 1024u;
    const int aoff = lds_byte(wr * 64 + fr, fq * 8), boff = lds_byte(wc * 32 + fr, fq * 8);
#define PG8_SA(b, h) (((b) * 2 + (h)) * HTB)
#define PG8_SB(b, h) ((4 + (b) * 2 + (h)) * HTB)
#define PG8_STAGE(bufoff, gbase, voff) do { _Pragma("unroll") for (int _i = 0; _i < 2; ++_i) \
        __builtin_amdgcn_global_load_lds((const unsigned*)((const char*)(gbase) + (voff)[_i]), (PG8_LAS unsigned*)(lds + (bufoff) + ldsw + _i * 8192), 16, 0, 0); } while (0)
#define PG8_LDA(dst, b, h) do { _Pragma("unroll") for (int m = 0; m < 4; ++m) _Pragma("unroll") for (int k = 0; k < 2; ++k) dst[m][k] = *(const PG8_LAS bf16x8*)(lds + PG8_SA(b, h) + aoff + m * 2048 + k * 1024); } while (0)
#define PG8_LDB(dst, b, h) do { _Pragma("unroll") for (int n = 0; n < 2; ++n) _Pragma("unroll") for (int k = 0; k < 2; ++k) dst[n][k] = *(const PG8_LAS bf16x8*)(lds + PG8_SB(b, h) + boff + n * 2048 + k * 1024); } while (0)
#define PG8_MMA(ai, bj, At, Bt) do { __builtin_amdgcn_s_setprio(1); _Pragma("unroll") for (int m = 0; m < 4; ++m) _Pragma("unroll") for (int n = 0; n < 2; ++n) _Pragma("unroll") for (int k = 0; k < 2; ++k) \
        acc[ai][bj][m][n] = __builtin_amdgcn_mfma_f32_16x16x32_bf16(Bt[n][k], At[m][k], acc[ai][bj][m][n], 0, 0, 0); __builtin_amdgcn_s_setprio(0); } while (0)
#define PG8_WAIT_V(n) asm volatile("s_waitcnt vmcnt(" #n ")" ::: "memory")
#define PG8_WAIT_L(n) asm volatile("s_waitcnt lgkmcnt(" #n ")" ::: "memory")
#define PG8_BAR __builtin_amdgcn_s_barrier()
#define PG8_SCHED __builtin_amdgcn_sched_barrier(0)
    Unit cur, nxt; int ui = 0;
    if (!S.next(0, cur)) return;
    f32x4 acc[2][2][4][2];
#pragma unroll
    for (int a = 0; a < 2; ++a)
#pragma unroll
        for (int b = 0; b < 2; ++b)
#pragma unroll
            for (int m = 0; m < 4; ++m)
#pragma unroll
                for (int n = 0; n < 2; ++n) acc[a][b][m][n] = (f32x4){0.f, 0.f, 0.f, 0.f};
    bf16x8 At[4][2], B0[2][2], B1[2][2];
    const char* cA = (const char*)g.A + (size_t)cur.pm * tstep; const char* cB = (const char*)g.Bt + (size_t)cur.pn * tstep;
    S.a_ready(cur);
    if constexpr (SP2) {
        PG8_STAGE(PG8_SB(0, 0), cB, voffB); PG8_STAGE(PG8_SB(0, 1), cB + hstep, voffB); PG8_STAGE(PG8_SA(0, 0), cA, voffA); PG8_STAGE(PG8_SA(0, 1), cA + hstep, voffA);
        if (wr == 1) PG8_BAR;
        PG8_WAIT_V(2); PG8_BAR;
        PG8_STAGE(PG8_SB(1, 0), cB + kstep, voffB); PG8_STAGE(PG8_SA(1, 0), cA + kstep, voffA); PG8_STAGE(PG8_SB(1, 1), cB + hstep + kstep, voffB);
        PG8_WAIT_V(6); PG8_BAR;
    } else {
        PG8_STAGE(PG8_SB(0, 0), cB, voffB); PG8_STAGE(PG8_SA(0, 0), cA, voffA); PG8_STAGE(PG8_SB(0, 1), cB + hstep, voffB); PG8_STAGE(PG8_SA(0, 1), cA + hstep, voffA);
        if (wr == 1) PG8_BAR;
        PG8_WAIT_V(4); PG8_BAR;
        PG8_STAGE(PG8_SB(1, 0), cB + kstep, voffB); PG8_STAGE(PG8_SA(1, 0), cA + kstep, voffA); PG8_STAGE(PG8_SB(1, 1), cB + hstep + kstep, voffB);
        PG8_WAIT_V(6); PG8_BAR;
    }
    for (;;) {
        const bool has_next = S.next(ui + 1, nxt);
        const char* nA = has_next ? (const char*)g.A + (size_t)nxt.pm * tstep : cA; const char* nB = has_next ? (const char*)g.Bt + (size_t)nxt.pn * tstep : cB;
        for (int t = 0; t < nt; t += 2) {
            const bool last = (t == nt - 2);
            const char* a1 = cA + (size_t)(t + 1) * kstep;
            const char* a2 = last ? nA : cA + (size_t)(t + 2) * kstep; const char* b2 = last ? nB : cB + (size_t)(t + 2) * kstep;
            const char* a3 = a2 + kstep; const char* b3 = b2 + kstep;
            if (last && has_next) S.a_ready(nxt);
            if constexpr (SP2) {
            PG8_LDB(B0, 0, 0); PG8_LDB(B1, 0, 1); PG8_SCHED; PG8_LDA(At, 0, 0); PG8_STAGE(PG8_SA(1, 1), a1 + hstep, voffA);
            PG8_WAIT_V(8); PG8_WAIT_L(0); PG8_BAR; PG8_MMA(0, 0, At, B0); PG8_MMA(0, 1, At, B1); PG8_BAR; PG8_SCHED;
            PG8_LDA(At, 0, 1); PG8_STAGE(PG8_SB(0, 0), b2, voffB); PG8_STAGE(PG8_SB(0, 1), b2 + hstep, voffB); PG8_STAGE(PG8_SA(0, 0), a2, voffA);
            PG8_WAIT_V(8); PG8_WAIT_L(0); PG8_BAR; PG8_MMA(1, 0, At, B0); PG8_MMA(1, 1, At, B1); PG8_BAR; PG8_SCHED;
            PG8_LDB(B0, 1, 0); PG8_LDB(B1, 1, 1); PG8_SCHED; PG8_LDA(At, 1, 0); PG8_STAGE(PG8_SA(0, 1), a2 + hstep, voffA);
            PG8_WAIT_V(8); PG8_WAIT_L(0); PG8_BAR; PG8_MMA(0, 0, At, B0); PG8_MMA(0, 1, At, B1); PG8_BAR; PG8_SCHED;
            PG8_LDA(At, 1, 1); PG8_STAGE(PG8_SB(1, 0), b3, voffB); PG8_STAGE(PG8_SB(1, 1), b3 + hstep, voffB); PG8_STAGE(PG8_SA(1, 0), a3, voffA);
            PG8_WAIT_V(8); PG8_WAIT_L(0); PG8_BAR; PG8_MMA(1, 0, At, B0); PG8_MMA(1, 1, At, B1); PG8_BAR; PG8_SCHED;
            } else {
            PG8_LDB(B0, 0, 0); PG8_SCHED; PG8_LDA(At, 0, 0); PG8_STAGE(PG8_SA(1, 1), a1 + hstep, voffA);
            PG8_WAIT_L(8); PG8_BAR; PG8_WAIT_L(0); PG8_MMA(0, 0, At, B0); PG8_BAR; PG8_SCHED;
            PG8_LDB(B1, 0, 1); PG8_STAGE(PG8_SB(0, 0), b2, voffB);
            PG8_BAR; PG8_WAIT_L(0); PG8_MMA(0, 1, At, B1); PG8_BAR;
            PG8_LDA(At, 0, 1); PG8_STAGE(PG8_SA(0, 0), a2, voffA);
            PG8_BAR; PG8_WAIT_L(0); PG8_MMA(1, 0, At, B0); PG8_BAR; PG8_SCHED;
            PG8_STAGE(PG8_SB(0, 1), b2 + hstep, voffB);
            PG8_WAIT_V(6); PG8_BAR; PG8_MMA(1, 1, At, B1); PG8_BAR;
            PG8_LDB(B0, 1, 0); PG8_SCHED; PG8_LDA(At, 1, 0); PG8_STAGE(PG8_SA(0, 1), a2 + hstep, voffA);
            PG8_WAIT_L(8); PG8_BAR; PG8_WAIT_L(0); PG8_MMA(0, 0, At, B0); PG8_BAR; PG8_SCHED;
            PG8_LDB(B1, 1, 1); PG8_STAGE(PG8_SB(1, 0), b3, voffB);
            PG8_BAR; PG8_WAIT_L(0); PG8_MMA(0, 1, At, B1); PG8_BAR;
            PG8_LDA(At, 1, 1); PG8_STAGE(PG8_SA(1, 0), a3, voffA);
            PG8_BAR; PG8_WAIT_L(0); PG8_MMA(1, 0, At, B0); PG8_BAR; PG8_SCHED;
            PG8_STAGE(PG8_SB(1, 1), b3 + hstep, voffB);
            PG8_WAIT_V(6); PG8_BAR; PG8_MMA(1, 1, At, B1); PG8_BAR;
            }
        }
        if constexpr (ALIGN_EPI) { if (wr == 0) PG8_BAR; }
        if constexpr (!Epi::AFTER_DRAIN) { E(acc, cur, wr, wc, fr, fq); S.done(cur); }
        if (!has_next) break;
#pragma unroll
        for (int a = 0; a < 2; ++a)
#pragma unroll
            for (int b = 0; b < 2; ++b)
#pragma unroll
                for (int m = 0; m < 4; ++m)
#pragma unroll
                    for (int n = 0; n < 2; ++n) acc[a][b][m][n] = (f32x4){0.f, 0.f, 0.f, 0.f};
        cur = nxt; cA = nA; cB = nB; ++ui;
        if constexpr (ALIGN_EPI) { if (wr == 1) PG8_BAR; }
    }
    PG8_WAIT_V(0);
    if constexpr (!ALIGN_EPI) { if (wr == 0) PG8_BAR; }
    PG8_BAR;
    if constexpr (Epi::AFTER_DRAIN) { E.fused(acc, cur, wr, wc, fr, fq, lds, wid, lane); S.done(cur); }
#undef PG8_SA
#undef PG8_SB
#undef PG8_STAGE
#undef PG8_LDA
#undef PG8_LDB
#undef PG8_MMA
#undef PG8_WAIT_V
#undef PG8_WAIT_L
#undef PG8_BAR
#undef PG8_SCHED
}
}
namespace fox {
constexpr int D = 128, PITCH = 8192, OPITCH = 2048, SKV = 8192, GATE_OFF = 3072;
constexpr float THR = 8.f;
constexpr float SCALE = 0.08838834764831845f;
constexpr int NW = 8, QBLK = 32, KVBLK = 64, QB = NW * QBLK;
constexpr int SHM_V = KVBLK * D * 2, SHM_K = KVBLK * D * 2;
constexpr int BIAS_OFF = 2 * SHM_V + 2 * SHM_K + NW * 64 * 4;
constexpr int LDS_BYTES = BIAS_OFF + SKV * 4;

using bf16 = __hip_bfloat16;
typedef short bf16x8 __attribute__((ext_vector_type(8)));
typedef short s16x4 __attribute__((ext_vector_type(4)));
typedef float f32x16 __attribute__((ext_vector_type(16)));
typedef float f32x4 __attribute__((ext_vector_type(4)));
typedef unsigned u32x4 __attribute__((ext_vector_type(4)));

#define KSWZ(row, colB) ((row) * 256 + ((colB) ^ (((row) & 7) << 4)))
#define SBAR() __builtin_amdgcn_sched_barrier(0)
__device__ __forceinline__ int v_st(int k, int c) { const int kk = (k & ~0xC) | ((k & 4) << 1) | ((k & 8) >> 1); return ((kk >> 3) * 4 + (c >> 5)) * 512 + ((kk & 7) * 32 + (c & 31)) * 2; }
__device__ __forceinline__ int v_rd_base(int lane) { return ((lane & 3) << 3) | (((lane >> 2) & 3) << 6) | (((lane >> 4) & 1) << 5) | (((lane >> 5) & 1) << 8); }
constexpr int v_rd_off(int d0, int ks, int half) { return d0 * 512 + ks * 4096 + half * 2048; }
__device__ __forceinline__ int crow(int r, int hi) { return (r & 3) + 8 * (r >> 2) + 4 * hi; }
__device__ __forceinline__ unsigned cvtpk(float lo, float hi) {
    unsigned r; asm volatile("v_cvt_pk_bf16_f32 %0, %1, %2" : "=v"(r) : "v"(lo), "v"(hi)); return r;
}
__device__ __forceinline__ bf16x8 load8(const bf16* p) { return *reinterpret_cast<const bf16x8*>(p); }
__device__ __forceinline__ void mask_tile(f32x16& p0, f32x16& p1, int dq, unsigned W) {
    const float NEG = -__builtin_inff();
#pragma unroll
    for (int r = 0; r < 16; ++r) {
        const int c = (r & 3) + 8 * (r >> 2);
        if ((unsigned)(dq - c) >= W) p0[r] = NEG;
        if ((unsigned)(dq - c - 32) >= W) p1[r] = NEG;
    }
}
__device__ __forceinline__ void partialSM(f32x16& p0, f32x16& p1, float& m_reg, float& mn, float& alpha) {
    float pmax = p0[0]; for (int r = 1; r < 16; ++r) pmax = fmaxf(pmax, p0[r]); for (int r = 0; r < 16; ++r) pmax = fmaxf(pmax, p1[r]);
    { auto rr = __builtin_amdgcn_permlane32_swap(__float_as_uint(pmax), __float_as_uint(pmax), false, false);
      pmax = fmaxf(__uint_as_float(rr[0]), __uint_as_float(rr[1])); }
    constexpr float C2 = 1.4426950408889634f * SCALE;
    if (__builtin_expect(__all((pmax - m_reg) * SCALE <= THR), 1)) { mn = m_reg; alpha = 1.f; }
    else { mn = fmaxf(m_reg, pmax); alpha = __builtin_amdgcn_exp2f((m_reg - mn) * C2); m_reg = mn; }
    const float mnL = -mn * C2;
    for (int r = 0; r < 16; ++r) p0[r] = fmaf(p0[r], C2, mnL); for (int r = 0; r < 16; ++r) p1[r] = fmaf(p1[r], C2, mnL);
    for (int r = 0; r < 16; ++r) p0[r] = __builtin_amdgcn_exp2f(p0[r]);
}
__device__ __forceinline__ void finishSM(f32x16& p0, f32x16& p1, float alpha, float& l_reg, bf16x8& pa0, bf16x8& pa1, bf16x8& pa2, bf16x8& pa3) {
    for (int r = 0; r < 16; ++r) p1[r] = __builtin_amdgcn_exp2f(p1[r]);
    float ps = 0; for (int r = 0; r < 16; ++r) ps += p0[r]; for (int r = 0; r < 16; ++r) ps += p1[r];
    { auto rr = __builtin_amdgcn_permlane32_swap(__float_as_uint(ps), __float_as_uint(ps), false, false);
      ps = __uint_as_float(rr[0]) + __uint_as_float(rr[1]); }
    l_reg = l_reg * alpha + ps;
#define PK4(P, B_, OUT) do { unsigned a0 = cvtpk(P[B_+0], P[B_+1]), a1 = cvtpk(P[B_+2], P[B_+3]);                          \
        unsigned b0 = cvtpk(P[B_+4], P[B_+5]), b1 = cvtpk(P[B_+6], P[B_+7]);                                             \
        auto r0 = __builtin_amdgcn_permlane32_swap(a0, b0, false, false); auto r1 = __builtin_amdgcn_permlane32_swap(a1, b1, false, false); \
        u32x4 w = {r0[0], r1[0], r0[1], r1[1]}; OUT = *reinterpret_cast<bf16x8*>(&w); } while (0)
    PK4(p0, 0, pa0); PK4(p0, 8, pa1); PK4(p1, 0, pa2); PK4(p1, 8, pa3);
#undef PK4
}
template <int KB>
__device__ __forceinline__ void qkt(f32x16& p0, f32x16& p1, const char* K_lds, const float* bt, int r32, int hi, const bf16x8* qr) {
#pragma unroll
    for (int j = 0; j < 4; ++j) { const f32x4 a = *(const f32x4*)(bt + 8 * j), b = *(const f32x4*)(bt + 32 + 8 * j);
        p0[4 * j + 0] = a[0]; p0[4 * j + 1] = a[1]; p0[4 * j + 2] = a[2]; p0[4 * j + 3] = a[3];
        p1[4 * j + 0] = b[0]; p1[4 * j + 1] = b[1]; p1[4 * j + 2] = b[2]; p1[4 * j + 3] = b[3]; }
    const char* kb[4];
#pragma unroll
    for (int dd = 0; dd < 4; ++dd) kb[dd] = K_lds + KB * SHM_K + KSWZ(r32, (dd * 16 + hi * 8) * 2);
#pragma unroll
    for (int d0 = 0; d0 < 8; ++d0) { const char* a = kb[d0 & 3] + (d0 >> 2) * 128;
        bf16x8 b0 = *reinterpret_cast<const bf16x8*>(a);
        bf16x8 b1 = *reinterpret_cast<const bf16x8*>(a + 32 * 256);
        p0 = __builtin_amdgcn_mfma_f32_32x32x16_bf16(b0, qr[d0], p0, 0, 0, 0);
        p1 = __builtin_amdgcn_mfma_f32_32x32x16_bf16(b1, qr[d0], p1, 0, 0, 0); }
}
template <int VB>
__device__ __forceinline__ void pv_tile(f32x16* o, int vb0, bf16x8 pa0, bf16x8 pa1, bf16x8 pa2, bf16x8 pa3) {
#define TRRD(dst, off) asm volatile("ds_read_b64_tr_b16 %0, %1 offset:%2" : "=&v"(dst) : "v"(vb0), "i"(off) : "memory")
#define PV_D0(d0) do { s16x4 l0, l1, l2, l3, h0, h1, h2, h3; constexpr int b_ = VB * SHM_V + v_rd_off(d0, 0, 0);     \
        TRRD(l0, b_); TRRD(h0, b_ + 2048); TRRD(l1, b_ + 4096); TRRD(h1, b_ + 6144); TRRD(l2, b_ + 8192); TRRD(h2, b_ + 10240); TRRD(l3, b_ + 12288); TRRD(h3, b_ + 14336); \
        asm volatile("s_waitcnt lgkmcnt(0)" ::: "memory"); SBAR();                 \
        o[d0] = __builtin_amdgcn_mfma_f32_32x32x16_bf16(pa0, (bf16x8){l0[0], l0[1], l0[2], l0[3], h0[0], h0[1], h0[2], h0[3]}, o[d0], 0, 0, 0);   \
        o[d0] = __builtin_amdgcn_mfma_f32_32x32x16_bf16(pa1, (bf16x8){l1[0], l1[1], l1[2], l1[3], h1[0], h1[1], h1[2], h1[3]}, o[d0], 0, 0, 0);   \
        o[d0] = __builtin_amdgcn_mfma_f32_32x32x16_bf16(pa2, (bf16x8){l2[0], l2[1], l2[2], l2[3], h2[0], h2[1], h2[2], h2[3]}, o[d0], 0, 0, 0);   \
        o[d0] = __builtin_amdgcn_mfma_f32_32x32x16_bf16(pa3, (bf16x8){l3[0], l3[1], l3[2], l3[3], h3[0], h3[1], h3[2], h3[3]}, o[d0], 0, 0, 0); } while (0)
    PV_D0(0); PV_D0(1); PV_D0(2); PV_D0(3);
#undef PV_D0
#undef TRRD
}

struct BlockRef { const bf16* Q; const bf16* K; const bf16* V; bf16* O; const float* Bias; int P0; float THp; };
struct Seam { bf16x8 qr[8]; bf16x8 st_v0, st_v1, st_k0, st_k1; };
#define ROW(p, k0, rr) ((const bf16*)((const char*)(p) + (size_t)(k0) * (PITCH * 2) + (unsigned)(voff + (unsigned)(rr) * (PITCH * 2u))))
#define VMW() asm volatile("s_waitcnt vmcnt(0)" ::: "memory")
#define VMWN(n) asm volatile("s_waitcnt vmcnt(%0)" :: "i"(n) : "memory")
#define SLOAD_H(Kp, Vp, k0) do { S.st_v0 = load8(ROW(Vp, k0, 0)); S.st_v1 = load8(ROW(Vp, k0, 32));              \
                         S.st_k0 = load8(ROW(Kp, k0, 0)); S.st_k1 = load8(ROW(Kp, k0, 32)); } while (0)
#define SWRITE_HK(bf) do { *(bf16x8*)(K_lds + (bf) * SHM_K + kws) = S.st_k0; *(bf16x8*)(K_lds + (bf) * SHM_K + kws + 32 * 256) = S.st_k1; } while (0)
#define SWRITE_HV(bf) do { *(bf16x8*)(V_lds + (bf) * SHM_V + vst0) = S.st_v0; *(bf16x8*)(V_lds + (bf) * SHM_V + vst1) = S.st_v1; } while (0)
#define SWRITE_H(bf) do { SWRITE_HV(bf); SWRITE_HK(bf); } while (0)
__device__ __forceinline__ void fox_prime(const BlockRef& cur, char* lds, Seam& S, const int tid) {
    const int wid = __builtin_amdgcn_readfirstlane(tid >> 6), lane = tid & 63, r32 = lane & 31, hi = lane >> 5;
    const int sr = tid >> 4, sc = (tid & 15) * 8, kws = KSWZ(sr, sc * 2); char* K_lds = lds + 2 * SHM_V;
    const unsigned voff = (unsigned)(sr * PITCH + sc) * 2u, qoff = (unsigned)((wid * QBLK + r32) * PITCH + hi * 8) * 2u;
    for (int d0 = 0; d0 < 8; ++d0) S.qr[d0] = load8((const bf16*)((const char*)cur.Q + (qoff + d0 * 32)));
    (void)kws; (void)K_lds; (void)voff;
    __syncthreads();
}
__device__ __forceinline__ void fox_block(const BlockRef& cur, const BlockRef& nxt, char* lds, Seam& S, const int tid) {
    const int wid = __builtin_amdgcn_readfirstlane(tid >> 6), lane = tid & 63, r32 = lane & 31, hi = lane >> 5;
    const int W = SKV;
    const int NTF = (cur.P0 + QB - 1) / KVBLK + 1;
    const int qlo = cur.P0 + wid * QBLK, qm = qlo + r32 - 4 * hi;
    char* V_lds = lds; char* K_lds = lds + 2 * SHM_V;
    float* ws = (float*)(lds + 2 * SHM_V + 2 * SHM_K) + wid * 64; float* li_l = ws, * al_l = ws + 32;
    float* biasL = (float*)(lds + BIAS_OFF);
    { const int nk = cur.P0 + QB;
      int t4 = tid * 4; asm volatile("" : "+v"(t4));
      f32x4 bv[4];
#pragma unroll
      for (int k = 0; k < 4; ++k) { const int i = t4 + k * (NW * 64 * 4); if (i < nk) bv[k] = *(const f32x4*)((const char*)cur.Bias + (unsigned)(i * 4)); }
#pragma unroll
      for (int k = 0; k < 4; ++k) { const int i = t4 + k * (NW * 64 * 4); if (i < nk) *(f32x4*)(biasL + i) = bv[k]; }
      __syncthreads(); }
    int j_lo; { int lo_ = 0, hi_ = cur.P0 / KVBLK; const float bref = biasL[cur.P0] - cur.THp;
        while (lo_ < hi_) { const int mid = (lo_ + hi_) >> 1; if (biasL[mid * KVBLK + KVBLK - 1] < bref) lo_ = mid + 1; else hi_ = mid; }
        j_lo = __builtin_amdgcn_readfirstlane(lo_); }
    const int NT = NTF - j_lo;
    const float* bl = biasL + 4 * hi;
    float m_reg = -1e30f, l_reg = 0; f32x16 o[4] = {};
    const int sr = tid >> 4, sc = (tid & 15) * 8, vst0 = v_st(sr, sc), vst1 = v_st(32 + sr, sc), kws = KSWZ(sr, sc * 2);
    const unsigned voff = (unsigned)(sr * PITCH + sc) * 2u, qoff = (unsigned)((wid * QBLK + r32) * PITCH + hi * 8) * 2u;
    const int vb0 = (int)(uintptr_t)V_lds + v_rd_base(lane);
    const bf16* Kh = cur.K; const bf16* Vh = cur.V;
#define RESC(a) do { if (__any((a) < 1.f)) { if (hi == 0) al_l[r32] = (a); asm volatile("s_waitcnt lgkmcnt(0)" ::: "memory");              \
                     for (int d_ = 0; d_ < 4; ++d_) for (int r = 0; r < 16; ++r) o[d_][r] *= al_l[crow(r, hi)]; } } while (0)
#define KBASE(t) ((j_lo + (NT - 1 - (t))) * KVBLK)
#define MASKT(P0_, P1_, t) do { const int kb_ = KBASE(t); if (kb_ + KVBLK - 1 > qlo) mask_tile(P0_, P1_, qm - kb_, (unsigned)W); } while (0)
    constexpr int NQL = 8;
#define SEAM_K0() do { VMWN(NQL); SWRITE_HK(0); SBAR(); } while (0)
    f32x16 pA0, pA1, pB0, pB1; float mnA, mnB, alA, alB; bf16x8 pa0, pa1, pa2, pa3;
    SLOAD_H(Kh, Vh, KBASE(0)); VMW(); SWRITE_HK(0); SWRITE_HV(0); __syncthreads();
    SBAR();
    if (NT > 1) { SLOAD_H(Kh, Vh, KBASE(1)); }
    SBAR(); qkt<0>(pA0, pA1, K_lds, bl + KBASE(0), r32, hi, S.qr);
    MASKT(pA0, pA1, 0); partialSM(pA0, pA1, m_reg, mnA, alA);
    if (NT > 1) { VMW(); SWRITE_H(1); }
    __syncthreads();
#define HALF_STEP(PX0, PX1, mnX, alX, PY0, PY1, alY, t, KB, VB, SB) do {                                                      \
        SBAR(); qkt<KB>(PX0, PX1, K_lds, bl + KBASE(t), r32, hi, S.qr);                                             \
        finishSM(PY0, PY1, alY, l_reg, pa0, pa1, pa2, pa3); SBAR();                                                           \
        if ((t) + 1 < NT) { SLOAD_H(Kh, Vh, KBASE((t) + 1)); SBAR(); }                                               \
        pv_tile<VB>(o, vb0, pa0, pa1, pa2, pa3); MASKT(PX0, PX1, (t)); partialSM(PX0, PX1, m_reg, mnX, alX);                                        \
        __syncthreads();                                                                                                      \
        if ((t) + 1 < NT) { VMW(); SWRITE_H(SB); }                                                                          \
        RESC(alX); __syncthreads(); } while (0)
    for (int t = 1; t + 1 < NT; t += 2) {
        HALF_STEP(pB0, pB1, mnB, alB, pA0, pA1, alA, t, 1, 0, 0);
        HALF_STEP(pA0, pA1, mnA, alA, pB0, pB1, alB, t + 1, 0, 1, 1);
    }
    const bool even = (NT & 1) == 0;
    if (even) { SBAR(); qkt<1>(pB0, pB1, K_lds, bl + KBASE(NT - 1), r32, hi, S.qr); SBAR(); }
#pragma unroll
    for (int d0 = 0; d0 < 8; ++d0) S.qr[d0] = load8((const bf16*)((const char*)nxt.Q + (qoff + d0 * 32)));
    SBAR();
    finishSM(pA0, pA1, alA, l_reg, pa0, pa1, pa2, pa3); SBAR();
    pv_tile<0>(o, vb0, pa0, pa1, pa2, pa3);
    if (even) { MASKT(pB0, pB1, NT - 1); partialSM(pB0, pB1, m_reg, mnB, alB); __syncthreads(); RESC(alB);
        finishSM(pB0, pB1, alB, l_reg, pa0, pa1, pa2, pa3); SBAR(); pv_tile<1>(o, vb0, pa0, pa1, pa2, pa3); }
    SBAR();
    if (hi == 0) li_l[r32] = l_reg; asm volatile("s_waitcnt lgkmcnt(0)" ::: "memory");
    float rli[16];
#pragma unroll
    for (int r = 0; r < 16; ++r) rli[r] = __builtin_amdgcn_rcpf(li_l[crow(r, hi)]);
    char* Ow = (char*)cur.O; const unsigned ooff = (unsigned)((wid * QBLK + 4 * hi) * OPITCH + r32) * 2u;
    const char* Gq = (const char*)cur.Q + GATE_OFF * 2; const unsigned goff = (unsigned)((wid * QBLK + 4 * hi) * PITCH + r32) * 2u;
    unsigned short gq[16][4];
#pragma unroll
    for (int r = 0; r < 16; ++r)
#pragma unroll
        for (int d0 = 0; d0 < 4; ++d0) gq[r][d0] = *(const unsigned short*)(Gq + (goff + (unsigned)(((r & 3) + 8 * (r >> 2)) * PITCH + d0 * 32) * 2u));
#pragma unroll
    for (int r = 0; r < 16; ++r) {
#pragma unroll
        for (int d0 = 0; d0 < 4; ++d0) { const unsigned short gw = gq[r][d0];
            const float gl = __builtin_bit_cast(float, (unsigned)gw << 16);
            const float v = o[d0][r] * rli[r] * __builtin_amdgcn_rcpf(1.0f + __builtin_amdgcn_exp2f(-1.4426950408889634f * gl));
            const float vn = xor1_get(v);
            if ((r32 & 1) == 0) *(unsigned*)(Ow + (ooff + (unsigned)(((r & 3) + 8 * (r >> 2)) * OPITCH + d0 * 32) * 2u)) = cvtpk(v, vn); } }
    __syncthreads();
#undef RESC
#undef KBASE
#undef MASKT
#undef SEAM_K0
#undef HALF_STEP
}
#undef ROW
#undef VMW
#undef VMWN
#undef SLOAD_H
#undef SWRITE_HK
#undef SWRITE_HV
#undef SWRITE_H
#undef KSWZ
#undef SBAR
}

constexpr int NWAVES = 8, NTHREADS = NWAVES * 64;
constexpr int DM = 2048, BATCH = 2, T = 8192, M = BATCH * T, DEPTH = 4;
constexpr int AB_IN = 8200, AB_N = 8192;
constexpr int C_IN = 6160, C_N = 6144;
constexpr int FF = 5632, FF2 = 2 * FF;
constexpr float EPS = 1e-6f;
enum PhaseKind { K_NORM1 = 0, K_MIXIN, K_PREP, K_REC, K_POST, K_MIXOUT, K_NORM2, K_FFIN, K_FFOUT, K_PRO };
constexpr int phase_base(int layer) { return 1 + 9 * layer; }
constexpr int N_PHASES = phase_base(DEPTH) + 1;
constexpr int CW_QUEUE = 8192;
inline int phase_kind(int p, int& layer) { if (p == 0) { layer = 0; return K_PRO; } for (layer = DEPTH - 1; phase_base(layer) > p; --layer) {} return p - phase_base(layer); }
constexpr size_t MiB = 1u << 20;
constexpr size_t WS_CTL = 0, CTL_ZERO_BYTES = 1 * MiB;
constexpr size_t WS_MOD = 1 * MiB;
constexpr size_t WS_LOGF = 2 * MiB;
constexpr size_t WS_BIAS = 3 * MiB;
constexpr size_t WS_GLOW = 4 * MiB;
constexpr size_t WS_W_ABIN = 8 * MiB, WS_W_ABOUT = 72 * MiB, WS_W_GLIN = 88 * MiB, WS_W_GLOUT = 136 * MiB, WS_W_FFIN = 152 * MiB, WS_W_FFOUT = 328 * MiB;
constexpr size_t WS_H = 416 * MiB, WS_CAT = 480 * MiB, WS_PROJ = 544 * MiB, WS_FFH = WS_PROJ, WS_O = 800 * MiB, WS_REC = 928 * MiB, WS_Y = 1064 * MiB, WS_XB = 1128 * MiB, WS_END = 1192 * MiB;
constexpr int CW_BAR = 4096;
constexpr int RING_OFF = 0, RING_BYTES = 139264;
constexpr int LDSCTL_OFF = RING_BYTES, MISC_OFF = LDSCTL_OFF + 320;
constexpr int LDS_BYTES = 155648;
static_assert(fox::LDS_BYTES <= RING_BYTES, "attention LDS");

#define GAS __attribute__((address_space(1)))
#define LAS __attribute__((address_space(3)))
typedef unsigned short bf16;
typedef unsigned v4u __attribute__((ext_vector_type(4)));
typedef unsigned v2u __attribute__((ext_vector_type(2)));
typedef float f32x4 __attribute__((ext_vector_type(4)));
typedef GAS unsigned gu32;
#define RLX_AGENT __ATOMIC_RELAXED, __HIP_MEMORY_SCOPE_AGENT
#define LDS_WAIT() asm volatile("s_waitcnt lgkmcnt(0)" ::: "memory")
__device__ __forceinline__ unsigned pk2(float lo, float hi) { unsigned r; asm("v_cvt_pk_bf16_f32 %0, %1, %2" : "=v"(r) : "v"(lo), "v"(hi)); return r; }
__device__ __forceinline__ unsigned f2bf(float f) { return pk2(f, f) & 0xffffu; }
__device__ __forceinline__ float bf_lo(unsigned w) { return __builtin_bit_cast(float, w << 16); }
__device__ __forceinline__ float bf_hi(unsigned w) { return __builtin_bit_cast(float, w & 0xffff0000u); }
__device__ __forceinline__ float bf1(bf16 h) { return __builtin_bit_cast(float, (unsigned)h << 16); }
__device__ __forceinline__ float sigmoid_f(float x) { return __builtin_amdgcn_rcpf(1.0f + __expf(-x)); }
__device__ __forceinline__ float silu_x(float x) { return x * __builtin_amdgcn_rcpf(1.0f + __expf(-x)); }
__device__ __forceinline__ float log_sigmoid_f(float x) { return fminf(x, 0.f) - log1pf(__expf(-fabsf(x))); }
__device__ __forceinline__ float log_sigmoid_fast(float x) { return fminf(x, 0.f) - __logf(1.0f + __expf(-fabsf(x))); }
__device__ __forceinline__ float wave_sum(float v) {
    v = xsum<1>(v); v = xsum<2>(v); v = xsum<4>(v); v = xsum<8>(v); v = xsum<16>(v); v = xsum<32>(v);
    return v;
}

#define XB_TMO      128
#define XB_XCNT(j)  (256  + 64 * (j))
#define XB_XSUB(j)  (1280 + 64 * (j))
#define XB_XGEN(j)  (2304 + 64 * (j))
#define XB_TOP      3328
#define XB_TOPGEN   3392
#define XCD_BAR_WORDS 3456
#define XB_SPIN_CAP (1u << 18)
__device__ __forceinline__ unsigned xb_ld(unsigned* p)              { return __hip_atomic_load(p, __ATOMIC_RELAXED, __HIP_MEMORY_SCOPE_AGENT); }
__device__ __forceinline__ unsigned xb_add(unsigned* p, unsigned v) { return __hip_atomic_fetch_add(p, v, __ATOMIC_RELAXED, __HIP_MEMORY_SCOPE_AGENT); }
__device__ __forceinline__ unsigned xb_xcc_id() { return (unsigned)__builtin_amdgcn_s_getreg((3 << 11) | 20) & 0xFu; }
#define XB_SPIN(cond, bar) do { unsigned _sp = 0; while (cond) { __builtin_amdgcn_s_sleep(1); \
    if ((++_sp & 255u) == 0u) { if (xb_ld(&(bar)[XB_TMO])) break; if (_sp > XB_SPIN_CAP) { atomicAdd(&(bar)[XB_TMO], 1u); break; } } } } while (0)
struct XcdBarrier { unsigned* bar; unsigned x; volatile LAS unsigned* st; };
__device__ __forceinline__ XcdBarrier xcd_barrier_post(unsigned* bar, volatile LAS unsigned* st, bool tid0) {
    XcdBarrier b; b.bar = bar; b.x = xb_xcc_id(); b.st = st;
    if (tid0) (void)xb_add(&bar[XB_XCNT(b.x)], 1u);
    return b;
}
__device__ __forceinline__ void xcd_barrier_complete(unsigned* bar, unsigned x, unsigned& nloc, unsigned& nx) {
    const unsigned G = gridDim.x * gridDim.y * gridDim.z;
    unsigned sum, cnt, mine, sp = 0u;
    for (;;) {
        sum = 0u; cnt = 0u; mine = 0u;
#pragma unroll
        for (unsigned j = 0; j < 16; ++j) { const unsigned c = xb_ld(&bar[XB_XCNT(j)]); sum += c; cnt += (c > 0u) ? 1u : 0u; mine = (j == x) ? c : mine; }
        if (sum == G) break;
        __builtin_amdgcn_s_sleep(1);
        if ((++sp & 255u) == 0u) { if (xb_ld(&bar[XB_TMO])) break; if (sp > XB_SPIN_CAP) { atomicAdd(&bar[XB_TMO], 1u); break; } }
    }
    nloc = mine > 0u ? mine : 1u; nx = cnt > 0u ? cnt : 1u;
}
template <bool FIRST>
__device__ __forceinline__ void xcd_barrier(const XcdBarrier& b, bool tid0) {
    asm volatile("s_waitcnt vmcnt(0)" ::: "memory");
    __syncthreads();
    if (tid0) {
        unsigned* bar = b.bar;
        __builtin_amdgcn_s_waitcnt(0);
        unsigned nloc = b.st[0], nx = b.st[1];
        if (FIRST) { if (nloc == 0u) { xcd_barrier_complete(bar, b.x, nloc, nx); b.st[0] = nloc; b.st[1] = nx; } }
        else { if (nloc == 0u) nloc = 1u; if (nx == 0u) nx = 1u; }
        const unsigned old = xb_add(&bar[XB_XSUB(b.x)], 1u);
        const unsigned gen = old / nloc;
        if (old + 1u == (gen + 1u) * nloc) {
            __builtin_amdgcn_fence(__ATOMIC_RELEASE, "agent");
            asm volatile("s_waitcnt vmcnt(0)" ::: "memory");
            const unsigned og = xb_add(&bar[XB_TOP], 1u);
            const unsigned tg = og / nx;
            if (og + 1u == (tg + 1u) * nx) xb_add(&bar[XB_TOPGEN], 1u);
            else XB_SPIN(xb_ld(&bar[XB_TOPGEN]) == tg, bar);
            __builtin_amdgcn_fence(__ATOMIC_ACQUIRE, "agent");
            xb_add(&bar[XB_XGEN(b.x)], 1u);
            asm volatile("s_waitcnt vmcnt(0)" ::: "memory");
        } else {
            XB_SPIN(xb_ld(&bar[XB_XGEN(b.x)]) == gen, bar);
            __builtin_amdgcn_fence(__ATOMIC_ACQUIRE, "agent");
            asm volatile("s_waitcnt vmcnt(0)" ::: "memory");
        }
    }
    __syncthreads();
}

struct Args { const float* in[20]; float* out; unsigned char* ws; int ph_lo, ph_hi, use_bar, pad; };
typedef const Args __attribute__((address_space(4))) CArgs;
__device__ __forceinline__ CArgs* opq_args() { CArgs* p = (CArgs*)__builtin_amdgcn_kernarg_segment_ptr(); asm volatile("" : "+s"(p)); return p; }
struct Frame {
    LAS unsigned char* lds;
    int tid, lane, wave, G, bid;
};

__device__ __forceinline__ void transpose_item(const float* W, int ldn, int K, bf16* WT, int k0, int n0, int drow0, LAS float* scr, int lane) {
    f32x4 v[16];
    const float* src = W + (size_t)(k0 + (lane >> 4)) * ldn + n0 + 4 * (lane & 15);
#pragma unroll
    for (int i = 0; i < 16; ++i) v[i] = *(const f32x4*)(src + (size_t)(4 * i) * ldn);
#pragma unroll
    for (int i = 0; i < 16; ++i) { LAS float* d = scr + (4 * i + (lane >> 4)) * 65 + 4 * (lane & 15); d[0] = v[i].x; d[1] = v[i].y; d[2] = v[i].z; d[3] = v[i].w; }
    LDS_WAIT(); asm volatile("" ::: "memory");
    const int c = lane & 7, r = lane >> 3;
#pragma unroll
    for (int j = 0; j < 8; ++j) { const int n = r + 8 * j; const LAS float* s = scr + (8 * c) * 65 + n;
        v4u o; o.x = pg8::cvt_pk_bf16(s[0 * 65], s[1 * 65]); o.y = pg8::cvt_pk_bf16(s[2 * 65], s[3 * 65]); o.z = pg8::cvt_pk_bf16(s[4 * 65], s[5 * 65]); o.w = pg8::cvt_pk_bf16(s[6 * 65], s[7 * 65]);
        *(GAS v4u*)(WT + (size_t)(drow0 + n) * K + k0 + 8 * c) = o; }
    LDS_WAIT(); asm volatile("" ::: "memory");
}
template <int MODE>
__device__ __forceinline__ void transpose_matrix(const float* W, int nmat, int K, int ldn, int ncols, bf16* WT, LAS float* scr, int gw, int NGW, int lane) {
    const int nblk = ncols / 64, kblk = K / 64, per = nblk * kblk, total = per * nmat;
    for (int it = gw; it < total; it += NGW) {
        const int mat = it / per, r = it - mat * per, kb = r / nblk, nb = r - kb * nblk, n0 = 64 * nb;
        int drow0 = n0;
        if (MODE == 1) { if (n0 < FF) drow0 = (n0 / 128) * 256 + (n0 % 128); else { const int n1 = n0 - FF; drow0 = (n1 / 128) * 256 + 128 + (n1 % 128); } }
        if (MODE == 2) drow0 = n0 < 3072 ? n0 : (n0 < 4096 ? n0 + 4096 : n0 - 1024);
        transpose_item(W + (size_t)mat * K * ldn, ldn, K, WT + (size_t)mat * ncols * K, 64 * kb, n0, drow0, scr, lane);
    }
}
template <int SET>
__device__ __forceinline__ void convert_weights(CArgs* ap, LAS float* scr, int gw, int NGW, int lane) {
    unsigned char* ws = ap->ws;
    bf16* abin = (bf16*)(ws + WS_W_ABIN); bf16* about = (bf16*)(ws + WS_W_ABOUT); bf16* glin = (bf16*)(ws + WS_W_GLIN); bf16* glout = (bf16*)(ws + WS_W_GLOUT); bf16* ffin = (bf16*)(ws + WS_W_FFIN); bf16* ffout = (bf16*)(ws + WS_W_FFOUT);
    constexpr size_t S_ABIN_W = (size_t)DM * AB_IN, S_ABIN_T = (size_t)AB_N * DM, S_SQ = (size_t)DM * DM, S_GLIN_W = (size_t)DM * C_IN, S_GLIN_T = (size_t)C_N * DM, S_FFIN = (size_t)DM * FF2, S_FFOUT = (size_t)FF * DM;
    if (SET == 0) {
        transpose_matrix<2>(ap->in[6], 1, DM, AB_IN, AB_N, abin, scr, gw, NGW, lane);
        transpose_matrix<0>(ap->in[7], 1, DM, DM, DM, about, scr, gw, NGW, lane);
        transpose_matrix<1>(ap->in[18], 1, DM, FF2, FF2, ffin, scr, gw, NGW, lane);
        transpose_matrix<0>(ap->in[19], 1, FF, DM, DM, ffout, scr, gw, NGW, lane);
        transpose_matrix<0>(ap->in[13], 1, DM, C_IN, C_N, glin, scr, gw, NGW, lane);
    } else if (SET == 1) {
        transpose_matrix<0>(ap->in[17], 1, DM, DM, DM, glout, scr, gw, NGW, lane);
        transpose_matrix<1>(ap->in[18] + S_FFIN, 2, DM, FF2, FF2, ffin + S_FFIN, scr, gw, NGW, lane);
        transpose_matrix<0>(ap->in[19] + S_FFOUT, 2, FF, DM, DM, ffout + S_FFOUT, scr, gw, NGW, lane);
        transpose_matrix<2>(ap->in[6] + S_ABIN_W, 1, DM, AB_IN, AB_N, abin + S_ABIN_T, scr, gw, NGW, lane);
        transpose_matrix<0>(ap->in[7] + S_SQ, 1, DM, DM, DM, about + S_SQ, scr, gw, NGW, lane);
        transpose_matrix<0>(ap->in[13] + S_GLIN_W, 1, DM, C_IN, C_N, glin + S_GLIN_T, scr, gw, NGW, lane);
    } else {
        transpose_matrix<0>(ap->in[17] + S_SQ, 1, DM, DM, DM, glout + S_SQ, scr, gw, NGW, lane);
        transpose_matrix<1>(ap->in[18] + 3 * S_FFIN, 1, DM, FF2, FF2, ffin + 3 * S_FFIN, scr, gw, NGW, lane);
        transpose_matrix<0>(ap->in[19] + 3 * S_FFOUT, 1, FF, DM, DM, ffout + 3 * S_FFOUT, scr, gw, NGW, lane);
    }
}
__device__ __forceinline__ void p0_prologue(Frame& F, CArgs* ap) {
    unsigned char* ws = ap->ws;
    {
        LAS float* sc = (LAS float*)(F.lds);
        LAS float* part = (LAS float*)(F.lds + 16384);
        const float* c = ap->in[1];
        for (int i = F.tid; i < 2 * DM; i += NTHREADS) sc[i] = silu_x(c[i]);
        __syncthreads();
        const float* mw = ap->in[2]; const float* mb = ap->in[3]; float* mod = (float*)(ws + WS_MOD);
        constexpr int NU = DEPTH * (6 * DM / 64);
        for (int u = F.bid; u < NU; u += F.G) {
            const int layer = u / (6 * DM / 64), colb = (u % (6 * DM / 64)) * 64, kk = F.lane >> 4, c4 = F.lane & 15;
            const float* wp = mw + ((size_t)layer * DM + F.wave * 256 + kk) * (6 * DM) + colb + 4 * c4;
            f32x4 a0 = {0.f, 0.f, 0.f, 0.f}, a1 = {0.f, 0.f, 0.f, 0.f};
            for (int i0 = 0; i0 < 64; i0 += 16) { f32x4 wv[16];
#pragma unroll
                for (int i = 0; i < 16; ++i) wv[i] = *(const f32x4*)(wp + (size_t)(4 * (i0 + i)) * (6 * DM));
#pragma unroll
                for (int i = 0; i < 16; ++i) { const int k = F.wave * 256 + 4 * (i0 + i) + kk; a0 = a0 + wv[i] * sc[k]; a1 = a1 + wv[i] * sc[DM + k]; } }
            a0.x = xsum<16>(a0.x); a0.x = xsum<32>(a0.x); a0.y = xsum<16>(a0.y); a0.y = xsum<32>(a0.y); a0.z = xsum<16>(a0.z); a0.z = xsum<32>(a0.z); a0.w = xsum<16>(a0.w); a0.w = xsum<32>(a0.w);
            a1.x = xsum<16>(a1.x); a1.x = xsum<32>(a1.x); a1.y = xsum<16>(a1.y); a1.y = xsum<32>(a1.y); a1.z = xsum<16>(a1.z); a1.z = xsum<32>(a1.z); a1.w = xsum<16>(a1.w); a1.w = xsum<32>(a1.w);
            if (F.lane < 16) { *(LAS f32x4*)(part + (F.wave * 2 + 0) * 64 + 4 * c4) = a0; *(LAS f32x4*)(part + (F.wave * 2 + 1) * 64 + 4 * c4) = a1; }
            __syncthreads();
            if (F.tid < 128) { const int b = F.tid >> 6, l = F.tid & 63; float s = 0.f;
#pragma unroll
                for (int w = 0; w < 8; ++w) s += part[(w * 2 + b) * 64 + l];
                const int cc = (u % (6 * DM / 64)) * 64 + l;
                mod[((size_t)layer * 2 + b) * (6 * DM) + cc] = s + mb[(size_t)layer * (6 * DM) + cc]; }
            __syncthreads();
        }
    }
    __syncthreads();
    LAS float* scr = (LAS float*)(F.lds + RING_OFF + F.wave * 16640);
    const int gw = F.bid * NWAVES + F.wave, NGW = F.G * NWAVES;
    convert_weights<0>(ap, scr, gw, NGW, F.lane);
}

template <int MASK> __device__ __forceinline__ float xget(float v) { return __builtin_bit_cast(float, __builtin_amdgcn_ds_swizzle(__builtin_bit_cast(int, v), (MASK << 10) | 0x1f)); }
template <int N> __device__ __forceinline__ float rs_reduce(float (&a)[N], int lane) {
    if (N == 16) {
#pragma unroll
        for (int i = 0; i < 8; ++i) { const bool up = lane & 1; const float keep = up ? a[i + 8] : a[i], send = up ? a[i] : a[i + 8]; a[i] = keep + xget<1>(send); } }
    if (N >= 8) {
#pragma unroll
        for (int i = 0; i < 4; ++i) { const bool up = lane & (N == 16 ? 2 : 1); const float keep = up ? a[i + 4] : a[i], send = up ? a[i] : a[i + 4]; a[i] = keep + (N == 16 ? xget<2>(send) : xget<1>(send)); } }
#pragma unroll
    for (int i = 0; i < 2; ++i) { const bool up = lane & (N == 16 ? 4 : 2); const float keep = up ? a[i + 2] : a[i], send = up ? a[i] : a[i + 2]; a[i] = keep + (N == 16 ? xget<4>(send) : xget<2>(send)); }
    { const bool up = lane & (N == 16 ? 8 : 4); const float keep = up ? a[1] : a[0], send = up ? a[0] : a[1]; a[0] = keep + (N == 16 ? xget<8>(send) : xget<4>(send)); }
    float r = a[0];
    if (N == 8) r = xsum<8>(r);
    r = xsum<16>(r); r = xsum<32>(r);
    return r;
}
template <int N> __device__ __forceinline__ int rs_col(int lane) { return N == 16 ? (((lane & 1) << 3) | ((lane & 2) << 1) | ((lane & 4) >> 1) | ((lane & 8) >> 3)) : (((lane & 1) << 2) | (lane & 2) | ((lane & 4) >> 2)); }
template <int NC, int MODE, bool RES, bool XF32>
__device__ __forceinline__ void norm_phase(Frame& F, const void* xin, const float* gain, const float* mod_sh, const float* mod_sc  ,
                                           bf16* hout, const float* Wsm, int ldn, const float* fbias, float* sout, const bf16* yres = nullptr, const float* rgate = nullptr, bf16* xb = nullptr) {
    LAS float* wl = (LAS float*)(F.lds);
    if (NC > 0) {
        for (int i = F.tid; i < NC * DM; i += NTHREADS) { const int k = i / NC, c = i % NC; wl[c * DM + k] = Wsm[(size_t)k * ldn + c]; }
        __syncthreads();
    }
    f32x4 gm[8], shv[8]; int bprev = -1;
    for (int mp = F.bid * NWAVES + F.wave; mp < M / 2; mp += F.G * NWAVES) {
        const int m0 = 2 * mp, b = m0 / T;
        if (b != bprev) { bprev = b; const f32x4* gp = (const f32x4*)gain + F.lane; const f32x4* shp = (const f32x4*)(mod_sh + (size_t)b * 6 * DM) + F.lane; const f32x4* scp = (const f32x4*)(mod_sc + (size_t)b * 6 * DM) + F.lane;
#pragma unroll
            for (int j = 0; j < 8; ++j) { gm[j] = gp[64 * j] * (scp[64 * j] + 1.0f); shv[j] = shp[64 * j]; } }
        f32x4 v[2][8]; float s0 = 0.f, s1 = 0.f;
        v2u yv[2][8];
        if (RES) { const GAS v2u* yr = (const GAS v2u*)(yres + (size_t)m0 * DM) + F.lane;
#pragma unroll
            for (int j = 0; j < 8; ++j) { yv[0][j] = yr[64 * j]; yv[1][j] = yr[512 + 64 * j]; } }
        if (XF32) { const GAS f32x4* xr = (const GAS f32x4*)((const float*)xin + (size_t)m0 * DM) + F.lane;
#pragma unroll
            for (int j = 0; j < 8; ++j) { v[0][j] = xr[64 * j]; v[1][j] = xr[512 + 64 * j]; } }
        else { const GAS v2u* xr = (const GAS v2u*)((const bf16*)xin + (size_t)m0 * DM) + F.lane; v2u xv[2][8];
#pragma unroll
            for (int j = 0; j < 8; ++j) { xv[0][j] = xr[64 * j]; xv[1][j] = xr[512 + 64 * j]; }
#pragma unroll
            for (int j = 0; j < 8; ++j) { v[0][j] = (f32x4){bf_lo(xv[0][j].x), bf_hi(xv[0][j].x), bf_lo(xv[0][j].y), bf_hi(xv[0][j].y)}; v[1][j] = (f32x4){bf_lo(xv[1][j].x), bf_hi(xv[1][j].x), bf_lo(xv[1][j].y), bf_hi(xv[1][j].y)}; } }
        if (RES) { const f32x4* rg = (const f32x4*)(rgate + (size_t)b * 6 * DM) + F.lane; GAS v2u* xo = (GAS v2u*)(xb + (size_t)m0 * DM) + F.lane;
#pragma unroll
            for (int j = 0; j < 8; ++j) { const f32x4 g = rg[64 * j];
                v[0][j] = v[0][j] + g * (f32x4){bf_lo(yv[0][j].x), bf_hi(yv[0][j].x), bf_lo(yv[0][j].y), bf_hi(yv[0][j].y)}; v[1][j] = v[1][j] + g * (f32x4){bf_lo(yv[1][j].x), bf_hi(yv[1][j].x), bf_lo(yv[1][j].y), bf_hi(yv[1][j].y)};
                v2u w; w.x = pk2(v[0][j].x, v[0][j].y); w.y = pk2(v[0][j].z, v[0][j].w); xo[64 * j] = w;
                w.x = pk2(v[1][j].x, v[1][j].y); w.y = pk2(v[1][j].z, v[1][j].w); xo[512 + 64 * j] = w; } }
#pragma unroll
        for (int j = 0; j < 8; ++j) { s0 += (v[0][j].x * v[0][j].x + v[0][j].y * v[0][j].y) + (v[0][j].z * v[0][j].z + v[0][j].w * v[0][j].w);
                                      s1 += (v[1][j].x * v[1][j].x + v[1][j].y * v[1][j].y) + (v[1][j].z * v[1][j].z + v[1][j].w * v[1][j].w); }
        const float rstd0 = __builtin_amdgcn_rsqf(wave_sum(s0) * (1.f / DM) + EPS), rstd1 = __builtin_amdgcn_rsqf(wave_sum(s1) * (1.f / DM) + EPS);
        GAS v2u* o8 = (GAS v2u*)(hout + (size_t)m0 * DM) + F.lane;
#pragma unroll
        for (int j = 0; j < 8; ++j) { const f32x4 g = gm[j], sh = shv[j];
            v[0][j] = (v[0][j] * rstd0) * g + sh; v[1][j] = (v[1][j] * rstd1) * g + sh;
            v2u w; w.x = pk2(v[0][j].x, v[0][j].y); w.y = pk2(v[0][j].z, v[0][j].w); o8[64 * j] = w;
            w.x = pk2(v[1][j].x, v[1][j].y); w.y = pk2(v[1][j].z, v[1][j].w); o8[512 + 64 * j] = w; }
        if constexpr (NC > 0) {
            float a0[NC], a1[NC];
#pragma unroll
            for (int c = 0; c < NC; ++c) { float acc0 = 0.f, acc1 = 0.f;
#pragma unroll
                for (int j = 0; j < 8; ++j) { const f32x4 w = *(const LAS f32x4*)(wl + c * DM + 256 * j + 4 * F.lane);
                    acc0 += (v[0][j].x * w.x + v[0][j].y * w.y) + (v[0][j].z * w.z + v[0][j].w * w.w); acc1 += (v[1][j].x * w.x + v[1][j].y * w.y) + (v[1][j].z * w.z + v[1][j].w * w.w); }
                a0[c] = acc0; a1[c] = acc1; __builtin_amdgcn_sched_barrier(0); }
            const float r0 = rs_reduce<NC>(a0, F.lane), r1 = rs_reduce<NC>(a1, F.lane); const int cc = rs_col<NC>(F.lane);
            if (MODE == 1) { const int t = m0 % T; if (F.lane < NC) { const float fb = fbias[cc]; sout[((size_t)b * 8 + cc) * T + t] = log_sigmoid_f(r0 + fb); sout[((size_t)b * 8 + cc) * T + t + 1] = log_sigmoid_f(r1 + fb); } }
            if (MODE == 2) { if (F.lane < NC) { sout[(size_t)m0 * 16 + cc] = r0; sout[(size_t)m0 * 16 + 16 + cc] = r1; } }
        }
    }
}

__device__ __forceinline__ void resid_final(Frame& F, const bf16* xb, const bf16* yres, const float* rgate, float* xout) {
    for (int mp = F.bid * NWAVES + F.wave; mp < M / 2; mp += F.G * NWAVES) {
        const int m0 = 2 * mp, b = m0 / T;
        const GAS v2u* xr = (const GAS v2u*)(xb + (size_t)m0 * DM) + F.lane; const GAS v2u* yr = (const GAS v2u*)(yres + (size_t)m0 * DM) + F.lane;
        const f32x4* rg = (const f32x4*)(rgate + (size_t)b * 6 * DM) + F.lane; GAS f32x4* xo = (GAS f32x4*)(xout + (size_t)m0 * DM) + F.lane;
        v2u xv[2][8], yv[2][8];
#pragma unroll
        for (int j = 0; j < 8; ++j) { xv[0][j] = xr[64 * j]; xv[1][j] = xr[512 + 64 * j]; yv[0][j] = yr[64 * j]; yv[1][j] = yr[512 + 64 * j]; }
#pragma unroll
        for (int j = 0; j < 8; ++j) { const f32x4 g = rg[64 * j];
            xo[64 * j] = (f32x4){bf_lo(xv[0][j].x), bf_hi(xv[0][j].x), bf_lo(xv[0][j].y), bf_hi(xv[0][j].y)} + g * (f32x4){bf_lo(yv[0][j].x), bf_hi(yv[0][j].x), bf_lo(yv[0][j].y), bf_hi(yv[0][j].y)};
            xo[512 + 64 * j] = (f32x4){bf_lo(xv[1][j].x), bf_hi(xv[1][j].x), bf_lo(xv[1][j].y), bf_hi(xv[1][j].y)} + g * (f32x4){bf_lo(yv[1][j].x), bf_hi(yv[1][j].x), bf_lo(yv[1][j].y), bf_hi(yv[1][j].y)}; }
    }
}

__device__ __forceinline__ void fox_prep(Frame& F, bf16* proj, const float* qg, const float* kg, const float* logf, float* bias) {
    const int gw = F.bid * NWAVES + F.wave, NGW = F.G * NWAVES;
    const f32x4 gq0 = *(const f32x4*)(qg + (F.lane & 15) * 8), gq1 = *(const f32x4*)(qg + (F.lane & 15) * 8 + 4), gk0 = *(const f32x4*)(kg + (F.lane & 15) * 8), gk1 = *(const f32x4*)(kg + (F.lane & 15) * 8 + 4);
    for (int m = gw; m < M; m += NGW) {
        GAS v4u* p = (GAS v4u*)(proj + (size_t)m * AB_N + 3072) + F.lane;
        v4u wv[4];
#pragma unroll
        for (int j = 0; j < 4; ++j) wv[j] = p[64 * j];
#pragma unroll
        for (int j = 0; j < 4; ++j) {
            const v4u w = wv[j];
            float e[8] = {bf_lo(w.x), bf_hi(w.x), bf_lo(w.y), bf_hi(w.y), bf_lo(w.z), bf_hi(w.z), bf_lo(w.w), bf_hi(w.w)};
            float s = 0.f;
#pragma unroll
            for (int i = 0; i < 8; ++i) s += e[i] * e[i];
            s = xsum<1>(s); s = xsum<2>(s); s = xsum<4>(s); s = xsum<8>(s);
            const float rstd = __builtin_amdgcn_rsqf(s * (1.f / 128.f) + EPS);
            const f32x4 g0 = j < 2 ? gq0 : gk0, g1 = j < 2 ? gq1 : gk1;
#pragma unroll
            for (int i = 0; i < 4; ++i) { e[i] = e[i] * rstd * g0[i]; e[4 + i] = e[4 + i] * rstd * g1[i]; }
            v4u o; o.x = pk2(e[0], e[1]); o.y = pk2(e[2], e[3]); o.z = pk2(e[4], e[5]); o.w = pk2(e[6], e[7]);
            p[64 * j] = o;
        }
    }
    if (F.bid < 16) {
        LAS double* tsum = (LAS double*)(F.lds);
        const float* lf = logf + (size_t)F.bid * T; float* bo = bias + (size_t)F.bid * T;
        double v[16]; double run = 0.0;
        const int i0 = F.tid * 16;
#pragma unroll
        for (int i = 0; i < 16; ++i) { run += (double)lf[i0 + i]; v[i] = run; }
        tsum[F.tid] = run;
        __syncthreads();
        LAS double* bsum = tsum + NTHREADS;
        if (F.tid < 8) { double s = 0.0; for (int w = 0; w < 64; ++w) s += tsum[F.tid * 64 + w]; bsum[F.tid] = s; }
        __syncthreads();
        double base = 0.0;
        for (int w = 0; w < F.wave; ++w) base += bsum[w];
        for (int w = 0; w < F.lane; ++w) base += tsum[F.wave * 64 + w];
        const double k = -11.313708498984761;
#pragma unroll
        for (int i = 0; i < 16; ++i) bo[i0 + i] = (float)((base + v[i]) * k);
        __syncthreads();
    }
}

#ifndef DBG_REC
#define DBG_REC 0
#endif
#if DBG_REC
template <bool GLA>
__device__ __forceinline__ void rec_naive(Frame& F, const bf16* proj, float* O, const float* lbl  , int lb_on,
                                          const float* glow, const float* wup  , const float* bgate  ) {
    constexpr int DK = GLA ? 256 : 128, DVH = GLA ? 512 : 128, NH = GLA ? 4 : 8, DVS = 32, NSL = DVH / DVS, TB = GLA ? 16 : 32;
    constexpr int PITCH = GLA ? C_N : AB_N, OPITCH = GLA ? 2048 : 1024;
    constexpr int R = DK / 16;
    constexpr int NPAIR = TB * DK / 2 / NTHREADS;
    constexpr int NUNITS = BATCH * NH * NSL;
    LAS float* sq = (LAS float*)(F.lds); LAS float* sf = sq + TB * DK; LAS float* sk = sf + TB * DK; LAS float* sv = sk + TB * DK; LAS float* part = sv + TB * DVS; LAS float* sgl = part + TB * 4 * DVS;
    const int lane = F.lane, e_l = lane & 15, dsub = lane >> 4, eg = F.wave & 1, dg = F.wave >> 1, e = eg * 16 + e_l, d0 = (dg * 4 + dsub) * R;
    for (int unit = F.bid; unit < NUNITS; unit += F.G) {
        const int sl = unit % NSL, h = (unit / NSL) % NH, b = unit / (NSL * NH);
        const bf16* pq = proj + (size_t)b * T * PITCH + h * DK;
        const bf16* pk = pq + 1024;
        const bf16* pv = proj + (size_t)b * T * PITCH + 2048 + h * DVH + sl * DVS;
        const int dp = 2 * (F.tid % (DK / 2)), tt0 = F.tid / (DK / 2); constexpr int TSTEP = NTHREADS / (DK / 2);
        float lb0 = 0.f, lb1 = 0.f; float wu0[16], wu1[16]; float bg0 = 0.f, bg1 = 0.f;
        if (!GLA) { if (lb_on) { const float l0a = lbl[h * DK + dp], l1a = lbl[1024 + h * DK + dp], l0b = lbl[h * DK + dp + 1], l1b = lbl[1024 + h * DK + dp + 1];
                                 lb0 = fminf(fmaxf(sigmoid_f(l1a - l0a), 0.f), 1.0f - 1e-6f); lb1 = fminf(fmaxf(sigmoid_f(l1b - l0b), 0.f), 1.0f - 1e-6f); } }
        else {
#pragma unroll
            for (int r = 0; r < 16; ++r) { wu0[r] = wup[r * 1024 + h * DK + dp]; wu1[r] = wup[r * 1024 + h * DK + dp + 1]; }
            bg0 = bgate[h * DK + dp]; bg1 = bgate[h * DK + dp + 1]; }
        const int vt = F.tid / 16, ve = 2 * (F.tid % 16); const bool vact = vt < TB;
        float S[R];
#pragma unroll
        for (int j = 0; j < R; ++j) S[j] = 0.f;
        unsigned rq[NPAIR], rk[NPAIR], rv = 0u; float rgl = 0.f;
#define REC_PREFETCH(t0) do { _Pragma("unroll") for (int i = 0; i < NPAIR; ++i) { const size_t row = (size_t)((t0) + tt0 + TSTEP * i); \
            rq[i] = *(const unsigned*)(pq + row * PITCH + dp); rk[i] = *(const unsigned*)(pk + row * PITCH + dp); \
            } \
            if (GLA && F.tid < TB * 16) rgl = glow[((size_t)b * T + (t0)) * 16 + F.tid]; \
            if (vact) rv = *(const unsigned*)(pv + (size_t)((t0) + vt) * PITCH + ve); } while (0)
        REC_PREFETCH(0);
        for (int t0 = 0; t0 < T; t0 += TB) {
            if (GLA) { if (F.tid < TB * 16) sgl[F.tid] = rgl; __syncthreads(); }
#pragma unroll
            for (int i = 0; i < NPAIR; ++i) { const int tt = tt0 + TSTEP * i; const float qa = bf_lo(rq[i]), qb = bf_hi(rq[i]), ka = bf_lo(rk[i]), kb = bf_hi(rk[i]);
                float q0, q1, f0, f1, k0, k1;
                if (!GLA) { q0 = silu_x(qa); q1 = silu_x(qb); const float s0 = sigmoid_f(ka), s1 = sigmoid_f(kb), n0 = sigmoid_f(-ka), n1 = sigmoid_f(-kb);
                    f0 = fmaxf(lb0 + (1.f - lb0) * s0, 1e-30f); f1 = fmaxf(lb1 + (1.f - lb1) * s1, 1e-30f); k0 = (1.f - lb0) * n0; k1 = (1.f - lb1) * n1; }
                else { q0 = qa * 0.0625f; q1 = qb * 0.0625f; k0 = ka; k1 = kb; float x0 = bg0, x1 = bg1;
#pragma unroll
                    for (int r = 0; r < 16; ++r) { const float g = sgl[tt * 16 + r]; x0 += g * wu0[r]; x1 += g * wu1[r]; }
                    f0 = __expf(log_sigmoid_f(x0) * 0.0625f); f1 = __expf(log_sigmoid_f(x1) * 0.0625f); }
                sq[tt * DK + dp] = q0; sq[tt * DK + dp + 1] = q1; sf[tt * DK + dp] = f0; sf[tt * DK + dp + 1] = f1; sk[tt * DK + dp] = k0; sk[tt * DK + dp + 1] = k1; }
            if (vact) { sv[vt * DVS + ve] = bf_lo(rv); sv[vt * DVS + ve + 1] = bf_hi(rv); }
            __syncthreads();
            if (t0 + TB < T) REC_PREFETCH(t0 + TB);
            for (int tt = 0; tt < TB; ++tt) {
                const float v = sv[tt * DVS + e]; float acc = 0.f;
#pragma unroll
                for (int g4 = 0; g4 < R / 4; ++g4) { const f32x4 f4 = *(const LAS f32x4*)(sf + tt * DK + d0 + 4 * g4), k4 = *(const LAS f32x4*)(sk + tt * DK + d0 + 4 * g4), q4 = *(const LAS f32x4*)(sq + tt * DK + d0 + 4 * g4);
#pragma unroll
                    for (int i = 0; i < 4; ++i) { S[4 * g4 + i] = f4[i] * S[4 * g4 + i] + k4[i] * v; acc += q4[i] * S[4 * g4 + i]; } }
                acc = xsum<16>(acc); acc = xsum<32>(acc);
                if (dsub == 0) part[(tt * 4 + dg) * DVS + e] = acc;
            }
            __syncthreads();
            for (int i = F.tid; i < TB * DVS; i += NTHREADS) { const int tt = i / DVS, ee = i % DVS;
                const float o = (part[(tt * 4 + 0) * DVS + ee] + part[(tt * 4 + 1) * DVS + ee]) + (part[(tt * 4 + 2) * DVS + ee] + part[(tt * 4 + 3) * DVS + ee]);
                O[((size_t)b * T + t0 + tt) * OPITCH + h * DVH + sl * DVS + ee] = o; }
        }
#undef REC_PREFETCH
        __syncthreads();
    }
}

#endif
#ifndef DBG_ZERO
#define DBG_ZERO 0
#endif
__device__ __forceinline__ void post_even(Frame& F, const bf16* O, const bf16* proj, const float* gain  , bf16* cat) {
    const int gw = F.bid * NWAVES + F.wave, NGW = F.G * NWAVES;
    f32x4 gn[4];
#pragma unroll
    for (int j = 0; j < 4; ++j) gn[j] = *((const f32x4*)gain + 64 * j + F.lane);
    for (int mp = gw; mp < M / 2; mp += NGW) {
        const int m = 2 * mp;
        const GAS v2u* op = (const GAS v2u*)(O + (size_t)m * 1024) + F.lane;
        const GAS v2u* ga = (const GAS v2u*)(proj + (size_t)m * AB_N + 7168) + F.lane;
        GAS v2u* cp = (GAS v2u*)(cat + (size_t)m * DM) + F.lane;
        v2u vr[2][4], gr[2][4];
#pragma unroll
        for (int r = 0; r < 2; ++r)
#pragma unroll
            for (int j = 0; j < 4; ++j) { vr[r][j] = op[r * 256 + 64 * j]; gr[r][j] = ga[r * (AB_N / 4) + 64 * j]; }
#pragma unroll
        for (int r = 0; r < 2; ++r)
#pragma unroll
        for (int j = 0; j < 4; ++j) {
            const f32x4 v = {bf_lo(vr[r][j].x), bf_hi(vr[r][j].x), bf_lo(vr[r][j].y), bf_hi(vr[r][j].y)}; float s = (v.x * v.x + v.y * v.y) + (v.z * v.z + v.w * v.w);
            s = xsum<1>(s); s = xsum<2>(s); s = xsum<4>(s); s = xsum<8>(s); s = xsum<16>(s);
            const float rstd = __builtin_amdgcn_rsqf(s * (1.f / 128.f) + EPS);
            const f32x4 g = gn[j];
            const v2u gw2 = gr[r][j];
            const float o0 = v.x * rstd * g.x * silu_x(bf_lo(gw2.x)), o1 = v.y * rstd * g.y * silu_x(bf_hi(gw2.x)), o2 = v.z * rstd * g.z * silu_x(bf_lo(gw2.y)), o3 = v.w * rstd * g.w * silu_x(bf_hi(gw2.y));
            v2u w; w.x = pk2(o0, o1); w.y = pk2(o2, o3); cp[r * 512 + 64 * j] = w;
        }
    }
}
__device__ __forceinline__ void post_odd(Frame& F, const bf16* O, const bf16* proj, const float* gain  , bf16* cat) {
    const int gw = F.bid * NWAVES + F.wave, NGW = F.G * NWAVES;
    const f32x4 gn0 = *((const f32x4*)gain + F.lane), gn1 = *((const f32x4*)gain + 64 + F.lane);
    for (int mp = gw; mp < M / 2; mp += NGW) {
        const int m = 2 * mp;
        const GAS v2u* op = (const GAS v2u*)(O + (size_t)m * DM) + F.lane;
        const GAS v2u* gg = (const GAS v2u*)(proj + (size_t)m * C_N + 4096) + F.lane;
        GAS v2u* cp = (GAS v2u*)(cat + (size_t)m * DM) + F.lane;
        v2u vr[2][8], gr[2][8];
#pragma unroll
        for (int r = 0; r < 2; ++r)
#pragma unroll
            for (int j = 0; j < 8; ++j) { vr[r][j] = op[r * 512 + 64 * j]; gr[r][j] = gg[r * (C_N / 4) + 64 * j]; }
#pragma unroll
        for (int r = 0; r < 2; ++r)
#pragma unroll
        for (int hh = 0; hh < 4; ++hh) {
            const v2u r0 = vr[r][2 * hh], r1 = vr[r][2 * hh + 1]; const f32x4 v0 = {bf_lo(r0.x), bf_hi(r0.x), bf_lo(r0.y), bf_hi(r0.y)}, v1 = {bf_lo(r1.x), bf_hi(r1.x), bf_lo(r1.y), bf_hi(r1.y)};
            float s = ((v0.x * v0.x + v0.y * v0.y) + (v0.z * v0.z + v0.w * v0.w)) + ((v1.x * v1.x + v1.y * v1.y) + (v1.z * v1.z + v1.w * v1.w));
            s = wave_sum(s);
            const float rstd = __builtin_amdgcn_rsqf(s * (1.f / 512.f) + EPS);
#pragma unroll
            for (int jj = 0; jj < 2; ++jj) { const f32x4 v = jj ? v1 : v0; const f32x4 g = jj ? gn1 : gn0; const v2u gw2 = gr[r][2 * hh + jj];
                const float o0 = v.x * rstd * g.x * silu_x(bf_lo(gw2.x)), o1 = v.y * rstd * g.y * silu_x(bf_hi(gw2.x)), o2 = v.z * rstd * g.z * silu_x(bf_lo(gw2.y)), o3 = v.w * rstd * g.w * silu_x(bf_hi(gw2.y));
                v2u w; w.x = pk2(o0, o1); w.y = pk2(o2, o3); cp[r * 512 + 64 * (2 * hh + jj)] = w; }
        }
    }
}

__device__ __forceinline__ fox::BlockRef fox_ref(int item, const bf16* proj, bf16* cat, const float* bias, float thp) {
    const int bh = item & 15, qb = 31 - (item >> 4), b = bh >> 3, h = bh & 7;
    fox::BlockRef r;
    const bf16* base = proj + (size_t)b * T * AB_N + h * 128;
    r.Q = (const fox::bf16*)(base + (size_t)qb * 256 * AB_N + 3072); r.K = (const fox::bf16*)(base + 4096); r.V = (const fox::bf16*)(base + 5120);
    r.O = (fox::bf16*)(cat + ((size_t)b * T + (size_t)qb * 256) * DM + 1024 + h * 128);
    r.Bias = bias + (size_t)bh * T; r.P0 = qb * 256; r.THp = thp;
    return r;
}
__device__ __forceinline__ int fox_fetch(Frame& F, unsigned* ctr, volatile LAS unsigned* slot) {
    if (F.tid == 0) *slot = __hip_atomic_fetch_add(ctr, 1u, __ATOMIC_RELAXED, __HIP_MEMORY_SCOPE_AGENT);
    __syncthreads();
    const int v = __builtin_amdgcn_readfirstlane((int)*slot);
    __syncthreads();
    return v;
}
__device__ __forceinline__ void fox_phase(Frame& F, char* lds, const bf16* proj, bf16* cat, const float* bias, unsigned* ctr, const float* qg, const float* kg) {
    constexpr int TOTAL = 512;
    float gqm = 0.f, gkm = 0.f;
    for (int i = 0; i < 128; ++i) { gqm = fmaxf(gqm, fabsf(qg[i])); gkm = fmaxf(gkm, fabsf(kg[i])); }
    const float thp = 2.0f * (128.0f * 1.02f * gqm * gkm) + (128.0f + 12.0f + 6.0f) / (1.4426950408889634f * fox::SCALE);
    volatile LAS unsigned* slot = (volatile LAS unsigned*)(F.lds + MISC_OFF) + 16;
    int ci = fox_fetch(F, ctr, slot); if (ci >= TOTAL) return;
    fox::BlockRef cur = fox_ref(ci, proj, cat, bias, thp);
    fox::Seam S;
    fox::fox_prime(cur, lds, S, F.tid);
    for (;;) {
        const int ni = fox_fetch(F, ctr, slot); const bool last = ni >= TOTAL;
        const fox::BlockRef nxt = last ? cur : fox_ref(ni, proj, cat, bias, thp);
        fox::fox_block(cur, nxt, lds, S, F.tid);
        if (last) break;
        cur = nxt;
    }
}

template <bool GLA> struct RecCfg {
    static constexpr int DK = GLA ? 256 : 128, DVH = GLA ? 512 : 128, NH = GLA ? 4 : 8, CH = 32, NCH = T / CH, PITCH = GLA ? C_N : AB_N, OPITCH = GLA ? 2048 : 1024;
    static constexpr int QP = DK + 16;
    static constexpr int QT_B = ((CH * QP * 2 + 1023) / 1024) * 1024, KT_B = DK * CH * 2, P_B = CH * CH * 2, A_B = 1024, VT_B = DVH * CH * 2;
    static constexpr int OFF_QT = 0, OFF_KT = QT_B, OFF_P = OFF_KT + KT_B, OFF_A = OFF_P + P_B, OFF_VT = OFF_A + A_B, UNIT_B = OFF_VT + VT_B;
    static constexpr int NSL = DVH / 128, BUF_B = OFF_VT + 8192, NP1 = OFF_VT / 1024, NP = NP1 + 8, NR = (NP + 7) / 8;
    static_assert(A_B >= DK * 4 && OFF_VT % 1024 == 0, "rec layout");
};
typedef short rbf16x8 __attribute__((ext_vector_type(8)));
__device__ __forceinline__ rbf16x8 rpack8(f32x4 a, f32x4 b) { v4u w; w.x = pg8::cvt_pk_bf16(a.x, a.y); w.y = pg8::cvt_pk_bf16(a.z, a.w); w.z = pg8::cvt_pk_bf16(b.x, b.y); w.w = pg8::cvt_pk_bf16(b.z, b.w); return __builtin_bit_cast(rbf16x8, w); }

template <bool GLA>
__device__ __forceinline__ void rec_prep(Frame& F, const bf16* proj, unsigned char* rec, const float* lbl, int lb_on, const float* glow, const float* wup, const float* bgate) {
    using C = RecCfg<GLA>;
    constexpr int DK = C::DK, DVH = C::DVH, NH = C::NH, CH = C::CH, NCH = C::NCH, PITCH = C::PITCH, QP = C::QP;
    constexpr int NSEG = NTHREADS / DK, TPS = CH / NSEG;
    constexpr int NSEGV = NTHREADS / DVH, TPV = CH / NSEGV;
    LAS float* segtot = (LAS float*)F.lds;
    LAS bf16* qm = (LAS bf16*)(F.lds + 2048);
    LAS bf16* km = qm + CH * QP;
    LAS float* sgl = (LAS float*)(F.lds + 2048 + 2 * CH * QP * 2);
    const int d = F.tid % DK, seg = F.tid / DK, lane = F.lane, el = lane & 15, q4 = lane >> 4;
    const int x = d & 31, y = x & 15, pos = (d & ~31) + 8 * (y >> 2) + (y & 3) + 4 * (x >> 4);
    constexpr int NUNITS = BATCH * NH * NCH, NBH = BATCH * NH;
    float lb = 0.f, bg = 0.f; float wu[16]; int hprev = -1;
    unsigned short rq[TPS], rk[TPS]; unsigned rvv[TPV / 2]; float rgl = 0.f;
    unsigned short rvr[GLA ? 1 : TPV];
    const int ev = F.tid % DVH, sv = F.tid / DVH;
    const unsigned toff = (unsigned)(seg * TPS) * (unsigned)(PITCH * 2) + (unsigned)d * 2u, voff = (unsigned)(sv * TPV) * (unsigned)(PITCH * 2) + (unsigned)ev * 2u;
#define PREP_LOAD(un) do { const int c_ = (un) / NBH, bh_ = (un) % NBH; const size_t row_ = (size_t)(bh_ / NH) * T + (size_t)c_ * CH; const int h_ = bh_ % NH; \
        const char* ubq_ = (const char*)(proj + row_ * PITCH + h_ * DK); const char* ubv_ = (const char*)(proj + row_ * PITCH + 2048 + h_ * DVH); (void)ubv_; \
        if (GLA) rgl = glow[row_ * 16 + F.tid];     \
        _Pragma("unroll") for (int i = 0; i < TPS; ++i) { const char* rb_ = ubq_ + (size_t)i * (PITCH * 2);     \
            rq[i] = *(const bf16*)(rb_ + toff); rk[i] = *(const bf16*)(rb_ + 2048 + toff); } \
        if (!GLA) { _Pragma("unroll") for (int i = 0; i < TPV; ++i) rvr[i] = *(const bf16*)((ubv_ + (size_t)i * (PITCH * 2)) + voff); } \
        } while (0)
    if (F.bid < NUNITS) PREP_LOAD(F.bid);
    for (int unit = F.bid; unit < NUNITS; unit += F.G) {
        const int c = unit / NBH, bh = unit % NBH, h = bh % NH, b = bh / NH;
        const size_t row0 = (size_t)b * T + (size_t)c * CH;
        if (h != hprev) { hprev = h;
            if (!GLA) { lb = 0.f; if (lb_on) lb = fminf(fmaxf(sigmoid_f(lbl[1024 + h * DK + d] - lbl[h * DK + d]), 0.f), 1.0f - 1e-6f); }
            else {
#pragma unroll
                for (int r = 0; r < 16; ++r) wu[r] = wup[r * 1024 + h * DK + d];
                bg = bgate[h * DK + d]; } }
        if (GLA) { sgl[F.tid] = rgl; __syncthreads(); }
        float qv[TPS], kv[TPS], G[TPS]; float run = 0.f;
#pragma unroll
        for (int i = 0; i < TPS; ++i) { const int t = seg * TPS + i; const float qa = bf1(rq[i]), ka = bf1(rk[i]); float g;
            if (!GLA) { qv[i] = silu_x(qa); const float ez = __expf(-fabsf(ka)), rz = __builtin_amdgcn_rcpf(1.0f + ez), big = rz, small = ez * rz;
                const float sg = ka >= 0.f ? big : small, ng = ka >= 0.f ? small : big; const float f = fmaxf(lb + (1.f - lb) * sg, 1e-30f); g = __logf(f); kv[i] = (1.f - lb) * ng; }
            else { qv[i] = qa * 0.0625f; kv[i] = ka; float xx = bg;
#pragma unroll
                for (int r = 0; r < 16; ++r) xx += sgl[t * 16 + r] * wu[r];
                g = log_sigmoid_fast(xx) * 0.0625f; }
            run += g; G[i] = run; }
        segtot[seg * DK + d] = run;
        __syncthreads();
        float off = 0.f, tot = 0.f, rmid = 0.f;
#pragma unroll
        for (int s = 0; s < NSEG; ++s) { const float v = segtot[s * DK + d]; tot += v; if (s < seg) off += v; if (s < 16 / TPS) rmid += v; }
        unsigned char* ub = rec + (size_t)(bh * NCH + c) * C::UNIT_B;
        bf16* QT = (bf16*)(ub + C::OFF_QT); bf16* KT = (bf16*)(ub + C::OFF_KT); bf16* Pb = (bf16*)(ub + C::OFF_P); float* Ab = (float*)(ub + C::OFF_A); bf16* VT = (bf16*)(ub + C::OFF_VT);
        unsigned kt[TPS / 2];
#pragma unroll
        for (int i = 0; i < TPS; i += 2) { float kh[2];
#pragma unroll
            for (int u = 0; u < 2; ++u) { const int t = seg * TPS + i + u; const float Gt = G[i + u] + off;
                QT[t * QP + pos] = (bf16)f2bf(qv[i + u] * __expf(Gt)); kh[u] = kv[i + u] * __expf(tot - Gt);
                qm[t * QP + d] = (bf16)f2bf(qv[i + u] * __expf(fminf(Gt - rmid, 80.f))); km[t * QP + d] = (bf16)f2bf(kv[i + u] * __expf(fminf(rmid - Gt, 80.f))); }
            kt[i / 2] = pk2(kh[0], kh[1]); }
#pragma unroll
        for (int j = 0; j < TPS / 8; ++j) { v4u w; w.x = kt[4 * j]; w.y = kt[4 * j + 1]; w.z = kt[4 * j + 2]; w.w = kt[4 * j + 3]; *(v4u*)(KT + d * CH + ((seg * TPS + 8 * j) ^ ((d & 8) << 1))) = w; }
        if (seg == NSEG - 1) Ab[d] = __expf(tot);
        { bf16* vt_ = VT + ev * CH;
          if (GLA) { const char* ubv_ = (const char*)(proj + row0 * PITCH + 2048 + h * DVH);
#pragma unroll
              for (int i = 0; i < TPV; i += 2) rvv[i / 2] = (unsigned)*(const bf16*)(ubv_ + (voff + (unsigned)i * (unsigned)(PITCH * 2))) | ((unsigned)*(const bf16*)(ubv_ + (voff + (unsigned)(i + 1) * (unsigned)(PITCH * 2))) << 16); }
          else {
#pragma unroll
              for (int i = 0; i < TPV; i += 2) rvv[i / 2] = (unsigned)rvr[i] | ((unsigned)rvr[i + 1] << 16); }
#pragma unroll
          for (int j = 0; j < TPV / 8; ++j) { v4u w; w.x = rvv[4 * j]; w.y = rvv[4 * j + 1]; w.z = rvv[4 * j + 2]; w.w = rvv[4 * j + 3];
              *(v4u*)(vt_ + ((sv * TPV + 8 * j) ^ ((ev & 8) << 1))) = w; } }
        if (unit + F.G < NUNITS) PREP_LOAD(unit + F.G);
        __syncthreads();
        if (F.wave < 3) { const int tt = F.wave >= 1, st = F.wave == 2; f32x4 acc = {0.f, 0.f, 0.f, 0.f};
#pragma unroll
            for (int i = 0; i < DK / 32; ++i) { const rbf16x8 a = *(const LAS rbf16x8*)(km + (16 * st + el) * QP + 32 * i + 8 * q4), bq = *(const LAS rbf16x8*)(qm + (16 * tt + el) * QP + 32 * i + 8 * q4);
                acc = __builtin_amdgcn_mfma_f32_16x16x32_bf16(a, bq, acc, 0, 0, 0); }
            const int ta = 16 * tt + el, s0 = 16 * st + 4 * q4;
            const float p0 = s0 + 0 <= ta ? acc[0] : 0.f, p1 = s0 + 1 <= ta ? acc[1] : 0.f, p2 = s0 + 2 <= ta ? acc[2] : 0.f, p3 = s0 + 3 <= ta ? acc[3] : 0.f;
            v2u w; w.x = pk2(p0, p1); w.y = pk2(p2, p3); *(v2u*)(Pb + ta * CH + (s0 ^ ((ta & 8) << 1))) = w; }
        else if (F.wave == 3) { v2u w; w.x = 0u; w.y = 0u; *(v2u*)(Pb + el * CH + ((16 + 4 * q4) ^ ((el & 8) << 1))) = w; }
        __syncthreads();
    }
#undef PREP_LOAD
}

template <bool GLA>
__device__ __forceinline__ void rec_seq(Frame& F, const unsigned char* rec, float* O, const bf16* proj, const float* gain, bf16* cat) {
    using C = RecCfg<GLA>;
    constexpr int DK = C::DK, DVH = C::DVH, NH = C::NH, CH = C::CH, NCH = C::NCH, QP = C::QP, NSL = C::NSL, NDT = DK / 16, NKS = DK / 32;
    constexpr int NBUF = 3, PF = NBUF - 1;
    constexpr int BUFG = C::BUF_B + (GLA ? 0 : 8192);
    constexpr int NWAIT = (PF - 1) * ((C::NR - 1) + (GLA ? 0 : 1) + 2);
    static_assert(NBUF * BUFG + 2048 <= RING_BYTES, "rec ring");
    constexpr int NUNITS = BATCH * NH * NSL;
    const int lane = F.lane, el = lane & 15, q4 = lane >> 4, wave = F.wave;
    for (int unit = F.bid; unit < NUNITS; unit += F.G) {
        const int sl = unit % NSL, h = (unit / NSL) % NH, b = unit / (NSL * NH);
        const unsigned char* ubase = rec + (size_t)((b * NH + h) * NCH) * C::UNIT_B;
#define REC_DMA(cc) do { const unsigned char* ub_ = ubase + (size_t)(cc) * C::UNIT_B; const int bufi_ = (cc) % NBUF; _Pragma("unroll") for (int r_ = 0; r_ < C::NR; ++r_) { const int p_ = r_ * 8 + wave; \
            if (p_ < C::NP) { const unsigned char* src_ = ub_ + (p_ < C::NP1 ? p_ * 1024 : C::OFF_VT + sl * 8192 + (p_ - C::NP1) * 1024) + lane * 16; \
                __builtin_amdgcn_global_load_lds((const unsigned*)src_, (LAS unsigned*)(F.lds + bufi_ * BUFG + p_ * 1024), 16, 0, 0); } } \
            if (!GLA) { const unsigned char* gsrc_ = (const unsigned char*)(proj + ((size_t)b * T + (size_t)(cc) * CH + 4 * wave + (lane >> 4)) * AB_N + 3072 + h * DVH) + (lane & 15) * 16; \
                __builtin_amdgcn_global_load_lds((const unsigned*)gsrc_, (LAS unsigned*)(F.lds + bufi_ * BUFG + C::BUF_B + wave * 1024), 16, 0, 0); } } while (0)
        f32x4 S[NDT];
#pragma unroll
        for (int i = 0; i < NDT; ++i) S[i] = (f32x4){0.f, 0.f, 0.f, 0.f};
#pragma unroll
        for (int cc = 0; cc < PF; ++cc) REC_DMA(cc);
        float* Ob = O + ((size_t)b * T) * C::OPITCH + h * DVH + sl * 128 + 16 * wave + 4 * q4;
        LAS float* ssq = (LAS float*)(F.lds + NBUF * BUFG);
        f32x4 oprev[2] = {{0.f, 0.f, 0.f, 0.f}, {0.f, 0.f, 0.f, 0.f}};
        v2u gsave[2] = {{0u, 0u}, {0u, 0u}};
        const unsigned ecol = (unsigned)(h * DVH + 16 * wave + 4 * q4);
        f32x4 gn4 = {1.f, 1.f, 1.f, 1.f}; if (!GLA) gn4 = *(const f32x4*)(gain + ecol);
#define REC_FINISH(cp) do { _Pragma("unroll") for (int tt = 0; tt < 2; ++tt) { const int tl = 16 * tt + el; float tot = 0.f; \
            _Pragma("unroll") for (int w_ = 0; w_ < 8; ++w_) tot += ssq[(((cp) & 1) * 8 + w_) * 32 + tl]; \
            const float rstd = 1.0f / sqrtf(tot * (1.f / 128.f) + EPS); const size_t row_ = (size_t)b * T + (size_t)(cp) * CH + tl; \
            const v2u gw_ = gsave[tt]; const f32x4 ov = oprev[tt]; \
            v2u w_o; w_o.x = pk2(ov.x * rstd * gn4.x * silu_x(bf_lo(gw_.x)), ov.y * rstd * gn4.y * silu_x(bf_hi(gw_.x))); \
            w_o.y = pk2(ov.z * rstd * gn4.z * silu_x(bf_lo(gw_.y)), ov.w * rstd * gn4.w * silu_x(bf_hi(gw_.y))); \
            *(v2u*)(cat + row_ * DM + ecol) = w_o; } } while (0)
        for (int c = 0; c < NCH; ++c) {
            if (c <= PF) asm volatile("s_waitcnt vmcnt(0)" ::: "memory"); else asm volatile("s_waitcnt vmcnt(%0)" :: "i"(NWAIT) : "memory");
            asm volatile("s_waitcnt lgkmcnt(0)" ::: "memory"); __builtin_amdgcn_s_barrier(); asm volatile("" ::: "memory");
            if (!GLA) {
                if (c > 0) REC_FINISH(c - 1);
                else { v2u z; z.x = 0u; z.y = 0u; *(v2u*)(cat + ((size_t)b * T + el) * DM + ecol) = z; *(v2u*)(cat + ((size_t)b * T + 16 + el) * DM + ecol) = z; }
            }
            if (c + PF < NCH) REC_DMA(c + PF); else REC_DMA(NCH - 1);
            const LAS unsigned char* L = F.lds + (c % NBUF) * BUFG;
            rbf16x8 sf[NKS];
#pragma unroll
            for (int i = 0; i < NKS; ++i) sf[i] = rpack8(S[2 * i], S[2 * i + 1]);
            f32x4 o[2];
#pragma unroll
            for (int tt = 0; tt < 2; ++tt) { o[tt] = (f32x4){0.f, 0.f, 0.f, 0.f};
#pragma unroll
                for (int i = 0; i < NKS; ++i) { const rbf16x8 qf = *(const LAS rbf16x8*)(L + C::OFF_QT + ((16 * tt + el) * QP + 32 * i + 8 * q4) * 2);
                    o[tt] = __builtin_amdgcn_mfma_f32_16x16x32_bf16(sf[i], qf, o[tt], 0, 0, 0); } }
            const rbf16x8 vf = *(const LAS rbf16x8*)(L + C::OFF_VT + ((16 * wave + el) * CH + 8 * q4) * 2);
#pragma unroll
            for (int tt = 0; tt < 2; ++tt) { const rbf16x8 pf = *(const LAS rbf16x8*)(L + C::OFF_P + ((16 * tt + el) * CH + 8 * q4) * 2);
                o[tt] = __builtin_amdgcn_mfma_f32_16x16x32_bf16(vf, pf, o[tt], 0, 0, 0); }
#pragma unroll
            for (int dt = 0; dt < NDT; ++dt) { const f32x4 a4 = *(const LAS f32x4*)(L + C::OFF_A + (16 * dt + 4 * q4) * 4); S[dt] = S[dt] * a4;
                const rbf16x8 kf = *(const LAS rbf16x8*)(L + C::OFF_KT + ((16 * dt + el) * CH + 8 * q4) * 2);
                S[dt] = __builtin_amdgcn_mfma_f32_16x16x32_bf16(kf, vf, S[dt], 0, 0, 0); }
            if (GLA) {
#pragma unroll
                for (int tt = 0; tt < 2; ++tt) *(f32x4*)(Ob + (size_t)(c * CH + 16 * tt + el) * C::OPITCH) = o[tt];
            } else {
#pragma unroll
                for (int tt = 0; tt < 2; ++tt) { float p = (o[tt].x * o[tt].x + o[tt].y * o[tt].y) + (o[tt].z * o[tt].z + o[tt].w * o[tt].w); p = xsum<16>(p); p = xsum<32>(p);
                    if (q4 == 0) ssq[((c & 1) * 8 + wave) * 32 + 16 * tt + el] = p; oprev[tt] = o[tt];
                    gsave[tt] = *(const LAS v2u*)(L + C::BUF_B + ((16 * tt + el) * 128 + 16 * wave + 4 * q4) * 2); }
            }
        }
        asm volatile("s_waitcnt vmcnt(0)" ::: "memory"); __syncthreads();
        if (!GLA) { REC_FINISH(NCH - 1); }
        __syncthreads();
#undef REC_FINISH
#undef REC_DMA
    }
}

template <bool GLA>
__device__ __forceinline__ void rec_seq2(Frame& F, const unsigned char* rec, bf16* O) {
    using C = RecCfg<GLA>;
    constexpr int DK = C::DK, DVH = C::DVH, NH = C::NH, CH = C::CH, NCH = C::NCH, QP = C::QP;
    constexpr int NDH = DK / 32, NKH = DK / 64;
    constexpr int ES = 64, NSL = DVH / ES, BUF2 = C::OFF_VT + ES * CH * 2, NP1 = C::OFF_VT / 1024, NP = NP1 + ES * CH * 2 / 1024, NR = NP / 8;
    constexpr int NBUF = GLA ? 3 : 5, PF = NBUF - 1, NWAIT = (PF - 1) * (NR + 1);
    static_assert(NP % 8 == 0 && NBUF * BUF2 + 2 * 8 * 1024 <= RING_BYTES, "rec_seq2 ring");
    constexpr int NUNITS = BATCH * NH * NSL;
    const int lane = F.lane, el = lane & 15, q4 = lane >> 4, wave = F.wave, eg = wave & 3, dg = wave >> 2;
    LAS unsigned char* xch = F.lds + NBUF * BUF2;
    for (int unit = F.bid; unit < NUNITS; unit += F.G) {
        const int sl = unit % NSL, h = (unit / NSL) % NH, b = unit / (NSL * NH);
        const unsigned char* ubase = rec + (size_t)((b * NH + h) * NCH) * C::UNIT_B;
#define G2_DMA(cc) do { const unsigned char* ub_ = ubase + (size_t)(cc) * C::UNIT_B; const int bufi_ = (cc) % NBUF; _Pragma("unroll") for (int r_ = 0; r_ < NR; ++r_) { const int p_ = r_ * 8 + wave; \
            const unsigned char* src_ = ub_ + (p_ < NP1 ? p_ * 1024 : C::OFF_VT + sl * (ES * CH * 2) + (p_ - NP1) * 1024) + lane * 16; \
            __builtin_amdgcn_global_load_lds((const unsigned*)src_, (LAS unsigned*)(F.lds + bufi_ * BUF2 + p_ * 1024), 16, 0, 0); } } while (0)
        f32x4 S[NDH];
#pragma unroll
        for (int i = 0; i < NDH; ++i) S[i] = (f32x4){0.f, 0.f, 0.f, 0.f};
#pragma unroll
        for (int cc = 0; cc < PF; ++cc) G2_DMA(cc);
        bf16* Ob = O + ((size_t)b * T + 16 * dg + el) * C::OPITCH + h * DVH + sl * ES + 16 * eg + 4 * q4;
#define G2_ST(p_, v_) do { const f32x4 v4_ = (v_); v2u w2_; w2_.x = pg8::cvt_pk_bf16(v4_.x, v4_.y); w2_.y = pg8::cvt_pk_bf16(v4_.z, v4_.w); *(v2u*)(p_) = w2_; } while (0)
        f32x4 okeep = {0.f, 0.f, 0.f, 0.f};
        for (int c = 0; c < NCH; ++c) {
            if (c <= PF) asm volatile("s_waitcnt vmcnt(0)" ::: "memory"); else asm volatile("s_waitcnt vmcnt(%0)" :: "i"(NWAIT) : "memory");
            asm volatile("s_waitcnt lgkmcnt(0)" ::: "memory"); __builtin_amdgcn_s_barrier(); asm volatile("" ::: "memory");
            if (c + PF < NCH) G2_DMA(c + PF); else G2_DMA(NCH - 1);
            const LAS unsigned char* L = F.lds + (c % NBUF) * BUF2;
            rbf16x8 qf[2][NKH], kf[NDH]; f32x4 a4[NDH];
#pragma unroll
            for (int tt = 0; tt < 2; ++tt)
#pragma unroll
                for (int i = 0; i < NKH; ++i) qf[tt][i] = *(const LAS rbf16x8*)(L + C::OFF_QT + ((16 * tt + el) * QP + 32 * (NKH * dg + i) + 8 * q4) * 2);
            const int sw8 = (8 * q4) ^ ((el & 8) << 1);
            const rbf16x8 vf = *(const LAS rbf16x8*)(L + C::OFF_VT + ((16 * eg + el) * CH + sw8) * 2);
            const rbf16x8 pf = *(const LAS rbf16x8*)(L + C::OFF_P + ((16 * dg + el) * CH + sw8) * 2);
#pragma unroll
            for (int j = 0; j < NDH; ++j) { kf[j] = *(const LAS rbf16x8*)(L + C::OFF_KT + ((16 * (NDH * dg + j) + el) * CH + sw8) * 2); a4[j] = *(const LAS f32x4*)(L + C::OFF_A + (16 * (NDH * dg + j) + 4 * q4) * 4); }
            rbf16x8 sf[NKH];
#pragma unroll
            for (int i = 0; i < NKH; ++i) sf[i] = rpack8(S[2 * i], S[2 * i + 1]);
            f32x4 o[2];
#pragma unroll
            for (int tt = 0; tt < 2; ++tt) { o[tt] = (f32x4){0.f, 0.f, 0.f, 0.f};
#pragma unroll
                for (int i = 0; i < NKH; ++i) o[tt] = __builtin_amdgcn_mfma_f32_16x16x32_bf16(sf[i], qf[tt][i], o[tt], 0, 0, 0); }
            if (dg == 0) o[0] = __builtin_amdgcn_mfma_f32_16x16x32_bf16(vf, pf, o[0], 0, 0, 0); else o[1] = __builtin_amdgcn_mfma_f32_16x16x32_bf16(vf, pf, o[1], 0, 0, 0);
#pragma unroll
            for (int j = 0; j < NDH; ++j) { S[j] = S[j] * a4[j]; S[j] = __builtin_amdgcn_mfma_f32_16x16x32_bf16(kf[j], vf, S[j], 0, 0, 0); }
            if (c > 0) { const f32x4 pr = *(const LAS f32x4*)(xch + ((((c - 1) & 1) * 8 + (wave ^ 4)) * 64 + lane) * 16);
                         G2_ST(Ob + (size_t)((c - 1) * CH) * C::OPITCH, okeep + pr); }
            else { G2_ST(Ob, okeep); }
            *(LAS f32x4*)(xch + (((c & 1) * 8 + wave) * 64 + lane) * 16) = dg == 0 ? o[1] : o[0];
            okeep = dg == 0 ? o[0] : o[1];
        }
        asm volatile("s_waitcnt vmcnt(0) lgkmcnt(0)" ::: "memory"); __syncthreads();
        { const f32x4 pr = *(const LAS f32x4*)(xch + ((((NCH - 1) & 1) * 8 + (wave ^ 4)) * 64 + lane) * 16); G2_ST(Ob + (size_t)((NCH - 1) * CH) * C::OPITCH, okeep + pr); }
        __syncthreads();
#undef G2_ST
#undef G2_DMA
    }
}

template <bool GLA>
__device__ __forceinline__ void rec_seq3(Frame& F, const unsigned char* rec, bf16* O) {
    using C = RecCfg<GLA>;
    constexpr int DK = C::DK, DVH = C::DVH, NH = C::NH, CH = C::CH, NCH = C::NCH, QP = C::QP;
    constexpr int NDH = DK / 32, NKH = DK / 64;
    constexpr int ES = 64, NSL = DVH / ES, BUF2 = C::OFF_VT + ES * CH * 2, NP1 = C::OFF_VT / 1024, NP = NP1 + ES * CH * 2 / 1024, NRL = NP / 4;
    constexpr int NBUF = GLA ? 3 : 5, PF = NBUF - 1, NWAIT = (PF - 1) * NRL;
    static_assert(NP % 4 == 0 && NBUF * BUF2 + 2 * 8 * 1024 <= RING_BYTES && NWAIT < 64, "rec_seq3 ring");
    constexpr int NUNITS = BATCH * NH * NSL;
    const int lane = F.lane, el = lane & 15, q4 = lane >> 4, wave = F.wave;
    LAS unsigned char* xch = F.lds + NBUF * BUF2;
    for (int unit = F.bid; unit < NUNITS; unit += F.G) {
        const int bh = unit % (BATCH * NH), sl = unit / (BATCH * NH), h = bh % NH, b = bh / NH;
        const unsigned char* ubase = rec + (size_t)((b * NH + h) * NCH) * C::UNIT_B;
        const int eg2 = wave & 1, dg = (wave >> 1) & 1;
        bf16* Ob = O + ((size_t)b * T + 16 * dg + el) * C::OPITCH + h * DVH + sl * ES + 32 * eg2 + 4 * q4;
        f32x4 okeep[2] = {{0.f, 0.f, 0.f, 0.f}, {0.f, 0.f, 0.f, 0.f}};
#define G3_ST(p_, v_) do { const f32x4 v4_ = (v_); v2u w2_; w2_.x = pg8::cvt_pk_bf16(v4_.x, v4_.y); w2_.y = pg8::cvt_pk_bf16(v4_.z, v4_.w); *(v2u*)(p_) = w2_; } while (0)
        if (wave >= 4) {
            const int lw = wave - 4;
#define G3_DMA(cc) do { const unsigned char* ub_ = ubase + (size_t)(cc) * C::UNIT_B; const int bufi_ = (cc) % NBUF; _Pragma("unroll") for (int r_ = 0; r_ < NRL; ++r_) { const int p_ = r_ * 4 + lw; \
            const unsigned char* src_ = ub_ + (p_ < NP1 ? p_ * 1024 : C::OFF_VT + sl * (ES * CH * 2) + (p_ - NP1) * 1024) + lane * 16; \
            __builtin_amdgcn_global_load_lds((const unsigned*)src_, (LAS unsigned*)(F.lds + bufi_ * BUF2 + p_ * 1024), 16, 0, 0); } } while (0)
#pragma unroll
            for (int cc = 0; cc < PF; ++cc) G3_DMA(cc);
            for (int c = 0; c < NCH; ++c) {
                asm volatile("s_waitcnt vmcnt(%0)" :: "i"(NWAIT) : "memory");
                __builtin_amdgcn_s_barrier(); asm volatile("" ::: "memory");
                if (c + PF < NCH) G3_DMA(c + PF); else G3_DMA(NCH - 1);
            }
            asm volatile("s_waitcnt vmcnt(0)" ::: "memory");
#undef G3_DMA
        } else {
            f32x4 S[NDH][2];
#pragma unroll
            for (int i = 0; i < NDH; ++i) { S[i][0] = (f32x4){0.f, 0.f, 0.f, 0.f}; S[i][1] = (f32x4){0.f, 0.f, 0.f, 0.f}; }
            const int sw8 = (8 * q4) ^ ((el & 8) << 1);
            for (int c = 0; c < NCH; ++c) {
                asm volatile("s_waitcnt lgkmcnt(0)" ::: "memory"); __builtin_amdgcn_s_barrier(); asm volatile("" ::: "memory");
                const LAS unsigned char* L = F.lds + (c % NBUF) * BUF2;
                rbf16x8 qf[2][NKH], kf[NDH], vf[2]; f32x4 a4[NDH];
#pragma unroll
                for (int tt = 0; tt < 2; ++tt)
#pragma unroll
                    for (int i = 0; i < NKH; ++i) qf[tt][i] = *(const LAS rbf16x8*)(L + C::OFF_QT + ((16 * tt + el) * QP + 32 * (NKH * dg + i) + 8 * q4) * 2);
#pragma unroll
                for (int et = 0; et < 2; ++et) vf[et] = *(const LAS rbf16x8*)(L + C::OFF_VT + ((32 * eg2 + 16 * et + el) * CH + sw8) * 2);
                const rbf16x8 pf = *(const LAS rbf16x8*)(L + C::OFF_P + ((16 * dg + el) * CH + sw8) * 2);
#pragma unroll
                for (int j = 0; j < NDH; ++j) { kf[j] = *(const LAS rbf16x8*)(L + C::OFF_KT + ((16 * (NDH * dg + j) + el) * CH + sw8) * 2); a4[j] = *(const LAS f32x4*)(L + C::OFF_A + (16 * (NDH * dg + j) + 4 * q4) * 4); }
                f32x4 o[2][2];
#pragma unroll
                for (int et = 0; et < 2; ++et) { rbf16x8 sf[NKH];
#pragma unroll
                    for (int i = 0; i < NKH; ++i) sf[i] = rpack8(S[2 * i][et], S[2 * i + 1][et]);
#pragma unroll
                    for (int tt = 0; tt < 2; ++tt) { o[tt][et] = (f32x4){0.f, 0.f, 0.f, 0.f};
#pragma unroll
                        for (int i = 0; i < NKH; ++i) o[tt][et] = __builtin_amdgcn_mfma_f32_16x16x32_bf16(sf[i], qf[tt][i], o[tt][et], 0, 0, 0); } }
#pragma unroll
                for (int et = 0; et < 2; ++et) { if (dg == 0) o[0][et] = __builtin_amdgcn_mfma_f32_16x16x32_bf16(vf[et], pf, o[0][et], 0, 0, 0); else o[1][et] = __builtin_amdgcn_mfma_f32_16x16x32_bf16(vf[et], pf, o[1][et], 0, 0, 0); }
#pragma unroll
                for (int j = 0; j < NDH; ++j)
#pragma unroll
                    for (int et = 0; et < 2; ++et) { S[j][et] = S[j][et] * a4[j]; S[j][et] = __builtin_amdgcn_mfma_f32_16x16x32_bf16(kf[j], vf[et], S[j][et], 0, 0, 0); }
                if (c > 0) {
#pragma unroll
                    for (int et = 0; et < 2; ++et) { const f32x4 pr = *(const LAS f32x4*)(xch + (((((c - 1) & 1) * 4 + (wave ^ 2)) * 2 + et) * 64 + lane) * 16);
                        G3_ST(Ob + (size_t)((c - 1) * CH) * C::OPITCH + 16 * et, okeep[et] + pr); } }
#pragma unroll
                for (int et = 0; et < 2; ++et) { *(LAS f32x4*)(xch + ((((c & 1) * 4 + wave) * 2 + et) * 64 + lane) * 16) = dg == 0 ? o[1][et] : o[0][et]; okeep[et] = dg == 0 ? o[0][et] : o[1][et]; }
            }
        }
        asm volatile("s_waitcnt vmcnt(0) lgkmcnt(0)" ::: "memory"); __syncthreads();
        if (wave < 4) {
#pragma unroll
            for (int et = 0; et < 2; ++et) { const f32x4 pr = *(const LAS f32x4*)(xch + (((((NCH - 1) & 1) * 4 + (wave ^ 2)) * 2 + et) * 64 + lane) * 16);
                G3_ST(Ob + (size_t)((NCH - 1) * CH) * C::OPITCH + 16 * et, okeep[et] + pr); } }
        __syncthreads();
#undef G3_ST
    }
}
#define WSP(T_, off) ((T_*)(ws + (off)))
#define REFRAME() CArgs* ap = opq_args(); unsigned char* ws = ap->ws; (void)ws; \
    F.lds = (LAS unsigned char*)lds; F.tid = opq_tid(wave_s); F.lane = F.tid & 63; F.wave = __builtin_amdgcn_readfirstlane(F.tid >> 6); F.G = gridDim.x; F.bid = opq_bid()
#ifndef DBG_DOUBLE
#define DBG_DOUBLE 0
#endif
#define NREP(bit) ((DBG_DOUBLE & (bit)) ? 2 : 1)
#define REPBAR(rep, n) do { if ((rep) + 1 < (n)) xcd_barrier<false>(bar, F.tid == 0); } while (0)
#define IN(k) (lo <= (k) && (k) < hi)
#define SEAM(k) do { if (IN(k) && IN((k) + 1)) xcd_barrier<false>(bar, F.tid == 0); } while (0)
template <int layer>
__device__ __forceinline__ void layer_phases(unsigned char* lds, const int wave_s, const int lo, const int hi, const XcdBarrier& bar) {
    Frame F;

        constexpr int pb = phase_base(layer); constexpr bool odd = layer & 1; constexpr int li = layer >> 1;
        constexpr int P_NORM1 = pb, P_MIXIN = pb + 1, P_PREP = pb + 2, P_REC = pb + 3, P_POST = pb + 4, P_MIXOUT = pb + 5, P_NORM2 = P_MIXOUT + 1, P_FFIN = P_MIXOUT + 2, P_FFOUT = P_MIXOUT + 3;
#define MODL (WSP(float, WS_MOD) + (size_t)layer * 2 * 6 * DM)
#define XCUR (layer == 0 ? ap->in[0] : (const float*)ap->out)
        if (IN(P_NORM1)) { REFRAME();
            const float* modl = MODL;
            for (int rep = 0; rep < NREP(2); ++rep) {
            constexpr bool L0 = layer == 0; const float* g2p = WSP(float, WS_MOD) + (size_t)(L0 ? 0 : layer - 1) * 2 * 6 * DM + 5 * DM; const void* xin = L0 ? (const void*)ap->in[0] : (const void*)WSP(const bf16, WS_XB);
            if (!odd) norm_phase<8, 1, !L0, L0>(F, xin, ap->in[4] + (size_t)layer * DM, modl, modl + DM, WSP(bf16, WS_H), ap->in[6] + (size_t)li * DM * AB_IN + AB_N, AB_IN, ap->in[12] + li * 8, WSP(float, WS_LOGF), WSP(const bf16, WS_Y), g2p, WSP(bf16, WS_XB));
            else norm_phase<16, 2, !L0, L0>(F, xin, ap->in[4] + (size_t)layer * DM, modl, modl + DM, WSP(bf16, WS_H), ap->in[13] + (size_t)li * DM * C_IN + C_N, C_IN, nullptr, WSP(float, WS_GLOW), WSP(const bf16, WS_Y), g2p, WSP(bf16, WS_XB));
            REPBAR(rep, NREP(2)); }
            SEAM(P_NORM1);
        }
        if (IN(P_MIXIN)) { REFRAME();
            const int N = odd ? 4096 : AB_N, ldc = odd ? C_N : AB_N;
            const bf16* Wt = odd ? WSP(const bf16, WS_W_GLIN) + (size_t)li * C_N * DM : WSP(const bf16, WS_W_ABIN) + (size_t)li * AB_N * DM;
            pg8::Gemm g{WSP(const bf16, WS_H), Wt, M, N, DM}; pg8::StaticOrder S; S.init(M, N, F.G, F.bid);
            pg8::EpiBf16 E{WSP(bf16, WS_PROJ), ldc};
            for (int rep = 0; rep < NREP(1); ++rep) { pg8::gemm_phase<pg8::EpiBf16, pg8::StaticOrder, true, true>(F.lds + RING_OFF, g, S, E, F.tid); REPBAR(rep, NREP(1)); }
            SEAM(P_MIXIN);
        }
        if (IN(P_PREP)) { REFRAME();
            if (!odd) { fox_prep(F, WSP(bf16, WS_PROJ), ap->in[10] + li * 128, ap->in[11] + li * 128, WSP(float, WS_LOGF), WSP(float, WS_BIAS));
                        __syncthreads();
                        for (int rep = 0; rep < NREP(4); ++rep) { rec_prep<false>(F, WSP(const bf16, WS_PROJ), ws + WS_REC, ap->in[8], li, nullptr, nullptr, nullptr); REPBAR(rep, NREP(4)); } }
            else for (int rep = 0; rep < NREP(4); ++rep) { rec_prep<true>(F, WSP(const bf16, WS_PROJ), ws + WS_REC, nullptr, 0, WSP(float, WS_GLOW), ap->in[14] + (size_t)li * 16 * 1024, ap->in[15] + li * 1024); REPBAR(rep, NREP(4)); }
            SEAM(P_PREP);
        }
        if (IN(P_REC)) { REFRAME();
            for (int rep = 0; rep < (odd ? NREP(8) : 1); ++rep) {
            if (!odd) { rec_seq3<false>(F, ws + WS_REC, WSP(bf16, WS_O));
                        fox_phase(F, (char*)lds + RING_OFF, WSP(const bf16, WS_PROJ), WSP(bf16, WS_CAT), WSP(float, WS_BIAS), (unsigned*)(ws + WS_CTL) + CW_QUEUE + 64 * (li + 2 * rep), ap->in[10] + li * 128, ap->in[11] + li * 128); }
            else { rec_seq3<true>(F, ws + WS_REC, WSP(bf16, WS_O));
                   if (F.bid >= 64 && rep == 0) {
                       { pg8::Gemm g{WSP(const bf16, WS_H), WSP(const bf16, WS_W_GLIN) + (size_t)li * C_N * DM + (size_t)4096 * DM, M, 2048, DM}; pg8::StaticOrder S; S.init(M, 2048, F.G - 64, F.bid - 64);
                         pg8::EpiBf16 E{WSP(bf16, WS_PROJ) + 4096, C_N};
                         pg8::gemm_phase<pg8::EpiBf16, pg8::StaticOrder, true, true>(F.lds + RING_OFF, g, S, E, F.tid); }
                       LAS float* scr = (LAS float*)(F.lds + RING_OFF + F.wave * 16640);
                       convert_weights<(layer == 1 ? 1 : 2)>(ap, scr, (F.bid - 64) * NWAVES + F.wave, (F.G - 64) * NWAVES, F.lane); } }
            REPBAR(rep, (odd ? NREP(8) : 1)); }
            SEAM(P_REC);
        }
        if (IN(P_POST)) { REFRAME();
            if (!odd) post_even(F, WSP(const bf16, WS_O), WSP(const bf16, WS_PROJ), ap->in[9] + li * 1024, WSP(bf16, WS_CAT));
            else for (int rep = 0; rep < NREP(16); ++rep) { post_odd(F, WSP(const bf16, WS_O), WSP(const bf16, WS_PROJ), ap->in[16] + li * 512, WSP(bf16, WS_CAT)); REPBAR(rep, NREP(16)); }
            SEAM(P_POST);
        }
        if (IN(P_MIXOUT)) { REFRAME();
            const float* modl = MODL;
            const bf16* Wt = odd ? WSP(const bf16, WS_W_GLOUT) + (size_t)li * DM * DM : WSP(const bf16, WS_W_ABOUT) + (size_t)li * DM * DM;
            pg8::Gemm g{WSP(const bf16, WS_CAT), Wt, M, DM, DM}; pg8::StaticOrder S; S.init(M, DM, F.G, F.bid);
            pg8::EpiBf16 E{WSP(bf16, WS_Y), DM};
            pg8::gemm_phase<pg8::EpiBf16, pg8::StaticOrder, true, true>(F.lds + RING_OFF, g, S, E, F.tid);
            SEAM(P_MIXOUT);
        }
        if (IN(P_NORM2)) { REFRAME();
            const float* modl = MODL;
            { constexpr bool L0 = layer == 0; const void* xin = L0 ? (const void*)ap->in[0] : (const void*)WSP(const bf16, WS_XB);
              norm_phase<0, 0, true, L0>(F, xin, ap->in[5] + (size_t)layer * DM, modl + 3 * DM, modl + 4 * DM, WSP(bf16, WS_H), nullptr, 0, nullptr, nullptr, WSP(const bf16, WS_Y), modl + 2 * DM, WSP(bf16, WS_XB)); }
            SEAM(P_NORM2);
        }
        if (IN(P_FFIN)) { REFRAME();
            pg8::Gemm g{WSP(const bf16, WS_H), WSP(const bf16, WS_W_FFIN) + (size_t)layer * FF2 * DM, M, FF2, DM}; pg8::StaticOrder S; S.init(M, FF2, F.G, F.bid);
            pg8::EpiSwiglu E{WSP(bf16, WS_FFH), FF};
            for (int rep = 0; rep < NREP(1 | 128); ++rep) { pg8::gemm_phase<pg8::EpiSwiglu, pg8::StaticOrder, true, true>(F.lds + RING_OFF, g, S, E, F.tid); REPBAR(rep, NREP(1 | 128)); }
            SEAM(P_FFIN);
        }
        if (IN(P_FFOUT)) { REFRAME();
            const float* modl = MODL;
            pg8::Gemm g{WSP(const bf16, WS_FFH), WSP(const bf16, WS_W_FFOUT) + (size_t)layer * DM * FF, M, DM, FF}; pg8::StaticOrder S; S.init(M, DM, F.G, F.bid);
            pg8::EpiBf16 E{WSP(bf16, WS_Y), DM};
            pg8::gemm_phase<pg8::EpiBf16, pg8::StaticOrder, true, true>(F.lds + RING_OFF, g, S, E, F.tid);
            SEAM(P_FFOUT);
        }
    }
__global__ void __launch_bounds__(NTHREADS, 2) trunk_fwd(Args args_unused) {
    extern __shared__ __attribute__((aligned(16))) unsigned char lds[];
    Frame F;
    const int wave_s = __builtin_amdgcn_readfirstlane(threadIdx.x >> 6);
    int lo, hi, use_bar; XcdBarrier bar;
    {
        REFRAME();
        volatile LAS unsigned* MISC = (volatile LAS unsigned*)(F.lds + MISC_OFF);
        for (int u = F.tid; u < (LDS_BYTES - LDSCTL_OFF) / 4; u += NTHREADS) ((LAS unsigned*)(F.lds + LDSCTL_OFF))[u] = 0u;
        __syncthreads();
        lo = ap->ph_lo; hi = ap->ph_hi; use_bar = ap->use_bar;
        bar.bar = (unsigned*)(ws + WS_CTL) + CW_BAR; bar.x = 0; bar.st = MISC + 8;
        if (use_bar) bar = xcd_barrier_post((unsigned*)(ws + WS_CTL) + CW_BAR, MISC + 8, F.tid == 0);
    }

    if (IN(0)) { REFRAME(); p0_prologue(F, ap); if (IN(1)) xcd_barrier<true>(bar, F.tid == 0);
        if (DBG_DOUBLE & 32) { p0_prologue(F, ap); xcd_barrier<false>(bar, F.tid == 0); } }

    layer_phases<0>(lds, wave_s, lo, hi, bar);
    layer_phases<1>(lds, wave_s, lo, hi, bar);
    layer_phases<2>(lds, wave_s, lo, hi, bar);
    layer_phases<3>(lds, wave_s, lo, hi, bar);
    if (IN(phase_base(DEPTH))) { REFRAME(); resid_final(F, WSP(const bf16, WS_XB), WSP(const bf16, WS_Y), WSP(float, WS_MOD) + (size_t)(DEPTH - 1) * 2 * 6 * DM + 5 * DM, ap->out); }
#undef IN
#undef SEAM
}

#ifndef DBG_CHECK
#define DBG_CHECK 0
#endif
#if DBG_CHECK
#ifndef DBG_REPORT_ERR
#define DBG_REPORT_ERR 1
#endif
constexpr size_t WS_DBG = 5 * MiB;
constexpr size_t WS_DBG_OLD = 1072 * MiB;
__device__ __forceinline__ unsigned dbg_hash(unsigned x) { x ^= x >> 16; x *= 0x7feb352dU; x ^= x >> 15; x *= 0x846ca68bU; x ^= x >> 16; return x; }
__device__ __forceinline__ float dbg_bfr(float f) { return __builtin_bit_cast(float, f2bf(f) << 16); }
__device__ __forceinline__ void dbg_cmp(unsigned* dbg, unsigned code, float got, float ref, float rtol, float atol) {
    const float err = fabsf(got - ref); const bool bad = !(err <= atol + rtol * fabsf(ref));
    if (bad) { atomicMin(dbg, code); atomicMax(dbg + 1 + (code & 255u), __float_as_uint(err)); }
}
__global__ void dbg_gemm(unsigned* dbg, unsigned code, int mode, const bf16* A, int K, const float* W, int ldw, int N, const void* C, int ldc, const float* old, const float* gate0, const float* gate1) {
    const unsigned s = blockIdx.x * blockDim.x + threadIdx.x; const unsigned hsh = dbg_hash(s * 2654435761u + code);
    const int m = hsh % M, n = dbg_hash(hsh) % N;
    float d0 = 0.f, d1 = 0.f;
    for (int k = 0; k < K; ++k) { const float a = bf1(A[(size_t)m * K + k]); d0 += a * dbg_bfr(W[(size_t)k * ldw + n]); if (mode == 1) d1 += a * dbg_bfr(W[(size_t)k * ldw + FF + n]); }
    float got, ref;
    if (mode == 0) { got = bf1(((const bf16*)C)[(size_t)m * ldc + n]); ref = d0; }
    else if (mode == 1) { got = bf1(((const bf16*)C)[(size_t)m * ldc + n]); ref = d0 / (1.f + expf(-d0)) * d1; }
    else { got = ((const float*)C)[(size_t)m * ldc + n]; ref = old[(size_t)m * ldc + n] + (m >= T ? gate1 : gate0)[n] * d0; }
    dbg_cmp(dbg, code, got, ref, 0.02f, 0.03f);
}
__global__ void dbg_norm(unsigned* dbg, unsigned code, const float* x, const float* gain, const float* sh, const float* sc, const bf16* h) {
    const unsigned s = blockIdx.x * blockDim.x + threadIdx.x; const unsigned hsh = dbg_hash(s * 2654435761u + code);
    const int m = hsh % M, k = dbg_hash(hsh) % DM, b = m / T;
    double ss = 0.0; for (int i = 0; i < DM; ++i) { const double v = x[(size_t)m * DM + i]; ss += v * v; }
    const float rstd = (float)(1.0 / sqrt(ss / DM + 1e-6));
    const float ref = x[(size_t)m * DM + k] * rstd * gain[k] * (1.f + sc[(size_t)b * 6 * DM + k]) + sh[(size_t)b * 6 * DM + k];
    dbg_cmp(dbg, code, bf1(h[(size_t)m * DM + k]), ref, 0.01f, 0.01f);
}
__global__ void dbg_mod(unsigned* dbg, unsigned code, const float* c, const float* mw, const float* mb, const float* mod) {
    const unsigned s = blockIdx.x * blockDim.x + threadIdx.x; const unsigned hsh = dbg_hash(s * 2654435761u + code);
    const int layer = hsh % DEPTH, b = (hsh >> 8) & 1, j = dbg_hash(hsh) % (6 * DM);
    double acc = mb[(size_t)layer * 6 * DM + j];
    for (int k = 0; k < DM; ++k) { const double cv = c[b * DM + k]; acc += cv / (1.0 + exp(-cv)) * mw[((size_t)layer * DM + k) * (6 * DM) + j]; }
    dbg_cmp(dbg, code, mod[((size_t)layer * 2 + b) * 6 * DM + j], (float)acc, 1e-3f, 1e-4f);
}
__global__ void dbg_small(unsigned* dbg, unsigned code, int mode, const bf16* h, const float* W, int ldw, const float* fbias, const float* sout) {
    const unsigned s = blockIdx.x * blockDim.x + threadIdx.x; const unsigned hsh = dbg_hash(s * 2654435761u + code);
    const int m = hsh % M, cc = dbg_hash(hsh) % (mode == 1 ? 8 : 16), b = m / T, t = m % T;
    double acc = 0.0; for (int k = 0; k < DM; ++k) acc += (double)bf1(h[(size_t)m * DM + k]) * W[(size_t)k * ldw + cc];
    if (mode == 1) { const double xx = acc + fbias[cc]; const double ref = (xx < 0 ? xx : 0.0) - log1p(exp(-fabs(xx))); dbg_cmp(dbg, code, sout[((size_t)b * 8 + cc) * T + t], (float)ref, 0.02f, 0.02f); }
    else dbg_cmp(dbg, code, sout[(size_t)m * 16 + cc], (float)acc, 0.02f, 0.02f);
}
__global__ void dbg_cmpbuf(unsigned* dbg, unsigned code, const float* a, const float* b, size_t n) {
    for (size_t i = (size_t)blockIdx.x * blockDim.x + threadIdx.x; i < n; i += (size_t)gridDim.x * blockDim.x * 61) dbg_cmp(dbg, code, b[i], a[i], 0.05f, 0.1f);
}
__global__ void dbg_report(const unsigned* dbg, float* out) {
    if (threadIdx.x == 0 && blockIdx.x == 0) { const unsigned code = dbg[0]; if (code != 0xffffffffu) { out[0] = DBG_REPORT_ERR ? 1000.f * __uint_as_float(dbg[1 + (code & 255u)]) : 1000.f * (float)(code & 255u); } }
}
#endif
#ifndef N_LAUNCH_MODE
#define N_LAUNCH_MODE 1
#endif
extern "C" void kernel_launch(void* const* d_in, const int* in_sizes, int n_in, void* d_out, int out_size, void* d_ws, size_t ws_size, hipStream_t stream) {
    static int grid = 0;
    if (grid == 0) {
        if (n_in != 20 || out_size != M * DM || ws_size < WS_END) { fprintf(stderr, "kernel_launch: unexpected shapes (n_in %d out %d ws %zu)\n", n_in, out_size, ws_size); grid = -1; return; }
        int dev = 0, cus = 0, per_cu = 0;
        if (hipGetDevice(&dev) != hipSuccess || hipDeviceGetAttribute(&cus, hipDeviceAttributeMultiprocessorCount, dev) != hipSuccess) { grid = -1; return; }
        if (hipFuncSetAttribute((const void*)trunk_fwd, hipFuncAttributeMaxDynamicSharedMemorySize, LDS_BYTES) != hipSuccess) { fprintf(stderr, "kernel_launch: hipFuncSetAttribute failed\n"); grid = -1; return; }
        if (hipOccupancyMaxActiveBlocksPerMultiprocessor(&per_cu, (const void*)trunk_fwd, NTHREADS, LDS_BYTES) != hipSuccess || per_cu < 1)
            fprintf(stderr, "kernel_launch: occupancy query reports %d workgroups per CU\n", per_cu);
        (void)hipGetLastError();
        grid = cus;
    }
    if (grid < 0) return;
    if (hipMemsetAsync((char*)d_ws + WS_CTL, 0, CTL_ZERO_BYTES, stream) != hipSuccess) return;
    Args a{};
    for (int i = 0; i < 20; ++i) a.in[i] = (const float*)d_in[i];
    a.out = (float*)d_out; a.ws = (unsigned char*)d_ws; a.pad = 0;
#if N_LAUNCH_MODE == 1
    a.ph_lo = 0; a.ph_hi = N_PHASES; a.use_bar = 1;
    hipLaunchKernelGGL(trunk_fwd, dim3(grid), dim3(NTHREADS), LDS_BYTES, stream, a);
#else
    a.use_bar = 0;
#if DBG_CHECK
    unsigned char* wsb = (unsigned char*)d_ws; unsigned* dbg = (unsigned*)(wsb + WS_DBG);
    hipMemsetAsync(dbg, 0xFF, 4, stream); hipMemsetAsync(dbg + 1, 0, 1024, stream);
    const float* const* in = (const float* const*)a.in; float* outp = (float*)d_out; float* oldp = (float*)(wsb + WS_DBG_OLD);
    bf16* hbuf = (bf16*)(wsb + WS_H); bf16* catb = (bf16*)(wsb + WS_CAT); bf16* projb = (bf16*)(wsb + WS_PROJ); bf16* ffhb = (bf16*)(wsb + WS_FFH);
#endif
    for (int p = 0; p < N_PHASES; ++p) {
        int layer = 0; const int q = phase_kind(p, layer); const int li = layer >> 1; const bool odd = layer & 1; (void)li; (void)odd; (void)q;
#if DBG_CHECK
        const float* modl = (const float*)(wsb + WS_MOD) + (size_t)layer * 2 * 6 * DM; const float* xcur = layer == 0 ? in[0] : outp;
        if (q == K_MIXOUT) hipMemcpyAsync(oldp, xcur, (size_t)M * DM * 4, hipMemcpyDeviceToDevice, stream);
        if (q == K_FFOUT) hipMemcpyAsync(oldp, outp, (size_t)M * DM * 4, hipMemcpyDeviceToDevice, stream);
#endif
        a.ph_lo = p; a.ph_hi = p + 1;
        hipLaunchKernelGGL(trunk_fwd, dim3(grid), dim3(NTHREADS), LDS_BYTES, stream, a);
#if DBG_CHECK
        const unsigned code = 1 + p;
        if (q == K_PRO) dbg_mod<<<16, 256, 0, stream>>>(dbg, code, in[1], in[2], in[3], (const float*)(wsb + WS_MOD));
        if (q == K_NORM1) { dbg_norm<<<16, 256, 0, stream>>>(dbg, code, xcur, in[4] + (size_t)layer * DM, modl, modl + DM, hbuf);
            if (!odd) dbg_small<<<16, 256, 0, stream>>>(dbg, code | 0x100, 1, hbuf, in[6] + (size_t)li * DM * AB_IN + AB_N, AB_IN, in[12] + li * 8, (const float*)(wsb + WS_LOGF));
            else dbg_small<<<16, 256, 0, stream>>>(dbg, code | 0x100, 2, hbuf, in[13] + (size_t)li * DM * C_IN + C_N, C_IN, nullptr, (const float*)(wsb + WS_GLOW)); }
        if (q == K_MIXIN) { if (!odd) dbg_gemm<<<16, 256, 0, stream>>>(dbg, code, 0, hbuf, DM, in[6] + (size_t)li * DM * AB_IN, AB_IN, AB_N, projb, AB_N, nullptr, nullptr, nullptr);
            else dbg_gemm<<<16, 256, 0, stream>>>(dbg, code, 0, hbuf, DM, in[13] + (size_t)li * DM * C_IN, C_IN, C_N, projb, C_N, nullptr, nullptr, nullptr); }
#if DBG_REC
        if (q == K_REC) dbg_cmpbuf<<<256, 256, 0, stream>>>(dbg, code, (const float*)(wsb + WS_O), (const float*)(wsb + 1200 * MiB), odd ? (size_t)M * 2048 : (size_t)M * 1024);
#endif
        if (q == K_MIXOUT) dbg_gemm<<<16, 256, 0, stream>>>(dbg, code, 2, catb, DM, (odd ? in[17] : in[7]) + (size_t)li * DM * DM, DM, DM, outp, DM, oldp, modl + 2 * DM, modl + 6 * DM + 2 * DM);
        if (q == K_NORM2) dbg_norm<<<16, 256, 0, stream>>>(dbg, code, outp, in[5] + (size_t)layer * DM, modl + 3 * DM, modl + 4 * DM, hbuf);
        if (q == K_FFIN) dbg_gemm<<<16, 256, 0, stream>>>(dbg, code, 1, hbuf, DM, in[18] + (size_t)layer * DM * FF2, FF2, FF, ffhb, FF, nullptr, nullptr, nullptr);
        if (q == K_FFOUT) dbg_gemm<<<16, 256, 0, stream>>>(dbg, code, 2, ffhb, FF, in[19] + (size_t)layer * FF * DM, DM, DM, outp, DM, oldp, modl + 5 * DM, modl + 6 * DM + 5 * DM);
#endif
    }
#if DBG_CHECK
    dbg_report<<<1, 64, 0, stream>>>(dbg, outp);
#endif
#endif
}
```

```cpp
#include <hip/hip_runtime.h>
#include <hip/hip_bf16.h>
#include <cstdio>
#include <cstdint>
__device__ __forceinline__ int opq_tid(int wave_s) {
    int t; asm volatile("v_mbcnt_lo_u32_b32 %0, -1, 0\n\tv_mbcnt_hi_u32_b32 %0, -1, %0\n\tv_lshl_add_u32 %0, %1, 6, %0" : "=&v"(t) : "s"(wave_s)); return t; }
__device__ __forceinline__ int opq_bid() { int t = blockIdx.x; asm volatile("" : "+s"(t)); return t; }
template <int MASK> __device__ __forceinline__ float xsum(float v) {
    if constexpr (MASK < 32) { return v + __builtin_bit_cast(float, __builtin_amdgcn_ds_swizzle(__builtin_bit_cast(int, v), (MASK << 10) | 0x1f)); }
    else { auto rr = __builtin_amdgcn_permlane32_swap(__float_as_uint(v), __float_as_uint(v), false, false);
           const unsigned r0 = rr[0], r1 = rr[1];
           return __uint_as_float(r0) + __uint_as_float(r1); }
}
__device__ __forceinline__ float xor1_get(float v) { return __builtin_bit_cast(float, __builtin_amdgcn_ds_swizzle(__builtin_bit_cast(int, v), (1 << 10) | 0x1f)); }
namespace pg8 {
#define PG8_LAS __attribute__((address_space(3)))
typedef unsigned short bf16_t;
typedef short bf16x8 __attribute__((ext_vector_type(8)));
typedef float f32x4 __attribute__((ext_vector_type(4)));
typedef unsigned u32x4 __attribute__((ext_vector_type(4)));
constexpr int BM = 256, BK = 64, HALF = 128, HTB = HALF * BK * 2  , STAGE_BYTES = 8 * HTB, NXCD = 8, WGM = 8;

__host__ __device__ __forceinline__ int lds_byte(int r, int c) { const int st = (r >> 4) * 2 + (c >> 5), rr = r & 15, cc = c & 31, ob = rr * 64 + cc * 2; return st * 1024 + (ob ^ (((ob >> 9) & 1) << 5)); }
__host__ __device__ __forceinline__ void stage_rc(int b, int& R, int& C) { const int st = b / 1024, sb = b % 1024, swz = sb ^ (((sb >> 9) & 1) << 5); R = (st >> 1) * 16 + swz / 64; C = (st & 1) * 32 + (swz % 64) / 2; }
__host__ __device__ __forceinline__ int perm32(int rho) { const int n = rho >> 4, i = rho & 15; return 8 * (i >> 2) + 4 * n + (i & 3); }

struct Unit { int pm, pn; };
struct Gemm { const bf16_t* A; const bf16_t* Bt; int M, N, K; };

struct StaticOrder {
    int nM, nN, nwg, G, c;
    __host__ __device__ void init(int M, int N, int G_, int c_) { nM = M / BM; nN = N / BM; nwg = nM * nN; G = G_; c = c_; }
    __host__ __device__ bool next(int i, Unit& u) const {
        const long L = (long)i * G + c; if (L >= nwg) return false;
        int wgid = (int)L; { const int q = nwg / NXCD, r = nwg % NXCD, xcd = wgid % NXCD, off = wgid / NXCD; wgid = (xcd < r ? xcd * (q + 1) : r * (q + 1) + (xcd - r) * q) + off; }
        const int nig = WGM * nN, gid = wgid / nig, fm = gid * WGM, gsz = (nM - fm) < WGM ? (nM - fm) : WGM;
        u.pm = fm + ((wgid % nig) % gsz); u.pn = (wgid % nig) / gsz; return true;
    }
    __device__ __forceinline__ void a_ready(const Unit&) const {}
    __device__ __forceinline__ void done(const Unit&) const {}
};

__device__ __forceinline__ unsigned cvt_pk_bf16(float lo, float hi) { unsigned r; asm volatile("v_cvt_pk_bf16_f32 %0, %1, %2" : "=v"(r) : "v"(lo), "v"(hi)); return r; }
typedef float f32x2 __attribute__((ext_vector_type(2)));

struct EpiBf16 {
    static constexpr bool PERM = true, AFTER_DRAIN = false;
    bf16_t* O; int ldc;
    __device__ __forceinline__ void operator()(const f32x4 (&acc)[2][2][4][2], const Unit& u, int wr, int wc, int fr, int fq) const {
        const int row0 = u.pm * BM + wr * 64 + fr; const int col0 = u.pn * BM + wc * 32 + 8 * fq;
#pragma unroll
        for (int ai = 0; ai < 2; ++ai)
#pragma unroll
            for (int m = 0; m < 4; ++m) { bf16_t* rowp = O + (size_t)(row0 + ai * HALF + m * 16) * ldc + col0;
#pragma unroll
                for (int bj = 0; bj < 2; ++bj) { const f32x4 v0 = acc[ai][bj][m][0], v1 = acc[ai][bj][m][1];
                    u32x4 w; w.x = cvt_pk_bf16(v0[0], v0[1]); w.y = cvt_pk_bf16(v0[2], v0[3]); w.z = cvt_pk_bf16(v1[0], v1[1]); w.w = cvt_pk_bf16(v1[2], v1[3]);
                    *(u32x4*)(rowp + bj * HALF) = w; } }
    }
};
__device__ __forceinline__ float silu_f(float a) { return a * __builtin_amdgcn_rcpf(1.0f + __builtin_amdgcn_exp2f(-1.4426950408889634f * a)); }
struct EpiSwiglu {
    static constexpr bool PERM = true, AFTER_DRAIN = false;
    bf16_t* O; int ldc;
    __device__ __forceinline__ void operator()(const f32x4 (&acc)[2][2][4][2], const Unit& u, int wr, int wc, int fr, int fq) const {
        const int row0 = u.pm * BM + wr * 64 + fr; const int col0 = u.pn * HALF + wc * 32 + 8 * fq;
#pragma unroll
        for (int ai = 0; ai < 2; ++ai)
#pragma unroll
            for (int m = 0; m < 4; ++m) { bf16_t* rowp = O + (size_t)(row0 + ai * HALF + m * 16) * ldc + col0;
                const f32x4 a0 = acc[ai][0][m][0], a1 = acc[ai][0][m][1], u0 = acc[ai][1][m][0], u1 = acc[ai][1][m][1];
                u32x4 w;
                w.x = cvt_pk_bf16(silu_f(a0[0]) * u0[0], silu_f(a0[1]) * u0[1]); w.y = cvt_pk_bf16(silu_f(a0[2]) * u0[2], silu_f(a0[3]) * u0[3]);
                w.z = cvt_pk_bf16(silu_f(a1[0]) * u1[0], silu_f(a1[1]) * u1[1]); w.w = cvt_pk_bf16(silu_f(a1[2]) * u1[2], silu_f(a1[3]) * u1[3]);
                *(u32x4*)rowp = w; }
    }
};
struct EpiResid {
    static constexpr bool PERM = false, AFTER_DRAIN = false;
    const float* base; float* out; int ldc; const float* gate0; const float* gate1; int pm_split;
    __device__ __forceinline__ void operator()(const f32x4 (&acc)[2][2][4][2], const Unit& u, int wr, int wc, int fr, int fq) const {
        const int col0 = u.pn * BM + wc * 32 + 4 * fq; const float* g = (u.pm >= pm_split) ? gate1 : gate0;
        f32x4 gv[2][2];
#pragma unroll
        for (int bj = 0; bj < 2; ++bj)
#pragma unroll
            for (int n = 0; n < 2; ++n) gv[bj][n] = *(const f32x4*)(g + col0 + bj * HALF + n * 16);
#pragma unroll
        for (int ai = 0; ai < 2; ++ai) { f32x4 bs[4][2][2];
#pragma unroll
            for (int m = 0; m < 4; ++m) { const size_t off = (size_t)(u.pm * BM + ai * HALF + wr * 64 + m * 16 + fr) * ldc + col0;
#pragma unroll
                for (int bj = 0; bj < 2; ++bj)
#pragma unroll
                    for (int n = 0; n < 2; ++n) bs[m][bj][n] = *(const f32x4*)(base + off + bj * HALF + n * 16); }
#pragma unroll
            for (int m = 0; m < 4; ++m) { const size_t off = (size_t)(u.pm * BM + ai * HALF + wr * 64 + m * 16 + fr) * ldc + col0;
#pragma unroll
                for (int bj = 0; bj < 2; ++bj)
#pragma unroll
                    for (int n = 0; n < 2; ++n) *(f32x4*)(out + off + bj * HALF + n * 16) = bs[m][bj][n] + gv[bj][n] * acc[ai][bj][m][n]; }
            asm volatile("" ::: "memory"); }
    }
};

template <class Epi, class Sched, bool ALIGN_EPI = false, bool SP2 = false>
__device__ __forceinline__ void gemm_phase(PG8_LAS unsigned char* lds, const Gemm g, const Sched& S, const Epi& E, const int tid) {
    const int wid = __builtin_amdgcn_readfirstlane(tid >> 6), lane = tid & 63, wr = wid >> 2, wc = wid & 3, fr = lane & 15, fq = lane >> 4;
    const int K = g.K, nt = K / BK;
    unsigned voffA[2], voffB[2];
#pragma unroll
    for (int i = 0; i < 2; ++i) { int R, C; stage_rc(tid * 16 + i * 8192, R, C); const int Rb = Epi::PERM ? ((R & ~31) + perm32(R & 31)) : R;
        voffA[i] = (unsigned)(R * K + C) * 2u; voffB[i] = (unsigned)(Rb * K + C) * 2u; }
    const size_t kstep = (size_t)(BK * 2);
    const size_t hstep = (size_t)HALF * K * 2;
    const size_t tstep = 2 * hstep;
    const unsigned ldsw = (unsigned)wid * 1024u;
    const int aoff = lds_byte(wr * 64 + fr, fq * 8), boff = lds_byte(wc * 32 + fr, fq * 8);
#define PG8_SA(b, h) (((b) * 2 + (h)) * HTB)
#define PG8_SB(b, h) ((4 + (b) * 2 + (h)) * HTB)
#define PG8_STAGE(bufoff, gbase, voff) do { _Pragma("unroll") for (int _i = 0; _i < 2; ++_i) \
        __builtin_amdgcn_global_load_lds((const unsigned*)((const char*)(gbase) + (voff)[_i]), (PG8_LAS unsigned*)(lds + (bufoff) + ldsw + _i * 8192), 16, 0, 0); } while (0)
#define PG8_LDA(dst, b, h) do { _Pragma("unroll") for (int m = 0; m < 4; ++m) _Pragma("unroll") for (int k = 0; k < 2; ++k) dst[m][k] = *(const PG8_LAS bf16x8*)(lds + PG8_SA(b, h) + aoff + m * 2048 + k * 1024); } while (0)
#define PG8_LDB(dst, b, h) do { _Pragma("unroll") for (int n = 0; n < 2; ++n) _Pragma("unroll") for (int k = 0; k < 2; ++k) dst[n][k] = *(const PG8_LAS bf16x8*)(lds + PG8_SB(b, h) + boff + n * 2048 + k * 1024); } while (0)
#define PG8_MMA(ai, bj, At, Bt) do { __builtin_amdgcn_s_setprio(1); _Pragma("unroll") for (int m = 0; m < 4; ++m) _Pragma("unroll") for (int n = 0; n < 2; ++n) _Pragma("unroll") for (int k = 0; k < 2; ++k) \
        acc[ai][bj][m][n] = __builtin_amdgcn_mfma_f32_16x16x32_bf16(Bt[n][k], At[m][k], acc[ai][bj][m][n], 0, 0, 0); __builtin_amdgcn_s_setprio(0); } while (0)
#define PG8_WAIT_V(n) asm volatile("s_waitcnt vmcnt(" #n ")" ::: "memory")
#define PG8_WAIT_L(n) asm volatile("s_waitcnt lgkmcnt(" #n ")" ::: "memory")
#define PG8_BAR __builtin_amdgcn_s_barrier()
#define PG8_SCHED __builtin_amdgcn_sched_barrier(0)
    Unit cur, nxt; int ui = 0;
    if (!S.next(0, cur)) return;
    f32x4 acc[2][2][4][2];
#pragma unroll
    for (int a = 0; a < 2; ++a)
#pragma unroll
        for (int b = 0; b < 2; ++b)
#pragma unroll
            for (int m = 0; m < 4; ++m)
#pragma unroll
                for (int n = 0; n < 2; ++n) acc[a][b][m][n] = (f32x4){0.f, 0.f, 0.f, 0.f};
    bf16x8 At[4][2], B0[2][2], B1[2][2];
    const char* cA = (const char*)g.A + (size_t)cur.pm * tstep; const char* cB = (const char*)g.Bt + (size_t)cur.pn * tstep;
    S.a_ready(cur);
    if constexpr (SP2) {
        PG8_STAGE(PG8_SB(0, 0), cB, voffB); PG8_STAGE(PG8_SB(0, 1), cB + hstep, voffB); PG8_STAGE(PG8_SA(0, 0), cA, voffA); PG8_STAGE(PG8_SA(0, 1), cA + hstep, voffA);
        if (wr == 1) PG8_BAR;
        PG8_WAIT_V(2); PG8_BAR;
        PG8_STAGE(PG8_SB(1, 0), cB + kstep, voffB); PG8_STAGE(PG8_SA(1, 0), cA + kstep, voffA); PG8_STAGE(PG8_SB(1, 1), cB + hstep + kstep, voffB);
        PG8_WAIT_V(6); PG8_BAR;
    } else {
        PG8_STAGE(PG8_SB(0, 0), cB, voffB); PG8_STAGE(PG8_SA(0, 0), cA, voffA); PG8_STAGE(PG8_SB(0, 1), cB + hstep, voffB); PG8_STAGE(PG8_SA(0, 1), cA + hstep, voffA);
        if (wr == 1) PG8_BAR;
        PG8_WAIT_V(4); PG8_BAR;
        PG8_STAGE(PG8_SB(1, 0), cB + kstep, voffB); PG8_STAGE(PG8_SA(1, 0), cA + kstep, voffA); PG8_STAGE(PG8_SB(1, 1), cB + hstep + kstep, voffB);
        PG8_WAIT_V(6); PG8_BAR;
    }
    for (;;) {
        const bool has_next = S.next(ui + 1, nxt);
        const char* nA = has_next ? (const char*)g.A + (size_t)nxt.pm * tstep : cA; const char* nB = has_next ? (const char*)g.Bt + (size_t)nxt.pn * tstep : cB;
        for (int t = 0; t < nt; t += 2) {
            const bool last = (t == nt - 2);
            const char* a1 = cA + (size_t)(t + 1) * kstep;
            const char* a2 = last ? nA : cA + (size_t)(t + 2) * kstep; const char* b2 = last ? nB : cB + (size_t)(t + 2) * kstep;
            const char* a3 = a2 + kstep; const char* b3 = b2 + kstep;
            if (last && has_next) S.a_ready(nxt);
            if constexpr (SP2) {
            PG8_LDB(B0, 0, 0); PG8_LDB(B1, 0, 1); PG8_SCHED; PG8_LDA(At, 0, 0); PG8_STAGE(PG8_SA(1, 1), a1 + hstep, voffA);
            PG8_WAIT_V(8); PG8_WAIT_L(0); PG8_BAR; PG8_MMA(0, 0, At, B0); PG8_MMA(0, 1, At, B1); PG8_BAR; PG8_SCHED;
            PG8_LDA(At, 0, 1); PG8_STAGE(PG8_SB(0, 0), b2, voffB); PG8_STAGE(PG8_SB(0, 1), b2 + hstep, voffB); PG8_STAGE(PG8_SA(0, 0), a2, voffA);
            PG8_WAIT_V(8); PG8_WAIT_L(0); PG8_BAR; PG8_MMA(1, 0, At, B0); PG8_MMA(1, 1, At, B1); PG8_BAR; PG8_SCHED;
            PG8_LDB(B0, 1, 0); PG8_LDB(B1, 1, 1); PG8_SCHED; PG8_LDA(At, 1, 0); PG8_STAGE(PG8_SA(0, 1), a2 + hstep, voffA);
            PG8_WAIT_V(8); PG8_WAIT_L(0); PG8_BAR; PG8_MMA(0, 0, At, B0); PG8_MMA(0, 1, At, B1); PG8_BAR; PG8_SCHED;
            PG8_LDA(At, 1, 1); PG8_STAGE(PG8_SB(1, 0), b3, voffB); PG8_STAGE(PG8_SB(1, 1), b3 + hstep, voffB); PG8_STAGE(PG8_SA(1, 0), a3, voffA);
            PG8_WAIT_V(8); PG8_WAIT_L(0); PG8_BAR; PG8_MMA(1, 0, At, B0); PG8_MMA(1, 1, At, B1); PG8_BAR; PG8_SCHED;
            } else {
            PG8_LDB(B0, 0, 0); PG8_SCHED; PG8_LDA(At, 0, 0); PG8_STAGE(PG8_SA(1, 1), a1 + hstep, voffA);
            PG8_WAIT_L(8); PG8_BAR; PG8_WAIT_L(0); PG8_MMA(0, 0, At, B0); PG8_BAR; PG8_SCHED;
            PG8_LDB(B1, 0, 1); PG8_STAGE(PG8_SB(0, 0), b2, voffB);
            PG8_BAR; PG8_WAIT_L(0); PG8_MMA(0, 1, At, B1); PG8_BAR;
            PG8_LDA(At, 0, 1); PG8_STAGE(PG8_SA(0, 0), a2, voffA);
            PG8_BAR; PG8_WAIT_L(0); PG8_MMA(1, 0, At, B0); PG8_BAR; PG8_SCHED;
            PG8_STAGE(PG8_SB(0, 1), b2 + hstep, voffB);
            PG8_WAIT_V(6); PG8_BAR; PG8_MMA(1, 1, At, B1); PG8_BAR;
            PG8_LDB(B0, 1, 0); PG8_SCHED; PG8_LDA(At, 1, 0); PG8_STAGE(PG8_SA(0, 1), a2 + hstep, voffA);
            PG8_WAIT_L(8); PG8_BAR; PG8_WAIT_L(0); PG8_MMA(0, 0, At, B0); PG8_BAR; PG8_SCHED;
            PG8_LDB(B1, 1, 1); PG8_STAGE(PG8_SB(1, 0), b3, voffB);
            PG8_BAR; PG8_WAIT_L(0); PG8_MMA(0, 1, At, B1); PG8_BAR;
            PG8_LDA(At, 1, 1); PG8_STAGE(PG8_SA(1, 0), a3, voffA);
            PG8_BAR; PG8_WAIT_L(0); PG8_MMA(1, 0, At, B0); PG8_BAR; PG8_SCHED;
            PG8_STAGE(PG8_SB(1, 1), b3 + hstep, voffB);
            PG8_WAIT_V(6); PG8_BAR; PG8_MMA(1, 1, At, B1); PG8_BAR;
            }
        }
        if constexpr (ALIGN_EPI) { if (wr == 0) PG8_BAR; }
        if constexpr (!Epi::AFTER_DRAIN) { E(acc, cur, wr, wc, fr, fq); S.done(cur); }
        if (!has_next) break;
#pragma unroll
        for (int a = 0; a < 2; ++a)
#pragma unroll
            for (int b = 0; b < 2; ++b)
#pragma unroll
                for (int m = 0; m < 4; ++m)
#pragma unroll
                    for (int n = 0; n < 2; ++n) acc[a][b][m][n] = (f32x4){0.f, 0.f, 0.f, 0.f};
        cur = nxt; cA = nA; cB = nB; ++ui;
        if constexpr (ALIGN_EPI) { if (wr == 1) PG8_BAR; }
    }
    PG8_WAIT_V(0);
    if constexpr (!ALIGN_EPI) { if (wr == 0) PG8_BAR; }
    PG8_BAR;
    if constexpr (Epi::AFTER_DRAIN) { E.fused(acc, cur, wr, wc, fr, fq, lds, wid, lane); S.done(cur); }
#undef PG8_SA
#undef PG8_SB
#undef PG8_STAGE
#undef PG8_LDA
#undef PG8_LDB
#undef PG8_MMA
#undef PG8_WAIT_V
#undef PG8_WAIT_L
#undef PG8_BAR
#undef PG8_SCHED
}
}
namespace fox {
constexpr int D = 128, PITCH = 8192, OPITCH = 2048, SKV = 8192, GATE_OFF = 3072;
constexpr float THR = 8.f;
constexpr float SCALE = 0.08838834764831845f;
constexpr int NW = 8, QBLK = 32, KVBLK = 64, QB = NW * QBLK;
constexpr int SHM_V = KVBLK * D * 2, SHM_K = KVBLK * D * 2;
constexpr int BIAS_OFF = 2 * SHM_V + 2 * SHM_K + NW * 64 * 4;
constexpr int LDS_BYTES = BIAS_OFF + SKV * 4;

using bf16 = __hip_bfloat16;
typedef short bf16x8 __attribute__((ext_vector_type(8)));
typedef short s16x4 __attribute__((ext_vector_type(4)));
typedef float f32x16 __attribute__((ext_vector_type(16)));
typedef float f32x4 __attribute__((ext_vector_type(4)));
typedef unsigned u32x4 __attribute__((ext_vector_type(4)));

#define KSWZ(row, colB) ((row) * 256 + ((colB) ^ (((row) & 7) << 4)))
#define SBAR() __builtin_amdgcn_sched_barrier(0)
__device__ __forceinline__ int v_st(int k, int c) { const int kk = (k & ~0xC) | ((k & 4) << 1) | ((k & 8) >> 1); return ((kk >> 3) * 4 + (c >> 5)) * 512 + ((kk & 7) * 32 + (c & 31)) * 2; }
__device__ __forceinline__ int v_rd_base(int lane) { return ((lane & 3) << 3) | (((lane >> 2) & 3) << 6) | (((lane >> 4) & 1) << 5) | (((lane >> 5) & 1) << 8); }
constexpr int v_rd_off(int d0, int ks, int half) { return d0 * 512 + ks * 4096 + half * 2048; }
__device__ __forceinline__ int crow(int r, int hi) { return (r & 3) + 8 * (r >> 2) + 4 * hi; }
__device__ __forceinline__ unsigned cvtpk(float lo, float hi) {
    unsigned r; asm volatile("v_cvt_pk_bf16_f32 %0, %1, %2" : "=v"(r) : "v"(lo), "v"(hi)); return r;
}
__device__ __forceinline__ bf16x8 load8(const bf16* p) { return *reinterpret_cast<const bf16x8*>(p); }
__device__ __forceinline__ void mask_tile(f32x16& p0, f32x16& p1, int dq, unsigned W) {
    const float NEG = -__builtin_inff();
#pragma unroll
    for (int r = 0; r < 16; ++r) {
        const int c = (r & 3) + 8 * (r >> 2);
        if ((unsigned)(dq - c) >= W) p0[r] = NEG;
        if ((unsigned)(dq - c - 32) >= W) p1[r] = NEG;
    }
}
__device__ __forceinline__ void partialSM(f32x16& p0, f32x16& p1, float& m_reg, float& mn, float& alpha) {
    float pmax = p0[0]; for (int r = 1; r < 16; ++r) pmax = fmaxf(pmax, p0[r]); for (int r = 0; r < 16; ++r) pmax = fmaxf(pmax, p1[r]);
    { auto rr = __builtin_amdgcn_permlane32_swap(__float_as_uint(pmax), __float_as_uint(pmax), false, false);
      pmax = fmaxf(__uint_as_float(rr[0]), __uint_as_float(rr[1])); }
    constexpr float C2 = 1.4426950408889634f * SCALE;
    if (__builtin_expect(__all((pmax - m_reg) * SCALE <= THR), 1)) { mn = m_reg; alpha = 1.f; }
    else { mn = fmaxf(m_reg, pmax); alpha = __builtin_amdgcn_exp2f((m_reg - mn) * C2); m_reg = mn; }
    const float mnL = -mn * C2;
    for (int r = 0; r < 16; ++r) p0[r] = fmaf(p0[r], C2, mnL); for (int r = 0; r < 16; ++r) p1[r] = fmaf(p1[r], C2, mnL);
    for (int r = 0; r < 16; ++r) p0[r] = __builtin_amdgcn_exp2f(p0[r]);
}
__device__ __forceinline__ void finishSM(f32x16& p0, f32x16& p1, float alpha, float& l_reg, bf16x8& pa0, bf16x8& pa1, bf16x8& pa2, bf16x8& pa3) {
    for (int r = 0; r < 16; ++r) p1[r] = __builtin_amdgcn_exp2f(p1[r]);
    float ps = 0; for (int r = 0; r < 16; ++r) ps += p0[r]; for (int r = 0; r < 16; ++r) ps += p1[r];
    { auto rr = __builtin_amdgcn_permlane32_swap(__float_as_uint(ps), __float_as_uint(ps), false, false);
      ps = __uint_as_float(rr[0]) + __uint_as_float(rr[1]); }
    l_reg = l_reg * alpha + ps;
#define PK4(P, B_, OUT) do { unsigned a0 = cvtpk(P[B_+0], P[B_+1]), a1 = cvtpk(P[B_+2], P[B_+3]);                          \
        unsigned b0 = cvtpk(P[B_+4], P[B_+5]), b1 = cvtpk(P[B_+6], P[B_+7]);                                             \
        auto r0 = __builtin_amdgcn_permlane32_swap(a0, b0, false, false); auto r1 = __builtin_amdgcn_permlane32_swap(a1, b1, false, false); \
        u32x4 w = {r0[0], r1[0], r0[1], r1[1]}; OUT = *reinterpret_cast<bf16x8*>(&w); } while (0)
    PK4(p0, 0, pa0); PK4(p0, 8, pa1); PK4(p1, 0, pa2); PK4(p1, 8, pa3);
#undef PK4
}
template <int KB>
__device__ __forceinline__ void qkt(f32x16& p0, f32x16& p1, const char* K_lds, const float* bt, int r32, int hi, const bf16x8* qr) {
#pragma unroll
    for (int j = 0; j < 4; ++j) { const f32x4 a = *(const f32x4*)(bt + 8 * j), b = *(const f32x4*)(bt + 32 + 8 * j);
        p0[4 * j + 0] = a[0]; p0[4 * j + 1] = a[1]; p0[4 * j + 2] = a[2]; p0[4 * j + 3] = a[3];
        p1[4 * j + 0] = b[0]; p1[4 * j + 1] = b[1]; p1[4 * j + 2] = b[2]; p1[4 * j + 3] = b[3]; }
    const char* kb[4];
#pragma unroll
    for (int dd = 0; dd < 4; ++dd) kb[dd] = K_lds + KB * SHM_K + KSWZ(r32, (dd * 16 + hi * 8) * 2);
#pragma unroll
    for (int d0 = 0; d0 < 8; ++d0) { const char* a = kb[d0 & 3] + (d0 >> 2) * 128;
        bf16x8 b0 = *reinterpret_cast<const bf16x8*>(a);
        bf16x8 b1 = *reinterpret_cast<const bf16x8*>(a + 32 * 256);
        p0 = __builtin_amdgcn_mfma_f32_32x32x16_bf16(b0, qr[d0], p0, 0, 0, 0);
        p1 = __builtin_amdgcn_mfma_f32_32x32x16_bf16(b1, qr[d0], p1, 0, 0, 0); }
}
template <int VB>
__device__ __forceinline__ void pv_tile(f32x16* o, int vb0, bf16x8 pa0, bf16x8 pa1, bf16x8 pa2, bf16x8 pa3) {
#define TRRD(dst, off) asm volatile("ds_read_b64_tr_b16 %0, %1 offset:%2" : "=&v"(dst) : "v"(vb0), "i"(off) : "memory")
#define PV_D0(d0) do { s16x4 l0, l1, l2, l3, h0, h1, h2, h3; constexpr int b_ = VB * SHM_V + v_rd_off(d0, 0, 0);     \
        TRRD(l0, b_); TRRD(h0, b_ + 2048); TRRD(l1, b_ + 4096); TRRD(h1, b_ + 6144); TRRD(l2, b_ + 8192); TRRD(h2, b_ + 10240); TRRD(l3, b_ + 12288); TRRD(h3, b_ + 14336); \
        asm volatile("s_waitcnt lgkmcnt(0)" ::: "memory"); SBAR();                 \
        o[d0] = __builtin_amdgcn_mfma_f32_32x32x16_bf16(pa0, (bf16x8){l0[0], l0[1], l0[2], l0[3], h0[0], h0[1], h0[2], h0[3]}, o[d0], 0, 0, 0);   \
        o[d0] = __builtin_amdgcn_mfma_f32_32x32x16_bf16(pa1, (bf16x8){l1[0], l1[1], l1[2], l1[3], h1[0], h1[1], h1[2], h1[3]}, o[d0], 0, 0, 0);   \
        o[d0] = __builtin_amdgcn_mfma_f32_32x32x16_bf16(pa2, (bf16x8){l2[0], l2[1], l2[2], l2[3], h2[0], h2[1], h2[2], h2[3]}, o[d0], 0, 0, 0);   \
        o[d0] = __builtin_amdgcn_mfma_f32_32x32x16_bf16(pa3, (bf16x8){l3[0], l3[1], l3[2], l3[3], h3[0], h3[1], h3[2], h3[3]}, o[d0], 0, 0, 0); } while (0)
    PV_D0(0); PV_D0(1); PV_D0(2); PV_D0(3);
#undef PV_D0
#undef TRRD
}

struct BlockRef { const bf16* Q; const bf16* K; const bf16* V; bf16* O; const float* Bias; int P0; float THp; };
struct Seam { bf16x8 qr[8]; bf16x8 st_v0, st_v1, st_k0, st_k1; };
#define ROW(p, k0, rr) ((const bf16*)((const char*)(p) + (size_t)(k0) * (PITCH * 2) + (unsigned)(voff + (unsigned)(rr) * (PITCH * 2u))))
#define VMW() asm volatile("s_waitcnt vmcnt(0)" ::: "memory")
#define VMWN(n) asm volatile("s_waitcnt vmcnt(%0)" :: "i"(n) : "memory")
#define SLOAD_H(Kp, Vp, k0) do { S.st_v0 = load8(ROW(Vp, k0, 0)); S.st_v1 = load8(ROW(Vp, k0, 32));              \
                         S.st_k0 = load8(ROW(Kp, k0, 0)); S.st_k1 = load8(ROW(Kp, k0, 32)); } while (0)
#define SWRITE_HK(bf) do { *(bf16x8*)(K_lds + (bf) * SHM_K + kws) = S.st_k0; *(bf16x8*)(K_lds + (bf) * SHM_K + kws + 32 * 256) = S.st_k1; } while (0)
#define SWRITE_HV(bf) do { *(bf16x8*)(V_lds + (bf) * SHM_V + vst0) = S.st_v0; *(bf16x8*)(V_lds + (bf) * SHM_V + vst1) = S.st_v1; } while (0)
#define SWRITE_H(bf) do { SWRITE_HV(bf); SWRITE_HK(bf); } while (0)
__device__ __forceinline__ void fox_prime(const BlockRef& cur, char* lds, Seam& S, const int tid) {
    const int wid = __builtin_amdgcn_readfirstlane(tid >> 6), lane = tid & 63, r32 = lane & 31, hi = lane >> 5;
    const int sr = tid >> 4, sc = (tid & 15) * 8, kws = KSWZ(sr, sc * 2); char* K_lds = lds + 2 * SHM_V;
    const unsigned voff = (unsigned)(sr * PITCH + sc) * 2u, qoff = (unsigned)((wid * QBLK + r32) * PITCH + hi * 8) * 2u;
    for (int d0 = 0; d0 < 8; ++d0) S.qr[d0] = load8((const bf16*)((const char*)cur.Q + (qoff + d0 * 32)));
    (void)kws; (void)K_lds; (void)voff;
    __syncthreads();
}
__device__ __forceinline__ void fox_block(const BlockRef& cur, const BlockRef& nxt, char* lds, Seam& S, const int tid) {
    const int wid = __builtin_amdgcn_readfirstlane(tid >> 6), lane = tid & 63, r32 = lane & 31, hi = lane >> 5;
    const int W = SKV;
    const int NTF = (cur.P0 + QB - 1) / KVBLK + 1;
    const int qlo = cur.P0 + wid * QBLK, qm = qlo + r32 - 4 * hi;
    char* V_lds = lds; char* K_lds = lds + 2 * SHM_V;
    float* ws = (float*)(lds + 2 * SHM_V + 2 * SHM_K) + wid * 64; float* li_l = ws, * al_l = ws + 32;
    float* biasL = (float*)(lds + BIAS_OFF);
    { const int nk = cur.P0 + QB;
      int t4 = tid * 4; asm volatile("" : "+v"(t4));
      f32x4 bv[4];
#pragma unroll
      for (int k = 0; k < 4; ++k) { const int i = t4 + k * (NW * 64 * 4); if (i < nk) bv[k] = *(const f32x4*)((const char*)cur.Bias + (unsigned)(i * 4)); }
#pragma unroll
      for (int k = 0; k < 4; ++k) { const int i = t4 + k * (NW * 64 * 4); if (i < nk) *(f32x4*)(biasL + i) = bv[k]; }
      __syncthreads(); }
    int j_lo; { int lo_ = 0, hi_ = cur.P0 / KVBLK; const float bref = biasL[cur.P0] - cur.THp;
        while (lo_ < hi_) { const int mid = (lo_ + hi_) >> 1; if (biasL[mid * KVBLK + KVBLK - 1] < bref) lo_ = mid + 1; else hi_ = mid; }
        j_lo = __builtin_amdgcn_readfirstlane(lo_); }
    const int NT = NTF - j_lo;
    const float* bl = biasL + 4 * hi;
    float m_reg = -1e30f, l_reg = 0; f32x16 o[4] = {};
    const int sr = tid >> 4, sc = (tid & 15) * 8, vst0 = v_st(sr, sc), vst1 = v_st(32 + sr, sc), kws = KSWZ(sr, sc * 2);
    const unsigned voff = (unsigned)(sr * PITCH + sc) * 2u, qoff = (unsigned)((wid * QBLK + r32) * PITCH + hi * 8) * 2u;
    const int vb0 = (int)(uintptr_t)V_lds + v_rd_base(lane);
    const bf16* Kh = cur.K; const bf16* Vh = cur.V;
#define RESC(a) do { if (__any((a) < 1.f)) { if (hi == 0) al_l[r32] = (a); asm volatile("s_waitcnt lgkmcnt(0)" ::: "memory");              \
                     for (int d_ = 0; d_ < 4; ++d_) for (int r = 0; r < 16; ++r) o[d_][r] *= al_l[crow(r, hi)]; } } while (0)
#define KBASE(t) ((j_lo + (NT - 1 - (t))) * KVBLK)
#define MASKT(P0_, P1_, t) do { const int kb_ = KBASE(t); if (kb_ + KVBLK - 1 > qlo) mask_tile(P0_, P1_, qm - kb_, (unsigned)W); } while (0)
    constexpr int NQL = 8;
#define SEAM_K0() do { VMWN(NQL); SWRITE_HK(0); SBAR(); } while (0)
    f32x16 pA0, pA1, pB0, pB1; float mnA, mnB, alA, alB; bf16x8 pa0, pa1, pa2, pa3;
    SLOAD_H(Kh, Vh, KBASE(0)); VMW(); SWRITE_HK(0); SWRITE_HV(0); __syncthreads();
    SBAR();
    if (NT > 1) { SLOAD_H(Kh, Vh, KBASE(1)); }
    SBAR(); qkt<0>(pA0, pA1, K_lds, bl + KBASE(0), r32, hi, S.qr);
    MASKT(pA0, pA1, 0); partialSM(pA0, pA1, m_reg, mnA, alA);
    if (NT > 1) { VMW(); SWRITE_H(1); }
    __syncthreads();
#define HALF_STEP(PX0, PX1, mnX, alX, PY0, PY1, alY, t, KB, VB, SB) do {                                                      \
        SBAR(); qkt<KB>(PX0, PX1, K_lds, bl + KBASE(t), r32, hi, S.qr);                                             \
        finishSM(PY0, PY1, alY, l_reg, pa0, pa1, pa2, pa3); SBAR();                                                           \
        if ((t) + 1 < NT) { SLOAD_H(Kh, Vh, KBASE((t) + 1)); SBAR(); }                                               \
        pv_tile<VB>(o, vb0, pa0, pa1, pa2, pa3); MASKT(PX0, PX1, (t)); partialSM(PX0, PX1, m_reg, mnX, alX);                                        \
        __syncthreads();                                                                                                      \
        if ((t) + 1 < NT) { VMW(); SWRITE_H(SB); }                                                                          \
        RESC(alX); __syncthreads(); } while (0)
    for (int t = 1; t + 1 < NT; t += 2) {
        HALF_STEP(pB0, pB1, mnB, alB, pA0, pA1, alA, t, 1, 0, 0);
        HALF_STEP(pA0, pA1, mnA, alA, pB0, pB1, alB, t + 1, 0, 1, 1);
    }
    const bool even = (NT & 1) == 0;
    if (even) { SBAR(); qkt<1>(pB0, pB1, K_lds, bl + KBASE(NT - 1), r32, hi, S.qr); SBAR(); }
#pragma unroll
    for (int d0 = 0; d0 < 8; ++d0) S.qr[d0] = load8((const bf16*)((const char*)nxt.Q + (qoff + d0 * 32)));
    SBAR();
    finishSM(pA0, pA1, alA, l_reg, pa0, pa1, pa2, pa3); SBAR();
    pv_tile<0>(o, vb0, pa0, pa1, pa2, pa3);
    if (even) { MASKT(pB0, pB1, NT - 1); partialSM(pB0, pB1, m_reg, mnB, alB); __syncthreads(); RESC(alB);
        finishSM(pB0, pB1, alB, l_reg, pa0, pa1, pa2, pa3); SBAR(); pv_tile<1>(o, vb0, pa0, pa1, pa2, pa3); }
    SBAR();
    if (hi == 0) li_l[r32] = l_reg; asm volatile("s_waitcnt lgkmcnt(0)" ::: "memory");
    float rli[16];
#pragma unroll
    for (int r = 0; r < 16; ++r) rli[r] = __builtin_amdgcn_rcpf(li_l[crow(r, hi)]);
    char* Ow = (char*)cur.O; const unsigned ooff = (unsigned)((wid * QBLK + 4 * hi) * OPITCH + r32) * 2u;
    const char* Gq = (const char*)cur.Q + GATE_OFF * 2; const unsigned goff = (unsigned)((wid * QBLK + 4 * hi) * PITCH + r32) * 2u;
    unsigned short gq[16][4];
#pragma unroll
    for (int r = 0; r < 16; ++r)
#pragma unroll
        for (int d0 = 0; d0 < 4; ++d0) gq[r][d0] = *(const unsigned short*)(Gq + (goff + (unsigned)(((r & 3) + 8 * (r >> 2)) * PITCH + d0 * 32) * 2u));
#pragma unroll
    for (int r = 0; r < 16; ++r) {
#pragma unroll
        for (int d0 = 0; d0 < 4; ++d0) { const unsigned short gw = gq[r][d0];
            const float gl = __builtin_bit_cast(float, (unsigned)gw << 16);
            const float v = o[d0][r] * rli[r] * __builtin_amdgcn_rcpf(1.0f + __builtin_amdgcn_exp2f(-1.4426950408889634f * gl));
            const float vn = xor1_get(v);
            if ((r32 & 1) == 0) *(unsigned*)(Ow + (ooff + (unsigned)(((r & 3) + 8 * (r >> 2)) * OPITCH + d0 * 32) * 2u)) = cvtpk(v, vn); } }
    __syncthreads();
#undef RESC
#undef KBASE
#undef MASKT
#undef SEAM_K0
#undef HALF_STEP
}
#undef ROW
#undef VMW
#undef VMWN
#undef SLOAD_H
#undef SWRITE_HK
#undef SWRITE_HV
#undef SWRITE_H
#undef KSWZ
#undef SBAR
}

constexpr int NWAVES = 8, NTHREADS = NWAVES * 64;
constexpr int DM = 2048, BATCH = 2, T = 8192, M = BATCH * T, DEPTH = 4;
constexpr int AB_IN = 8200, AB_N = 8192;
constexpr int C_IN = 6160, C_N = 6144;
constexpr int FF = 5632, FF2 = 2 * FF;
constexpr float EPS = 1e-6f;
enum PhaseKind { K_NORM1 = 0, K_MIXIN, K_PREP, K_REC, K_POST, K_MIXOUT, K_NORM2, K_FFIN, K_FFOUT, K_PRO };
constexpr int phase_base(int layer) { return 1 + 9 * layer; }
constexpr int N_PHASES = phase_base(DEPTH) + 1;
constexpr int CW_QUEUE = 8192;
inline int phase_kind(int p, int& layer) { if (p == 0) { layer = 0; return K_PRO; } for (layer = DEPTH - 1; phase_base(layer) > p; --layer) {} return p - phase_base(layer); }
constexpr size_t MiB = 1u << 20;
constexpr size_t WS_CTL = 0, CTL_ZERO_BYTES = 1 * MiB;
constexpr size_t WS_MOD = 1 * MiB;
constexpr size_t WS_LOGF = 2 * MiB;
constexpr size_t WS_BIAS = 3 * MiB;
constexpr size_t WS_GLOW = 4 * MiB;
constexpr size_t WS_W_ABIN = 8 * MiB, WS_W_ABOUT = 72 * MiB, WS_W_GLIN = 88 * MiB, WS_W_GLOUT = 136 * MiB, WS_W_FFIN = 152 * MiB, WS_W_FFOUT = 328 * MiB;
constexpr size_t WS_H = 416 * MiB, WS_CAT = 480 * MiB, WS_PROJ = 544 * MiB, WS_FFH = WS_PROJ, WS_O = 800 * MiB, WS_REC = 928 * MiB, WS_Y = 1064 * MiB, WS_XB = 1128 * MiB, WS_END = 1192 * MiB;
constexpr int CW_BAR = 4096;
constexpr int CW_CONV = 16384;
constexpr int RING_OFF = 0, RING_BYTES = 139264;
constexpr int LDSCTL_OFF = RING_BYTES, MISC_OFF = LDSCTL_OFF + 320;
constexpr int LDS_BYTES = 155648;
static_assert(fox::LDS_BYTES <= RING_BYTES, "attention LDS");

#define GAS __attribute__((address_space(1)))
#define LAS __attribute__((address_space(3)))
typedef unsigned short bf16;
typedef unsigned v4u __attribute__((ext_vector_type(4)));
typedef unsigned v2u __attribute__((ext_vector_type(2)));
typedef float f32x4 __attribute__((ext_vector_type(4)));
typedef GAS unsigned gu32;
#define RLX_AGENT __ATOMIC_RELAXED, __HIP_MEMORY_SCOPE_AGENT
#define LDS_WAIT() asm volatile("s_waitcnt lgkmcnt(0)" ::: "memory")
__device__ __forceinline__ unsigned pk2(float lo, float hi) { unsigned r; asm("v_cvt_pk_bf16_f32 %0, %1, %2" : "=v"(r) : "v"(lo), "v"(hi)); return r; }
__device__ __forceinline__ unsigned f2bf(float f) { return pk2(f, f) & 0xffffu; }
__device__ __forceinline__ float bf_lo(unsigned w) { return __builtin_bit_cast(float, w << 16); }
__device__ __forceinline__ float bf_hi(unsigned w) { return __builtin_bit_cast(float, w & 0xffff0000u); }
__device__ __forceinline__ float bf1(bf16 h) { return __builtin_bit_cast(float, (unsigned)h << 16); }
__device__ __forceinline__ float sigmoid_f(float x) { return __builtin_amdgcn_rcpf(1.0f + __expf(-x)); }
__device__ __forceinline__ float silu_x(float x) { return x * __builtin_amdgcn_rcpf(1.0f + __expf(-x)); }
__device__ __forceinline__ float log_sigmoid_f(float x) { return fminf(x, 0.f) - log1pf(__expf(-fabsf(x))); }
__device__ __forceinline__ float log_sigmoid_fast(float x) { return fminf(x, 0.f) - __logf(1.0f + __expf(-fabsf(x))); }
__device__ __forceinline__ float wave_sum(float v) {
    v = xsum<1>(v); v = xsum<2>(v); v = xsum<4>(v); v = xsum<8>(v); v = xsum<16>(v); v = xsum<32>(v);
    return v;
}

#define XB_TMO      128
#define XB_XCNT(j)  (256  + 64 * (j))
#define XB_XSUB(j)  (1280 + 64 * (j))
#define XB_XGEN(j)  (2304 + 64 * (j))
#define XB_TOP      3328
#define XB_TOPGEN   3392
#define XCD_BAR_WORDS 3456
#define XB_SPIN_CAP (1u << 18)
__device__ __forceinline__ unsigned xb_ld(unsigned* p)              { return __hip_atomic_load(p, __ATOMIC_RELAXED, __HIP_MEMORY_SCOPE_AGENT); }
__device__ __forceinline__ unsigned xb_add(unsigned* p, unsigned v) { return __hip_atomic_fetch_add(p, v, __ATOMIC_RELAXED, __HIP_MEMORY_SCOPE_AGENT); }
__device__ __forceinline__ unsigned xb_xcc_id() { return (unsigned)__builtin_amdgcn_s_getreg((3 << 11) | 20) & 0xFu; }
#define XB_SPIN(cond, bar) do { unsigned _sp = 0; while (cond) { __builtin_amdgcn_s_sleep(1); \
    if ((++_sp & 255u) == 0u) { if (xb_ld(&(bar)[XB_TMO])) break; if (_sp > XB_SPIN_CAP) { atomicAdd(&(bar)[XB_TMO], 1u); break; } } } } while (0)
struct XcdBarrier { unsigned* bar; unsigned x; volatile LAS unsigned* st; };
__device__ __forceinline__ XcdBarrier xcd_barrier_post(unsigned* bar, volatile LAS unsigned* st, bool tid0) {
    XcdBarrier b; b.bar = bar; b.x = xb_xcc_id(); b.st = st;
    if (tid0) (void)xb_add(&bar[XB_XCNT(b.x)], 1u);
    return b;
}
__device__ __forceinline__ void xcd_barrier_complete(unsigned* bar, unsigned x, unsigned& nloc, unsigned& nx) {
    const unsigned G = gridDim.x * gridDim.y * gridDim.z;
    unsigned sum, cnt, mine, sp = 0u;
    for (;;) {
        sum = 0u; cnt = 0u; mine = 0u;
#pragma unroll
        for (unsigned j = 0; j < 16; ++j) { const unsigned c = xb_ld(&bar[XB_XCNT(j)]); sum += c; cnt += (c > 0u) ? 1u : 0u; mine = (j == x) ? c : mine; }
        if (sum == G) break;
        __builtin_amdgcn_s_sleep(1);
        if ((++sp & 255u) == 0u) { if (xb_ld(&bar[XB_TMO])) break; if (sp > XB_SPIN_CAP) { atomicAdd(&bar[XB_TMO], 1u); break; } }
    }
    nloc = mine > 0u ? mine : 1u; nx = cnt > 0u ? cnt : 1u;
}
template <bool FIRST>
__device__ __forceinline__ void xcd_barrier(const XcdBarrier& b, bool tid0) {
    asm volatile("s_waitcnt vmcnt(0)" ::: "memory");
    __syncthreads();
    if (tid0) {
        unsigned* bar = b.bar;
        __builtin_amdgcn_s_waitcnt(0);
        unsigned nloc = b.st[0], nx = b.st[1];
        if (FIRST) { if (nloc == 0u) { xcd_barrier_complete(bar, b.x, nloc, nx); b.st[0] = nloc; b.st[1] = nx; } }
        else { if (nloc == 0u) nloc = 1u; if (nx == 0u) nx = 1u; }
        const unsigned old = xb_add(&bar[XB_XSUB(b.x)], 1u);
        const unsigned gen = old / nloc;
        if (old + 1u == (gen + 1u) * nloc) {
            __builtin_amdgcn_fence(__ATOMIC_RELEASE, "agent");
            asm volatile("s_waitcnt vmcnt(0)" ::: "memory");
            const unsigned og = xb_add(&bar[XB_TOP], 1u);
            const unsigned tg = og / nx;
            if (og + 1u == (tg + 1u) * nx) xb_add(&bar[XB_TOPGEN], 1u);
            else XB_SPIN(xb_ld(&bar[XB_TOPGEN]) == tg, bar);
            __builtin_amdgcn_fence(__ATOMIC_ACQUIRE, "agent");
            xb_add(&bar[XB_XGEN(b.x)], 1u);
            asm volatile("s_waitcnt vmcnt(0)" ::: "memory");
        } else {
            XB_SPIN(xb_ld(&bar[XB_XGEN(b.x)]) == gen, bar);
            __builtin_amdgcn_fence(__ATOMIC_ACQUIRE, "agent");
            asm volatile("s_waitcnt vmcnt(0)" ::: "memory");
        }
    }
    __syncthreads();
}

struct Args { const float* in[20]; float* out; unsigned char* ws; int ph_lo, ph_hi, use_bar, pad; };
typedef const Args __attribute__((address_space(4))) CArgs;
__device__ __forceinline__ CArgs* opq_args() { CArgs* p = (CArgs*)__builtin_amdgcn_kernarg_segment_ptr(); asm volatile("" : "+s"(p)); return p; }
struct Frame {
    LAS unsigned char* lds;
    int tid, lane, wave, G, bid;
};

__device__ __forceinline__ void transpose_item(const float* W, int ldn, int K, bf16* WT, int k0, int n0, int drow0, LAS float* scr, int lane) {
    f32x4 v[16];
    const float* src = W + (size_t)(k0 + (lane >> 4)) * ldn + n0 + 4 * (lane & 15);
#pragma unroll
    for (int i = 0; i < 16; ++i) v[i] = *(const f32x4*)(src + (size_t)(4 * i) * ldn);
#pragma unroll
    for (int i = 0; i < 16; ++i) { LAS float* d = scr + (4 * i + (lane >> 4)) * 65 + 4 * (lane & 15); d[0] = v[i].x; d[1] = v[i].y; d[2] = v[i].z; d[3] = v[i].w; }
    LDS_WAIT(); asm volatile("" ::: "memory");
    const int c = lane & 7, r = lane >> 3;
#pragma unroll
    for (int j = 0; j < 8; ++j) { const int n = r + 8 * j; const LAS float* s = scr + (8 * c) * 65 + n;
        v4u o; o.x = pg8::cvt_pk_bf16(s[0 * 65], s[1 * 65]); o.y = pg8::cvt_pk_bf16(s[2 * 65], s[3 * 65]); o.z = pg8::cvt_pk_bf16(s[4 * 65], s[5 * 65]); o.w = pg8::cvt_pk_bf16(s[6 * 65], s[7 * 65]);
        *(GAS v4u*)(WT + (size_t)(drow0 + n) * K + k0 + 8 * c) = o; }
    LDS_WAIT(); asm volatile("" ::: "memory");
}
template <int MODE>
__device__ __forceinline__ void transpose_matrix(const float* W, int nmat, int K, int ldn, int ncols, bf16* WT, LAS float* scr, int gw, int NGW, int lane, unsigned* ctr = nullptr, int wave = 0, bool tid0 = false, volatile LAS unsigned* slot = nullptr) {
    const int nblk = ncols / 64, kblk = K / 64, per = nblk * kblk, total = per * nmat;
#define TM_ITEM(it) do { const int mat = (it) / per, r = (it) - mat * per, kb = r / nblk, nb = r - kb * nblk, n0 = 64 * nb; int drow0 = n0; \
        if (MODE == 1) { if (n0 < FF) drow0 = (n0 / 128) * 256 + (n0 % 128); else { const int n1 = n0 - FF; drow0 = (n1 / 128) * 256 + 128 + (n1 % 128); } } \
        if (MODE == 2) drow0 = n0 < 3072 ? n0 : (n0 < 4096 ? n0 + 4096 : n0 - 1024); \
        transpose_item(W + (size_t)mat * K * ldn, ldn, K, WT + (size_t)mat * ncols * K, 64 * kb, n0, drow0, scr, lane); } while (0)
    if (ctr == nullptr) { for (int it = gw; it < total; it += NGW) TM_ITEM(it); }
    else {
        unsigned pend = 0u; if (tid0) pend = __hip_atomic_fetch_add(ctr, 16u, __ATOMIC_RELAXED, __HIP_MEMORY_SCOPE_AGENT);
        for (;;) {
            if (tid0) *slot = pend;
            __syncthreads();
            const int base = __builtin_amdgcn_readfirstlane((int)*slot);
            __syncthreads();
            if (base >= total) break;
            if (tid0) pend = __hip_atomic_fetch_add(ctr, 16u, __ATOMIC_RELAXED, __HIP_MEMORY_SCOPE_AGENT);
#pragma unroll 1
            for (int k = 0; k < 2; ++k) { const int it = base + 8 * k + wave; if (it < total) TM_ITEM(it); } } }
#undef TM_ITEM
}
template <int SET>
__device__ __forceinline__ void convert_weights(CArgs* ap, LAS float* scr, int gw, int NGW, int lane, unsigned* ctr = nullptr, int wave = 0, bool tid0 = false, volatile LAS unsigned* slot = nullptr) {
#define CWC(k) (ctr ? ctr + 64 * (k) : nullptr), wave, tid0, slot
    unsigned char* ws = ap->ws;
    bf16* abin = (bf16*)(ws + WS_W_ABIN); bf16* about = (bf16*)(ws + WS_W_ABOUT); bf16* glin = (bf16*)(ws + WS_W_GLIN); bf16* glout = (bf16*)(ws + WS_W_GLOUT); bf16* ffin = (bf16*)(ws + WS_W_FFIN); bf16* ffout = (bf16*)(ws + WS_W_FFOUT);
    constexpr size_t S_ABIN_W = (size_t)DM * AB_IN, S_ABIN_T = (size_t)AB_N * DM, S_SQ = (size_t)DM * DM, S_GLIN_W = (size_t)DM * C_IN, S_GLIN_T = (size_t)C_N * DM, S_FFIN = (size_t)DM * FF2, S_FFOUT = (size_t)FF * DM;
    if (SET == 0) {
        transpose_matrix<2>(ap->in[6], 1, DM, AB_IN, AB_N, abin, scr, gw, NGW, lane);
        transpose_matrix<0>(ap->in[7], 1, DM, DM, DM, about, scr, gw, NGW, lane);
        transpose_matrix<1>(ap->in[18], 1, DM, FF2, FF2, ffin, scr, gw, NGW, lane);
        transpose_matrix<0>(ap->in[19], 1, FF, DM, DM, ffout, scr, gw, NGW, lane);
        transpose_matrix<0>(ap->in[13], 1, DM, C_IN, C_N, glin, scr, gw, NGW, lane);
    } else if (SET == 1) {
        transpose_matrix<0>(ap->in[17], 1, DM, DM, DM, glout, scr, gw, NGW, lane, CWC(0));
        transpose_matrix<1>(ap->in[18] + S_FFIN, 2, DM, FF2, FF2, ffin + S_FFIN, scr, gw, NGW, lane, CWC(1));
        transpose_matrix<0>(ap->in[19] + S_FFOUT, 2, FF, DM, DM, ffout + S_FFOUT, scr, gw, NGW, lane, CWC(2));
        transpose_matrix<2>(ap->in[6] + S_ABIN_W, 1, DM, AB_IN, AB_N, abin + S_ABIN_T, scr, gw, NGW, lane, CWC(3));
        transpose_matrix<0>(ap->in[7] + S_SQ, 1, DM, DM, DM, about + S_SQ, scr, gw, NGW, lane, CWC(4));
        transpose_matrix<0>(ap->in[13] + S_GLIN_W, 1, DM, C_IN, C_N, glin + S_GLIN_T, scr, gw, NGW, lane, CWC(5));
    } else {
        transpose_matrix<0>(ap->in[17] + S_SQ, 1, DM, DM, DM, glout + S_SQ, scr, gw, NGW, lane, CWC(8));
        transpose_matrix<1>(ap->in[18] + 3 * S_FFIN, 1, DM, FF2, FF2, ffin + 3 * S_FFIN, scr, gw, NGW, lane, CWC(9));
        transpose_matrix<0>(ap->in[19] + 3 * S_FFOUT, 1, FF, DM, DM, ffout + 3 * S_FFOUT, scr, gw, NGW, lane, CWC(10));
    }
#undef CWC
}
__device__ __forceinline__ void p0_prologue(Frame& F, CArgs* ap) {
    unsigned char* ws = ap->ws;
    {
        LAS float* sc = (LAS float*)(F.lds);
        LAS float* part = (LAS float*)(F.lds + 16384);
        const float* c = ap->in[1];
        for (int i = F.tid; i < 2 * DM; i += NTHREADS) sc[i] = silu_x(c[i]);
        __syncthreads();
        const float* mw = ap->in[2]; const float* mb = ap->in[3]; float* mod = (float*)(ws + WS_MOD);
        constexpr int NU = DEPTH * (6 * DM / 64);
        for (int u = F.bid; u < NU; u += F.G) {
            const int layer = u / (6 * DM / 64), colb = (u % (6 * DM / 64)) * 64, kk = F.lane >> 4, c4 = F.lane & 15;
            const float* wp = mw + ((size_t)layer * DM + F.wave * 256 + kk) * (6 * DM) + colb + 4 * c4;
            f32x4 a0 = {0.f, 0.f, 0.f, 0.f}, a1 = {0.f, 0.f, 0.f, 0.f};
            for (int i0 = 0; i0 < 64; i0 += 16) { f32x4 wv[16];
#pragma unroll
                for (int i = 0; i < 16; ++i) wv[i] = *(const f32x4*)(wp + (size_t)(4 * (i0 + i)) * (6 * DM));
#pragma unroll
                for (int i = 0; i < 16; ++i) { const int k = F.wave * 256 + 4 * (i0 + i) + kk; a0 = a0 + wv[i] * sc[k]; a1 = a1 + wv[i] * sc[DM + k]; } }
            a0.x = xsum<16>(a0.x); a0.x = xsum<32>(a0.x); a0.y = xsum<16>(a0.y); a0.y = xsum<32>(a0.y); a0.z = xsum<16>(a0.z); a0.z = xsum<32>(a0.z); a0.w = xsum<16>(a0.w); a0.w = xsum<32>(a0.w);
            a1.x = xsum<16>(a1.x); a1.x = xsum<32>(a1.x); a1.y = xsum<16>(a1.y); a1.y = xsum<32>(a1.y); a1.z = xsum<16>(a1.z); a1.z = xsum<32>(a1.z); a1.w = xsum<16>(a1.w); a1.w = xsum<32>(a1.w);
            if (F.lane < 16) { *(LAS f32x4*)(part + (F.wave * 2 + 0) * 64 + 4 * c4) = a0; *(LAS f32x4*)(part + (F.wave * 2 + 1) * 64 + 4 * c4) = a1; }
            __syncthreads();
            if (F.tid < 128) { const int b = F.tid >> 6, l = F.tid & 63; float s = 0.f;
#pragma unroll
                for (int w = 0; w < 8; ++w) s += part[(w * 2 + b) * 64 + l];
                const int cc = (u % (6 * DM / 64)) * 64 + l;
                mod[((size_t)layer * 2 + b) * (6 * DM) + cc] = s + mb[(size_t)layer * (6 * DM) + cc]; }
            __syncthreads();
        }
    }
    __syncthreads();
    LAS float* scr = (LAS float*)(F.lds + RING_OFF + F.wave * 16640);
    const int gw = F.bid * NWAVES + F.wave, NGW = F.G * NWAVES;
    convert_weights<0>(ap, scr, gw, NGW, F.lane);
}

template <int MASK> __device__ __forceinline__ float xget(float v) { return __builtin_bit_cast(float, __builtin_amdgcn_ds_swizzle(__builtin_bit_cast(int, v), (MASK << 10) | 0x1f)); }
template <int N> __device__ __forceinline__ float rs_reduce(float (&a)[N], int lane) {
    if (N == 16) {
#pragma unroll
        for (int i = 0; i < 8; ++i) { const bool up = lane & 1; const float keep = up ? a[i + 8] : a[i], send = up ? a[i] : a[i + 8]; a[i] = keep + xget<1>(send); } }
    if (N >= 8) {
#pragma unroll
        for (int i = 0; i < 4; ++i) { const bool up = lane & (N == 16 ? 2 : 1); const float keep = up ? a[i + 4] : a[i], send = up ? a[i] : a[i + 4]; a[i] = keep + (N == 16 ? xget<2>(send) : xget<1>(send)); } }
#pragma unroll
    for (int i = 0; i < 2; ++i) { const bool up = lane & (N == 16 ? 4 : 2); const float keep = up ? a[i + 2] : a[i], send = up ? a[i] : a[i + 2]; a[i] = keep + (N == 16 ? xget<4>(send) : xget<2>(send)); }
    { const bool up = lane & (N == 16 ? 8 : 4); const float keep = up ? a[1] : a[0], send = up ? a[0] : a[1]; a[0] = keep + (N == 16 ? xget<8>(send) : xget<4>(send)); }
    float r = a[0];
    if (N == 8) r = xsum<8>(r);
    r = xsum<16>(r); r = xsum<32>(r);
    return r;
}
template <int N> __device__ __forceinline__ int rs_col(int lane) { return N == 16 ? (((lane & 1) << 3) | ((lane & 2) << 1) | ((lane & 4) >> 1) | ((lane & 8) >> 3)) : (((lane & 1) << 2) | (lane & 2) | ((lane & 4) >> 2)); }
template <int NC, int MODE, bool RES, bool XF32>
__device__ __forceinline__ void norm_phase(Frame& F, const void* xin, const float* gain, const float* mod_sh, const float* mod_sc  ,
                                           bf16* hout, const float* Wsm, int ldn, const float* fbias, float* sout, const bf16* yres = nullptr, const float* rgate = nullptr, bf16* xb = nullptr) {
    LAS float* wl = (LAS float*)(F.lds);
    if (NC > 0) {
        for (int i = F.tid; i < NC * DM; i += NTHREADS) { const int k = i / NC, c = i % NC; wl[c * DM + k] = Wsm[(size_t)k * ldn + c]; }
        __syncthreads();
    }
    f32x4 gm[8], shv[8]; int bprev = -1;
    for (int mp = F.bid * NWAVES + F.wave; mp < M / 2; mp += F.G * NWAVES) {
        const int m0 = 2 * mp, b = m0 / T;
        if (b != bprev) { bprev = b; const f32x4* gp = (const f32x4*)gain + F.lane; const f32x4* shp = (const f32x4*)(mod_sh + (size_t)b * 6 * DM) + F.lane; const f32x4* scp = (const f32x4*)(mod_sc + (size_t)b * 6 * DM) + F.lane;
#pragma unroll
            for (int j = 0; j < 8; ++j) { gm[j] = gp[64 * j] * (scp[64 * j] + 1.0f); shv[j] = shp[64 * j]; } }
        f32x4 v[2][8]; float s0 = 0.f, s1 = 0.f;
        v2u yv[2][8];
        if (RES) { const GAS v2u* yr = (const GAS v2u*)(yres + (size_t)m0 * DM) + F.lane;
#pragma unroll
            for (int j = 0; j < 8; ++j) { yv[0][j] = yr[64 * j]; yv[1][j] = yr[512 + 64 * j]; } }
        if (XF32) { const GAS f32x4* xr = (const GAS f32x4*)((const float*)xin + (size_t)m0 * DM) + F.lane;
#pragma unroll
            for (int j = 0; j < 8; ++j) { v[0][j] = xr[64 * j]; v[1][j] = xr[512 + 64 * j]; } }
        else { const GAS v2u* xr = (const GAS v2u*)((const bf16*)xin + (size_t)m0 * DM) + F.lane; v2u xv[2][8];
#pragma unroll
            for (int j = 0; j < 8; ++j) { xv[0][j] = xr[64 * j]; xv[1][j] = xr[512 + 64 * j]; }
#pragma unroll
            for (int j = 0; j < 8; ++j) { v[0][j] = (f32x4){bf_lo(xv[0][j].x), bf_hi(xv[0][j].x), bf_lo(xv[0][j].y), bf_hi(xv[0][j].y)}; v[1][j] = (f32x4){bf_lo(xv[1][j].x), bf_hi(xv[1][j].x), bf_lo(xv[1][j].y), bf_hi(xv[1][j].y)}; } }
        if (RES) { const f32x4* rg = (const f32x4*)(rgate + (size_t)b * 6 * DM) + F.lane; GAS v2u* xo = (GAS v2u*)(xb + (size_t)m0 * DM) + F.lane;
#pragma unroll
            for (int j = 0; j < 8; ++j) { const f32x4 g = rg[64 * j];
                v[0][j] = v[0][j] + g * (f32x4){bf_lo(yv[0][j].x), bf_hi(yv[0][j].x), bf_lo(yv[0][j].y), bf_hi(yv[0][j].y)}; v[1][j] = v[1][j] + g * (f32x4){bf_lo(yv[1][j].x), bf_hi(yv[1][j].x), bf_lo(yv[1][j].y), bf_hi(yv[1][j].y)};
                v2u w; w.x = pk2(v[0][j].x, v[0][j].y); w.y = pk2(v[0][j].z, v[0][j].w); xo[64 * j] = w;
                w.x = pk2(v[1][j].x, v[1][j].y); w.y = pk2(v[1][j].z, v[1][j].w); xo[512 + 64 * j] = w; } }
#pragma unroll
        for (int j = 0; j < 8; ++j) { s0 += (v[0][j].x * v[0][j].x + v[0][j].y * v[0][j].y) + (v[0][j].z * v[0][j].z + v[0][j].w * v[0][j].w);
                                      s1 += (v[1][j].x * v[1][j].x + v[1][j].y * v[1][j].y) + (v[1][j].z * v[1][j].z + v[1][j].w * v[1][j].w); }
        const float rstd0 = __builtin_amdgcn_rsqf(wave_sum(s0) * (1.f / DM) + EPS), rstd1 = __builtin_amdgcn_rsqf(wave_sum(s1) * (1.f / DM) + EPS);
        GAS v2u* o8 = (GAS v2u*)(hout + (size_t)m0 * DM) + F.lane;
#pragma unroll
        for (int j = 0; j < 8; ++j) { const f32x4 g = gm[j], sh = shv[j];
            v[0][j] = (v[0][j] * rstd0) * g + sh; v[1][j] = (v[1][j] * rstd1) * g + sh;
            v2u w; w.x = pk2(v[0][j].x, v[0][j].y); w.y = pk2(v[0][j].z, v[0][j].w); o8[64 * j] = w;
            w.x = pk2(v[1][j].x, v[1][j].y); w.y = pk2(v[1][j].z, v[1][j].w); o8[512 + 64 * j] = w; }
        if constexpr (NC > 0) {
            float a0[NC], a1[NC];
#pragma unroll
            for (int c = 0; c < NC; ++c) { float acc0 = 0.f, acc1 = 0.f;
#pragma unroll
                for (int j = 0; j < 8; ++j) { const f32x4 w = *(const LAS f32x4*)(wl + c * DM + 256 * j + 4 * F.lane);
                    acc0 += (v[0][j].x * w.x + v[0][j].y * w.y) + (v[0][j].z * w.z + v[0][j].w * w.w); acc1 += (v[1][j].x * w.x + v[1][j].y * w.y) + (v[1][j].z * w.z + v[1][j].w * w.w); }
                a0[c] = acc0; a1[c] = acc1; __builtin_amdgcn_sched_barrier(0); }
            const float r0 = rs_reduce<NC>(a0, F.lane), r1 = rs_reduce<NC>(a1, F.lane); const int cc = rs_col<NC>(F.lane);
            if (MODE == 1) { const int t = m0 % T; if (F.lane < NC) { const float fb = fbias[cc]; sout[((size_t)b * 8 + cc) * T + t] = log_sigmoid_f(r0 + fb); sout[((size_t)b * 8 + cc) * T + t + 1] = log_sigmoid_f(r1 + fb); } }
            if (MODE == 2) { if (F.lane < NC) { sout[(size_t)m0 * 16 + cc] = r0; sout[(size_t)m0 * 16 + 16 + cc] = r1; } }
        }
    }
}

__device__ __forceinline__ void resid_final(Frame& F, const bf16* xb, const bf16* yres, const float* rgate, float* xout) {
    for (int mp = F.bid * NWAVES + F.wave; mp < M / 2; mp += F.G * NWAVES) {
        const int m0 = 2 * mp, b = m0 / T;
        const GAS v2u* xr = (const GAS v2u*)(xb + (size_t)m0 * DM) + F.lane; const GAS v2u* yr = (const GAS v2u*)(yres + (size_t)m0 * DM) + F.lane;
        const f32x4* rg = (const f32x4*)(rgate + (size_t)b * 6 * DM) + F.lane; GAS f32x4* xo = (GAS f32x4*)(xout + (size_t)m0 * DM) + F.lane;
        v2u xv[2][8], yv[2][8];
#pragma unroll
        for (int j = 0; j < 8; ++j) { xv[0][j] = xr[64 * j]; xv[1][j] = xr[512 + 64 * j]; yv[0][j] = yr[64 * j]; yv[1][j] = yr[512 + 64 * j]; }
#pragma unroll
        for (int j = 0; j < 8; ++j) { const f32x4 g = rg[64 * j];
            xo[64 * j] = (f32x4){bf_lo(xv[0][j].x), bf_hi(xv[0][j].x), bf_lo(xv[0][j].y), bf_hi(xv[0][j].y)} + g * (f32x4){bf_lo(yv[0][j].x), bf_hi(yv[0][j].x), bf_lo(yv[0][j].y), bf_hi(yv[0][j].y)};
            xo[512 + 64 * j] = (f32x4){bf_lo(xv[1][j].x), bf_hi(xv[1][j].x), bf_lo(xv[1][j].y), bf_hi(xv[1][j].y)} + g * (f32x4){bf_lo(yv[1][j].x), bf_hi(yv[1][j].x), bf_lo(yv[1][j].y), bf_hi(yv[1][j].y)}; }
    }
}

__device__ __forceinline__ void fox_prep(Frame& F, bf16* proj, const float* qg, const float* kg, const float* logf, float* bias) {
    const int gw = F.bid * NWAVES + F.wave, NGW = F.G * NWAVES;
    const f32x4 gq0 = *(const f32x4*)(qg + (F.lane & 15) * 8), gq1 = *(const f32x4*)(qg + (F.lane & 15) * 8 + 4), gk0 = *(const f32x4*)(kg + (F.lane & 15) * 8), gk1 = *(const f32x4*)(kg + (F.lane & 15) * 8 + 4);
    for (int m = gw; m < M; m += NGW) {
        GAS v4u* p = (GAS v4u*)(proj + (size_t)m * AB_N + 3072) + F.lane;
        v4u wv[4];
#pragma unroll
        for (int j = 0; j < 4; ++j) wv[j] = p[64 * j];
#pragma unroll
        for (int j = 0; j < 4; ++j) {
            const v4u w = wv[j];
            float e[8] = {bf_lo(w.x), bf_hi(w.x), bf_lo(w.y), bf_hi(w.y), bf_lo(w.z), bf_hi(w.z), bf_lo(w.w), bf_hi(w.w)};
            float s = 0.f;
#pragma unroll
            for (int i = 0; i < 8; ++i) s += e[i] * e[i];
            s = xsum<1>(s); s = xsum<2>(s); s = xsum<4>(s); s = xsum<8>(s);
            const float rstd = __builtin_amdgcn_rsqf(s * (1.f / 128.f) + EPS);
            const f32x4 g0 = j < 2 ? gq0 : gk0, g1 = j < 2 ? gq1 : gk1;
#pragma unroll
            for (int i = 0; i < 4; ++i) { e[i] = e[i] * rstd * g0[i]; e[4 + i] = e[4 + i] * rstd * g1[i]; }
            v4u o; o.x = pk2(e[0], e[1]); o.y = pk2(e[2], e[3]); o.z = pk2(e[4], e[5]); o.w = pk2(e[6], e[7]);
            p[64 * j] = o;
        }
    }
    if (F.bid < 16) {
        LAS double* tsum = (LAS double*)(F.lds);
        const float* lf = logf + (size_t)F.bid * T; float* bo = bias + (size_t)F.bid * T;
        double v[16]; double run = 0.0;
        const int i0 = F.tid * 16;
#pragma unroll
        for (int i = 0; i < 16; ++i) { run += (double)lf[i0 + i]; v[i] = run; }
        tsum[F.tid] = run;
        __syncthreads();
        LAS double* bsum = tsum + NTHREADS;
        if (F.tid < 8) { double s = 0.0; for (int w = 0; w < 64; ++w) s += tsum[F.tid * 64 + w]; bsum[F.tid] = s; }
        __syncthreads();
        double base = 0.0;
        for (int w = 0; w < F.wave; ++w) base += bsum[w];
        for (int w = 0; w < F.lane; ++w) base += tsum[F.wave * 64 + w];
        const double k = -11.313708498984761;
#pragma unroll
        for (int i = 0; i < 16; ++i) bo[i0 + i] = (float)((base + v[i]) * k);
        __syncthreads();
    }
}

#ifndef DBG_REC
#define DBG_REC 0
#endif
#if DBG_REC
template <bool GLA>
__device__ __forceinline__ void rec_naive(Frame& F, const bf16* proj, float* O, const float* lbl  , int lb_on,
                                          const float* glow, const float* wup  , const float* bgate  ) {
    constexpr int DK = GLA ? 256 : 128, DVH = GLA ? 512 : 128, NH = GLA ? 4 : 8, DVS = 32, NSL = DVH / DVS, TB = GLA ? 16 : 32;
    constexpr int PITCH = GLA ? C_N : AB_N, OPITCH = GLA ? 2048 : 1024;
    constexpr int R = DK / 16;
    constexpr int NPAIR = TB * DK / 2 / NTHREADS;
    constexpr int NUNITS = BATCH * NH * NSL;
    LAS float* sq = (LAS float*)(F.lds); LAS float* sf = sq + TB * DK; LAS float* sk = sf + TB * DK; LAS float* sv = sk + TB * DK; LAS float* part = sv + TB * DVS; LAS float* sgl = part + TB * 4 * DVS;
    const int lane = F.lane, e_l = lane & 15, dsub = lane >> 4, eg = F.wave & 1, dg = F.wave >> 1, e = eg * 16 + e_l, d0 = (dg * 4 + dsub) * R;
    for (int unit = F.bid; unit < NUNITS; unit += F.G) {
        const int sl = unit % NSL, h = (unit / NSL) % NH, b = unit / (NSL * NH);
        const bf16* pq = proj + (size_t)b * T * PITCH + h * DK;
        const bf16* pk = pq + 1024;
        const bf16* pv = proj + (size_t)b * T * PITCH + 2048 + h * DVH + sl * DVS;
        const int dp = 2 * (F.tid % (DK / 2)), tt0 = F.tid / (DK / 2); constexpr int TSTEP = NTHREADS / (DK / 2);
        float lb0 = 0.f, lb1 = 0.f; float wu0[16], wu1[16]; float bg0 = 0.f, bg1 = 0.f;
        if (!GLA) { if (lb_on) { const float l0a = lbl[h * DK + dp], l1a = lbl[1024 + h * DK + dp], l0b = lbl[h * DK + dp + 1], l1b = lbl[1024 + h * DK + dp + 1];
                                 lb0 = fminf(fmaxf(sigmoid_f(l1a - l0a), 0.f), 1.0f - 1e-6f); lb1 = fminf(fmaxf(sigmoid_f(l1b - l0b), 0.f), 1.0f - 1e-6f); } }
        else {
#pragma unroll
            for (int r = 0; r < 16; ++r) { wu0[r] = wup[r * 1024 + h * DK + dp]; wu1[r] = wup[r * 1024 + h * DK + dp + 1]; }
            bg0 = bgate[h * DK + dp]; bg1 = bgate[h * DK + dp + 1]; }
        const int vt = F.tid / 16, ve = 2 * (F.tid % 16); const bool vact = vt < TB;
        float S[R];
#pragma unroll
        for (int j = 0; j < R; ++j) S[j] = 0.f;
        unsigned rq[NPAIR], rk[NPAIR], rv = 0u; float rgl = 0.f;
#define REC_PREFETCH(t0) do { _Pragma("unroll") for (int i = 0; i < NPAIR; ++i) { const size_t row = (size_t)((t0) + tt0 + TSTEP * i); \
            rq[i] = *(const unsigned*)(pq + row * PITCH + dp); rk[i] = *(const unsigned*)(pk + row * PITCH + dp); \
            } \
            if (GLA && F.tid < TB * 16) rgl = glow[((size_t)b * T + (t0)) * 16 + F.tid]; \
            if (vact) rv = *(const unsigned*)(pv + (size_t)((t0) + vt) * PITCH + ve); } while (0)
        REC_PREFETCH(0);
        for (int t0 = 0; t0 < T; t0 += TB) {
            if (GLA) { if (F.tid < TB * 16) sgl[F.tid] = rgl; __syncthreads(); }
#pragma unroll
            for (int i = 0; i < NPAIR; ++i) { const int tt = tt0 + TSTEP * i; const float qa = bf_lo(rq[i]), qb = bf_hi(rq[i]), ka = bf_lo(rk[i]), kb = bf_hi(rk[i]);
                float q0, q1, f0, f1, k0, k1;
                if (!GLA) { q0 = silu_x(qa); q1 = silu_x(qb); const float s0 = sigmoid_f(ka), s1 = sigmoid_f(kb), n0 = sigmoid_f(-ka), n1 = sigmoid_f(-kb);
                    f0 = fmaxf(lb0 + (1.f - lb0) * s0, 1e-30f); f1 = fmaxf(lb1 + (1.f - lb1) * s1, 1e-30f); k0 = (1.f - lb0) * n0; k1 = (1.f - lb1) * n1; }
                else { q0 = qa * 0.0625f; q1 = qb * 0.0625f; k0 = ka; k1 = kb; float x0 = bg0, x1 = bg1;
#pragma unroll
                    for (int r = 0; r < 16; ++r) { const float g = sgl[tt * 16 + r]; x0 += g * wu0[r]; x1 += g * wu1[r]; }
                    f0 = __expf(log_sigmoid_f(x0) * 0.0625f); f1 = __expf(log_sigmoid_f(x1) * 0.0625f); }
                sq[tt * DK + dp] = q0; sq[tt * DK + dp + 1] = q1; sf[tt * DK + dp] = f0; sf[tt * DK + dp + 1] = f1; sk[tt * DK + dp] = k0; sk[tt * DK + dp + 1] = k1; }
            if (vact) { sv[vt * DVS + ve] = bf_lo(rv); sv[vt * DVS + ve + 1] = bf_hi(rv); }
            __syncthreads();
            if (t0 + TB < T) REC_PREFETCH(t0 + TB);
            for (int tt = 0; tt < TB; ++tt) {
                const float v = sv[tt * DVS + e]; float acc = 0.f;
#pragma unroll
                for (int g4 = 0; g4 < R / 4; ++g4) { const f32x4 f4 = *(const LAS f32x4*)(sf + tt * DK + d0 + 4 * g4), k4 = *(const LAS f32x4*)(sk + tt * DK + d0 + 4 * g4), q4 = *(const LAS f32x4*)(sq + tt * DK + d0 + 4 * g4);
#pragma unroll
                    for (int i = 0; i < 4; ++i) { S[4 * g4 + i] = f4[i] * S[4 * g4 + i] + k4[i] * v; acc += q4[i] * S[4 * g4 + i]; } }
                acc = xsum<16>(acc); acc = xsum<32>(acc);
                if (dsub == 0) part[(tt * 4 + dg) * DVS + e] = acc;
            }
            __syncthreads();
            for (int i = F.tid; i < TB * DVS; i += NTHREADS) { const int tt = i / DVS, ee = i % DVS;
                const float o = (part[(tt * 4 + 0) * DVS + ee] + part[(tt * 4 + 1) * DVS + ee]) + (part[(tt * 4 + 2) * DVS + ee] + part[(tt * 4 + 3) * DVS + ee]);
                O[((size_t)b * T + t0 + tt) * OPITCH + h * DVH + sl * DVS + ee] = o; }
        }
#undef REC_PREFETCH
        __syncthreads();
    }
}

#endif
#ifndef DBG_ZERO
#define DBG_ZERO 0
#endif
__device__ __forceinline__ void post_even(Frame& F, const bf16* O, const bf16* proj, const float* gain  , bf16* cat) {
    const int gw = F.bid * NWAVES + F.wave, NGW = F.G * NWAVES;
    f32x4 gn[4];
#pragma unroll
    for (int j = 0; j < 4; ++j) gn[j] = *((const f32x4*)gain + 64 * j + F.lane);
    for (int mp = gw; mp < M / 2; mp += NGW) {
        const int m = 2 * mp;
        const GAS v2u* op = (const GAS v2u*)(O + (size_t)m * 1024) + F.lane;
        const GAS v2u* ga = (const GAS v2u*)(proj + (size_t)m * AB_N + 7168) + F.lane;
        GAS v2u* cp = (GAS v2u*)(cat + (size_t)m * DM) + F.lane;
        v2u vr[2][4], gr[2][4];
#pragma unroll
        for (int r = 0; r < 2; ++r)
#pragma unroll
            for (int j = 0; j < 4; ++j) { vr[r][j] = op[r * 256 + 64 * j]; gr[r][j] = ga[r * (AB_N / 4) + 64 * j]; }
#pragma unroll
        for (int r = 0; r < 2; ++r)
#pragma unroll
        for (int j = 0; j < 4; ++j) {
            const f32x4 v = {bf_lo(vr[r][j].x), bf_hi(vr[r][j].x), bf_lo(vr[r][j].y), bf_hi(vr[r][j].y)}; float s = (v.x * v.x + v.y * v.y) + (v.z * v.z + v.w * v.w);
            s = xsum<1>(s); s = xsum<2>(s); s = xsum<4>(s); s = xsum<8>(s); s = xsum<16>(s);
            const float rstd = __builtin_amdgcn_rsqf(s * (1.f / 128.f) + EPS);
            const f32x4 g = gn[j];
            const v2u gw2 = gr[r][j];
            const float o0 = v.x * rstd * g.x * silu_x(bf_lo(gw2.x)), o1 = v.y * rstd * g.y * silu_x(bf_hi(gw2.x)), o2 = v.z * rstd * g.z * silu_x(bf_lo(gw2.y)), o3 = v.w * rstd * g.w * silu_x(bf_hi(gw2.y));
            v2u w; w.x = pk2(o0, o1); w.y = pk2(o2, o3); cp[r * 512 + 64 * j] = w;
        }
    }
}
__device__ __forceinline__ void post_odd(Frame& F, const bf16* O, const bf16* proj, const float* gain  , bf16* cat) {
    const int gw = F.bid * NWAVES + F.wave, NGW = F.G * NWAVES;
    const f32x4 gn0 = *((const f32x4*)gain + F.lane), gn1 = *((const f32x4*)gain + 64 + F.lane);
    for (int mp = gw; mp < M / 2; mp += NGW) {
        const int m = 2 * mp;
        const GAS v2u* op = (const GAS v2u*)(O + (size_t)m * DM) + F.lane;
        const GAS v2u* gg = (const GAS v2u*)(proj + (size_t)m * C_N + 4096) + F.lane;
        GAS v2u* cp = (GAS v2u*)(cat + (size_t)m * DM) + F.lane;
        v2u vr[2][8], gr[2][8];
#pragma unroll
        for (int r = 0; r < 2; ++r)
#pragma unroll
            for (int j = 0; j < 8; ++j) { vr[r][j] = op[r * 512 + 64 * j]; gr[r][j] = gg[r * (C_N / 4) + 64 * j]; }
#pragma unroll
        for (int r = 0; r < 2; ++r)
#pragma unroll
        for (int hh = 0; hh < 4; ++hh) {
            const v2u r0 = vr[r][2 * hh], r1 = vr[r][2 * hh + 1]; const f32x4 v0 = {bf_lo(r0.x), bf_hi(r0.x), bf_lo(r0.y), bf_hi(r0.y)}, v1 = {bf_lo(r1.x), bf_hi(r1.x), bf_lo(r1.y), bf_hi(r1.y)};
            float s = ((v0.x * v0.x + v0.y * v0.y) + (v0.z * v0.z + v0.w * v0.w)) + ((v1.x * v1.x + v1.y * v1.y) + (v1.z * v1.z + v1.w * v1.w));
            s = wave_sum(s);
            const float rstd = __builtin_amdgcn_rsqf(s * (1.f / 512.f) + EPS);
#pragma unroll
            for (int jj = 0; jj < 2; ++jj) { const f32x4 v = jj ? v1 : v0; const f32x4 g = jj ? gn1 : gn0; const v2u gw2 = gr[r][2 * hh + jj];
                const float o0 = v.x * rstd * g.x * silu_x(bf_lo(gw2.x)), o1 = v.y * rstd * g.y * silu_x(bf_hi(gw2.x)), o2 = v.z * rstd * g.z * silu_x(bf_lo(gw2.y)), o3 = v.w * rstd * g.w * silu_x(bf_hi(gw2.y));
                v2u w; w.x = pk2(o0, o1); w.y = pk2(o2, o3); cp[r * 512 + 64 * (2 * hh + jj)] = w; }
        }
    }
}

__device__ __forceinline__ fox::BlockRef fox_ref(int item, const bf16* proj, bf16* cat, const float* bias, float thp) {
    const int bh = item & 15, qb = 31 - (item >> 4), b = bh >> 3, h = bh & 7;
    fox::BlockRef r;
    const bf16* base = proj + (size_t)b * T * AB_N + h * 128;
    r.Q = (const fox::bf16*)(base + (size_t)qb * 256 * AB_N + 3072); r.K = (const fox::bf16*)(base + 4096); r.V = (const fox::bf16*)(base + 5120);
    r.O = (fox::bf16*)(cat + ((size_t)b * T + (size_t)qb * 256) * DM + 1024 + h * 128);
    r.Bias = bias + (size_t)bh * T; r.P0 = qb * 256; r.THp = thp;
    return r;
}
__device__ __forceinline__ int fox_fetch(Frame& F, unsigned* ctr, volatile LAS unsigned* slot) {
    if (F.tid == 0) *slot = __hip_atomic_fetch_add(ctr, 1u, __ATOMIC_RELAXED, __HIP_MEMORY_SCOPE_AGENT);
    __syncthreads();
    const int v = __builtin_amdgcn_readfirstlane((int)*slot);
    __syncthreads();
    return v;
}
__device__ __forceinline__ void fox_phase(Frame& F, char* lds, const bf16* proj, bf16* cat, const float* bias, unsigned* ctr, const float* qg, const float* kg) {
    constexpr int TOTAL = 512;
    float gqm = 0.f, gkm = 0.f;
    for (int i = 0; i < 128; ++i) { gqm = fmaxf(gqm, fabsf(qg[i])); gkm = fmaxf(gkm, fabsf(kg[i])); }
    const float thp = 2.0f * (128.0f * 1.02f * gqm * gkm) + (128.0f + 12.0f + 6.0f) / (1.4426950408889634f * fox::SCALE);
    volatile LAS unsigned* slot = (volatile LAS unsigned*)(F.lds + MISC_OFF) + 16;
    int ci = fox_fetch(F, ctr, slot); if (ci >= TOTAL) return;
    fox::BlockRef cur = fox_ref(ci, proj, cat, bias, thp);
    fox::Seam S;
    fox::fox_prime(cur, lds, S, F.tid);
    for (;;) {
        const int ni = fox_fetch(F, ctr, slot); const bool last = ni >= TOTAL;
        const fox::BlockRef nxt = last ? cur : fox_ref(ni, proj, cat, bias, thp);
        fox::fox_block(cur, nxt, lds, S, F.tid);
        if (last) break;
        cur = nxt;
    }
}

template <bool GLA> struct RecCfg {
    static constexpr int DK = GLA ? 256 : 128, DVH = GLA ? 512 : 128, NH = GLA ? 4 : 8, CH = 32, NCH = T / CH, PITCH = GLA ? C_N : AB_N, OPITCH = GLA ? 2048 : 1024;
    static constexpr int QP = DK + 16;
    static constexpr int QT_B = ((CH * QP * 2 + 1023) / 1024) * 1024, KT_B = DK * CH * 2, P_B = CH * CH * 2, A_B = 1024, VT_B = DVH * CH * 2;
    static constexpr int OFF_QT = 0, OFF_KT = QT_B, OFF_P = OFF_KT + KT_B, OFF_A = OFF_P + P_B, OFF_VT = OFF_A + A_B, UNIT_B = OFF_VT + VT_B;
    static constexpr int NSL = DVH / 128, BUF_B = OFF_VT + 8192, NP1 = OFF_VT / 1024, NP = NP1 + 8, NR = (NP + 7) / 8;
    static_assert(A_B >= DK * 4 && OFF_VT % 1024 == 0, "rec layout");
};
typedef short rbf16x8 __attribute__((ext_vector_type(8)));
__device__ __forceinline__ rbf16x8 rpack8(f32x4 a, f32x4 b) { v4u w; w.x = pg8::cvt_pk_bf16(a.x, a.y); w.y = pg8::cvt_pk_bf16(a.z, a.w); w.z = pg8::cvt_pk_bf16(b.x, b.y); w.w = pg8::cvt_pk_bf16(b.z, b.w); return __builtin_bit_cast(rbf16x8, w); }

template <bool GLA>
__device__ __forceinline__ void rec_prep(Frame& F, const bf16* proj, unsigned char* rec, const float* lbl, int lb_on, const float* glow, const float* wup, const float* bgate) {
    using C = RecCfg<GLA>;
    constexpr int DK = C::DK, DVH = C::DVH, NH = C::NH, CH = C::CH, NCH = C::NCH, PITCH = C::PITCH, QP = C::QP;
    constexpr int NSEG = NTHREADS / DK, TPS = CH / NSEG;
    constexpr int NSEGV = NTHREADS / DVH, TPV = CH / NSEGV;
    LAS float* segtot = (LAS float*)F.lds;
    LAS bf16* qm = (LAS bf16*)(F.lds + 2048);
    LAS bf16* km = qm + CH * QP;
    LAS float* sgl = (LAS float*)(F.lds + 2048 + 2 * CH * QP * 2);
    const int d = F.tid % DK, seg = F.tid / DK, lane = F.lane, el = lane & 15, q4 = lane >> 4;
    const int x = d & 31, y = x & 15, pos = (d & ~31) + 8 * (y >> 2) + (y & 3) + 4 * (x >> 4);
    constexpr int NUNITS = BATCH * NH * NCH, NBH = BATCH * NH;
    float lb = 0.f, bg = 0.f; float wu[16]; int hprev = -1;
    unsigned short rq[TPS], rk[TPS]; unsigned rvv[TPV / 2]; float rgl = 0.f;
    unsigned short rvr[GLA ? 1 : TPV];
    const int ev = F.tid % DVH, sv = F.tid / DVH;
    const unsigned toff = (unsigned)(seg * TPS) * (unsigned)(PITCH * 2) + (unsigned)d * 2u, voff = (unsigned)(sv * TPV) * (unsigned)(PITCH * 2) + (unsigned)ev * 2u;
#define PREP_LOAD(un) do { const int c_ = (un) / NBH, bh_ = (un) % NBH; const size_t row_ = (size_t)(bh_ / NH) * T + (size_t)c_ * CH; const int h_ = bh_ % NH; \
        const char* ubq_ = (const char*)(proj + row_ * PITCH + h_ * DK); const char* ubv_ = (const char*)(proj + row_ * PITCH + 2048 + h_ * DVH); (void)ubv_; \
        if (GLA) rgl = glow[row_ * 16 + F.tid];     \
        _Pragma("unroll") for (int i = 0; i < TPS; ++i) { const char* rb_ = ubq_ + (size_t)i * (PITCH * 2);     \
            rq[i] = *(const bf16*)(rb_ + toff); rk[i] = *(const bf16*)(rb_ + 2048 + toff); } \
        if (!GLA) { _Pragma("unroll") for (int i = 0; i < TPV; ++i) rvr[i] = *(const bf16*)((ubv_ + (size_t)i * (PITCH * 2)) + voff); } \
        } while (0)
    if (F.bid < NUNITS) PREP_LOAD(F.bid);
    for (int unit = F.bid; unit < NUNITS; unit += F.G) {
        const int c = unit / NBH, bh = unit % NBH, h = bh % NH, b = bh / NH;
        const size_t row0 = (size_t)b * T + (size_t)c * CH;
        if (h != hprev) { hprev = h;
            if (!GLA) { lb = 0.f; if (lb_on) lb = fminf(fmaxf(sigmoid_f(lbl[1024 + h * DK + d] - lbl[h * DK + d]), 0.f), 1.0f - 1e-6f); }
            else {
#pragma unroll
                for (int r = 0; r < 16; ++r) wu[r] = wup[r * 1024 + h * DK + d];
                bg = bgate[h * DK + d]; } }
        if (GLA) { sgl[F.tid] = rgl; __syncthreads(); }
        float qv[TPS], kv[TPS], G[TPS]; float run = 0.f;
#pragma unroll
        for (int i = 0; i < TPS; ++i) { const int t = seg * TPS + i; const float qa = bf1(rq[i]), ka = bf1(rk[i]); float g;
            if (!GLA) { qv[i] = silu_x(qa); const float ez = __expf(-fabsf(ka)), rz = __builtin_amdgcn_rcpf(1.0f + ez), big = rz, small = ez * rz;
                const float sg = ka >= 0.f ? big : small, ng = ka >= 0.f ? small : big; const float f = fmaxf(lb + (1.f - lb) * sg, 1e-30f); g = __logf(f); kv[i] = (1.f - lb) * ng; }
            else { qv[i] = qa * 0.0625f; kv[i] = ka; float xx = bg;
#pragma unroll
                for (int r = 0; r < 16; ++r) xx += sgl[t * 16 + r] * wu[r];
                g = log_sigmoid_fast(xx) * 0.0625f; }
            run += g; G[i] = run; }
        segtot[seg * DK + d] = run;
        __syncthreads();
        float off = 0.f, tot = 0.f, rmid = 0.f;
#pragma unroll
        for (int s = 0; s < NSEG; ++s) { const float v = segtot[s * DK + d]; tot += v; if (s < seg) off += v; if (s < 16 / TPS) rmid += v; }
        unsigned char* ub = rec + (size_t)(bh * NCH + c) * C::UNIT_B;
        bf16* QT = (bf16*)(ub + C::OFF_QT); bf16* KT = (bf16*)(ub + C::OFF_KT); bf16* Pb = (bf16*)(ub + C::OFF_P); float* Ab = (float*)(ub + C::OFF_A); bf16* VT = (bf16*)(ub + C::OFF_VT);
        unsigned kt[TPS / 2];
#pragma unroll
        for (int i = 0; i < TPS; i += 2) { float kh[2];
#pragma unroll
            for (int u = 0; u < 2; ++u) { const int t = seg * TPS + i + u; const float Gt = G[i + u] + off;
                QT[t * QP + pos] = (bf16)f2bf(qv[i + u] * __expf(Gt)); kh[u] = kv[i + u] * __expf(tot - Gt);
                qm[t * QP + d] = (bf16)f2bf(qv[i + u] * __expf(fminf(Gt - rmid, 80.f))); km[t * QP + d] = (bf16)f2bf(kv[i + u] * __expf(fminf(rmid - Gt, 80.f))); }
            kt[i / 2] = pk2(kh[0], kh[1]); }
#pragma unroll
        for (int j = 0; j < TPS / 8; ++j) { v4u w; w.x = kt[4 * j]; w.y = kt[4 * j + 1]; w.z = kt[4 * j + 2]; w.w = kt[4 * j + 3]; *(v4u*)(KT + d * CH + ((seg * TPS + 8 * j) ^ ((d & 8) << 1))) = w; }
        if (seg == NSEG - 1) Ab[d] = __expf(tot);
        { bf16* vt_ = VT + ev * CH;
          if (GLA) { const char* ubv_ = (const char*)(proj + row0 * PITCH + 2048 + h * DVH);
#pragma unroll
              for (int i = 0; i < TPV; i += 2) rvv[i / 2] = (unsigned)*(const bf16*)(ubv_ + (voff + (unsigned)i * (unsigned)(PITCH * 2))) | ((unsigned)*(const bf16*)(ubv_ + (voff + (unsigned)(i + 1) * (unsigned)(PITCH * 2))) << 16); }
          else {
#pragma unroll
              for (int i = 0; i < TPV; i += 2) rvv[i / 2] = (unsigned)rvr[i] | ((unsigned)rvr[i + 1] << 16); }
#pragma unroll
          for (int j = 0; j < TPV / 8; ++j) { v4u w; w.x = rvv[4 * j]; w.y = rvv[4 * j + 1]; w.z = rvv[4 * j + 2]; w.w = rvv[4 * j + 3];
              *(v4u*)(vt_ + ((sv * TPV + 8 * j) ^ ((ev & 8) << 1))) = w; } }
        if (unit + F.G < NUNITS) PREP_LOAD(unit + F.G);
        __syncthreads();
        if (F.wave < 3) { const int tt = F.wave >= 1, st = F.wave == 2; f32x4 acc = {0.f, 0.f, 0.f, 0.f};
#pragma unroll
            for (int i = 0; i < DK / 32; ++i) { const rbf16x8 a = *(const LAS rbf16x8*)(km + (16 * st + el) * QP + 32 * i + 8 * q4), bq = *(const LAS rbf16x8*)(qm + (16 * tt + el) * QP + 32 * i + 8 * q4);
                acc = __builtin_amdgcn_mfma_f32_16x16x32_bf16(a, bq, acc, 0, 0, 0); }
            const int ta = 16 * tt + el, s0 = 16 * st + 4 * q4;
            const float p0 = s0 + 0 <= ta ? acc[0] : 0.f, p1 = s0 + 1 <= ta ? acc[1] : 0.f, p2 = s0 + 2 <= ta ? acc[2] : 0.f, p3 = s0 + 3 <= ta ? acc[3] : 0.f;
            v2u w; w.x = pk2(p0, p1); w.y = pk2(p2, p3); *(v2u*)(Pb + ta * CH + (s0 ^ ((ta & 8) << 1))) = w; }
        else if (F.wave == 3) { v2u w; w.x = 0u; w.y = 0u; *(v2u*)(Pb + el * CH + ((16 + 4 * q4) ^ ((el & 8) << 1))) = w; }
        __syncthreads();
    }
#undef PREP_LOAD
}

template <bool GLA>
__device__ __forceinline__ void rec_seq(Frame& F, const unsigned char* rec, float* O, const bf16* proj, const float* gain, bf16* cat) {
    using C = RecCfg<GLA>;
    constexpr int DK = C::DK, DVH = C::DVH, NH = C::NH, CH = C::CH, NCH = C::NCH, QP = C::QP, NSL = C::NSL, NDT = DK / 16, NKS = DK / 32;
    constexpr int NBUF = 3, PF = NBUF - 1;
    constexpr int BUFG = C::BUF_B + (GLA ? 0 : 8192);
    constexpr int NWAIT = (PF - 1) * ((C::NR - 1) + (GLA ? 0 : 1) + 2);
    static_assert(NBUF * BUFG + 2048 <= RING_BYTES, "rec ring");
    constexpr int NUNITS = BATCH * NH * NSL;
    const int lane = F.lane, el = lane & 15, q4 = lane >> 4, wave = F.wave;
    for (int unit = F.bid; unit < NUNITS; unit += F.G) {
        const int sl = unit % NSL, h = (unit / NSL) % NH, b = unit / (NSL * NH);
        const unsigned char* ubase = rec + (size_t)((b * NH + h) * NCH) * C::UNIT_B;
#define REC_DMA(cc) do { const unsigned char* ub_ = ubase + (size_t)(cc) * C::UNIT_B; const int bufi_ = (cc) % NBUF; _Pragma("unroll") for (int r_ = 0; r_ < C::NR; ++r_) { const int p_ = r_ * 8 + wave; \
            if (p_ < C::NP) { const unsigned char* src_ = ub_ + (p_ < C::NP1 ? p_ * 1024 : C::OFF_VT + sl * 8192 + (p_ - C::NP1) * 1024) + lane * 16; \
                __builtin_amdgcn_global_load_lds((const unsigned*)src_, (LAS unsigned*)(F.lds + bufi_ * BUFG + p_ * 1024), 16, 0, 0); } } \
            if (!GLA) { const unsigned char* gsrc_ = (const unsigned char*)(proj + ((size_t)b * T + (size_t)(cc) * CH + 4 * wave + (lane >> 4)) * AB_N + 3072 + h * DVH) + (lane & 15) * 16; \
                __builtin_amdgcn_global_load_lds((const unsigned*)gsrc_, (LAS unsigned*)(F.lds + bufi_ * BUFG + C::BUF_B + wave * 1024), 16, 0, 0); } } while (0)
        f32x4 S[NDT];
#pragma unroll
        for (int i = 0; i < NDT; ++i) S[i] = (f32x4){0.f, 0.f, 0.f, 0.f};
#pragma unroll
        for (int cc = 0; cc < PF; ++cc) REC_DMA(cc);
        float* Ob = O + ((size_t)b * T) * C::OPITCH + h * DVH + sl * 128 + 16 * wave + 4 * q4;
        LAS float* ssq = (LAS float*)(F.lds + NBUF * BUFG);
        f32x4 oprev[2] = {{0.f, 0.f, 0.f, 0.f}, {0.f, 0.f, 0.f, 0.f}};
        v2u gsave[2] = {{0u, 0u}, {0u, 0u}};
        const unsigned ecol = (unsigned)(h * DVH + 16 * wave + 4 * q4);
        f32x4 gn4 = {1.f, 1.f, 1.f, 1.f}; if (!GLA) gn4 = *(const f32x4*)(gain + ecol);
#define REC_FINISH(cp) do { _Pragma("unroll") for (int tt = 0; tt < 2; ++tt) { const int tl = 16 * tt + el; float tot = 0.f; \
            _Pragma("unroll") for (int w_ = 0; w_ < 8; ++w_) tot += ssq[(((cp) & 1) * 8 + w_) * 32 + tl]; \
            const float rstd = 1.0f / sqrtf(tot * (1.f / 128.f) + EPS); const size_t row_ = (size_t)b * T + (size_t)(cp) * CH + tl; \
            const v2u gw_ = gsave[tt]; const f32x4 ov = oprev[tt]; \
            v2u w_o; w_o.x = pk2(ov.x * rstd * gn4.x * silu_x(bf_lo(gw_.x)), ov.y * rstd * gn4.y * silu_x(bf_hi(gw_.x))); \
            w_o.y = pk2(ov.z * rstd * gn4.z * silu_x(bf_lo(gw_.y)), ov.w * rstd * gn4.w * silu_x(bf_hi(gw_.y))); \
            *(v2u*)(cat + row_ * DM + ecol) = w_o; } } while (0)
        for (int c = 0; c < NCH; ++c) {
            if (c <= PF) asm volatile("s_waitcnt vmcnt(0)" ::: "memory"); else asm volatile("s_waitcnt vmcnt(%0)" :: "i"(NWAIT) : "memory");
            asm volatile("s_waitcnt lgkmcnt(0)" ::: "memory"); __builtin_amdgcn_s_barrier(); asm volatile("" ::: "memory");
            if (!GLA) {
                if (c > 0) REC_FINISH(c - 1);
                else { v2u z; z.x = 0u; z.y = 0u; *(v2u*)(cat + ((size_t)b * T + el) * DM + ecol) = z; *(v2u*)(cat + ((size_t)b * T + 16 + el) * DM + ecol) = z; }
            }
            if (c + PF < NCH) REC_DMA(c + PF); else REC_DMA(NCH - 1);
            const LAS unsigned char* L = F.lds + (c % NBUF) * BUFG;
            rbf16x8 sf[NKS];
#pragma unroll
            for (int i = 0; i < NKS; ++i) sf[i] = rpack8(S[2 * i], S[2 * i + 1]);
            f32x4 o[2];
#pragma unroll
            for (int tt = 0; tt < 2; ++tt) { o[tt] = (f32x4){0.f, 0.f, 0.f, 0.f};
#pragma unroll
                for (int i = 0; i < NKS; ++i) { const rbf16x8 qf = *(const LAS rbf16x8*)(L + C::OFF_QT + ((16 * tt + el) * QP + 32 * i + 8 * q4) * 2);
                    o[tt] = __builtin_amdgcn_mfma_f32_16x16x32_bf16(sf[i], qf, o[tt], 0, 0, 0); } }
            const rbf16x8 vf = *(const LAS rbf16x8*)(L + C::OFF_VT + ((16 * wave + el) * CH + 8 * q4) * 2);
#pragma unroll
            for (int tt = 0; tt < 2; ++tt) { const rbf16x8 pf = *(const LAS rbf16x8*)(L + C::OFF_P + ((16 * tt + el) * CH + 8 * q4) * 2);
                o[tt] = __builtin_amdgcn_mfma_f32_16x16x32_bf16(vf, pf, o[tt], 0, 0, 0); }
#pragma unroll
            for (int dt = 0; dt < NDT; ++dt) { const f32x4 a4 = *(const LAS f32x4*)(L + C::OFF_A + (16 * dt + 4 * q4) * 4); S[dt] = S[dt] * a4;
                const rbf16x8 kf = *(const LAS rbf16x8*)(L + C::OFF_KT + ((16 * dt + el) * CH + 8 * q4) * 2);
                S[dt] = __builtin_amdgcn_mfma_f32_16x16x32_bf16(kf, vf, S[dt], 0, 0, 0); }
            if (GLA) {
#pragma unroll
                for (int tt = 0; tt < 2; ++tt) *(f32x4*)(Ob + (size_t)(c * CH + 16 * tt + el) * C::OPITCH) = o[tt];
            } else {
#pragma unroll
                for (int tt = 0; tt < 2; ++tt) { float p = (o[tt].x * o[tt].x + o[tt].y * o[tt].y) + (o[tt].z * o[tt].z + o[tt].w * o[tt].w); p = xsum<16>(p); p = xsum<32>(p);
                    if (q4 == 0) ssq[((c & 1) * 8 + wave) * 32 + 16 * tt + el] = p; oprev[tt] = o[tt];
                    gsave[tt] = *(const LAS v2u*)(L + C::BUF_B + ((16 * tt + el) * 128 + 16 * wave + 4 * q4) * 2); }
            }
        }
        asm volatile("s_waitcnt vmcnt(0)" ::: "memory"); __syncthreads();
        if (!GLA) { REC_FINISH(NCH - 1); }
        __syncthreads();
#undef REC_FINISH
#undef REC_DMA
    }
}

template <bool GLA>
__device__ __forceinline__ void rec_seq2(Frame& F, const unsigned char* rec, bf16* O) {
    using C = RecCfg<GLA>;
    constexpr int DK = C::DK, DVH = C::DVH, NH = C::NH, CH = C::CH, NCH = C::NCH, QP = C::QP;
    constexpr int NDH = DK / 32, NKH = DK / 64;
    constexpr int ES = 64, NSL = DVH / ES, BUF2 = C::OFF_VT + ES * CH * 2, NP1 = C::OFF_VT / 1024, NP = NP1 + ES * CH * 2 / 1024, NR = NP / 8;
    constexpr int NBUF = GLA ? 3 : 5, PF = NBUF - 1, NWAIT = (PF - 1) * (NR + 1);
    static_assert(NP % 8 == 0 && NBUF * BUF2 + 2 * 8 * 1024 <= RING_BYTES, "rec_seq2 ring");
    constexpr int NUNITS = BATCH * NH * NSL;
    const int lane = F.lane, el = lane & 15, q4 = lane >> 4, wave = F.wave, eg = wave & 3, dg = wave >> 2;
    LAS unsigned char* xch = F.lds + NBUF * BUF2;
    for (int unit = F.bid; unit < NUNITS; unit += F.G) {
        const int sl = unit % NSL, h = (unit / NSL) % NH, b = unit / (NSL * NH);
        const unsigned char* ubase = rec + (size_t)((b * NH + h) * NCH) * C::UNIT_B;
#define G2_DMA(cc) do { const unsigned char* ub_ = ubase + (size_t)(cc) * C::UNIT_B; const int bufi_ = (cc) % NBUF; _Pragma("unroll") for (int r_ = 0; r_ < NR; ++r_) { const int p_ = r_ * 8 + wave; \
            const unsigned char* src_ = ub_ + (p_ < NP1 ? p_ * 1024 : C::OFF_VT + sl * (ES * CH * 2) + (p_ - NP1) * 1024) + lane * 16; \
            __builtin_amdgcn_global_load_lds((const unsigned*)src_, (LAS unsigned*)(F.lds + bufi_ * BUF2 + p_ * 1024), 16, 0, 0); } } while (0)
        f32x4 S[NDH];
#pragma unroll
        for (int i = 0; i < NDH; ++i) S[i] = (f32x4){0.f, 0.f, 0.f, 0.f};
#pragma unroll
        for (int cc = 0; cc < PF; ++cc) G2_DMA(cc);
        bf16* Ob = O + ((size_t)b * T + 16 * dg + el) * C::OPITCH + h * DVH + sl * ES + 16 * eg + 4 * q4;
#define G2_ST(p_, v_) do { const f32x4 v4_ = (v_); v2u w2_; w2_.x = pg8::cvt_pk_bf16(v4_.x, v4_.y); w2_.y = pg8::cvt_pk_bf16(v4_.z, v4_.w); *(v2u*)(p_) = w2_; } while (0)
        f32x4 okeep = {0.f, 0.f, 0.f, 0.f};
        for (int c = 0; c < NCH; ++c) {
            if (c <= PF) asm volatile("s_waitcnt vmcnt(0)" ::: "memory"); else asm volatile("s_waitcnt vmcnt(%0)" :: "i"(NWAIT) : "memory");
            asm volatile("s_waitcnt lgkmcnt(0)" ::: "memory"); __builtin_amdgcn_s_barrier(); asm volatile("" ::: "memory");
            if (c + PF < NCH) G2_DMA(c + PF); else G2_DMA(NCH - 1);
            const LAS unsigned char* L = F.lds + (c % NBUF) * BUF2;
            rbf16x8 qf[2][NKH], kf[NDH]; f32x4 a4[NDH];
#pragma unroll
            for (int tt = 0; tt < 2; ++tt)
#pragma unroll
                for (int i = 0; i < NKH; ++i) qf[tt][i] = *(const LAS rbf16x8*)(L + C::OFF_QT + ((16 * tt + el) * QP + 32 * (NKH * dg + i) + 8 * q4) * 2);
            const int sw8 = (8 * q4) ^ ((el & 8) << 1);
            const rbf16x8 vf = *(const LAS rbf16x8*)(L + C::OFF_VT + ((16 * eg + el) * CH + sw8) * 2);
            const rbf16x8 pf = *(const LAS rbf16x8*)(L + C::OFF_P + ((16 * dg + el) * CH + sw8) * 2);
#pragma unroll
            for (int j = 0; j < NDH; ++j) { kf[j] = *(const LAS rbf16x8*)(L + C::OFF_KT + ((16 * (NDH * dg + j) + el) * CH + sw8) * 2); a4[j] = *(const LAS f32x4*)(L + C::OFF_A + (16 * (NDH * dg + j) + 4 * q4) * 4); }
            rbf16x8 sf[NKH];
#pragma unroll
            for (int i = 0; i < NKH; ++i) sf[i] = rpack8(S[2 * i], S[2 * i + 1]);
            f32x4 o[2];
#pragma unroll
            for (int tt = 0; tt < 2; ++tt) { o[tt] = (f32x4){0.f, 0.f, 0.f, 0.f};
#pragma unroll
                for (int i = 0; i < NKH; ++i) o[tt] = __builtin_amdgcn_mfma_f32_16x16x32_bf16(sf[i], qf[tt][i], o[tt], 0, 0, 0); }
            if (dg == 0) o[0] = __builtin_amdgcn_mfma_f32_16x16x32_bf16(vf, pf, o[0], 0, 0, 0); else o[1] = __builtin_amdgcn_mfma_f32_16x16x32_bf16(vf, pf, o[1], 0, 0, 0);
#pragma unroll
            for (int j = 0; j < NDH; ++j) { S[j] = S[j] * a4[j]; S[j] = __builtin_amdgcn_mfma_f32_16x16x32_bf16(kf[j], vf, S[j], 0, 0, 0); }
            if (c > 0) { const f32x4 pr = *(const LAS f32x4*)(xch + ((((c - 1) & 1) * 8 + (wave ^ 4)) * 64 + lane) * 16);
                         G2_ST(Ob + (size_t)((c - 1) * CH) * C::OPITCH, okeep + pr); }
            else { G2_ST(Ob, okeep); }
            *(LAS f32x4*)(xch + (((c & 1) * 8 + wave) * 64 + lane) * 16) = dg == 0 ? o[1] : o[0];
            okeep = dg == 0 ? o[0] : o[1];
        }
        asm volatile("s_waitcnt vmcnt(0) lgkmcnt(0)" ::: "memory"); __syncthreads();
        { const f32x4 pr = *(const LAS f32x4*)(xch + ((((NCH - 1) & 1) * 8 + (wave ^ 4)) * 64 + lane) * 16); G2_ST(Ob + (size_t)((NCH - 1) * CH) * C::OPITCH, okeep + pr); }
        __syncthreads();
#undef G2_ST
#undef G2_DMA
    }
}

template <bool GLA>
__device__ __forceinline__ void rec_seq3(Frame& F, const unsigned char* rec, bf16* O) {
    using C = RecCfg<GLA>;
    constexpr int DK = C::DK, DVH = C::DVH, NH = C::NH, CH = C::CH, NCH = C::NCH, QP = C::QP;
    constexpr int NDH = DK / 32, NKH = DK / 64;
    constexpr int ES = 64, NSL = DVH / ES, BUF2 = C::OFF_VT + ES * CH * 2, NP1 = C::OFF_VT / 1024, NP = NP1 + ES * CH * 2 / 1024, NRL = NP / 4;
    constexpr int NBUF = GLA ? 3 : 5, PF = NBUF - 1, NWAIT = (PF - 1) * NRL;
    static_assert(NP % 4 == 0 && NBUF * BUF2 + 2 * 8 * 1024 <= RING_BYTES && NWAIT < 64, "rec_seq3 ring");
    constexpr int NUNITS = BATCH * NH * NSL;
    const int lane = F.lane, el = lane & 15, q4 = lane >> 4, wave = F.wave;
    LAS unsigned char* xch = F.lds + NBUF * BUF2;
    for (int unit = F.bid; unit < NUNITS; unit += F.G) {
        const int bh = unit % (BATCH * NH), sl = unit / (BATCH * NH), h = bh % NH, b = bh / NH;
        const unsigned char* ubase = rec + (size_t)((b * NH + h) * NCH) * C::UNIT_B;
        const int eg2 = wave & 1, dg = (wave >> 1) & 1;
        bf16* Ob = O + ((size_t)b * T + 16 * dg + el) * C::OPITCH + h * DVH + sl * ES + 32 * eg2 + 4 * q4;
        f32x4 okeep[2] = {{0.f, 0.f, 0.f, 0.f}, {0.f, 0.f, 0.f, 0.f}};
#define G3_ST(p_, v_) do { const f32x4 v4_ = (v_); v2u w2_; w2_.x = pg8::cvt_pk_bf16(v4_.x, v4_.y); w2_.y = pg8::cvt_pk_bf16(v4_.z, v4_.w); *(v2u*)(p_) = w2_; } while (0)
        if (wave >= 4) {
            const int lw = wave - 4;
#define G3_DMA(cc) do { const unsigned char* ub_ = ubase + (size_t)(cc) * C::UNIT_B; const int bufi_ = (cc) % NBUF; _Pragma("unroll") for (int r_ = 0; r_ < NRL; ++r_) { const int p_ = r_ * 4 + lw; \
            const unsigned char* src_ = ub_ + (p_ < NP1 ? p_ * 1024 : C::OFF_VT + sl * (ES * CH * 2) + (p_ - NP1) * 1024) + lane * 16; \
            __builtin_amdgcn_global_load_lds((const unsigned*)src_, (LAS unsigned*)(F.lds + bufi_ * BUF2 + p_ * 1024), 16, 0, 0); } } while (0)
#pragma unroll
            for (int cc = 0; cc < PF; ++cc) G3_DMA(cc);
            for (int c = 0; c < NCH; ++c) {
                asm volatile("s_waitcnt vmcnt(%0)" :: "i"(NWAIT) : "memory");
                __builtin_amdgcn_s_barrier(); asm volatile("" ::: "memory");
                if (c + PF < NCH) G3_DMA(c + PF); else G3_DMA(NCH - 1);
            }
            asm volatile("s_waitcnt vmcnt(0)" ::: "memory");
#undef G3_DMA
        } else {
            f32x4 S[NDH][2];
#pragma unroll
            for (int i = 0; i < NDH; ++i) { S[i][0] = (f32x4){0.f, 0.f, 0.f, 0.f}; S[i][1] = (f32x4){0.f, 0.f, 0.f, 0.f}; }
            const int sw8 = (8 * q4) ^ ((el & 8) << 1);
            for (int c = 0; c < NCH; ++c) {
                asm volatile("s_waitcnt lgkmcnt(0)" ::: "memory"); __builtin_amdgcn_s_barrier(); asm volatile("" ::: "memory");
                const LAS unsigned char* L = F.lds + (c % NBUF) * BUF2;
                rbf16x8 qf[2][NKH], kf[NDH], vf[2]; f32x4 a4[NDH];
#pragma unroll
                for (int tt = 0; tt < 2; ++tt)
#pragma unroll
                    for (int i = 0; i < NKH; ++i) qf[tt][i] = *(const LAS rbf16x8*)(L + C::OFF_QT + ((16 * tt + el) * QP + 32 * (NKH * dg + i) + 8 * q4) * 2);
#pragma unroll
                for (int et = 0; et < 2; ++et) vf[et] = *(const LAS rbf16x8*)(L + C::OFF_VT + ((32 * eg2 + 16 * et + el) * CH + sw8) * 2);
                const rbf16x8 pf = *(const LAS rbf16x8*)(L + C::OFF_P + ((16 * dg + el) * CH + sw8) * 2);
#pragma unroll
                for (int j = 0; j < NDH; ++j) { kf[j] = *(const LAS rbf16x8*)(L + C::OFF_KT + ((16 * (NDH * dg + j) + el) * CH + sw8) * 2); a4[j] = *(const LAS f32x4*)(L + C::OFF_A + (16 * (NDH * dg + j) + 4 * q4) * 4); }
                f32x4 o[2][2];
#pragma unroll
                for (int et = 0; et < 2; ++et) { rbf16x8 sf[NKH];
#pragma unroll
                    for (int i = 0; i < NKH; ++i) sf[i] = rpack8(S[2 * i][et], S[2 * i + 1][et]);
#pragma unroll
                    for (int tt = 0; tt < 2; ++tt) { o[tt][et] = (f32x4){0.f, 0.f, 0.f, 0.f};
#pragma unroll
                        for (int i = 0; i < NKH; ++i) o[tt][et] = __builtin_amdgcn_mfma_f32_16x16x32_bf16(sf[i], qf[tt][i], o[tt][et], 0, 0, 0); } }
#pragma unroll
                for (int et = 0; et < 2; ++et) { if (dg == 0) o[0][et] = __builtin_amdgcn_mfma_f32_16x16x32_bf16(vf[et], pf, o[0][et], 0, 0, 0); else o[1][et] = __builtin_amdgcn_mfma_f32_16x16x32_bf16(vf[et], pf, o[1][et], 0, 0, 0); }
#pragma unroll
                for (int j = 0; j < NDH; ++j)
#pragma unroll
                    for (int et = 0; et < 2; ++et) { S[j][et] = S[j][et] * a4[j]; S[j][et] = __builtin_amdgcn_mfma_f32_16x16x32_bf16(kf[j], vf[et], S[j][et], 0, 0, 0); }
                if (c > 0) {
#pragma unroll
                    for (int et = 0; et < 2; ++et) { const f32x4 pr = *(const LAS f32x4*)(xch + (((((c - 1) & 1) * 4 + (wave ^ 2)) * 2 + et) * 64 + lane) * 16);
                        G3_ST(Ob + (size_t)((c - 1) * CH) * C::OPITCH + 16 * et, okeep[et] + pr); } }
#pragma unroll
                for (int et = 0; et < 2; ++et) { *(LAS f32x4*)(xch + ((((c & 1) * 4 + wave) * 2 + et) * 64 + lane) * 16) = dg == 0 ? o[1][et] : o[0][et]; okeep[et] = dg == 0 ? o[0][et] : o[1][et]; }
            }
        }
        asm volatile("s_waitcnt vmcnt(0) lgkmcnt(0)" ::: "memory"); __syncthreads();
        if (wave < 4) {
#pragma unroll
            for (int et = 0; et < 2; ++et) { const f32x4 pr = *(const LAS f32x4*)(xch + (((((NCH - 1) & 1) * 4 + (wave ^ 2)) * 2 + et) * 64 + lane) * 16);
                G3_ST(Ob + (size_t)((NCH - 1) * CH) * C::OPITCH + 16 * et, okeep[et] + pr); } }
        __syncthreads();
#undef G3_ST
    }
}
#define WSP(T_, off) ((T_*)(ws + (off)))
#define REFRAME() CArgs* ap = opq_args(); unsigned char* ws = ap->ws; (void)ws; \
    F.lds = (LAS unsigned char*)lds; F.tid = opq_tid(wave_s); F.lane = F.tid & 63; F.wave = __builtin_amdgcn_readfirstlane(F.tid >> 6); F.G = gridDim.x; F.bid = opq_bid()
#ifndef DBG_DOUBLE
#define DBG_DOUBLE 0
#endif
#define NREP(bit) ((DBG_DOUBLE & (bit)) ? 2 : 1)
#define REPBAR(rep, n) do { if ((rep) + 1 < (n)) xcd_barrier<false>(bar, F.tid == 0); } while (0)
#define IN(k) (lo <= (k) && (k) < hi)
#define SEAM(k) do { if (IN(k) && IN((k) + 1)) xcd_barrier<false>(bar, F.tid == 0); } while (0)
template <int layer>
__device__ __forceinline__ void layer_phases(unsigned char* lds, const int wave_s, const int lo, const int hi, const XcdBarrier& bar) {
    Frame F;

        constexpr int pb = phase_base(layer); constexpr bool odd = layer & 1; constexpr int li = layer >> 1;
        constexpr int P_NORM1 = pb, P_MIXIN = pb + 1, P_PREP = pb + 2, P_REC = pb + 3, P_POST = pb + 4, P_MIXOUT = pb + 5, P_NORM2 = P_MIXOUT + 1, P_FFIN = P_MIXOUT + 2, P_FFOUT = P_MIXOUT + 3;
#define MODL (WSP(float, WS_MOD) + (size_t)layer * 2 * 6 * DM)
#define XCUR (layer == 0 ? ap->in[0] : (const float*)ap->out)
        if (IN(P_NORM1)) { REFRAME();
            const float* modl = MODL;
            for (int rep = 0; rep < NREP(2); ++rep) {
            constexpr bool L0 = layer == 0; const float* g2p = WSP(float, WS_MOD) + (size_t)(L0 ? 0 : layer - 1) * 2 * 6 * DM + 5 * DM; const void* xin = L0 ? (const void*)ap->in[0] : (const void*)WSP(const bf16, WS_XB);
            if (!odd) norm_phase<8, 1, !L0, L0>(F, xin, ap->in[4] + (size_t)layer * DM, modl, modl + DM, WSP(bf16, WS_H), ap->in[6] + (size_t)li * DM * AB_IN + AB_N, AB_IN, ap->in[12] + li * 8, WSP(float, WS_LOGF), WSP(const bf16, WS_Y), g2p, WSP(bf16, WS_XB));
            else norm_phase<16, 2, !L0, L0>(F, xin, ap->in[4] + (size_t)layer * DM, modl, modl + DM, WSP(bf16, WS_H), ap->in[13] + (size_t)li * DM * C_IN + C_N, C_IN, nullptr, WSP(float, WS_GLOW), WSP(const bf16, WS_Y), g2p, WSP(bf16, WS_XB));
            REPBAR(rep, NREP(2)); }
            SEAM(P_NORM1);
        }
        if (IN(P_MIXIN)) { REFRAME();
            const int N = odd ? 4096 : AB_N, ldc = odd ? C_N : AB_N;
            const bf16* Wt = odd ? WSP(const bf16, WS_W_GLIN) + (size_t)li * C_N * DM : WSP(const bf16, WS_W_ABIN) + (size_t)li * AB_N * DM;
            pg8::Gemm g{WSP(const bf16, WS_H), Wt, M, N, DM}; pg8::StaticOrder S; S.init(M, N, F.G, F.bid);
            pg8::EpiBf16 E{WSP(bf16, WS_PROJ), ldc};
            for (int rep = 0; rep < NREP(1); ++rep) { pg8::gemm_phase<pg8::EpiBf16, pg8::StaticOrder, true, true>(F.lds + RING_OFF, g, S, E, F.tid); REPBAR(rep, NREP(1)); }
            SEAM(P_MIXIN);
        }
        if (IN(P_PREP)) { REFRAME();
            if (!odd) { fox_prep(F, WSP(bf16, WS_PROJ), ap->in[10] + li * 128, ap->in[11] + li * 128, WSP(float, WS_LOGF), WSP(float, WS_BIAS));
                        __syncthreads();
                        for (int rep = 0; rep < NREP(4); ++rep) { rec_prep<false>(F, WSP(const bf16, WS_PROJ), ws + WS_REC, ap->in[8], li, nullptr, nullptr, nullptr); REPBAR(rep, NREP(4)); } }
            else for (int rep = 0; rep < NREP(4); ++rep) { rec_prep<true>(F, WSP(const bf16, WS_PROJ), ws + WS_REC, nullptr, 0, WSP(float, WS_GLOW), ap->in[14] + (size_t)li * 16 * 1024, ap->in[15] + li * 1024); REPBAR(rep, NREP(4)); }
            SEAM(P_PREP);
        }
        if (IN(P_REC)) { REFRAME();
            for (int rep = 0; rep < (odd ? NREP(8) : 1); ++rep) {
            if (!odd) { rec_seq3<false>(F, ws + WS_REC, WSP(bf16, WS_O));
                        fox_phase(F, (char*)lds + RING_OFF, WSP(const bf16, WS_PROJ), WSP(bf16, WS_CAT), WSP(float, WS_BIAS), (unsigned*)(ws + WS_CTL) + CW_QUEUE + 64 * (li + 2 * rep), ap->in[10] + li * 128, ap->in[11] + li * 128); }
            else { rec_seq3<true>(F, ws + WS_REC, WSP(bf16, WS_O));
                   if (F.bid < 64 && rep == 0) { LAS float* scr = (LAS float*)(F.lds + RING_OFF + F.wave * 16640);
                       convert_weights<(layer == 1 ? 1 : 2)>(ap, scr, 0, 1, F.lane, (unsigned*)(ws + WS_CTL) + CW_CONV, F.wave, F.tid == 0, (volatile LAS unsigned*)(F.lds + MISC_OFF) + 32); }
                   if (F.bid >= 64 && rep == 0) {
                       { pg8::Gemm g{WSP(const bf16, WS_H), WSP(const bf16, WS_W_GLIN) + (size_t)li * C_N * DM + (size_t)4096 * DM, M, 2048, DM}; pg8::StaticOrder S; S.init(M, 2048, F.G - 64, F.bid - 64);
                         pg8::EpiBf16 E{WSP(bf16, WS_PROJ) + 4096, C_N};
                         pg8::gemm_phase<pg8::EpiBf16, pg8::StaticOrder, true, true>(F.lds + RING_OFF, g, S, E, F.tid); }
                       LAS float* scr = (LAS float*)(F.lds + RING_OFF + F.wave * 16640);
                       convert_weights<(layer == 1 ? 1 : 2)>(ap, scr, 0, 1, F.lane, (unsigned*)(ws + WS_CTL) + CW_CONV, F.wave, F.tid == 0, (volatile LAS unsigned*)(F.lds + MISC_OFF) + 32); } }
            REPBAR(rep, (odd ? NREP(8) : 1)); }
            SEAM(P_REC);
        }
        if (IN(P_POST)) { REFRAME();
            if (!odd) post_even(F, WSP(const bf16, WS_O), WSP(const bf16, WS_PROJ), ap->in[9] + li * 1024, WSP(bf16, WS_CAT));
            else for (int rep = 0; rep < NREP(16); ++rep) { post_odd(F, WSP(const bf16, WS_O), WSP(const bf16, WS_PROJ), ap->in[16] + li * 512, WSP(bf16, WS_CAT)); REPBAR(rep, NREP(16)); }
            SEAM(P_POST);
        }
        if (IN(P_MIXOUT)) { REFRAME();
            const float* modl = MODL;
            const bf16* Wt = odd ? WSP(const bf16, WS_W_GLOUT) + (size_t)li * DM * DM : WSP(const bf16, WS_W_ABOUT) + (size_t)li * DM * DM;
            pg8::Gemm g{WSP(const bf16, WS_CAT), Wt, M, DM, DM}; pg8::StaticOrder S; S.init(M, DM, F.G, F.bid);
            pg8::EpiBf16 E{WSP(bf16, WS_Y), DM};
            pg8::gemm_phase<pg8::EpiBf16, pg8::StaticOrder, true, true>(F.lds + RING_OFF, g, S, E, F.tid);
            SEAM(P_MIXOUT);
        }
        if (IN(P_NORM2)) { REFRAME();
            const float* modl = MODL;
            { constexpr bool L0 = layer == 0; const void* xin = L0 ? (const void*)ap->in[0] : (const void*)WSP(const bf16, WS_XB);
              norm_phase<0, 0, true, L0>(F, xin, ap->in[5] + (size_t)layer * DM, modl + 3 * DM, modl + 4 * DM, WSP(bf16, WS_H), nullptr, 0, nullptr, nullptr, WSP(const bf16, WS_Y), modl + 2 * DM, WSP(bf16, WS_XB)); }
            SEAM(P_NORM2);
        }
        if (IN(P_FFIN)) { REFRAME();
            pg8::Gemm g{WSP(const bf16, WS_H), WSP(const bf16, WS_W_FFIN) + (size_t)layer * FF2 * DM, M, FF2, DM}; pg8::StaticOrder S; S.init(M, FF2, F.G, F.bid);
            pg8::EpiSwiglu E{WSP(bf16, WS_FFH), FF};
            for (int rep = 0; rep < NREP(1 | 128); ++rep) { pg8::gemm_phase<pg8::EpiSwiglu, pg8::StaticOrder, true, true>(F.lds + RING_OFF, g, S, E, F.tid); REPBAR(rep, NREP(1 | 128)); }
            SEAM(P_FFIN);
        }
        if (IN(P_FFOUT)) { REFRAME();
            const float* modl = MODL;
            pg8::Gemm g{WSP(const bf16, WS_FFH), WSP(const bf16, WS_W_FFOUT) + (size_t)layer * DM * FF, M, DM, FF}; pg8::StaticOrder S; S.init(M, DM, F.G, F.bid);
            pg8::EpiBf16 E{WSP(bf16, WS_Y), DM};
            pg8::gemm_phase<pg8::EpiBf16, pg8::StaticOrder, true, true>(F.lds + RING_OFF, g, S, E, F.tid);
            SEAM(P_FFOUT);
        }
    }
__global__ void __launch_bounds__(NTHREADS, 2) trunk_fwd(Args args_unused) {
    extern __shared__ __attribute__((aligned(16))) unsigned char lds[];
    Frame F;
    const int wave_s = __builtin_amdgcn_readfirstlane(threadIdx.x >> 6);
    int lo, hi, use_bar; XcdBarrier bar;
    {
        REFRAME();
        volatile LAS unsigned* MISC = (volatile LAS unsigned*)(F.lds + MISC_OFF);
        for (int u = F.tid; u < (LDS_BYTES - LDSCTL_OFF) / 4; u += NTHREADS) ((LAS unsigned*)(F.lds + LDSCTL_OFF))[u] = 0u;
        __syncthreads();
        lo = ap->ph_lo; hi = ap->ph_hi; use_bar = ap->use_bar;
        bar.bar = (unsigned*)(ws + WS_CTL) + CW_BAR; bar.x = 0; bar.st = MISC + 8;
        if (use_bar) bar = xcd_barrier_post((unsigned*)(ws + WS_CTL) + CW_BAR, MISC + 8, F.tid == 0);
    }

    if (IN(0)) { REFRAME(); p0_prologue(F, ap); if (IN(1)) xcd_barrier<true>(bar, F.tid == 0);
        if (DBG_DOUBLE & 32) { p0_prologue(F, ap); xcd_barrier<false>(bar, F.tid == 0); } }

    layer_phases<0>(lds, wave_s, lo, hi, bar);
    layer_phases<1>(lds, wave_s, lo, hi, bar);
    layer_phases<2>(lds, wave_s, lo, hi, bar);
    layer_phases<3>(lds, wave_s, lo, hi, bar);
    if (IN(phase_base(DEPTH))) { REFRAME(); resid_final(F, WSP(const bf16, WS_XB), WSP(const bf16, WS_Y), WSP(float, WS_MOD) + (size_t)(DEPTH - 1) * 2 * 6 * DM + 5 * DM, ap->out); }
#undef IN
#undef SEAM
}

#ifndef DBG_CHECK
#define DBG_CHECK 0
#endif
#if DBG_CHECK
#ifndef DBG_REPORT_ERR
#define DBG_REPORT_ERR 1
#endif
constexpr size_t WS_DBG = 5 * MiB;
constexpr size_t WS_DBG_OLD = 1072 * MiB;
__device__ __forceinline__ unsigned dbg_hash(unsigned x) { x ^= x >> 16; x *= 0x7feb352dU; x ^= x >> 15; x *= 0x846ca68bU; x ^= x >> 16; return x; }
__device__ __forceinline__ float dbg_bfr(float f) { return __builtin_bit_cast(float, f2bf(f) << 16); }
__device__ __forceinline__ void dbg_cmp(unsigned* dbg, unsigned code, float got, float ref, float rtol, float atol) {
    const float err = fabsf(got - ref); const bool bad = !(err <= atol + rtol * fabsf(ref));
    if (bad) { atomicMin(dbg, code); atomicMax(dbg + 1 + (code & 255u), __float_as_uint(err)); }
}
__global__ void dbg_gemm(unsigned* dbg, unsigned code, int mode, const bf16* A, int K, const float* W, int ldw, int N, const void* C, int ldc, const float* old, const float* gate0, const float* gate1) {
    const unsigned s = blockIdx.x * blockDim.x + threadIdx.x; const unsigned hsh = dbg_hash(s * 2654435761u + code);
    const int m = hsh % M, n = dbg_hash(hsh) % N;
    float d0 = 0.f, d1 = 0.f;
    for (int k = 0; k < K; ++k) { const float a = bf1(A[(size_t)m * K + k]); d0 += a * dbg_bfr(W[(size_t)k * ldw + n]); if (mode == 1) d1 += a * dbg_bfr(W[(size_t)k * ldw + FF + n]); }
    float got, ref;
    if (mode == 0) { got = bf1(((const bf16*)C)[(size_t)m * ldc + n]); ref = d0; }
    else if (mode == 1) { got = bf1(((const bf16*)C)[(size_t)m * ldc + n]); ref = d0 / (1.f + expf(-d0)) * d1; }
    else { got = ((const float*)C)[(size_t)m * ldc + n]; ref = old[(size_t)m * ldc + n] + (m >= T ? gate1 : gate0)[n] * d0; }
    dbg_cmp(dbg, code, got, ref, 0.02f, 0.03f);
}
__global__ void dbg_norm(unsigned* dbg, unsigned code, const float* x, const float* gain, const float* sh, const float* sc, const bf16* h) {
    const unsigned s = blockIdx.x * blockDim.x + threadIdx.x; const unsigned hsh = dbg_hash(s * 2654435761u + code);
    const int m = hsh % M, k = dbg_hash(hsh) % DM, b = m / T;
    double ss = 0.0; for (int i = 0; i < DM; ++i) { const double v = x[(size_t)m * DM + i]; ss += v * v; }
    const float rstd = (float)(1.0 / sqrt(ss / DM + 1e-6));
    const float ref = x[(size_t)m * DM + k] * rstd * gain[k] * (1.f + sc[(size_t)b * 6 * DM + k]) + sh[(size_t)b * 6 * DM + k];
    dbg_cmp(dbg, code, bf1(h[(size_t)m * DM + k]), ref, 0.01f, 0.01f);
}
__global__ void dbg_mod(unsigned* dbg, unsigned code, const float* c, const float* mw, const float* mb, const float* mod) {
    const unsigned s = blockIdx.x * blockDim.x + threadIdx.x; const unsigned hsh = dbg_hash(s * 2654435761u + code);
    const int layer = hsh % DEPTH, b = (hsh >> 8) & 1, j = dbg_hash(hsh) % (6 * DM);
    double acc = mb[(size_t)layer * 6 * DM + j];
    for (int k = 0; k < DM; ++k) { const double cv = c[b * DM + k]; acc += cv / (1.0 + exp(-cv)) * mw[((size_t)layer * DM + k) * (6 * DM) + j]; }
    dbg_cmp(dbg, code, mod[((size_t)layer * 2 + b) * 6 * DM + j], (float)acc, 1e-3f, 1e-4f);
}
__global__ void dbg_small(unsigned* dbg, unsigned code, int mode, const bf16* h, const float* W, int ldw, const float* fbias, const float* sout) {
    const unsigned s = blockIdx.x * blockDim.x + threadIdx.x; const unsigned hsh = dbg_hash(s * 2654435761u + code);
    const int m = hsh % M, cc = dbg_hash(hsh) % (mode == 1 ? 8 : 16), b = m / T, t = m % T;
    double acc = 0.0; for (int k = 0; k < DM; ++k) acc += (double)bf1(h[(size_t)m * DM + k]) * W[(size_t)k * ldw + cc];
    if (mode == 1) { const double xx = acc + fbias[cc]; const double ref = (xx < 0 ? xx : 0.0) - log1p(exp(-fabs(xx))); dbg_cmp(dbg, code, sout[((size_t)b * 8 + cc) * T + t], (float)ref, 0.02f, 0.02f); }
    else dbg_cmp(dbg, code, sout[(size_t)m * 16 + cc], (float)acc, 0.02f, 0.02f);
}
__global__ void dbg_cmpbuf(unsigned* dbg, unsigned code, const float* a, const float* b, size_t n) {
    for (size_t i = (size_t)blockIdx.x * blockDim.x + threadIdx.x; i < n; i += (size_t)gridDim.x * blockDim.x * 61) dbg_cmp(dbg, code, b[i], a[i], 0.05f, 0.1f);
}
__global__ void dbg_report(const unsigned* dbg, float* out) {
    if (threadIdx.x == 0 && blockIdx.x == 0) { const unsigned code = dbg[0]; if (code != 0xffffffffu) { out[0] = DBG_REPORT_ERR ? 1000.f * __uint_as_float(dbg[1 + (code & 255u)]) : 1000.f * (float)(code & 255u); } }
}
#endif
#ifndef N_LAUNCH_MODE
#define N_LAUNCH_MODE 1
#endif
extern "C" void kernel_launch(void* const* d_in, const int* in_sizes, int n_in, void* d_out, int out_size, void* d_ws, size_t ws_size, hipStream_t stream) {
    static int grid = 0;
    if (grid == 0) {
        if (n_in != 20 || out_size != M * DM || ws_size < WS_END) { fprintf(stderr, "kernel_launch: unexpected shapes (n_in %d out %d ws %zu)\n", n_in, out_size, ws_size); grid = -1; return; }
        int dev = 0, cus = 0, per_cu = 0;
        if (hipGetDevice(&dev) != hipSuccess || hipDeviceGetAttribute(&cus, hipDeviceAttributeMultiprocessorCount, dev) != hipSuccess) { grid = -1; return; }
        if (hipFuncSetAttribute((const void*)trunk_fwd, hipFuncAttributeMaxDynamicSharedMemorySize, LDS_BYTES) != hipSuccess) { fprintf(stderr, "kernel_launch: hipFuncSetAttribute failed\n"); grid = -1; return; }
        if (hipOccupancyMaxActiveBlocksPerMultiprocessor(&per_cu, (const void*)trunk_fwd, NTHREADS, LDS_BYTES) != hipSuccess || per_cu < 1)
            fprintf(stderr, "kernel_launch: occupancy query reports %d workgroups per CU\n", per_cu);
        (void)hipGetLastError();
        grid = cus;
    }
    if (grid < 0) return;
    if (hipMemsetAsync((char*)d_ws + WS_CTL, 0, CTL_ZERO_BYTES, stream) != hipSuccess) return;
    Args a{};
    for (int i = 0; i < 20; ++i) a.in[i] = (const float*)d_in[i];
    a.out = (float*)d_out; a.ws = (unsigned char*)d_ws; a.pad = 0;
#if N_LAUNCH_MODE == 1
    a.ph_lo = 0; a.ph_hi = N_PHASES; a.use_bar = 1;
    hipLaunchKernelGGL(trunk_fwd, dim3(grid), dim3(NTHREADS), LDS_BYTES, stream, a);
#else
    a.use_bar = 0;
#if DBG_CHECK
    unsigned char* wsb = (unsigned char*)d_ws; unsigned* dbg = (unsigned*)(wsb + WS_DBG);
    hipMemsetAsync(dbg, 0xFF, 4, stream); hipMemsetAsync(dbg + 1, 0, 1024, stream);
    const float* const* in = (const float* const*)a.in; float* outp = (float*)d_out; float* oldp = (float*)(wsb + WS_DBG_OLD);
    bf16* hbuf = (bf16*)(wsb + WS_H); bf16* catb = (bf16*)(wsb + WS_CAT); bf16* projb = (bf16*)(wsb + WS_PROJ); bf16* ffhb = (bf16*)(wsb + WS_FFH);
#endif
    for (int p = 0; p < N_PHASES; ++p) {
        int layer = 0; const int q = phase_kind(p, layer); const int li = layer >> 1; const bool odd = layer & 1; (void)li; (void)odd; (void)q;
#if DBG_CHECK
        const float* modl = (const float*)(wsb + WS_MOD) + (size_t)layer * 2 * 6 * DM; const float* xcur = layer == 0 ? in[0] : outp;
        if (q == K_MIXOUT) hipMemcpyAsync(oldp, xcur, (size_t)M * DM * 4, hipMemcpyDeviceToDevice, stream);
        if (q == K_FFOUT) hipMemcpyAsync(oldp, outp, (size_t)M * DM * 4, hipMemcpyDeviceToDevice, stream);
#endif
        a.ph_lo = p; a.ph_hi = p + 1;
        hipLaunchKernelGGL(trunk_fwd, dim3(grid), dim3(NTHREADS), LDS_BYTES, stream, a);
#if DBG_CHECK
        const unsigned code = 1 + p;
        if (q == K_PRO) dbg_mod<<<16, 256, 0, stream>>>(dbg, code, in[1], in[2], in[3], (const float*)(wsb + WS_MOD));
        if (q == K_NORM1) { dbg_norm<<<16, 256, 0, stream>>>(dbg, code, xcur, in[4] + (size_t)layer * DM, modl, modl + DM, hbuf);
            if (!odd) dbg_small<<<16, 256, 0, stream>>>(dbg, code | 0x100, 1, hbuf, in[6] + (size_t)li * DM * AB_IN + AB_N, AB_IN, in[12] + li * 8, (const float*)(wsb + WS_LOGF));
            else dbg_small<<<16, 256, 0, stream>>>(dbg, code | 0x100, 2, hbuf, in[13] + (size_t)li * DM * C_IN + C_N, C_IN, nullptr, (const float*)(wsb + WS_GLOW)); }
        if (q == K_MIXIN) { if (!odd) dbg_gemm<<<16, 256, 0, stream>>>(dbg, code, 0, hbuf, DM, in[6] + (size_t)li * DM * AB_IN, AB_IN, AB_N, projb, AB_N, nullptr, nullptr, nullptr);
            else dbg_gemm<<<16, 256, 0, stream>>>(dbg, code, 0, hbuf, DM, in[13] + (size_t)li * DM * C_IN, C_IN, C_N, projb, C_N, nullptr, nullptr, nullptr); }
#if DBG_REC
        if (q == K_REC) dbg_cmpbuf<<<256, 256, 0, stream>>>(dbg, code, (const float*)(wsb + WS_O), (const float*)(wsb + 1200 * MiB), odd ? (size_t)M * 2048 : (size_t)M * 1024);
#endif
        if (q == K_MIXOUT) dbg_gemm<<<16, 256, 0, stream>>>(dbg, code, 2, catb, DM, (odd ? in[17] : in[7]) + (size_t)li * DM * DM, DM, DM, outp, DM, oldp, modl + 2 * DM, modl + 6 * DM + 2 * DM);
        if (q == K_NORM2) dbg_norm<<<16, 256, 0, stream>>>(dbg, code, outp, in[5] + (size_t)layer * DM, modl + 3 * DM, modl + 4 * DM, hbuf);
        if (q == K_FFIN) dbg_gemm<<<16, 256, 0, stream>>>(dbg, code, 1, hbuf, DM, in[18] + (size_t)layer * DM * FF2, FF2, FF, ffhb, FF, nullptr, nullptr, nullptr);
        if (q == K_FFOUT) dbg_gemm<<<16, 256, 0, stream>>>(dbg, code, 2, ffhb, FF, in[19] + (size_t)layer * FF * DM, DM, DM, outp, DM, oldp, modl + 5 * DM, modl + 6 * DM + 5 * DM);
#endif
    }
#if DBG_CHECK
    dbg_report<<<1, 64, 0, stream>>>(dbg, outp);
#endif
#endif
}
```

```cpp
#include <hip/hip_runtime.h>
#include <hip/hip_bf16.h>
#include <cstdio>
#include <cstdint>
__device__ __forceinline__ int opq_tid(int wave_s) {
    int t; asm volatile("v_mbcnt_lo_u32_b32 %0, -1, 0\n\tv_mbcnt_hi_u32_b32 %0, -1, %0\n\tv_lshl_add_u32 %0, %1, 6, %0" : "=&v"(t) : "s"(wave_s)); return t; }
__device__ __forceinline__ int opq_bid() { int t = blockIdx.x; asm volatile("" : "+s"(t)); return t; }
template <int MASK> __device__ __forceinline__ float xsum(float v) {
    if constexpr (MASK < 32) { return v + __builtin_bit_cast(float, __builtin_amdgcn_ds_swizzle(__builtin_bit_cast(int, v), (MASK << 10) | 0x1f)); }
    else { auto rr = __builtin_amdgcn_permlane32_swap(__float_as_uint(v), __float_as_uint(v), false, false);
           const unsigned r0 = rr[0], r1 = rr[1];
           return __uint_as_float(r0) + __uint_as_float(r1); }
}
__device__ __forceinline__ float xor1_get(float v) { return __builtin_bit_cast(float, __builtin_amdgcn_ds_swizzle(__builtin_bit_cast(int, v), (1 << 10) | 0x1f)); }
namespace pg8 {
#define PG8_LAS __attribute__((address_space(3)))
typedef unsigned short bf16_t;
typedef short bf16x8 __attribute__((ext_vector_type(8)));
typedef float f32x4 __attribute__((ext_vector_type(4)));
typedef unsigned u32x4 __attribute__((ext_vector_type(4)));
constexpr int BM = 256, BK = 64, HALF = 128, HTB = HALF * BK * 2  , STAGE_BYTES = 8 * HTB, NXCD = 8, WGM = 8;

__host__ __device__ __forceinline__ int lds_byte(int r, int c) { const int st = (r >> 4) * 2 + (c >> 5), rr = r & 15, cc = c & 31, ob = rr * 64 + cc * 2; return st * 1024 + (ob ^ (((ob >> 9) & 1) << 5)); }
__host__ __device__ __forceinline__ void stage_rc(int b, int& R, int& C) { const int st = b / 1024, sb = b % 1024, swz = sb ^ (((sb >> 9) & 1) << 5); R = (st >> 1) * 16 + swz / 64; C = (st & 1) * 32 + (swz % 64) / 2; }
__host__ __device__ __forceinline__ int perm32(int rho) { const int n = rho >> 4, i = rho & 15; return 8 * (i >> 2) + 4 * n + (i & 3); }

struct Unit { int pm, pn; };
struct Gemm { const bf16_t* A; const bf16_t* Bt; int M, N, K; };

struct StaticOrder {
    int nM, nN, nwg, G, c;
    __host__ __device__ void init(int M, int N, int G_, int c_) { nM = M / BM; nN = N / BM; nwg = nM * nN; G = G_; c = c_; }
    __host__ __device__ bool next(int i, Unit& u) const {
        const long L = (long)i * G + c; if (L >= nwg) return false;
        int wgid = (int)L; { const int q = nwg / NXCD, r = nwg % NXCD, xcd = wgid % NXCD, off = wgid / NXCD; wgid = (xcd < r ? xcd * (q + 1) : r * (q + 1) + (xcd - r) * q) + off; }
        const int nig = WGM * nN, gid = wgid / nig, fm = gid * WGM, gsz = (nM - fm) < WGM ? (nM - fm) : WGM;
        u.pm = fm + ((wgid % nig) % gsz); u.pn = (wgid % nig) / gsz; return true;
    }
    __device__ __forceinline__ void a_ready(const Unit&) const {}
    __device__ __forceinline__ void done(const Unit&) const {}
};

__device__ __forceinline__ unsigned cvt_pk_bf16(float lo, float hi) { unsigned r; asm volatile("v_cvt_pk_bf16_f32 %0, %1, %2" : "=v"(r) : "v"(lo), "v"(hi)); return r; }
typedef float f32x2 __attribute__((ext_vector_type(2)));

struct EpiBf16 {
    static constexpr bool PERM = true, AFTER_DRAIN = false;
    bf16_t* O; int ldc;
    __device__ __forceinline__ void operator()(const f32x4 (&acc)[2][2][4][2], const Unit& u, int wr, int wc, int fr, int fq) const {
        const int row0 = u.pm * BM + wr * 64 + fr; const int col0 = u.pn * BM + wc * 32 + 8 * fq;
#pragma unroll
        for (int ai = 0; ai < 2; ++ai)
#pragma unroll
            for (int m = 0; m < 4; ++m) { bf16_t* rowp = O + (size_t)(row0 + ai * HALF + m * 16) * ldc + col0;
#pragma unroll
                for (int bj = 0; bj < 2; ++bj) { const f32x4 v0 = acc[ai][bj][m][0], v1 = acc[ai][bj][m][1];
                    u32x4 w; w.x = cvt_pk_bf16(v0[0], v0[1]); w.y = cvt_pk_bf16(v0[2], v0[3]); w.z = cvt_pk_bf16(v1[0], v1[1]); w.w = cvt_pk_bf16(v1[2], v1[3]);
                    *(u32x4*)(rowp + bj * HALF) = w; } }
    }
};
__device__ __forceinline__ float silu_f(float a) { return a * __builtin_amdgcn_rcpf(1.0f + __builtin_amdgcn_exp2f(-1.4426950408889634f * a)); }
struct EpiSwiglu {
    static constexpr bool PERM = true, AFTER_DRAIN = false;
    bf16_t* O; int ldc;
    __device__ __forceinline__ void operator()(const f32x4 (&acc)[2][2][4][2], const Unit& u, int wr, int wc, int fr, int fq) const {
        const int row0 = u.pm * BM + wr * 64 + fr; const int col0 = u.pn * HALF + wc * 32 + 8 * fq;
#pragma unroll
        for (int ai = 0; ai < 2; ++ai)
#pragma unroll
            for (int m = 0; m < 4; ++m) { bf16_t* rowp = O + (size_t)(row0 + ai * HALF + m * 16) * ldc + col0;
                const f32x4 a0 = acc[ai][0][m][0], a1 = acc[ai][0][m][1], u0 = acc[ai][1][m][0], u1 = acc[ai][1][m][1];
                u32x4 w;
                w.x = cvt_pk_bf16(silu_f(a0[0]) * u0[0], silu_f(a0[1]) * u0[1]); w.y = cvt_pk_bf16(silu_f(a0[2]) * u0[2], silu_f(a0[3]) * u0[3]);
                w.z = cvt_pk_bf16(silu_f(a1[0]) * u1[0], silu_f(a1[1]) * u1[1]); w.w = cvt_pk_bf16(silu_f(a1[2]) * u1[2], silu_f(a1[3]) * u1[3]);
                *(u32x4*)rowp = w; }
    }
};
struct EpiResid {
    static constexpr bool PERM = false, AFTER_DRAIN = false;
    const float* base; float* out; int ldc; const float* gate0; const float* gate1; int pm_split;
    __device__ __forceinline__ void operator()(const f32x4 (&acc)[2][2][4][2], const Unit& u, int wr, int wc, int fr, int fq) const {
        const int col0 = u.pn * BM + wc * 32 + 4 * fq; const float* g = (u.pm >= pm_split) ? gate1 : gate0;
        f32x4 gv[2][2];
#pragma unroll
        for (int bj = 0; bj < 2; ++bj)
#pragma unroll
            for (int n = 0; n < 2; ++n) gv[bj][n] = *(const f32x4*)(g + col0 + bj * HALF + n * 16);
#pragma unroll
        for (int ai = 0; ai < 2; ++ai) { f32x4 bs[4][2][2];
#pragma unroll
            for (int m = 0; m < 4; ++m) { const size_t off = (size_t)(u.pm * BM + ai * HALF + wr * 64 + m * 16 + fr) * ldc + col0;
#pragma unroll
                for (int bj = 0; bj < 2; ++bj)
#pragma unroll
                    for (int n = 0; n < 2; ++n) bs[m][bj][n] = *(const f32x4*)(base + off + bj * HALF + n * 16); }
#pragma unroll
            for (int m = 0; m < 4; ++m) { const size_t off = (size_t)(u.pm * BM + ai * HALF + wr * 64 + m * 16 + fr) * ldc + col0;
#pragma unroll
                for (int bj = 0; bj < 2; ++bj)
#pragma unroll
                    for (int n = 0; n < 2; ++n) *(f32x4*)(out + off + bj * HALF + n * 16) = bs[m][bj][n] + gv[bj][n] * acc[ai][bj][m][n]; }
            asm volatile("" ::: "memory"); }
    }
};
struct EpiResidBf {
    static constexpr bool PERM = false, AFTER_DRAIN = false;
    const bf16_t* xb; float* out; int ldc; const float* gate0; const float* gate1; int pm_split;
    typedef unsigned u32x2 __attribute__((ext_vector_type(2)));
    __device__ __forceinline__ void operator()(const f32x4 (&acc)[2][2][4][2], const Unit& u, int wr, int wc, int fr, int fq) const {
        const int col0 = u.pn * BM + wc * 32 + 4 * fq; const float* g = (u.pm >= pm_split) ? gate1 : gate0;
        f32x4 gv[2][2];
#pragma unroll
        for (int bj = 0; bj < 2; ++bj)
#pragma unroll
            for (int n = 0; n < 2; ++n) gv[bj][n] = *(const f32x4*)(g + col0 + bj * HALF + n * 16);
#pragma unroll
        for (int ai = 0; ai < 2; ++ai) { u32x2 bs[4][2][2];
#pragma unroll
            for (int m = 0; m < 4; ++m) { const size_t off = (size_t)(u.pm * BM + ai * HALF + wr * 64 + m * 16 + fr) * ldc + col0;
#pragma unroll
                for (int bj = 0; bj < 2; ++bj)
#pragma unroll
                    for (int n = 0; n < 2; ++n) bs[m][bj][n] = *(const u32x2*)(xb + off + bj * HALF + n * 16); }
#pragma unroll
            for (int m = 0; m < 4; ++m) { const size_t off = (size_t)(u.pm * BM + ai * HALF + wr * 64 + m * 16 + fr) * ldc + col0;
#pragma unroll
                for (int bj = 0; bj < 2; ++bj)
#pragma unroll
                    for (int n = 0; n < 2; ++n) { const u32x2 b = bs[m][bj][n];
                        const f32x4 xv = {__uint_as_float(b.x << 16), __uint_as_float(b.x & 0xffff0000u), __uint_as_float(b.y << 16), __uint_as_float(b.y & 0xffff0000u)};
                        *(f32x4*)(out + off + bj * HALF + n * 16) = xv + gv[bj][n] * acc[ai][bj][m][n]; } }
            asm volatile("" ::: "memory"); }
    }
};

template <class Epi, class Sched, bool ALIGN_EPI = false, bool SP2 = false>
__device__ __forceinline__ void gemm_phase(PG8_LAS unsigned char* lds, const Gemm g, const Sched& S, const Epi& E, const int tid) {
    const int wid = __builtin_amdgcn_readfirstlane(tid >> 6), lane = tid & 63, wr = wid >> 2, wc = wid & 3, fr = lane & 15, fq = lane >> 4;
    const int K = g.K, nt = K / BK;
    unsigned voffA[2], voffB[2];
#pragma unroll
    for (int i = 0; i < 2; ++i) { int R, C; stage_rc(tid * 16 + i * 8192, R, C); const int Rb = Epi::PERM ? ((R & ~31) + perm32(R & 31)) : R;
        voffA[i] = (unsigned)(R * K + C) * 2u; voffB[i] = (unsigned)(Rb * K + C) * 2u; }
    const size_t kstep = (size_t)(BK * 2);
    const size_t hstep = (size_t)HALF * K * 2;
    const size_t tstep = 2 * hstep;
    const unsigned ldsw = (unsigned)wid * 1024u;
    const int aoff = lds_byte(wr * 64 + fr, fq * 8), boff = lds_byte(wc * 32 + fr, fq * 8);
#define PG8_SA(b, h) (((b) * 2 + (h)) * HTB)
#define PG8_SB(b, h) ((4 + (b) * 2 + (h)) * HTB)
#define PG8_STAGE(bufoff, gbase, voff) do { _Pragma("unroll") for (int _i = 0; _i < 2; ++_i) \
        __builtin_amdgcn_global_load_lds((const unsigned*)((const char*)(gbase) + (voff)[_i]), (PG8_LAS unsigned*)(lds + (bufoff) + ldsw + _i * 8192), 16, 0, 0); } while (0)
#define PG8_LDA(dst, b, h) do { _Pragma("unroll") for (int m = 0; m < 4; ++m) _Pragma("unroll") for (int k = 0; k < 2; ++k) dst[m][k] = *(const PG8_LAS bf16x8*)(lds + PG8_SA(b, h) + aoff + m * 2048 + k * 1024); } while (0)
#define PG8_LDB(dst, b, h) do { _Pragma("unroll") for (int n = 0; n < 2; ++n) _Pragma("unroll") for (int k = 0; k < 2; ++k) dst[n][k] = *(const PG8_LAS bf16x8*)(lds + PG8_SB(b, h) + boff + n * 2048 + k * 1024); } while (0)
#define PG8_MMA(ai, bj, At, Bt) do { __builtin_amdgcn_s_setprio(1); _Pragma("unroll") for (int m = 0; m < 4; ++m) _Pragma("unroll") for (int n = 0; n < 2; ++n) _Pragma("unroll") for (int k = 0; k < 2; ++k) \
        acc[ai][bj][m][n] = __builtin_amdgcn_mfma_f32_16x16x32_bf16(Bt[n][k], At[m][k], acc[ai][bj][m][n], 0, 0, 0); __builtin_amdgcn_s_setprio(0); } while (0)
#define PG8_WAIT_V(n) asm volatile("s_waitcnt vmcnt(" #n ")" ::: "memory")
#define PG8_WAIT_L(n) asm volatile("s_waitcnt lgkmcnt(" #n ")" ::: "memory")
#define PG8_BAR __builtin_amdgcn_s_barrier()
#define PG8_SCHED __builtin_amdgcn_sched_barrier(0)
    Unit cur, nxt; int ui = 0;
    if (!S.next(0, cur)) return;
    f32x4 acc[2][2][4][2];
#pragma unroll
    for (int a = 0; a < 2; ++a)
#pragma unroll
        for (int b = 0; b < 2; ++b)
#pragma unroll
            for (int m = 0; m < 4; ++m)
#pragma unroll
                for (int n = 0; n < 2; ++n) acc[a][b][m][n] = (f32x4){0.f, 0.f, 0.f, 0.f};
    bf16x8 At[4][2], B0[2][2], B1[2][2];
    const char* cA = (const char*)g.A + (size_t)cur.pm * tstep; const char* cB = (const char*)g.Bt + (size_t)cur.pn * tstep;
    S.a_ready(cur);
    if constexpr (SP2) {
        PG8_STAGE(PG8_SB(0, 0), cB, voffB); PG8_STAGE(PG8_SB(0, 1), cB + hstep, voffB); PG8_STAGE(PG8_SA(0, 0), cA, voffA); PG8_STAGE(PG8_SA(0, 1), cA + hstep, voffA);
        if (wr == 1) PG8_BAR;
        PG8_WAIT_V(2); PG8_BAR;
        PG8_STAGE(PG8_SB(1, 0), cB + kstep, voffB); PG8_STAGE(PG8_SA(1, 0), cA + kstep, voffA); PG8_STAGE(PG8_SB(1, 1), cB + hstep + kstep, voffB);
        PG8_WAIT_V(6); PG8_BAR;
    } else {
        PG8_STAGE(PG8_SB(0, 0), cB, voffB); PG8_STAGE(PG8_SA(0, 0), cA, voffA); PG8_STAGE(PG8_SB(0, 1), cB + hstep, voffB); PG8_STAGE(PG8_SA(0, 1), cA + hstep, voffA);
        if (wr == 1) PG8_BAR;
        PG8_WAIT_V(4); PG8_BAR;
        PG8_STAGE(PG8_SB(1, 0), cB + kstep, voffB); PG8_STAGE(PG8_SA(1, 0), cA + kstep, voffA); PG8_STAGE(PG8_SB(1, 1), cB + hstep + kstep, voffB);
        PG8_WAIT_V(6); PG8_BAR;
    }
    for (;;) {
        const bool has_next = S.next(ui + 1, nxt);
        const char* nA = has_next ? (const char*)g.A + (size_t)nxt.pm * tstep : cA; const char* nB = has_next ? (const char*)g.Bt + (size_t)nxt.pn * tstep : cB;
        for (int t = 0; t < nt; t += 2) {
            const bool last = (t == nt - 2);
            const char* a1 = cA + (size_t)(t + 1) * kstep;
            const char* a2 = last ? nA : cA + (size_t)(t + 2) * kstep; const char* b2 = last ? nB : cB + (size_t)(t + 2) * kstep;
            const char* a3 = a2 + kstep; const char* b3 = b2 + kstep;
            if (last && has_next) S.a_ready(nxt);
            if constexpr (SP2) {
            PG8_LDB(B0, 0, 0); PG8_LDB(B1, 0, 1); PG8_SCHED; PG8_LDA(At, 0, 0); PG8_STAGE(PG8_SA(1, 1), a1 + hstep, voffA);
            PG8_WAIT_V(8); PG8_WAIT_L(0); PG8_BAR; PG8_MMA(0, 0, At, B0); PG8_MMA(0, 1, At, B1); PG8_BAR; PG8_SCHED;
            PG8_LDA(At, 0, 1); PG8_STAGE(PG8_SB(0, 0), b2, voffB); PG8_STAGE(PG8_SB(0, 1), b2 + hstep, voffB); PG8_STAGE(PG8_SA(0, 0), a2, voffA);
            PG8_WAIT_V(8); PG8_WAIT_L(0); PG8_BAR; PG8_MMA(1, 0, At, B0); PG8_MMA(1, 1, At, B1); PG8_BAR; PG8_SCHED;
            PG8_LDB(B0, 1, 0); PG8_LDB(B1, 1, 1); PG8_SCHED; PG8_LDA(At, 1, 0); PG8_STAGE(PG8_SA(0, 1), a2 + hstep, voffA);
            PG8_WAIT_V(8); PG8_WAIT_L(0); PG8_BAR; PG8_MMA(0, 0, At, B0); PG8_MMA(0, 1, At, B1); PG8_BAR; PG8_SCHED;
            PG8_LDA(At, 1, 1); PG8_STAGE(PG8_SB(1, 0), b3, voffB); PG8_STAGE(PG8_SB(1, 1), b3 + hstep, voffB); PG8_STAGE(PG8_SA(1, 0), a3, voffA);
            PG8_WAIT_V(8); PG8_WAIT_L(0); PG8_BAR; PG8_MMA(1, 0, At, B0); PG8_MMA(1, 1, At, B1); PG8_BAR; PG8_SCHED;
            } else {
            PG8_LDB(B0, 0, 0); PG8_SCHED; PG8_LDA(At, 0, 0); PG8_STAGE(PG8_SA(1, 1), a1 + hstep, voffA);
            PG8_WAIT_L(8); PG8_BAR; PG8_WAIT_L(0); PG8_MMA(0, 0, At, B0); PG8_BAR; PG8_SCHED;
            PG8_LDB(B1, 0, 1); PG8_STAGE(PG8_SB(0, 0), b2, voffB);
            PG8_BAR; PG8_WAIT_L(0); PG8_MMA(0, 1, At, B1); PG8_BAR;
            PG8_LDA(At, 0, 1); PG8_STAGE(PG8_SA(0, 0), a2, voffA);
            PG8_BAR; PG8_WAIT_L(0); PG8_MMA(1, 0, At, B0); PG8_BAR; PG8_SCHED;
            PG8_STAGE(PG8_SB(0, 1), b2 + hstep, voffB);
            PG8_WAIT_V(6); PG8_BAR; PG8_MMA(1, 1, At, B1); PG8_BAR;
            PG8_LDB(B0, 1, 0); PG8_SCHED; PG8_LDA(At, 1, 0); PG8_STAGE(PG8_SA(0, 1), a2 + hstep, voffA);
            PG8_WAIT_L(8); PG8_BAR; PG8_WAIT_L(0); PG8_MMA(0, 0, At, B0); PG8_BAR; PG8_SCHED;
            PG8_LDB(B1, 1, 1); PG8_STAGE(PG8_SB(1, 0), b3, voffB);
            PG8_BAR; PG8_WAIT_L(0); PG8_MMA(0, 1, At, B1); PG8_BAR;
            PG8_LDA(At, 1, 1); PG8_STAGE(PG8_SA(1, 0), a3, voffA);
            PG8_BAR; PG8_WAIT_L(0); PG8_MMA(1, 0, At, B0); PG8_BAR; PG8_SCHED;
            PG8_STAGE(PG8_SB(1, 1), b3 + hstep, voffB);
            PG8_WAIT_V(6); PG8_BAR; PG8_MMA(1, 1, At, B1); PG8_BAR;
            }
        }
        if constexpr (ALIGN_EPI) { if (wr == 0) PG8_BAR; }
        if constexpr (!Epi::AFTER_DRAIN) { E(acc, cur, wr, wc, fr, fq); S.done(cur); }
        if (!has_next) break;
#pragma unroll
        for (int a = 0; a < 2; ++a)
#pragma unroll
            for (int b = 0; b < 2; ++b)
#pragma unroll
                for (int m = 0; m < 4; ++m)
#pragma unroll
                    for (int n = 0; n < 2; ++n) acc[a][b][m][n] = (f32x4){0.f, 0.f, 0.f, 0.f};
        cur = nxt; cA = nA; cB = nB; ++ui;
        if constexpr (ALIGN_EPI) { if (wr == 1) PG8_BAR; }
    }
    PG8_WAIT_V(0);
    if constexpr (!ALIGN_EPI) { if (wr == 0) PG8_BAR; }
    PG8_BAR;
    if constexpr (Epi::AFTER_DRAIN) { E.fused(acc, cur, wr, wc, fr, fq, lds, wid, lane); S.done(cur); }
#undef PG8_SA
#undef PG8_SB
#undef PG8_STAGE
#undef PG8_LDA
#undef PG8_LDB
#undef PG8_MMA
#undef PG8_WAIT_V
#undef PG8_WAIT_L
#undef PG8_BAR
#undef PG8_SCHED
}
}
namespace fox {
constexpr int D = 128, PITCH = 8192, OPITCH = 2048, SKV = 8192, GATE_OFF = 3072;
constexpr float THR = 8.f;
constexpr float SCALE = 0.08838834764831845f;
constexpr int NW = 8, QBLK = 32, KVBLK = 64, QB = NW * QBLK;
constexpr int SHM_V = KVBLK * D * 2, SHM_K = KVBLK * D * 2;
constexpr int BIAS_OFF = 2 * SHM_V + 2 * SHM_K + NW * 64 * 4;
constexpr int LDS_BYTES = BIAS_OFF + SKV * 4;

using bf16 = __hip_bfloat16;
typedef short bf16x8 __attribute__((ext_vector_type(8)));
typedef short s16x4 __attribute__((ext_vector_type(4)));
typedef float f32x16 __attribute__((ext_vector_type(16)));
typedef float f32x4 __attribute__((ext_vector_type(4)));
typedef unsigned u32x4 __attribute__((ext_vector_type(4)));

#define KSWZ(row, colB) ((row) * 256 + ((colB) ^ (((row) & 7) << 4)))
#define SBAR() __builtin_amdgcn_sched_barrier(0)
__device__ __forceinline__ int v_st(int k, int c) { const int kk = (k & ~0xC) | ((k & 4) << 1) | ((k & 8) >> 1); return ((kk >> 3) * 4 + (c >> 5)) * 512 + ((kk & 7) * 32 + (c & 31)) * 2; }
__device__ __forceinline__ int v_rd_base(int lane) { return ((lane & 3) << 3) | (((lane >> 2) & 3) << 6) | (((lane >> 4) & 1) << 5) | (((lane >> 5) & 1) << 8); }
constexpr int v_rd_off(int d0, int ks, int half) { return d0 * 512 + ks * 4096 + half * 2048; }
__device__ __forceinline__ int crow(int r, int hi) { return (r & 3) + 8 * (r >> 2) + 4 * hi; }
__device__ __forceinline__ unsigned cvtpk(float lo, float hi) {
    unsigned r; asm volatile("v_cvt_pk_bf16_f32 %0, %1, %2" : "=v"(r) : "v"(lo), "v"(hi)); return r;
}
__device__ __forceinline__ bf16x8 load8(const bf16* p) { return *reinterpret_cast<const bf16x8*>(p); }
__device__ __forceinline__ void mask_tile(f32x16& p0, f32x16& p1, int dq, unsigned W) {
    const float NEG = -__builtin_inff();
#pragma unroll
    for (int r = 0; r < 16; ++r) {
        const int c = (r & 3) + 8 * (r >> 2);
        if ((unsigned)(dq - c) >= W) p0[r] = NEG;
        if ((unsigned)(dq - c - 32) >= W) p1[r] = NEG;
    }
}
__device__ __forceinline__ void partialSM(f32x16& p0, f32x16& p1, float& m_reg, float& mn, float& alpha) {
    float pmax = p0[0]; for (int r = 1; r < 16; ++r) pmax = fmaxf(pmax, p0[r]); for (int r = 0; r < 16; ++r) pmax = fmaxf(pmax, p1[r]);
    { auto rr = __builtin_amdgcn_permlane32_swap(__float_as_uint(pmax), __float_as_uint(pmax), false, false);
      pmax = fmaxf(__uint_as_float(rr[0]), __uint_as_float(rr[1])); }
    constexpr float C2 = 1.4426950408889634f * SCALE;
    if (__builtin_expect(__all((pmax - m_reg) * SCALE <= THR), 1)) { mn = m_reg; alpha = 1.f; }
    else { mn = fmaxf(m_reg, pmax); alpha = __builtin_amdgcn_exp2f((m_reg - mn) * C2); m_reg = mn; }
    const float mnL = -mn * C2;
    for (int r = 0; r < 16; ++r) p0[r] = fmaf(p0[r], C2, mnL); for (int r = 0; r < 16; ++r) p1[r] = fmaf(p1[r], C2, mnL);
    for (int r = 0; r < 16; ++r) p0[r] = __builtin_amdgcn_exp2f(p0[r]);
}
__device__ __forceinline__ void finishSM(f32x16& p0, f32x16& p1, float alpha, float& l_reg, bf16x8& pa0, bf16x8& pa1, bf16x8& pa2, bf16x8& pa3) {
    for (int r = 0; r < 16; ++r) p1[r] = __builtin_amdgcn_exp2f(p1[r]);
    float ps = 0; for (int r = 0; r < 16; ++r) ps += p0[r]; for (int r = 0; r < 16; ++r) ps += p1[r];
    { auto rr = __builtin_amdgcn_permlane32_swap(__float_as_uint(ps), __float_as_uint(ps), false, false);
      ps = __uint_as_float(rr[0]) + __uint_as_float(rr[1]); }
    l_reg = l_reg * alpha + ps;
#define PK4(P, B_, OUT) do { unsigned a0 = cvtpk(P[B_+0], P[B_+1]), a1 = cvtpk(P[B_+2], P[B_+3]);                          \
        unsigned b0 = cvtpk(P[B_+4], P[B_+5]), b1 = cvtpk(P[B_+6], P[B_+7]);                                             \
        auto r0 = __builtin_amdgcn_permlane32_swap(a0, b0, false, false); auto r1 = __builtin_amdgcn_permlane32_swap(a1, b1, false, false); \
        u32x4 w = {r0[0], r1[0], r0[1], r1[1]}; OUT = *reinterpret_cast<bf16x8*>(&w); } while (0)
    PK4(p0, 0, pa0); PK4(p0, 8, pa1); PK4(p1, 0, pa2); PK4(p1, 8, pa3);
#undef PK4
}
template <int KB>
__device__ __forceinline__ void qkt(f32x16& p0, f32x16& p1, const char* K_lds, const float* bt, int r32, int hi, const bf16x8* qr) {
#pragma unroll
    for (int j = 0; j < 4; ++j) { const f32x4 a = *(const f32x4*)(bt + 8 * j), b = *(const f32x4*)(bt + 32 + 8 * j);
        p0[4 * j + 0] = a[0]; p0[4 * j + 1] = a[1]; p0[4 * j + 2] = a[2]; p0[4 * j + 3] = a[3];
        p1[4 * j + 0] = b[0]; p1[4 * j + 1] = b[1]; p1[4 * j + 2] = b[2]; p1[4 * j + 3] = b[3]; }
    const char* kb[4];
#pragma unroll
    for (int dd = 0; dd < 4; ++dd) kb[dd] = K_lds + KB * SHM_K + KSWZ(r32, (dd * 16 + hi * 8) * 2);
#pragma unroll
    for (int d0 = 0; d0 < 8; ++d0) { const char* a = kb[d0 & 3] + (d0 >> 2) * 128;
        bf16x8 b0 = *reinterpret_cast<const bf16x8*>(a);
        bf16x8 b1 = *reinterpret_cast<const bf16x8*>(a + 32 * 256);
        p0 = __builtin_amdgcn_mfma_f32_32x32x16_bf16(b0, qr[d0], p0, 0, 0, 0);
        p1 = __builtin_amdgcn_mfma_f32_32x32x16_bf16(b1, qr[d0], p1, 0, 0, 0); }
}
template <int VB>
__device__ __forceinline__ void pv_tile(f32x16* o, int vb0, bf16x8 pa0, bf16x8 pa1, bf16x8 pa2, bf16x8 pa3) {
#define TRRD(dst, off) asm volatile("ds_read_b64_tr_b16 %0, %1 offset:%2" : "=&v"(dst) : "v"(vb0), "i"(off) : "memory")
#define PV_D0(d0) do { s16x4 l0, l1, l2, l3, h0, h1, h2, h3; constexpr int b_ = VB * SHM_V + v_rd_off(d0, 0, 0);     \
        TRRD(l0, b_); TRRD(h0, b_ + 2048); TRRD(l1, b_ + 4096); TRRD(h1, b_ + 6144); TRRD(l2, b_ + 8192); TRRD(h2, b_ + 10240); TRRD(l3, b_ + 12288); TRRD(h3, b_ + 14336); \
        asm volatile("s_waitcnt lgkmcnt(0)" ::: "memory"); SBAR();                 \
        o[d0] = __builtin_amdgcn_mfma_f32_32x32x16_bf16(pa0, (bf16x8){l0[0], l0[1], l0[2], l0[3], h0[0], h0[1], h0[2], h0[3]}, o[d0], 0, 0, 0);   \
        o[d0] = __builtin_amdgcn_mfma_f32_32x32x16_bf16(pa1, (bf16x8){l1[0], l1[1], l1[2], l1[3], h1[0], h1[1], h1[2], h1[3]}, o[d0], 0, 0, 0);   \
        o[d0] = __builtin_amdgcn_mfma_f32_32x32x16_bf16(pa2, (bf16x8){l2[0], l2[1], l2[2], l2[3], h2[0], h2[1], h2[2], h2[3]}, o[d0], 0, 0, 0);   \
        o[d0] = __builtin_amdgcn_mfma_f32_32x32x16_bf16(pa3, (bf16x8){l3[0], l3[1], l3[2], l3[3], h3[0], h3[1], h3[2], h3[3]}, o[d0], 0, 0, 0); } while (0)
    PV_D0(0); PV_D0(1); PV_D0(2); PV_D0(3);
#undef PV_D0
#undef TRRD
}

struct BlockRef { const bf16* Q; const bf16* K; const bf16* V; bf16* O; const float* Bias; int P0; float THp; };
struct Seam { bf16x8 qr[8]; bf16x8 st_v0, st_v1, st_k0, st_k1; };
#define ROW(p, k0, rr) ((const bf16*)((const char*)(p) + (size_t)(k0) * (PITCH * 2) + (unsigned)(voff + (unsigned)(rr) * (PITCH * 2u))))
#define VMW() asm volatile("s_waitcnt vmcnt(0)" ::: "memory")
#define VMWN(n) asm volatile("s_waitcnt vmcnt(%0)" :: "i"(n) : "memory")
#define SLOAD_H(Kp, Vp, k0) do { S.st_v0 = load8(ROW(Vp, k0, 0)); S.st_v1 = load8(ROW(Vp, k0, 32));              \
                         S.st_k0 = load8(ROW(Kp, k0, 0)); S.st_k1 = load8(ROW(Kp, k0, 32)); } while (0)
#define SWRITE_HK(bf) do { *(bf16x8*)(K_lds + (bf) * SHM_K + kws) = S.st_k0; *(bf16x8*)(K_lds + (bf) * SHM_K + kws + 32 * 256) = S.st_k1; } while (0)
#define SWRITE_HV(bf) do { *(bf16x8*)(V_lds + (bf) * SHM_V + vst0) = S.st_v0; *(bf16x8*)(V_lds + (bf) * SHM_V + vst1) = S.st_v1; } while (0)
#define SWRITE_H(bf) do { SWRITE_HV(bf); SWRITE_HK(bf); } while (0)
__device__ __forceinline__ void fox_prime(const BlockRef& cur, char* lds, Seam& S, const int tid) {
    const int wid = __builtin_amdgcn_readfirstlane(tid >> 6), lane = tid & 63, r32 = lane & 31, hi = lane >> 5;
    const int sr = tid >> 4, sc = (tid & 15) * 8, kws = KSWZ(sr, sc * 2); char* K_lds = lds + 2 * SHM_V;
    const unsigned voff = (unsigned)(sr * PITCH + sc) * 2u, qoff = (unsigned)((wid * QBLK + r32) * PITCH + hi * 8) * 2u;
    for (int d0 = 0; d0 < 8; ++d0) S.qr[d0] = load8((const bf16*)((const char*)cur.Q + (qoff + d0 * 32)));
    (void)kws; (void)K_lds; (void)voff;
    __syncthreads();
}
__device__ __forceinline__ void fox_block(const BlockRef& cur, const BlockRef& nxt, char* lds, Seam& S, const int tid) {
    const int wid = __builtin_amdgcn_readfirstlane(tid >> 6), lane = tid & 63, r32 = lane & 31, hi = lane >> 5;
    const int W = SKV;
    const int NTF = (cur.P0 + QB - 1) / KVBLK + 1;
    const int qlo = cur.P0 + wid * QBLK, qm = qlo + r32 - 4 * hi;
    char* V_lds = lds; char* K_lds = lds + 2 * SHM_V;
    float* ws = (float*)(lds + 2 * SHM_V + 2 * SHM_K) + wid * 64; float* li_l = ws, * al_l = ws + 32;
    float* biasL = (float*)(lds + BIAS_OFF);
    { const int nk = cur.P0 + QB;
      int t4 = tid * 4; asm volatile("" : "+v"(t4));
      f32x4 bv[4];
#pragma unroll
      for (int k = 0; k < 4; ++k) { const int i = t4 + k * (NW * 64 * 4); if (i < nk) bv[k] = *(const f32x4*)((const char*)cur.Bias + (unsigned)(i * 4)); }
#pragma unroll
      for (int k = 0; k < 4; ++k) { const int i = t4 + k * (NW * 64 * 4); if (i < nk) *(f32x4*)(biasL + i) = bv[k]; }
      __syncthreads(); }
    int j_lo; { int lo_ = 0, hi_ = cur.P0 / KVBLK; const float bref = biasL[cur.P0] - cur.THp;
        while (lo_ < hi_) { const int mid = (lo_ + hi_) >> 1; if (biasL[mid * KVBLK + KVBLK - 1] < bref) lo_ = mid + 1; else hi_ = mid; }
        j_lo = __builtin_amdgcn_readfirstlane(lo_); }
    const int NT = NTF - j_lo;
    const float* bl = biasL + 4 * hi;
    float m_reg = -1e30f, l_reg = 0; f32x16 o[4] = {};
    const int sr = tid >> 4, sc = (tid & 15) * 8, vst0 = v_st(sr, sc), vst1 = v_st(32 + sr, sc), kws = KSWZ(sr, sc * 2);
    const unsigned voff = (unsigned)(sr * PITCH + sc) * 2u, qoff = (unsigned)((wid * QBLK + r32) * PITCH + hi * 8) * 2u;
    const int vb0 = (int)(uintptr_t)V_lds + v_rd_base(lane);
    const bf16* Kh = cur.K; const bf16* Vh = cur.V;
#define RESC(a) do { if (__any((a) < 1.f)) { if (hi == 0) al_l[r32] = (a); asm volatile("s_waitcnt lgkmcnt(0)" ::: "memory");              \
                     for (int d_ = 0; d_ < 4; ++d_) for (int r = 0; r < 16; ++r) o[d_][r] *= al_l[crow(r, hi)]; } } while (0)
#define KBASE(t) ((j_lo + (NT - 1 - (t))) * KVBLK)
#define MASKT(P0_, P1_, t) do { const int kb_ = KBASE(t); if (kb_ + KVBLK - 1 > qlo) mask_tile(P0_, P1_, qm - kb_, (unsigned)W); } while (0)
    constexpr int NQL = 8;
#define SEAM_K0() do { VMWN(NQL); SWRITE_HK(0); SBAR(); } while (0)
    f32x16 pA0, pA1, pB0, pB1; float mnA, mnB, alA, alB; bf16x8 pa0, pa1, pa2, pa3;
    SLOAD_H(Kh, Vh, KBASE(0)); VMW(); SWRITE_HK(0); SWRITE_HV(0); __syncthreads();
    SBAR();
    if (NT > 1) { SLOAD_H(Kh, Vh, KBASE(1)); }
    SBAR(); qkt<0>(pA0, pA1, K_lds, bl + KBASE(0), r32, hi, S.qr);
    MASKT(pA0, pA1, 0); partialSM(pA0, pA1, m_reg, mnA, alA);
    if (NT > 1) { VMW(); SWRITE_H(1); }
    __syncthreads();
#define HALF_STEP(PX0, PX1, mnX, alX, PY0, PY1, alY, t, KB, VB, SB) do {                                                      \
        SBAR(); qkt<KB>(PX0, PX1, K_lds, bl + KBASE(t), r32, hi, S.qr);                                             \
        finishSM(PY0, PY1, alY, l_reg, pa0, pa1, pa2, pa3); SBAR();                                                           \
        if ((t) + 1 < NT) { SLOAD_H(Kh, Vh, KBASE((t) + 1)); SBAR(); }                                               \
        pv_tile<VB>(o, vb0, pa0, pa1, pa2, pa3); MASKT(PX0, PX1, (t)); partialSM(PX0, PX1, m_reg, mnX, alX);                                        \
        __syncthreads();                                                                                                      \
        if ((t) + 1 < NT) { VMW(); SWRITE_H(SB); }                                                                          \
        RESC(alX); __syncthreads(); } while (0)
    for (int t = 1; t + 1 < NT; t += 2) {
        HALF_STEP(pB0, pB1, mnB, alB, pA0, pA1, alA, t, 1, 0, 0);
        HALF_STEP(pA0, pA1, mnA, alA, pB0, pB1, alB, t + 1, 0, 1, 1);
    }
    const bool even = (NT & 1) == 0;
    if (even) { SBAR(); qkt<1>(pB0, pB1, K_lds, bl + KBASE(NT - 1), r32, hi, S.qr); SBAR(); }
#pragma unroll
    for (int d0 = 0; d0 < 8; ++d0) S.qr[d0] = load8((const bf16*)((const char*)nxt.Q + (qoff + d0 * 32)));
    SBAR();
    finishSM(pA0, pA1, alA, l_reg, pa0, pa1, pa2, pa3); SBAR();
    pv_tile<0>(o, vb0, pa0, pa1, pa2, pa3);
    if (even) { MASKT(pB0, pB1, NT - 1); partialSM(pB0, pB1, m_reg, mnB, alB); __syncthreads(); RESC(alB);
        finishSM(pB0, pB1, alB, l_reg, pa0, pa1, pa2, pa3); SBAR(); pv_tile<1>(o, vb0, pa0, pa1, pa2, pa3); }
    SBAR();
    if (hi == 0) li_l[r32] = l_reg; asm volatile("s_waitcnt lgkmcnt(0)" ::: "memory");
    float rli[16];
#pragma unroll
    for (int r = 0; r < 16; ++r) rli[r] = __builtin_amdgcn_rcpf(li_l[crow(r, hi)]);
    char* Ow = (char*)cur.O; const unsigned ooff = (unsigned)((wid * QBLK + 4 * hi) * OPITCH + r32) * 2u;
    const char* Gq = (const char*)cur.Q + GATE_OFF * 2; const unsigned goff = (unsigned)((wid * QBLK + 4 * hi) * PITCH + r32) * 2u;
    unsigned short gq[16][4];
#pragma unroll
    for (int r = 0; r < 16; ++r)
#pragma unroll
        for (int d0 = 0; d0 < 4; ++d0) gq[r][d0] = *(const unsigned short*)(Gq + (goff + (unsigned)(((r & 3) + 8 * (r >> 2)) * PITCH + d0 * 32) * 2u));
#pragma unroll
    for (int r = 0; r < 16; ++r) {
#pragma unroll
        for (int d0 = 0; d0 < 4; ++d0) { const unsigned short gw = gq[r][d0];
            const float gl = __builtin_bit_cast(float, (unsigned)gw << 16);
            const float v = o[d0][r] * rli[r] * __builtin_amdgcn_rcpf(1.0f + __builtin_amdgcn_exp2f(-1.4426950408889634f * gl));
            const float vn = xor1_get(v);
            if ((r32 & 1) == 0) *(unsigned*)(Ow + (ooff + (unsigned)(((r & 3) + 8 * (r >> 2)) * OPITCH + d0 * 32) * 2u)) = cvtpk(v, vn); } }
    __syncthreads();
#undef RESC
#undef KBASE
#undef MASKT
#undef SEAM_K0
#undef HALF_STEP
}
#undef ROW
#undef VMW
#undef VMWN
#undef SLOAD_H
#undef SWRITE_HK
#undef SWRITE_HV
#undef SWRITE_H
#undef KSWZ
#undef SBAR
}

constexpr int NWAVES = 8, NTHREADS = NWAVES * 64;
constexpr int DM = 2048, BATCH = 2, T = 8192, M = BATCH * T, DEPTH = 4;
constexpr int AB_IN = 8200, AB_N = 8192;
constexpr int C_IN = 6160, C_N = 6144;
constexpr int FF = 5632, FF2 = 2 * FF;
constexpr float EPS = 1e-6f;
enum PhaseKind { K_NORM1 = 0, K_MIXIN, K_PREP, K_REC, K_POST, K_MIXOUT, K_NORM2, K_FFIN, K_FFOUT, K_PRO };
constexpr int phase_base(int layer) { return 1 + 9 * layer; }
constexpr int N_PHASES = phase_base(DEPTH);
constexpr int CW_QUEUE = 8192;
inline int phase_kind(int p, int& layer) { if (p == 0) { layer = 0; return K_PRO; } for (layer = DEPTH - 1; phase_base(layer) > p; --layer) {} return p - phase_base(layer); }
constexpr size_t MiB = 1u << 20;
constexpr size_t WS_CTL = 0, CTL_ZERO_BYTES = 1 * MiB;
constexpr size_t WS_MOD = 1 * MiB;
constexpr size_t WS_LOGF = 2 * MiB;
constexpr size_t WS_BIAS = 3 * MiB;
constexpr size_t WS_GLOW = 4 * MiB;
constexpr size_t WS_W_ABIN = 8 * MiB, WS_W_ABOUT = 72 * MiB, WS_W_GLIN = 88 * MiB, WS_W_GLOUT = 136 * MiB, WS_W_FFIN = 152 * MiB, WS_W_FFOUT = 328 * MiB;
constexpr size_t WS_H = 416 * MiB, WS_CAT = 480 * MiB, WS_PROJ = 544 * MiB, WS_FFH = WS_PROJ, WS_O = 800 * MiB, WS_REC = 928 * MiB, WS_Y = 1064 * MiB, WS_XB = 1128 * MiB, WS_END = 1192 * MiB;
constexpr int CW_BAR = 4096;
constexpr int CW_CONV = 16384;
constexpr int RING_OFF = 0, RING_BYTES = 139264;
constexpr int LDSCTL_OFF = RING_BYTES, MISC_OFF = LDSCTL_OFF + 320;
constexpr int LDS_BYTES = 155648;
static_assert(fox::LDS_BYTES <= RING_BYTES, "attention LDS");

#define GAS __attribute__((address_space(1)))
#define LAS __attribute__((address_space(3)))
typedef unsigned short bf16;
typedef unsigned v4u __attribute__((ext_vector_type(4)));
typedef unsigned v2u __attribute__((ext_vector_type(2)));
typedef float f32x4 __attribute__((ext_vector_type(4)));
typedef GAS unsigned gu32;
#define RLX_AGENT __ATOMIC_RELAXED, __HIP_MEMORY_SCOPE_AGENT
#define LDS_WAIT() asm volatile("s_waitcnt lgkmcnt(0)" ::: "memory")
__device__ __forceinline__ unsigned pk2(float lo, float hi) { unsigned r; asm("v_cvt_pk_bf16_f32 %0, %1, %2" : "=v"(r) : "v"(lo), "v"(hi)); return r; }
__device__ __forceinline__ unsigned f2bf(float f) { return pk2(f, f) & 0xffffu; }
__device__ __forceinline__ float bf_lo(unsigned w) { return __builtin_bit_cast(float, w << 16); }
__device__ __forceinline__ float bf_hi(unsigned w) { return __builtin_bit_cast(float, w & 0xffff0000u); }
__device__ __forceinline__ float bf1(bf16 h) { return __builtin_bit_cast(float, (unsigned)h << 16); }
__device__ __forceinline__ float sigmoid_f(float x) { return __builtin_amdgcn_rcpf(1.0f + __expf(-x)); }
__device__ __forceinline__ float silu_x(float x) { return x * __builtin_amdgcn_rcpf(1.0f + __expf(-x)); }
__device__ __forceinline__ float log_sigmoid_f(float x) { return fminf(x, 0.f) - log1pf(__expf(-fabsf(x))); }
__device__ __forceinline__ float log_sigmoid_fast(float x) { return fminf(x, 0.f) - __logf(1.0f + __expf(-fabsf(x))); }
__device__ __forceinline__ float wave_sum(float v) {
    v = xsum<1>(v); v = xsum<2>(v); v = xsum<4>(v); v = xsum<8>(v); v = xsum<16>(v); v = xsum<32>(v);
    return v;
}

#define XB_TMO      128
#define XB_XCNT(j)  (256  + 64 * (j))
#define XB_XSUB(j)  (1280 + 64 * (j))
#define XB_XGEN(j)  (2304 + 64 * (j))
#define XB_TOP      3328
#define XB_TOPGEN   3392
#define XCD_BAR_WORDS 3456
#define XB_SPIN_CAP (1u << 18)
__device__ __forceinline__ unsigned xb_ld(unsigned* p)              { return __hip_atomic_load(p, __ATOMIC_RELAXED, __HIP_MEMORY_SCOPE_AGENT); }
__device__ __forceinline__ unsigned xb_add(unsigned* p, unsigned v) { return __hip_atomic_fetch_add(p, v, __ATOMIC_RELAXED, __HIP_MEMORY_SCOPE_AGENT); }
__device__ __forceinline__ unsigned xb_xcc_id() { return (unsigned)__builtin_amdgcn_s_getreg((3 << 11) | 20) & 0xFu; }
#define XB_SPIN(cond, bar) do { unsigned _sp = 0; while (cond) { __builtin_amdgcn_s_sleep(1); \
    if ((++_sp & 255u) == 0u) { if (xb_ld(&(bar)[XB_TMO])) break; if (_sp > XB_SPIN_CAP) { atomicAdd(&(bar)[XB_TMO], 1u); break; } } } } while (0)
struct XcdBarrier { unsigned* bar; unsigned x; volatile LAS unsigned* st; };
__device__ __forceinline__ XcdBarrier xcd_barrier_post(unsigned* bar, volatile LAS unsigned* st, bool tid0) {
    XcdBarrier b; b.bar = bar; b.x = xb_xcc_id(); b.st = st;
    if (tid0) (void)xb_add(&bar[XB_XCNT(b.x)], 1u);
    return b;
}
__device__ __forceinline__ void xcd_barrier_complete(unsigned* bar, unsigned x, unsigned& nloc, unsigned& nx) {
    const unsigned G = gridDim.x * gridDim.y * gridDim.z;
    unsigned sum, cnt, mine, sp = 0u;
    for (;;) {
        sum = 0u; cnt = 0u; mine = 0u;
#pragma unroll
        for (unsigned j = 0; j < 16; ++j) { const unsigned c = xb_ld(&bar[XB_XCNT(j)]); sum += c; cnt += (c > 0u) ? 1u : 0u; mine = (j == x) ? c : mine; }
        if (sum == G) break;
        __builtin_amdgcn_s_sleep(1);
        if ((++sp & 255u) == 0u) { if (xb_ld(&bar[XB_TMO])) break; if (sp > XB_SPIN_CAP) { atomicAdd(&bar[XB_TMO], 1u); break; } }
    }
    nloc = mine > 0u ? mine : 1u; nx = cnt > 0u ? cnt : 1u;
}
template <bool FIRST>
__device__ __forceinline__ void xcd_barrier(const XcdBarrier& b, bool tid0) {
    asm volatile("s_waitcnt vmcnt(0)" ::: "memory");
    __syncthreads();
    if (tid0) {
        unsigned* bar = b.bar;
        __builtin_amdgcn_s_waitcnt(0);
        unsigned nloc = b.st[0], nx = b.st[1];
        if (FIRST) { if (nloc == 0u) { xcd_barrier_complete(bar, b.x, nloc, nx); b.st[0] = nloc; b.st[1] = nx; } }
        else { if (nloc == 0u) nloc = 1u; if (nx == 0u) nx = 1u; }
        const unsigned old = xb_add(&bar[XB_XSUB(b.x)], 1u);
        const unsigned gen = old / nloc;
        if (old + 1u == (gen + 1u) * nloc) {
            __builtin_amdgcn_fence(__ATOMIC_RELEASE, "agent");
            asm volatile("s_waitcnt vmcnt(0)" ::: "memory");
            const unsigned og = xb_add(&bar[XB_TOP], 1u);
            const unsigned tg = og / nx;
            if (og + 1u == (tg + 1u) * nx) xb_add(&bar[XB_TOPGEN], 1u);
            else XB_SPIN(xb_ld(&bar[XB_TOPGEN]) == tg, bar);
            __builtin_amdgcn_fence(__ATOMIC_ACQUIRE, "agent");
            xb_add(&bar[XB_XGEN(b.x)], 1u);
            asm volatile("s_waitcnt vmcnt(0)" ::: "memory");
        } else {
            XB_SPIN(xb_ld(&bar[XB_XGEN(b.x)]) == gen, bar);
            __builtin_amdgcn_fence(__ATOMIC_ACQUIRE, "agent");
            asm volatile("s_waitcnt vmcnt(0)" ::: "memory");
        }
    }
    __syncthreads();
}

struct Args { const float* in[20]; float* out; unsigned char* ws; int ph_lo, ph_hi, use_bar, pad; };
typedef const Args __attribute__((address_space(4))) CArgs;
__device__ __forceinline__ CArgs* opq_args() { CArgs* p = (CArgs*)__builtin_amdgcn_kernarg_segment_ptr(); asm volatile("" : "+s"(p)); return p; }
struct Frame {
    LAS unsigned char* lds;
    int tid, lane, wave, G, bid;
};

__device__ __forceinline__ void transpose_item(const float* W, int ldn, int K, bf16* WT, int k0, int n0, int drow0, LAS float* scr, int lane) {
    f32x4 v[16];
    const float* src = W + (size_t)(k0 + (lane >> 4)) * ldn + n0 + 4 * (lane & 15);
#pragma unroll
    for (int i = 0; i < 16; ++i) v[i] = *(const f32x4*)(src + (size_t)(4 * i) * ldn);
#pragma unroll
    for (int i = 0; i < 16; ++i) { LAS float* d = scr + (4 * i + (lane >> 4)) * 65 + 4 * (lane & 15); d[0] = v[i].x; d[1] = v[i].y; d[2] = v[i].z; d[3] = v[i].w; }
    LDS_WAIT(); asm volatile("" ::: "memory");
    const int c = lane & 7, r = lane >> 3;
#pragma unroll
    for (int j = 0; j < 8; ++j) { const int n = r + 8 * j; const LAS float* s = scr + (8 * c) * 65 + n;
        v4u o; o.x = pg8::cvt_pk_bf16(s[0 * 65], s[1 * 65]); o.y = pg8::cvt_pk_bf16(s[2 * 65], s[3 * 65]); o.z = pg8::cvt_pk_bf16(s[4 * 65], s[5 * 65]); o.w = pg8::cvt_pk_bf16(s[6 * 65], s[7 * 65]);
        *(GAS v4u*)(WT + (size_t)(drow0 + n) * K + k0 + 8 * c) = o; }
    LDS_WAIT(); asm volatile("" ::: "memory");
}
template <int MODE>
__device__ __forceinline__ void transpose_matrix(const float* W, int nmat, int K, int ldn, int ncols, bf16* WT, LAS float* scr, int gw, int NGW, int lane, unsigned* ctr = nullptr, int wave = 0, bool tid0 = false, volatile LAS unsigned* slot = nullptr) {
    const int nblk = ncols / 64, kblk = K / 64, per = nblk * kblk, total = per * nmat;
#define TM_ITEM(it) do { const int mat = (it) / per, r = (it) - mat * per, kb = r / nblk, nb = r - kb * nblk, n0 = 64 * nb; int drow0 = n0; \
        if (MODE == 1) { if (n0 < FF) drow0 = (n0 / 128) * 256 + (n0 % 128); else { const int n1 = n0 - FF; drow0 = (n1 / 128) * 256 + 128 + (n1 % 128); } } \
        if (MODE == 2) drow0 = n0 < 3072 ? n0 : (n0 < 4096 ? n0 + 4096 : n0 - 1024); \
        transpose_item(W + (size_t)mat * K * ldn, ldn, K, WT + (size_t)mat * ncols * K, 64 * kb, n0, drow0, scr, lane); } while (0)
    if (ctr == nullptr) { for (int it = gw; it < total; it += NGW) TM_ITEM(it); }
    else {
        unsigned pend = 0u; if (tid0) pend = __hip_atomic_fetch_add(ctr, 16u, __ATOMIC_RELAXED, __HIP_MEMORY_SCOPE_AGENT);
        for (;;) {
            if (tid0) *slot = pend;
            __syncthreads();
            const int base = __builtin_amdgcn_readfirstlane((int)*slot);
            __syncthreads();
            if (base >= total) break;
            if (tid0) pend = __hip_atomic_fetch_add(ctr, 16u, __ATOMIC_RELAXED, __HIP_MEMORY_SCOPE_AGENT);
#pragma unroll 1
            for (int k = 0; k < 2; ++k) { const int it = base + 8 * k + wave; if (it < total) TM_ITEM(it); } } }
#undef TM_ITEM
}
template <int SET>
__device__ __forceinline__ void convert_weights(CArgs* ap, LAS float* scr, int gw, int NGW, int lane, unsigned* ctr = nullptr, int wave = 0, bool tid0 = false, volatile LAS unsigned* slot = nullptr) {
#define CWC(k) (ctr ? ctr + 64 * (k) : nullptr), wave, tid0, slot
    unsigned char* ws = ap->ws;
    bf16* abin = (bf16*)(ws + WS_W_ABIN); bf16* about = (bf16*)(ws + WS_W_ABOUT); bf16* glin = (bf16*)(ws + WS_W_GLIN); bf16* glout = (bf16*)(ws + WS_W_GLOUT); bf16* ffin = (bf16*)(ws + WS_W_FFIN); bf16* ffout = (bf16*)(ws + WS_W_FFOUT);
    constexpr size_t S_ABIN_W = (size_t)DM * AB_IN, S_ABIN_T = (size_t)AB_N * DM, S_SQ = (size_t)DM * DM, S_GLIN_W = (size_t)DM * C_IN, S_GLIN_T = (size_t)C_N * DM, S_FFIN = (size_t)DM * FF2, S_FFOUT = (size_t)FF * DM;
    if (SET == 0) {
        transpose_matrix<2>(ap->in[6], 1, DM, AB_IN, AB_N, abin, scr, gw, NGW, lane);
        transpose_matrix<0>(ap->in[7], 1, DM, DM, DM, about, scr, gw, NGW, lane);
        transpose_matrix<1>(ap->in[18], 1, DM, FF2, FF2, ffin, scr, gw, NGW, lane);
        transpose_matrix<0>(ap->in[19], 1, FF, DM, DM, ffout, scr, gw, NGW, lane);
        transpose_matrix<0>(ap->in[13], 1, DM, C_IN, C_N, glin, scr, gw, NGW, lane);
    } else if (SET == 1) {
        transpose_matrix<0>(ap->in[17], 1, DM, DM, DM, glout, scr, gw, NGW, lane, CWC(0));
        transpose_matrix<1>(ap->in[18] + S_FFIN, 2, DM, FF2, FF2, ffin + S_FFIN, scr, gw, NGW, lane, CWC(1));
        transpose_matrix<0>(ap->in[19] + S_FFOUT, 2, FF, DM, DM, ffout + S_FFOUT, scr, gw, NGW, lane, CWC(2));
        transpose_matrix<2>(ap->in[6] + S_ABIN_W, 1, DM, AB_IN, AB_N, abin + S_ABIN_T, scr, gw, NGW, lane, CWC(3));
        transpose_matrix<0>(ap->in[7] + S_SQ, 1, DM, DM, DM, about + S_SQ, scr, gw, NGW, lane, CWC(4));
        transpose_matrix<0>(ap->in[13] + S_GLIN_W, 1, DM, C_IN, C_N, glin + S_GLIN_T, scr, gw, NGW, lane, CWC(5));
    } else {
        transpose_matrix<0>(ap->in[17] + S_SQ, 1, DM, DM, DM, glout + S_SQ, scr, gw, NGW, lane, CWC(8));
        transpose_matrix<1>(ap->in[18] + 3 * S_FFIN, 1, DM, FF2, FF2, ffin + 3 * S_FFIN, scr, gw, NGW, lane, CWC(9));
        transpose_matrix<0>(ap->in[19] + 3 * S_FFOUT, 1, FF, DM, DM, ffout + 3 * S_FFOUT, scr, gw, NGW, lane, CWC(10));
    }
#undef CWC
}
__device__ __forceinline__ void p0_prologue(Frame& F, CArgs* ap) {
    unsigned char* ws = ap->ws;
    {
        LAS float* sc = (LAS float*)(F.lds);
        LAS float* part = (LAS float*)(F.lds + 16384);
        const float* c = ap->in[1];
        for (int i = F.tid; i < 2 * DM; i += NTHREADS) sc[i] = silu_x(c[i]);
        __syncthreads();
        const float* mw = ap->in[2]; const float* mb = ap->in[3]; float* mod = (float*)(ws + WS_MOD);
        constexpr int NU = DEPTH * (6 * DM / 64);
        for (int u = F.bid; u < NU; u += F.G) {
            const int layer = u / (6 * DM / 64), colb = (u % (6 * DM / 64)) * 64, kk = F.lane >> 4, c4 = F.lane & 15;
            const float* wp = mw + ((size_t)layer * DM + F.wave * 256 + kk) * (6 * DM) + colb + 4 * c4;
            f32x4 a0 = {0.f, 0.f, 0.f, 0.f}, a1 = {0.f, 0.f, 0.f, 0.f};
            for (int i0 = 0; i0 < 64; i0 += 16) { f32x4 wv[16];
#pragma unroll
                for (int i = 0; i < 16; ++i) wv[i] = *(const f32x4*)(wp + (size_t)(4 * (i0 + i)) * (6 * DM));
#pragma unroll
                for (int i = 0; i < 16; ++i) { const int k = F.wave * 256 + 4 * (i0 + i) + kk; a0 = a0 + wv[i] * sc[k]; a1 = a1 + wv[i] * sc[DM + k]; } }
            a0.x = xsum<16>(a0.x); a0.x = xsum<32>(a0.x); a0.y = xsum<16>(a0.y); a0.y = xsum<32>(a0.y); a0.z = xsum<16>(a0.z); a0.z = xsum<32>(a0.z); a0.w = xsum<16>(a0.w); a0.w = xsum<32>(a0.w);
            a1.x = xsum<16>(a1.x); a1.x = xsum<32>(a1.x); a1.y = xsum<16>(a1.y); a1.y = xsum<32>(a1.y); a1.z = xsum<16>(a1.z); a1.z = xsum<32>(a1.z); a1.w = xsum<16>(a1.w); a1.w = xsum<32>(a1.w);
            if (F.lane < 16) { *(LAS f32x4*)(part + (F.wave * 2 + 0) * 64 + 4 * c4) = a0; *(LAS f32x4*)(part + (F.wave * 2 + 1) * 64 + 4 * c4) = a1; }
            __syncthreads();
            if (F.tid < 128) { const int b = F.tid >> 6, l = F.tid & 63; float s = 0.f;
#pragma unroll
                for (int w = 0; w < 8; ++w) s += part[(w * 2 + b) * 64 + l];
                const int cc = (u % (6 * DM / 64)) * 64 + l;
                mod[((size_t)layer * 2 + b) * (6 * DM) + cc] = s + mb[(size_t)layer * (6 * DM) + cc]; }
            __syncthreads();
        }
    }
    __syncthreads();
    LAS float* scr = (LAS float*)(F.lds + RING_OFF + F.wave * 16640);
    const int gw = F.bid * NWAVES + F.wave, NGW = F.G * NWAVES;
    convert_weights<0>(ap, scr, gw, NGW, F.lane);
}

template <int MASK> __device__ __forceinline__ float xget(float v) { return __builtin_bit_cast(float, __builtin_amdgcn_ds_swizzle(__builtin_bit_cast(int, v), (MASK << 10) | 0x1f)); }
template <int N> __device__ __forceinline__ float rs_reduce(float (&a)[N], int lane) {
    if (N == 16) {
#pragma unroll
        for (int i = 0; i < 8; ++i) { const bool up = lane & 1; const float keep = up ? a[i + 8] : a[i], send = up ? a[i] : a[i + 8]; a[i] = keep + xget<1>(send); } }
    if (N >= 8) {
#pragma unroll
        for (int i = 0; i < 4; ++i) { const bool up = lane & (N == 16 ? 2 : 1); const float keep = up ? a[i + 4] : a[i], send = up ? a[i] : a[i + 4]; a[i] = keep + (N == 16 ? xget<2>(send) : xget<1>(send)); } }
#pragma unroll
    for (int i = 0; i < 2; ++i) { const bool up = lane & (N == 16 ? 4 : 2); const float keep = up ? a[i + 2] : a[i], send = up ? a[i] : a[i + 2]; a[i] = keep + (N == 16 ? xget<4>(send) : xget<2>(send)); }
    { const bool up = lane & (N == 16 ? 8 : 4); const float keep = up ? a[1] : a[0], send = up ? a[0] : a[1]; a[0] = keep + (N == 16 ? xget<8>(send) : xget<4>(send)); }
    float r = a[0];
    if (N == 8) r = xsum<8>(r);
    r = xsum<16>(r); r = xsum<32>(r);
    return r;
}
template <int N> __device__ __forceinline__ int rs_col(int lane) { return N == 16 ? (((lane & 1) << 3) | ((lane & 2) << 1) | ((lane & 4) >> 1) | ((lane & 8) >> 3)) : (((lane & 1) << 2) | (lane & 2) | ((lane & 4) >> 2)); }
template <int NC, int MODE, bool RES, bool XF32>
__device__ __forceinline__ void norm_phase(Frame& F, const void* xin, const float* gain, const float* mod_sh, const float* mod_sc  ,
                                           bf16* hout, const float* Wsm, int ldn, const float* fbias, float* sout, const bf16* yres = nullptr, const float* rgate = nullptr, bf16* xb = nullptr) {
    LAS float* wl = (LAS float*)(F.lds);
    if (NC > 0) {
        for (int i = F.tid; i < NC * DM; i += NTHREADS) { const int k = i / NC, c = i % NC; wl[c * DM + k] = Wsm[(size_t)k * ldn + c]; }
        __syncthreads();
    }
    f32x4 gm[8], shv[8]; int bprev = -1;
    for (int mp = F.bid * NWAVES + F.wave; mp < M / 2; mp += F.G * NWAVES) {
        const int m0 = 2 * mp, b = m0 / T;
        if (b != bprev) { bprev = b; const f32x4* gp = (const f32x4*)gain + F.lane; const f32x4* shp = (const f32x4*)(mod_sh + (size_t)b * 6 * DM) + F.lane; const f32x4* scp = (const f32x4*)(mod_sc + (size_t)b * 6 * DM) + F.lane;
#pragma unroll
            for (int j = 0; j < 8; ++j) { gm[j] = gp[64 * j] * (scp[64 * j] + 1.0f); shv[j] = shp[64 * j]; } }
        f32x4 v[2][8]; float s0 = 0.f, s1 = 0.f;
        v2u yv[2][8];
        if (RES) { const GAS v2u* yr = (const GAS v2u*)(yres + (size_t)m0 * DM) + F.lane;
#pragma unroll
            for (int j = 0; j < 8; ++j) { yv[0][j] = yr[64 * j]; yv[1][j] = yr[512 + 64 * j]; } }
        if (XF32) { const GAS f32x4* xr = (const GAS f32x4*)((const float*)xin + (size_t)m0 * DM) + F.lane;
#pragma unroll
            for (int j = 0; j < 8; ++j) { v[0][j] = xr[64 * j]; v[1][j] = xr[512 + 64 * j]; } }
        else { const GAS v2u* xr = (const GAS v2u*)((const bf16*)xin + (size_t)m0 * DM) + F.lane; v2u xv[2][8];
#pragma unroll
            for (int j = 0; j < 8; ++j) { xv[0][j] = xr[64 * j]; xv[1][j] = xr[512 + 64 * j]; }
#pragma unroll
            for (int j = 0; j < 8; ++j) { v[0][j] = (f32x4){bf_lo(xv[0][j].x), bf_hi(xv[0][j].x), bf_lo(xv[0][j].y), bf_hi(xv[0][j].y)}; v[1][j] = (f32x4){bf_lo(xv[1][j].x), bf_hi(xv[1][j].x), bf_lo(xv[1][j].y), bf_hi(xv[1][j].y)}; } }
        if (RES) { const f32x4* rg = (const f32x4*)(rgate + (size_t)b * 6 * DM) + F.lane; GAS v2u* xo = (GAS v2u*)(xb + (size_t)m0 * DM) + F.lane;
#pragma unroll
            for (int j = 0; j < 8; ++j) { const f32x4 g = rg[64 * j];
                v[0][j] = v[0][j] + g * (f32x4){bf_lo(yv[0][j].x), bf_hi(yv[0][j].x), bf_lo(yv[0][j].y), bf_hi(yv[0][j].y)}; v[1][j] = v[1][j] + g * (f32x4){bf_lo(yv[1][j].x), bf_hi(yv[1][j].x), bf_lo(yv[1][j].y), bf_hi(yv[1][j].y)};
                v2u w; w.x = pk2(v[0][j].x, v[0][j].y); w.y = pk2(v[0][j].z, v[0][j].w); xo[64 * j] = w;
                w.x = pk2(v[1][j].x, v[1][j].y); w.y = pk2(v[1][j].z, v[1][j].w); xo[512 + 64 * j] = w; } }
#pragma unroll
        for (int j = 0; j < 8; ++j) { s0 += (v[0][j].x * v[0][j].x + v[0][j].y * v[0][j].y) + (v[0][j].z * v[0][j].z + v[0][j].w * v[0][j].w);
                                      s1 += (v[1][j].x * v[1][j].x + v[1][j].y * v[1][j].y) + (v[1][j].z * v[1][j].z + v[1][j].w * v[1][j].w); }
        const float rstd0 = __builtin_amdgcn_rsqf(wave_sum(s0) * (1.f / DM) + EPS), rstd1 = __builtin_amdgcn_rsqf(wave_sum(s1) * (1.f / DM) + EPS);
        GAS v2u* o8 = (GAS v2u*)(hout + (size_t)m0 * DM) + F.lane;
#pragma unroll
        for (int j = 0; j < 8; ++j) { const f32x4 g = gm[j], sh = shv[j];
            v[0][j] = (v[0][j] * rstd0) * g + sh; v[1][j] = (v[1][j] * rstd1) * g + sh;
            v2u w; w.x = pk2(v[0][j].x, v[0][j].y); w.y = pk2(v[0][j].z, v[0][j].w); o8[64 * j] = w;
            w.x = pk2(v[1][j].x, v[1][j].y); w.y = pk2(v[1][j].z, v[1][j].w); o8[512 + 64 * j] = w; }
        if constexpr (NC > 0) {
            float a0[NC], a1[NC];
#pragma unroll
            for (int c = 0; c < NC; ++c) { float acc0 = 0.f, acc1 = 0.f;
#pragma unroll
                for (int j = 0; j < 8; ++j) { const f32x4 w = *(const LAS f32x4*)(wl + c * DM + 256 * j + 4 * F.lane);
                    acc0 += (v[0][j].x * w.x + v[0][j].y * w.y) + (v[0][j].z * w.z + v[0][j].w * w.w); acc1 += (v[1][j].x * w.x + v[1][j].y * w.y) + (v[1][j].z * w.z + v[1][j].w * w.w); }
                a0[c] = acc0; a1[c] = acc1; __builtin_amdgcn_sched_barrier(0); }
            const float r0 = rs_reduce<NC>(a0, F.lane), r1 = rs_reduce<NC>(a1, F.lane); const int cc = rs_col<NC>(F.lane);
            if (MODE == 1) { const int t = m0 % T; if (F.lane < NC) { const float fb = fbias[cc]; sout[((size_t)b * 8 + cc) * T + t] = log_sigmoid_f(r0 + fb); sout[((size_t)b * 8 + cc) * T + t + 1] = log_sigmoid_f(r1 + fb); } }
            if (MODE == 2) { if (F.lane < NC) { sout[(size_t)m0 * 16 + cc] = r0; sout[(size_t)m0 * 16 + 16 + cc] = r1; } }
        }
    }
}

__device__ __forceinline__ void resid_final(Frame& F, const bf16* xb, const bf16* yres, const float* rgate, float* xout) {
    for (int mp = F.bid * NWAVES + F.wave; mp < M / 2; mp += F.G * NWAVES) {
        const int m0 = 2 * mp, b = m0 / T;
        const GAS v2u* xr = (const GAS v2u*)(xb + (size_t)m0 * DM) + F.lane; const GAS v2u* yr = (const GAS v2u*)(yres + (size_t)m0 * DM) + F.lane;
        const f32x4* rg = (const f32x4*)(rgate + (size_t)b * 6 * DM) + F.lane; GAS f32x4* xo = (GAS f32x4*)(xout + (size_t)m0 * DM) + F.lane;
        v2u xv[2][8], yv[2][8];
#pragma unroll
        for (int j = 0; j < 8; ++j) { xv[0][j] = xr[64 * j]; xv[1][j] = xr[512 + 64 * j]; yv[0][j] = yr[64 * j]; yv[1][j] = yr[512 + 64 * j]; }
#pragma unroll
        for (int j = 0; j < 8; ++j) { const f32x4 g = rg[64 * j];
            xo[64 * j] = (f32x4){bf_lo(xv[0][j].x), bf_hi(xv[0][j].x), bf_lo(xv[0][j].y), bf_hi(xv[0][j].y)} + g * (f32x4){bf_lo(yv[0][j].x), bf_hi(yv[0][j].x), bf_lo(yv[0][j].y), bf_hi(yv[0][j].y)};
            xo[512 + 64 * j] = (f32x4){bf_lo(xv[1][j].x), bf_hi(xv[1][j].x), bf_lo(xv[1][j].y), bf_hi(xv[1][j].y)} + g * (f32x4){bf_lo(yv[1][j].x), bf_hi(yv[1][j].x), bf_lo(yv[1][j].y), bf_hi(yv[1][j].y)}; }
    }
}

__device__ __forceinline__ void fox_prep(Frame& F, bf16* proj, const float* qg, const float* kg, const float* logf, float* bias) {
    const int gw = F.bid * NWAVES + F.wave, NGW = F.G * NWAVES;
    const f32x4 gq0 = *(const f32x4*)(qg + (F.lane & 15) * 8), gq1 = *(const f32x4*)(qg + (F.lane & 15) * 8 + 4), gk0 = *(const f32x4*)(kg + (F.lane & 15) * 8), gk1 = *(const f32x4*)(kg + (F.lane & 15) * 8 + 4);
    for (int m = gw; m < M; m += NGW) {
        GAS v4u* p = (GAS v4u*)(proj + (size_t)m * AB_N + 3072) + F.lane;
        v4u wv[4];
#pragma unroll
        for (int j = 0; j < 4; ++j) wv[j] = p[64 * j];
#pragma unroll
        for (int j = 0; j < 4; ++j) {
            const v4u w = wv[j];
            float e[8] = {bf_lo(w.x), bf_hi(w.x), bf_lo(w.y), bf_hi(w.y), bf_lo(w.z), bf_hi(w.z), bf_lo(w.w), bf_hi(w.w)};
            float s = 0.f;
#pragma unroll
            for (int i = 0; i < 8; ++i) s += e[i] * e[i];
            s = xsum<1>(s); s = xsum<2>(s); s = xsum<4>(s); s = xsum<8>(s);
            const float rstd = __builtin_amdgcn_rsqf(s * (1.f / 128.f) + EPS);
            const f32x4 g0 = j < 2 ? gq0 : gk0, g1 = j < 2 ? gq1 : gk1;
#pragma unroll
            for (int i = 0; i < 4; ++i) { e[i] = e[i] * rstd * g0[i]; e[4 + i] = e[4 + i] * rstd * g1[i]; }
            v4u o; o.x = pk2(e[0], e[1]); o.y = pk2(e[2], e[3]); o.z = pk2(e[4], e[5]); o.w = pk2(e[6], e[7]);
            p[64 * j] = o;
        }
    }
    if (F.bid < 16) {
        LAS double* tsum = (LAS double*)(F.lds);
        const float* lf = logf + (size_t)F.bid * T; float* bo = bias + (size_t)F.bid * T;
        double v[16]; double run = 0.0;
        const int i0 = F.tid * 16;
#pragma unroll
        for (int i = 0; i < 16; ++i) { run += (double)lf[i0 + i]; v[i] = run; }
        tsum[F.tid] = run;
        __syncthreads();
        LAS double* bsum = tsum + NTHREADS;
        if (F.tid < 8) { double s = 0.0; for (int w = 0; w < 64; ++w) s += tsum[F.tid * 64 + w]; bsum[F.tid] = s; }
        __syncthreads();
        double base = 0.0;
        for (int w = 0; w < F.wave; ++w) base += bsum[w];
        for (int w = 0; w < F.lane; ++w) base += tsum[F.wave * 64 + w];
        const double k = -11.313708498984761;
#pragma unroll
        for (int i = 0; i < 16; ++i) bo[i0 + i] = (float)((base + v[i]) * k);
        __syncthreads();
    }
}

#ifndef DBG_REC
#define DBG_REC 0
#endif
#if DBG_REC
template <bool GLA>
__device__ __forceinline__ void rec_naive(Frame& F, const bf16* proj, float* O, const float* lbl  , int lb_on,
                                          const float* glow, const float* wup  , const float* bgate  ) {
    constexpr int DK = GLA ? 256 : 128, DVH = GLA ? 512 : 128, NH = GLA ? 4 : 8, DVS = 32, NSL = DVH / DVS, TB = GLA ? 16 : 32;
    constexpr int PITCH = GLA ? C_N : AB_N, OPITCH = GLA ? 2048 : 1024;
    constexpr int R = DK / 16;
    constexpr int NPAIR = TB * DK / 2 / NTHREADS;
    constexpr int NUNITS = BATCH * NH * NSL;
    LAS float* sq = (LAS float*)(F.lds); LAS float* sf = sq + TB * DK; LAS float* sk = sf + TB * DK; LAS float* sv = sk + TB * DK; LAS float* part = sv + TB * DVS; LAS float* sgl = part + TB * 4 * DVS;
    const int lane = F.lane, e_l = lane & 15, dsub = lane >> 4, eg = F.wave & 1, dg = F.wave >> 1, e = eg * 16 + e_l, d0 = (dg * 4 + dsub) * R;
    for (int unit = F.bid; unit < NUNITS; unit += F.G) {
        const int sl = unit % NSL, h = (unit / NSL) % NH, b = unit / (NSL * NH);
        const bf16* pq = proj + (size_t)b * T * PITCH + h * DK;
        const bf16* pk = pq + 1024;
        const bf16* pv = proj + (size_t)b * T * PITCH + 2048 + h * DVH + sl * DVS;
        const int dp = 2 * (F.tid % (DK / 2)), tt0 = F.tid / (DK / 2); constexpr int TSTEP = NTHREADS / (DK / 2);
        float lb0 = 0.f, lb1 = 0.f; float wu0[16], wu1[16]; float bg0 = 0.f, bg1 = 0.f;
        if (!GLA) { if (lb_on) { const float l0a = lbl[h * DK + dp], l1a = lbl[1024 + h * DK + dp], l0b = lbl[h * DK + dp + 1], l1b = lbl[1024 + h * DK + dp + 1];
                                 lb0 = fminf(fmaxf(sigmoid_f(l1a - l0a), 0.f), 1.0f - 1e-6f); lb1 = fminf(fmaxf(sigmoid_f(l1b - l0b), 0.f), 1.0f - 1e-6f); } }
        else {
#pragma unroll
            for (int r = 0; r < 16; ++r) { wu0[r] = wup[r * 1024 + h * DK + dp]; wu1[r] = wup[r * 1024 + h * DK + dp + 1]; }
            bg0 = bgate[h * DK + dp]; bg1 = bgate[h * DK + dp + 1]; }
        const int vt = F.tid / 16, ve = 2 * (F.tid % 16); const bool vact = vt < TB;
        float S[R];
#pragma unroll
        for (int j = 0; j < R; ++j) S[j] = 0.f;
        unsigned rq[NPAIR], rk[NPAIR], rv = 0u; float rgl = 0.f;
#define REC_PREFETCH(t0) do { _Pragma("unroll") for (int i = 0; i < NPAIR; ++i) { const size_t row = (size_t)((t0) + tt0 + TSTEP * i); \
            rq[i] = *(const unsigned*)(pq + row * PITCH + dp); rk[i] = *(const unsigned*)(pk + row * PITCH + dp); \
            } \
            if (GLA && F.tid < TB * 16) rgl = glow[((size_t)b * T + (t0)) * 16 + F.tid]; \
            if (vact) rv = *(const unsigned*)(pv + (size_t)((t0) + vt) * PITCH + ve); } while (0)
        REC_PREFETCH(0);
        for (int t0 = 0; t0 < T; t0 += TB) {
            if (GLA) { if (F.tid < TB * 16) sgl[F.tid] = rgl; __syncthreads(); }
#pragma unroll
            for (int i = 0; i < NPAIR; ++i) { const int tt = tt0 + TSTEP * i; const float qa = bf_lo(rq[i]), qb = bf_hi(rq[i]), ka = bf_lo(rk[i]), kb = bf_hi(rk[i]);
                float q0, q1, f0, f1, k0, k1;
                if (!GLA) { q0 = silu_x(qa); q1 = silu_x(qb); const float s0 = sigmoid_f(ka), s1 = sigmoid_f(kb), n0 = sigmoid_f(-ka), n1 = sigmoid_f(-kb);
                    f0 = fmaxf(lb0 + (1.f - lb0) * s0, 1e-30f); f1 = fmaxf(lb1 + (1.f - lb1) * s1, 1e-30f); k0 = (1.f - lb0) * n0; k1 = (1.f - lb1) * n1; }
                else { q0 = qa * 0.0625f; q1 = qb * 0.0625f; k0 = ka; k1 = kb; float x0 = bg0, x1 = bg1;
#pragma unroll
                    for (int r = 0; r < 16; ++r) { const float g = sgl[tt * 16 + r]; x0 += g * wu0[r]; x1 += g * wu1[r]; }
                    f0 = __expf(log_sigmoid_f(x0) * 0.0625f); f1 = __expf(log_sigmoid_f(x1) * 0.0625f); }
                sq[tt * DK + dp] = q0; sq[tt * DK + dp + 1] = q1; sf[tt * DK + dp] = f0; sf[tt * DK + dp + 1] = f1; sk[tt * DK + dp] = k0; sk[tt * DK + dp + 1] = k1; }
            if (vact) { sv[vt * DVS + ve] = bf_lo(rv); sv[vt * DVS + ve + 1] = bf_hi(rv); }
            __syncthreads();
            if (t0 + TB < T) REC_PREFETCH(t0 + TB);
            for (int tt = 0; tt < TB; ++tt) {
                const float v = sv[tt * DVS + e]; float acc = 0.f;
#pragma unroll
                for (int g4 = 0; g4 < R / 4; ++g4) { const f32x4 f4 = *(const LAS f32x4*)(sf + tt * DK + d0 + 4 * g4), k4 = *(const LAS f32x4*)(sk + tt * DK + d0 + 4 * g4), q4 = *(const LAS f32x4*)(sq + tt * DK + d0 + 4 * g4);
#pragma unroll
                    for (int i = 0; i < 4; ++i) { S[4 * g4 + i] = f4[i] * S[4 * g4 + i] + k4[i] * v; acc += q4[i] * S[4 * g4 + i]; } }
                acc = xsum<16>(acc); acc = xsum<32>(acc);
                if (dsub == 0) part[(tt * 4 + dg) * DVS + e] = acc;
            }
            __syncthreads();
            for (int i = F.tid; i < TB * DVS; i += NTHREADS) { const int tt = i / DVS, ee = i % DVS;
                const float o = (part[(tt * 4 + 0) * DVS + ee] + part[(tt * 4 + 1) * DVS + ee]) + (part[(tt * 4 + 2) * DVS + ee] + part[(tt * 4 + 3) * DVS + ee]);
                O[((size_t)b * T + t0 + tt) * OPITCH + h * DVH + sl * DVS + ee] = o; }
        }
#undef REC_PREFETCH
        __syncthreads();
    }
}

#endif
#ifndef DBG_ZERO
#define DBG_ZERO 0
#endif
__device__ __forceinline__ void post_even(Frame& F, const bf16* O, const bf16* proj, const float* gain  , bf16* cat) {
    const int gw = F.bid * NWAVES + F.wave, NGW = F.G * NWAVES;
    f32x4 gn[4];
#pragma unroll
    for (int j = 0; j < 4; ++j) gn[j] = *((const f32x4*)gain + 64 * j + F.lane);
    for (int mp = gw; mp < M / 2; mp += NGW) {
        const int m = 2 * mp;
        const GAS v2u* op = (const GAS v2u*)(O + (size_t)m * 1024) + F.lane;
        const GAS v2u* ga = (const GAS v2u*)(proj + (size_t)m * AB_N + 7168) + F.lane;
        GAS v2u* cp = (GAS v2u*)(cat + (size_t)m * DM) + F.lane;
        v2u vr[2][4], gr[2][4];
#pragma unroll
        for (int r = 0; r < 2; ++r)
#pragma unroll
            for (int j = 0; j < 4; ++j) { vr[r][j] = op[r * 256 + 64 * j]; gr[r][j] = ga[r * (AB_N / 4) + 64 * j]; }
#pragma unroll
        for (int r = 0; r < 2; ++r)
#pragma unroll
        for (int j = 0; j < 4; ++j) {
            const f32x4 v = {bf_lo(vr[r][j].x), bf_hi(vr[r][j].x), bf_lo(vr[r][j].y), bf_hi(vr[r][j].y)}; float s = (v.x * v.x + v.y * v.y) + (v.z * v.z + v.w * v.w);
            s = xsum<1>(s); s = xsum<2>(s); s = xsum<4>(s); s = xsum<8>(s); s = xsum<16>(s);
            const float rstd = __builtin_amdgcn_rsqf(s * (1.f / 128.f) + EPS);
            const f32x4 g = gn[j];
            const v2u gw2 = gr[r][j];
            const float o0 = v.x * rstd * g.x * silu_x(bf_lo(gw2.x)), o1 = v.y * rstd * g.y * silu_x(bf_hi(gw2.x)), o2 = v.z * rstd * g.z * silu_x(bf_lo(gw2.y)), o3 = v.w * rstd * g.w * silu_x(bf_hi(gw2.y));
            v2u w; w.x = pk2(o0, o1); w.y = pk2(o2, o3); cp[r * 512 + 64 * j] = w;
        }
    }
}
__device__ __forceinline__ void post_odd(Frame& F, const bf16* O, const bf16* proj, const float* gain  , bf16* cat) {
    const int gw = F.bid * NWAVES + F.wave, NGW = F.G * NWAVES;
    const f32x4 gn0 = *((const f32x4*)gain + F.lane), gn1 = *((const f32x4*)gain + 64 + F.lane);
    for (int mp = gw; mp < M / 2; mp += NGW) {
        const int m = 2 * mp;
        const GAS v2u* op = (const GAS v2u*)(O + (size_t)m * DM) + F.lane;
        const GAS v2u* gg = (const GAS v2u*)(proj + (size_t)m * C_N + 4096) + F.lane;
        GAS v2u* cp = (GAS v2u*)(cat + (size_t)m * DM) + F.lane;
        v2u vr[2][8], gr[2][8];
#pragma unroll
        for (int r = 0; r < 2; ++r)
#pragma unroll
            for (int j = 0; j < 8; ++j) { vr[r][j] = op[r * 512 + 64 * j]; gr[r][j] = gg[r * (C_N / 4) + 64 * j]; }
#pragma unroll
        for (int r = 0; r < 2; ++r)
#pragma unroll
        for (int hh = 0; hh < 4; ++hh) {
            const v2u r0 = vr[r][2 * hh], r1 = vr[r][2 * hh + 1]; const f32x4 v0 = {bf_lo(r0.x), bf_hi(r0.x), bf_lo(r0.y), bf_hi(r0.y)}, v1 = {bf_lo(r1.x), bf_hi(r1.x), bf_lo(r1.y), bf_hi(r1.y)};
            float s = ((v0.x * v0.x + v0.y * v0.y) + (v0.z * v0.z + v0.w * v0.w)) + ((v1.x * v1.x + v1.y * v1.y) + (v1.z * v1.z + v1.w * v1.w));
            s = wave_sum(s);
            const float rstd = __builtin_amdgcn_rsqf(s * (1.f / 512.f) + EPS);
#pragma unroll
            for (int jj = 0; jj < 2; ++jj) { const f32x4 v = jj ? v1 : v0; const f32x4 g = jj ? gn1 : gn0; const v2u gw2 = gr[r][2 * hh + jj];
                const float o0 = v.x * rstd * g.x * silu_x(bf_lo(gw2.x)), o1 = v.y * rstd * g.y * silu_x(bf_hi(gw2.x)), o2 = v.z * rstd * g.z * silu_x(bf_lo(gw2.y)), o3 = v.w * rstd * g.w * silu_x(bf_hi(gw2.y));
                v2u w; w.x = pk2(o0, o1); w.y = pk2(o2, o3); cp[r * 512 + 64 * (2 * hh + jj)] = w; }
        }
    }
}

__device__ __forceinline__ fox::BlockRef fox_ref(int item, const bf16* proj, bf16* cat, const float* bias, float thp) {
    const int bh = item & 15, qb = 31 - (item >> 4), b = bh >> 3, h = bh & 7;
    fox::BlockRef r;
    const bf16* base = proj + (size_t)b * T * AB_N + h * 128;
    r.Q = (const fox::bf16*)(base + (size_t)qb * 256 * AB_N + 3072); r.K = (const fox::bf16*)(base + 4096); r.V = (const fox::bf16*)(base + 5120);
    r.O = (fox::bf16*)(cat + ((size_t)b * T + (size_t)qb * 256) * DM + 1024 + h * 128);
    r.Bias = bias + (size_t)bh * T; r.P0 = qb * 256; r.THp = thp;
    return r;
}
__device__ __forceinline__ int fox_fetch(Frame& F, unsigned* ctr, volatile LAS unsigned* slot) {
    if (F.tid == 0) *slot = __hip_atomic_fetch_add(ctr, 1u, __ATOMIC_RELAXED, __HIP_MEMORY_SCOPE_AGENT);
    __syncthreads();
    const int v = __builtin_amdgcn_readfirstlane((int)*slot);
    __syncthreads();
    return v;
}
__device__ __forceinline__ void fox_phase(Frame& F, char* lds, const bf16* proj, bf16* cat, const float* bias, unsigned* ctr, const float* qg, const float* kg) {
    constexpr int TOTAL = 512;
    float gqm = 0.f, gkm = 0.f;
    for (int i = 0; i < 128; ++i) { gqm = fmaxf(gqm, fabsf(qg[i])); gkm = fmaxf(gkm, fabsf(kg[i])); }
    const float thp = 2.0f * (128.0f * 1.02f * gqm * gkm) + (128.0f + 12.0f + 6.0f) / (1.4426950408889634f * fox::SCALE);
    volatile LAS unsigned* slot = (volatile LAS unsigned*)(F.lds + MISC_OFF) + 16;
    int ci = fox_fetch(F, ctr, slot); if (ci >= TOTAL) return;
    fox::BlockRef cur = fox_ref(ci, proj, cat, bias, thp);
    fox::Seam S;
    fox::fox_prime(cur, lds, S, F.tid);
    for (;;) {
        const int ni = fox_fetch(F, ctr, slot); const bool last = ni >= TOTAL;
        const fox::BlockRef nxt = last ? cur : fox_ref(ni, proj, cat, bias, thp);
        fox::fox_block(cur, nxt, lds, S, F.tid);
        if (last) break;
        cur = nxt;
    }
}

template <bool GLA> struct RecCfg {
    static constexpr int DK = GLA ? 256 : 128, DVH = GLA ? 512 : 128, NH = GLA ? 4 : 8, CH = 32, NCH = T / CH, PITCH = GLA ? C_N : AB_N, OPITCH = GLA ? 2048 : 1024;
    static constexpr int QP = DK + 16;
    static constexpr int QT_B = ((CH * QP * 2 + 1023) / 1024) * 1024, KT_B = DK * CH * 2, P_B = CH * CH * 2, A_B = 1024, VT_B = DVH * CH * 2;
    static constexpr int OFF_QT = 0, OFF_KT = QT_B, OFF_P = OFF_KT + KT_B, OFF_A = OFF_P + P_B, OFF_VT = OFF_A + A_B, UNIT_B = OFF_VT + VT_B;
    static constexpr int NSL = DVH / 128, BUF_B = OFF_VT + 8192, NP1 = OFF_VT / 1024, NP = NP1 + 8, NR = (NP + 7) / 8;
    static_assert(A_B >= DK * 4 && OFF_VT % 1024 == 0, "rec layout");
};
typedef short rbf16x8 __attribute__((ext_vector_type(8)));
__device__ __forceinline__ rbf16x8 rpack8(f32x4 a, f32x4 b) { v4u w; w.x = pg8::cvt_pk_bf16(a.x, a.y); w.y = pg8::cvt_pk_bf16(a.z, a.w); w.z = pg8::cvt_pk_bf16(b.x, b.y); w.w = pg8::cvt_pk_bf16(b.z, b.w); return __builtin_bit_cast(rbf16x8, w); }

template <bool GLA>
__device__ __forceinline__ void rec_prep(Frame& F, const bf16* proj, unsigned char* rec, const float* lbl, int lb_on, const float* glow, const float* wup, const float* bgate) {
    using C = RecCfg<GLA>;
    constexpr int DK = C::DK, DVH = C::DVH, NH = C::NH, CH = C::CH, NCH = C::NCH, PITCH = C::PITCH, QP = C::QP;
    constexpr int NSEG = NTHREADS / DK, TPS = CH / NSEG;
    constexpr int NSEGV = NTHREADS / DVH, TPV = CH / NSEGV;
    LAS float* segtot = (LAS float*)F.lds;
    LAS bf16* qm = (LAS bf16*)(F.lds + 2048);
    LAS bf16* km = qm + CH * QP;
    LAS float* sgl = (LAS float*)(F.lds + 2048 + 2 * CH * QP * 2);
    const int d = F.tid % DK, seg = F.tid / DK, lane = F.lane, el = lane & 15, q4 = lane >> 4;
    const int x = d & 31, y = x & 15, pos = (d & ~31) + 8 * (y >> 2) + (y & 3) + 4 * (x >> 4);
    constexpr int NUNITS = BATCH * NH * NCH, NBH = BATCH * NH;
    float lb = 0.f, bg = 0.f; float wu[16]; int hprev = -1;
    unsigned short rq[TPS], rk[TPS]; unsigned rvv[TPV / 2]; float rgl = 0.f;
    unsigned short rvr[GLA ? 1 : TPV];
    const int ev = F.tid % DVH, sv = F.tid / DVH;
    const unsigned toff = (unsigned)(seg * TPS) * (unsigned)(PITCH * 2) + (unsigned)d * 2u, voff = (unsigned)(sv * TPV) * (unsigned)(PITCH * 2) + (unsigned)ev * 2u;
#define PREP_LOAD(un) do { const int c_ = (un) / NBH, bh_ = (un) % NBH; const size_t row_ = (size_t)(bh_ / NH) * T + (size_t)c_ * CH; const int h_ = bh_ % NH; \
        const char* ubq_ = (const char*)(proj + row_ * PITCH + h_ * DK); const char* ubv_ = (const char*)(proj + row_ * PITCH + 2048 + h_ * DVH); (void)ubv_; \
        if (GLA) rgl = glow[row_ * 16 + F.tid];     \
        _Pragma("unroll") for (int i = 0; i < TPS; ++i) { const char* rb_ = ubq_ + (size_t)i * (PITCH * 2);     \
            rq[i] = *(const bf16*)(rb_ + toff); rk[i] = *(const bf16*)(rb_ + 2048 + toff); } \
        if (!GLA) { _Pragma("unroll") for (int i = 0; i < TPV; ++i) rvr[i] = *(const bf16*)((ubv_ + (size_t)i * (PITCH * 2)) + voff); } \
        } while (0)
    if (F.bid < NUNITS) PREP_LOAD(F.bid);
    for (int unit = F.bid; unit < NUNITS; unit += F.G) {
        const int c = unit / NBH, bh = unit % NBH, h = bh % NH, b = bh / NH;
        const size_t row0 = (size_t)b * T + (size_t)c * CH;
        if (h != hprev) { hprev = h;
            if (!GLA) { lb = 0.f; if (lb_on) lb = fminf(fmaxf(sigmoid_f(lbl[1024 + h * DK + d] - lbl[h * DK + d]), 0.f), 1.0f - 1e-6f); }
            else {
#pragma unroll
                for (int r = 0; r < 16; ++r) wu[r] = wup[r * 1024 + h * DK + d];
                bg = bgate[h * DK + d]; } }
        if (GLA) { sgl[F.tid] = rgl; __syncthreads(); }
        float qv[TPS], kv[TPS], G[TPS]; float run = 0.f;
#pragma unroll
        for (int i = 0; i < TPS; ++i) { const int t = seg * TPS + i; const float qa = bf1(rq[i]), ka = bf1(rk[i]); float g;
            if (!GLA) { qv[i] = silu_x(qa); const float ez = __expf(-fabsf(ka)), rz = __builtin_amdgcn_rcpf(1.0f + ez), big = rz, small = ez * rz;
                const float sg = ka >= 0.f ? big : small, ng = ka >= 0.f ? small : big; const float f = fmaxf(lb + (1.f - lb) * sg, 1e-30f); g = __logf(f); kv[i] = (1.f - lb) * ng; }
            else { qv[i] = qa * 0.0625f; kv[i] = ka; float xx = bg;
#pragma unroll
                for (int r = 0; r < 16; ++r) xx += sgl[t * 16 + r] * wu[r];
                g = log_sigmoid_fast(xx) * 0.0625f; }
            run += g; G[i] = run; }
        segtot[seg * DK + d] = run;
        __syncthreads();
        float off = 0.f, tot = 0.f, rmid = 0.f;
#pragma unroll
        for (int s = 0; s < NSEG; ++s) { const float v = segtot[s * DK + d]; tot += v; if (s < seg) off += v; if (s < 16 / TPS) rmid += v; }
        unsigned char* ub = rec + (size_t)(bh * NCH + c) * C::UNIT_B;
        bf16* QT = (bf16*)(ub + C::OFF_QT); bf16* KT = (bf16*)(ub + C::OFF_KT); bf16* Pb = (bf16*)(ub + C::OFF_P); float* Ab = (float*)(ub + C::OFF_A); bf16* VT = (bf16*)(ub + C::OFF_VT);
        unsigned kt[TPS / 2];
#pragma unroll
        for (int i = 0; i < TPS; i += 2) { float kh[2];
#pragma unroll
            for (int u = 0; u < 2; ++u) { const int t = seg * TPS + i + u; const float Gt = G[i + u] + off;
                QT[t * QP + pos] = (bf16)f2bf(qv[i + u] * __expf(Gt)); kh[u] = kv[i + u] * __expf(tot - Gt);
                qm[t * QP + d] = (bf16)f2bf(qv[i + u] * __expf(fminf(Gt - rmid, 80.f))); km[t * QP + d] = (bf16)f2bf(kv[i + u] * __expf(fminf(rmid - Gt, 80.f))); }
            kt[i / 2] = pk2(kh[0], kh[1]); }
#pragma unroll
        for (int j = 0; j < TPS / 8; ++j) { v4u w; w.x = kt[4 * j]; w.y = kt[4 * j + 1]; w.z = kt[4 * j + 2]; w.w = kt[4 * j + 3]; *(v4u*)(KT + d * CH + ((seg * TPS + 8 * j) ^ ((d & 8) << 1))) = w; }
        if (seg == NSEG - 1) Ab[d] = __expf(tot);
        { bf16* vt_ = VT + ev * CH;
          if (GLA) { const char* ubv_ = (const char*)(proj + row0 * PITCH + 2048 + h * DVH);
#pragma unroll
              for (int i = 0; i < TPV; i += 2) rvv[i / 2] = (unsigned)*(const bf16*)(ubv_ + (voff + (unsigned)i * (unsigned)(PITCH * 2))) | ((unsigned)*(const bf16*)(ubv_ + (voff + (unsigned)(i + 1) * (unsigned)(PITCH * 2))) << 16); }
          else {
#pragma unroll
              for (int i = 0; i < TPV; i += 2) rvv[i / 2] = (unsigned)rvr[i] | ((unsigned)rvr[i + 1] << 16); }
#pragma unroll
          for (int j = 0; j < TPV / 8; ++j) { v4u w; w.x = rvv[4 * j]; w.y = rvv[4 * j + 1]; w.z = rvv[4 * j + 2]; w.w = rvv[4 * j + 3];
              *(v4u*)(vt_ + ((sv * TPV + 8 * j) ^ ((ev & 8) << 1))) = w; } }
        if (unit + F.G < NUNITS) PREP_LOAD(unit + F.G);
        __syncthreads();
        if (F.wave < 3) { const int tt = F.wave >= 1, st = F.wave == 2; f32x4 acc = {0.f, 0.f, 0.f, 0.f};
#pragma unroll
            for (int i = 0; i < DK / 32; ++i) { const rbf16x8 a = *(const LAS rbf16x8*)(km + (16 * st + el) * QP + 32 * i + 8 * q4), bq = *(const LAS rbf16x8*)(qm + (16 * tt + el) * QP + 32 * i + 8 * q4);
                acc = __builtin_amdgcn_mfma_f32_16x16x32_bf16(a, bq, acc, 0, 0, 0); }
            const int ta = 16 * tt + el, s0 = 16 * st + 4 * q4;
            const float p0 = s0 + 0 <= ta ? acc[0] : 0.f, p1 = s0 + 1 <= ta ? acc[1] : 0.f, p2 = s0 + 2 <= ta ? acc[2] : 0.f, p3 = s0 + 3 <= ta ? acc[3] : 0.f;
            v2u w; w.x = pk2(p0, p1); w.y = pk2(p2, p3); *(v2u*)(Pb + ta * CH + (s0 ^ ((ta & 8) << 1))) = w; }
        else if (F.wave == 3) { v2u w; w.x = 0u; w.y = 0u; *(v2u*)(Pb + el * CH + ((16 + 4 * q4) ^ ((el & 8) << 1))) = w; }
        __syncthreads();
    }
#undef PREP_LOAD
}

template <bool GLA>
__device__ __forceinline__ void rec_seq(Frame& F, const unsigned char* rec, float* O, const bf16* proj, const float* gain, bf16* cat) {
    using C = RecCfg<GLA>;
    constexpr int DK = C::DK, DVH = C::DVH, NH = C::NH, CH = C::CH, NCH = C::NCH, QP = C::QP, NSL = C::NSL, NDT = DK / 16, NKS = DK / 32;
    constexpr int NBUF = 3, PF = NBUF - 1;
    constexpr int BUFG = C::BUF_B + (GLA ? 0 : 8192);
    constexpr int NWAIT = (PF - 1) * ((C::NR - 1) + (GLA ? 0 : 1) + 2);
    static_assert(NBUF * BUFG + 2048 <= RING_BYTES, "rec ring");
    constexpr int NUNITS = BATCH * NH * NSL;
    const int lane = F.lane, el = lane & 15, q4 = lane >> 4, wave = F.wave;
    for (int unit = F.bid; unit < NUNITS; unit += F.G) {
        const int sl = unit % NSL, h = (unit / NSL) % NH, b = unit / (NSL * NH);
        const unsigned char* ubase = rec + (size_t)((b * NH + h) * NCH) * C::UNIT_B;
#define REC_DMA(cc) do { const unsigned char* ub_ = ubase + (size_t)(cc) * C::UNIT_B; const int bufi_ = (cc) % NBUF; _Pragma("unroll") for (int r_ = 0; r_ < C::NR; ++r_) { const int p_ = r_ * 8 + wave; \
            if (p_ < C::NP) { const unsigned char* src_ = ub_ + (p_ < C::NP1 ? p_ * 1024 : C::OFF_VT + sl * 8192 + (p_ - C::NP1) * 1024) + lane * 16; \
                __builtin_amdgcn_global_load_lds((const unsigned*)src_, (LAS unsigned*)(F.lds + bufi_ * BUFG + p_ * 1024), 16, 0, 0); } } \
            if (!GLA) { const unsigned char* gsrc_ = (const unsigned char*)(proj + ((size_t)b * T + (size_t)(cc) * CH + 4 * wave + (lane >> 4)) * AB_N + 3072 + h * DVH) + (lane & 15) * 16; \
                __builtin_amdgcn_global_load_lds((const unsigned*)gsrc_, (LAS unsigned*)(F.lds + bufi_ * BUFG + C::BUF_B + wave * 1024), 16, 0, 0); } } while (0)
        f32x4 S[NDT];
#pragma unroll
        for (int i = 0; i < NDT; ++i) S[i] = (f32x4){0.f, 0.f, 0.f, 0.f};
#pragma unroll
        for (int cc = 0; cc < PF; ++cc) REC_DMA(cc);
        float* Ob = O + ((size_t)b * T) * C::OPITCH + h * DVH + sl * 128 + 16 * wave + 4 * q4;
        LAS float* ssq = (LAS float*)(F.lds + NBUF * BUFG);
        f32x4 oprev[2] = {{0.f, 0.f, 0.f, 0.f}, {0.f, 0.f, 0.f, 0.f}};
        v2u gsave[2] = {{0u, 0u}, {0u, 0u}};
        const unsigned ecol = (unsigned)(h * DVH + 16 * wave + 4 * q4);
        f32x4 gn4 = {1.f, 1.f, 1.f, 1.f}; if (!GLA) gn4 = *(const f32x4*)(gain + ecol);
#define REC_FINISH(cp) do { _Pragma("unroll") for (int tt = 0; tt < 2; ++tt) { const int tl = 16 * tt + el; float tot = 0.f; \
            _Pragma("unroll") for (int w_ = 0; w_ < 8; ++w_) tot += ssq[(((cp) & 1) * 8 + w_) * 32 + tl]; \
            const float rstd = 1.0f / sqrtf(tot * (1.f / 128.f) + EPS); const size_t row_ = (size_t)b * T + (size_t)(cp) * CH + tl; \
            const v2u gw_ = gsave[tt]; const f32x4 ov = oprev[tt]; \
            v2u w_o; w_o.x = pk2(ov.x * rstd * gn4.x * silu_x(bf_lo(gw_.x)), ov.y * rstd * gn4.y * silu_x(bf_hi(gw_.x))); \
            w_o.y = pk2(ov.z * rstd * gn4.z * silu_x(bf_lo(gw_.y)), ov.w * rstd * gn4.w * silu_x(bf_hi(gw_.y))); \
            *(v2u*)(cat + row_ * DM + ecol) = w_o; } } while (0)
        for (int c = 0; c < NCH; ++c) {
            if (c <= PF) asm volatile("s_waitcnt vmcnt(0)" ::: "memory"); else asm volatile("s_waitcnt vmcnt(%0)" :: "i"(NWAIT) : "memory");
            asm volatile("s_waitcnt lgkmcnt(0)" ::: "memory"); __builtin_amdgcn_s_barrier(); asm volatile("" ::: "memory");
            if (!GLA) {
                if (c > 0) REC_FINISH(c - 1);
                else { v2u z; z.x = 0u; z.y = 0u; *(v2u*)(cat + ((size_t)b * T + el) * DM + ecol) = z; *(v2u*)(cat + ((size_t)b * T + 16 + el) * DM + ecol) = z; }
            }
            if (c + PF < NCH) REC_DMA(c + PF); else REC_DMA(NCH - 1);
            const LAS unsigned char* L = F.lds + (c % NBUF) * BUFG;
            rbf16x8 sf[NKS];
#pragma unroll
            for (int i = 0; i < NKS; ++i) sf[i] = rpack8(S[2 * i], S[2 * i + 1]);
            f32x4 o[2];
#pragma unroll
            for (int tt = 0; tt < 2; ++tt) { o[tt] = (f32x4){0.f, 0.f, 0.f, 0.f};
#pragma unroll
                for (int i = 0; i < NKS; ++i) { const rbf16x8 qf = *(const LAS rbf16x8*)(L + C::OFF_QT + ((16 * tt + el) * QP + 32 * i + 8 * q4) * 2);
                    o[tt] = __builtin_amdgcn_mfma_f32_16x16x32_bf16(sf[i], qf, o[tt], 0, 0, 0); } }
            const rbf16x8 vf = *(const LAS rbf16x8*)(L + C::OFF_VT + ((16 * wave + el) * CH + 8 * q4) * 2);
#pragma unroll
            for (int tt = 0; tt < 2; ++tt) { const rbf16x8 pf = *(const LAS rbf16x8*)(L + C::OFF_P + ((16 * tt + el) * CH + 8 * q4) * 2);
                o[tt] = __builtin_amdgcn_mfma_f32_16x16x32_bf16(vf, pf, o[tt], 0, 0, 0); }
#pragma unroll
            for (int dt = 0; dt < NDT; ++dt) { const f32x4 a4 = *(const LAS f32x4*)(L + C::OFF_A + (16 * dt + 4 * q4) * 4); S[dt] = S[dt] * a4;
                const rbf16x8 kf = *(const LAS rbf16x8*)(L + C::OFF_KT + ((16 * dt + el) * CH + 8 * q4) * 2);
                S[dt] = __builtin_amdgcn_mfma_f32_16x16x32_bf16(kf, vf, S[dt], 0, 0, 0); }
            if (GLA) {
#pragma unroll
                for (int tt = 0; tt < 2; ++tt) *(f32x4*)(Ob + (size_t)(c * CH + 16 * tt + el) * C::OPITCH) = o[tt];
            } else {
#pragma unroll
                for (int tt = 0; tt < 2; ++tt) { float p = (o[tt].x * o[tt].x + o[tt].y * o[tt].y) + (o[tt].z * o[tt].z + o[tt].w * o[tt].w); p = xsum<16>(p); p = xsum<32>(p);
                    if (q4 == 0) ssq[((c & 1) * 8 + wave) * 32 + 16 * tt + el] = p; oprev[tt] = o[tt];
                    gsave[tt] = *(const LAS v2u*)(L + C::BUF_B + ((16 * tt + el) * 128 + 16 * wave + 4 * q4) * 2); }
            }
        }
        asm volatile("s_waitcnt vmcnt(0)" ::: "memory"); __syncthreads();
        if (!GLA) { REC_FINISH(NCH - 1); }
        __syncthreads();
#undef REC_FINISH
#undef REC_DMA
    }
}

template <bool GLA>
__device__ __forceinline__ void rec_seq2(Frame& F, const unsigned char* rec, bf16* O) {
    using C = RecCfg<GLA>;
    constexpr int DK = C::DK, DVH = C::DVH, NH = C::NH, CH = C::CH, NCH = C::NCH, QP = C::QP;
    constexpr int NDH = DK / 32, NKH = DK / 64;
    constexpr int ES = 64, NSL = DVH / ES, BUF2 = C::OFF_VT + ES * CH * 2, NP1 = C::OFF_VT / 1024, NP = NP1 + ES * CH * 2 / 1024, NR = NP / 8;
    constexpr int NBUF = GLA ? 3 : 5, PF = NBUF - 1, NWAIT = (PF - 1) * (NR + 1);
    static_assert(NP % 8 == 0 && NBUF * BUF2 + 2 * 8 * 1024 <= RING_BYTES, "rec_seq2 ring");
    constexpr int NUNITS = BATCH * NH * NSL;
    const int lane = F.lane, el = lane & 15, q4 = lane >> 4, wave = F.wave, eg = wave & 3, dg = wave >> 2;
    LAS unsigned char* xch = F.lds + NBUF * BUF2;
    for (int unit = F.bid; unit < NUNITS; unit += F.G) {
        const int sl = unit % NSL, h = (unit / NSL) % NH, b = unit / (NSL * NH);
        const unsigned char* ubase = rec + (size_t)((b * NH + h) * NCH) * C::UNIT_B;
#define G2_DMA(cc) do { const unsigned char* ub_ = ubase + (size_t)(cc) * C::UNIT_B; const int bufi_ = (cc) % NBUF; _Pragma("unroll") for (int r_ = 0; r_ < NR; ++r_) { const int p_ = r_ * 8 + wave; \
            const unsigned char* src_ = ub_ + (p_ < NP1 ? p_ * 1024 : C::OFF_VT + sl * (ES * CH * 2) + (p_ - NP1) * 1024) + lane * 16; \
            __builtin_amdgcn_global_load_lds((const unsigned*)src_, (LAS unsigned*)(F.lds + bufi_ * BUF2 + p_ * 1024), 16, 0, 0); } } while (0)
        f32x4 S[NDH];
#pragma unroll
        for (int i = 0; i < NDH; ++i) S[i] = (f32x4){0.f, 0.f, 0.f, 0.f};
#pragma unroll
        for (int cc = 0; cc < PF; ++cc) G2_DMA(cc);
        bf16* Ob = O + ((size_t)b * T + 16 * dg + el) * C::OPITCH + h * DVH + sl * ES + 16 * eg + 4 * q4;
#define G2_ST(p_, v_) do { const f32x4 v4_ = (v_); v2u w2_; w2_.x = pg8::cvt_pk_bf16(v4_.x, v4_.y); w2_.y = pg8::cvt_pk_bf16(v4_.z, v4_.w); *(v2u*)(p_) = w2_; } while (0)
        f32x4 okeep = {0.f, 0.f, 0.f, 0.f};
        for (int c = 0; c < NCH; ++c) {
            if (c <= PF) asm volatile("s_waitcnt vmcnt(0)" ::: "memory"); else asm volatile("s_waitcnt vmcnt(%0)" :: "i"(NWAIT) : "memory");
            asm volatile("s_waitcnt lgkmcnt(0)" ::: "memory"); __builtin_amdgcn_s_barrier(); asm volatile("" ::: "memory");
            if (c + PF < NCH) G2_DMA(c + PF); else G2_DMA(NCH - 1);
            const LAS unsigned char* L = F.lds + (c % NBUF) * BUF2;
            rbf16x8 qf[2][NKH], kf[NDH]; f32x4 a4[NDH];
#pragma unroll
            for (int tt = 0; tt < 2; ++tt)
#pragma unroll
                for (int i = 0; i < NKH; ++i) qf[tt][i] = *(const LAS rbf16x8*)(L + C::OFF_QT + ((16 * tt + el) * QP + 32 * (NKH * dg + i) + 8 * q4) * 2);
            const int sw8 = (8 * q4) ^ ((el & 8) << 1);
            const rbf16x8 vf = *(const LAS rbf16x8*)(L + C::OFF_VT + ((16 * eg + el) * CH + sw8) * 2);
            const rbf16x8 pf = *(const LAS rbf16x8*)(L + C::OFF_P + ((16 * dg + el) * CH + sw8) * 2);
#pragma unroll
            for (int j = 0; j < NDH; ++j) { kf[j] = *(const LAS rbf16x8*)(L + C::OFF_KT + ((16 * (NDH * dg + j) + el) * CH + sw8) * 2); a4[j] = *(const LAS f32x4*)(L + C::OFF_A + (16 * (NDH * dg + j) + 4 * q4) * 4); }
            rbf16x8 sf[NKH];
#pragma unroll
            for (int i = 0; i < NKH; ++i) sf[i] = rpack8(S[2 * i], S[2 * i + 1]);
            f32x4 o[2];
#pragma unroll
            for (int tt = 0; tt < 2; ++tt) { o[tt] = (f32x4){0.f, 0.f, 0.f, 0.f};
#pragma unroll
                for (int i = 0; i < NKH; ++i) o[tt] = __builtin_amdgcn_mfma_f32_16x16x32_bf16(sf[i], qf[tt][i], o[tt], 0, 0, 0); }
            if (dg == 0) o[0] = __builtin_amdgcn_mfma_f32_16x16x32_bf16(vf, pf, o[0], 0, 0, 0); else o[1] = __builtin_amdgcn_mfma_f32_16x16x32_bf16(vf, pf, o[1], 0, 0, 0);
#pragma unroll
            for (int j = 0; j < NDH; ++j) { S[j] = S[j] * a4[j]; S[j] = __builtin_amdgcn_mfma_f32_16x16x32_bf16(kf[j], vf, S[j], 0, 0, 0); }
            if (c > 0) { const f32x4 pr = *(const LAS f32x4*)(xch + ((((c - 1) & 1) * 8 + (wave ^ 4)) * 64 + lane) * 16);
                         G2_ST(Ob + (size_t)((c - 1) * CH) * C::OPITCH, okeep + pr); }
            else { G2_ST(Ob, okeep); }
            *(LAS f32x4*)(xch + (((c & 1) * 8 + wave) * 64 + lane) * 16) = dg == 0 ? o[1] : o[0];
            okeep = dg == 0 ? o[0] : o[1];
        }
        asm volatile("s_waitcnt vmcnt(0) lgkmcnt(0)" ::: "memory"); __syncthreads();
        { const f32x4 pr = *(const LAS f32x4*)(xch + ((((NCH - 1) & 1) * 8 + (wave ^ 4)) * 64 + lane) * 16); G2_ST(Ob + (size_t)((NCH - 1) * CH) * C::OPITCH, okeep + pr); }
        __syncthreads();
#undef G2_ST
#undef G2_DMA
    }
}

template <bool GLA>
__device__ __forceinline__ void rec_seq3(Frame& F, const unsigned char* rec, bf16* O) {
    using C = RecCfg<GLA>;
    constexpr int DK = C::DK, DVH = C::DVH, NH = C::NH, CH = C::CH, NCH = C::NCH, QP = C::QP;
    constexpr int NDH = DK / 32, NKH = DK / 64;
    constexpr int ES = 64, NSL = DVH / ES, BUF2 = C::OFF_VT + ES * CH * 2, NP1 = C::OFF_VT / 1024, NP = NP1 + ES * CH * 2 / 1024, NRL = NP / 4;
    constexpr int NBUF = GLA ? 3 : 5, PF = NBUF - 1, NWAIT = (PF - 1) * NRL;
    static_assert(NP % 4 == 0 && NBUF * BUF2 + 2 * 8 * 1024 <= RING_BYTES && NWAIT < 64, "rec_seq3 ring");
    constexpr int NUNITS = BATCH * NH * NSL;
    const int lane = F.lane, el = lane & 15, q4 = lane >> 4, wave = F.wave;
    LAS unsigned char* xch = F.lds + NBUF * BUF2;
    for (int unit = F.bid; unit < NUNITS; unit += F.G) {
        const int bh = unit % (BATCH * NH), sl = unit / (BATCH * NH), h = bh % NH, b = bh / NH;
        const unsigned char* ubase = rec + (size_t)((b * NH + h) * NCH) * C::UNIT_B;
        const int eg2 = wave & 1, dg = (wave >> 1) & 1;
        bf16* Ob = O + ((size_t)b * T + 16 * dg + el) * C::OPITCH + h * DVH + sl * ES + 32 * eg2 + 4 * q4;
        f32x4 okeep[2] = {{0.f, 0.f, 0.f, 0.f}, {0.f, 0.f, 0.f, 0.f}};
#define G3_ST(p_, v_) do { const f32x4 v4_ = (v_); v2u w2_; w2_.x = pg8::cvt_pk_bf16(v4_.x, v4_.y); w2_.y = pg8::cvt_pk_bf16(v4_.z, v4_.w); *(v2u*)(p_) = w2_; } while (0)
        if (wave >= 4) {
            const int lw = wave - 4;
#define G3_DMA(cc) do { const unsigned char* ub_ = ubase + (size_t)(cc) * C::UNIT_B; const int bufi_ = (cc) % NBUF; _Pragma("unroll") for (int r_ = 0; r_ < NRL; ++r_) { const int p_ = r_ * 4 + lw; \
            const unsigned char* src_ = ub_ + (p_ < NP1 ? p_ * 1024 : C::OFF_VT + sl * (ES * CH * 2) + (p_ - NP1) * 1024) + lane * 16; \
            __builtin_amdgcn_global_load_lds((const unsigned*)src_, (LAS unsigned*)(F.lds + bufi_ * BUF2 + p_ * 1024), 16, 0, 0); } } while (0)
#pragma unroll
            for (int cc = 0; cc < PF; ++cc) G3_DMA(cc);
            for (int c = 0; c < NCH; ++c) {
                asm volatile("s_waitcnt vmcnt(%0)" :: "i"(NWAIT) : "memory");
                __builtin_amdgcn_s_barrier(); asm volatile("" ::: "memory");
                if (c + PF < NCH) G3_DMA(c + PF); else G3_DMA(NCH - 1);
            }
            asm volatile("s_waitcnt vmcnt(0)" ::: "memory");
#undef G3_DMA
        } else {
            f32x4 S[NDH][2];
#pragma unroll
            for (int i = 0; i < NDH; ++i) { S[i][0] = (f32x4){0.f, 0.f, 0.f, 0.f}; S[i][1] = (f32x4){0.f, 0.f, 0.f, 0.f}; }
            const int sw8 = (8 * q4) ^ ((el & 8) << 1);
            for (int c = 0; c < NCH; ++c) {
                asm volatile("s_waitcnt lgkmcnt(0)" ::: "memory"); __builtin_amdgcn_s_barrier(); asm volatile("" ::: "memory");
                const LAS unsigned char* L = F.lds + (c % NBUF) * BUF2;
                rbf16x8 qf[2][NKH], kf[NDH], vf[2]; f32x4 a4[NDH];
#pragma unroll
                for (int tt = 0; tt < 2; ++tt)
#pragma unroll
                    for (int i = 0; i < NKH; ++i) qf[tt][i] = *(const LAS rbf16x8*)(L + C::OFF_QT + ((16 * tt + el) * QP + 32 * (NKH * dg + i) + 8 * q4) * 2);
#pragma unroll
                for (int et = 0; et < 2; ++et) vf[et] = *(const LAS rbf16x8*)(L + C::OFF_VT + ((32 * eg2 + 16 * et + el) * CH + sw8) * 2);
                const rbf16x8 pf = *(const LAS rbf16x8*)(L + C::OFF_P + ((16 * dg + el) * CH + sw8) * 2);
#pragma unroll
                for (int j = 0; j < NDH; ++j) { kf[j] = *(const LAS rbf16x8*)(L + C::OFF_KT + ((16 * (NDH * dg + j) + el) * CH + sw8) * 2); a4[j] = *(const LAS f32x4*)(L + C::OFF_A + (16 * (NDH * dg + j) + 4 * q4) * 4); }
                f32x4 o[2][2];
#pragma unroll
                for (int et = 0; et < 2; ++et) { rbf16x8 sf[NKH];
#pragma unroll
                    for (int i = 0; i < NKH; ++i) sf[i] = rpack8(S[2 * i][et], S[2 * i + 1][et]);
#pragma unroll
                    for (int tt = 0; tt < 2; ++tt) { o[tt][et] = (f32x4){0.f, 0.f, 0.f, 0.f};
#pragma unroll
                        for (int i = 0; i < NKH; ++i) o[tt][et] = __builtin_amdgcn_mfma_f32_16x16x32_bf16(sf[i], qf[tt][i], o[tt][et], 0, 0, 0); } }
#pragma unroll
                for (int et = 0; et < 2; ++et) { if (dg == 0) o[0][et] = __builtin_amdgcn_mfma_f32_16x16x32_bf16(vf[et], pf, o[0][et], 0, 0, 0); else o[1][et] = __builtin_amdgcn_mfma_f32_16x16x32_bf16(vf[et], pf, o[1][et], 0, 0, 0); }
#pragma unroll
                for (int j = 0; j < NDH; ++j)
#pragma unroll
                    for (int et = 0; et < 2; ++et) { S[j][et] = S[j][et] * a4[j]; S[j][et] = __builtin_amdgcn_mfma_f32_16x16x32_bf16(kf[j], vf[et], S[j][et], 0, 0, 0); }
                if (c > 0) {
#pragma unroll
                    for (int et = 0; et < 2; ++et) { const f32x4 pr = *(const LAS f32x4*)(xch + (((((c - 1) & 1) * 4 + (wave ^ 2)) * 2 + et) * 64 + lane) * 16);
                        G3_ST(Ob + (size_t)((c - 1) * CH) * C::OPITCH + 16 * et, okeep[et] + pr); } }
#pragma unroll
                for (int et = 0; et < 2; ++et) { *(LAS f32x4*)(xch + ((((c & 1) * 4 + wave) * 2 + et) * 64 + lane) * 16) = dg == 0 ? o[1][et] : o[0][et]; okeep[et] = dg == 0 ? o[0][et] : o[1][et]; }
            }
        }
        asm volatile("s_waitcnt vmcnt(0) lgkmcnt(0)" ::: "memory"); __syncthreads();
        if (wave < 4) {
#pragma unroll
            for (int et = 0; et < 2; ++et) { const f32x4 pr = *(const LAS f32x4*)(xch + (((((NCH - 1) & 1) * 4 + (wave ^ 2)) * 2 + et) * 64 + lane) * 16);
                G3_ST(Ob + (size_t)((NCH - 1) * CH) * C::OPITCH + 16 * et, okeep[et] + pr); } }
        __syncthreads();
#undef G3_ST
    }
}
#define WSP(T_, off) ((T_*)(ws + (off)))
#define REFRAME() CArgs* ap = opq_args(); unsigned char* ws = ap->ws; (void)ws; \
    F.lds = (LAS unsigned char*)lds; F.tid = opq_tid(wave_s); F.lane = F.tid & 63; F.wave = __builtin_amdgcn_readfirstlane(F.tid >> 6); F.G = gridDim.x; F.bid = opq_bid()
#ifndef DBG_DOUBLE
#define DBG_DOUBLE 0
#endif
#define NREP(bit) ((DBG_DOUBLE & (bit)) ? 2 : 1)
#define REPBAR(rep, n) do { if ((rep) + 1 < (n)) xcd_barrier<false>(bar, F.tid == 0); } while (0)
#define IN(k) (lo <= (k) && (k) < hi)
#define SEAM(k) do { if (IN(k) && IN((k) + 1)) xcd_barrier<false>(bar, F.tid == 0); } while (0)
template <int layer>
__device__ __forceinline__ void layer_phases(unsigned char* lds, const int wave_s, const int lo, const int hi, const XcdBarrier& bar) {
    Frame F;

        constexpr int pb = phase_base(layer); constexpr bool odd = layer & 1; constexpr int li = layer >> 1;
        constexpr int P_NORM1 = pb, P_MIXIN = pb + 1, P_PREP = pb + 2, P_REC = pb + 3, P_POST = pb + 4, P_MIXOUT = pb + 5, P_NORM2 = P_MIXOUT + 1, P_FFIN = P_MIXOUT + 2, P_FFOUT = P_MIXOUT + 3;
#define MODL (WSP(float, WS_MOD) + (size_t)layer * 2 * 6 * DM)
#define XCUR (layer == 0 ? ap->in[0] : (const float*)ap->out)
        if (IN(P_NORM1)) { REFRAME();
            const float* modl = MODL;
            for (int rep = 0; rep < NREP(2); ++rep) {
            constexpr bool L0 = layer == 0; const float* g2p = WSP(float, WS_MOD) + (size_t)(L0 ? 0 : layer - 1) * 2 * 6 * DM + 5 * DM; const void* xin = L0 ? (const void*)ap->in[0] : (const void*)WSP(const bf16, WS_XB);
            if (!odd) norm_phase<8, 1, !L0, L0>(F, xin, ap->in[4] + (size_t)layer * DM, modl, modl + DM, WSP(bf16, WS_H), ap->in[6] + (size_t)li * DM * AB_IN + AB_N, AB_IN, ap->in[12] + li * 8, WSP(float, WS_LOGF), WSP(const bf16, WS_Y), g2p, WSP(bf16, WS_XB));
            else norm_phase<16, 2, !L0, L0>(F, xin, ap->in[4] + (size_t)layer * DM, modl, modl + DM, WSP(bf16, WS_H), ap->in[13] + (size_t)li * DM * C_IN + C_N, C_IN, nullptr, WSP(float, WS_GLOW), WSP(const bf16, WS_Y), g2p, WSP(bf16, WS_XB));
            REPBAR(rep, NREP(2)); }
            SEAM(P_NORM1);
        }
        if (IN(P_MIXIN)) { REFRAME();
            const int N = odd ? 4096 : AB_N, ldc = odd ? C_N : AB_N;
            const bf16* Wt = odd ? WSP(const bf16, WS_W_GLIN) + (size_t)li * C_N * DM : WSP(const bf16, WS_W_ABIN) + (size_t)li * AB_N * DM;
            pg8::Gemm g{WSP(const bf16, WS_H), Wt, M, N, DM}; pg8::StaticOrder S; S.init(M, N, F.G, F.bid);
            pg8::EpiBf16 E{WSP(bf16, WS_PROJ), ldc};
            for (int rep = 0; rep < NREP(1); ++rep) { pg8::gemm_phase<pg8::EpiBf16, pg8::StaticOrder, true, true>(F.lds + RING_OFF, g, S, E, F.tid); REPBAR(rep, NREP(1)); }
            SEAM(P_MIXIN);
        }
        if (IN(P_PREP)) { REFRAME();
            if (!odd) { fox_prep(F, WSP(bf16, WS_PROJ), ap->in[10] + li * 128, ap->in[11] + li * 128, WSP(float, WS_LOGF), WSP(float, WS_BIAS));
                        __syncthreads();
                        for (int rep = 0; rep < NREP(4); ++rep) { rec_prep<false>(F, WSP(const bf16, WS_PROJ), ws + WS_REC, ap->in[8], li, nullptr, nullptr, nullptr); REPBAR(rep, NREP(4)); } }
            else for (int rep = 0; rep < NREP(4); ++rep) { rec_prep<true>(F, WSP(const bf16, WS_PROJ), ws + WS_REC, nullptr, 0, WSP(float, WS_GLOW), ap->in[14] + (size_t)li * 16 * 1024, ap->in[15] + li * 1024); REPBAR(rep, NREP(4)); }
            SEAM(P_PREP);
        }
        if (IN(P_REC)) { REFRAME();
            for (int rep = 0; rep < (odd ? NREP(8) : 1); ++rep) {
            if (!odd) { rec_seq3<false>(F, ws + WS_REC, WSP(bf16, WS_O));
                        fox_phase(F, (char*)lds + RING_OFF, WSP(const bf16, WS_PROJ), WSP(bf16, WS_CAT), WSP(float, WS_BIAS), (unsigned*)(ws + WS_CTL) + CW_QUEUE + 64 * (li + 2 * rep), ap->in[10] + li * 128, ap->in[11] + li * 128); }
            else { rec_seq3<true>(F, ws + WS_REC, WSP(bf16, WS_O));
                   if (F.bid < 64 && rep == 0) { LAS float* scr = (LAS float*)(F.lds + RING_OFF + F.wave * 16640);
                       convert_weights<(layer == 1 ? 1 : 2)>(ap, scr, 0, 1, F.lane, (unsigned*)(ws + WS_CTL) + CW_CONV, F.wave, F.tid == 0, (volatile LAS unsigned*)(F.lds + MISC_OFF) + 32); }
                   if (F.bid >= 64 && rep == 0) {
                       { pg8::Gemm g{WSP(const bf16, WS_H), WSP(const bf16, WS_W_GLIN) + (size_t)li * C_N * DM + (size_t)4096 * DM, M, 2048, DM}; pg8::StaticOrder S; S.init(M, 2048, F.G - 64, F.bid - 64);
                         pg8::EpiBf16 E{WSP(bf16, WS_PROJ) + 4096, C_N};
                         pg8::gemm_phase<pg8::EpiBf16, pg8::StaticOrder, true, true>(F.lds + RING_OFF, g, S, E, F.tid); }
                       LAS float* scr = (LAS float*)(F.lds + RING_OFF + F.wave * 16640);
                       convert_weights<(layer == 1 ? 1 : 2)>(ap, scr, 0, 1, F.lane, (unsigned*)(ws + WS_CTL) + CW_CONV, F.wave, F.tid == 0, (volatile LAS unsigned*)(F.lds + MISC_OFF) + 32); } }
            REPBAR(rep, (odd ? NREP(8) : 1)); }
            SEAM(P_REC);
        }
        if (IN(P_POST)) { REFRAME();
            if (!odd) post_even(F, WSP(const bf16, WS_O), WSP(const bf16, WS_PROJ), ap->in[9] + li * 1024, WSP(bf16, WS_CAT));
            else for (int rep = 0; rep < NREP(16); ++rep) { post_odd(F, WSP(const bf16, WS_O), WSP(const bf16, WS_PROJ), ap->in[16] + li * 512, WSP(bf16, WS_CAT)); REPBAR(rep, NREP(16)); }
            SEAM(P_POST);
        }
        if (IN(P_MIXOUT)) { REFRAME();
            const float* modl = MODL;
            const bf16* Wt = odd ? WSP(const bf16, WS_W_GLOUT) + (size_t)li * DM * DM : WSP(const bf16, WS_W_ABOUT) + (size_t)li * DM * DM;
            pg8::Gemm g{WSP(const bf16, WS_CAT), Wt, M, DM, DM}; pg8::StaticOrder S; S.init(M, DM, F.G, F.bid);
            pg8::EpiBf16 E{WSP(bf16, WS_Y), DM};
            pg8::gemm_phase<pg8::EpiBf16, pg8::StaticOrder, true, true>(F.lds + RING_OFF, g, S, E, F.tid);
            SEAM(P_MIXOUT);
        }
        if (IN(P_NORM2)) { REFRAME();
            const float* modl = MODL;
            { constexpr bool L0 = layer == 0; const void* xin = L0 ? (const void*)ap->in[0] : (const void*)WSP(const bf16, WS_XB);
              norm_phase<0, 0, true, L0>(F, xin, ap->in[5] + (size_t)layer * DM, modl + 3 * DM, modl + 4 * DM, WSP(bf16, WS_H), nullptr, 0, nullptr, nullptr, WSP(const bf16, WS_Y), modl + 2 * DM, WSP(bf16, WS_XB)); }
            SEAM(P_NORM2);
        }
        if (IN(P_FFIN)) { REFRAME();
            pg8::Gemm g{WSP(const bf16, WS_H), WSP(const bf16, WS_W_FFIN) + (size_t)layer * FF2 * DM, M, FF2, DM}; pg8::StaticOrder S; S.init(M, FF2, F.G, F.bid);
            pg8::EpiSwiglu E{WSP(bf16, WS_FFH), FF};
            for (int rep = 0; rep < NREP(1 | 128); ++rep) { pg8::gemm_phase<pg8::EpiSwiglu, pg8::StaticOrder, true, true>(F.lds + RING_OFF, g, S, E, F.tid); REPBAR(rep, NREP(1 | 128)); }
            SEAM(P_FFIN);
        }
        if (IN(P_FFOUT)) { REFRAME();
            const float* modl = MODL;
            pg8::Gemm g{WSP(const bf16, WS_FFH), WSP(const bf16, WS_W_FFOUT) + (size_t)layer * DM * FF, M, DM, FF}; pg8::StaticOrder S; S.init(M, DM, F.G, F.bid);
            if constexpr (layer == DEPTH - 1) {
                const float* g2 = WSP(float, WS_MOD) + (size_t)(DEPTH - 1) * 2 * 6 * DM + 5 * DM;
                pg8::EpiResidBf E{(const pg8::bf16_t*)WSP(const bf16, WS_XB), ap->out, DM, g2, g2 + 6 * DM, (int)(T / pg8::BM)};
                pg8::gemm_phase<pg8::EpiResidBf, pg8::StaticOrder, true, true>(F.lds + RING_OFF, g, S, E, F.tid);
            } else {
            pg8::EpiBf16 E{WSP(bf16, WS_Y), DM};
            pg8::gemm_phase<pg8::EpiBf16, pg8::StaticOrder, true, true>(F.lds + RING_OFF, g, S, E, F.tid); }
            SEAM(P_FFOUT);
        }
    }
__global__ void __launch_bounds__(NTHREADS, 2) trunk_fwd(Args args_unused) {
    extern __shared__ __attribute__((aligned(16))) unsigned char lds[];
    Frame F;
    const int wave_s = __builtin_amdgcn_readfirstlane(threadIdx.x >> 6);
    int lo, hi, use_bar; XcdBarrier bar;
    {
        REFRAME();
        volatile LAS unsigned* MISC = (volatile LAS unsigned*)(F.lds + MISC_OFF);
        for (int u = F.tid; u < (LDS_BYTES - LDSCTL_OFF) / 4; u += NTHREADS) ((LAS unsigned*)(F.lds + LDSCTL_OFF))[u] = 0u;
        __syncthreads();
        lo = ap->ph_lo; hi = ap->ph_hi; use_bar = ap->use_bar;
        bar.bar = (unsigned*)(ws + WS_CTL) + CW_BAR; bar.x = 0; bar.st = MISC + 8;
        if (use_bar) bar = xcd_barrier_post((unsigned*)(ws + WS_CTL) + CW_BAR, MISC + 8, F.tid == 0);
    }

    if (IN(0)) { REFRAME(); p0_prologue(F, ap); if (IN(1)) xcd_barrier<true>(bar, F.tid == 0);
        if (DBG_DOUBLE & 32) { p0_prologue(F, ap); xcd_barrier<false>(bar, F.tid == 0); } }

    layer_phases<0>(lds, wave_s, lo, hi, bar);
    layer_phases<1>(lds, wave_s, lo, hi, bar);
    layer_phases<2>(lds, wave_s, lo, hi, bar);
    layer_phases<3>(lds, wave_s, lo, hi, bar);
#undef IN
#undef SEAM
}

#ifndef DBG_CHECK
#define DBG_CHECK 0
#endif
#if DBG_CHECK
#ifndef DBG_REPORT_ERR
#define DBG_REPORT_ERR 1
#endif
constexpr size_t WS_DBG = 5 * MiB;
constexpr size_t WS_DBG_OLD = 1072 * MiB;
__device__ __forceinline__ unsigned dbg_hash(unsigned x) { x ^= x >> 16; x *= 0x7feb352dU; x ^= x >> 15; x *= 0x846ca68bU; x ^= x >> 16; return x; }
__device__ __forceinline__ float dbg_bfr(float f) { return __builtin_bit_cast(float, f2bf(f) << 16); }
__device__ __forceinline__ void dbg_cmp(unsigned* dbg, unsigned code, float got, float ref, float rtol, float atol) {
    const float err = fabsf(got - ref); const bool bad = !(err <= atol + rtol * fabsf(ref));
    if (bad) { atomicMin(dbg, code); atomicMax(dbg + 1 + (code & 255u), __float_as_uint(err)); }
}
__global__ void dbg_gemm(unsigned* dbg, unsigned code, int mode, const bf16* A, int K, const float* W, int ldw, int N, const void* C, int ldc, const float* old, const float* gate0, const float* gate1) {
    const unsigned s = blockIdx.x * blockDim.x + threadIdx.x; const unsigned hsh = dbg_hash(s * 2654435761u + code);
    const int m = hsh % M, n = dbg_hash(hsh) % N;
    float d0 = 0.f, d1 = 0.f;
    for (int k = 0; k < K; ++k) { const float a = bf1(A[(size_t)m * K + k]); d0 += a * dbg_bfr(W[(size_t)k * ldw + n]); if (mode == 1) d1 += a * dbg_bfr(W[(size_t)k * ldw + FF + n]); }
    float got, ref;
    if (mode == 0) { got = bf1(((const bf16*)C)[(size_t)m * ldc + n]); ref = d0; }
    else if (mode == 1) { got = bf1(((const bf16*)C)[(size_t)m * ldc + n]); ref = d0 / (1.f + expf(-d0)) * d1; }
    else { got = ((const float*)C)[(size_t)m * ldc + n]; ref = old[(size_t)m * ldc + n] + (m >= T ? gate1 : gate0)[n] * d0; }
    dbg_cmp(dbg, code, got, ref, 0.02f, 0.03f);
}
__global__ void dbg_norm(unsigned* dbg, unsigned code, const float* x, const float* gain, const float* sh, const float* sc, const bf16* h) {
    const unsigned s = blockIdx.x * blockDim.x + threadIdx.x; const unsigned hsh = dbg_hash(s * 2654435761u + code);
    const int m = hsh % M, k = dbg_hash(hsh) % DM, b = m / T;
    double ss = 0.0; for (int i = 0; i < DM; ++i) { const double v = x[(size_t)m * DM + i]; ss += v * v; }
    const float rstd = (float)(1.0 / sqrt(ss / DM + 1e-6));
    const float ref = x[(size_t)m * DM + k] * rstd * gain[k] * (1.f + sc[(size_t)b * 6 * DM + k]) + sh[(size_t)b * 6 * DM + k];
    dbg_cmp(dbg, code, bf1(h[(size_t)m * DM + k]), ref, 0.01f, 0.01f);
}
__global__ void dbg_mod(unsigned* dbg, unsigned code, const float* c, const float* mw, const float* mb, const float* mod) {
    const unsigned s = blockIdx.x * blockDim.x + threadIdx.x; const unsigned hsh = dbg_hash(s * 2654435761u + code);
    const int layer = hsh % DEPTH, b = (hsh >> 8) & 1, j = dbg_hash(hsh) % (6 * DM);
    double acc = mb[(size_t)layer * 6 * DM + j];
    for (int k = 0; k < DM; ++k) { const double cv = c[b * DM + k]; acc += cv / (1.0 + exp(-cv)) * mw[((size_t)layer * DM + k) * (6 * DM) + j]; }
    dbg_cmp(dbg, code, mod[((size_t)layer * 2 + b) * 6 * DM + j], (float)acc, 1e-3f, 1e-4f);
}
__global__ void dbg_small(unsigned* dbg, unsigned code, int mode, const bf16* h, const float* W, int ldw, const float* fbias, const float* sout) {
    const unsigned s = blockIdx.x * blockDim.x + threadIdx.x; const unsigned hsh = dbg_hash(s * 2654435761u + code);
    const int m = hsh % M, cc = dbg_hash(hsh) % (mode == 1 ? 8 : 16), b = m / T, t = m % T;
    double acc = 0.0; for (int k = 0; k < DM; ++k) acc += (double)bf1(h[(size_t)m * DM + k]) * W[(size_t)k * ldw + cc];
    if (mode == 1) { const double xx = acc + fbias[cc]; const double ref = (xx < 0 ? xx : 0.0) - log1p(exp(-fabs(xx))); dbg_cmp(dbg, code, sout[((size_t)b * 8 + cc) * T + t], (float)ref, 0.02f, 0.02f); }
    else dbg_cmp(dbg, code, sout[(size_t)m * 16 + cc], (float)acc, 0.02f, 0.02f);
}
__global__ void dbg_cmpbuf(unsigned* dbg, unsigned code, const float* a, const float* b, size_t n) {
    for (size_t i = (size_t)blockIdx.x * blockDim.x + threadIdx.x; i < n; i += (size_t)gridDim.x * blockDim.x * 61) dbg_cmp(dbg, code, b[i], a[i], 0.05f, 0.1f);
}
__global__ void dbg_report(const unsigned* dbg, float* out) {
    if (threadIdx.x == 0 && blockIdx.x == 0) { const unsigned code = dbg[0]; if (code != 0xffffffffu) { out[0] = DBG_REPORT_ERR ? 1000.f * __uint_as_float(dbg[1 + (code & 255u)]) : 1000.f * (float)(code & 255u); } }
}
#endif
#ifndef N_LAUNCH_MODE
#define N_LAUNCH_MODE 1
#endif
extern "C" void kernel_launch(void* const* d_in, const int* in_sizes, int n_in, void* d_out, int out_size, void* d_ws, size_t ws_size, hipStream_t stream) {
    static int grid = 0;
    if (grid == 0) {
        if (n_in != 20 || out_size != M * DM || ws_size < WS_END) { fprintf(stderr, "kernel_launch: unexpected shapes (n_in %d out %d ws %zu)\n", n_in, out_size, ws_size); grid = -1; return; }
        int dev = 0, cus = 0, per_cu = 0;
        if (hipGetDevice(&dev) != hipSuccess || hipDeviceGetAttribute(&cus, hipDeviceAttributeMultiprocessorCount, dev) != hipSuccess) { grid = -1; return; }
        if (hipFuncSetAttribute((const void*)trunk_fwd, hipFuncAttributeMaxDynamicSharedMemorySize, LDS_BYTES) != hipSuccess) { fprintf(stderr, "kernel_launch: hipFuncSetAttribute failed\n"); grid = -1; return; }
        if (hipOccupancyMaxActiveBlocksPerMultiprocessor(&per_cu, (const void*)trunk_fwd, NTHREADS, LDS_BYTES) != hipSuccess || per_cu < 1)
            fprintf(stderr, "kernel_launch: occupancy query reports %d workgroups per CU\n", per_cu);
        (void)hipGetLastError();
        grid = cus;
    }
    if (grid < 0) return;
    if (hipMemsetAsync((char*)d_ws + WS_CTL, 0, CTL_ZERO_BYTES, stream) != hipSuccess) return;
    Args a{};
    for (int i = 0; i < 20; ++i) a.in[i] = (const float*)d_in[i];
    a.out = (float*)d_out; a.ws = (unsigned char*)d_ws; a.pad = 0;
#if N_LAUNCH_MODE == 1
    a.ph_lo = 0; a.ph_hi = N_PHASES; a.use_bar = 1;
    hipLaunchKernelGGL(trunk_fwd, dim3(grid), dim3(NTHREADS), LDS_BYTES, stream, a);
#else
    a.use_bar = 0;
#if DBG_CHECK
    unsigned char* wsb = (unsigned char*)d_ws; unsigned* dbg = (unsigned*)(wsb + WS_DBG);
    hipMemsetAsync(dbg, 0xFF, 4, stream); hipMemsetAsync(dbg + 1, 0, 1024, stream);
    const float* const* in = (const float* const*)a.in; float* outp = (float*)d_out; float* oldp = (float*)(wsb + WS_DBG_OLD);
    bf16* hbuf = (bf16*)(wsb + WS_H); bf16* catb = (bf16*)(wsb + WS_CAT); bf16* projb = (bf16*)(wsb + WS_PROJ); bf16* ffhb = (bf16*)(wsb + WS_FFH);
#endif
    for (int p = 0; p < N_PHASES; ++p) {
        int layer = 0; const int q = phase_kind(p, layer); const int li = layer >> 1; const bool odd = layer & 1; (void)li; (void)odd; (void)q;
#if DBG_CHECK
        const float* modl = (const float*)(wsb + WS_MOD) + (size_t)layer * 2 * 6 * DM; const float* xcur = layer == 0 ? in[0] : outp;
        if (q == K_MIXOUT) hipMemcpyAsync(oldp, xcur, (size_t)M * DM * 4, hipMemcpyDeviceToDevice, stream);
        if (q == K_FFOUT) hipMemcpyAsync(oldp, outp, (size_t)M * DM * 4, hipMemcpyDeviceToDevice, stream);
#endif
        a.ph_lo = p; a.ph_hi = p + 1;
        hipLaunchKernelGGL(trunk_fwd, dim3(grid), dim3(NTHREADS), LDS_BYTES, stream, a);
#if DBG_CHECK
        const unsigned code = 1 + p;
        if (q == K_PRO) dbg_mod<<<16, 256, 0, stream>>>(dbg, code, in[1], in[2], in[3], (const float*)(wsb + WS_MOD));
        if (q == K_NORM1) { dbg_norm<<<16, 256, 0, stream>>>(dbg, code, xcur, in[4] + (size_t)layer * DM, modl, modl + DM, hbuf);
            if (!odd) dbg_small<<<16, 256, 0, stream>>>(dbg, code | 0x100, 1, hbuf, in[6] + (size_t)li * DM * AB_IN + AB_N, AB_IN, in[12] + li * 8, (const float*)(wsb + WS_LOGF));
            else dbg_small<<<16, 256, 0, stream>>>(dbg, code | 0x100, 2, hbuf, in[13] + (size_t)li * DM * C_IN + C_N, C_IN, nullptr, (const float*)(wsb + WS_GLOW)); }
        if (q == K_MIXIN) { if (!odd) dbg_gemm<<<16, 256, 0, stream>>>(dbg, code, 0, hbuf, DM, in[6] + (size_t)li * DM * AB_IN, AB_IN, AB_N, projb, AB_N, nullptr, nullptr, nullptr);
            else dbg_gemm<<<16, 256, 0, stream>>>(dbg, code, 0, hbuf, DM, in[13] + (size_t)li * DM * C_IN, C_IN, C_N, projb, C_N, nullptr, nullptr, nullptr); }
#if DBG_REC
        if (q == K_REC) dbg_cmpbuf<<<256, 256, 0, stream>>>(dbg, code, (const float*)(wsb + WS_O), (const float*)(wsb + 1200 * MiB), odd ? (size_t)M * 2048 : (size_t)M * 1024);
#endif
        if (q == K_MIXOUT) dbg_gemm<<<16, 256, 0, stream>>>(dbg, code, 2, catb, DM, (odd ? in[17] : in[7]) + (size_t)li * DM * DM, DM, DM, outp, DM, oldp, modl + 2 * DM, modl + 6 * DM + 2 * DM);
        if (q == K_NORM2) dbg_norm<<<16, 256, 0, stream>>>(dbg, code, outp, in[5] + (size_t)layer * DM, modl + 3 * DM, modl + 4 * DM, hbuf);
        if (q == K_FFIN) dbg_gemm<<<16, 256, 0, stream>>>(dbg, code, 1, hbuf, DM, in[18] + (size_t)layer * DM * FF2, FF2, FF, ffhb, FF, nullptr, nullptr, nullptr);
        if (q == K_FFOUT) dbg_gemm<<<16, 256, 0, stream>>>(dbg, code, 2, ffhb, FF, in[19] + (size_t)layer * FF * DM, DM, DM, outp, DM, oldp, modl + 5 * DM, modl + 6 * DM + 5 * DM);
#endif
    }
#if DBG_CHECK
    dbg_report<<<1, 64, 0, stream>>>(dbg, outp);
#endif
#endif
}
```

```cpp
#include <hip/hip_runtime.h>
#include <hip/hip_bf16.h>
#include <cstdio>
#include <cstdint>
__device__ __forceinline__ int opq_tid(int wave_s) {
    int t; asm volatile("v_mbcnt_lo_u32_b32 %0, -1, 0\n\tv_mbcnt_hi_u32_b32 %0, -1, %0\n\tv_lshl_add_u32 %0, %1, 6, %0" : "=&v"(t) : "s"(wave_s)); return t; }
__device__ __forceinline__ int opq_bid() { int t = blockIdx.x; asm volatile("" : "+s"(t)); return t; }
template <int MASK> __device__ __forceinline__ float xsum(float v) {
    if constexpr (MASK < 32) { return v + __builtin_bit_cast(float, __builtin_amdgcn_ds_swizzle(__builtin_bit_cast(int, v), (MASK << 10) | 0x1f)); }
    else { auto rr = __builtin_amdgcn_permlane32_swap(__float_as_uint(v), __float_as_uint(v), false, false);
           const unsigned r0 = rr[0], r1 = rr[1];
           return __uint_as_float(r0) + __uint_as_float(r1); }
}
__device__ __forceinline__ float xor1_get(float v) { return __builtin_bit_cast(float, __builtin_amdgcn_ds_swizzle(__builtin_bit_cast(int, v), (1 << 10) | 0x1f)); }
namespace pg8 {
#define PG8_LAS __attribute__((address_space(3)))
typedef unsigned short bf16_t;
typedef short bf16x8 __attribute__((ext_vector_type(8)));
typedef float f32x4 __attribute__((ext_vector_type(4)));
typedef unsigned u32x4 __attribute__((ext_vector_type(4)));
constexpr int BM = 256, BK = 64, HALF = 128, HTB = HALF * BK * 2  , STAGE_BYTES = 8 * HTB, NXCD = 8, WGM = 8;

__host__ __device__ __forceinline__ int lds_byte(int r, int c) { const int st = (r >> 4) * 2 + (c >> 5), rr = r & 15, cc = c & 31, ob = rr * 64 + cc * 2; return st * 1024 + (ob ^ (((ob >> 9) & 1) << 5)); }
__host__ __device__ __forceinline__ void stage_rc(int b, int& R, int& C) { const int st = b / 1024, sb = b % 1024, swz = sb ^ (((sb >> 9) & 1) << 5); R = (st >> 1) * 16 + swz / 64; C = (st & 1) * 32 + (swz % 64) / 2; }
__host__ __device__ __forceinline__ int perm32(int rho) { const int n = rho >> 4, i = rho & 15; return 8 * (i >> 2) + 4 * n + (i & 3); }

struct Unit { int pm, pn; };
struct Gemm { const bf16_t* A; const bf16_t* Bt; int M, N, K; };

struct StaticOrder {
    int nM, nN, nwg, G, c;
    __host__ __device__ void init(int M, int N, int G_, int c_) { nM = M / BM; nN = N / BM; nwg = nM * nN; G = G_; c = c_; }
    __host__ __device__ bool next(int i, Unit& u) const {
        const long L = (long)i * G + c; if (L >= nwg) return false;
        int wgid = (int)L; { const int q = nwg / NXCD, r = nwg % NXCD, xcd = wgid % NXCD, off = wgid / NXCD; wgid = (xcd < r ? xcd * (q + 1) : r * (q + 1) + (xcd - r) * q) + off; }
        const int nig = WGM * nN, gid = wgid / nig, fm = gid * WGM, gsz = (nM - fm) < WGM ? (nM - fm) : WGM;
        u.pm = fm + ((wgid % nig) % gsz); u.pn = (wgid % nig) / gsz; return true;
    }
    __device__ __forceinline__ void a_ready(const Unit&) const {}
    __device__ __forceinline__ void done(const Unit&) const {}
};

__device__ __forceinline__ unsigned cvt_pk_bf16(float lo, float hi) { unsigned r; asm volatile("v_cvt_pk_bf16_f32 %0, %1, %2" : "=v"(r) : "v"(lo), "v"(hi)); return r; }
typedef float f32x2 __attribute__((ext_vector_type(2)));

struct EpiBf16 {
    static constexpr bool PERM = true, AFTER_DRAIN = false;
    bf16_t* O; int ldc;
    __device__ __forceinline__ void operator()(const f32x4 (&acc)[2][2][4][2], const Unit& u, int wr, int wc, int fr, int fq) const {
        const int row0 = u.pm * BM + wr * 64 + fr; const int col0 = u.pn * BM + wc * 32 + 8 * fq;
#pragma unroll
        for (int ai = 0; ai < 2; ++ai)
#pragma unroll
            for (int m = 0; m < 4; ++m) { bf16_t* rowp = O + (size_t)(row0 + ai * HALF + m * 16) * ldc + col0;
#pragma unroll
                for (int bj = 0; bj < 2; ++bj) { const f32x4 v0 = acc[ai][bj][m][0], v1 = acc[ai][bj][m][1];
                    u32x4 w; w.x = cvt_pk_bf16(v0[0], v0[1]); w.y = cvt_pk_bf16(v0[2], v0[3]); w.z = cvt_pk_bf16(v1[0], v1[1]); w.w = cvt_pk_bf16(v1[2], v1[3]);
                    *(u32x4*)(rowp + bj * HALF) = w; } }
    }
};
__device__ __forceinline__ float silu_f(float a) { return a * __builtin_amdgcn_rcpf(1.0f + __builtin_amdgcn_exp2f(-1.4426950408889634f * a)); }
struct EpiSwiglu {
    static constexpr bool PERM = true, AFTER_DRAIN = false;
    bf16_t* O; int ldc;
    __device__ __forceinline__ void operator()(const f32x4 (&acc)[2][2][4][2], const Unit& u, int wr, int wc, int fr, int fq) const {
        const int row0 = u.pm * BM + wr * 64 + fr; const int col0 = u.pn * HALF + wc * 32 + 8 * fq;
#pragma unroll
        for (int ai = 0; ai < 2; ++ai)
#pragma unroll
            for (int m = 0; m < 4; ++m) { bf16_t* rowp = O + (size_t)(row0 + ai * HALF + m * 16) * ldc + col0;
                const f32x4 a0 = acc[ai][0][m][0], a1 = acc[ai][0][m][1], u0 = acc[ai][1][m][0], u1 = acc[ai][1][m][1];
                u32x4 w;
                w.x = cvt_pk_bf16(silu_f(a0[0]) * u0[0], silu_f(a0[1]) * u0[1]); w.y = cvt_pk_bf16(silu_f(a0[2]) * u0[2], silu_f(a0[3]) * u0[3]);
                w.z = cvt_pk_bf16(silu_f(a1[0]) * u1[0], silu_f(a1[1]) * u1[1]); w.w = cvt_pk_bf16(silu_f(a1[2]) * u1[2], silu_f(a1[3]) * u1[3]);
                *(u32x4*)rowp = w; }
    }
};
struct EpiResid {
    static constexpr bool PERM = false, AFTER_DRAIN = false;
    const float* base; float* out; int ldc; const float* gate0; const float* gate1; int pm_split;
    __device__ __forceinline__ void operator()(const f32x4 (&acc)[2][2][4][2], const Unit& u, int wr, int wc, int fr, int fq) const {
        const int col0 = u.pn * BM + wc * 32 + 4 * fq; const float* g = (u.pm >= pm_split) ? gate1 : gate0;
        f32x4 gv[2][2];
#pragma unroll
        for (int bj = 0; bj < 2; ++bj)
#pragma unroll
            for (int n = 0; n < 2; ++n) gv[bj][n] = *(const f32x4*)(g + col0 + bj * HALF + n * 16);
#pragma unroll
        for (int ai = 0; ai < 2; ++ai) { f32x4 bs[4][2][2];
#pragma unroll
            for (int m = 0; m < 4; ++m) { const size_t off = (size_t)(u.pm * BM + ai * HALF + wr * 64 + m * 16 + fr) * ldc + col0;
#pragma unroll
                for (int bj = 0; bj < 2; ++bj)
#pragma unroll
                    for (int n = 0; n < 2; ++n) bs[m][bj][n] = *(const f32x4*)(base + off + bj * HALF + n * 16); }
#pragma unroll
            for (int m = 0; m < 4; ++m) { const size_t off = (size_t)(u.pm * BM + ai * HALF + wr * 64 + m * 16 + fr) * ldc + col0;
#pragma unroll
                for (int bj = 0; bj < 2; ++bj)
#pragma unroll
                    for (int n = 0; n < 2; ++n) *(f32x4*)(out + off + bj * HALF + n * 16) = bs[m][bj][n] + gv[bj][n] * acc[ai][bj][m][n]; }
            asm volatile("" ::: "memory"); }
    }
};
struct EpiResidBf {
    static constexpr bool PERM = false, AFTER_DRAIN = false;
    const bf16_t* xb; float* out; int ldc; const float* gate0; const float* gate1; int pm_split;
    typedef unsigned u32x2 __attribute__((ext_vector_type(2)));
    __device__ __forceinline__ void operator()(const f32x4 (&acc)[2][2][4][2], const Unit& u, int wr, int wc, int fr, int fq) const {
        const int col0 = u.pn * BM + wc * 32 + 4 * fq; const float* g = (u.pm >= pm_split) ? gate1 : gate0;
        f32x4 gv[2][2];
#pragma unroll
        for (int bj = 0; bj < 2; ++bj)
#pragma unroll
            for (int n = 0; n < 2; ++n) gv[bj][n] = *(const f32x4*)(g + col0 + bj * HALF + n * 16);
#pragma unroll
        for (int ai = 0; ai < 2; ++ai) { u32x2 bs[4][2][2];
#pragma unroll
            for (int m = 0; m < 4; ++m) { const size_t off = (size_t)(u.pm * BM + ai * HALF + wr * 64 + m * 16 + fr) * ldc + col0;
#pragma unroll
                for (int bj = 0; bj < 2; ++bj)
#pragma unroll
                    for (int n = 0; n < 2; ++n) bs[m][bj][n] = *(const u32x2*)(xb + off + bj * HALF + n * 16); }
#pragma unroll
            for (int m = 0; m < 4; ++m) { const size_t off = (size_t)(u.pm * BM + ai * HALF + wr * 64 + m * 16 + fr) * ldc + col0;
#pragma unroll
                for (int bj = 0; bj < 2; ++bj)
#pragma unroll
                    for (int n = 0; n < 2; ++n) { const u32x2 b = bs[m][bj][n];
                        const f32x4 xv = {__uint_as_float(b.x << 16), __uint_as_float(b.x & 0xffff0000u), __uint_as_float(b.y << 16), __uint_as_float(b.y & 0xffff0000u)};
                        *(f32x4*)(out + off + bj * HALF + n * 16) = xv + gv[bj][n] * acc[ai][bj][m][n]; } }
            asm volatile("" ::: "memory"); }
    }
};

template <class Epi, class Sched, bool ALIGN_EPI = false, bool SP2 = false>
__device__ __forceinline__ void gemm_phase(PG8_LAS unsigned char* lds, const Gemm g, const Sched& S, const Epi& E, const int tid) {
    const int wid = __builtin_amdgcn_readfirstlane(tid >> 6), lane = tid & 63, wr = wid >> 2, wc = wid & 3, fr = lane & 15, fq = lane >> 4;
    const int K = g.K, nt = K / BK;
    unsigned voffA[2], voffB[2];
#pragma unroll
    for (int i = 0; i < 2; ++i) { int R, C; stage_rc(tid * 16 + i * 8192, R, C); const int Rb = Epi::PERM ? ((R & ~31) + perm32(R & 31)) : R;
        voffA[i] = (unsigned)(R * K + C) * 2u; voffB[i] = (unsigned)(Rb * K + C) * 2u; }
    const size_t kstep = (size_t)(BK * 2);
    const size_t hstep = (size_t)HALF * K * 2;
    const size_t tstep = 2 * hstep;
    const unsigned ldsw = (unsigned)wid * 1024u;
    const int aoff = lds_byte(wr * 64 + fr, fq * 8), boff = lds_byte(wc * 32 + fr, fq * 8);
#define PG8_SA(b, h) (((b) * 2 + (h)) * HTB)
#define PG8_SB(b, h) ((4 + (b) * 2 + (h)) * HTB)
#define PG8_STAGE(bufoff, gbase, voff) do { _Pragma("unroll") for (int _i = 0; _i < 2; ++_i) \
        __builtin_amdgcn_global_load_lds((const unsigned*)((const char*)(gbase) + (voff)[_i]), (PG8_LAS unsigned*)(lds + (bufoff) + ldsw + _i * 8192), 16, 0, 0); } while (0)
#define PG8_LDA(dst, b, h) do { _Pragma("unroll") for (int m = 0; m < 4; ++m) _Pragma("unroll") for (int k = 0; k < 2; ++k) dst[m][k] = *(const PG8_LAS bf16x8*)(lds + PG8_SA(b, h) + aoff + m * 2048 + k * 1024); } while (0)
#define PG8_LDB(dst, b, h) do { _Pragma("unroll") for (int n = 0; n < 2; ++n) _Pragma("unroll") for (int k = 0; k < 2; ++k) dst[n][k] = *(const PG8_LAS bf16x8*)(lds + PG8_SB(b, h) + boff + n * 2048 + k * 1024); } while (0)
#define PG8_MMA(ai, bj, At, Bt) do { __builtin_amdgcn_s_setprio(1); _Pragma("unroll") for (int m = 0; m < 4; ++m) _Pragma("unroll") for (int n = 0; n < 2; ++n) _Pragma("unroll") for (int k = 0; k < 2; ++k) \
        acc[ai][bj][m][n] = __builtin_amdgcn_mfma_f32_16x16x32_bf16(Bt[n][k], At[m][k], acc[ai][bj][m][n], 0, 0, 0); __builtin_amdgcn_s_setprio(0); } while (0)
#define PG8_WAIT_V(n) asm volatile("s_waitcnt vmcnt(" #n ")" ::: "memory")
#define PG8_WAIT_L(n) asm volatile("s_waitcnt lgkmcnt(" #n ")" ::: "memory")
#define PG8_BAR __builtin_amdgcn_s_barrier()
#define PG8_SCHED __builtin_amdgcn_sched_barrier(0)
    Unit cur, nxt; int ui = 0;
    if (!S.next(0, cur)) return;
    f32x4 acc[2][2][4][2];
#pragma unroll
    for (int a = 0; a < 2; ++a)
#pragma unroll
        for (int b = 0; b < 2; ++b)
#pragma unroll
            for (int m = 0; m < 4; ++m)
#pragma unroll
                for (int n = 0; n < 2; ++n) acc[a][b][m][n] = (f32x4){0.f, 0.f, 0.f, 0.f};
    bf16x8 At[4][2], B0[2][2], B1[2][2];
    const char* cA = (const char*)g.A + (size_t)cur.pm * tstep; const char* cB = (const char*)g.Bt + (size_t)cur.pn * tstep;
    S.a_ready(cur);
    if constexpr (SP2) {
        PG8_STAGE(PG8_SB(0, 0), cB, voffB); PG8_STAGE(PG8_SB(0, 1), cB + hstep, voffB); PG8_STAGE(PG8_SA(0, 0), cA, voffA); PG8_STAGE(PG8_SA(0, 1), cA + hstep, voffA);
        if (wr == 1) PG8_BAR;
        PG8_WAIT_V(2); PG8_BAR;
        PG8_STAGE(PG8_SB(1, 0), cB + kstep, voffB); PG8_STAGE(PG8_SA(1, 0), cA + kstep, voffA); PG8_STAGE(PG8_SB(1, 1), cB + hstep + kstep, voffB);
        PG8_WAIT_V(6); PG8_BAR;
    } else {
        PG8_STAGE(PG8_SB(0, 0), cB, voffB); PG8_STAGE(PG8_SA(0, 0), cA, voffA); PG8_STAGE(PG8_SB(0, 1), cB + hstep, voffB); PG8_STAGE(PG8_SA(0, 1), cA + hstep, voffA);
        if (wr == 1) PG8_BAR;
        PG8_WAIT_V(4); PG8_BAR;
        PG8_STAGE(PG8_SB(1, 0), cB + kstep, voffB); PG8_STAGE(PG8_SA(1, 0), cA + kstep, voffA); PG8_STAGE(PG8_SB(1, 1), cB + hstep + kstep, voffB);
        PG8_WAIT_V(6); PG8_BAR;
    }
    for (;;) {
        const bool has_next = S.next(ui + 1, nxt);
        const char* nA = has_next ? (const char*)g.A + (size_t)nxt.pm * tstep : cA; const char* nB = has_next ? (const char*)g.Bt + (size_t)nxt.pn * tstep : cB;
        for (int t = 0; t < nt; t += 2) {
            const bool last = (t == nt - 2);
            const char* a1 = cA + (size_t)(t + 1) * kstep;
            const char* a2 = last ? nA : cA + (size_t)(t + 2) * kstep; const char* b2 = last ? nB : cB + (size_t)(t + 2) * kstep;
            const char* a3 = a2 + kstep; const char* b3 = b2 + kstep;
            if (last && has_next) S.a_ready(nxt);
            if constexpr (SP2) {
            PG8_LDB(B0, 0, 0); PG8_LDB(B1, 0, 1); PG8_SCHED; PG8_LDA(At, 0, 0); PG8_STAGE(PG8_SA(1, 1), a1 + hstep, voffA);
            PG8_WAIT_V(8); PG8_WAIT_L(0); PG8_BAR; PG8_MMA(0, 0, At, B0); PG8_MMA(0, 1, At, B1); PG8_BAR; PG8_SCHED;
            PG8_LDA(At, 0, 1); PG8_STAGE(PG8_SB(0, 0), b2, voffB); PG8_STAGE(PG8_SB(0, 1), b2 + hstep, voffB); PG8_STAGE(PG8_SA(0, 0), a2, voffA);
            PG8_WAIT_V(8); PG8_WAIT_L(0); PG8_BAR; PG8_MMA(1, 0, At, B0); PG8_MMA(1, 1, At, B1); PG8_BAR; PG8_SCHED;
            PG8_LDB(B0, 1, 0); PG8_LDB(B1, 1, 1); PG8_SCHED; PG8_LDA(At, 1, 0); PG8_STAGE(PG8_SA(0, 1), a2 + hstep, voffA);
            PG8_WAIT_V(8); PG8_WAIT_L(0); PG8_BAR; PG8_MMA(0, 0, At, B0); PG8_MMA(0, 1, At, B1); PG8_BAR; PG8_SCHED;
            PG8_LDA(At, 1, 1); PG8_STAGE(PG8_SB(1, 0), b3, voffB); PG8_STAGE(PG8_SB(1, 1), b3 + hstep, voffB); PG8_STAGE(PG8_SA(1, 0), a3, voffA);
            PG8_WAIT_V(8); PG8_WAIT_L(0); PG8_BAR; PG8_MMA(1, 0, At, B0); PG8_MMA(1, 1, At, B1); PG8_BAR; PG8_SCHED;
            } else {
            PG8_LDB(B0, 0, 0); PG8_SCHED; PG8_LDA(At, 0, 0); PG8_STAGE(PG8_SA(1, 1), a1 + hstep, voffA);
            PG8_WAIT_L(8); PG8_BAR; PG8_WAIT_L(0); PG8_MMA(0, 0, At, B0); PG8_BAR; PG8_SCHED;
            PG8_LDB(B1, 0, 1); PG8_STAGE(PG8_SB(0, 0), b2, voffB);
            PG8_BAR; PG8_WAIT_L(0); PG8_MMA(0, 1, At, B1); PG8_BAR;
            PG8_LDA(At, 0, 1); PG8_STAGE(PG8_SA(0, 0), a2, voffA);
            PG8_BAR; PG8_WAIT_L(0); PG8_MMA(1, 0, At, B0); PG8_BAR; PG8_SCHED;
            PG8_STAGE(PG8_SB(0, 1), b2 + hstep, voffB);
            PG8_WAIT_V(6); PG8_BAR; PG8_MMA(1, 1, At, B1); PG8_BAR;
            PG8_LDB(B0, 1, 0); PG8_SCHED; PG8_LDA(At, 1, 0); PG8_STAGE(PG8_SA(0, 1), a2 + hstep, voffA);
            PG8_WAIT_L(8); PG8_BAR; PG8_WAIT_L(0); PG8_MMA(0, 0, At, B0); PG8_BAR; PG8_SCHED;
            PG8_LDB(B1, 1, 1); PG8_STAGE(PG8_SB(1, 0), b3, voffB);
            PG8_BAR; PG8_WAIT_L(0); PG8_MMA(0, 1, At, B1); PG8_BAR;
            PG8_LDA(At, 1, 1); PG8_STAGE(PG8_SA(1, 0), a3, voffA);
            PG8_BAR; PG8_WAIT_L(0); PG8_MMA(1, 0, At, B0); PG8_BAR; PG8_SCHED;
            PG8_STAGE(PG8_SB(1, 1), b3 + hstep, voffB);
            PG8_WAIT_V(6); PG8_BAR; PG8_MMA(1, 1, At, B1); PG8_BAR;
            }
        }
        if constexpr (ALIGN_EPI) { if (wr == 0) PG8_BAR; }
        if constexpr (!Epi::AFTER_DRAIN) { E(acc, cur, wr, wc, fr, fq); S.done(cur); }
        if (!has_next) break;
#pragma unroll
        for (int a = 0; a < 2; ++a)
#pragma unroll
            for (int b = 0; b < 2; ++b)
#pragma unroll
                for (int m = 0; m < 4; ++m)
#pragma unroll
                    for (int n = 0; n < 2; ++n) acc[a][b][m][n] = (f32x4){0.f, 0.f, 0.f, 0.f};
        cur = nxt; cA = nA; cB = nB; ++ui;
        if constexpr (ALIGN_EPI) { if (wr == 1) PG8_BAR; }
    }
    PG8_WAIT_V(0);
    if constexpr (!ALIGN_EPI) { if (wr == 0) PG8_BAR; }
    PG8_BAR;
    if constexpr (Epi::AFTER_DRAIN) { E.fused(acc, cur, wr, wc, fr, fq, lds, wid, lane); S.done(cur); }
#undef PG8_SA
#undef PG8_SB
#undef PG8_STAGE
#undef PG8_LDA
#undef PG8_LDB
#undef PG8_MMA
#undef PG8_WAIT_V
#undef PG8_WAIT_L
#undef PG8_BAR
#undef PG8_SCHED
}
}
namespace fox {
constexpr int D = 128, PITCH = 8192, OPITCH = 2048, SKV = 8192, GATE_OFF = 3072;
constexpr float THR = 8.f;
constexpr float SCALE = 0.08838834764831845f;
constexpr int NW = 8, QBLK = 32, KVBLK = 64, QB = NW * QBLK;
constexpr int SHM_V = KVBLK * D * 2, SHM_K = KVBLK * D * 2;
constexpr int BIAS_OFF = 2 * SHM_V + 2 * SHM_K + NW * 64 * 4;
constexpr int LDS_BYTES = BIAS_OFF + SKV * 4;

using bf16 = __hip_bfloat16;
typedef short bf16x8 __attribute__((ext_vector_type(8)));
typedef short s16x4 __attribute__((ext_vector_type(4)));
typedef float f32x16 __attribute__((ext_vector_type(16)));
typedef float f32x4 __attribute__((ext_vector_type(4)));
typedef unsigned u32x4 __attribute__((ext_vector_type(4)));

#define KSWZ(row, colB) ((row) * 256 + ((colB) ^ (((row) & 7) << 4)))
#define SBAR() __builtin_amdgcn_sched_barrier(0)
__device__ __forceinline__ int v_st(int k, int c) { const int kk = (k & ~0xC) | ((k & 4) << 1) | ((k & 8) >> 1); return ((kk >> 3) * 4 + (c >> 5)) * 512 + ((kk & 7) * 32 + (c & 31)) * 2; }
__device__ __forceinline__ int v_rd_base(int lane) { return ((lane & 3) << 3) | (((lane >> 2) & 3) << 6) | (((lane >> 4) & 1) << 5) | (((lane >> 5) & 1) << 8); }
constexpr int v_rd_off(int d0, int ks, int half) { return d0 * 512 + ks * 4096 + half * 2048; }
__device__ __forceinline__ int crow(int r, int hi) { return (r & 3) + 8 * (r >> 2) + 4 * hi; }
__device__ __forceinline__ unsigned cvtpk(float lo, float hi) {
    unsigned r; asm volatile("v_cvt_pk_bf16_f32 %0, %1, %2" : "=v"(r) : "v"(lo), "v"(hi)); return r;
}
__device__ __forceinline__ bf16x8 load8(const bf16* p) { return *reinterpret_cast<const bf16x8*>(p); }
__device__ __forceinline__ void mask_tile(f32x16& p0, f32x16& p1, int dq, unsigned W) {
    const float NEG = -__builtin_inff();
#pragma unroll
    for (int r = 0; r < 16; ++r) {
        const int c = (r & 3) + 8 * (r >> 2);
        if ((unsigned)(dq - c) >= W) p0[r] = NEG;
        if ((unsigned)(dq - c - 32) >= W) p1[r] = NEG;
    }
}
__device__ __forceinline__ void partialSM(f32x16& p0, f32x16& p1, float& m_reg, float& mn, float& alpha) {
    float pmax = p0[0]; for (int r = 1; r < 16; ++r) pmax = fmaxf(pmax, p0[r]); for (int r = 0; r < 16; ++r) pmax = fmaxf(pmax, p1[r]);
    { auto rr = __builtin_amdgcn_permlane32_swap(__float_as_uint(pmax), __float_as_uint(pmax), false, false);
      pmax = fmaxf(__uint_as_float(rr[0]), __uint_as_float(rr[1])); }
    constexpr float C2 = 1.4426950408889634f * SCALE;
    if (__builtin_expect(__all((pmax - m_reg) * SCALE <= THR), 1)) { mn = m_reg; alpha = 1.f; }
    else { mn = fmaxf(m_reg, pmax); alpha = __builtin_amdgcn_exp2f((m_reg - mn) * C2); m_reg = mn; }
    const float mnL = -mn * C2;
    for (int r = 0; r < 16; ++r) p0[r] = fmaf(p0[r], C2, mnL); for (int r = 0; r < 16; ++r) p1[r] = fmaf(p1[r], C2, mnL);
    for (int r = 0; r < 16; ++r) p0[r] = __builtin_amdgcn_exp2f(p0[r]);
}
__device__ __forceinline__ void finishSM(f32x16& p0, f32x16& p1, float alpha, float& l_reg, bf16x8& pa0, bf16x8& pa1, bf16x8& pa2, bf16x8& pa3) {
    for (int r = 0; r < 16; ++r) p1[r] = __builtin_amdgcn_exp2f(p1[r]);
    float ps = 0; for (int r = 0; r < 16; ++r) ps += p0[r]; for (int r = 0; r < 16; ++r) ps += p1[r];
    { auto rr = __builtin_amdgcn_permlane32_swap(__float_as_uint(ps), __float_as_uint(ps), false, false);
      ps = __uint_as_float(rr[0]) + __uint_as_float(rr[1]); }
    l_reg = l_reg * alpha + ps;
#define PK4(P, B_, OUT) do { unsigned a0 = cvtpk(P[B_+0], P[B_+1]), a1 = cvtpk(P[B_+2], P[B_+3]);                          \
        unsigned b0 = cvtpk(P[B_+4], P[B_+5]), b1 = cvtpk(P[B_+6], P[B_+7]);                                             \
        auto r0 = __builtin_amdgcn_permlane32_swap(a0, b0, false, false); auto r1 = __builtin_amdgcn_permlane32_swap(a1, b1, false, false); \
        u32x4 w = {r0[0], r1[0], r0[1], r1[1]}; OUT = *reinterpret_cast<bf16x8*>(&w); } while (0)
    PK4(p0, 0, pa0); PK4(p0, 8, pa1); PK4(p1, 0, pa2); PK4(p1, 8, pa3);
#undef PK4
}
template <int KB>
__device__ __forceinline__ void qkt(f32x16& p0, f32x16& p1, const char* K_lds, const float* bt, int r32, int hi, const bf16x8* qr) {
#pragma unroll
    for (int j = 0; j < 4; ++j) { const f32x4 a = *(const f32x4*)(bt + 8 * j), b = *(const f32x4*)(bt + 32 + 8 * j);
        p0[4 * j + 0] = a[0]; p0[4 * j + 1] = a[1]; p0[4 * j + 2] = a[2]; p0[4 * j + 3] = a[3];
        p1[4 * j + 0] = b[0]; p1[4 * j + 1] = b[1]; p1[4 * j + 2] = b[2]; p1[4 * j + 3] = b[3]; }
    const char* kb[4];
#pragma unroll
    for (int dd = 0; dd < 4; ++dd) kb[dd] = K_lds + KB * SHM_K + KSWZ(r32, (dd * 16 + hi * 8) * 2);
#pragma unroll
    for (int d0 = 0; d0 < 8; ++d0) { const char* a = kb[d0 & 3] + (d0 >> 2) * 128;
        bf16x8 b0 = *reinterpret_cast<const bf16x8*>(a);
        bf16x8 b1 = *reinterpret_cast<const bf16x8*>(a + 32 * 256);
        p0 = __builtin_amdgcn_mfma_f32_32x32x16_bf16(b0, qr[d0], p0, 0, 0, 0);
        p1 = __builtin_amdgcn_mfma_f32_32x32x16_bf16(b1, qr[d0], p1, 0, 0, 0); }
}
template <int VB>
__device__ __forceinline__ void pv_tile(f32x16* o, int vb0, bf16x8 pa0, bf16x8 pa1, bf16x8 pa2, bf16x8 pa3) {
#define TRRD(dst, off) asm volatile("ds_read_b64_tr_b16 %0, %1 offset:%2" : "=&v"(dst) : "v"(vb0), "i"(off) : "memory")
#define PV_D0(d0) do { s16x4 l0, l1, l2, l3, h0, h1, h2, h3; constexpr int b_ = VB * SHM_V + v_rd_off(d0, 0, 0);     \
        TRRD(l0, b_); TRRD(h0, b_ + 2048); TRRD(l1, b_ + 4096); TRRD(h1, b_ + 6144); TRRD(l2, b_ + 8192); TRRD(h2, b_ + 10240); TRRD(l3, b_ + 12288); TRRD(h3, b_ + 14336); \
        asm volatile("s_waitcnt lgkmcnt(0)" ::: "memory"); SBAR();                 \
        o[d0] = __builtin_amdgcn_mfma_f32_32x32x16_bf16(pa0, (bf16x8){l0[0], l0[1], l0[2], l0[3], h0[0], h0[1], h0[2], h0[3]}, o[d0], 0, 0, 0);   \
        o[d0] = __builtin_amdgcn_mfma_f32_32x32x16_bf16(pa1, (bf16x8){l1[0], l1[1], l1[2], l1[3], h1[0], h1[1], h1[2], h1[3]}, o[d0], 0, 0, 0);   \
        o[d0] = __builtin_amdgcn_mfma_f32_32x32x16_bf16(pa2, (bf16x8){l2[0], l2[1], l2[2], l2[3], h2[0], h2[1], h2[2], h2[3]}, o[d0], 0, 0, 0);   \
        o[d0] = __builtin_amdgcn_mfma_f32_32x32x16_bf16(pa3, (bf16x8){l3[0], l3[1], l3[2], l3[3], h3[0], h3[1], h3[2], h3[3]}, o[d0], 0, 0, 0); } while (0)
    PV_D0(0); PV_D0(1); PV_D0(2); PV_D0(3);
#undef PV_D0
#undef TRRD
}

struct BlockRef { const bf16* Q; const bf16* K; const bf16* V; bf16* O; const float* Bias; int P0; float THp; };
struct Seam { bf16x8 qr[8]; bf16x8 st_v0, st_v1, st_k0, st_k1; };
#define ROW(p, k0, rr) ((const bf16*)((const char*)(p) + (size_t)(k0) * (PITCH * 2) + (unsigned)(voff + (unsigned)(rr) * (PITCH * 2u))))
#define VMW() asm volatile("s_waitcnt vmcnt(0)" ::: "memory")
#define VMWN(n) asm volatile("s_waitcnt vmcnt(%0)" :: "i"(n) : "memory")
#define SLOAD_H(Kp, Vp, k0) do { S.st_v0 = load8(ROW(Vp, k0, 0)); S.st_v1 = load8(ROW(Vp, k0, 32));              \
                         S.st_k0 = load8(ROW(Kp, k0, 0)); S.st_k1 = load8(ROW(Kp, k0, 32)); } while (0)
#define SWRITE_HK(bf) do { *(bf16x8*)(K_lds + (bf) * SHM_K + kws) = S.st_k0; *(bf16x8*)(K_lds + (bf) * SHM_K + kws + 32 * 256) = S.st_k1; } while (0)
#define SWRITE_HV(bf) do { *(bf16x8*)(V_lds + (bf) * SHM_V + vst0) = S.st_v0; *(bf16x8*)(V_lds + (bf) * SHM_V + vst1) = S.st_v1; } while (0)
#define SWRITE_H(bf) do { SWRITE_HV(bf); SWRITE_HK(bf); } while (0)
__device__ __forceinline__ void fox_prime(const BlockRef& cur, char* lds, Seam& S, const int tid) {
    const int wid = __builtin_amdgcn_readfirstlane(tid >> 6), lane = tid & 63, r32 = lane & 31, hi = lane >> 5;
    const int sr = tid >> 4, sc = (tid & 15) * 8, kws = KSWZ(sr, sc * 2); char* K_lds = lds + 2 * SHM_V;
    const unsigned voff = (unsigned)(sr * PITCH + sc) * 2u, qoff = (unsigned)((wid * QBLK + r32) * PITCH + hi * 8) * 2u;
    for (int d0 = 0; d0 < 8; ++d0) S.qr[d0] = load8((const bf16*)((const char*)cur.Q + (qoff + d0 * 32)));
    (void)kws; (void)K_lds; (void)voff;
    __syncthreads();
}
__device__ __forceinline__ void fox_block(const BlockRef& cur, const BlockRef& nxt, char* lds, Seam& S, const int tid) {
    const int wid = __builtin_amdgcn_readfirstlane(tid >> 6), lane = tid & 63, r32 = lane & 31, hi = lane >> 5;
    const int W = SKV;
    const int NTF = (cur.P0 + QB - 1) / KVBLK + 1;
    const int qlo = cur.P0 + wid * QBLK, qm = qlo + r32 - 4 * hi;
    char* V_lds = lds; char* K_lds = lds + 2 * SHM_V;
    float* ws = (float*)(lds + 2 * SHM_V + 2 * SHM_K) + wid * 64; float* li_l = ws, * al_l = ws + 32;
    float* biasL = (float*)(lds + BIAS_OFF);
    { const int nk = cur.P0 + QB;
      int t4 = tid * 4; asm volatile("" : "+v"(t4));
      f32x4 bv[4];
#pragma unroll
      for (int k = 0; k < 4; ++k) { const int i = t4 + k * (NW * 64 * 4); if (i < nk) bv[k] = *(const f32x4*)((const char*)cur.Bias + (unsigned)(i * 4)); }
#pragma unroll
      for (int k = 0; k < 4; ++k) { const int i = t4 + k * (NW * 64 * 4); if (i < nk) *(f32x4*)(biasL + i) = bv[k]; }
      __syncthreads(); }
    int j_lo; { int lo_ = 0, hi_ = cur.P0 / KVBLK; const float bref = biasL[cur.P0] - cur.THp;
        while (lo_ < hi_) { const int mid = (lo_ + hi_) >> 1; if (biasL[mid * KVBLK + KVBLK - 1] < bref) lo_ = mid + 1; else hi_ = mid; }
        j_lo = __builtin_amdgcn_readfirstlane(lo_); }
    const int NT = NTF - j_lo;
    const float* bl = biasL + 4 * hi;
    float m_reg = -1e30f, l_reg = 0; f32x16 o[4] = {};
    const int sr = tid >> 4, sc = (tid & 15) * 8, vst0 = v_st(sr, sc), vst1 = v_st(32 + sr, sc), kws = KSWZ(sr, sc * 2);
    const unsigned voff = (unsigned)(sr * PITCH + sc) * 2u, qoff = (unsigned)((wid * QBLK + r32) * PITCH + hi * 8) * 2u;
    const int vb0 = (int)(uintptr_t)V_lds + v_rd_base(lane);
    const bf16* Kh = cur.K; const bf16* Vh = cur.V;
#define RESC(a) do { if (__any((a) < 1.f)) { if (hi == 0) al_l[r32] = (a); asm volatile("s_waitcnt lgkmcnt(0)" ::: "memory");              \
                     for (int d_ = 0; d_ < 4; ++d_) for (int r = 0; r < 16; ++r) o[d_][r] *= al_l[crow(r, hi)]; } } while (0)
#define KBASE(t) ((j_lo + (NT - 1 - (t))) * KVBLK)
#define MASKT(P0_, P1_, t) do { const int kb_ = KBASE(t); if (kb_ + KVBLK - 1 > qlo) mask_tile(P0_, P1_, qm - kb_, (unsigned)W); } while (0)
    constexpr int NQL = 8;
#define SEAM_K0() do { VMWN(NQL); SWRITE_HK(0); SBAR(); } while (0)
    f32x16 pA0, pA1, pB0, pB1; float mnA, mnB, alA, alB; bf16x8 pa0, pa1, pa2, pa3;
    SLOAD_H(Kh, Vh, KBASE(0)); VMW(); SWRITE_HK(0); SWRITE_HV(0); __syncthreads();
    SBAR();
    if (NT > 1) { SLOAD_H(Kh, Vh, KBASE(1)); }
    SBAR(); qkt<0>(pA0, pA1, K_lds, bl + KBASE(0), r32, hi, S.qr);
    MASKT(pA0, pA1, 0); partialSM(pA0, pA1, m_reg, mnA, alA);
    if (NT > 1) { VMW(); SWRITE_H(1); if (NT > 2) SLOAD_H(Kh, Vh, KBASE(2)); }
    __syncthreads();
#define HALF_STEP(PX0, PX1, mnX, alX, PY0, PY1, alY, t, KB, VB, SB) do {                                                      \
        SBAR(); qkt<KB>(PX0, PX1, K_lds, bl + KBASE(t), r32, hi, S.qr);                                             \
        finishSM(PY0, PY1, alY, l_reg, pa0, pa1, pa2, pa3); SBAR();                                                           \
        pv_tile<VB>(o, vb0, pa0, pa1, pa2, pa3); MASKT(PX0, PX1, (t)); partialSM(PX0, PX1, m_reg, mnX, alX);                                        \
        __syncthreads();                                                                                                      \
        if ((t) + 1 < NT) { VMW(); SWRITE_H(SB); if ((t) + 2 < NT) SLOAD_H(Kh, Vh, KBASE((t) + 2)); }                               \
        RESC(alX); __syncthreads(); } while (0)
    for (int t = 1; t + 1 < NT; t += 2) {
        HALF_STEP(pB0, pB1, mnB, alB, pA0, pA1, alA, t, 1, 0, 0);
        HALF_STEP(pA0, pA1, mnA, alA, pB0, pB1, alB, t + 1, 0, 1, 1);
    }
    const bool even = (NT & 1) == 0;
    if (even) { SBAR(); qkt<1>(pB0, pB1, K_lds, bl + KBASE(NT - 1), r32, hi, S.qr); SBAR(); }
#pragma unroll
    for (int d0 = 0; d0 < 8; ++d0) S.qr[d0] = load8((const bf16*)((const char*)nxt.Q + (qoff + d0 * 32)));
    SBAR();
    finishSM(pA0, pA1, alA, l_reg, pa0, pa1, pa2, pa3); SBAR();
    pv_tile<0>(o, vb0, pa0, pa1, pa2, pa3);
    if (even) { MASKT(pB0, pB1, NT - 1); partialSM(pB0, pB1, m_reg, mnB, alB); __syncthreads(); RESC(alB);
        finishSM(pB0, pB1, alB, l_reg, pa0, pa1, pa2, pa3); SBAR(); pv_tile<1>(o, vb0, pa0, pa1, pa2, pa3); }
    SBAR();
    if (hi == 0) li_l[r32] = l_reg; asm volatile("s_waitcnt lgkmcnt(0)" ::: "memory");
    float rli[16];
#pragma unroll
    for (int r = 0; r < 16; ++r) rli[r] = __builtin_amdgcn_rcpf(li_l[crow(r, hi)]);
    char* Ow = (char*)cur.O; const unsigned ooff = (unsigned)((wid * QBLK + 4 * hi) * OPITCH + r32) * 2u;
    const char* Gq = (const char*)cur.Q + GATE_OFF * 2; const unsigned goff = (unsigned)((wid * QBLK + 4 * hi) * PITCH + r32) * 2u;
    unsigned short gq[16][4];
#pragma unroll
    for (int r = 0; r < 16; ++r)
#pragma unroll
        for (int d0 = 0; d0 < 4; ++d0) gq[r][d0] = *(const unsigned short*)(Gq + (goff + (unsigned)(((r & 3) + 8 * (r >> 2)) * PITCH + d0 * 32) * 2u));
#pragma unroll
    for (int r = 0; r < 16; ++r) {
#pragma unroll
        for (int d0 = 0; d0 < 4; ++d0) { const unsigned short gw = gq[r][d0];
            const float gl = __builtin_bit_cast(float, (unsigned)gw << 16);
            const float v = o[d0][r] * rli[r] * __builtin_amdgcn_rcpf(1.0f + __builtin_amdgcn_exp2f(-1.4426950408889634f * gl));
            const float vn = xor1_get(v);
            if ((r32 & 1) == 0) *(unsigned*)(Ow + (ooff + (unsigned)(((r & 3) + 8 * (r >> 2)) * OPITCH + d0 * 32) * 2u)) = cvtpk(v, vn); } }
    __syncthreads();
#undef RESC
#undef KBASE
#undef MASKT
#undef SEAM_K0
#undef HALF_STEP
}
#undef ROW
#undef VMW
#undef VMWN
#undef SLOAD_H
#undef SWRITE_HK
#undef SWRITE_HV
#undef SWRITE_H
#undef KSWZ
#undef SBAR
}

constexpr int NWAVES = 8, NTHREADS = NWAVES * 64;
constexpr int DM = 2048, BATCH = 2, T = 8192, M = BATCH * T, DEPTH = 4;
constexpr int AB_IN = 8200, AB_N = 8192;
constexpr int C_IN = 6160, C_N = 6144;
constexpr int FF = 5632, FF2 = 2 * FF;
constexpr float EPS = 1e-6f;
enum PhaseKind { K_NORM1 = 0, K_MIXIN, K_PREP, K_REC, K_POST, K_MIXOUT, K_NORM2, K_FFIN, K_FFOUT, K_PRO };
constexpr int phase_base(int layer) { return 1 + 9 * layer; }
constexpr int N_PHASES = phase_base(DEPTH);
constexpr int CW_QUEUE = 8192;
inline int phase_kind(int p, int& layer) { if (p == 0) { layer = 0; return K_PRO; } for (layer = DEPTH - 1; phase_base(layer) > p; --layer) {} return p - phase_base(layer); }
constexpr size_t MiB = 1u << 20;
constexpr size_t WS_CTL = 0, CTL_ZERO_BYTES = 1 * MiB;
constexpr size_t WS_MOD = 1 * MiB;
constexpr size_t WS_LOGF = 2 * MiB;
constexpr size_t WS_BIAS = 3 * MiB;
constexpr size_t WS_GLOW = 4 * MiB;
constexpr size_t WS_W_ABIN = 8 * MiB, WS_W_ABOUT = 72 * MiB, WS_W_GLIN = 88 * MiB, WS_W_GLOUT = 136 * MiB, WS_W_FFIN = 152 * MiB, WS_W_FFOUT = 328 * MiB;
constexpr size_t WS_H = 416 * MiB, WS_CAT = 480 * MiB, WS_PROJ = 544 * MiB, WS_FFH = WS_PROJ, WS_O = 800 * MiB, WS_REC = 928 * MiB, WS_Y = 1064 * MiB, WS_XB = 1128 * MiB, WS_END = 1192 * MiB;
constexpr int CW_BAR = 4096;
constexpr int CW_CONV = 16384;
constexpr int RING_OFF = 0, RING_BYTES = 139264;
constexpr int LDSCTL_OFF = RING_BYTES, MISC_OFF = LDSCTL_OFF + 320;
constexpr int LDS_BYTES = 155648;
static_assert(fox::LDS_BYTES <= RING_BYTES, "attention LDS");

#define GAS __attribute__((address_space(1)))
#define LAS __attribute__((address_space(3)))
typedef unsigned short bf16;
typedef unsigned v4u __attribute__((ext_vector_type(4)));
typedef unsigned v2u __attribute__((ext_vector_type(2)));
typedef float f32x4 __attribute__((ext_vector_type(4)));
typedef GAS unsigned gu32;
#define RLX_AGENT __ATOMIC_RELAXED, __HIP_MEMORY_SCOPE_AGENT
#define LDS_WAIT() asm volatile("s_waitcnt lgkmcnt(0)" ::: "memory")
__device__ __forceinline__ unsigned pk2(float lo, float hi) { unsigned r; asm("v_cvt_pk_bf16_f32 %0, %1, %2" : "=v"(r) : "v"(lo), "v"(hi)); return r; }
__device__ __forceinline__ unsigned f2bf(float f) { return pk2(f, f) & 0xffffu; }
__device__ __forceinline__ float bf_lo(unsigned w) { return __builtin_bit_cast(float, w << 16); }
__device__ __forceinline__ float bf_hi(unsigned w) { return __builtin_bit_cast(float, w & 0xffff0000u); }
__device__ __forceinline__ float bf1(bf16 h) { return __builtin_bit_cast(float, (unsigned)h << 16); }
__device__ __forceinline__ float sigmoid_f(float x) { return __builtin_amdgcn_rcpf(1.0f + __expf(-x)); }
__device__ __forceinline__ float silu_x(float x) { return x * __builtin_amdgcn_rcpf(1.0f + __expf(-x)); }
__device__ __forceinline__ float log_sigmoid_f(float x) { return fminf(x, 0.f) - log1pf(__expf(-fabsf(x))); }
__device__ __forceinline__ float log_sigmoid_fast(float x) { return fminf(x, 0.f) - __logf(1.0f + __expf(-fabsf(x))); }
__device__ __forceinline__ float wave_sum(float v) {
    v = xsum<1>(v); v = xsum<2>(v); v = xsum<4>(v); v = xsum<8>(v); v = xsum<16>(v); v = xsum<32>(v);
    return v;
}

#define XB_TMO      128
#define XB_XCNT(j)  (256  + 64 * (j))
#define XB_XSUB(j)  (1280 + 64 * (j))
#define XB_XGEN(j)  (2304 + 64 * (j))
#define XB_TOP      3328
#define XB_TOPGEN   3392
#define XCD_BAR_WORDS 3456
#define XB_SPIN_CAP (1u << 18)
__device__ __forceinline__ unsigned xb_ld(unsigned* p)              { return __hip_atomic_load(p, __ATOMIC_RELAXED, __HIP_MEMORY_SCOPE_AGENT); }
__device__ __forceinline__ unsigned xb_add(unsigned* p, unsigned v) { return __hip_atomic_fetch_add(p, v, __ATOMIC_RELAXED, __HIP_MEMORY_SCOPE_AGENT); }
__device__ __forceinline__ unsigned xb_xcc_id() { return (unsigned)__builtin_amdgcn_s_getreg((3 << 11) | 20) & 0xFu; }
#define XB_SPIN(cond, bar) do { unsigned _sp = 0; while (cond) { __builtin_amdgcn_s_sleep(1); \
    if ((++_sp & 255u) == 0u) { if (xb_ld(&(bar)[XB_TMO])) break; if (_sp > XB_SPIN_CAP) { atomicAdd(&(bar)[XB_TMO], 1u); break; } } } } while (0)
struct XcdBarrier { unsigned* bar; unsigned x; volatile LAS unsigned* st; };
__device__ __forceinline__ XcdBarrier xcd_barrier_post(unsigned* bar, volatile LAS unsigned* st, bool tid0) {
    XcdBarrier b; b.bar = bar; b.x = xb_xcc_id(); b.st = st;
    if (tid0) (void)xb_add(&bar[XB_XCNT(b.x)], 1u);
    return b;
}
__device__ __forceinline__ void xcd_barrier_complete(unsigned* bar, unsigned x, unsigned& nloc, unsigned& nx) {
    const unsigned G = gridDim.x * gridDim.y * gridDim.z;
    unsigned sum, cnt, mine, sp = 0u;
    for (;;) {
        sum = 0u; cnt = 0u; mine = 0u;
#pragma unroll
        for (unsigned j = 0; j < 16; ++j) { const unsigned c = xb_ld(&bar[XB_XCNT(j)]); sum += c; cnt += (c > 0u) ? 1u : 0u; mine = (j == x) ? c : mine; }
        if (sum == G) break;
        __builtin_amdgcn_s_sleep(1);
        if ((++sp & 255u) == 0u) { if (xb_ld(&bar[XB_TMO])) break; if (sp > XB_SPIN_CAP) { atomicAdd(&bar[XB_TMO], 1u); break; } }
    }
    nloc = mine > 0u ? mine : 1u; nx = cnt > 0u ? cnt : 1u;
}
template <bool FIRST>
__device__ __forceinline__ void xcd_barrier(const XcdBarrier& b, bool tid0) {
    asm volatile("s_waitcnt vmcnt(0)" ::: "memory");
    __syncthreads();
    if (tid0) {
        unsigned* bar = b.bar;
        __builtin_amdgcn_s_waitcnt(0);
        unsigned nloc = b.st[0], nx = b.st[1];
        if (FIRST) { if (nloc == 0u) { xcd_barrier_complete(bar, b.x, nloc, nx); b.st[0] = nloc; b.st[1] = nx; } }
        else { if (nloc == 0u) nloc = 1u; if (nx == 0u) nx = 1u; }
        const unsigned old = xb_add(&bar[XB_XSUB(b.x)], 1u);
        const unsigned gen = old / nloc;
        if (old + 1u == (gen + 1u) * nloc) {
            __builtin_amdgcn_fence(__ATOMIC_RELEASE, "agent");
            asm volatile("s_waitcnt vmcnt(0)" ::: "memory");
            const unsigned og = xb_add(&bar[XB_TOP], 1u);
            const unsigned tg = og / nx;
            if (og + 1u == (tg + 1u) * nx) xb_add(&bar[XB_TOPGEN], 1u);
            else XB_SPIN(xb_ld(&bar[XB_TOPGEN]) == tg, bar);
            __builtin_amdgcn_fence(__ATOMIC_ACQUIRE, "agent");
            xb_add(&bar[XB_XGEN(b.x)], 1u);
            asm volatile("s_waitcnt vmcnt(0)" ::: "memory");
        } else {
            XB_SPIN(xb_ld(&bar[XB_XGEN(b.x)]) == gen, bar);
            __builtin_amdgcn_fence(__ATOMIC_ACQUIRE, "agent");
            asm volatile("s_waitcnt vmcnt(0)" ::: "memory");
        }
    }
    __syncthreads();
}

struct Args { const float* in[20]; float* out; unsigned char* ws; int ph_lo, ph_hi, use_bar, pad; };
typedef const Args __attribute__((address_space(4))) CArgs;
__device__ __forceinline__ CArgs* opq_args() { CArgs* p = (CArgs*)__builtin_amdgcn_kernarg_segment_ptr(); asm volatile("" : "+s"(p)); return p; }
struct Frame {
    LAS unsigned char* lds;
    int tid, lane, wave, G, bid;
};

__device__ __forceinline__ void transpose_item(const float* W, int ldn, int K, bf16* WT, int k0, int n0, int drow0, LAS float* scr, int lane) {
    f32x4 v[16];
    const float* src = W + (size_t)(k0 + (lane >> 4)) * ldn + n0 + 4 * (lane & 15);
#pragma unroll
    for (int i = 0; i < 16; ++i) v[i] = *(const f32x4*)(src + (size_t)(4 * i) * ldn);
#pragma unroll
    for (int i = 0; i < 16; ++i) { LAS float* d = scr + (4 * i + (lane >> 4)) * 65 + 4 * (lane & 15); d[0] = v[i].x; d[1] = v[i].y; d[2] = v[i].z; d[3] = v[i].w; }
    LDS_WAIT(); asm volatile("" ::: "memory");
    const int c = lane & 7, r = lane >> 3;
#pragma unroll
    for (int j = 0; j < 8; ++j) { const int n = r + 8 * j; const LAS float* s = scr + (8 * c) * 65 + n;
        v4u o; o.x = pg8::cvt_pk_bf16(s[0 * 65], s[1 * 65]); o.y = pg8::cvt_pk_bf16(s[2 * 65], s[3 * 65]); o.z = pg8::cvt_pk_bf16(s[4 * 65], s[5 * 65]); o.w = pg8::cvt_pk_bf16(s[6 * 65], s[7 * 65]);
        *(GAS v4u*)(WT + (size_t)(drow0 + n) * K + k0 + 8 * c) = o; }
    LDS_WAIT(); asm volatile("" ::: "memory");
}
template <int MODE>
__device__ __forceinline__ void transpose_matrix(const float* W, int nmat, int K, int ldn, int ncols, bf16* WT, LAS float* scr, int gw, int NGW, int lane, unsigned* ctr = nullptr, int wave = 0, bool tid0 = false, volatile LAS unsigned* slot = nullptr) {
    const int nblk = ncols / 64, kblk = K / 64, per = nblk * kblk, total = per * nmat;
#define TM_ITEM(it) do { const int mat = (it) / per, r = (it) - mat * per, kb = r / nblk, nb = r - kb * nblk, n0 = 64 * nb; int drow0 = n0; \
        if (MODE == 1) { if (n0 < FF) drow0 = (n0 / 128) * 256 + (n0 % 128); else { const int n1 = n0 - FF; drow0 = (n1 / 128) * 256 + 128 + (n1 % 128); } } \
        if (MODE == 2) drow0 = n0 < 3072 ? n0 : (n0 < 4096 ? n0 + 4096 : n0 - 1024); \
        transpose_item(W + (size_t)mat * K * ldn, ldn, K, WT + (size_t)mat * ncols * K, 64 * kb, n0, drow0, scr, lane); } while (0)
    if (ctr == nullptr) { for (int it = gw; it < total; it += NGW) TM_ITEM(it); }
    else {
        unsigned pend = 0u; if (tid0) pend = __hip_atomic_fetch_add(ctr, 16u, __ATOMIC_RELAXED, __HIP_MEMORY_SCOPE_AGENT);
        for (;;) {
            if (tid0) *slot = pend;
            __syncthreads();
            const int base = __builtin_amdgcn_readfirstlane((int)*slot);
            __syncthreads();
            if (base >= total) break;
            if (tid0) pend = __hip_atomic_fetch_add(ctr, 16u, __ATOMIC_RELAXED, __HIP_MEMORY_SCOPE_AGENT);
#pragma unroll 1
            for (int k = 0; k < 2; ++k) { const int it = base + 8 * k + wave; if (it < total) TM_ITEM(it); } } }
#undef TM_ITEM
}
template <int SET>
__device__ __forceinline__ void convert_weights(CArgs* ap, LAS float* scr, int gw, int NGW, int lane, unsigned* ctr = nullptr, int wave = 0, bool tid0 = false, volatile LAS unsigned* slot = nullptr) {
#define CWC(k) (ctr ? ctr + 64 * (k) : nullptr), wave, tid0, slot
    unsigned char* ws = ap->ws;
    bf16* abin = (bf16*)(ws + WS_W_ABIN); bf16* about = (bf16*)(ws + WS_W_ABOUT); bf16* glin = (bf16*)(ws + WS_W_GLIN); bf16* glout = (bf16*)(ws + WS_W_GLOUT); bf16* ffin = (bf16*)(ws + WS_W_FFIN); bf16* ffout = (bf16*)(ws + WS_W_FFOUT);
    constexpr size_t S_ABIN_W = (size_t)DM * AB_IN, S_ABIN_T = (size_t)AB_N * DM, S_SQ = (size_t)DM * DM, S_GLIN_W = (size_t)DM * C_IN, S_GLIN_T = (size_t)C_N * DM, S_FFIN = (size_t)DM * FF2, S_FFOUT = (size_t)FF * DM;
    if (SET == 0) {
        transpose_matrix<2>(ap->in[6], 1, DM, AB_IN, AB_N, abin, scr, gw, NGW, lane);
        transpose_matrix<0>(ap->in[7], 1, DM, DM, DM, about, scr, gw, NGW, lane);
        transpose_matrix<1>(ap->in[18], 1, DM, FF2, FF2, ffin, scr, gw, NGW, lane);
        transpose_matrix<0>(ap->in[19], 1, FF, DM, DM, ffout, scr, gw, NGW, lane);
        transpose_matrix<0>(ap->in[13], 1, DM, C_IN, C_N, glin, scr, gw, NGW, lane);
    } else if (SET == 1) {
        transpose_matrix<0>(ap->in[17], 1, DM, DM, DM, glout, scr, gw, NGW, lane, CWC(0));
        transpose_matrix<1>(ap->in[18] + S_FFIN, 2, DM, FF2, FF2, ffin + S_FFIN, scr, gw, NGW, lane, CWC(1));
        transpose_matrix<0>(ap->in[19] + S_FFOUT, 2, FF, DM, DM, ffout + S_FFOUT, scr, gw, NGW, lane, CWC(2));
        transpose_matrix<2>(ap->in[6] + S_ABIN_W, 1, DM, AB_IN, AB_N, abin + S_ABIN_T, scr, gw, NGW, lane, CWC(3));
        transpose_matrix<0>(ap->in[7] + S_SQ, 1, DM, DM, DM, about + S_SQ, scr, gw, NGW, lane, CWC(4));
        transpose_matrix<0>(ap->in[13] + S_GLIN_W, 1, DM, C_IN, C_N, glin + S_GLIN_T, scr, gw, NGW, lane, CWC(5));
    } else {
        transpose_matrix<0>(ap->in[17] + S_SQ, 1, DM, DM, DM, glout + S_SQ, scr, gw, NGW, lane, CWC(8));
        transpose_matrix<1>(ap->in[18] + 3 * S_FFIN, 1, DM, FF2, FF2, ffin + 3 * S_FFIN, scr, gw, NGW, lane, CWC(9));
        transpose_matrix<0>(ap->in[19] + 3 * S_FFOUT, 1, FF, DM, DM, ffout + 3 * S_FFOUT, scr, gw, NGW, lane, CWC(10));
    }
#undef CWC
}
__device__ __forceinline__ void p0_prologue(Frame& F, CArgs* ap) {
    unsigned char* ws = ap->ws;
    {
        LAS float* sc = (LAS float*)(F.lds);
        LAS float* part = (LAS float*)(F.lds + 16384);
        const float* c = ap->in[1];
        for (int i = F.tid; i < 2 * DM; i += NTHREADS) sc[i] = silu_x(c[i]);
        __syncthreads();
        const float* mw = ap->in[2]; const float* mb = ap->in[3]; float* mod = (float*)(ws + WS_MOD);
        constexpr int NU = DEPTH * (6 * DM / 64);
        for (int u = F.bid; u < NU; u += F.G) {
            const int layer = u / (6 * DM / 64), colb = (u % (6 * DM / 64)) * 64, kk = F.lane >> 4, c4 = F.lane & 15;
            const float* wp = mw + ((size_t)layer * DM + F.wave * 256 + kk) * (6 * DM) + colb + 4 * c4;
            f32x4 a0 = {0.f, 0.f, 0.f, 0.f}, a1 = {0.f, 0.f, 0.f, 0.f};
            for (int i0 = 0; i0 < 64; i0 += 16) { f32x4 wv[16];
#pragma unroll
                for (int i = 0; i < 16; ++i) wv[i] = *(const f32x4*)(wp + (size_t)(4 * (i0 + i)) * (6 * DM));
#pragma unroll
                for (int i = 0; i < 16; ++i) { const int k = F.wave * 256 + 4 * (i0 + i) + kk; a0 = a0 + wv[i] * sc[k]; a1 = a1 + wv[i] * sc[DM + k]; } }
            a0.x = xsum<16>(a0.x); a0.x = xsum<32>(a0.x); a0.y = xsum<16>(a0.y); a0.y = xsum<32>(a0.y); a0.z = xsum<16>(a0.z); a0.z = xsum<32>(a0.z); a0.w = xsum<16>(a0.w); a0.w = xsum<32>(a0.w);
            a1.x = xsum<16>(a1.x); a1.x = xsum<32>(a1.x); a1.y = xsum<16>(a1.y); a1.y = xsum<32>(a1.y); a1.z = xsum<16>(a1.z); a1.z = xsum<32>(a1.z); a1.w = xsum<16>(a1.w); a1.w = xsum<32>(a1.w);
            if (F.lane < 16) { *(LAS f32x4*)(part + (F.wave * 2 + 0) * 64 + 4 * c4) = a0; *(LAS f32x4*)(part + (F.wave * 2 + 1) * 64 + 4 * c4) = a1; }
            __syncthreads();
            if (F.tid < 128) { const int b = F.tid >> 6, l = F.tid & 63; float s = 0.f;
#pragma unroll
                for (int w = 0; w < 8; ++w) s += part[(w * 2 + b) * 64 + l];
                const int cc = (u % (6 * DM / 64)) * 64 + l;
                mod[((size_t)layer * 2 + b) * (6 * DM) + cc] = s + mb[(size_t)layer * (6 * DM) + cc]; }
            __syncthreads();
        }
    }
    __syncthreads();
    LAS float* scr = (LAS float*)(F.lds + RING_OFF + F.wave * 16640);
    const int gw = F.bid * NWAVES + F.wave, NGW = F.G * NWAVES;
    convert_weights<0>(ap, scr, gw, NGW, F.lane);
}

template <int MASK> __device__ __forceinline__ float xget(float v) { return __builtin_bit_cast(float, __builtin_amdgcn_ds_swizzle(__builtin_bit_cast(int, v), (MASK << 10) | 0x1f)); }
template <int N> __device__ __forceinline__ float rs_reduce(float (&a)[N], int lane) {
    if (N == 16) {
#pragma unroll
        for (int i = 0; i < 8; ++i) { const bool up = lane & 1; const float keep = up ? a[i + 8] : a[i], send = up ? a[i] : a[i + 8]; a[i] = keep + xget<1>(send); } }
    if (N >= 8) {
#pragma unroll
        for (int i = 0; i < 4; ++i) { const bool up = lane & (N == 16 ? 2 : 1); const float keep = up ? a[i + 4] : a[i], send = up ? a[i] : a[i + 4]; a[i] = keep + (N == 16 ? xget<2>(send) : xget<1>(send)); } }
#pragma unroll
    for (int i = 0; i < 2; ++i) { const bool up = lane & (N == 16 ? 4 : 2); const float keep = up ? a[i + 2] : a[i], send = up ? a[i] : a[i + 2]; a[i] = keep + (N == 16 ? xget<4>(send) : xget<2>(send)); }
    { const bool up = lane & (N == 16 ? 8 : 4); const float keep = up ? a[1] : a[0], send = up ? a[0] : a[1]; a[0] = keep + (N == 16 ? xget<8>(send) : xget<4>(send)); }
    float r = a[0];
    if (N == 8) r = xsum<8>(r);
    r = xsum<16>(r); r = xsum<32>(r);
    return r;
}
template <int N> __device__ __forceinline__ int rs_col(int lane) { return N == 16 ? (((lane & 1) << 3) | ((lane & 2) << 1) | ((lane & 4) >> 1) | ((lane & 8) >> 3)) : (((lane & 1) << 2) | (lane & 2) | ((lane & 4) >> 2)); }
template <int NC, int MODE, bool RES, bool XF32>
__device__ __forceinline__ void norm_phase(Frame& F, const void* xin, const float* gain, const float* mod_sh, const float* mod_sc  ,
                                           bf16* hout, const float* Wsm, int ldn, const float* fbias, float* sout, const bf16* yres = nullptr, const float* rgate = nullptr, bf16* xb = nullptr) {
    LAS float* wl = (LAS float*)(F.lds);
    if (NC > 0) {
        for (int i = F.tid; i < NC * DM; i += NTHREADS) { const int k = i / NC, c = i % NC; wl[c * DM + k] = Wsm[(size_t)k * ldn + c]; }
        __syncthreads();
    }
    f32x4 gm[8], shv[8]; int bprev = -1;
    for (int mp = F.bid * NWAVES + F.wave; mp < M / 2; mp += F.G * NWAVES) {
        const int m0 = 2 * mp, b = m0 / T;
        if (b != bprev) { bprev = b; const f32x4* gp = (const f32x4*)gain + F.lane; const f32x4* shp = (const f32x4*)(mod_sh + (size_t)b * 6 * DM) + F.lane; const f32x4* scp = (const f32x4*)(mod_sc + (size_t)b * 6 * DM) + F.lane;
#pragma unroll
            for (int j = 0; j < 8; ++j) { gm[j] = gp[64 * j] * (scp[64 * j] + 1.0f); shv[j] = shp[64 * j]; } }
        f32x4 v[2][8]; float s0 = 0.f, s1 = 0.f;
        v2u yv[2][8];
        if (RES) { const GAS v2u* yr = (const GAS v2u*)(yres + (size_t)m0 * DM) + F.lane;
#pragma unroll
            for (int j = 0; j < 8; ++j) { yv[0][j] = yr[64 * j]; yv[1][j] = yr[512 + 64 * j]; } }
        if (XF32) { const GAS f32x4* xr = (const GAS f32x4*)((const float*)xin + (size_t)m0 * DM) + F.lane;
#pragma unroll
            for (int j = 0; j < 8; ++j) { v[0][j] = xr[64 * j]; v[1][j] = xr[512 + 64 * j]; } }
        else { const GAS v2u* xr = (const GAS v2u*)((const bf16*)xin + (size_t)m0 * DM) + F.lane; v2u xv[2][8];
#pragma unroll
            for (int j = 0; j < 8; ++j) { xv[0][j] = xr[64 * j]; xv[1][j] = xr[512 + 64 * j]; }
#pragma unroll
            for (int j = 0; j < 8; ++j) { v[0][j] = (f32x4){bf_lo(xv[0][j].x), bf_hi(xv[0][j].x), bf_lo(xv[0][j].y), bf_hi(xv[0][j].y)}; v[1][j] = (f32x4){bf_lo(xv[1][j].x), bf_hi(xv[1][j].x), bf_lo(xv[1][j].y), bf_hi(xv[1][j].y)}; } }
        if (RES) { const f32x4* rg = (const f32x4*)(rgate + (size_t)b * 6 * DM) + F.lane; GAS v2u* xo = (GAS v2u*)(xb + (size_t)m0 * DM) + F.lane;
#pragma unroll
            for (int j = 0; j < 8; ++j) { const f32x4 g = rg[64 * j];
                v[0][j] = v[0][j] + g * (f32x4){bf_lo(yv[0][j].x), bf_hi(yv[0][j].x), bf_lo(yv[0][j].y), bf_hi(yv[0][j].y)}; v[1][j] = v[1][j] + g * (f32x4){bf_lo(yv[1][j].x), bf_hi(yv[1][j].x), bf_lo(yv[1][j].y), bf_hi(yv[1][j].y)};
                v2u w; w.x = pk2(v[0][j].x, v[0][j].y); w.y = pk2(v[0][j].z, v[0][j].w); xo[64 * j] = w;
                w.x = pk2(v[1][j].x, v[1][j].y); w.y = pk2(v[1][j].z, v[1][j].w); xo[512 + 64 * j] = w; } }
#pragma unroll
        for (int j = 0; j < 8; ++j) { s0 += (v[0][j].x * v[0][j].x + v[0][j].y * v[0][j].y) + (v[0][j].z * v[0][j].z + v[0][j].w * v[0][j].w);
                                      s1 += (v[1][j].x * v[1][j].x + v[1][j].y * v[1][j].y) + (v[1][j].z * v[1][j].z + v[1][j].w * v[1][j].w); }
        const float rstd0 = __builtin_amdgcn_rsqf(wave_sum(s0) * (1.f / DM) + EPS), rstd1 = __builtin_amdgcn_rsqf(wave_sum(s1) * (1.f / DM) + EPS);
        GAS v2u* o8 = (GAS v2u*)(hout + (size_t)m0 * DM) + F.lane;
#pragma unroll
        for (int j = 0; j < 8; ++j) { const f32x4 g = gm[j], sh = shv[j];
            v[0][j] = (v[0][j] * rstd0) * g + sh; v[1][j] = (v[1][j] * rstd1) * g + sh;
            v2u w; w.x = pk2(v[0][j].x, v[0][j].y); w.y = pk2(v[0][j].z, v[0][j].w); o8[64 * j] = w;
            w.x = pk2(v[1][j].x, v[1][j].y); w.y = pk2(v[1][j].z, v[1][j].w); o8[512 + 64 * j] = w; }
        if constexpr (NC > 0) {
            float a0[NC], a1[NC];
#pragma unroll
            for (int c = 0; c < NC; ++c) { float acc0 = 0.f, acc1 = 0.f;
#pragma unroll
                for (int j = 0; j < 8; ++j) { const f32x4 w = *(const LAS f32x4*)(wl + c * DM + 256 * j + 4 * F.lane);
                    acc0 += (v[0][j].x * w.x + v[0][j].y * w.y) + (v[0][j].z * w.z + v[0][j].w * w.w); acc1 += (v[1][j].x * w.x + v[1][j].y * w.y) + (v[1][j].z * w.z + v[1][j].w * w.w); }
                a0[c] = acc0; a1[c] = acc1; __builtin_amdgcn_sched_barrier(0); }
            const float r0 = rs_reduce<NC>(a0, F.lane), r1 = rs_reduce<NC>(a1, F.lane); const int cc = rs_col<NC>(F.lane);
            if (MODE == 1) { const int t = m0 % T; if (F.lane < NC) { const float fb = fbias[cc]; sout[((size_t)b * 8 + cc) * T + t] = log_sigmoid_f(r0 + fb); sout[((size_t)b * 8 + cc) * T + t + 1] = log_sigmoid_f(r1 + fb); } }
            if (MODE == 2) { if (F.lane < NC) { sout[(size_t)m0 * 16 + cc] = r0; sout[(size_t)m0 * 16 + 16 + cc] = r1; } }
        }
    }
}

__device__ __forceinline__ void resid_final(Frame& F, const bf16* xb, const bf16* yres, const float* rgate, float* xout) {
    for (int mp = F.bid * NWAVES + F.wave; mp < M / 2; mp += F.G * NWAVES) {
        const int m0 = 2 * mp, b = m0 / T;
        const GAS v2u* xr = (const GAS v2u*)(xb + (size_t)m0 * DM) + F.lane; const GAS v2u* yr = (const GAS v2u*)(yres + (size_t)m0 * DM) + F.lane;
        const f32x4* rg = (const f32x4*)(rgate + (size_t)b * 6 * DM) + F.lane; GAS f32x4* xo = (GAS f32x4*)(xout + (size_t)m0 * DM) + F.lane;
        v2u xv[2][8], yv[2][8];
#pragma unroll
        for (int j = 0; j < 8; ++j) { xv[0][j] = xr[64 * j]; xv[1][j] = xr[512 + 64 * j]; yv[0][j] = yr[64 * j]; yv[1][j] = yr[512 + 64 * j]; }
#pragma unroll
        for (int j = 0; j < 8; ++j) { const f32x4 g = rg[64 * j];
            xo[64 * j] = (f32x4){bf_lo(xv[0][j].x), bf_hi(xv[0][j].x), bf_lo(xv[0][j].y), bf_hi(xv[0][j].y)} + g * (f32x4){bf_lo(yv[0][j].x), bf_hi(yv[0][j].x), bf_lo(yv[0][j].y), bf_hi(yv[0][j].y)};
            xo[512 + 64 * j] = (f32x4){bf_lo(xv[1][j].x), bf_hi(xv[1][j].x), bf_lo(xv[1][j].y), bf_hi(xv[1][j].y)} + g * (f32x4){bf_lo(yv[1][j].x), bf_hi(yv[1][j].x), bf_lo(yv[1][j].y), bf_hi(yv[1][j].y)}; }
    }
}

__device__ __forceinline__ void fox_prep(Frame& F, bf16* proj, const float* qg, const float* kg, const float* logf, float* bias) {
    const int gw = F.bid * NWAVES + F.wave, NGW = F.G * NWAVES;
    const f32x4 gq0 = *(const f32x4*)(qg + (F.lane & 15) * 8), gq1 = *(const f32x4*)(qg + (F.lane & 15) * 8 + 4), gk0 = *(const f32x4*)(kg + (F.lane & 15) * 8), gk1 = *(const f32x4*)(kg + (F.lane & 15) * 8 + 4);
    for (int m = gw; m < M; m += NGW) {
        GAS v4u* p = (GAS v4u*)(proj + (size_t)m * AB_N + 3072) + F.lane;
        v4u wv[4];
#pragma unroll
        for (int j = 0; j < 4; ++j) wv[j] = p[64 * j];
#pragma unroll
        for (int j = 0; j < 4; ++j) {
            const v4u w = wv[j];
            float e[8] = {bf_lo(w.x), bf_hi(w.x), bf_lo(w.y), bf_hi(w.y), bf_lo(w.z), bf_hi(w.z), bf_lo(w.w), bf_hi(w.w)};
            float s = 0.f;
#pragma unroll
            for (int i = 0; i < 8; ++i) s += e[i] * e[i];
            s = xsum<1>(s); s = xsum<2>(s); s = xsum<4>(s); s = xsum<8>(s);
            const float rstd = __builtin_amdgcn_rsqf(s * (1.f / 128.f) + EPS);
            const f32x4 g0 = j < 2 ? gq0 : gk0, g1 = j < 2 ? gq1 : gk1;
#pragma unroll
            for (int i = 0; i < 4; ++i) { e[i] = e[i] * rstd * g0[i]; e[4 + i] = e[4 + i] * rstd * g1[i]; }
            v4u o; o.x = pk2(e[0], e[1]); o.y = pk2(e[2], e[3]); o.z = pk2(e[4], e[5]); o.w = pk2(e[6], e[7]);
            p[64 * j] = o;
        }
    }
    if (F.bid < 16) {
        LAS double* tsum = (LAS double*)(F.lds);
        const float* lf = logf + (size_t)F.bid * T; float* bo = bias + (size_t)F.bid * T;
        double v[16]; double run = 0.0;
        const int i0 = F.tid * 16;
#pragma unroll
        for (int i = 0; i < 16; ++i) { run += (double)lf[i0 + i]; v[i] = run; }
        tsum[F.tid] = run;
        __syncthreads();
        LAS double* bsum = tsum + NTHREADS;
        if (F.tid < 8) { double s = 0.0; for (int w = 0; w < 64; ++w) s += tsum[F.tid * 64 + w]; bsum[F.tid] = s; }
        __syncthreads();
        double base = 0.0;
        for (int w = 0; w < F.wave; ++w) base += bsum[w];
        for (int w = 0; w < F.lane; ++w) base += tsum[F.wave * 64 + w];
        const double k = -11.313708498984761;
#pragma unroll
        for (int i = 0; i < 16; ++i) bo[i0 + i] = (float)((base + v[i]) * k);
        __syncthreads();
    }
}

#ifndef DBG_REC
#define DBG_REC 0
#endif
#if DBG_REC
template <bool GLA>
__device__ __forceinline__ void rec_naive(Frame& F, const bf16* proj, float* O, const float* lbl  , int lb_on,
                                          const float* glow, const float* wup  , const float* bgate  ) {
    constexpr int DK = GLA ? 256 : 128, DVH = GLA ? 512 : 128, NH = GLA ? 4 : 8, DVS = 32, NSL = DVH / DVS, TB = GLA ? 16 : 32;
    constexpr int PITCH = GLA ? C_N : AB_N, OPITCH = GLA ? 2048 : 1024;
    constexpr int R = DK / 16;
    constexpr int NPAIR = TB * DK / 2 / NTHREADS;
    constexpr int NUNITS = BATCH * NH * NSL;
    LAS float* sq = (LAS float*)(F.lds); LAS float* sf = sq + TB * DK; LAS float* sk = sf + TB * DK; LAS float* sv = sk + TB * DK; LAS float* part = sv + TB * DVS; LAS float* sgl = part + TB * 4 * DVS;
    const int lane = F.lane, e_l = lane & 15, dsub = lane >> 4, eg = F.wave & 1, dg = F.wave >> 1, e = eg * 16 + e_l, d0 = (dg * 4 + dsub) * R;
    for (int unit = F.bid; unit < NUNITS; unit += F.G) {
        const int sl = unit % NSL, h = (unit / NSL) % NH, b = unit / (NSL * NH);
        const bf16* pq = proj + (size_t)b * T * PITCH + h * DK;
        const bf16* pk = pq + 1024;
        const bf16* pv = proj + (size_t)b * T * PITCH + 2048 + h * DVH + sl * DVS;
        const int dp = 2 * (F.tid % (DK / 2)), tt0 = F.tid / (DK / 2); constexpr int TSTEP = NTHREADS / (DK / 2);
        float lb0 = 0.f, lb1 = 0.f; float wu0[16], wu1[16]; float bg0 = 0.f, bg1 = 0.f;
        if (!GLA) { if (lb_on) { const float l0a = lbl[h * DK + dp], l1a = lbl[1024 + h * DK + dp], l0b = lbl[h * DK + dp + 1], l1b = lbl[1024 + h * DK + dp + 1];
                                 lb0 = fminf(fmaxf(sigmoid_f(l1a - l0a), 0.f), 1.0f - 1e-6f); lb1 = fminf(fmaxf(sigmoid_f(l1b - l0b), 0.f), 1.0f - 1e-6f); } }
        else {
#pragma unroll
            for (int r = 0; r < 16; ++r) { wu0[r] = wup[r * 1024 + h * DK + dp]; wu1[r] = wup[r * 1024 + h * DK + dp + 1]; }
            bg0 = bgate[h * DK + dp]; bg1 = bgate[h * DK + dp + 1]; }
        const int vt = F.tid / 16, ve = 2 * (F.tid % 16); const bool vact = vt < TB;
        float S[R];
#pragma unroll
        for (int j = 0; j < R; ++j) S[j] = 0.f;
        unsigned rq[NPAIR], rk[NPAIR], rv = 0u; float rgl = 0.f;
#define REC_PREFETCH(t0) do { _Pragma("unroll") for (int i = 0; i < NPAIR; ++i) { const size_t row = (size_t)((t0) + tt0 + TSTEP * i); \
            rq[i] = *(const unsigned*)(pq + row * PITCH + dp); rk[i] = *(const unsigned*)(pk + row * PITCH + dp); \
            } \
            if (GLA && F.tid < TB * 16) rgl = glow[((size_t)b * T + (t0)) * 16 + F.tid]; \
            if (vact) rv = *(const unsigned*)(pv + (size_t)((t0) + vt) * PITCH + ve); } while (0)
        REC_PREFETCH(0);
        for (int t0 = 0; t0 < T; t0 += TB) {
            if (GLA) { if (F.tid < TB * 16) sgl[F.tid] = rgl; __syncthreads(); }
#pragma unroll
            for (int i = 0; i < NPAIR; ++i) { const int tt = tt0 + TSTEP * i; const float qa = bf_lo(rq[i]), qb = bf_hi(rq[i]), ka = bf_lo(rk[i]), kb = bf_hi(rk[i]);
                float q0, q1, f0, f1, k0, k1;
                if (!GLA) { q0 = silu_x(qa); q1 = silu_x(qb); const float s0 = sigmoid_f(ka), s1 = sigmoid_f(kb), n0 = sigmoid_f(-ka), n1 = sigmoid_f(-kb);
                    f0 = fmaxf(lb0 + (1.f - lb0) * s0, 1e-30f); f1 = fmaxf(lb1 + (1.f - lb1) * s1, 1e-30f); k0 = (1.f - lb0) * n0; k1 = (1.f - lb1) * n1; }
                else { q0 = qa * 0.0625f; q1 = qb * 0.0625f; k0 = ka; k1 = kb; float x0 = bg0, x1 = bg1;
#pragma unroll
                    for (int r = 0; r < 16; ++r) { const float g = sgl[tt * 16 + r]; x0 += g * wu0[r]; x1 += g * wu1[r]; }
                    f0 = __expf(log_sigmoid_f(x0) * 0.0625f); f1 = __expf(log_sigmoid_f(x1) * 0.0625f); }
                sq[tt * DK + dp] = q0; sq[tt * DK + dp + 1] = q1; sf[tt * DK + dp] = f0; sf[tt * DK + dp + 1] = f1; sk[tt * DK + dp] = k0; sk[tt * DK + dp + 1] = k1; }
            if (vact) { sv[vt * DVS + ve] = bf_lo(rv); sv[vt * DVS + ve + 1] = bf_hi(rv); }
            __syncthreads();
            if (t0 + TB < T) REC_PREFETCH(t0 + TB);
            for (int tt = 0; tt < TB; ++tt) {
                const float v = sv[tt * DVS + e]; float acc = 0.f;
#pragma unroll
                for (int g4 = 0; g4 < R / 4; ++g4) { const f32x4 f4 = *(const LAS f32x4*)(sf + tt * DK + d0 + 4 * g4), k4 = *(const LAS f32x4*)(sk + tt * DK + d0 + 4 * g4), q4 = *(const LAS f32x4*)(sq + tt * DK + d0 + 4 * g4);
#pragma unroll
                    for (int i = 0; i < 4; ++i) { S[4 * g4 + i] = f4[i] * S[4 * g4 + i] + k4[i] * v; acc += q4[i] * S[4 * g4 + i]; } }
                acc = xsum<16>(acc); acc = xsum<32>(acc);
                if (dsub == 0) part[(tt * 4 + dg) * DVS + e] = acc;
            }
            __syncthreads();
            for (int i = F.tid; i < TB * DVS; i += NTHREADS) { const int tt = i / DVS, ee = i % DVS;
                const float o = (part[(tt * 4 + 0) * DVS + ee] + part[(tt * 4 + 1) * DVS + ee]) + (part[(tt * 4 + 2) * DVS + ee] + part[(tt * 4 + 3) * DVS + ee]);
                O[((size_t)b * T + t0 + tt) * OPITCH + h * DVH + sl * DVS + ee] = o; }
        }
#undef REC_PREFETCH
        __syncthreads();
    }
}

#endif
#ifndef DBG_ZERO
#define DBG_ZERO 0
#endif
__device__ __forceinline__ void post_even(Frame& F, const bf16* O, const bf16* proj, const float* gain  , bf16* cat) {
    const int gw = F.bid * NWAVES + F.wave, NGW = F.G * NWAVES;
    f32x4 gn[4];
#pragma unroll
    for (int j = 0; j < 4; ++j) gn[j] = *((const f32x4*)gain + 64 * j + F.lane);
    for (int mp = gw; mp < M / 2; mp += NGW) {
        const int m = 2 * mp;
        const GAS v2u* op = (const GAS v2u*)(O + (size_t)m * 1024) + F.lane;
        const GAS v2u* ga = (const GAS v2u*)(proj + (size_t)m * AB_N + 7168) + F.lane;
        GAS v2u* cp = (GAS v2u*)(cat + (size_t)m * DM) + F.lane;
        v2u vr[2][4], gr[2][4];
#pragma unroll
        for (int r = 0; r < 2; ++r)
#pragma unroll
            for (int j = 0; j < 4; ++j) { vr[r][j] = op[r * 256 + 64 * j]; gr[r][j] = ga[r * (AB_N / 4) + 64 * j]; }
#pragma unroll
        for (int r = 0; r < 2; ++r)
#pragma unroll
        for (int j = 0; j < 4; ++j) {
            const f32x4 v = {bf_lo(vr[r][j].x), bf_hi(vr[r][j].x), bf_lo(vr[r][j].y), bf_hi(vr[r][j].y)}; float s = (v.x * v.x + v.y * v.y) + (v.z * v.z + v.w * v.w);
            s = xsum<1>(s); s = xsum<2>(s); s = xsum<4>(s); s = xsum<8>(s); s = xsum<16>(s);
            const float rstd = __builtin_amdgcn_rsqf(s * (1.f / 128.f) + EPS);
            const f32x4 g = gn[j];
            const v2u gw2 = gr[r][j];
            const float o0 = v.x * rstd * g.x * silu_x(bf_lo(gw2.x)), o1 = v.y * rstd * g.y * silu_x(bf_hi(gw2.x)), o2 = v.z * rstd * g.z * silu_x(bf_lo(gw2.y)), o3 = v.w * rstd * g.w * silu_x(bf_hi(gw2.y));
            v2u w; w.x = pk2(o0, o1); w.y = pk2(o2, o3); cp[r * 512 + 64 * j] = w;
        }
    }
}
__device__ __forceinline__ void post_odd(Frame& F, const bf16* O, const bf16* proj, const float* gain  , bf16* cat) {
    const int gw = F.bid * NWAVES + F.wave, NGW = F.G * NWAVES;
    const f32x4 gn0 = *((const f32x4*)gain + F.lane), gn1 = *((const f32x4*)gain + 64 + F.lane);
    for (int mp = gw; mp < M / 2; mp += NGW) {
        const int m = 2 * mp;
        const GAS v2u* op = (const GAS v2u*)(O + (size_t)m * DM) + F.lane;
        const GAS v2u* gg = (const GAS v2u*)(proj + (size_t)m * C_N + 4096) + F.lane;
        GAS v2u* cp = (GAS v2u*)(cat + (size_t)m * DM) + F.lane;
        v2u vr[2][8], gr[2][8];
#pragma unroll
        for (int r = 0; r < 2; ++r)
#pragma unroll
            for (int j = 0; j < 8; ++j) { vr[r][j] = op[r * 512 + 64 * j]; gr[r][j] = gg[r * (C_N / 4) + 64 * j]; }
#pragma unroll
        for (int r = 0; r < 2; ++r)
#pragma unroll
        for (int hh = 0; hh < 4; ++hh) {
            const v2u r0 = vr[r][2 * hh], r1 = vr[r][2 * hh + 1]; const f32x4 v0 = {bf_lo(r0.x), bf_hi(r0.x), bf_lo(r0.y), bf_hi(r0.y)}, v1 = {bf_lo(r1.x), bf_hi(r1.x), bf_lo(r1.y), bf_hi(r1.y)};
            float s = ((v0.x * v0.x + v0.y * v0.y) + (v0.z * v0.z + v0.w * v0.w)) + ((v1.x * v1.x + v1.y * v1.y) + (v1.z * v1.z + v1.w * v1.w));
            s = wave_sum(s);
            const float rstd = __builtin_amdgcn_rsqf(s * (1.f / 512.f) + EPS);
#pragma unroll
            for (int jj = 0; jj < 2; ++jj) { const f32x4 v = jj ? v1 : v0; const f32x4 g = jj ? gn1 : gn0; const v2u gw2 = gr[r][2 * hh + jj];
                const float o0 = v.x * rstd * g.x * silu_x(bf_lo(gw2.x)), o1 = v.y * rstd * g.y * silu_x(bf_hi(gw2.x)), o2 = v.z * rstd * g.z * silu_x(bf_lo(gw2.y)), o3 = v.w * rstd * g.w * silu_x(bf_hi(gw2.y));
                v2u w; w.x = pk2(o0, o1); w.y = pk2(o2, o3); cp[r * 512 + 64 * (2 * hh + jj)] = w; }
        }
    }
}

__device__ __forceinline__ fox::BlockRef fox_ref(int item, const bf16* proj, bf16* cat, const float* bias, float thp) {
    const int bh = item & 15, qb = 31 - (item >> 4), b = bh >> 3, h = bh & 7;
    fox::BlockRef r;
    const bf16* base = proj + (size_t)b * T * AB_N + h * 128;
    r.Q = (const fox::bf16*)(base + (size_t)qb * 256 * AB_N + 3072); r.K = (const fox::bf16*)(base + 4096); r.V = (const fox::bf16*)(base + 5120);
    r.O = (fox::bf16*)(cat + ((size_t)b * T + (size_t)qb * 256) * DM + 1024 + h * 128);
    r.Bias = bias + (size_t)bh * T; r.P0 = qb * 256; r.THp = thp;
    return r;
}
__device__ __forceinline__ int fox_fetch(Frame& F, unsigned* ctr, volatile LAS unsigned* slot) {
    if (F.tid == 0) *slot = __hip_atomic_fetch_add(ctr, 1u, __ATOMIC_RELAXED, __HIP_MEMORY_SCOPE_AGENT);
    __syncthreads();
    const int v = __builtin_amdgcn_readfirstlane((int)*slot);
    __syncthreads();
    return v;
}
__device__ __forceinline__ void fox_phase(Frame& F, char* lds, const bf16* proj, bf16* cat, const float* bias, unsigned* ctr, const float* qg, const float* kg) {
    constexpr int TOTAL = 512;
    float gqm = 0.f, gkm = 0.f;
    for (int i = 0; i < 128; ++i) { gqm = fmaxf(gqm, fabsf(qg[i])); gkm = fmaxf(gkm, fabsf(kg[i])); }
    const float thp = 2.0f * (128.0f * 1.02f * gqm * gkm) + (128.0f + 12.0f + 6.0f) / (1.4426950408889634f * fox::SCALE);
    volatile LAS unsigned* slot = (volatile LAS unsigned*)(F.lds + MISC_OFF) + 16;
    int ci = fox_fetch(F, ctr, slot); if (ci >= TOTAL) return;
    fox::BlockRef cur = fox_ref(ci, proj, cat, bias, thp);
    fox::Seam S;
    fox::fox_prime(cur, lds, S, F.tid);
    for (;;) {
        const int ni = fox_fetch(F, ctr, slot); const bool last = ni >= TOTAL;
        const fox::BlockRef nxt = last ? cur : fox_ref(ni, proj, cat, bias, thp);
        fox::fox_block(cur, nxt, lds, S, F.tid);
        if (last) break;
        cur = nxt;
    }
}

template <bool GLA> struct RecCfg {
    static constexpr int DK = GLA ? 256 : 128, DVH = GLA ? 512 : 128, NH = GLA ? 4 : 8, CH = 32, NCH = T / CH, PITCH = GLA ? C_N : AB_N, OPITCH = GLA ? 2048 : 1024;
    static constexpr int QP = DK + 16;
    static constexpr int QT_B = ((CH * QP * 2 + 1023) / 1024) * 1024, KT_B = DK * CH * 2, P_B = CH * CH * 2, A_B = 1024, VT_B = DVH * CH * 2;
    static constexpr int OFF_QT = 0, OFF_KT = QT_B, OFF_P = OFF_KT + KT_B, OFF_A = OFF_P + P_B, OFF_VT = OFF_A + A_B, UNIT_B = OFF_VT + VT_B;
    static constexpr int NSL = DVH / 128, BUF_B = OFF_VT + 8192, NP1 = OFF_VT / 1024, NP = NP1 + 8, NR = (NP + 7) / 8;
    static_assert(A_B >= DK * 4 && OFF_VT % 1024 == 0, "rec layout");
};
typedef short rbf16x8 __attribute__((ext_vector_type(8)));
__device__ __forceinline__ rbf16x8 rpack8(f32x4 a, f32x4 b) { v4u w; w.x = pg8::cvt_pk_bf16(a.x, a.y); w.y = pg8::cvt_pk_bf16(a.z, a.w); w.z = pg8::cvt_pk_bf16(b.x, b.y); w.w = pg8::cvt_pk_bf16(b.z, b.w); return __builtin_bit_cast(rbf16x8, w); }

template <bool GLA>
__device__ __forceinline__ void rec_prep(Frame& F, const bf16* proj, unsigned char* rec, const float* lbl, int lb_on, const float* glow, const float* wup, const float* bgate) {
    using C = RecCfg<GLA>;
    constexpr int DK = C::DK, DVH = C::DVH, NH = C::NH, CH = C::CH, NCH = C::NCH, PITCH = C::PITCH, QP = C::QP;
    constexpr int NSEG = NTHREADS / DK, TPS = CH / NSEG;
    constexpr int NSEGV = NTHREADS / DVH, TPV = CH / NSEGV;
    LAS float* segtot = (LAS float*)F.lds;
    LAS bf16* qm = (LAS bf16*)(F.lds + 2048);
    LAS bf16* km = qm + CH * QP;
    LAS float* sgl = (LAS float*)(F.lds + 2048 + 2 * CH * QP * 2);
    const int d = F.tid % DK, seg = F.tid / DK, lane = F.lane, el = lane & 15, q4 = lane >> 4;
    const int x = d & 31, y = x & 15, pos = (d & ~31) + 8 * (y >> 2) + (y & 3) + 4 * (x >> 4);
    constexpr int NUNITS = BATCH * NH * NCH, NBH = BATCH * NH;
    float lb = 0.f, bg = 0.f; float wu[16]; int hprev = -1;
    unsigned short rq[TPS], rk[TPS]; unsigned rvv[TPV / 2]; float rgl = 0.f;
    unsigned short rvr[GLA ? 1 : TPV];
    const int ev = F.tid % DVH, sv = F.tid / DVH;
    const unsigned toff = (unsigned)(seg * TPS) * (unsigned)(PITCH * 2) + (unsigned)d * 2u, voff = (unsigned)(sv * TPV) * (unsigned)(PITCH * 2) + (unsigned)ev * 2u;
#define PREP_LOAD(un) do { const int c_ = (un) / NBH, bh_ = (un) % NBH; const size_t row_ = (size_t)(bh_ / NH) * T + (size_t)c_ * CH; const int h_ = bh_ % NH; \
        const char* ubq_ = (const char*)(proj + row_ * PITCH + h_ * DK); const char* ubv_ = (const char*)(proj + row_ * PITCH + 2048 + h_ * DVH); (void)ubv_; \
        if (GLA) rgl = glow[row_ * 16 + F.tid];     \
        _Pragma("unroll") for (int i = 0; i < TPS; ++i) { const char* rb_ = ubq_ + (size_t)i * (PITCH * 2);     \
            rq[i] = *(const bf16*)(rb_ + toff); rk[i] = *(const bf16*)(rb_ + 2048 + toff); } \
        if (!GLA) { _Pragma("unroll") for (int i = 0; i < TPV; ++i) rvr[i] = *(const bf16*)((ubv_ + (size_t)i * (PITCH * 2)) + voff); } \
        } while (0)
    if (F.bid < NUNITS) PREP_LOAD(F.bid);
    for (int unit = F.bid; unit < NUNITS; unit += F.G) {
        const int c = unit / NBH, bh = unit % NBH, h = bh % NH, b = bh / NH;
        const size_t row0 = (size_t)b * T + (size_t)c * CH;
        if (h != hprev) { hprev = h;
            if (!GLA) { lb = 0.f; if (lb_on) lb = fminf(fmaxf(sigmoid_f(lbl[1024 + h * DK + d] - lbl[h * DK + d]), 0.f), 1.0f - 1e-6f); }
            else {
#pragma unroll
                for (int r = 0; r < 16; ++r) wu[r] = wup[r * 1024 + h * DK + d];
                bg = bgate[h * DK + d]; } }
        if (GLA) { sgl[F.tid] = rgl; __syncthreads(); }
        float qv[TPS], kv[TPS], G[TPS]; float run = 0.f;
#pragma unroll
        for (int i = 0; i < TPS; ++i) { const int t = seg * TPS + i; const float qa = bf1(rq[i]), ka = bf1(rk[i]); float g;
            if (!GLA) { qv[i] = silu_x(qa); const float ez = __expf(-fabsf(ka)), rz = __builtin_amdgcn_rcpf(1.0f + ez), big = rz, small = ez * rz;
                const float sg = ka >= 0.f ? big : small, ng = ka >= 0.f ? small : big; const float f = fmaxf(lb + (1.f - lb) * sg, 1e-30f); g = __logf(f); kv[i] = (1.f - lb) * ng; }
            else { qv[i] = qa * 0.0625f; kv[i] = ka; float xx = bg;
#pragma unroll
                for (int r = 0; r < 16; ++r) xx += sgl[t * 16 + r] * wu[r];
                g = log_sigmoid_fast(xx) * 0.0625f; }
            run += g; G[i] = run; }
        segtot[seg * DK + d] = run;
        __syncthreads();
        float off = 0.f, tot = 0.f, rmid = 0.f;
#pragma unroll
        for (int s = 0; s < NSEG; ++s) { const float v = segtot[s * DK + d]; tot += v; if (s < seg) off += v; if (s < 16 / TPS) rmid += v; }
        unsigned char* ub = rec + (size_t)(bh * NCH + c) * C::UNIT_B;
        bf16* QT = (bf16*)(ub + C::OFF_QT); bf16* KT = (bf16*)(ub + C::OFF_KT); bf16* Pb = (bf16*)(ub + C::OFF_P); float* Ab = (float*)(ub + C::OFF_A); bf16* VT = (bf16*)(ub + C::OFF_VT);
        unsigned kt[TPS / 2];
#pragma unroll
        for (int i = 0; i < TPS; i += 2) { float kh[2];
#pragma unroll
            for (int u = 0; u < 2; ++u) { const int t = seg * TPS + i + u; const float Gt = G[i + u] + off;
                QT[t * QP + pos] = (bf16)f2bf(qv[i + u] * __expf(Gt)); kh[u] = kv[i + u] * __expf(tot - Gt);
                qm[t * QP + d] = (bf16)f2bf(qv[i + u] * __expf(fminf(Gt - rmid, 80.f))); km[t * QP + d] = (bf16)f2bf(kv[i + u] * __expf(fminf(rmid - Gt, 80.f))); }
            kt[i / 2] = pk2(kh[0], kh[1]); }
#pragma unroll
        for (int j = 0; j < TPS / 8; ++j) { v4u w; w.x = kt[4 * j]; w.y = kt[4 * j + 1]; w.z = kt[4 * j + 2]; w.w = kt[4 * j + 3]; *(v4u*)(KT + d * CH + ((seg * TPS + 8 * j) ^ ((d & 8) << 1))) = w; }
        if (seg == NSEG - 1) Ab[d] = __expf(tot);
        { bf16* vt_ = VT + ev * CH;
          if (GLA) { const char* ubv_ = (const char*)(proj + row0 * PITCH + 2048 + h * DVH);
#pragma unroll
              for (int i = 0; i < TPV; i += 2) rvv[i / 2] = (unsigned)*(const bf16*)(ubv_ + (voff + (unsigned)i * (unsigned)(PITCH * 2))) | ((unsigned)*(const bf16*)(ubv_ + (voff + (unsigned)(i + 1) * (unsigned)(PITCH * 2))) << 16); }
          else {
#pragma unroll
              for (int i = 0; i < TPV; i += 2) rvv[i / 2] = (unsigned)rvr[i] | ((unsigned)rvr[i + 1] << 16); }
#pragma unroll
          for (int j = 0; j < TPV / 8; ++j) { v4u w; w.x = rvv[4 * j]; w.y = rvv[4 * j + 1]; w.z = rvv[4 * j + 2]; w.w = rvv[4 * j + 3];
              *(v4u*)(vt_ + ((sv * TPV + 8 * j) ^ ((ev & 8) << 1))) = w; } }
        if (unit + F.G < NUNITS) PREP_LOAD(unit + F.G);
        __syncthreads();
        if (F.wave < 3) { const int tt = F.wave >= 1, st = F.wave == 2; f32x4 acc = {0.f, 0.f, 0.f, 0.f};
#pragma unroll
            for (int i = 0; i < DK / 32; ++i) { const rbf16x8 a = *(const LAS rbf16x8*)(km + (16 * st + el) * QP + 32 * i + 8 * q4), bq = *(const LAS rbf16x8*)(qm + (16 * tt + el) * QP + 32 * i + 8 * q4);
                acc = __builtin_amdgcn_mfma_f32_16x16x32_bf16(a, bq, acc, 0, 0, 0); }
            const int ta = 16 * tt + el, s0 = 16 * st + 4 * q4;
            const float p0 = s0 + 0 <= ta ? acc[0] : 0.f, p1 = s0 + 1 <= ta ? acc[1] : 0.f, p2 = s0 + 2 <= ta ? acc[2] : 0.f, p3 = s0 + 3 <= ta ? acc[3] : 0.f;
            v2u w; w.x = pk2(p0, p1); w.y = pk2(p2, p3); *(v2u*)(Pb + ta * CH + (s0 ^ ((ta & 8) << 1))) = w; }
        else if (F.wave == 3) { v2u w; w.x = 0u; w.y = 0u; *(v2u*)(Pb + el * CH + ((16 + 4 * q4) ^ ((el & 8) << 1))) = w; }
        __syncthreads();
    }
#undef PREP_LOAD
}

template <bool GLA>
__device__ __forceinline__ void rec_seq(Frame& F, const unsigned char* rec, float* O, const bf16* proj, const float* gain, bf16* cat) {
    using C = RecCfg<GLA>;
    constexpr int DK = C::DK, DVH = C::DVH, NH = C::NH, CH = C::CH, NCH = C::NCH, QP = C::QP, NSL = C::NSL, NDT = DK / 16, NKS = DK / 32;
    constexpr int NBUF = 3, PF = NBUF - 1;
    constexpr int BUFG = C::BUF_B + (GLA ? 0 : 8192);
    constexpr int NWAIT = (PF - 1) * ((C::NR - 1) + (GLA ? 0 : 1) + 2);
    static_assert(NBUF * BUFG + 2048 <= RING_BYTES, "rec ring");
    constexpr int NUNITS = BATCH * NH * NSL;
    const int lane = F.lane, el = lane & 15, q4 = lane >> 4, wave = F.wave;
    for (int unit = F.bid; unit < NUNITS; unit += F.G) {
        const int sl = unit % NSL, h = (unit / NSL) % NH, b = unit / (NSL * NH);
        const unsigned char* ubase = rec + (size_t)((b * NH + h) * NCH) * C::UNIT_B;
#define REC_DMA(cc) do { const unsigned char* ub_ = ubase + (size_t)(cc) * C::UNIT_B; const int bufi_ = (cc) % NBUF; _Pragma("unroll") for (int r_ = 0; r_ < C::NR; ++r_) { const int p_ = r_ * 8 + wave; \
            if (p_ < C::NP) { const unsigned char* src_ = ub_ + (p_ < C::NP1 ? p_ * 1024 : C::OFF_VT + sl * 8192 + (p_ - C::NP1) * 1024) + lane * 16; \
                __builtin_amdgcn_global_load_lds((const unsigned*)src_, (LAS unsigned*)(F.lds + bufi_ * BUFG + p_ * 1024), 16, 0, 0); } } \
            if (!GLA) { const unsigned char* gsrc_ = (const unsigned char*)(proj + ((size_t)b * T + (size_t)(cc) * CH + 4 * wave + (lane >> 4)) * AB_N + 3072 + h * DVH) + (lane & 15) * 16; \
                __builtin_amdgcn_global_load_lds((const unsigned*)gsrc_, (LAS unsigned*)(F.lds + bufi_ * BUFG + C::BUF_B + wave * 1024), 16, 0, 0); } } while (0)
        f32x4 S[NDT];
#pragma unroll
        for (int i = 0; i < NDT; ++i) S[i] = (f32x4){0.f, 0.f, 0.f, 0.f};
#pragma unroll
        for (int cc = 0; cc < PF; ++cc) REC_DMA(cc);
        float* Ob = O + ((size_t)b * T) * C::OPITCH + h * DVH + sl * 128 + 16 * wave + 4 * q4;
        LAS float* ssq = (LAS float*)(F.lds + NBUF * BUFG);
        f32x4 oprev[2] = {{0.f, 0.f, 0.f, 0.f}, {0.f, 0.f, 0.f, 0.f}};
        v2u gsave[2] = {{0u, 0u}, {0u, 0u}};
        const unsigned ecol = (unsigned)(h * DVH + 16 * wave + 4 * q4);
        f32x4 gn4 = {1.f, 1.f, 1.f, 1.f}; if (!GLA) gn4 = *(const f32x4*)(gain + ecol);
#define REC_FINISH(cp) do { _Pragma("unroll") for (int tt = 0; tt < 2; ++tt) { const int tl = 16 * tt + el; float tot = 0.f; \
            _Pragma("unroll") for (int w_ = 0; w_ < 8; ++w_) tot += ssq[(((cp) & 1) * 8 + w_) * 32 + tl]; \
            const float rstd = 1.0f / sqrtf(tot * (1.f / 128.f) + EPS); const size_t row_ = (size_t)b * T + (size_t)(cp) * CH + tl; \
            const v2u gw_ = gsave[tt]; const f32x4 ov = oprev[tt]; \
            v2u w_o; w_o.x = pk2(ov.x * rstd * gn4.x * silu_x(bf_lo(gw_.x)), ov.y * rstd * gn4.y * silu_x(bf_hi(gw_.x))); \
            w_o.y = pk2(ov.z * rstd * gn4.z * silu_x(bf_lo(gw_.y)), ov.w * rstd * gn4.w * silu_x(bf_hi(gw_.y))); \
            *(v2u*)(cat + row_ * DM + ecol) = w_o; } } while (0)
        for (int c = 0; c < NCH; ++c) {
            if (c <= PF) asm volatile("s_waitcnt vmcnt(0)" ::: "memory"); else asm volatile("s_waitcnt vmcnt(%0)" :: "i"(NWAIT) : "memory");
            asm volatile("s_waitcnt lgkmcnt(0)" ::: "memory"); __builtin_amdgcn_s_barrier(); asm volatile("" ::: "memory");
            if (!GLA) {
                if (c > 0) REC_FINISH(c - 1);
                else { v2u z; z.x = 0u; z.y = 0u; *(v2u*)(cat + ((size_t)b * T + el) * DM + ecol) = z; *(v2u*)(cat + ((size_t)b * T + 16 + el) * DM + ecol) = z; }
            }
            if (c + PF < NCH) REC_DMA(c + PF); else REC_DMA(NCH - 1);
            const LAS unsigned char* L = F.lds + (c % NBUF) * BUFG;
            rbf16x8 sf[NKS];
#pragma unroll
            for (int i = 0; i < NKS; ++i) sf[i] = rpack8(S[2 * i], S[2 * i + 1]);
            f32x4 o[2];
#pragma unroll
            for (int tt = 0; tt < 2; ++tt) { o[tt] = (f32x4){0.f, 0.f, 0.f, 0.f};
#pragma unroll
                for (int i = 0; i < NKS; ++i) { const rbf16x8 qf = *(const LAS rbf16x8*)(L + C::OFF_QT + ((16 * tt + el) * QP + 32 * i + 8 * q4) * 2);
                    o[tt] = __builtin_amdgcn_mfma_f32_16x16x32_bf16(sf[i], qf, o[tt], 0, 0, 0); } }
            const rbf16x8 vf = *(const LAS rbf16x8*)(L + C::OFF_VT + ((16 * wave + el) * CH + 8 * q4) * 2);
#pragma unroll
            for (int tt = 0; tt < 2; ++tt) { const rbf16x8 pf = *(const LAS rbf16x8*)(L + C::OFF_P + ((16 * tt + el) * CH + 8 * q4) * 2);
                o[tt] = __builtin_amdgcn_mfma_f32_16x16x32_bf16(vf, pf, o[tt], 0, 0, 0); }
#pragma unroll
            for (int dt = 0; dt < NDT; ++dt) { const f32x4 a4 = *(const LAS f32x4*)(L + C::OFF_A + (16 * dt + 4 * q4) * 4); S[dt] = S[dt] * a4;
                const rbf16x8 kf = *(const LAS rbf16x8*)(L + C::OFF_KT + ((16 * dt + el) * CH + 8 * q4) * 2);
                S[dt] = __builtin_amdgcn_mfma_f32_16x16x32_bf16(kf, vf, S[dt], 0, 0, 0); }
            if (GLA) {
#pragma unroll
                for (int tt = 0; tt < 2; ++tt) *(f32x4*)(Ob + (size_t)(c * CH + 16 * tt + el) * C::OPITCH) = o[tt];
            } else {
#pragma unroll
                for (int tt = 0; tt < 2; ++tt) { float p = (o[tt].x * o[tt].x + o[tt].y * o[tt].y) + (o[tt].z * o[tt].z + o[tt].w * o[tt].w); p = xsum<16>(p); p = xsum<32>(p);
                    if (q4 == 0) ssq[((c & 1) * 8 + wave) * 32 + 16 * tt + el] = p; oprev[tt] = o[tt];
                    gsave[tt] = *(const LAS v2u*)(L + C::BUF_B + ((16 * tt + el) * 128 + 16 * wave + 4 * q4) * 2); }
            }
        }
        asm volatile("s_waitcnt vmcnt(0)" ::: "memory"); __syncthreads();
        if (!GLA) { REC_FINISH(NCH - 1); }
        __syncthreads();
#undef REC_FINISH
#undef REC_DMA
    }
}

template <bool GLA>
__device__ __forceinline__ void rec_seq2(Frame& F, const unsigned char* rec, bf16* O) {
    using C = RecCfg<GLA>;
    constexpr int DK = C::DK, DVH = C::DVH, NH = C::NH, CH = C::CH, NCH = C::NCH, QP = C::QP;
    constexpr int NDH = DK / 32, NKH = DK / 64;
    constexpr int ES = 64, NSL = DVH / ES, BUF2 = C::OFF_VT + ES * CH * 2, NP1 = C::OFF_VT / 1024, NP = NP1 + ES * CH * 2 / 1024, NR = NP / 8;
    constexpr int NBUF = GLA ? 3 : 5, PF = NBUF - 1, NWAIT = (PF - 1) * (NR + 1);
    static_assert(NP % 8 == 0 && NBUF * BUF2 + 2 * 8 * 1024 <= RING_BYTES, "rec_seq2 ring");
    constexpr int NUNITS = BATCH * NH * NSL;
    const int lane = F.lane, el = lane & 15, q4 = lane >> 4, wave = F.wave, eg = wave & 3, dg = wave >> 2;
    LAS unsigned char* xch = F.lds + NBUF * BUF2;
    for (int unit = F.bid; unit < NUNITS; unit += F.G) {
        const int sl = unit % NSL, h = (unit / NSL) % NH, b = unit / (NSL * NH);
        const unsigned char* ubase = rec + (size_t)((b * NH + h) * NCH) * C::UNIT_B;
#define G2_DMA(cc) do { const unsigned char* ub_ = ubase + (size_t)(cc) * C::UNIT_B; const int bufi_ = (cc) % NBUF; _Pragma("unroll") for (int r_ = 0; r_ < NR; ++r_) { const int p_ = r_ * 8 + wave; \
            const unsigned char* src_ = ub_ + (p_ < NP1 ? p_ * 1024 : C::OFF_VT + sl * (ES * CH * 2) + (p_ - NP1) * 1024) + lane * 16; \
            __builtin_amdgcn_global_load_lds((const unsigned*)src_, (LAS unsigned*)(F.lds + bufi_ * BUF2 + p_ * 1024), 16, 0, 0); } } while (0)
        f32x4 S[NDH];
#pragma unroll
        for (int i = 0; i < NDH; ++i) S[i] = (f32x4){0.f, 0.f, 0.f, 0.f};
#pragma unroll
        for (int cc = 0; cc < PF; ++cc) G2_DMA(cc);
        bf16* Ob = O + ((size_t)b * T + 16 * dg + el) * C::OPITCH + h * DVH + sl * ES + 16 * eg + 4 * q4;
#define G2_ST(p_, v_) do { const f32x4 v4_ = (v_); v2u w2_; w2_.x = pg8::cvt_pk_bf16(v4_.x, v4_.y); w2_.y = pg8::cvt_pk_bf16(v4_.z, v4_.w); *(v2u*)(p_) = w2_; } while (0)
        f32x4 okeep = {0.f, 0.f, 0.f, 0.f};
        for (int c = 0; c < NCH; ++c) {
            if (c <= PF) asm volatile("s_waitcnt vmcnt(0)" ::: "memory"); else asm volatile("s_waitcnt vmcnt(%0)" :: "i"(NWAIT) : "memory");
            asm volatile("s_waitcnt lgkmcnt(0)" ::: "memory"); __builtin_amdgcn_s_barrier(); asm volatile("" ::: "memory");
            if (c + PF < NCH) G2_DMA(c + PF); else G2_DMA(NCH - 1);
            const LAS unsigned char* L = F.lds + (c % NBUF) * BUF2;
            rbf16x8 qf[2][NKH], kf[NDH]; f32x4 a4[NDH];
#pragma unroll
            for (int tt = 0; tt < 2; ++tt)
#pragma unroll
                for (int i = 0; i < NKH; ++i) qf[tt][i] = *(const LAS rbf16x8*)(L + C::OFF_QT + ((16 * tt + el) * QP + 32 * (NKH * dg + i) + 8 * q4) * 2);
            const int sw8 = (8 * q4) ^ ((el & 8) << 1);
            const rbf16x8 vf = *(const LAS rbf16x8*)(L + C::OFF_VT + ((16 * eg + el) * CH + sw8) * 2);
            const rbf16x8 pf = *(const LAS rbf16x8*)(L + C::OFF_P + ((16 * dg + el) * CH + sw8) * 2);
#pragma unroll
            for (int j = 0; j < NDH; ++j) { kf[j] = *(const LAS rbf16x8*)(L + C::OFF_KT + ((16 * (NDH * dg + j) + el) * CH + sw8) * 2); a4[j] = *(const LAS f32x4*)(L + C::OFF_A + (16 * (NDH * dg + j) + 4 * q4) * 4); }
            rbf16x8 sf[NKH];
#pragma unroll
            for (int i = 0; i < NKH; ++i) sf[i] = rpack8(S[2 * i], S[2 * i + 1]);
            f32x4 o[2];
#pragma unroll
            for (int tt = 0; tt < 2; ++tt) { o[tt] = (f32x4){0.f, 0.f, 0.f, 0.f};
#pragma unroll
                for (int i = 0; i < NKH; ++i) o[tt] = __builtin_amdgcn_mfma_f32_16x16x32_bf16(sf[i], qf[tt][i], o[tt], 0, 0, 0); }
            if (dg == 0) o[0] = __builtin_amdgcn_mfma_f32_16x16x32_bf16(vf, pf, o[0], 0, 0, 0); else o[1] = __builtin_amdgcn_mfma_f32_16x16x32_bf16(vf, pf, o[1], 0, 0, 0);
#pragma unroll
            for (int j = 0; j < NDH; ++j) { S[j] = S[j] * a4[j]; S[j] = __builtin_amdgcn_mfma_f32_16x16x32_bf16(kf[j], vf, S[j], 0, 0, 0); }
            if (c > 0) { const f32x4 pr = *(const LAS f32x4*)(xch + ((((c - 1) & 1) * 8 + (wave ^ 4)) * 64 + lane) * 16);
                         G2_ST(Ob + (size_t)((c - 1) * CH) * C::OPITCH, okeep + pr); }
            else { G2_ST(Ob, okeep); }
            *(LAS f32x4*)(xch + (((c & 1) * 8 + wave) * 64 + lane) * 16) = dg == 0 ? o[1] : o[0];
            okeep = dg == 0 ? o[0] : o[1];
        }
        asm volatile("s_waitcnt vmcnt(0) lgkmcnt(0)" ::: "memory"); __syncthreads();
        { const f32x4 pr = *(const LAS f32x4*)(xch + ((((NCH - 1) & 1) * 8 + (wave ^ 4)) * 64 + lane) * 16); G2_ST(Ob + (size_t)((NCH - 1) * CH) * C::OPITCH, okeep + pr); }
        __syncthreads();
#undef G2_ST
#undef G2_DMA
    }
}

template <bool GLA>
__device__ __forceinline__ void rec_seq3(Frame& F, const unsigned char* rec, bf16* O) {
    using C = RecCfg<GLA>;
    constexpr int DK = C::DK, DVH = C::DVH, NH = C::NH, CH = C::CH, NCH = C::NCH, QP = C::QP;
    constexpr int NDH = DK / 32, NKH = DK / 64;
    constexpr int ES = 64, NSL = DVH / ES, BUF2 = C::OFF_VT + ES * CH * 2, NP1 = C::OFF_VT / 1024, NP = NP1 + ES * CH * 2 / 1024, NRL = NP / 4;
    constexpr int NBUF = GLA ? 3 : 5, PF = NBUF - 1, NWAIT = (PF - 1) * NRL;
    static_assert(NP % 4 == 0 && NBUF * BUF2 + 2 * 8 * 1024 <= RING_BYTES && NWAIT < 64, "rec_seq3 ring");
    constexpr int NUNITS = BATCH * NH * NSL;
    const int lane = F.lane, el = lane & 15, q4 = lane >> 4, wave = F.wave;
    LAS unsigned char* xch = F.lds + NBUF * BUF2;
    for (int unit = F.bid; unit < NUNITS; unit += F.G) {
        const int bh = unit % (BATCH * NH), sl = unit / (BATCH * NH), h = bh % NH, b = bh / NH;
        const unsigned char* ubase = rec + (size_t)((b * NH + h) * NCH) * C::UNIT_B;
        const int eg2 = wave & 1, dg = (wave >> 1) & 1;
        bf16* Ob = O + ((size_t)b * T + 16 * dg + el) * C::OPITCH + h * DVH + sl * ES + 32 * eg2 + 4 * q4;
        f32x4 okeep[2] = {{0.f, 0.f, 0.f, 0.f}, {0.f, 0.f, 0.f, 0.f}};
#define G3_ST(p_, v_) do { const f32x4 v4_ = (v_); v2u w2_; w2_.x = pg8::cvt_pk_bf16(v4_.x, v4_.y); w2_.y = pg8::cvt_pk_bf16(v4_.z, v4_.w); *(v2u*)(p_) = w2_; } while (0)
        if (wave >= 4) {
            const int lw = wave - 4;
#define G3_DMA(cc) do { const unsigned char* ub_ = ubase + (size_t)(cc) * C::UNIT_B; const int bufi_ = (cc) % NBUF; _Pragma("unroll") for (int r_ = 0; r_ < NRL; ++r_) { const int p_ = r_ * 4 + lw; \
            const unsigned char* src_ = ub_ + (p_ < NP1 ? p_ * 1024 : C::OFF_VT + sl * (ES * CH * 2) + (p_ - NP1) * 1024) + lane * 16; \
            __builtin_amdgcn_global_load_lds((const unsigned*)src_, (LAS unsigned*)(F.lds + bufi_ * BUF2 + p_ * 1024), 16, 0, 0); } } while (0)
#pragma unroll
            for (int cc = 0; cc < PF; ++cc) G3_DMA(cc);
            for (int c = 0; c < NCH; ++c) {
                asm volatile("s_waitcnt vmcnt(%0)" :: "i"(NWAIT) : "memory");
                __builtin_amdgcn_s_barrier(); asm volatile("" ::: "memory");
                if (c + PF < NCH) G3_DMA(c + PF); else G3_DMA(NCH - 1);
            }
            asm volatile("s_waitcnt vmcnt(0)" ::: "memory");
#undef G3_DMA
        } else {
            f32x4 S[NDH][2];
#pragma unroll
            for (int i = 0; i < NDH; ++i) { S[i][0] = (f32x4){0.f, 0.f, 0.f, 0.f}; S[i][1] = (f32x4){0.f, 0.f, 0.f, 0.f}; }
            const int sw8 = (8 * q4) ^ ((el & 8) << 1);
            for (int c = 0; c < NCH; ++c) {
                asm volatile("s_waitcnt lgkmcnt(0)" ::: "memory"); __builtin_amdgcn_s_barrier(); asm volatile("" ::: "memory");
                const LAS unsigned char* L = F.lds + (c % NBUF) * BUF2;
                rbf16x8 qf[2][NKH], kf[NDH], vf[2]; f32x4 a4[NDH];
#pragma unroll
                for (int tt = 0; tt < 2; ++tt)
#pragma unroll
                    for (int i = 0; i < NKH; ++i) qf[tt][i] = *(const LAS rbf16x8*)(L + C::OFF_QT + ((16 * tt + el) * QP + 32 * (NKH * dg + i) + 8 * q4) * 2);
#pragma unroll
                for (int et = 0; et < 2; ++et) vf[et] = *(const LAS rbf16x8*)(L + C::OFF_VT + ((32 * eg2 + 16 * et + el) * CH + sw8) * 2);
                const rbf16x8 pf = *(const LAS rbf16x8*)(L + C::OFF_P + ((16 * dg + el) * CH + sw8) * 2);
#pragma unroll
                for (int j = 0; j < NDH; ++j) { kf[j] = *(const LAS rbf16x8*)(L + C::OFF_KT + ((16 * (NDH * dg + j) + el) * CH + sw8) * 2); a4[j] = *(const LAS f32x4*)(L + C::OFF_A + (16 * (NDH * dg + j) + 4 * q4) * 4); }
                f32x4 o[2][2];
#pragma unroll
                for (int et = 0; et < 2; ++et) { rbf16x8 sf[NKH];
#pragma unroll
                    for (int i = 0; i < NKH; ++i) sf[i] = rpack8(S[2 * i][et], S[2 * i + 1][et]);
#pragma unroll
                    for (int tt = 0; tt < 2; ++tt) { o[tt][et] = (f32x4){0.f, 0.f, 0.f, 0.f};
#pragma unroll
                        for (int i = 0; i < NKH; ++i) o[tt][et] = __builtin_amdgcn_mfma_f32_16x16x32_bf16(sf[i], qf[tt][i], o[tt][et], 0, 0, 0); } }
#pragma unroll
                for (int et = 0; et < 2; ++et) { if (dg == 0) o[0][et] = __builtin_amdgcn_mfma_f32_16x16x32_bf16(vf[et], pf, o[0][et], 0, 0, 0); else o[1][et] = __builtin_amdgcn_mfma_f32_16x16x32_bf16(vf[et], pf, o[1][et], 0, 0, 0); }
#pragma unroll
                for (int j = 0; j < NDH; ++j)
#pragma unroll
                    for (int et = 0; et < 2; ++et) { S[j][et] = S[j][et] * a4[j]; S[j][et] = __builtin_amdgcn_mfma_f32_16x16x32_bf16(kf[j], vf[et], S[j][et], 0, 0, 0); }
                if (c > 0) {
#pragma unroll
                    for (int et = 0; et < 2; ++et) { const f32x4 pr = *(const LAS f32x4*)(xch + (((((c - 1) & 1) * 4 + (wave ^ 2)) * 2 + et) * 64 + lane) * 16);
                        G3_ST(Ob + (size_t)((c - 1) * CH) * C::OPITCH + 16 * et, okeep[et] + pr); } }
#pragma unroll
                for (int et = 0; et < 2; ++et) { *(LAS f32x4*)(xch + ((((c & 1) * 4 + wave) * 2 + et) * 64 + lane) * 16) = dg == 0 ? o[1][et] : o[0][et]; okeep[et] = dg == 0 ? o[0][et] : o[1][et]; }
            }
        }
        asm volatile("s_waitcnt vmcnt(0) lgkmcnt(0)" ::: "memory"); __syncthreads();
        if (wave < 4) {
#pragma unroll
            for (int et = 0; et < 2; ++et) { const f32x4 pr = *(const LAS f32x4*)(xch + (((((NCH - 1) & 1) * 4 + (wave ^ 2)) * 2 + et) * 64 + lane) * 16);
                G3_ST(Ob + (size_t)((NCH - 1) * CH) * C::OPITCH + 16 * et, okeep[et] + pr); } }
        __syncthreads();
#undef G3_ST
    }
}
#define WSP(T_, off) ((T_*)(ws + (off)))
#define REFRAME() CArgs* ap = opq_args(); unsigned char* ws = ap->ws; (void)ws; \
    F.lds = (LAS unsigned char*)lds; F.tid = opq_tid(wave_s); F.lane = F.tid & 63; F.wave = __builtin_amdgcn_readfirstlane(F.tid >> 6); F.G = gridDim.x; F.bid = opq_bid()
#ifndef DBG_DOUBLE
#define DBG_DOUBLE 0
#endif
#define NREP(bit) ((DBG_DOUBLE & (bit)) ? 2 : 1)
#define REPBAR(rep, n) do { if ((rep) + 1 < (n)) xcd_barrier<false>(bar, F.tid == 0); } while (0)
#define IN(k) (lo <= (k) && (k) < hi)
#define SEAM(k) do { if (IN(k) && IN((k) + 1)) xcd_barrier<false>(bar, F.tid == 0); } while (0)
template <int layer>
__device__ __forceinline__ void layer_phases(unsigned char* lds, const int wave_s, const int lo, const int hi, const XcdBarrier& bar) {
    Frame F;

        constexpr int pb = phase_base(layer); constexpr bool odd = layer & 1; constexpr int li = layer >> 1;
        constexpr int P_NORM1 = pb, P_MIXIN = pb + 1, P_PREP = pb + 2, P_REC = pb + 3, P_POST = pb + 4, P_MIXOUT = pb + 5, P_NORM2 = P_MIXOUT + 1, P_FFIN = P_MIXOUT + 2, P_FFOUT = P_MIXOUT + 3;
#define MODL (WSP(float, WS_MOD) + (size_t)layer * 2 * 6 * DM)
#define XCUR (layer == 0 ? ap->in[0] : (const float*)ap->out)
        if (IN(P_NORM1)) { REFRAME();
            const float* modl = MODL;
            for (int rep = 0; rep < NREP(2); ++rep) {
            constexpr bool L0 = layer == 0; const float* g2p = WSP(float, WS_MOD) + (size_t)(L0 ? 0 : layer - 1) * 2 * 6 * DM + 5 * DM; const void* xin = L0 ? (const void*)ap->in[0] : (const void*)WSP(const bf16, WS_XB);
            if (!odd) norm_phase<8, 1, !L0, L0>(F, xin, ap->in[4] + (size_t)layer * DM, modl, modl + DM, WSP(bf16, WS_H), ap->in[6] + (size_t)li * DM * AB_IN + AB_N, AB_IN, ap->in[12] + li * 8, WSP(float, WS_LOGF), WSP(const bf16, WS_Y), g2p, WSP(bf16, WS_XB));
            else norm_phase<16, 2, !L0, L0>(F, xin, ap->in[4] + (size_t)layer * DM, modl, modl + DM, WSP(bf16, WS_H), ap->in[13] + (size_t)li * DM * C_IN + C_N, C_IN, nullptr, WSP(float, WS_GLOW), WSP(const bf16, WS_Y), g2p, WSP(bf16, WS_XB));
            REPBAR(rep, NREP(2)); }
            SEAM(P_NORM1);
        }
        if (IN(P_MIXIN)) { REFRAME();
            const int N = odd ? 4096 : AB_N, ldc = odd ? C_N : AB_N;
            const bf16* Wt = odd ? WSP(const bf16, WS_W_GLIN) + (size_t)li * C_N * DM : WSP(const bf16, WS_W_ABIN) + (size_t)li * AB_N * DM;
            pg8::Gemm g{WSP(const bf16, WS_H), Wt, M, N, DM}; pg8::StaticOrder S; S.init(M, N, F.G, F.bid);
            pg8::EpiBf16 E{WSP(bf16, WS_PROJ), ldc};
            for (int rep = 0; rep < NREP(1); ++rep) { pg8::gemm_phase<pg8::EpiBf16, pg8::StaticOrder, true, true>(F.lds + RING_OFF, g, S, E, F.tid); REPBAR(rep, NREP(1)); }
            SEAM(P_MIXIN);
        }
        if (IN(P_PREP)) { REFRAME();
            if (!odd) { fox_prep(F, WSP(bf16, WS_PROJ), ap->in[10] + li * 128, ap->in[11] + li * 128, WSP(float, WS_LOGF), WSP(float, WS_BIAS));
                        __syncthreads();
                        for (int rep = 0; rep < NREP(4); ++rep) { rec_prep<false>(F, WSP(const bf16, WS_PROJ), ws + WS_REC, ap->in[8], li, nullptr, nullptr, nullptr); REPBAR(rep, NREP(4)); } }
            else for (int rep = 0; rep < NREP(4); ++rep) { rec_prep<true>(F, WSP(const bf16, WS_PROJ), ws + WS_REC, nullptr, 0, WSP(float, WS_GLOW), ap->in[14] + (size_t)li * 16 * 1024, ap->in[15] + li * 1024); REPBAR(rep, NREP(4)); }
            SEAM(P_PREP);
        }
        if (IN(P_REC)) { REFRAME();
            for (int rep = 0; rep < (odd ? NREP(8) : 1); ++rep) {
            if (!odd) { rec_seq3<false>(F, ws + WS_REC, WSP(bf16, WS_O));
                        fox_phase(F, (char*)lds + RING_OFF, WSP(const bf16, WS_PROJ), WSP(bf16, WS_CAT), WSP(float, WS_BIAS), (unsigned*)(ws + WS_CTL) + CW_QUEUE + 64 * (li + 2 * rep), ap->in[10] + li * 128, ap->in[11] + li * 128); }
            else { rec_seq3<true>(F, ws + WS_REC, WSP(bf16, WS_O));
                   if (F.bid < 64 && rep == 0) { LAS float* scr = (LAS float*)(F.lds + RING_OFF + F.wave * 16640);
                       convert_weights<(layer == 1 ? 1 : 2)>(ap, scr, 0, 1, F.lane, (unsigned*)(ws + WS_CTL) + CW_CONV, F.wave, F.tid == 0, (volatile LAS unsigned*)(F.lds + MISC_OFF) + 32); }
                   if (F.bid >= 64 && rep == 0) {
                       { pg8::Gemm g{WSP(const bf16, WS_H), WSP(const bf16, WS_W_GLIN) + (size_t)li * C_N * DM + (size_t)4096 * DM, M, 2048, DM}; pg8::StaticOrder S; S.init(M, 2048, F.G - 64, F.bid - 64);
                         pg8::EpiBf16 E{WSP(bf16, WS_PROJ) + 4096, C_N};
                         pg8::gemm_phase<pg8::EpiBf16, pg8::StaticOrder, true, true>(F.lds + RING_OFF, g, S, E, F.tid); }
                       LAS float* scr = (LAS float*)(F.lds + RING_OFF + F.wave * 16640);
                       convert_weights<(layer == 1 ? 1 : 2)>(ap, scr, 0, 1, F.lane, (unsigned*)(ws + WS_CTL) + CW_CONV, F.wave, F.tid == 0, (volatile LAS unsigned*)(F.lds + MISC_OFF) + 32); } }
            REPBAR(rep, (odd ? NREP(8) : 1)); }
            SEAM(P_REC);
        }
        if (IN(P_POST)) { REFRAME();
            if (!odd) post_even(F, WSP(const bf16, WS_O), WSP(const bf16, WS_PROJ), ap->in[9] + li * 1024, WSP(bf16, WS_CAT));
            else for (int rep = 0; rep < NREP(16); ++rep) { post_odd(F, WSP(const bf16, WS_O), WSP(const bf16, WS_PROJ), ap->in[16] + li * 512, WSP(bf16, WS_CAT)); REPBAR(rep, NREP(16)); }
            SEAM(P_POST);
        }
        if (IN(P_MIXOUT)) { REFRAME();
            const float* modl = MODL;
            const bf16* Wt = odd ? WSP(const bf16, WS_W_GLOUT) + (size_t)li * DM * DM : WSP(const bf16, WS_W_ABOUT) + (size_t)li * DM * DM;
            pg8::Gemm g{WSP(const bf16, WS_CAT), Wt, M, DM, DM}; pg8::StaticOrder S; S.init(M, DM, F.G, F.bid);
            pg8::EpiBf16 E{WSP(bf16, WS_Y), DM};
            pg8::gemm_phase<pg8::EpiBf16, pg8::StaticOrder, true, true>(F.lds + RING_OFF, g, S, E, F.tid);
            SEAM(P_MIXOUT);
        }
        if (IN(P_NORM2)) { REFRAME();
            const float* modl = MODL;
            { constexpr bool L0 = layer == 0; const void* xin = L0 ? (const void*)ap->in[0] : (const void*)WSP(const bf16, WS_XB);
              norm_phase<0, 0, true, L0>(F, xin, ap->in[5] + (size_t)layer * DM, modl + 3 * DM, modl + 4 * DM, WSP(bf16, WS_H), nullptr, 0, nullptr, nullptr, WSP(const bf16, WS_Y), modl + 2 * DM, WSP(bf16, WS_XB)); }
            SEAM(P_NORM2);
        }
        if (IN(P_FFIN)) { REFRAME();
            pg8::Gemm g{WSP(const bf16, WS_H), WSP(const bf16, WS_W_FFIN) + (size_t)layer * FF2 * DM, M, FF2, DM}; pg8::StaticOrder S; S.init(M, FF2, F.G, F.bid);
            pg8::EpiSwiglu E{WSP(bf16, WS_FFH), FF};
            for (int rep = 0; rep < NREP(1 | 128); ++rep) { pg8::gemm_phase<pg8::EpiSwiglu, pg8::StaticOrder, true, true>(F.lds + RING_OFF, g, S, E, F.tid); REPBAR(rep, NREP(1 | 128)); }
            SEAM(P_FFIN);
        }
        if (IN(P_FFOUT)) { REFRAME();
            const float* modl = MODL;
            pg8::Gemm g{WSP(const bf16, WS_FFH), WSP(const bf16, WS_W_FFOUT) + (size_t)layer * DM * FF, M, DM, FF}; pg8::StaticOrder S; S.init(M, DM, F.G, F.bid);
            if constexpr (layer == DEPTH - 1) {
                const float* g2 = WSP(float, WS_MOD) + (size_t)(DEPTH - 1) * 2 * 6 * DM + 5 * DM;
                pg8::EpiResidBf E{(const pg8::bf16_t*)WSP(const bf16, WS_XB), ap->out, DM, g2, g2 + 6 * DM, (int)(T / pg8::BM)};
                pg8::gemm_phase<pg8::EpiResidBf, pg8::StaticOrder, true, true>(F.lds + RING_OFF, g, S, E, F.tid);
            } else {
            pg8::EpiBf16 E{WSP(bf16, WS_Y), DM};
            pg8::gemm_phase<pg8::EpiBf16, pg8::StaticOrder, true, true>(F.lds + RING_OFF, g, S, E, F.tid); }
            SEAM(P_FFOUT);
        }
    }
__global__ void __launch_bounds__(NTHREADS, 2) trunk_fwd(Args args_unused) {
    extern __shared__ __attribute__((aligned(16))) unsigned char lds[];
    Frame F;
    const int wave_s = __builtin_amdgcn_readfirstlane(threadIdx.x >> 6);
    int lo, hi, use_bar; XcdBarrier bar;
    {
        REFRAME();
        volatile LAS unsigned* MISC = (volatile LAS unsigned*)(F.lds + MISC_OFF);
        for (int u = F.tid; u < (LDS_BYTES - LDSCTL_OFF) / 4; u += NTHREADS) ((LAS unsigned*)(F.lds + LDSCTL_OFF))[u] = 0u;
        __syncthreads();
        lo = ap->ph_lo; hi = ap->ph_hi; use_bar = ap->use_bar;
        bar.bar = (unsigned*)(ws + WS_CTL) + CW_BAR; bar.x = 0; bar.st = MISC + 8;
        if (use_bar) bar = xcd_barrier_post((unsigned*)(ws + WS_CTL) + CW_BAR, MISC + 8, F.tid == 0);
    }

    if (IN(0)) { REFRAME(); p0_prologue(F, ap); if (IN(1)) xcd_barrier<true>(bar, F.tid == 0);
        if (DBG_DOUBLE & 32) { p0_prologue(F, ap); xcd_barrier<false>(bar, F.tid == 0); } }

    layer_phases<0>(lds, wave_s, lo, hi, bar);
    layer_phases<1>(lds, wave_s, lo, hi, bar);
    layer_phases<2>(lds, wave_s, lo, hi, bar);
    layer_phases<3>(lds, wave_s, lo, hi, bar);
#undef IN
#undef SEAM
}

#ifndef DBG_CHECK
#define DBG_CHECK 0
#endif
#if DBG_CHECK
#ifndef DBG_REPORT_ERR
#define DBG_REPORT_ERR 1
#endif
constexpr size_t WS_DBG = 5 * MiB;
constexpr size_t WS_DBG_OLD = 1072 * MiB;
__device__ __forceinline__ unsigned dbg_hash(unsigned x) { x ^= x >> 16; x *= 0x7feb352dU; x ^= x >> 15; x *= 0x846ca68bU; x ^= x >> 16; return x; }
__device__ __forceinline__ float dbg_bfr(float f) { return __builtin_bit_cast(float, f2bf(f) << 16); }
__device__ __forceinline__ void dbg_cmp(unsigned* dbg, unsigned code, float got, float ref, float rtol, float atol) {
    const float err = fabsf(got - ref); const bool bad = !(err <= atol + rtol * fabsf(ref));
    if (bad) { atomicMin(dbg, code); atomicMax(dbg + 1 + (code & 255u), __float_as_uint(err)); }
}
__global__ void dbg_gemm(unsigned* dbg, unsigned code, int mode, const bf16* A, int K, const float* W, int ldw, int N, const void* C, int ldc, const float* old, const float* gate0, const float* gate1) {
    const unsigned s = blockIdx.x * blockDim.x + threadIdx.x; const unsigned hsh = dbg_hash(s * 2654435761u + code);
    const int m = hsh % M, n = dbg_hash(hsh) % N;
    float d0 = 0.f, d1 = 0.f;
    for (int k = 0; k < K; ++k) { const float a = bf1(A[(size_t)m * K + k]); d0 += a * dbg_bfr(W[(size_t)k * ldw + n]); if (mode == 1) d1 += a * dbg_bfr(W[(size_t)k * ldw + FF + n]); }
    float got, ref;
    if (mode == 0) { got = bf1(((const bf16*)C)[(size_t)m * ldc + n]); ref = d0; }
    else if (mode == 1) { got = bf1(((const bf16*)C)[(size_t)m * ldc + n]); ref = d0 / (1.f + expf(-d0)) * d1; }
    else { got = ((const float*)C)[(size_t)m * ldc + n]; ref = old[(size_t)m * ldc + n] + (m >= T ? gate1 : gate0)[n] * d0; }
    dbg_cmp(dbg, code, got, ref, 0.02f, 0.03f);
}
__global__ void dbg_norm(unsigned* dbg, unsigned code, const float* x, const float* gain, const float* sh, const float* sc, const bf16* h) {
    const unsigned s = blockIdx.x * blockDim.x + threadIdx.x; const unsigned hsh = dbg_hash(s * 2654435761u + code);
    const int m = hsh % M, k = dbg_hash(hsh) % DM, b = m / T;
    double ss = 0.0; for (int i = 0; i < DM; ++i) { const double v = x[(size_t)m * DM + i]; ss += v * v; }
    const float rstd = (float)(1.0 / sqrt(ss / DM + 1e-6));
    const float ref = x[(size_t)m * DM + k] * rstd * gain[k] * (1.f + sc[(size_t)b * 6 * DM + k]) + sh[(size_t)b * 6 * DM + k];
    dbg_cmp(dbg, code, bf1(h[(size_t)m * DM + k]), ref, 0.01f, 0.01f);
}
__global__ void dbg_mod(unsigned* dbg, unsigned code, const float* c, const float* mw, const float* mb, const float* mod) {
    const unsigned s = blockIdx.x * blockDim.x + threadIdx.x; const unsigned hsh = dbg_hash(s * 2654435761u + code);
    const int layer = hsh % DEPTH, b = (hsh >> 8) & 1, j = dbg_hash(hsh) % (6 * DM);
    double acc = mb[(size_t)layer * 6 * DM + j];
    for (int k = 0; k < DM; ++k) { const double cv = c[b * DM + k]; acc += cv / (1.0 + exp(-cv)) * mw[((size_t)layer * DM + k) * (6 * DM) + j]; }
    dbg_cmp(dbg, code, mod[((size_t)layer * 2 + b) * 6 * DM + j], (float)acc, 1e-3f, 1e-4f);
}
__global__ void dbg_small(unsigned* dbg, unsigned code, int mode, const bf16* h, const float* W, int ldw, const float* fbias, const float* sout) {
    const unsigned s = blockIdx.x * blockDim.x + threadIdx.x; const unsigned hsh = dbg_hash(s * 2654435761u + code);
    const int m = hsh % M, cc = dbg_hash(hsh) % (mode == 1 ? 8 : 16), b = m / T, t = m % T;
    double acc = 0.0; for (int k = 0; k < DM; ++k) acc += (double)bf1(h[(size_t)m * DM + k]) * W[(size_t)k * ldw + cc];
    if (mode == 1) { const double xx = acc + fbias[cc]; const double ref = (xx < 0 ? xx : 0.0) - log1p(exp(-fabs(xx))); dbg_cmp(dbg, code, sout[((size_t)b * 8 + cc) * T + t], (float)ref, 0.02f, 0.02f); }
    else dbg_cmp(dbg, code, sout[(size_t)m * 16 + cc], (float)acc, 0.02f, 0.02f);
}
__global__ void dbg_cmpbuf(unsigned* dbg, unsigned code, const float* a, const float* b, size_t n) {
    for (size_t i = (size_t)blockIdx.x * blockDim.x + threadIdx.x; i < n; i += (size_t)gridDim.x * blockDim.x * 61) dbg_cmp(dbg, code, b[i], a[i], 0.05f, 0.1f);
}
__global__ void dbg_report(const unsigned* dbg, float* out) {
    if (threadIdx.x == 0 && blockIdx.x == 0) { const unsigned code = dbg[0]; if (code != 0xffffffffu) { out[0] = DBG_REPORT_ERR ? 1000.f * __uint_as_float(dbg[1 + (code & 255u)]) : 1000.f * (float)(code & 255u); } }
}
#endif
#ifndef N_LAUNCH_MODE
#define N_LAUNCH_MODE 1
#endif
extern "C" void kernel_launch(void* const* d_in, const int* in_sizes, int n_in, void* d_out, int out_size, void* d_ws, size_t ws_size, hipStream_t stream) {
    static int grid = 0;
    if (grid == 0) {
        if (n_in != 20 || out_size != M * DM || ws_size < WS_END) { fprintf(stderr, "kernel_launch: unexpected shapes (n_in %d out %d ws %zu)\n", n_in, out_size, ws_size); grid = -1; return; }
        int dev = 0, cus = 0, per_cu = 0;
        if (hipGetDevice(&dev) != hipSuccess || hipDeviceGetAttribute(&cus, hipDeviceAttributeMultiprocessorCount, dev) != hipSuccess) { grid = -1; return; }
        if (hipFuncSetAttribute((const void*)trunk_fwd, hipFuncAttributeMaxDynamicSharedMemorySize, LDS_BYTES) != hipSuccess) { fprintf(stderr, "kernel_launch: hipFuncSetAttribute failed\n"); grid = -1; return; }
        if (hipOccupancyMaxActiveBlocksPerMultiprocessor(&per_cu, (const void*)trunk_fwd, NTHREADS, LDS_BYTES) != hipSuccess || per_cu < 1)
            fprintf(stderr, "kernel_launch: occupancy query reports %d workgroups per CU\n", per_cu);
        (void)hipGetLastError();
        grid = cus;
    }
    if (grid < 0) return;
    if (hipMemsetAsync((char*)d_ws + WS_CTL, 0, CTL_ZERO_BYTES, stream) != hipSuccess) return;
    Args a{};
    for (int i = 0; i < 20; ++i) a.in[i] = (const float*)d_in[i];
    a.out = (float*)d_out; a.ws = (unsigned char*)d_ws; a.pad = 0;
#if N_LAUNCH_MODE == 1
    a.ph_lo = 0; a.ph_hi = N_PHASES; a.use_bar = 1;
    hipLaunchKernelGGL(trunk_fwd, dim3(grid), dim3(NTHREADS), LDS_BYTES, stream, a);
#else
    a.use_bar = 0;
#if DBG_CHECK
    unsigned char* wsb = (unsigned char*)d_ws; unsigned* dbg = (unsigned*)(wsb + WS_DBG);
    hipMemsetAsync(dbg, 0xFF, 4, stream); hipMemsetAsync(dbg + 1, 0, 1024, stream);
    const float* const* in = (const float* const*)a.in; float* outp = (float*)d_out; float* oldp = (float*)(wsb + WS_DBG_OLD);
    bf16* hbuf = (bf16*)(wsb + WS_H); bf16* catb = (bf16*)(wsb + WS_CAT); bf16* projb = (bf16*)(wsb + WS_PROJ); bf16* ffhb = (bf16*)(wsb + WS_FFH);
#endif
    for (int p = 0; p < N_PHASES; ++p) {
        int layer = 0; const int q = phase_kind(p, layer); const int li = layer >> 1; const bool odd = layer & 1; (void)li; (void)odd; (void)q;
#if DBG_CHECK
        const float* modl = (const float*)(wsb + WS_MOD) + (size_t)layer * 2 * 6 * DM; const float* xcur = layer == 0 ? in[0] : outp;
        if (q == K_MIXOUT) hipMemcpyAsync(oldp, xcur, (size_t)M * DM * 4, hipMemcpyDeviceToDevice, stream);
        if (q == K_FFOUT) hipMemcpyAsync(oldp, outp, (size_t)M * DM * 4, hipMemcpyDeviceToDevice, stream);
#endif
        a.ph_lo = p; a.ph_hi = p + 1;
        hipLaunchKernelGGL(trunk_fwd, dim3(grid), dim3(NTHREADS), LDS_BYTES, stream, a);
#if DBG_CHECK
        const unsigned code = 1 + p;
        if (q == K_PRO) dbg_mod<<<16, 256, 0, stream>>>(dbg, code, in[1], in[2], in[3], (const float*)(wsb + WS_MOD));
        if (q == K_NORM1) { dbg_norm<<<16, 256, 0, stream>>>(dbg, code, xcur, in[4] + (size_t)layer * DM, modl, modl + DM, hbuf);
            if (!odd) dbg_small<<<16, 256, 0, stream>>>(dbg, code | 0x100, 1, hbuf, in[6] + (size_t)li * DM * AB_IN + AB_N, AB_IN, in[12] + li * 8, (const float*)(wsb + WS_LOGF));
            else dbg_small<<<16, 256, 0, stream>>>(dbg, code | 0x100, 2, hbuf, in[13] + (size_t)li * DM * C_IN + C_N, C_IN, nullptr, (const float*)(wsb + WS_GLOW)); }
        if (q == K_MIXIN) { if (!odd) dbg_gemm<<<16, 256, 0, stream>>>(dbg, code, 0, hbuf, DM, in[6] + (size_t)li * DM * AB_IN, AB_IN, AB_N, projb, AB_N, nullptr, nullptr, nullptr);
            else dbg_gemm<<<16, 256, 0, stream>>>(dbg, code, 0, hbuf, DM, in[13] + (size_t)li * DM * C_IN, C_IN, C_N, projb, C_N, nullptr, nullptr, nullptr); }
#if DBG_REC
        if (q == K_REC) dbg_cmpbuf<<<256, 256, 0, stream>>>(dbg, code, (const float*)(wsb + WS_O), (const float*)(wsb + 1200 * MiB), odd ? (size_t)M * 2048 : (size_t)M * 1024);
#endif
        if (q == K_MIXOUT) dbg_gemm<<<16, 256, 0, stream>>>(dbg, code, 2, catb, DM, (odd ? in[17] : in[7]) + (size_t)li * DM * DM, DM, DM, outp, DM, oldp, modl + 2 * DM, modl + 6 * DM + 2 * DM);
        if (q == K_NORM2) dbg_norm<<<16, 256, 0, stream>>>(dbg, code, outp, in[5] + (size_t)layer * DM, modl + 3 * DM, modl + 4 * DM, hbuf);
        if (q == K_FFIN) dbg_gemm<<<16, 256, 0, stream>>>(dbg, code, 1, hbuf, DM, in[18] + (size_t)layer * DM * FF2, FF2, FF, ffhb, FF, nullptr, nullptr, nullptr);
        if (q == K_FFOUT) dbg_gemm<<<16, 256, 0, stream>>>(dbg, code, 2, ffhb, FF, in[19] + (size_t)layer * FF * DM, DM, DM, outp, DM, oldp, modl + 5 * DM, modl + 6 * DM + 5 * DM);
#endif
    }
#if DBG_CHECK
    dbg_report<<<1, 64, 0, stream>>>(dbg, outp);
#endif
#endif
}
```

```cpp
#include <hip/hip_runtime.h>
#include <hip/hip_bf16.h>
#include <cstdio>
#include <cstdint>
__device__ __forceinline__ int opq_tid(int wave_s) {
    int t; asm volatile("v_mbcnt_lo_u32_b32 %0, -1, 0\n\tv_mbcnt_hi_u32_b32 %0, -1, %0\n\tv_lshl_add_u32 %0, %1, 6, %0" : "=&v"(t) : "s"(wave_s)); return t; }
__device__ __forceinline__ int opq_bid() { int t = blockIdx.x; asm volatile("" : "+s"(t)); return t; }
template <int MASK> __device__ __forceinline__ float xsum(float v) {
    if constexpr (MASK < 32) { return v + __builtin_bit_cast(float, __builtin_amdgcn_ds_swizzle(__builtin_bit_cast(int, v), (MASK << 10) | 0x1f)); }
    else { auto rr = __builtin_amdgcn_permlane32_swap(__float_as_uint(v), __float_as_uint(v), false, false);
           const unsigned r0 = rr[0], r1 = rr[1];
           return __uint_as_float(r0) + __uint_as_float(r1); }
}
__device__ __forceinline__ float xor1_get(float v) { return __builtin_bit_cast(float, __builtin_amdgcn_ds_swizzle(__builtin_bit_cast(int, v), (1 << 10) | 0x1f)); }
namespace pg8 {
#define PG8_LAS __attribute__((address_space(3)))
typedef unsigned short bf16_t;
typedef short bf16x8 __attribute__((ext_vector_type(8)));
typedef float f32x4 __attribute__((ext_vector_type(4)));
typedef unsigned u32x4 __attribute__((ext_vector_type(4)));
constexpr int BM = 256, BK = 64, HALF = 128, HTB = HALF * BK * 2  , STAGE_BYTES = 8 * HTB, NXCD = 8, WGM = 8;

__host__ __device__ __forceinline__ int lds_byte(int r, int c) { const int st = (r >> 4) * 2 + (c >> 5), rr = r & 15, cc = c & 31, ob = rr * 64 + cc * 2; return st * 1024 + (ob ^ (((ob >> 9) & 1) << 5)); }
__host__ __device__ __forceinline__ void stage_rc(int b, int& R, int& C) { const int st = b / 1024, sb = b % 1024, swz = sb ^ (((sb >> 9) & 1) << 5); R = (st >> 1) * 16 + swz / 64; C = (st & 1) * 32 + (swz % 64) / 2; }
__host__ __device__ __forceinline__ int perm32(int rho) { const int n = rho >> 4, i = rho & 15; return 8 * (i >> 2) + 4 * n + (i & 3); }

struct Unit { int pm, pn; };
struct Gemm { const bf16_t* A; const bf16_t* Bt; int M, N, K; };

struct StaticOrder {
    int nM, nN, nwg, G, c;
    __host__ __device__ void init(int M, int N, int G_, int c_) { nM = M / BM; nN = N / BM; nwg = nM * nN; G = G_; c = c_; }
    __host__ __device__ bool next(int i, Unit& u) const {
        const long L = (long)i * G + c; if (L >= nwg) return false;
        int wgid = (int)L; { const int q = nwg / NXCD, r = nwg % NXCD, xcd = wgid % NXCD, off = wgid / NXCD; wgid = (xcd < r ? xcd * (q + 1) : r * (q + 1) + (xcd - r) * q) + off; }
        const int nig = WGM * nN, gid = wgid / nig, fm = gid * WGM, gsz = (nM - fm) < WGM ? (nM - fm) : WGM;
        u.pm = fm + ((wgid % nig) % gsz); u.pn = (wgid % nig) / gsz; return true;
    }
    __device__ __forceinline__ void a_ready(const Unit&) const {}
    __device__ __forceinline__ void done(const Unit&) const {}
};

__device__ __forceinline__ unsigned cvt_pk_bf16(float lo, float hi) { unsigned r; asm volatile("v_cvt_pk_bf16_f32 %0, %1, %2" : "=v"(r) : "v"(lo), "v"(hi)); return r; }
typedef float f32x2 __attribute__((ext_vector_type(2)));

struct EpiBf16 {
    static constexpr bool PERM = true, AFTER_DRAIN = false;
    bf16_t* O; int ldc;
    __device__ __forceinline__ void operator()(const f32x4 (&acc)[2][2][4][2], const Unit& u, int wr, int wc, int fr, int fq) const {
        const int row0 = u.pm * BM + wr * 64 + fr; const int col0 = u.pn * BM + wc * 32 + 8 * fq;
#pragma unroll
        for (int ai = 0; ai < 2; ++ai)
#pragma unroll
            for (int m = 0; m < 4; ++m) { bf16_t* rowp = O + (size_t)(row0 + ai * HALF + m * 16) * ldc + col0;
#pragma unroll
                for (int bj = 0; bj < 2; ++bj) { const f32x4 v0 = acc[ai][bj][m][0], v1 = acc[ai][bj][m][1];
                    u32x4 w; w.x = cvt_pk_bf16(v0[0], v0[1]); w.y = cvt_pk_bf16(v0[2], v0[3]); w.z = cvt_pk_bf16(v1[0], v1[1]); w.w = cvt_pk_bf16(v1[2], v1[3]);
                    *(u32x4*)(rowp + bj * HALF) = w; } }
    }
};
__device__ __forceinline__ float silu_f(float a) { return a * __builtin_amdgcn_rcpf(1.0f + __builtin_amdgcn_exp2f(-1.4426950408889634f * a)); }
struct EpiSwiglu {
    static constexpr bool PERM = true, AFTER_DRAIN = false;
    bf16_t* O; int ldc;
    __device__ __forceinline__ void operator()(const f32x4 (&acc)[2][2][4][2], const Unit& u, int wr, int wc, int fr, int fq) const {
        const int row0 = u.pm * BM + wr * 64 + fr; const int col0 = u.pn * HALF + wc * 32 + 8 * fq;
#pragma unroll
        for (int ai = 0; ai < 2; ++ai)
#pragma unroll
            for (int m = 0; m < 4; ++m) { bf16_t* rowp = O + (size_t)(row0 + ai * HALF + m * 16) * ldc + col0;
                const f32x4 a0 = acc[ai][0][m][0], a1 = acc[ai][0][m][1], u0 = acc[ai][1][m][0], u1 = acc[ai][1][m][1];
                u32x4 w;
                w.x = cvt_pk_bf16(silu_f(a0[0]) * u0[0], silu_f(a0[1]) * u0[1]); w.y = cvt_pk_bf16(silu_f(a0[2]) * u0[2], silu_f(a0[3]) * u0[3]);
                w.z = cvt_pk_bf16(silu_f(a1[0]) * u1[0], silu_f(a1[1]) * u1[1]); w.w = cvt_pk_bf16(silu_f(a1[2]) * u1[2], silu_f(a1[3]) * u1[3]);
                *(u32x4*)rowp = w; }
    }
};
struct EpiResid {
    static constexpr bool PERM = false, AFTER_DRAIN = false;
    const float* base; float* out; int ldc; const float* gate0; const float* gate1; int pm_split;
    __device__ __forceinline__ void operator()(const f32x4 (&acc)[2][2][4][2], const Unit& u, int wr, int wc, int fr, int fq) const {
        const int col0 = u.pn * BM + wc * 32 + 4 * fq; const float* g = (u.pm >= pm_split) ? gate1 : gate0;
        f32x4 gv[2][2];
#pragma unroll
        for (int bj = 0; bj < 2; ++bj)
#pragma unroll
            for (int n = 0; n < 2; ++n) gv[bj][n] = *(const f32x4*)(g + col0 + bj * HALF + n * 16);
#pragma unroll
        for (int ai = 0; ai < 2; ++ai) { f32x4 bs[4][2][2];
#pragma unroll
            for (int m = 0; m < 4; ++m) { const size_t off = (size_t)(u.pm * BM + ai * HALF + wr * 64 + m * 16 + fr) * ldc + col0;
#pragma unroll
                for (int bj = 0; bj < 2; ++bj)
#pragma unroll
                    for (int n = 0; n < 2; ++n) bs[m][bj][n] = *(const f32x4*)(base + off + bj * HALF + n * 16); }
#pragma unroll
            for (int m = 0; m < 4; ++m) { const size_t off = (size_t)(u.pm * BM + ai * HALF + wr * 64 + m * 16 + fr) * ldc + col0;
#pragma unroll
                for (int bj = 0; bj < 2; ++bj)
#pragma unroll
                    for (int n = 0; n < 2; ++n) *(f32x4*)(out + off + bj * HALF + n * 16) = bs[m][bj][n] + gv[bj][n] * acc[ai][bj][m][n]; }
            asm volatile("" ::: "memory"); }
    }
};
struct EpiResidBf {
    static constexpr bool PERM = false, AFTER_DRAIN = false;
    const bf16_t* xb; float* out; int ldc; const float* gate0; const float* gate1; int pm_split;
    typedef unsigned u32x2 __attribute__((ext_vector_type(2)));
    __device__ __forceinline__ void operator()(const f32x4 (&acc)[2][2][4][2], const Unit& u, int wr, int wc, int fr, int fq) const {
        const int col0 = u.pn * BM + wc * 32 + 4 * fq; const float* g = (u.pm >= pm_split) ? gate1 : gate0;
        f32x4 gv[2][2];
#pragma unroll
        for (int bj = 0; bj < 2; ++bj)
#pragma unroll
            for (int n = 0; n < 2; ++n) gv[bj][n] = *(const f32x4*)(g + col0 + bj * HALF + n * 16);
#pragma unroll
        for (int ai = 0; ai < 2; ++ai) { u32x2 bs[4][2][2];
#pragma unroll
            for (int m = 0; m < 4; ++m) { const size_t off = (size_t)(u.pm * BM + ai * HALF + wr * 64 + m * 16 + fr) * ldc + col0;
#pragma unroll
                for (int bj = 0; bj < 2; ++bj)
#pragma unroll
                    for (int n = 0; n < 2; ++n) bs[m][bj][n] = *(const u32x2*)(xb + off + bj * HALF + n * 16); }
#pragma unroll
            for (int m = 0; m < 4; ++m) { const size_t off = (size_t)(u.pm * BM + ai * HALF + wr * 64 + m * 16 + fr) * ldc + col0;
#pragma unroll
                for (int bj = 0; bj < 2; ++bj)
#pragma unroll
                    for (int n = 0; n < 2; ++n) { const u32x2 b = bs[m][bj][n];
                        const f32x4 xv = {__uint_as_float(b.x << 16), __uint_as_float(b.x & 0xffff0000u), __uint_as_float(b.y << 16), __uint_as_float(b.y & 0xffff0000u)};
                        *(f32x4*)(out + off + bj * HALF + n * 16) = xv + gv[bj][n] * acc[ai][bj][m][n]; } }
            asm volatile("" ::: "memory"); }
    }
};

template <class Epi, class Sched, bool ALIGN_EPI = false, bool SP2 = false>
__device__ __forceinline__ void gemm_phase(PG8_LAS unsigned char* lds, const Gemm g, const Sched& S, const Epi& E, const int tid) {
    const int wid = __builtin_amdgcn_readfirstlane(tid >> 6), lane = tid & 63, wr = wid >> 2, wc = wid & 3, fr = lane & 15, fq = lane >> 4;
    const int K = g.K, nt = K / BK;
    unsigned voffA[2], voffB[2];
#pragma unroll
    for (int i = 0; i < 2; ++i) { int R, C; stage_rc(tid * 16 + i * 8192, R, C); const int Rb = Epi::PERM ? ((R & ~31) + perm32(R & 31)) : R;
        voffA[i] = (unsigned)(R * K + C) * 2u; voffB[i] = (unsigned)(Rb * K + C) * 2u; }
    const size_t kstep = (size_t)(BK * 2);
    const size_t hstep = (size_t)HALF * K * 2;
    const size_t tstep = 2 * hstep;
    const unsigned ldsw = (unsigned)wid * 1024u;
    const int aoff = lds_byte(wr * 64 + fr, fq * 8), boff = lds_byte(wc * 32 + fr, fq * 8);
#define PG8_SA(b, h) (((b) * 2 + (h)) * HTB)
#define PG8_SB(b, h) ((4 + (b) * 2 + (h)) * HTB)
#define PG8_STAGE(bufoff, gbase, voff) do { _Pragma("unroll") for (int _i = 0; _i < 2; ++_i) \
        __builtin_amdgcn_global_load_lds((const unsigned*)((const char*)(gbase) + (voff)[_i]), (PG8_LAS unsigned*)(lds + (bufoff) + ldsw + _i * 8192), 16, 0, 0); } while (0)
#define PG8_LDA(dst, b, h) do { _Pragma("unroll") for (int m = 0; m < 4; ++m) _Pragma("unroll") for (int k = 0; k < 2; ++k) dst[m][k] = *(const PG8_LAS bf16x8*)(lds + PG8_SA(b, h) + aoff + m * 2048 + k * 1024); } while (0)
#define PG8_LDB(dst, b, h) do { _Pragma("unroll") for (int n = 0; n < 2; ++n) _Pragma("unroll") for (int k = 0; k < 2; ++k) dst[n][k] = *(const PG8_LAS bf16x8*)(lds + PG8_SB(b, h) + boff + n * 2048 + k * 1024); } while (0)
#define PG8_MMA(ai, bj, At, Bt) do { __builtin_amdgcn_s_setprio(1); _Pragma("unroll") for (int m = 0; m < 4; ++m) _Pragma("unroll") for (int n = 0; n < 2; ++n) _Pragma("unroll") for (int k = 0; k < 2; ++k) \
        acc[ai][bj][m][n] = __builtin_amdgcn_mfma_f32_16x16x32_bf16(Bt[n][k], At[m][k], acc[ai][bj][m][n], 0, 0, 0); __builtin_amdgcn_s_setprio(0); } while (0)
#define PG8_WAIT_V(n) asm volatile("s_waitcnt vmcnt(" #n ")" ::: "memory")
#define PG8_WAIT_L(n) asm volatile("s_waitcnt lgkmcnt(" #n ")" ::: "memory")
#define PG8_BAR __builtin_amdgcn_s_barrier()
#define PG8_SCHED __builtin_amdgcn_sched_barrier(0)
    Unit cur, nxt; int ui = 0;
    if (!S.next(0, cur)) return;
    f32x4 acc[2][2][4][2];
#pragma unroll
    for (int a = 0; a < 2; ++a)
#pragma unroll
        for (int b = 0; b < 2; ++b)
#pragma unroll
            for (int m = 0; m < 4; ++m)
#pragma unroll
                for (int n = 0; n < 2; ++n) acc[a][b][m][n] = (f32x4){0.f, 0.f, 0.f, 0.f};
    bf16x8 At[4][2], B0[2][2], B1[2][2];
    const char* cA = (const char*)g.A + (size_t)cur.pm * tstep; const char* cB = (const char*)g.Bt + (size_t)cur.pn * tstep;
    S.a_ready(cur);
    if constexpr (SP2) {
        PG8_STAGE(PG8_SB(0, 0), cB, voffB); PG8_STAGE(PG8_SB(0, 1), cB + hstep, voffB); PG8_STAGE(PG8_SA(0, 0), cA, voffA); PG8_STAGE(PG8_SA(0, 1), cA + hstep, voffA);
        if (wr == 1) PG8_BAR;
        PG8_WAIT_V(2); PG8_BAR;
        PG8_STAGE(PG8_SB(1, 0), cB + kstep, voffB); PG8_STAGE(PG8_SA(1, 0), cA + kstep, voffA); PG8_STAGE(PG8_SB(1, 1), cB + hstep + kstep, voffB);
        PG8_WAIT_V(6); PG8_BAR;
    } else {
        PG8_STAGE(PG8_SB(0, 0), cB, voffB); PG8_STAGE(PG8_SA(0, 0), cA, voffA); PG8_STAGE(PG8_SB(0, 1), cB + hstep, voffB); PG8_STAGE(PG8_SA(0, 1), cA + hstep, voffA);
        if (wr == 1) PG8_BAR;
        PG8_WAIT_V(4); PG8_BAR;
        PG8_STAGE(PG8_SB(1, 0), cB + kstep, voffB); PG8_STAGE(PG8_SA(1, 0), cA + kstep, voffA); PG8_STAGE(PG8_SB(1, 1), cB + hstep + kstep, voffB);
        PG8_WAIT_V(6); PG8_BAR;
    }
    for (;;) {
        const bool has_next = S.next(ui + 1, nxt);
        const char* nA = has_next ? (const char*)g.A + (size_t)nxt.pm * tstep : cA; const char* nB = has_next ? (const char*)g.Bt + (size_t)nxt.pn * tstep : cB;
        for (int t = 0; t < nt; t += 2) {
            const bool last = (t == nt - 2);
            const char* a1 = cA + (size_t)(t + 1) * kstep;
            const char* a2 = last ? nA : cA + (size_t)(t + 2) * kstep; const char* b2 = last ? nB : cB + (size_t)(t + 2) * kstep;
            const char* a3 = a2 + kstep; const char* b3 = b2 + kstep;
            if (last && has_next) S.a_ready(nxt);
            if constexpr (SP2) {
            PG8_LDB(B0, 0, 0); PG8_LDB(B1, 0, 1); PG8_SCHED; PG8_LDA(At, 0, 0); PG8_STAGE(PG8_SA(1, 1), a1 + hstep, voffA);
            PG8_WAIT_V(8); PG8_WAIT_L(0); PG8_BAR; PG8_MMA(0, 0, At, B0); PG8_MMA(0, 1, At, B1); PG8_BAR; PG8_SCHED;
            PG8_LDA(At, 0, 1); PG8_STAGE(PG8_SB(0, 0), b2, voffB); PG8_STAGE(PG8_SB(0, 1), b2 + hstep, voffB); PG8_STAGE(PG8_SA(0, 0), a2, voffA);
            PG8_WAIT_V(8); PG8_WAIT_L(0); PG8_BAR; PG8_MMA(1, 0, At, B0); PG8_MMA(1, 1, At, B1); PG8_BAR; PG8_SCHED;
            PG8_LDB(B0, 1, 0); PG8_LDB(B1, 1, 1); PG8_SCHED; PG8_LDA(At, 1, 0); PG8_STAGE(PG8_SA(0, 1), a2 + hstep, voffA);
            PG8_WAIT_V(8); PG8_WAIT_L(0); PG8_BAR; PG8_MMA(0, 0, At, B0); PG8_MMA(0, 1, At, B1); PG8_BAR; PG8_SCHED;
            PG8_LDA(At, 1, 1); PG8_STAGE(PG8_SB(1, 0), b3, voffB); PG8_STAGE(PG8_SB(1, 1), b3 + hstep, voffB); PG8_STAGE(PG8_SA(1, 0), a3, voffA);
            PG8_WAIT_V(8); PG8_WAIT_L(0); PG8_BAR; PG8_MMA(1, 0, At, B0); PG8_MMA(1, 1, At, B1); PG8_BAR; PG8_SCHED;
            } else {
            PG8_LDB(B0, 0, 0); PG8_SCHED; PG8_LDA(At, 0, 0); PG8_STAGE(PG8_SA(1, 1), a1 + hstep, voffA);
            PG8_WAIT_L(8); PG8_BAR; PG8_WAIT_L(0); PG8_MMA(0, 0, At, B0); PG8_BAR; PG8_SCHED;
            PG8_LDB(B1, 0, 1); PG8_STAGE(PG8_SB(0, 0), b2, voffB);
            PG8_BAR; PG8_WAIT_L(0); PG8_MMA(0, 1, At, B1); PG8_BAR;
            PG8_LDA(At, 0, 1); PG8_STAGE(PG8_SA(0, 0), a2, voffA);
            PG8_BAR; PG8_WAIT_L(0); PG8_MMA(1, 0, At, B0); PG8_BAR; PG8_SCHED;
            PG8_STAGE(PG8_SB(0, 1), b2 + hstep, voffB);
            PG8_WAIT_V(6); PG8_BAR; PG8_MMA(1, 1, At, B1); PG8_BAR;
            PG8_LDB(B0, 1, 0); PG8_SCHED; PG8_LDA(At, 1, 0); PG8_STAGE(PG8_SA(0, 1), a2 + hstep, voffA);
            PG8_WAIT_L(8); PG8_BAR; PG8_WAIT_L(0); PG8_MMA(0, 0, At, B0); PG8_BAR; PG8_SCHED;
            PG8_LDB(B1, 1, 1); PG8_STAGE(PG8_SB(1, 0), b3, voffB);
            PG8_BAR; PG8_WAIT_L(0); PG8_MMA(0, 1, At, B1); PG8_BAR;
            PG8_LDA(At, 1, 1); PG8_STAGE(PG8_SA(1, 0), a3, voffA);
            PG8_BAR; PG8_WAIT_L(0); PG8_MMA(1, 0, At, B0); PG8_BAR; PG8_SCHED;
            PG8_STAGE(PG8_SB(1, 1), b3 + hstep, voffB);
            PG8_WAIT_V(6); PG8_BAR; PG8_MMA(1, 1, At, B1); PG8_BAR;
            }
        }
        if constexpr (ALIGN_EPI) { if (wr == 0) PG8_BAR; }
        if constexpr (!Epi::AFTER_DRAIN) { E(acc, cur, wr, wc, fr, fq); S.done(cur); }
        if (!has_next) break;
#pragma unroll
        for (int a = 0; a < 2; ++a)
#pragma unroll
            for (int b = 0; b < 2; ++b)
#pragma unroll
                for (int m = 0; m < 4; ++m)
#pragma unroll
                    for (int n = 0; n < 2; ++n) acc[a][b][m][n] = (f32x4){0.f, 0.f, 0.f, 0.f};
        cur = nxt; cA = nA; cB = nB; ++ui;
        if constexpr (ALIGN_EPI) { if (wr == 1) PG8_BAR; }
    }
    PG8_WAIT_V(0);
    if constexpr (!ALIGN_EPI) { if (wr == 0) PG8_BAR; }
    PG8_BAR;
    if constexpr (Epi::AFTER_DRAIN) { E.fused(acc, cur, wr, wc, fr, fq, lds, wid, lane); S.done(cur); }
#undef PG8_SA
#undef PG8_SB
#undef PG8_STAGE
#undef PG8_LDA
#undef PG8_LDB
#undef PG8_MMA
#undef PG8_WAIT_V
#undef PG8_WAIT_L
#undef PG8_BAR
#undef PG8_SCHED
}
}
namespace fox {
constexpr int D = 128, PITCH = 8192, OPITCH = 2048, SKV = 8192, GATE_OFF = 3072;
constexpr float THR = 8.f;
constexpr float SCALE = 0.08838834764831845f;
constexpr int NW = 8, QBLK = 32, KVBLK = 64, QB = NW * QBLK;
constexpr int SHM_V = KVBLK * D * 2, SHM_K = KVBLK * D * 2;
constexpr int BIAS_OFF = 2 * SHM_V + 2 * SHM_K + NW * 64 * 4;
constexpr int LDS_BYTES = BIAS_OFF + SKV * 4;

using bf16 = __hip_bfloat16;
typedef short bf16x8 __attribute__((ext_vector_type(8)));
typedef short s16x4 __attribute__((ext_vector_type(4)));
typedef float f32x16 __attribute__((ext_vector_type(16)));
typedef float f32x4 __attribute__((ext_vector_type(4)));
typedef unsigned u32x4 __attribute__((ext_vector_type(4)));

#define KSWZ(row, colB) ((row) * 256 + ((colB) ^ (((row) & 7) << 4)))
#define SBAR() __builtin_amdgcn_sched_barrier(0)
__device__ __forceinline__ int v_st(int k, int c) { const int kk = (k & ~0xC) | ((k & 4) << 1) | ((k & 8) >> 1); return ((kk >> 3) * 4 + (c >> 5)) * 512 + ((kk & 7) * 32 + (c & 31)) * 2; }
__device__ __forceinline__ int v_rd_base(int lane) { return ((lane & 3) << 3) | (((lane >> 2) & 3) << 6) | (((lane >> 4) & 1) << 5) | (((lane >> 5) & 1) << 8); }
constexpr int v_rd_off(int d0, int ks, int half) { return d0 * 512 + ks * 4096 + half * 2048; }
__device__ __forceinline__ int crow(int r, int hi) { return (r & 3) + 8 * (r >> 2) + 4 * hi; }
__device__ __forceinline__ unsigned cvtpk(float lo, float hi) {
    unsigned r; asm volatile("v_cvt_pk_bf16_f32 %0, %1, %2" : "=v"(r) : "v"(lo), "v"(hi)); return r;
}
__device__ __forceinline__ bf16x8 load8(const bf16* p) { return *reinterpret_cast<const bf16x8*>(p); }
__device__ __forceinline__ void mask_tile(f32x16& p0, f32x16& p1, int dq, unsigned W) {
    const float NEG = -__builtin_inff();
#pragma unroll
    for (int r = 0; r < 16; ++r) {
        const int c = (r & 3) + 8 * (r >> 2);
        if ((unsigned)(dq - c) >= W) p0[r] = NEG;
        if ((unsigned)(dq - c - 32) >= W) p1[r] = NEG;
    }
}
__device__ __forceinline__ void partialSM(f32x16& p0, f32x16& p1, float& m_reg, float& mn, float& alpha) {
    float pmax = p0[0]; for (int r = 1; r < 16; ++r) pmax = fmaxf(pmax, p0[r]); for (int r = 0; r < 16; ++r) pmax = fmaxf(pmax, p1[r]);
    { auto rr = __builtin_amdgcn_permlane32_swap(__float_as_uint(pmax), __float_as_uint(pmax), false, false);
      pmax = fmaxf(__uint_as_float(rr[0]), __uint_as_float(rr[1])); }
    constexpr float C2 = 1.4426950408889634f * SCALE;
    if (__builtin_expect(__all((pmax - m_reg) * SCALE <= THR), 1)) { mn = m_reg; alpha = 1.f; }
    else { mn = fmaxf(m_reg, pmax); alpha = __builtin_amdgcn_exp2f((m_reg - mn) * C2); m_reg = mn; }
    const float mnL = -mn * C2;
    for (int r = 0; r < 16; ++r) p0[r] = fmaf(p0[r], C2, mnL); for (int r = 0; r < 16; ++r) p1[r] = fmaf(p1[r], C2, mnL);
    for (int r = 0; r < 16; ++r) p0[r] = __builtin_amdgcn_exp2f(p0[r]);
}
__device__ __forceinline__ void finishSM(f32x16& p0, f32x16& p1, float alpha, float& l_reg, bf16x8& pa0, bf16x8& pa1, bf16x8& pa2, bf16x8& pa3) {
    for (int r = 0; r < 16; ++r) p1[r] = __builtin_amdgcn_exp2f(p1[r]);
    float ps = 0; for (int r = 0; r < 16; ++r) ps += p0[r]; for (int r = 0; r < 16; ++r) ps += p1[r];
    { auto rr = __builtin_amdgcn_permlane32_swap(__float_as_uint(ps), __float_as_uint(ps), false, false);
      ps = __uint_as_float(rr[0]) + __uint_as_float(rr[1]); }
    l_reg = l_reg * alpha + ps;
#define PK4(P, B_, OUT) do { unsigned a0 = cvtpk(P[B_+0], P[B_+1]), a1 = cvtpk(P[B_+2], P[B_+3]);                          \
        unsigned b0 = cvtpk(P[B_+4], P[B_+5]), b1 = cvtpk(P[B_+6], P[B_+7]);                                             \
        auto r0 = __builtin_amdgcn_permlane32_swap(a0, b0, false, false); auto r1 = __builtin_amdgcn_permlane32_swap(a1, b1, false, false); \
        u32x4 w = {r0[0], r1[0], r0[1], r1[1]}; OUT = *reinterpret_cast<bf16x8*>(&w); } while (0)
    PK4(p0, 0, pa0); PK4(p0, 8, pa1); PK4(p1, 0, pa2); PK4(p1, 8, pa3);
#undef PK4
}
template <int KB>
__device__ __forceinline__ void qkt(f32x16& p0, f32x16& p1, const char* K_lds, const float* bt, int r32, int hi, const bf16x8* qr) {
#pragma unroll
    for (int j = 0; j < 4; ++j) { const f32x4 a = *(const f32x4*)(bt + 8 * j), b = *(const f32x4*)(bt + 32 + 8 * j);
        p0[4 * j + 0] = a[0]; p0[4 * j + 1] = a[1]; p0[4 * j + 2] = a[2]; p0[4 * j + 3] = a[3];
        p1[4 * j + 0] = b[0]; p1[4 * j + 1] = b[1]; p1[4 * j + 2] = b[2]; p1[4 * j + 3] = b[3]; }
    const char* kb[4];
#pragma unroll
    for (int dd = 0; dd < 4; ++dd) kb[dd] = K_lds + KB * SHM_K + KSWZ(r32, (dd * 16 + hi * 8) * 2);
#pragma unroll
    for (int d0 = 0; d0 < 8; ++d0) { const char* a = kb[d0 & 3] + (d0 >> 2) * 128;
        bf16x8 b0 = *reinterpret_cast<const bf16x8*>(a);
        bf16x8 b1 = *reinterpret_cast<const bf16x8*>(a + 32 * 256);
        p0 = __builtin_amdgcn_mfma_f32_32x32x16_bf16(b0, qr[d0], p0, 0, 0, 0);
        p1 = __builtin_amdgcn_mfma_f32_32x32x16_bf16(b1, qr[d0], p1, 0, 0, 0); }
}
template <int VB>
__device__ __forceinline__ void pv_tile(f32x16* o, int vb0, bf16x8 pa0, bf16x8 pa1, bf16x8 pa2, bf16x8 pa3) {
#define TRRD(dst, off) asm volatile("ds_read_b64_tr_b16 %0, %1 offset:%2" : "=&v"(dst) : "v"(vb0), "i"(off) : "memory")
#define PV_D0(d0) do { s16x4 l0, l1, l2, l3, h0, h1, h2, h3; constexpr int b_ = VB * SHM_V + v_rd_off(d0, 0, 0);     \
        TRRD(l0, b_); TRRD(h0, b_ + 2048); TRRD(l1, b_ + 4096); TRRD(h1, b_ + 6144); TRRD(l2, b_ + 8192); TRRD(h2, b_ + 10240); TRRD(l3, b_ + 12288); TRRD(h3, b_ + 14336); \
        asm volatile("s_waitcnt lgkmcnt(0)" ::: "memory"); SBAR();                 \
        o[d0] = __builtin_amdgcn_mfma_f32_32x32x16_bf16(pa0, (bf16x8){l0[0], l0[1], l0[2], l0[3], h0[0], h0[1], h0[2], h0[3]}, o[d0], 0, 0, 0);   \
        o[d0] = __builtin_amdgcn_mfma_f32_32x32x16_bf16(pa1, (bf16x8){l1[0], l1[1], l1[2], l1[3], h1[0], h1[1], h1[2], h1[3]}, o[d0], 0, 0, 0);   \
        o[d0] = __builtin_amdgcn_mfma_f32_32x32x16_bf16(pa2, (bf16x8){l2[0], l2[1], l2[2], l2[3], h2[0], h2[1], h2[2], h2[3]}, o[d0], 0, 0, 0);   \
        o[d0] = __builtin_amdgcn_mfma_f32_32x32x16_bf16(pa3, (bf16x8){l3[0], l3[1], l3[2], l3[3], h3[0], h3[1], h3[2], h3[3]}, o[d0], 0, 0, 0); } while (0)
    PV_D0(0); PV_D0(1); PV_D0(2); PV_D0(3);
#undef PV_D0
#undef TRRD
}

struct BlockRef { const bf16* Q; const bf16* K; const bf16* V; bf16* O; const float* Bias; int P0; float THp; };
struct Seam { bf16x8 qr[8]; bf16x8 st_v0, st_v1, st_k0, st_k1; };
#define ROW(p, k0, rr) ((const bf16*)((const char*)(p) + (size_t)(k0) * (PITCH * 2) + (unsigned)(voff + (unsigned)(rr) * (PITCH * 2u))))
#define VMW() asm volatile("s_waitcnt vmcnt(0)" ::: "memory")
#define VMWN(n) asm volatile("s_waitcnt vmcnt(%0)" :: "i"(n) : "memory")
#define SLOAD_H(Kp, Vp, k0) do { S.st_v0 = load8(ROW(Vp, k0, 0)); S.st_v1 = load8(ROW(Vp, k0, 32));              \
                         S.st_k0 = load8(ROW(Kp, k0, 0)); S.st_k1 = load8(ROW(Kp, k0, 32)); } while (0)
#define SWRITE_HK(bf) do { *(bf16x8*)(K_lds + (bf) * SHM_K + kws) = S.st_k0; *(bf16x8*)(K_lds + (bf) * SHM_K + kws + 32 * 256) = S.st_k1; } while (0)
#define SWRITE_HV(bf) do { *(bf16x8*)(V_lds + (bf) * SHM_V + vst0) = S.st_v0; *(bf16x8*)(V_lds + (bf) * SHM_V + vst1) = S.st_v1; } while (0)
#define SWRITE_H(bf) do { SWRITE_HV(bf); SWRITE_HK(bf); } while (0)
__device__ __forceinline__ void fox_prime(const BlockRef& cur, char* lds, Seam& S, const int tid) {
    const int wid = __builtin_amdgcn_readfirstlane(tid >> 6), lane = tid & 63, r32 = lane & 31, hi = lane >> 5;
    const int sr = tid >> 4, sc = (tid & 15) * 8, kws = KSWZ(sr, sc * 2); char* K_lds = lds + 2 * SHM_V;
    const unsigned voff = (unsigned)(sr * PITCH + sc) * 2u, qoff = (unsigned)((wid * QBLK + r32) * PITCH + hi * 8) * 2u;
    for (int d0 = 0; d0 < 8; ++d0) S.qr[d0] = load8((const bf16*)((const char*)cur.Q + (qoff + d0 * 32)));
    (void)kws; (void)K_lds; (void)voff;
    __syncthreads();
}
template <class NextF>
__device__ __forceinline__ void fox_block(const BlockRef& cur, NextF& nextf, char* lds, Seam& S, const int tid) {
    const int wid = __builtin_amdgcn_readfirstlane(tid >> 6), lane = tid & 63, r32 = lane & 31, hi = lane >> 5;
    const int W = SKV;
    const int NTF = (cur.P0 + QB - 1) / KVBLK + 1;
    const int qlo = cur.P0 + wid * QBLK, qm = qlo + r32 - 4 * hi;
    char* V_lds = lds; char* K_lds = lds + 2 * SHM_V;
    float* ws = (float*)(lds + 2 * SHM_V + 2 * SHM_K) + wid * 64; float* li_l = ws, * al_l = ws + 32;
    float* biasL = (float*)(lds + BIAS_OFF);
    { const int nk = cur.P0 + QB;
      int t4 = tid * 4; asm volatile("" : "+v"(t4));
      f32x4 bv[4];
#pragma unroll
      for (int k = 0; k < 4; ++k) { const int i = t4 + k * (NW * 64 * 4); if (i < nk) bv[k] = *(const f32x4*)((const char*)cur.Bias + (unsigned)(i * 4)); }
#pragma unroll
      for (int k = 0; k < 4; ++k) { const int i = t4 + k * (NW * 64 * 4); if (i < nk) *(f32x4*)(biasL + i) = bv[k]; }
      __syncthreads(); }
    int j_lo; { int lo_ = 0, hi_ = cur.P0 / KVBLK; const float bref = biasL[cur.P0] - cur.THp;
        while (lo_ < hi_) { const int mid = (lo_ + hi_) >> 1; if (biasL[mid * KVBLK + KVBLK - 1] < bref) lo_ = mid + 1; else hi_ = mid; }
        j_lo = __builtin_amdgcn_readfirstlane(lo_); }
    const int NT = NTF - j_lo;
    const float* bl = biasL + 4 * hi;
    float m_reg = -1e30f, l_reg = 0; f32x16 o[4] = {};
    const int sr = tid >> 4, sc = (tid & 15) * 8, vst0 = v_st(sr, sc), vst1 = v_st(32 + sr, sc), kws = KSWZ(sr, sc * 2);
    const unsigned voff = (unsigned)(sr * PITCH + sc) * 2u, qoff = (unsigned)((wid * QBLK + r32) * PITCH + hi * 8) * 2u;
    const int vb0 = (int)(uintptr_t)V_lds + v_rd_base(lane);
    const bf16* Kh = cur.K; const bf16* Vh = cur.V;
#define RESC(a) do { if (__any((a) < 1.f)) { if (hi == 0) al_l[r32] = (a); asm volatile("s_waitcnt lgkmcnt(0)" ::: "memory");              \
                     for (int d_ = 0; d_ < 4; ++d_) for (int r = 0; r < 16; ++r) o[d_][r] *= al_l[crow(r, hi)]; } } while (0)
#define KBASE(t) ((j_lo + (NT - 1 - (t))) * KVBLK)
#define MASKT(P0_, P1_, t) do { const int kb_ = KBASE(t); if (kb_ + KVBLK - 1 > qlo) mask_tile(P0_, P1_, qm - kb_, (unsigned)W); } while (0)
    constexpr int NQL = 8;
#define SEAM_K0() do { VMWN(NQL); SWRITE_HK(0); SBAR(); } while (0)
    f32x16 pA0, pA1, pB0, pB1; float mnA, mnB, alA, alB; bf16x8 pa0, pa1, pa2, pa3;
    SLOAD_H(Kh, Vh, KBASE(0)); VMW(); SWRITE_HK(0); SWRITE_HV(0); __syncthreads();
    SBAR();
    if (NT > 1) { SLOAD_H(Kh, Vh, KBASE(1)); }
    SBAR(); qkt<0>(pA0, pA1, K_lds, bl + KBASE(0), r32, hi, S.qr);
    MASKT(pA0, pA1, 0); partialSM(pA0, pA1, m_reg, mnA, alA);
    if (NT > 1) { VMW(); SWRITE_H(1); if (NT > 2) SLOAD_H(Kh, Vh, KBASE(2)); }
    __syncthreads();
#define HALF_STEP(PX0, PX1, mnX, alX, PY0, PY1, alY, t, KB, VB, SB) do {                                                      \
        SBAR(); qkt<KB>(PX0, PX1, K_lds, bl + KBASE(t), r32, hi, S.qr);                                             \
        finishSM(PY0, PY1, alY, l_reg, pa0, pa1, pa2, pa3); SBAR();                                                           \
        pv_tile<VB>(o, vb0, pa0, pa1, pa2, pa3); MASKT(PX0, PX1, (t)); partialSM(PX0, PX1, m_reg, mnX, alX);                                        \
        __syncthreads();                                                                                                      \
        if ((t) + 1 < NT) { VMW(); SWRITE_H(SB); if ((t) + 2 < NT) SLOAD_H(Kh, Vh, KBASE((t) + 2)); }                               \
        RESC(alX); __syncthreads(); } while (0)
    for (int t = 1; t + 1 < NT; t += 2) {
        HALF_STEP(pB0, pB1, mnB, alB, pA0, pA1, alA, t, 1, 0, 0);
        HALF_STEP(pA0, pA1, mnA, alA, pB0, pB1, alB, t + 1, 0, 1, 1);
    }
    const bool even = (NT & 1) == 0;
    if (even) { SBAR(); qkt<1>(pB0, pB1, K_lds, bl + KBASE(NT - 1), r32, hi, S.qr); SBAR(); }
    const bf16* nxtQ = nextf();
#pragma unroll
    for (int d0 = 0; d0 < 8; ++d0) S.qr[d0] = load8((const bf16*)((const char*)nxtQ + (qoff + d0 * 32)));
    SBAR();
    finishSM(pA0, pA1, alA, l_reg, pa0, pa1, pa2, pa3); SBAR();
    pv_tile<0>(o, vb0, pa0, pa1, pa2, pa3);
    if (even) { MASKT(pB0, pB1, NT - 1); partialSM(pB0, pB1, m_reg, mnB, alB); __syncthreads(); RESC(alB);
        finishSM(pB0, pB1, alB, l_reg, pa0, pa1, pa2, pa3); SBAR(); pv_tile<1>(o, vb0, pa0, pa1, pa2, pa3); }
    SBAR();
    if (hi == 0) li_l[r32] = l_reg; asm volatile("s_waitcnt lgkmcnt(0)" ::: "memory");
    float rli[16];
#pragma unroll
    for (int r = 0; r < 16; ++r) rli[r] = __builtin_amdgcn_rcpf(li_l[crow(r, hi)]);
    char* Ow = (char*)cur.O; const unsigned ooff = (unsigned)((wid * QBLK + 4 * hi) * OPITCH + r32) * 2u;
    const char* Gq = (const char*)cur.Q + GATE_OFF * 2; const unsigned goff = (unsigned)((wid * QBLK + 4 * hi) * PITCH + r32) * 2u;
    unsigned short gq[16][4];
#pragma unroll
    for (int r = 0; r < 16; ++r)
#pragma unroll
        for (int d0 = 0; d0 < 4; ++d0) gq[r][d0] = *(const unsigned short*)(Gq + (goff + (unsigned)(((r & 3) + 8 * (r >> 2)) * PITCH + d0 * 32) * 2u));
#pragma unroll
    for (int r = 0; r < 16; ++r) {
#pragma unroll
        for (int d0 = 0; d0 < 4; ++d0) { const unsigned short gw = gq[r][d0];
            const float gl = __builtin_bit_cast(float, (unsigned)gw << 16);
            const float v = o[d0][r] * rli[r] * __builtin_amdgcn_rcpf(1.0f + __builtin_amdgcn_exp2f(-1.4426950408889634f * gl));
            const float vn = xor1_get(v);
            if ((r32 & 1) == 0) *(unsigned*)(Ow + (ooff + (unsigned)(((r & 3) + 8 * (r >> 2)) * OPITCH + d0 * 32) * 2u)) = cvtpk(v, vn); } }
    __syncthreads();
#undef RESC
#undef KBASE
#undef MASKT
#undef SEAM_K0
#undef HALF_STEP
}
#undef ROW
#undef VMW
#undef VMWN
#undef SLOAD_H
#undef SWRITE_HK
#undef SWRITE_HV
#undef SWRITE_H
#undef KSWZ
#undef SBAR
}

constexpr int NWAVES = 8, NTHREADS = NWAVES * 64;
constexpr int DM = 2048, BATCH = 2, T = 8192, M = BATCH * T, DEPTH = 4;
constexpr int AB_IN = 8200, AB_N = 8192;
constexpr int C_IN = 6160, C_N = 6144;
constexpr int FF = 5632, FF2 = 2 * FF;
constexpr float EPS = 1e-6f;
enum PhaseKind { K_NORM1 = 0, K_MIXIN, K_PREP, K_REC, K_POST, K_MIXOUT, K_NORM2, K_FFIN, K_FFOUT, K_PRO };
constexpr int phase_base(int layer) { return 1 + 9 * layer; }
constexpr int N_PHASES = phase_base(DEPTH);
constexpr int CW_QUEUE = 8192;
inline int phase_kind(int p, int& layer) { if (p == 0) { layer = 0; return K_PRO; } for (layer = DEPTH - 1; phase_base(layer) > p; --layer) {} return p - phase_base(layer); }
constexpr size_t MiB = 1u << 20;
constexpr size_t WS_CTL = 0, CTL_ZERO_BYTES = 1 * MiB;
constexpr size_t WS_MOD = 1 * MiB;
constexpr size_t WS_LOGF = 2 * MiB;
constexpr size_t WS_BIAS = 3 * MiB;
constexpr size_t WS_GLOW = 4 * MiB;
constexpr size_t WS_W_ABIN = 8 * MiB, WS_W_ABOUT = 72 * MiB, WS_W_GLIN = 88 * MiB, WS_W_GLOUT = 136 * MiB, WS_W_FFIN = 152 * MiB, WS_W_FFOUT = 328 * MiB;
constexpr size_t WS_H = 416 * MiB, WS_CAT = 480 * MiB, WS_PROJ = 544 * MiB, WS_FFH = WS_PROJ, WS_O = 800 * MiB, WS_REC = 928 * MiB, WS_Y = 1064 * MiB, WS_XB = 1128 * MiB, WS_END = 1192 * MiB;
constexpr int CW_BAR = 4096;
constexpr int CW_CONV = 16384;
constexpr int RING_OFF = 0, RING_BYTES = 139264;
constexpr int LDSCTL_OFF = RING_BYTES, MISC_OFF = LDSCTL_OFF + 320;
constexpr int LDS_BYTES = 155648;
static_assert(fox::LDS_BYTES <= RING_BYTES, "attention LDS");

#define GAS __attribute__((address_space(1)))
#define LAS __attribute__((address_space(3)))
typedef unsigned short bf16;
typedef unsigned v4u __attribute__((ext_vector_type(4)));
typedef unsigned v2u __attribute__((ext_vector_type(2)));
typedef float f32x4 __attribute__((ext_vector_type(4)));
typedef GAS unsigned gu32;
#define RLX_AGENT __ATOMIC_RELAXED, __HIP_MEMORY_SCOPE_AGENT
#define LDS_WAIT() asm volatile("s_waitcnt lgkmcnt(0)" ::: "memory")
__device__ __forceinline__ unsigned pk2(float lo, float hi) { unsigned r; asm("v_cvt_pk_bf16_f32 %0, %1, %2" : "=v"(r) : "v"(lo), "v"(hi)); return r; }
__device__ __forceinline__ unsigned f2bf(float f) { return pk2(f, f) & 0xffffu; }
__device__ __forceinline__ float bf_lo(unsigned w) { return __builtin_bit_cast(float, w << 16); }
__device__ __forceinline__ float bf_hi(unsigned w) { return __builtin_bit_cast(float, w & 0xffff0000u); }
__device__ __forceinline__ float bf1(bf16 h) { return __builtin_bit_cast(float, (unsigned)h << 16); }
__device__ __forceinline__ float sigmoid_f(float x) { return __builtin_amdgcn_rcpf(1.0f + __expf(-x)); }
__device__ __forceinline__ float silu_x(float x) { return x * __builtin_amdgcn_rcpf(1.0f + __expf(-x)); }
__device__ __forceinline__ float log_sigmoid_f(float x) { return fminf(x, 0.f) - log1pf(__expf(-fabsf(x))); }
__device__ __forceinline__ float log_sigmoid_fast(float x) { return fminf(x, 0.f) - __logf(1.0f + __expf(-fabsf(x))); }
__device__ __forceinline__ float wave_sum(float v) {
    v = xsum<1>(v); v = xsum<2>(v); v = xsum<4>(v); v = xsum<8>(v); v = xsum<16>(v); v = xsum<32>(v);
    return v;
}

#define XB_TMO      128
#define XB_XCNT(j)  (256  + 64 * (j))
#define XB_XSUB(j)  (1280 + 64 * (j))
#define XB_XGEN(j)  (2304 + 64 * (j))
#define XB_TOP      3328
#define XB_TOPGEN   3392
#define XCD_BAR_WORDS 3456
#define XB_SPIN_CAP (1u << 18)
__device__ __forceinline__ unsigned xb_ld(unsigned* p)              { return __hip_atomic_load(p, __ATOMIC_RELAXED, __HIP_MEMORY_SCOPE_AGENT); }
__device__ __forceinline__ unsigned xb_add(unsigned* p, unsigned v) { return __hip_atomic_fetch_add(p, v, __ATOMIC_RELAXED, __HIP_MEMORY_SCOPE_AGENT); }
__device__ __forceinline__ unsigned xb_xcc_id() { return (unsigned)__builtin_amdgcn_s_getreg((3 << 11) | 20) & 0xFu; }
#define XB_SPIN(cond, bar) do { unsigned _sp = 0; while (cond) { __builtin_amdgcn_s_sleep(1); \
    if ((++_sp & 255u) == 0u) { if (xb_ld(&(bar)[XB_TMO])) break; if (_sp > XB_SPIN_CAP) { atomicAdd(&(bar)[XB_TMO], 1u); break; } } } } while (0)
struct XcdBarrier { unsigned* bar; unsigned x; volatile LAS unsigned* st; };
__device__ __forceinline__ XcdBarrier xcd_barrier_post(unsigned* bar, volatile LAS unsigned* st, bool tid0) {
    XcdBarrier b; b.bar = bar; b.x = xb_xcc_id(); b.st = st;
    if (tid0) (void)xb_add(&bar[XB_XCNT(b.x)], 1u);
    return b;
}
__device__ __forceinline__ void xcd_barrier_complete(unsigned* bar, unsigned x, unsigned& nloc, unsigned& nx) {
    const unsigned G = gridDim.x * gridDim.y * gridDim.z;
    unsigned sum, cnt, mine, sp = 0u;
    for (;;) {
        sum = 0u; cnt = 0u; mine = 0u;
#pragma unroll
        for (unsigned j = 0; j < 16; ++j) { const unsigned c = xb_ld(&bar[XB_XCNT(j)]); sum += c; cnt += (c > 0u) ? 1u : 0u; mine = (j == x) ? c : mine; }
        if (sum == G) break;
        __builtin_amdgcn_s_sleep(1);
        if ((++sp & 255u) == 0u) { if (xb_ld(&bar[XB_TMO])) break; if (sp > XB_SPIN_CAP) { atomicAdd(&bar[XB_TMO], 1u); break; } }
    }
    nloc = mine > 0u ? mine : 1u; nx = cnt > 0u ? cnt : 1u;
}
template <bool FIRST>
__device__ __forceinline__ void xcd_barrier(const XcdBarrier& b, bool tid0) {
    asm volatile("s_waitcnt vmcnt(0)" ::: "memory");
    __syncthreads();
    if (tid0) {
        unsigned* bar = b.bar;
        __builtin_amdgcn_s_waitcnt(0);
        unsigned nloc = b.st[0], nx = b.st[1];
        if (FIRST) { if (nloc == 0u) { xcd_barrier_complete(bar, b.x, nloc, nx); b.st[0] = nloc; b.st[1] = nx; } }
        else { if (nloc == 0u) nloc = 1u; if (nx == 0u) nx = 1u; }
        const unsigned old = xb_add(&bar[XB_XSUB(b.x)], 1u);
        const unsigned gen = old / nloc;
        if (old + 1u == (gen + 1u) * nloc) {
            __builtin_amdgcn_fence(__ATOMIC_RELEASE, "agent");
            asm volatile("s_waitcnt vmcnt(0)" ::: "memory");
            const unsigned og = xb_add(&bar[XB_TOP], 1u);
            const unsigned tg = og / nx;
            if (og + 1u == (tg + 1u) * nx) xb_add(&bar[XB_TOPGEN], 1u);
            else XB_SPIN(xb_ld(&bar[XB_TOPGEN]) == tg, bar);
            __builtin_amdgcn_fence(__ATOMIC_ACQUIRE, "agent");
            xb_add(&bar[XB_XGEN(b.x)], 1u);
            asm volatile("s_waitcnt vmcnt(0)" ::: "memory");
        } else {
            XB_SPIN(xb_ld(&bar[XB_XGEN(b.x)]) == gen, bar);
            __builtin_amdgcn_fence(__ATOMIC_ACQUIRE, "agent");
            asm volatile("s_waitcnt vmcnt(0)" ::: "memory");
        }
    }
    __syncthreads();
}

struct Args { const float* in[20]; float* out; unsigned char* ws; int ph_lo, ph_hi, use_bar, pad; };
typedef const Args __attribute__((address_space(4))) CArgs;
__device__ __forceinline__ CArgs* opq_args() { CArgs* p = (CArgs*)__builtin_amdgcn_kernarg_segment_ptr(); asm volatile("" : "+s"(p)); return p; }
struct Frame {
    LAS unsigned char* lds;
    int tid, lane, wave, G, bid;
};

__device__ __forceinline__ void transpose_item(const float* W, int ldn, int K, bf16* WT, int k0, int n0, int drow0, LAS float* scr, int lane) {
    f32x4 v[16];
    const float* src = W + (size_t)(k0 + (lane >> 4)) * ldn + n0 + 4 * (lane & 15);
#pragma unroll
    for (int i = 0; i < 16; ++i) v[i] = *(const f32x4*)(src + (size_t)(4 * i) * ldn);
#pragma unroll
    for (int i = 0; i < 16; ++i) { LAS float* d = scr + (4 * i + (lane >> 4)) * 65 + 4 * (lane & 15); d[0] = v[i].x; d[1] = v[i].y; d[2] = v[i].z; d[3] = v[i].w; }
    LDS_WAIT(); asm volatile("" ::: "memory");
    const int c = lane & 7, r = lane >> 3;
#pragma unroll
    for (int j = 0; j < 8; ++j) { const int n = r + 8 * j; const LAS float* s = scr + (8 * c) * 65 + n;
        v4u o; o.x = pg8::cvt_pk_bf16(s[0 * 65], s[1 * 65]); o.y = pg8::cvt_pk_bf16(s[2 * 65], s[3 * 65]); o.z = pg8::cvt_pk_bf16(s[4 * 65], s[5 * 65]); o.w = pg8::cvt_pk_bf16(s[6 * 65], s[7 * 65]);
        *(GAS v4u*)(WT + (size_t)(drow0 + n) * K + k0 + 8 * c) = o; }
    LDS_WAIT(); asm volatile("" ::: "memory");
}
template <int MODE>
__device__ __forceinline__ void transpose_matrix(const float* W, int nmat, int K, int ldn, int ncols, bf16* WT, LAS float* scr, int gw, int NGW, int lane, unsigned* ctr = nullptr, int wave = 0, bool tid0 = false, volatile LAS unsigned* slot = nullptr) {
    const int nblk = ncols / 64, kblk = K / 64, per = nblk * kblk, total = per * nmat;
#define TM_ITEM(it) do { const int mat = (it) / per, r = (it) - mat * per, kb = r / nblk, nb = r - kb * nblk, n0 = 64 * nb; int drow0 = n0; \
        if (MODE == 1) { if (n0 < FF) drow0 = (n0 / 128) * 256 + (n0 % 128); else { const int n1 = n0 - FF; drow0 = (n1 / 128) * 256 + 128 + (n1 % 128); } } \
        if (MODE == 2) drow0 = n0 < 3072 ? n0 : (n0 < 4096 ? n0 + 4096 : n0 - 1024); \
        transpose_item(W + (size_t)mat * K * ldn, ldn, K, WT + (size_t)mat * ncols * K, 64 * kb, n0, drow0, scr, lane); } while (0)
    if (ctr == nullptr) { for (int it = gw; it < total; it += NGW) TM_ITEM(it); }
    else {
        unsigned pend = 0u; if (tid0) pend = __hip_atomic_fetch_add(ctr, 16u, __ATOMIC_RELAXED, __HIP_MEMORY_SCOPE_AGENT);
        for (;;) {
            if (tid0) *slot = pend;
            __syncthreads();
            const int base = __builtin_amdgcn_readfirstlane((int)*slot);
            __syncthreads();
            if (base >= total) break;
            if (tid0) pend = __hip_atomic_fetch_add(ctr, 16u, __ATOMIC_RELAXED, __HIP_MEMORY_SCOPE_AGENT);
#pragma unroll 1
            for (int k = 0; k < 2; ++k) { const int it = base + 8 * k + wave; if (it < total) TM_ITEM(it); } } }
#undef TM_ITEM
}
template <int SET>
__device__ __forceinline__ void convert_weights(CArgs* ap, LAS float* scr, int gw, int NGW, int lane, unsigned* ctr = nullptr, int wave = 0, bool tid0 = false, volatile LAS unsigned* slot = nullptr) {
#define CWC(k) (ctr ? ctr + 64 * (k) : nullptr), wave, tid0, slot
    unsigned char* ws = ap->ws;
    bf16* abin = (bf16*)(ws + WS_W_ABIN); bf16* about = (bf16*)(ws + WS_W_ABOUT); bf16* glin = (bf16*)(ws + WS_W_GLIN); bf16* glout = (bf16*)(ws + WS_W_GLOUT); bf16* ffin = (bf16*)(ws + WS_W_FFIN); bf16* ffout = (bf16*)(ws + WS_W_FFOUT);
    constexpr size_t S_ABIN_W = (size_t)DM * AB_IN, S_ABIN_T = (size_t)AB_N * DM, S_SQ = (size_t)DM * DM, S_GLIN_W = (size_t)DM * C_IN, S_GLIN_T = (size_t)C_N * DM, S_FFIN = (size_t)DM * FF2, S_FFOUT = (size_t)FF * DM;
    if (SET == 0) {
        transpose_matrix<2>(ap->in[6], 1, DM, AB_IN, AB_N, abin, scr, gw, NGW, lane);
        transpose_matrix<0>(ap->in[7], 1, DM, DM, DM, about, scr, gw, NGW, lane);
        transpose_matrix<1>(ap->in[18], 1, DM, FF2, FF2, ffin, scr, gw, NGW, lane);
        transpose_matrix<0>(ap->in[19], 1, FF, DM, DM, ffout, scr, gw, NGW, lane);
        transpose_matrix<0>(ap->in[13], 1, DM, C_IN, C_N, glin, scr, gw, NGW, lane);
    } else if (SET == 1) {
        transpose_matrix<0>(ap->in[17], 1, DM, DM, DM, glout, scr, gw, NGW, lane, CWC(0));
        transpose_matrix<1>(ap->in[18] + S_FFIN, 2, DM, FF2, FF2, ffin + S_FFIN, scr, gw, NGW, lane, CWC(1));
        transpose_matrix<0>(ap->in[19] + S_FFOUT, 2, FF, DM, DM, ffout + S_FFOUT, scr, gw, NGW, lane, CWC(2));
        transpose_matrix<2>(ap->in[6] + S_ABIN_W, 1, DM, AB_IN, AB_N, abin + S_ABIN_T, scr, gw, NGW, lane, CWC(3));
        transpose_matrix<0>(ap->in[7] + S_SQ, 1, DM, DM, DM, about + S_SQ, scr, gw, NGW, lane, CWC(4));
        transpose_matrix<0>(ap->in[13] + S_GLIN_W, 1, DM, C_IN, C_N, glin + S_GLIN_T, scr, gw, NGW, lane, CWC(5));
    } else {
        transpose_matrix<0>(ap->in[17] + S_SQ, 1, DM, DM, DM, glout + S_SQ, scr, gw, NGW, lane, CWC(8));
        transpose_matrix<1>(ap->in[18] + 3 * S_FFIN, 1, DM, FF2, FF2, ffin + 3 * S_FFIN, scr, gw, NGW, lane, CWC(9));
        transpose_matrix<0>(ap->in[19] + 3 * S_FFOUT, 1, FF, DM, DM, ffout + 3 * S_FFOUT, scr, gw, NGW, lane, CWC(10));
    }
#undef CWC
}
__device__ __forceinline__ void p0_prologue(Frame& F, CArgs* ap) {
    unsigned char* ws = ap->ws;
    {
        LAS float* sc = (LAS float*)(F.lds);
        LAS float* part = (LAS float*)(F.lds + 16384);
        const float* c = ap->in[1];
        for (int i = F.tid; i < 2 * DM; i += NTHREADS) sc[i] = silu_x(c[i]);
        __syncthreads();
        const float* mw = ap->in[2]; const float* mb = ap->in[3]; float* mod = (float*)(ws + WS_MOD);
        constexpr int NU = DEPTH * (6 * DM / 64);
        for (int u = F.bid; u < NU; u += F.G) {
            const int layer = u / (6 * DM / 64), colb = (u % (6 * DM / 64)) * 64, kk = F.lane >> 4, c4 = F.lane & 15;
            const float* wp = mw + ((size_t)layer * DM + F.wave * 256 + kk) * (6 * DM) + colb + 4 * c4;
            f32x4 a0 = {0.f, 0.f, 0.f, 0.f}, a1 = {0.f, 0.f, 0.f, 0.f};
            for (int i0 = 0; i0 < 64; i0 += 16) { f32x4 wv[16];
#pragma unroll
                for (int i = 0; i < 16; ++i) wv[i] = *(const f32x4*)(wp + (size_t)(4 * (i0 + i)) * (6 * DM));
#pragma unroll
                for (int i = 0; i < 16; ++i) { const int k = F.wave * 256 + 4 * (i0 + i) + kk; a0 = a0 + wv[i] * sc[k]; a1 = a1 + wv[i] * sc[DM + k]; } }
            a0.x = xsum<16>(a0.x); a0.x = xsum<32>(a0.x); a0.y = xsum<16>(a0.y); a0.y = xsum<32>(a0.y); a0.z = xsum<16>(a0.z); a0.z = xsum<32>(a0.z); a0.w = xsum<16>(a0.w); a0.w = xsum<32>(a0.w);
            a1.x = xsum<16>(a1.x); a1.x = xsum<32>(a1.x); a1.y = xsum<16>(a1.y); a1.y = xsum<32>(a1.y); a1.z = xsum<16>(a1.z); a1.z = xsum<32>(a1.z); a1.w = xsum<16>(a1.w); a1.w = xsum<32>(a1.w);
            if (F.lane < 16) { *(LAS f32x4*)(part + (F.wave * 2 + 0) * 64 + 4 * c4) = a0; *(LAS f32x4*)(part + (F.wave * 2 + 1) * 64 + 4 * c4) = a1; }
            __syncthreads();
            if (F.tid < 128) { const int b = F.tid >> 6, l = F.tid & 63; float s = 0.f;
#pragma unroll
                for (int w = 0; w < 8; ++w) s += part[(w * 2 + b) * 64 + l];
                const int cc = (u % (6 * DM / 64)) * 64 + l;
                mod[((size_t)layer * 2 + b) * (6 * DM) + cc] = s + mb[(size_t)layer * (6 * DM) + cc]; }
            __syncthreads();
        }
    }
    __syncthreads();
    LAS float* scr = (LAS float*)(F.lds + RING_OFF + F.wave * 16640);
    const int gw = F.bid * NWAVES + F.wave, NGW = F.G * NWAVES;
    convert_weights<0>(ap, scr, gw, NGW, F.lane);
}

template <int MASK> __device__ __forceinline__ float xget(float v) { return __builtin_bit_cast(float, __builtin_amdgcn_ds_swizzle(__builtin_bit_cast(int, v), (MASK << 10) | 0x1f)); }
template <int N> __device__ __forceinline__ float rs_reduce(float (&a)[N], int lane) {
    if (N == 16) {
#pragma unroll
        for (int i = 0; i < 8; ++i) { const bool up = lane & 1; const float keep = up ? a[i + 8] : a[i], send = up ? a[i] : a[i + 8]; a[i] = keep + xget<1>(send); } }
    if (N >= 8) {
#pragma unroll
        for (int i = 0; i < 4; ++i) { const bool up = lane & (N == 16 ? 2 : 1); const float keep = up ? a[i + 4] : a[i], send = up ? a[i] : a[i + 4]; a[i] = keep + (N == 16 ? xget<2>(send) : xget<1>(send)); } }
#pragma unroll
    for (int i = 0; i < 2; ++i) { const bool up = lane & (N == 16 ? 4 : 2); const float keep = up ? a[i + 2] : a[i], send = up ? a[i] : a[i + 2]; a[i] = keep + (N == 16 ? xget<4>(send) : xget<2>(send)); }
    { const bool up = lane & (N == 16 ? 8 : 4); const float keep = up ? a[1] : a[0], send = up ? a[0] : a[1]; a[0] = keep + (N == 16 ? xget<8>(send) : xget<4>(send)); }
    float r = a[0];
    if (N == 8) r = xsum<8>(r);
    r = xsum<16>(r); r = xsum<32>(r);
    return r;
}
template <int N> __device__ __forceinline__ int rs_col(int lane) { return N == 16 ? (((lane & 1) << 3) | ((lane & 2) << 1) | ((lane & 4) >> 1) | ((lane & 8) >> 3)) : (((lane & 1) << 2) | (lane & 2) | ((lane & 4) >> 2)); }
template <int NC, int MODE, bool RES, bool XF32>
__device__ __forceinline__ void norm_phase(Frame& F, const void* xin, const float* gain, const float* mod_sh, const float* mod_sc  ,
                                           bf16* hout, const float* Wsm, int ldn, const float* fbias, float* sout, const bf16* yres = nullptr, const float* rgate = nullptr, bf16* xb = nullptr) {
    LAS float* wl = (LAS float*)(F.lds);
    if (NC > 0) {
        for (int i = F.tid; i < NC * DM; i += NTHREADS) { const int k = i / NC, c = i % NC; wl[c * DM + k] = Wsm[(size_t)k * ldn + c]; }
        __syncthreads();
    }
    f32x4 gm[8], shv[8]; int bprev = -1;
    for (int mp = F.bid * NWAVES + F.wave; mp < M / 2; mp += F.G * NWAVES) {
        const int m0 = 2 * mp, b = m0 / T;
        if (b != bprev) { bprev = b; const f32x4* gp = (const f32x4*)gain + F.lane; const f32x4* shp = (const f32x4*)(mod_sh + (size_t)b * 6 * DM) + F.lane; const f32x4* scp = (const f32x4*)(mod_sc + (size_t)b * 6 * DM) + F.lane;
#pragma unroll
            for (int j = 0; j < 8; ++j) { gm[j] = gp[64 * j] * (scp[64 * j] + 1.0f); shv[j] = shp[64 * j]; } }
        f32x4 v[2][8]; float s0 = 0.f, s1 = 0.f;
        v2u yv[2][8];
        if (RES) { const GAS v2u* yr = (const GAS v2u*)(yres + (size_t)m0 * DM) + F.lane;
#pragma unroll
            for (int j = 0; j < 8; ++j) { yv[0][j] = yr[64 * j]; yv[1][j] = yr[512 + 64 * j]; } }
        if (XF32) { const GAS f32x4* xr = (const GAS f32x4*)((const float*)xin + (size_t)m0 * DM) + F.lane;
#pragma unroll
            for (int j = 0; j < 8; ++j) { v[0][j] = xr[64 * j]; v[1][j] = xr[512 + 64 * j]; } }
        else { const GAS v2u* xr = (const GAS v2u*)((const bf16*)xin + (size_t)m0 * DM) + F.lane; v2u xv[2][8];
#pragma unroll
            for (int j = 0; j < 8; ++j) { xv[0][j] = xr[64 * j]; xv[1][j] = xr[512 + 64 * j]; }
#pragma unroll
            for (int j = 0; j < 8; ++j) { v[0][j] = (f32x4){bf_lo(xv[0][j].x), bf_hi(xv[0][j].x), bf_lo(xv[0][j].y), bf_hi(xv[0][j].y)}; v[1][j] = (f32x4){bf_lo(xv[1][j].x), bf_hi(xv[1][j].x), bf_lo(xv[1][j].y), bf_hi(xv[1][j].y)}; } }
        if (RES) { const f32x4* rg = (const f32x4*)(rgate + (size_t)b * 6 * DM) + F.lane; GAS v2u* xo = (GAS v2u*)(xb + (size_t)m0 * DM) + F.lane;
#pragma unroll
            for (int j = 0; j < 8; ++j) { const f32x4 g = rg[64 * j];
                v[0][j] = v[0][j] + g * (f32x4){bf_lo(yv[0][j].x), bf_hi(yv[0][j].x), bf_lo(yv[0][j].y), bf_hi(yv[0][j].y)}; v[1][j] = v[1][j] + g * (f32x4){bf_lo(yv[1][j].x), bf_hi(yv[1][j].x), bf_lo(yv[1][j].y), bf_hi(yv[1][j].y)};
                v2u w; w.x = pk2(v[0][j].x, v[0][j].y); w.y = pk2(v[0][j].z, v[0][j].w); xo[64 * j] = w;
                w.x = pk2(v[1][j].x, v[1][j].y); w.y = pk2(v[1][j].z, v[1][j].w); xo[512 + 64 * j] = w; } }
#pragma unroll
        for (int j = 0; j < 8; ++j) { s0 += (v[0][j].x * v[0][j].x + v[0][j].y * v[0][j].y) + (v[0][j].z * v[0][j].z + v[0][j].w * v[0][j].w);
                                      s1 += (v[1][j].x * v[1][j].x + v[1][j].y * v[1][j].y) + (v[1][j].z * v[1][j].z + v[1][j].w * v[1][j].w); }
        const float rstd0 = __builtin_amdgcn_rsqf(wave_sum(s0) * (1.f / DM) + EPS), rstd1 = __builtin_amdgcn_rsqf(wave_sum(s1) * (1.f / DM) + EPS);
        GAS v2u* o8 = (GAS v2u*)(hout + (size_t)m0 * DM) + F.lane;
#pragma unroll
        for (int j = 0; j < 8; ++j) { const f32x4 g = gm[j], sh = shv[j];
            v[0][j] = (v[0][j] * rstd0) * g + sh; v[1][j] = (v[1][j] * rstd1) * g + sh;
            v2u w; w.x = pk2(v[0][j].x, v[0][j].y); w.y = pk2(v[0][j].z, v[0][j].w); o8[64 * j] = w;
            w.x = pk2(v[1][j].x, v[1][j].y); w.y = pk2(v[1][j].z, v[1][j].w); o8[512 + 64 * j] = w; }
        if constexpr (NC > 0) {
            float a0[NC], a1[NC];
#pragma unroll
            for (int c = 0; c < NC; ++c) { float acc0 = 0.f, acc1 = 0.f;
#pragma unroll
                for (int j = 0; j < 8; ++j) { const f32x4 w = *(const LAS f32x4*)(wl + c * DM + 256 * j + 4 * F.lane);
                    acc0 += (v[0][j].x * w.x + v[0][j].y * w.y) + (v[0][j].z * w.z + v[0][j].w * w.w); acc1 += (v[1][j].x * w.x + v[1][j].y * w.y) + (v[1][j].z * w.z + v[1][j].w * w.w); }
                a0[c] = acc0; a1[c] = acc1; __builtin_amdgcn_sched_barrier(0); }
            const float r0 = rs_reduce<NC>(a0, F.lane), r1 = rs_reduce<NC>(a1, F.lane); const int cc = rs_col<NC>(F.lane);
            if (MODE == 1) { const int t = m0 % T; if (F.lane < NC) { const float fb = fbias[cc]; sout[((size_t)b * 8 + cc) * T + t] = log_sigmoid_f(r0 + fb); sout[((size_t)b * 8 + cc) * T + t + 1] = log_sigmoid_f(r1 + fb); } }
            if (MODE == 2) { if (F.lane < NC) { sout[(size_t)m0 * 16 + cc] = r0; sout[(size_t)m0 * 16 + 16 + cc] = r1; } }
        }
    }
}

__device__ __forceinline__ void resid_final(Frame& F, const bf16* xb, const bf16* yres, const float* rgate, float* xout) {
    for (int mp = F.bid * NWAVES + F.wave; mp < M / 2; mp += F.G * NWAVES) {
        const int m0 = 2 * mp, b = m0 / T;
        const GAS v2u* xr = (const GAS v2u*)(xb + (size_t)m0 * DM) + F.lane; const GAS v2u* yr = (const GAS v2u*)(yres + (size_t)m0 * DM) + F.lane;
        const f32x4* rg = (const f32x4*)(rgate + (size_t)b * 6 * DM) + F.lane; GAS f32x4* xo = (GAS f32x4*)(xout + (size_t)m0 * DM) + F.lane;
        v2u xv[2][8], yv[2][8];
#pragma unroll
        for (int j = 0; j < 8; ++j) { xv[0][j] = xr[64 * j]; xv[1][j] = xr[512 + 64 * j]; yv[0][j] = yr[64 * j]; yv[1][j] = yr[512 + 64 * j]; }
#pragma unroll
        for (int j = 0; j < 8; ++j) { const f32x4 g = rg[64 * j];
            xo[64 * j] = (f32x4){bf_lo(xv[0][j].x), bf_hi(xv[0][j].x), bf_lo(xv[0][j].y), bf_hi(xv[0][j].y)} + g * (f32x4){bf_lo(yv[0][j].x), bf_hi(yv[0][j].x), bf_lo(yv[0][j].y), bf_hi(yv[0][j].y)};
            xo[512 + 64 * j] = (f32x4){bf_lo(xv[1][j].x), bf_hi(xv[1][j].x), bf_lo(xv[1][j].y), bf_hi(xv[1][j].y)} + g * (f32x4){bf_lo(yv[1][j].x), bf_hi(yv[1][j].x), bf_lo(yv[1][j].y), bf_hi(yv[1][j].y)}; }
    }
}

__device__ __forceinline__ void fox_prep(Frame& F, bf16* proj, const float* qg, const float* kg, const float* logf, float* bias) {
    const int gw = F.bid * NWAVES + F.wave, NGW = F.G * NWAVES;
    const f32x4 gq0 = *(const f32x4*)(qg + (F.lane & 15) * 8), gq1 = *(const f32x4*)(qg + (F.lane & 15) * 8 + 4), gk0 = *(const f32x4*)(kg + (F.lane & 15) * 8), gk1 = *(const f32x4*)(kg + (F.lane & 15) * 8 + 4);
    for (int m = gw; m < M; m += NGW) {
        GAS v4u* p = (GAS v4u*)(proj + (size_t)m * AB_N + 3072) + F.lane;
        v4u wv[4];
#pragma unroll
        for (int j = 0; j < 4; ++j) wv[j] = p[64 * j];
#pragma unroll
        for (int j = 0; j < 4; ++j) {
            const v4u w = wv[j];
            float e[8] = {bf_lo(w.x), bf_hi(w.x), bf_lo(w.y), bf_hi(w.y), bf_lo(w.z), bf_hi(w.z), bf_lo(w.w), bf_hi(w.w)};
            float s = 0.f;
#pragma unroll
            for (int i = 0; i < 8; ++i) s += e[i] * e[i];
            s = xsum<1>(s); s = xsum<2>(s); s = xsum<4>(s); s = xsum<8>(s);
            const float rstd = __builtin_amdgcn_rsqf(s * (1.f / 128.f) + EPS);
            const f32x4 g0 = j < 2 ? gq0 : gk0, g1 = j < 2 ? gq1 : gk1;
#pragma unroll
            for (int i = 0; i < 4; ++i) { e[i] = e[i] * rstd * g0[i]; e[4 + i] = e[4 + i] * rstd * g1[i]; }
            v4u o; o.x = pk2(e[0], e[1]); o.y = pk2(e[2], e[3]); o.z = pk2(e[4], e[5]); o.w = pk2(e[6], e[7]);
            p[64 * j] = o;
        }
    }
    if (F.bid < 16) {
        LAS double* tsum = (LAS double*)(F.lds);
        const float* lf = logf + (size_t)F.bid * T; float* bo = bias + (size_t)F.bid * T;
        double v[16]; double run = 0.0;
        const int i0 = F.tid * 16;
#pragma unroll
        for (int i = 0; i < 16; ++i) { run += (double)lf[i0 + i]; v[i] = run; }
        tsum[F.tid] = run;
        __syncthreads();
        LAS double* bsum = tsum + NTHREADS;
        if (F.tid < 8) { double s = 0.0; for (int w = 0; w < 64; ++w) s += tsum[F.tid * 64 + w]; bsum[F.tid] = s; }
        __syncthreads();
        double base = 0.0;
        for (int w = 0; w < F.wave; ++w) base += bsum[w];
        for (int w = 0; w < F.lane; ++w) base += tsum[F.wave * 64 + w];
        const double k = -11.313708498984761;
#pragma unroll
        for (int i = 0; i < 16; ++i) bo[i0 + i] = (float)((base + v[i]) * k);
        __syncthreads();
    }
}

#ifndef DBG_REC
#define DBG_REC 0
#endif
#if DBG_REC
template <bool GLA>
__device__ __forceinline__ void rec_naive(Frame& F, const bf16* proj, float* O, const float* lbl  , int lb_on,
                                          const float* glow, const float* wup  , const float* bgate  ) {
    constexpr int DK = GLA ? 256 : 128, DVH = GLA ? 512 : 128, NH = GLA ? 4 : 8, DVS = 32, NSL = DVH / DVS, TB = GLA ? 16 : 32;
    constexpr int PITCH = GLA ? C_N : AB_N, OPITCH = GLA ? 2048 : 1024;
    constexpr int R = DK / 16;
    constexpr int NPAIR = TB * DK / 2 / NTHREADS;
    constexpr int NUNITS = BATCH * NH * NSL;
    LAS float* sq = (LAS float*)(F.lds); LAS float* sf = sq + TB * DK; LAS float* sk = sf + TB * DK; LAS float* sv = sk + TB * DK; LAS float* part = sv + TB * DVS; LAS float* sgl = part + TB * 4 * DVS;
    const int lane = F.lane, e_l = lane & 15, dsub = lane >> 4, eg = F.wave & 1, dg = F.wave >> 1, e = eg * 16 + e_l, d0 = (dg * 4 + dsub) * R;
    for (int unit = F.bid; unit < NUNITS; unit += F.G) {
        const int sl = unit % NSL, h = (unit / NSL) % NH, b = unit / (NSL * NH);
        const bf16* pq = proj + (size_t)b * T * PITCH + h * DK;
        const bf16* pk = pq + 1024;
        const bf16* pv = proj + (size_t)b * T * PITCH + 2048 + h * DVH + sl * DVS;
        const int dp = 2 * (F.tid % (DK / 2)), tt0 = F.tid / (DK / 2); constexpr int TSTEP = NTHREADS / (DK / 2);
        float lb0 = 0.f, lb1 = 0.f; float wu0[16], wu1[16]; float bg0 = 0.f, bg1 = 0.f;
        if (!GLA) { if (lb_on) { const float l0a = lbl[h * DK + dp], l1a = lbl[1024 + h * DK + dp], l0b = lbl[h * DK + dp + 1], l1b = lbl[1024 + h * DK + dp + 1];
                                 lb0 = fminf(fmaxf(sigmoid_f(l1a - l0a), 0.f), 1.0f - 1e-6f); lb1 = fminf(fmaxf(sigmoid_f(l1b - l0b), 0.f), 1.0f - 1e-6f); } }
        else {
#pragma unroll
            for (int r = 0; r < 16; ++r) { wu0[r] = wup[r * 1024 + h * DK + dp]; wu1[r] = wup[r * 1024 + h * DK + dp + 1]; }
            bg0 = bgate[h * DK + dp]; bg1 = bgate[h * DK + dp + 1]; }
        const int vt = F.tid / 16, ve = 2 * (F.tid % 16); const bool vact = vt < TB;
        float S[R];
#pragma unroll
        for (int j = 0; j < R; ++j) S[j] = 0.f;
        unsigned rq[NPAIR], rk[NPAIR], rv = 0u; float rgl = 0.f;
#define REC_PREFETCH(t0) do { _Pragma("unroll") for (int i = 0; i < NPAIR; ++i) { const size_t row = (size_t)((t0) + tt0 + TSTEP * i); \
            rq[i] = *(const unsigned*)(pq + row * PITCH + dp); rk[i] = *(const unsigned*)(pk + row * PITCH + dp); \
            } \
            if (GLA && F.tid < TB * 16) rgl = glow[((size_t)b * T + (t0)) * 16 + F.tid]; \
            if (vact) rv = *(const unsigned*)(pv + (size_t)((t0) + vt) * PITCH + ve); } while (0)
        REC_PREFETCH(0);
        for (int t0 = 0; t0 < T; t0 += TB) {
            if (GLA) { if (F.tid < TB * 16) sgl[F.tid] = rgl; __syncthreads(); }
#pragma unroll
            for (int i = 0; i < NPAIR; ++i) { const int tt = tt0 + TSTEP * i; const float qa = bf_lo(rq[i]), qb = bf_hi(rq[i]), ka = bf_lo(rk[i]), kb = bf_hi(rk[i]);
                float q0, q1, f0, f1, k0, k1;
                if (!GLA) { q0 = silu_x(qa); q1 = silu_x(qb); const float s0 = sigmoid_f(ka), s1 = sigmoid_f(kb), n0 = sigmoid_f(-ka), n1 = sigmoid_f(-kb);
                    f0 = fmaxf(lb0 + (1.f - lb0) * s0, 1e-30f); f1 = fmaxf(lb1 + (1.f - lb1) * s1, 1e-30f); k0 = (1.f - lb0) * n0; k1 = (1.f - lb1) * n1; }
                else { q0 = qa * 0.0625f; q1 = qb * 0.0625f; k0 = ka; k1 = kb; float x0 = bg0, x1 = bg1;
#pragma unroll
                    for (int r = 0; r < 16; ++r) { const float g = sgl[tt * 16 + r]; x0 += g * wu0[r]; x1 += g * wu1[r]; }
                    f0 = __expf(log_sigmoid_f(x0) * 0.0625f); f1 = __expf(log_sigmoid_f(x1) * 0.0625f); }
                sq[tt * DK + dp] = q0; sq[tt * DK + dp + 1] = q1; sf[tt * DK + dp] = f0; sf[tt * DK + dp + 1] = f1; sk[tt * DK + dp] = k0; sk[tt * DK + dp + 1] = k1; }
            if (vact) { sv[vt * DVS + ve] = bf_lo(rv); sv[vt * DVS + ve + 1] = bf_hi(rv); }
            __syncthreads();
            if (t0 + TB < T) REC_PREFETCH(t0 + TB);
            for (int tt = 0; tt < TB; ++tt) {
                const float v = sv[tt * DVS + e]; float acc = 0.f;
#pragma unroll
                for (int g4 = 0; g4 < R / 4; ++g4) { const f32x4 f4 = *(const LAS f32x4*)(sf + tt * DK + d0 + 4 * g4), k4 = *(const LAS f32x4*)(sk + tt * DK + d0 + 4 * g4), q4 = *(const LAS f32x4*)(sq + tt * DK + d0 + 4 * g4);
#pragma unroll
                    for (int i = 0; i < 4; ++i) { S[4 * g4 + i] = f4[i] * S[4 * g4 + i] + k4[i] * v; acc += q4[i] * S[4 * g4 + i]; } }
                acc = xsum<16>(acc); acc = xsum<32>(acc);
                if (dsub == 0) part[(tt * 4 + dg) * DVS + e] = acc;
            }
            __syncthreads();
            for (int i = F.tid; i < TB * DVS; i += NTHREADS) { const int tt = i / DVS, ee = i % DVS;
                const float o = (part[(tt * 4 + 0) * DVS + ee] + part[(tt * 4 + 1) * DVS + ee]) + (part[(tt * 4 + 2) * DVS + ee] + part[(tt * 4 + 3) * DVS + ee]);
                O[((size_t)b * T + t0 + tt) * OPITCH + h * DVH + sl * DVS + ee] = o; }
        }
#undef REC_PREFETCH
        __syncthreads();
    }
}

#endif
#ifndef DBG_ZERO
#define DBG_ZERO 0
#endif
__device__ __forceinline__ void post_even(Frame& F, const bf16* O, const bf16* proj, const float* gain  , bf16* cat) {
    const int gw = F.bid * NWAVES + F.wave, NGW = F.G * NWAVES;
    f32x4 gn[4];
#pragma unroll
    for (int j = 0; j < 4; ++j) gn[j] = *((const f32x4*)gain + 64 * j + F.lane);
    for (int mp = gw; mp < M / 2; mp += NGW) {
        const int m = 2 * mp;
        const GAS v2u* op = (const GAS v2u*)(O + (size_t)m * 1024) + F.lane;
        const GAS v2u* ga = (const GAS v2u*)(proj + (size_t)m * AB_N + 7168) + F.lane;
        GAS v2u* cp = (GAS v2u*)(cat + (size_t)m * DM) + F.lane;
        v2u vr[2][4], gr[2][4];
#pragma unroll
        for (int r = 0; r < 2; ++r)
#pragma unroll
            for (int j = 0; j < 4; ++j) { vr[r][j] = op[r * 256 + 64 * j]; gr[r][j] = ga[r * (AB_N / 4) + 64 * j]; }
#pragma unroll
        for (int r = 0; r < 2; ++r)
#pragma unroll
        for (int j = 0; j < 4; ++j) {
            const f32x4 v = {bf_lo(vr[r][j].x), bf_hi(vr[r][j].x), bf_lo(vr[r][j].y), bf_hi(vr[r][j].y)}; float s = (v.x * v.x + v.y * v.y) + (v.z * v.z + v.w * v.w);
            s = xsum<1>(s); s = xsum<2>(s); s = xsum<4>(s); s = xsum<8>(s); s = xsum<16>(s);
            const float rstd = __builtin_amdgcn_rsqf(s * (1.f / 128.f) + EPS);
            const f32x4 g = gn[j];
            const v2u gw2 = gr[r][j];
            const float o0 = v.x * rstd * g.x * silu_x(bf_lo(gw2.x)), o1 = v.y * rstd * g.y * silu_x(bf_hi(gw2.x)), o2 = v.z * rstd * g.z * silu_x(bf_lo(gw2.y)), o3 = v.w * rstd * g.w * silu_x(bf_hi(gw2.y));
            v2u w; w.x = pk2(o0, o1); w.y = pk2(o2, o3); cp[r * 512 + 64 * j] = w;
        }
    }
}
__device__ __forceinline__ void post_odd(Frame& F, const bf16* O, const bf16* proj, const float* gain  , bf16* cat) {
    const int gw = F.bid * NWAVES + F.wave, NGW = F.G * NWAVES;
    const f32x4 gn0 = *((const f32x4*)gain + F.lane), gn1 = *((const f32x4*)gain + 64 + F.lane);
    for (int mp = gw; mp < M / 2; mp += NGW) {
        const int m = 2 * mp;
        const GAS v2u* op = (const GAS v2u*)(O + (size_t)m * DM) + F.lane;
        const GAS v2u* gg = (const GAS v2u*)(proj + (size_t)m * C_N + 4096) + F.lane;
        GAS v2u* cp = (GAS v2u*)(cat + (size_t)m * DM) + F.lane;
        v2u vr[2][8], gr[2][8];
#pragma unroll
        for (int r = 0; r < 2; ++r)
#pragma unroll
            for (int j = 0; j < 8; ++j) { vr[r][j] = op[r * 512 + 64 * j]; gr[r][j] = gg[r * (C_N / 4) + 64 * j]; }
#pragma unroll
        for (int r = 0; r < 2; ++r)
#pragma unroll
        for (int hh = 0; hh < 4; ++hh) {
            const v2u r0 = vr[r][2 * hh], r1 = vr[r][2 * hh + 1]; const f32x4 v0 = {bf_lo(r0.x), bf_hi(r0.x), bf_lo(r0.y), bf_hi(r0.y)}, v1 = {bf_lo(r1.x), bf_hi(r1.x), bf_lo(r1.y), bf_hi(r1.y)};
            float s = ((v0.x * v0.x + v0.y * v0.y) + (v0.z * v0.z + v0.w * v0.w)) + ((v1.x * v1.x + v1.y * v1.y) + (v1.z * v1.z + v1.w * v1.w));
            s = wave_sum(s);
            const float rstd = __builtin_amdgcn_rsqf(s * (1.f / 512.f) + EPS);
#pragma unroll
            for (int jj = 0; jj < 2; ++jj) { const f32x4 v = jj ? v1 : v0; const f32x4 g = jj ? gn1 : gn0; const v2u gw2 = gr[r][2 * hh + jj];
                const float o0 = v.x * rstd * g.x * silu_x(bf_lo(gw2.x)), o1 = v.y * rstd * g.y * silu_x(bf_hi(gw2.x)), o2 = v.z * rstd * g.z * silu_x(bf_lo(gw2.y)), o3 = v.w * rstd * g.w * silu_x(bf_hi(gw2.y));
                v2u w; w.x = pk2(o0, o1); w.y = pk2(o2, o3); cp[r * 512 + 64 * (2 * hh + jj)] = w; }
        }
    }
}

__device__ __forceinline__ fox::BlockRef fox_ref(int item, const bf16* proj, bf16* cat, const float* bias, float thp) {
    const int bh = item & 15, qb = 31 - (item >> 4), b = bh >> 3, h = bh & 7;
    fox::BlockRef r;
    const bf16* base = proj + (size_t)b * T * AB_N + h * 128;
    r.Q = (const fox::bf16*)(base + (size_t)qb * 256 * AB_N + 3072); r.K = (const fox::bf16*)(base + 4096); r.V = (const fox::bf16*)(base + 5120);
    r.O = (fox::bf16*)(cat + ((size_t)b * T + (size_t)qb * 256) * DM + 1024 + h * 128);
    r.Bias = bias + (size_t)bh * T; r.P0 = qb * 256; r.THp = thp;
    return r;
}
__device__ __forceinline__ int fox_fetch(Frame& F, unsigned* ctr, volatile LAS unsigned* slot) {
    if (F.tid == 0) *slot = __hip_atomic_fetch_add(ctr, 1u, __ATOMIC_RELAXED, __HIP_MEMORY_SCOPE_AGENT);
    __syncthreads();
    const int v = __builtin_amdgcn_readfirstlane((int)*slot);
    __syncthreads();
    return v;
}
__device__ __forceinline__ void fox_phase(Frame& F, char* lds, const bf16* proj, bf16* cat, const float* bias, unsigned* ctr, const float* qg, const float* kg) {
    constexpr int TOTAL = 512;
    float gqm = 0.f, gkm = 0.f;
    for (int i = 0; i < 128; ++i) { gqm = fmaxf(gqm, fabsf(qg[i])); gkm = fmaxf(gkm, fabsf(kg[i])); }
    const float thp = 2.0f * (128.0f * 1.02f * gqm * gkm) + (128.0f + 12.0f + 6.0f) / (1.4426950408889634f * fox::SCALE);
    volatile LAS unsigned* slot = (volatile LAS unsigned*)(F.lds + MISC_OFF) + 16;
    int ci = fox_fetch(F, ctr, slot); if (ci >= TOTAL) return;
    fox::BlockRef cur = fox_ref(ci, proj, cat, bias, thp);
    fox::Seam S;
    fox::fox_prime(cur, lds, S, F.tid);
    struct Next { Frame& F; unsigned* ctr; volatile LAS unsigned* slot; const bf16* proj; bf16* cat; const float* bias; float thp; fox::BlockRef cur, nxt; bool last;
        __device__ __forceinline__ const fox::bf16* operator()() { const int ni = fox_fetch(F, ctr, slot); last = ni >= 512; nxt = last ? cur : fox_ref(ni, proj, cat, bias, thp); return nxt.Q; } };
    Next nx{F, ctr, slot, proj, cat, bias, thp, cur, cur, false};
    for (;;) {
        fox::fox_block(nx.cur, nx, lds, S, F.tid);
        if (nx.last) break;
        nx.cur = nx.nxt;
    }
}

template <bool GLA> struct RecCfg {
    static constexpr int DK = GLA ? 256 : 128, DVH = GLA ? 512 : 128, NH = GLA ? 4 : 8, CH = 32, NCH = T / CH, PITCH = GLA ? C_N : AB_N, OPITCH = GLA ? 2048 : 1024;
    static constexpr int QP = DK + 16;
    static constexpr int QT_B = ((CH * QP * 2 + 1023) / 1024) * 1024, KT_B = DK * CH * 2, P_B = CH * CH * 2, A_B = 1024, VT_B = DVH * CH * 2;
    static constexpr int OFF_QT = 0, OFF_KT = QT_B, OFF_P = OFF_KT + KT_B, OFF_A = OFF_P + P_B, OFF_VT = OFF_A + A_B, UNIT_B = OFF_VT + VT_B;
    static constexpr int NSL = DVH / 128, BUF_B = OFF_VT + 8192, NP1 = OFF_VT / 1024, NP = NP1 + 8, NR = (NP + 7) / 8;
    static_assert(A_B >= DK * 4 && OFF_VT % 1024 == 0, "rec layout");
};
typedef short rbf16x8 __attribute__((ext_vector_type(8)));
__device__ __forceinline__ rbf16x8 rpack8(f32x4 a, f32x4 b) { v4u w; w.x = pg8::cvt_pk_bf16(a.x, a.y); w.y = pg8::cvt_pk_bf16(a.z, a.w); w.z = pg8::cvt_pk_bf16(b.x, b.y); w.w = pg8::cvt_pk_bf16(b.z, b.w); return __builtin_bit_cast(rbf16x8, w); }

template <bool GLA>
__device__ __forceinline__ void rec_prep(Frame& F, const bf16* proj, unsigned char* rec, const float* lbl, int lb_on, const float* glow, const float* wup, const float* bgate) {
    using C = RecCfg<GLA>;
    constexpr int DK = C::DK, DVH = C::DVH, NH = C::NH, CH = C::CH, NCH = C::NCH, PITCH = C::PITCH, QP = C::QP;
    constexpr int NSEG = NTHREADS / DK, TPS = CH / NSEG;
    constexpr int NSEGV = NTHREADS / DVH, TPV = CH / NSEGV;
    LAS float* segtot = (LAS float*)F.lds;
    LAS bf16* qm = (LAS bf16*)(F.lds + 2048);
    LAS bf16* km = qm + CH * QP;
    LAS float* sgl = (LAS float*)(F.lds + 2048 + 2 * CH * QP * 2);
    const int d = F.tid % DK, seg = F.tid / DK, lane = F.lane, el = lane & 15, q4 = lane >> 4;
    const int x = d & 31, y = x & 15, pos = (d & ~31) + 8 * (y >> 2) + (y & 3) + 4 * (x >> 4);
    constexpr int NUNITS = BATCH * NH * NCH, NBH = BATCH * NH;
    float lb = 0.f, bg = 0.f; float wu[16]; int hprev = -1;
    unsigned short rq[TPS], rk[TPS]; unsigned rvv[TPV / 2]; float rgl = 0.f;
    unsigned short rvr[GLA ? 1 : TPV];
    const int ev = F.tid % DVH, sv = F.tid / DVH;
    const unsigned toff = (unsigned)(seg * TPS) * (unsigned)(PITCH * 2) + (unsigned)d * 2u, voff = (unsigned)(sv * TPV) * (unsigned)(PITCH * 2) + (unsigned)ev * 2u;
#define PREP_LOAD(un) do { const int c_ = (un) / NBH, bh_ = (un) % NBH; const size_t row_ = (size_t)(bh_ / NH) * T + (size_t)c_ * CH; const int h_ = bh_ % NH; \
        const char* ubq_ = (const char*)(proj + row_ * PITCH + h_ * DK); const char* ubv_ = (const char*)(proj + row_ * PITCH + 2048 + h_ * DVH); (void)ubv_; \
        if (GLA) rgl = glow[row_ * 16 + F.tid];     \
        _Pragma("unroll") for (int i = 0; i < TPS; ++i) { const char* rb_ = ubq_ + (size_t)i * (PITCH * 2);     \
            rq[i] = *(const bf16*)(rb_ + toff); rk[i] = *(const bf16*)(rb_ + 2048 + toff); } \
        if (!GLA) { _Pragma("unroll") for (int i = 0; i < TPV; ++i) rvr[i] = *(const bf16*)((ubv_ + (size_t)i * (PITCH * 2)) + voff); } \
        } while (0)
    if (F.bid < NUNITS) PREP_LOAD(F.bid);
    for (int unit = F.bid; unit < NUNITS; unit += F.G) {
        const int c = unit / NBH, bh = unit % NBH, h = bh % NH, b = bh / NH;
        const size_t row0 = (size_t)b * T + (size_t)c * CH;
        if (h != hprev) { hprev = h;
            if (!GLA) { lb = 0.f; if (lb_on) lb = fminf(fmaxf(sigmoid_f(lbl[1024 + h * DK + d] - lbl[h * DK + d]), 0.f), 1.0f - 1e-6f); }
            else {
#pragma unroll
                for (int r = 0; r < 16; ++r) wu[r] = wup[r * 1024 + h * DK + d];
                bg = bgate[h * DK + d]; } }
        if (GLA) { sgl[F.tid] = rgl; __syncthreads(); }
        float qv[TPS], kv[TPS], G[TPS]; float run = 0.f;
#pragma unroll
        for (int i = 0; i < TPS; ++i) { const int t = seg * TPS + i; const float qa = bf1(rq[i]), ka = bf1(rk[i]); float g;
            if (!GLA) { qv[i] = silu_x(qa); const float ez = __expf(-fabsf(ka)), rz = __builtin_amdgcn_rcpf(1.0f + ez), big = rz, small = ez * rz;
                const float sg = ka >= 0.f ? big : small, ng = ka >= 0.f ? small : big; const float f = fmaxf(lb + (1.f - lb) * sg, 1e-30f); g = __logf(f); kv[i] = (1.f - lb) * ng; }
            else { qv[i] = qa * 0.0625f; kv[i] = ka; float xx = bg;
#pragma unroll
                for (int r = 0; r < 16; ++r) xx += sgl[t * 16 + r] * wu[r];
                g = log_sigmoid_fast(xx) * 0.0625f; }
            run += g; G[i] = run; }
        segtot[seg * DK + d] = run;
        __syncthreads();
        float off = 0.f, tot = 0.f, rmid = 0.f;
#pragma unroll
        for (int s = 0; s < NSEG; ++s) { const float v = segtot[s * DK + d]; tot += v; if (s < seg) off += v; if (s < 16 / TPS) rmid += v; }
        unsigned char* ub = rec + (size_t)(bh * NCH + c) * C::UNIT_B;
        bf16* QT = (bf16*)(ub + C::OFF_QT); bf16* KT = (bf16*)(ub + C::OFF_KT); bf16* Pb = (bf16*)(ub + C::OFF_P); float* Ab = (float*)(ub + C::OFF_A); bf16* VT = (bf16*)(ub + C::OFF_VT);
        unsigned kt[TPS / 2];
#pragma unroll
        for (int i = 0; i < TPS; i += 2) { float kh[2];
#pragma unroll
            for (int u = 0; u < 2; ++u) { const int t = seg * TPS + i + u; const float Gt = G[i + u] + off;
                QT[t * QP + pos] = (bf16)f2bf(qv[i + u] * __expf(Gt)); kh[u] = kv[i + u] * __expf(tot - Gt);
                qm[t * QP + d] = (bf16)f2bf(qv[i + u] * __expf(fminf(Gt - rmid, 80.f))); km[t * QP + d] = (bf16)f2bf(kv[i + u] * __expf(fminf(rmid - Gt, 80.f))); }
            kt[i / 2] = pk2(kh[0], kh[1]); }
#pragma unroll
        for (int j = 0; j < TPS / 8; ++j) { v4u w; w.x = kt[4 * j]; w.y = kt[4 * j + 1]; w.z = kt[4 * j + 2]; w.w = kt[4 * j + 3]; *(v4u*)(KT + d * CH + ((seg * TPS + 8 * j) ^ ((d & 8) << 1))) = w; }
        if (seg == NSEG - 1) Ab[d] = __expf(tot);
        { bf16* vt_ = VT + ev * CH;
          if (GLA) { const char* ubv_ = (const char*)(proj + row0 * PITCH + 2048 + h * DVH);
#pragma unroll
              for (int i = 0; i < TPV; i += 2) rvv[i / 2] = (unsigned)*(const bf16*)(ubv_ + (voff + (unsigned)i * (unsigned)(PITCH * 2))) | ((unsigned)*(const bf16*)(ubv_ + (voff + (unsigned)(i + 1) * (unsigned)(PITCH * 2))) << 16); }
          else {
#pragma unroll
              for (int i = 0; i < TPV; i += 2) rvv[i / 2] = (unsigned)rvr[i] | ((unsigned)rvr[i + 1] << 16); }
#pragma unroll
          for (int j = 0; j < TPV / 8; ++j) { v4u w; w.x = rvv[4 * j]; w.y = rvv[4 * j + 1]; w.z = rvv[4 * j + 2]; w.w = rvv[4 * j + 3];
              *(v4u*)(vt_ + ((sv * TPV + 8 * j) ^ ((ev & 8) << 1))) = w; } }
        if (unit + F.G < NUNITS) PREP_LOAD(unit + F.G);
        __syncthreads();
        if (F.wave < 3) { const int tt = F.wave >= 1, st = F.wave == 2; f32x4 acc = {0.f, 0.f, 0.f, 0.f};
#pragma unroll
            for (int i = 0; i < DK / 32; ++i) { const rbf16x8 a = *(const LAS rbf16x8*)(km + (16 * st + el) * QP + 32 * i + 8 * q4), bq = *(const LAS rbf16x8*)(qm + (16 * tt + el) * QP + 32 * i + 8 * q4);
                acc = __builtin_amdgcn_mfma_f32_16x16x32_bf16(a, bq, acc, 0, 0, 0); }
            const int ta = 16 * tt + el, s0 = 16 * st + 4 * q4;
            const float p0 = s0 + 0 <= ta ? acc[0] : 0.f, p1 = s0 + 1 <= ta ? acc[1] : 0.f, p2 = s0 + 2 <= ta ? acc[2] : 0.f, p3 = s0 + 3 <= ta ? acc[3] : 0.f;
            v2u w; w.x = pk2(p0, p1); w.y = pk2(p2, p3); *(v2u*)(Pb + ta * CH + (s0 ^ ((ta & 8) << 1))) = w; }
        else if (F.wave == 3) { v2u w; w.x = 0u; w.y = 0u; *(v2u*)(Pb + el * CH + ((16 + 4 * q4) ^ ((el & 8) << 1))) = w; }
        __syncthreads();
    }
#undef PREP_LOAD
}

template <bool GLA>
__device__ __forceinline__ void rec_seq(Frame& F, const unsigned char* rec, float* O, const bf16* proj, const float* gain, bf16* cat) {
    using C = RecCfg<GLA>;
    constexpr int DK = C::DK, DVH = C::DVH, NH = C::NH, CH = C::CH, NCH = C::NCH, QP = C::QP, NSL = C::NSL, NDT = DK / 16, NKS = DK / 32;
    constexpr int NBUF = 3, PF = NBUF - 1;
    constexpr int BUFG = C::BUF_B + (GLA ? 0 : 8192);
    constexpr int NWAIT = (PF - 1) * ((C::NR - 1) + (GLA ? 0 : 1) + 2);
    static_assert(NBUF * BUFG + 2048 <= RING_BYTES, "rec ring");
    constexpr int NUNITS = BATCH * NH * NSL;
    const int lane = F.lane, el = lane & 15, q4 = lane >> 4, wave = F.wave;
    for (int unit = F.bid; unit < NUNITS; unit += F.G) {
        const int sl = unit % NSL, h = (unit / NSL) % NH, b = unit / (NSL * NH);
        const unsigned char* ubase = rec + (size_t)((b * NH + h) * NCH) * C::UNIT_B;
#define REC_DMA(cc) do { const unsigned char* ub_ = ubase + (size_t)(cc) * C::UNIT_B; const int bufi_ = (cc) % NBUF; _Pragma("unroll") for (int r_ = 0; r_ < C::NR; ++r_) { const int p_ = r_ * 8 + wave; \
            if (p_ < C::NP) { const unsigned char* src_ = ub_ + (p_ < C::NP1 ? p_ * 1024 : C::OFF_VT + sl * 8192 + (p_ - C::NP1) * 1024) + lane * 16; \
                __builtin_amdgcn_global_load_lds((const unsigned*)src_, (LAS unsigned*)(F.lds + bufi_ * BUFG + p_ * 1024), 16, 0, 0); } } \
            if (!GLA) { const unsigned char* gsrc_ = (const unsigned char*)(proj + ((size_t)b * T + (size_t)(cc) * CH + 4 * wave + (lane >> 4)) * AB_N + 3072 + h * DVH) + (lane & 15) * 16; \
                __builtin_amdgcn_global_load_lds((const unsigned*)gsrc_, (LAS unsigned*)(F.lds + bufi_ * BUFG + C::BUF_B + wave * 1024), 16, 0, 0); } } while (0)
        f32x4 S[NDT];
#pragma unroll
        for (int i = 0; i < NDT; ++i) S[i] = (f32x4){0.f, 0.f, 0.f, 0.f};
#pragma unroll
        for (int cc = 0; cc < PF; ++cc) REC_DMA(cc);
        float* Ob = O + ((size_t)b * T) * C::OPITCH + h * DVH + sl * 128 + 16 * wave + 4 * q4;
        LAS float* ssq = (LAS float*)(F.lds + NBUF * BUFG);
        f32x4 oprev[2] = {{0.f, 0.f, 0.f, 0.f}, {0.f, 0.f, 0.f, 0.f}};
        v2u gsave[2] = {{0u, 0u}, {0u, 0u}};
        const unsigned ecol = (unsigned)(h * DVH + 16 * wave + 4 * q4);
        f32x4 gn4 = {1.f, 1.f, 1.f, 1.f}; if (!GLA) gn4 = *(const f32x4*)(gain + ecol);
#define REC_FINISH(cp) do { _Pragma("unroll") for (int tt = 0; tt < 2; ++tt) { const int tl = 16 * tt + el; float tot = 0.f; \
            _Pragma("unroll") for (int w_ = 0; w_ < 8; ++w_) tot += ssq[(((cp) & 1) * 8 + w_) * 32 + tl]; \
            const float rstd = 1.0f / sqrtf(tot * (1.f / 128.f) + EPS); const size_t row_ = (size_t)b * T + (size_t)(cp) * CH + tl; \
            const v2u gw_ = gsave[tt]; const f32x4 ov = oprev[tt]; \
            v2u w_o; w_o.x = pk2(ov.x * rstd * gn4.x * silu_x(bf_lo(gw_.x)), ov.y * rstd * gn4.y * silu_x(bf_hi(gw_.x))); \
            w_o.y = pk2(ov.z * rstd * gn4.z * silu_x(bf_lo(gw_.y)), ov.w * rstd * gn4.w * silu_x(bf_hi(gw_.y))); \
            *(v2u*)(cat + row_ * DM + ecol) = w_o; } } while (0)
        for (int c = 0; c < NCH; ++c) {
            if (c <= PF) asm volatile("s_waitcnt vmcnt(0)" ::: "memory"); else asm volatile("s_waitcnt vmcnt(%0)" :: "i"(NWAIT) : "memory");
            asm volatile("s_waitcnt lgkmcnt(0)" ::: "memory"); __builtin_amdgcn_s_barrier(); asm volatile("" ::: "memory");
            if (!GLA) {
                if (c > 0) REC_FINISH(c - 1);
                else { v2u z; z.x = 0u; z.y = 0u; *(v2u*)(cat + ((size_t)b * T + el) * DM + ecol) = z; *(v2u*)(cat + ((size_t)b * T + 16 + el) * DM + ecol) = z; }
            }
            if (c + PF < NCH) REC_DMA(c + PF); else REC_DMA(NCH - 1);
            const LAS unsigned char* L = F.lds + (c % NBUF) * BUFG;
            rbf16x8 sf[NKS];
#pragma unroll
            for (int i = 0; i < NKS; ++i) sf[i] = rpack8(S[2 * i], S[2 * i + 1]);
            f32x4 o[2];
#pragma unroll
            for (int tt = 0; tt < 2; ++tt) { o[tt] = (f32x4){0.f, 0.f, 0.f, 0.f};
#pragma unroll
                for (int i = 0; i < NKS; ++i) { const rbf16x8 qf = *(const LAS rbf16x8*)(L + C::OFF_QT + ((16 * tt + el) * QP + 32 * i + 8 * q4) * 2);
                    o[tt] = __builtin_amdgcn_mfma_f32_16x16x32_bf16(sf[i], qf, o[tt], 0, 0, 0); } }
            const rbf16x8 vf = *(const LAS rbf16x8*)(L + C::OFF_VT + ((16 * wave + el) * CH + 8 * q4) * 2);
#pragma unroll
            for (int tt = 0; tt < 2; ++tt) { const rbf16x8 pf = *(const LAS rbf16x8*)(L + C::OFF_P + ((16 * tt + el) * CH + 8 * q4) * 2);
                o[tt] = __builtin_amdgcn_mfma_f32_16x16x32_bf16(vf, pf, o[tt], 0, 0, 0); }
#pragma unroll
            for (int dt = 0; dt < NDT; ++dt) { const f32x4 a4 = *(const LAS f32x4*)(L + C::OFF_A + (16 * dt + 4 * q4) * 4); S[dt] = S[dt] * a4;
                const rbf16x8 kf = *(const LAS rbf16x8*)(L + C::OFF_KT + ((16 * dt + el) * CH + 8 * q4) * 2);
                S[dt] = __builtin_amdgcn_mfma_f32_16x16x32_bf16(kf, vf, S[dt], 0, 0, 0); }
            if (GLA) {
#pragma unroll
                for (int tt = 0; tt < 2; ++tt) *(f32x4*)(Ob + (size_t)(c * CH + 16 * tt + el) * C::OPITCH) = o[tt];
            } else {
#pragma unroll
                for (int tt = 0; tt < 2; ++tt) { float p = (o[tt].x * o[tt].x + o[tt].y * o[tt].y) + (o[tt].z * o[tt].z + o[tt].w * o[tt].w); p = xsum<16>(p); p = xsum<32>(p);
                    if (q4 == 0) ssq[((c & 1) * 8 + wave) * 32 + 16 * tt + el] = p; oprev[tt] = o[tt];
                    gsave[tt] = *(const LAS v2u*)(L + C::BUF_B + ((16 * tt + el) * 128 + 16 * wave + 4 * q4) * 2); }
            }
        }
        asm volatile("s_waitcnt vmcnt(0)" ::: "memory"); __syncthreads();
        if (!GLA) { REC_FINISH(NCH - 1); }
        __syncthreads();
#undef REC_FINISH
#undef REC_DMA
    }
}

template <bool GLA>
__device__ __forceinline__ void rec_seq2(Frame& F, const unsigned char* rec, bf16* O) {
    using C = RecCfg<GLA>;
    constexpr int DK = C::DK, DVH = C::DVH, NH = C::NH, CH = C::CH, NCH = C::NCH, QP = C::QP;
    constexpr int NDH = DK / 32, NKH = DK / 64;
    constexpr int ES = 64, NSL = DVH / ES, BUF2 = C::OFF_VT + ES * CH * 2, NP1 = C::OFF_VT / 1024, NP = NP1 + ES * CH * 2 / 1024, NR = NP / 8;
    constexpr int NBUF = GLA ? 3 : 5, PF = NBUF - 1, NWAIT = (PF - 1) * (NR + 1);
    static_assert(NP % 8 == 0 && NBUF * BUF2 + 2 * 8 * 1024 <= RING_BYTES, "rec_seq2 ring");
    constexpr int NUNITS = BATCH * NH * NSL;
    const int lane = F.lane, el = lane & 15, q4 = lane >> 4, wave = F.wave, eg = wave & 3, dg = wave >> 2;
    LAS unsigned char* xch = F.lds + NBUF * BUF2;
    for (int unit = F.bid; unit < NUNITS; unit += F.G) {
        const int sl = unit % NSL, h = (unit / NSL) % NH, b = unit / (NSL * NH);
        const unsigned char* ubase = rec + (size_t)((b * NH + h) * NCH) * C::UNIT_B;
#define G2_DMA(cc) do { const unsigned char* ub_ = ubase + (size_t)(cc) * C::UNIT_B; const int bufi_ = (cc) % NBUF; _Pragma("unroll") for (int r_ = 0; r_ < NR; ++r_) { const int p_ = r_ * 8 + wave; \
            const unsigned char* src_ = ub_ + (p_ < NP1 ? p_ * 1024 : C::OFF_VT + sl * (ES * CH * 2) + (p_ - NP1) * 1024) + lane * 16; \
            __builtin_amdgcn_global_load_lds((const unsigned*)src_, (LAS unsigned*)(F.lds + bufi_ * BUF2 + p_ * 1024), 16, 0, 0); } } while (0)
        f32x4 S[NDH];
#pragma unroll
        for (int i = 0; i < NDH; ++i) S[i] = (f32x4){0.f, 0.f, 0.f, 0.f};
#pragma unroll
        for (int cc = 0; cc < PF; ++cc) G2_DMA(cc);
        bf16* Ob = O + ((size_t)b * T + 16 * dg + el) * C::OPITCH + h * DVH + sl * ES + 16 * eg + 4 * q4;
#define G2_ST(p_, v_) do { const f32x4 v4_ = (v_); v2u w2_; w2_.x = pg8::cvt_pk_bf16(v4_.x, v4_.y); w2_.y = pg8::cvt_pk_bf16(v4_.z, v4_.w); *(v2u*)(p_) = w2_; } while (0)
        f32x4 okeep = {0.f, 0.f, 0.f, 0.f};
        for (int c = 0; c < NCH; ++c) {
            if (c <= PF) asm volatile("s_waitcnt vmcnt(0)" ::: "memory"); else asm volatile("s_waitcnt vmcnt(%0)" :: "i"(NWAIT) : "memory");
            asm volatile("s_waitcnt lgkmcnt(0)" ::: "memory"); __builtin_amdgcn_s_barrier(); asm volatile("" ::: "memory");
            if (c + PF < NCH) G2_DMA(c + PF); else G2_DMA(NCH - 1);
            const LAS unsigned char* L = F.lds + (c % NBUF) * BUF2;
            rbf16x8 qf[2][NKH], kf[NDH]; f32x4 a4[NDH];
#pragma unroll
            for (int tt = 0; tt < 2; ++tt)
#pragma unroll
                for (int i = 0; i < NKH; ++i) qf[tt][i] = *(const LAS rbf16x8*)(L + C::OFF_QT + ((16 * tt + el) * QP + 32 * (NKH * dg + i) + 8 * q4) * 2);
            const int sw8 = (8 * q4) ^ ((el & 8) << 1);
            const rbf16x8 vf = *(const LAS rbf16x8*)(L + C::OFF_VT + ((16 * eg + el) * CH + sw8) * 2);
            const rbf16x8 pf = *(const LAS rbf16x8*)(L + C::OFF_P + ((16 * dg + el) * CH + sw8) * 2);
#pragma unroll
            for (int j = 0; j < NDH; ++j) { kf[j] = *(const LAS rbf16x8*)(L + C::OFF_KT + ((16 * (NDH * dg + j) + el) * CH + sw8) * 2); a4[j] = *(const LAS f32x4*)(L + C::OFF_A + (16 * (NDH * dg + j) + 4 * q4) * 4); }
            rbf16x8 sf[NKH];
#pragma unroll
            for (int i = 0; i < NKH; ++i) sf[i] = rpack8(S[2 * i], S[2 * i + 1]);
            f32x4 o[2];
#pragma unroll
            for (int tt = 0; tt < 2; ++tt) { o[tt] = (f32x4){0.f, 0.f, 0.f, 0.f};
#pragma unroll
                for (int i = 0; i < NKH; ++i) o[tt] = __builtin_amdgcn_mfma_f32_16x16x32_bf16(sf[i], qf[tt][i], o[tt], 0, 0, 0); }
            if (dg == 0) o[0] = __builtin_amdgcn_mfma_f32_16x16x32_bf16(vf, pf, o[0], 0, 0, 0); else o[1] = __builtin_amdgcn_mfma_f32_16x16x32_bf16(vf, pf, o[1], 0, 0, 0);
#pragma unroll
            for (int j = 0; j < NDH; ++j) { S[j] = S[j] * a4[j]; S[j] = __builtin_amdgcn_mfma_f32_16x16x32_bf16(kf[j], vf, S[j], 0, 0, 0); }
            if (c > 0) { const f32x4 pr = *(const LAS f32x4*)(xch + ((((c - 1) & 1) * 8 + (wave ^ 4)) * 64 + lane) * 16);
                         G2_ST(Ob + (size_t)((c - 1) * CH) * C::OPITCH, okeep + pr); }
            else { G2_ST(Ob, okeep); }
            *(LAS f32x4*)(xch + (((c & 1) * 8 + wave) * 64 + lane) * 16) = dg == 0 ? o[1] : o[0];
            okeep = dg == 0 ? o[0] : o[1];
        }
        asm volatile("s_waitcnt vmcnt(0) lgkmcnt(0)" ::: "memory"); __syncthreads();
        { const f32x4 pr = *(const LAS f32x4*)(xch + ((((NCH - 1) & 1) * 8 + (wave ^ 4)) * 64 + lane) * 16); G2_ST(Ob + (size_t)((NCH - 1) * CH) * C::OPITCH, okeep + pr); }
        __syncthreads();
#undef G2_ST
#undef G2_DMA
    }
}

template <bool GLA>
__device__ __forceinline__ void rec_seq3(Frame& F, const unsigned char* rec, bf16* O) {
    using C = RecCfg<GLA>;
    constexpr int DK = C::DK, DVH = C::DVH, NH = C::NH, CH = C::CH, NCH = C::NCH, QP = C::QP;
    constexpr int NDH = DK / 32, NKH = DK / 64;
    constexpr int ES = 64, NSL = DVH / ES, BUF2 = C::OFF_VT + ES * CH * 2, NP1 = C::OFF_VT / 1024, NP = NP1 + ES * CH * 2 / 1024, NRL = NP / 4;
    constexpr int NBUF = GLA ? 3 : 5, PF = NBUF - 1, NWAIT = (PF - 1) * NRL;
    static_assert(NP % 4 == 0 && NBUF * BUF2 + 2 * 8 * 1024 <= RING_BYTES && NWAIT < 64, "rec_seq3 ring");
    constexpr int NUNITS = BATCH * NH * NSL;
    const int lane = F.lane, el = lane & 15, q4 = lane >> 4, wave = F.wave;
    LAS unsigned char* xch = F.lds + NBUF * BUF2;
    for (int unit = F.bid; unit < NUNITS; unit += F.G) {
        const int bh = unit % (BATCH * NH), sl = unit / (BATCH * NH), h = bh % NH, b = bh / NH;
        const unsigned char* ubase = rec + (size_t)((b * NH + h) * NCH) * C::UNIT_B;
        const int eg2 = wave & 1, dg = (wave >> 1) & 1;
        bf16* Ob = O + ((size_t)b * T + 16 * dg + el) * C::OPITCH + h * DVH + sl * ES + 32 * eg2 + 4 * q4;
        f32x4 okeep[2] = {{0.f, 0.f, 0.f, 0.f}, {0.f, 0.f, 0.f, 0.f}};
#define G3_ST(p_, v_) do { const f32x4 v4_ = (v_); v2u w2_; w2_.x = pg8::cvt_pk_bf16(v4_.x, v4_.y); w2_.y = pg8::cvt_pk_bf16(v4_.z, v4_.w); *(v2u*)(p_) = w2_; } while (0)
        if (wave >= 4) {
            const int lw = wave - 4;
#define G3_DMA(cc) do { const unsigned char* ub_ = ubase + (size_t)(cc) * C::UNIT_B; const int bufi_ = (cc) % NBUF; _Pragma("unroll") for (int r_ = 0; r_ < NRL; ++r_) { const int p_ = r_ * 4 + lw; \
            const unsigned char* src_ = ub_ + (p_ < NP1 ? p_ * 1024 : C::OFF_VT + sl * (ES * CH * 2) + (p_ - NP1) * 1024) + lane * 16; \
            __builtin_amdgcn_global_load_lds((const unsigned*)src_, (LAS unsigned*)(F.lds + bufi_ * BUF2 + p_ * 1024), 16, 0, 0); } } while (0)
#pragma unroll
            for (int cc = 0; cc < PF; ++cc) G3_DMA(cc);
            for (int c = 0; c < NCH; ++c) {
                asm volatile("s_waitcnt vmcnt(%0)" :: "i"(NWAIT) : "memory");
                __builtin_amdgcn_s_barrier(); asm volatile("" ::: "memory");
                if (c + PF < NCH) G3_DMA(c + PF); else G3_DMA(NCH - 1);
            }
            asm volatile("s_waitcnt vmcnt(0)" ::: "memory");
#undef G3_DMA
        } else {
            f32x4 S[NDH][2];
#pragma unroll
            for (int i = 0; i < NDH; ++i) { S[i][0] = (f32x4){0.f, 0.f, 0.f, 0.f}; S[i][1] = (f32x4){0.f, 0.f, 0.f, 0.f}; }
            const int sw8 = (8 * q4) ^ ((el & 8) << 1);
            for (int c = 0; c < NCH; ++c) {
                asm volatile("s_waitcnt lgkmcnt(0)" ::: "memory"); __builtin_amdgcn_s_barrier(); asm volatile("" ::: "memory");
                const LAS unsigned char* L = F.lds + (c % NBUF) * BUF2;
                rbf16x8 qf[2][NKH], kf[NDH], vf[2]; f32x4 a4[NDH];
#pragma unroll
                for (int tt = 0; tt < 2; ++tt)
#pragma unroll
                    for (int i = 0; i < NKH; ++i) qf[tt][i] = *(const LAS rbf16x8*)(L + C::OFF_QT + ((16 * tt + el) * QP + 32 * (NKH * dg + i) + 8 * q4) * 2);
#pragma unroll
                for (int et = 0; et < 2; ++et) vf[et] = *(const LAS rbf16x8*)(L + C::OFF_VT + ((32 * eg2 + 16 * et + el) * CH + sw8) * 2);
                const rbf16x8 pf = *(const LAS rbf16x8*)(L + C::OFF_P + ((16 * dg + el) * CH + sw8) * 2);
#pragma unroll
                for (int j = 0; j < NDH; ++j) { kf[j] = *(const LAS rbf16x8*)(L + C::OFF_KT + ((16 * (NDH * dg + j) + el) * CH + sw8) * 2); a4[j] = *(const LAS f32x4*)(L + C::OFF_A + (16 * (NDH * dg + j) + 4 * q4) * 4); }
                f32x4 o[2][2];
#pragma unroll
                for (int et = 0; et < 2; ++et) { rbf16x8 sf[NKH];
#pragma unroll
                    for (int i = 0; i < NKH; ++i) sf[i] = rpack8(S[2 * i][et], S[2 * i + 1][et]);
#pragma unroll
                    for (int tt = 0; tt < 2; ++tt) { o[tt][et] = (f32x4){0.f, 0.f, 0.f, 0.f};
#pragma unroll
                        for (int i = 0; i < NKH; ++i) o[tt][et] = __builtin_amdgcn_mfma_f32_16x16x32_bf16(sf[i], qf[tt][i], o[tt][et], 0, 0, 0); } }
#pragma unroll
                for (int et = 0; et < 2; ++et) { if (dg == 0) o[0][et] = __builtin_amdgcn_mfma_f32_16x16x32_bf16(vf[et], pf, o[0][et], 0, 0, 0); else o[1][et] = __builtin_amdgcn_mfma_f32_16x16x32_bf16(vf[et], pf, o[1][et], 0, 0, 0); }
#pragma unroll
                for (int j = 0; j < NDH; ++j)
#pragma unroll
                    for (int et = 0; et < 2; ++et) { S[j][et] = S[j][et] * a4[j]; S[j][et] = __builtin_amdgcn_mfma_f32_16x16x32_bf16(kf[j], vf[et], S[j][et], 0, 0, 0); }
                if (c > 0) {
#pragma unroll
                    for (int et = 0; et < 2; ++et) { const f32x4 pr = *(const LAS f32x4*)(xch + (((((c - 1) & 1) * 4 + (wave ^ 2)) * 2 + et) * 64 + lane) * 16);
                        G3_ST(Ob + (size_t)((c - 1) * CH) * C::OPITCH + 16 * et, okeep[et] + pr); } }
#pragma unroll
                for (int et = 0; et < 2; ++et) { *(LAS f32x4*)(xch + ((((c & 1) * 4 + wave) * 2 + et) * 64 + lane) * 16) = dg == 0 ? o[1][et] : o[0][et]; okeep[et] = dg == 0 ? o[0][et] : o[1][et]; }
            }
        }
        asm volatile("s_waitcnt vmcnt(0) lgkmcnt(0)" ::: "memory"); __syncthreads();
        if (wave < 4) {
#pragma unroll
            for (int et = 0; et < 2; ++et) { const f32x4 pr = *(const LAS f32x4*)(xch + (((((NCH - 1) & 1) * 4 + (wave ^ 2)) * 2 + et) * 64 + lane) * 16);
                G3_ST(Ob + (size_t)((NCH - 1) * CH) * C::OPITCH + 16 * et, okeep[et] + pr); } }
        __syncthreads();
#undef G3_ST
    }
}
#define WSP(T_, off) ((T_*)(ws + (off)))
#define REFRAME() CArgs* ap = opq_args(); unsigned char* ws = ap->ws; (void)ws; \
    F.lds = (LAS unsigned char*)lds; F.tid = opq_tid(wave_s); F.lane = F.tid & 63; F.wave = __builtin_amdgcn_readfirstlane(F.tid >> 6); F.G = gridDim.x; F.bid = opq_bid()
#ifndef DBG_DOUBLE
#define DBG_DOUBLE 0
#endif
#define NREP(bit) ((DBG_DOUBLE & (bit)) ? 2 : 1)
#define REPBAR(rep, n) do { if ((rep) + 1 < (n)) xcd_barrier<false>(bar, F.tid == 0); } while (0)
#define IN(k) (lo <= (k) && (k) < hi)
#define SEAM(k) do { if (IN(k) && IN((k) + 1)) xcd_barrier<false>(bar, F.tid == 0); } while (0)
template <int layer>
__device__ __forceinline__ void layer_phases(unsigned char* lds, const int wave_s, const int lo, const int hi, const XcdBarrier& bar) {
    Frame F;

        constexpr int pb = phase_base(layer); constexpr bool odd = layer & 1; constexpr int li = layer >> 1;
        constexpr int P_NORM1 = pb, P_MIXIN = pb + 1, P_PREP = pb + 2, P_REC = pb + 3, P_POST = pb + 4, P_MIXOUT = pb + 5, P_NORM2 = P_MIXOUT + 1, P_FFIN = P_MIXOUT + 2, P_FFOUT = P_MIXOUT + 3;
#define MODL (WSP(float, WS_MOD) + (size_t)layer * 2 * 6 * DM)
#define XCUR (layer == 0 ? ap->in[0] : (const float*)ap->out)
        if (IN(P_NORM1)) { REFRAME();
            const float* modl = MODL;
            for (int rep = 0; rep < NREP(2); ++rep) {
            constexpr bool L0 = layer == 0; const float* g2p = WSP(float, WS_MOD) + (size_t)(L0 ? 0 : layer - 1) * 2 * 6 * DM + 5 * DM; const void* xin = L0 ? (const void*)ap->in[0] : (const void*)WSP(const bf16, WS_XB);
            if (!odd) norm_phase<8, 1, !L0, L0>(F, xin, ap->in[4] + (size_t)layer * DM, modl, modl + DM, WSP(bf16, WS_H), ap->in[6] + (size_t)li * DM * AB_IN + AB_N, AB_IN, ap->in[12] + li * 8, WSP(float, WS_LOGF), WSP(const bf16, WS_Y), g2p, WSP(bf16, WS_XB));
            else norm_phase<16, 2, !L0, L0>(F, xin, ap->in[4] + (size_t)layer * DM, modl, modl + DM, WSP(bf16, WS_H), ap->in[13] + (size_t)li * DM * C_IN + C_N, C_IN, nullptr, WSP(float, WS_GLOW), WSP(const bf16, WS_Y), g2p, WSP(bf16, WS_XB));
            REPBAR(rep, NREP(2)); }
            SEAM(P_NORM1);
        }
        if (IN(P_MIXIN)) { REFRAME();
            const int N = odd ? 4096 : AB_N, ldc = odd ? C_N : AB_N;
            const bf16* Wt = odd ? WSP(const bf16, WS_W_GLIN) + (size_t)li * C_N * DM : WSP(const bf16, WS_W_ABIN) + (size_t)li * AB_N * DM;
            pg8::Gemm g{WSP(const bf16, WS_H), Wt, M, N, DM}; pg8::StaticOrder S; S.init(M, N, F.G, F.bid);
            pg8::EpiBf16 E{WSP(bf16, WS_PROJ), ldc};
            for (int rep = 0; rep < NREP(1); ++rep) { pg8::gemm_phase<pg8::EpiBf16, pg8::StaticOrder, true, true>(F.lds + RING_OFF, g, S, E, F.tid); REPBAR(rep, NREP(1)); }
            SEAM(P_MIXIN);
        }
        if (IN(P_PREP)) { REFRAME();
            if (!odd) { fox_prep(F, WSP(bf16, WS_PROJ), ap->in[10] + li * 128, ap->in[11] + li * 128, WSP(float, WS_LOGF), WSP(float, WS_BIAS));
                        __syncthreads();
                        for (int rep = 0; rep < NREP(4); ++rep) { rec_prep<false>(F, WSP(const bf16, WS_PROJ), ws + WS_REC, ap->in[8], li, nullptr, nullptr, nullptr); REPBAR(rep, NREP(4)); } }
            else for (int rep = 0; rep < NREP(4); ++rep) { rec_prep<true>(F, WSP(const bf16, WS_PROJ), ws + WS_REC, nullptr, 0, WSP(float, WS_GLOW), ap->in[14] + (size_t)li * 16 * 1024, ap->in[15] + li * 1024); REPBAR(rep, NREP(4)); }
            SEAM(P_PREP);
        }
        if (IN(P_REC)) { REFRAME();
            for (int rep = 0; rep < (odd ? NREP(8) : 1); ++rep) {
            if (!odd) { rec_seq3<false>(F, ws + WS_REC, WSP(bf16, WS_O));
                        fox_phase(F, (char*)lds + RING_OFF, WSP(const bf16, WS_PROJ), WSP(bf16, WS_CAT), WSP(float, WS_BIAS), (unsigned*)(ws + WS_CTL) + CW_QUEUE + 64 * (li + 2 * rep), ap->in[10] + li * 128, ap->in[11] + li * 128); }
            else { rec_seq3<true>(F, ws + WS_REC, WSP(bf16, WS_O));
                   if (F.bid < 64 && rep == 0) { LAS float* scr = (LAS float*)(F.lds + RING_OFF + F.wave * 16640);
                       convert_weights<(layer == 1 ? 1 : 2)>(ap, scr, 0, 1, F.lane, (unsigned*)(ws + WS_CTL) + CW_CONV, F.wave, F.tid == 0, (volatile LAS unsigned*)(F.lds + MISC_OFF) + 32); }
                   if (F.bid >= 64 && rep == 0) {
                       { pg8::Gemm g{WSP(const bf16, WS_H), WSP(const bf16, WS_W_GLIN) + (size_t)li * C_N * DM + (size_t)4096 * DM, M, 2048, DM}; pg8::StaticOrder S; S.init(M, 2048, F.G - 64, F.bid - 64);
                         pg8::EpiBf16 E{WSP(bf16, WS_PROJ) + 4096, C_N};
                         pg8::gemm_phase<pg8::EpiBf16, pg8::StaticOrder, true, true>(F.lds + RING_OFF, g, S, E, F.tid); }
                       LAS float* scr = (LAS float*)(F.lds + RING_OFF + F.wave * 16640);
                       convert_weights<(layer == 1 ? 1 : 2)>(ap, scr, 0, 1, F.lane, (unsigned*)(ws + WS_CTL) + CW_CONV, F.wave, F.tid == 0, (volatile LAS unsigned*)(F.lds + MISC_OFF) + 32); } }
            REPBAR(rep, (odd ? NREP(8) : 1)); }
            SEAM(P_REC);
        }
        if (IN(P_POST)) { REFRAME();
            if (!odd) post_even(F, WSP(const bf16, WS_O), WSP(const bf16, WS_PROJ), ap->in[9] + li * 1024, WSP(bf16, WS_CAT));
            else for (int rep = 0; rep < NREP(16); ++rep) { post_odd(F, WSP(const bf16, WS_O), WSP(const bf16, WS_PROJ), ap->in[16] + li * 512, WSP(bf16, WS_CAT)); REPBAR(rep, NREP(16)); }
            SEAM(P_POST);
        }
        if (IN(P_MIXOUT)) { REFRAME();
            const float* modl = MODL;
            const bf16* Wt = odd ? WSP(const bf16, WS_W_GLOUT) + (size_t)li * DM * DM : WSP(const bf16, WS_W_ABOUT) + (size_t)li * DM * DM;
            pg8::Gemm g{WSP(const bf16, WS_CAT), Wt, M, DM, DM}; pg8::StaticOrder S; S.init(M, DM, F.G, F.bid);
            pg8::EpiBf16 E{WSP(bf16, WS_Y), DM};
            pg8::gemm_phase<pg8::EpiBf16, pg8::StaticOrder, true, true>(F.lds + RING_OFF, g, S, E, F.tid);
            SEAM(P_MIXOUT);
        }
        if (IN(P_NORM2)) { REFRAME();
            const float* modl = MODL;
            { constexpr bool L0 = layer == 0; const void* xin = L0 ? (const void*)ap->in[0] : (const void*)WSP(const bf16, WS_XB);
              norm_phase<0, 0, true, L0>(F, xin, ap->in[5] + (size_t)layer * DM, modl + 3 * DM, modl + 4 * DM, WSP(bf16, WS_H), nullptr, 0, nullptr, nullptr, WSP(const bf16, WS_Y), modl + 2 * DM, WSP(bf16, WS_XB)); }
            SEAM(P_NORM2);
        }
        if (IN(P_FFIN)) { REFRAME();
            pg8::Gemm g{WSP(const bf16, WS_H), WSP(const bf16, WS_W_FFIN) + (size_t)layer * FF2 * DM, M, FF2, DM}; pg8::StaticOrder S; S.init(M, FF2, F.G, F.bid);
            pg8::EpiSwiglu E{WSP(bf16, WS_FFH), FF};
            for (int rep = 0; rep < NREP(1 | 128); ++rep) { pg8::gemm_phase<pg8::EpiSwiglu, pg8::StaticOrder, true, true>(F.lds + RING_OFF, g, S, E, F.tid); REPBAR(rep, NREP(1 | 128)); }
            SEAM(P_FFIN);
        }
        if (IN(P_FFOUT)) { REFRAME();
            const float* modl = MODL;
            pg8::Gemm g{WSP(const bf16, WS_FFH), WSP(const bf16, WS_W_FFOUT) + (size_t)layer * DM * FF, M, DM, FF}; pg8::StaticOrder S; S.init(M, DM, F.G, F.bid);
            if constexpr (layer == DEPTH - 1) {
                const float* g2 = WSP(float, WS_MOD) + (size_t)(DEPTH - 1) * 2 * 6 * DM + 5 * DM;
                pg8::EpiResidBf E{(const pg8::bf16_t*)WSP(const bf16, WS_XB), ap->out, DM, g2, g2 + 6 * DM, (int)(T / pg8::BM)};
                pg8::gemm_phase<pg8::EpiResidBf, pg8::StaticOrder, true, true>(F.lds + RING_OFF, g, S, E, F.tid);
            } else {
            pg8::EpiBf16 E{WSP(bf16, WS_Y), DM};
            pg8::gemm_phase<pg8::EpiBf16, pg8::StaticOrder, true, true>(F.lds + RING_OFF, g, S, E, F.tid); }
            SEAM(P_FFOUT);
        }
    }
__global__ void __launch_bounds__(NTHREADS, 2) trunk_fwd(Args args_unused) {
    extern __shared__ __attribute__((aligned(16))) unsigned char lds[];
    Frame F;
    const int wave_s = __builtin_amdgcn_readfirstlane(threadIdx.x >> 6);
    int lo, hi, use_bar; XcdBarrier bar;
    {
        REFRAME();
        volatile LAS unsigned* MISC = (volatile LAS unsigned*)(F.lds + MISC_OFF);
        for (int u = F.tid; u < (LDS_BYTES - LDSCTL_OFF) / 4; u += NTHREADS) ((LAS unsigned*)(F.lds + LDSCTL_OFF))[u] = 0u;
        __syncthreads();
        lo = ap->ph_lo; hi = ap->ph_hi; use_bar = ap->use_bar;
        bar.bar = (unsigned*)(ws + WS_CTL) + CW_BAR; bar.x = 0; bar.st = MISC + 8;
        if (use_bar) bar = xcd_barrier_post((unsigned*)(ws + WS_CTL) + CW_BAR, MISC + 8, F.tid == 0);
    }

    if (IN(0)) { REFRAME(); p0_prologue(F, ap); if (IN(1)) xcd_barrier<true>(bar, F.tid == 0);
        if (DBG_DOUBLE & 32) { p0_prologue(F, ap); xcd_barrier<false>(bar, F.tid == 0); } }

    layer_phases<0>(lds, wave_s, lo, hi, bar);
    layer_phases<1>(lds, wave_s, lo, hi, bar);
    layer_phases<2>(lds, wave_s, lo, hi, bar);
    layer_phases<3>(lds, wave_s, lo, hi, bar);
#undef IN
#undef SEAM
}

#ifndef DBG_CHECK
#define DBG_CHECK 0
#endif
#if DBG_CHECK
#ifndef DBG_REPORT_ERR
#define DBG_REPORT_ERR 1
#endif
constexpr size_t WS_DBG = 5 * MiB;
constexpr size_t WS_DBG_OLD = 1072 * MiB;
__device__ __forceinline__ unsigned dbg_hash(unsigned x) { x ^= x >> 16; x *= 0x7feb352dU; x ^= x >> 15; x *= 0x846ca68bU; x ^= x >> 16; return x; }
__device__ __forceinline__ float dbg_bfr(float f) { return __builtin_bit_cast(float, f2bf(f) << 16); }
__device__ __forceinline__ void dbg_cmp(unsigned* dbg, unsigned code, float got, float ref, float rtol, float atol) {
    const float err = fabsf(got - ref); const bool bad = !(err <= atol + rtol * fabsf(ref));
    if (bad) { atomicMin(dbg, code); atomicMax(dbg + 1 + (code & 255u), __float_as_uint(err)); }
}
__global__ void dbg_gemm(unsigned* dbg, unsigned code, int mode, const bf16* A, int K, const float* W, int ldw, int N, const void* C, int ldc, const float* old, const float* gate0, const float* gate1) {
    const unsigned s = blockIdx.x * blockDim.x + threadIdx.x; const unsigned hsh = dbg_hash(s * 2654435761u + code);
    const int m = hsh % M, n = dbg_hash(hsh) % N;
    float d0 = 0.f, d1 = 0.f;
    for (int k = 0; k < K; ++k) { const float a = bf1(A[(size_t)m * K + k]); d0 += a * dbg_bfr(W[(size_t)k * ldw + n]); if (mode == 1) d1 += a * dbg_bfr(W[(size_t)k * ldw + FF + n]); }
    float got, ref;
    if (mode == 0) { got = bf1(((const bf16*)C)[(size_t)m * ldc + n]); ref = d0; }
    else if (mode == 1) { got = bf1(((const bf16*)C)[(size_t)m * ldc + n]); ref = d0 / (1.f + expf(-d0)) * d1; }
    else { got = ((const float*)C)[(size_t)m * ldc + n]; ref = old[(size_t)m * ldc + n] + (m >= T ? gate1 : gate0)[n] * d0; }
    dbg_cmp(dbg, code, got, ref, 0.02f, 0.03f);
}
__global__ void dbg_norm(unsigned* dbg, unsigned code, const float* x, const float* gain, const float* sh, const float* sc, const bf16* h) {
    const unsigned s = blockIdx.x * blockDim.x + threadIdx.x; const unsigned hsh = dbg_hash(s * 2654435761u + code);
    const int m = hsh % M, k = dbg_hash(hsh) % DM, b = m / T;
    double ss = 0.0; for (int i = 0; i < DM; ++i) { const double v = x[(size_t)m * DM + i]; ss += v * v; }
    const float rstd = (float)(1.0 / sqrt(ss / DM + 1e-6));
    const float ref = x[(size_t)m * DM + k] * rstd * gain[k] * (1.f + sc[(size_t)b * 6 * DM + k]) + sh[(size_t)b * 6 * DM + k];
    dbg_cmp(dbg, code, bf1(h[(size_t)m * DM + k]), ref, 0.01f, 0.01f);
}
__global__ void dbg_mod(unsigned* dbg, unsigned code, const float* c, const float* mw, const float* mb, const float* mod) {
    const unsigned s = blockIdx.x * blockDim.x + threadIdx.x; const unsigned hsh = dbg_hash(s * 2654435761u + code);
    const int layer = hsh % DEPTH, b = (hsh >> 8) & 1, j = dbg_hash(hsh) % (6 * DM);
    double acc = mb[(size_t)layer * 6 * DM + j];
    for (int k = 0; k < DM; ++k) { const double cv = c[b * DM + k]; acc += cv / (1.0 + exp(-cv)) * mw[((size_t)layer * DM + k) * (6 * DM) + j]; }
    dbg_cmp(dbg, code, mod[((size_t)layer * 2 + b) * 6 * DM + j], (float)acc, 1e-3f, 1e-4f);
}
__global__ void dbg_small(unsigned* dbg, unsigned code, int mode, const bf16* h, const float* W, int ldw, const float* fbias, const float* sout) {
    const unsigned s = blockIdx.x * blockDim.x + threadIdx.x; const unsigned hsh = dbg_hash(s * 2654435761u + code);
    const int m = hsh % M, cc = dbg_hash(hsh) % (mode == 1 ? 8 : 16), b = m / T, t = m % T;
    double acc = 0.0; for (int k = 0; k < DM; ++k) acc += (double)bf1(h[(size_t)m * DM + k]) * W[(size_t)k * ldw + cc];
    if (mode == 1) { const double xx = acc + fbias[cc]; const double ref = (xx < 0 ? xx : 0.0) - log1p(exp(-fabs(xx))); dbg_cmp(dbg, code, sout[((size_t)b * 8 + cc) * T + t], (float)ref, 0.02f, 0.02f); }
    else dbg_cmp(dbg, code, sout[(size_t)m * 16 + cc], (float)acc, 0.02f, 0.02f);
}
__global__ void dbg_cmpbuf(unsigned* dbg, unsigned code, const float* a, const float* b, size_t n) {
    for (size_t i = (size_t)blockIdx.x * blockDim.x + threadIdx.x; i < n; i += (size_t)gridDim.x * blockDim.x * 61) dbg_cmp(dbg, code, b[i], a[i], 0.05f, 0.1f);
}
__global__ void dbg_report(const unsigned* dbg, float* out) {
    if (threadIdx.x == 0 && blockIdx.x == 0) { const unsigned code = dbg[0]; if (code != 0xffffffffu) { out[0] = DBG_REPORT_ERR ? 1000.f * __uint_as_float(dbg[1 + (code & 255u)]) : 1000.f * (float)(code & 255u); } }
}
#endif
#ifndef N_LAUNCH_MODE
#define N_LAUNCH_MODE 1
#endif
extern "C" void kernel_launch(void* const* d_in, const int* in_sizes, int n_in, void* d_out, int out_size, void* d_ws, size_t ws_size, hipStream_t stream) {
    static int grid = 0;
    if (grid == 0) {
        if (n_in != 20 || out_size != M * DM || ws_size < WS_END) { fprintf(stderr, "kernel_launch: unexpected shapes (n_in %d out %d ws %zu)\n", n_in, out_size, ws_size); grid = -1; return; }
        int dev = 0, cus = 0, per_cu = 0;
        if (hipGetDevice(&dev) != hipSuccess || hipDeviceGetAttribute(&cus, hipDeviceAttributeMultiprocessorCount, dev) != hipSuccess) { grid = -1; return; }
        if (hipFuncSetAttribute((const void*)trunk_fwd, hipFuncAttributeMaxDynamicSharedMemorySize, LDS_BYTES) != hipSuccess) { fprintf(stderr, "kernel_launch: hipFuncSetAttribute failed\n"); grid = -1; return; }
        if (hipOccupancyMaxActiveBlocksPerMultiprocessor(&per_cu, (const void*)trunk_fwd, NTHREADS, LDS_BYTES) != hipSuccess || per_cu < 1)
            fprintf(stderr, "kernel_launch: occupancy query reports %d workgroups per CU\n", per_cu);
        (void)hipGetLastError();
        grid = cus;
    }
    if (grid < 0) return;
    if (hipMemsetAsync((char*)d_ws + WS_CTL, 0, CTL_ZERO_BYTES, stream) != hipSuccess) return;
    Args a{};
    for (int i = 0; i < 20; ++i) a.in[i] = (const float*)d_in[i];
    a.out = (float*)d_out; a.ws = (unsigned char*)d_ws; a.pad = 0;
#if N_LAUNCH_MODE == 1
    a.ph_lo = 0; a.ph_hi = N_PHASES; a.use_bar = 1;
    hipLaunchKernelGGL(trunk_fwd, dim3(grid), dim3(NTHREADS), LDS_BYTES, stream, a);
#else
    a.use_bar = 0;
#if DBG_CHECK
    unsigned char* wsb = (unsigned char*)d_ws; unsigned* dbg = (unsigned*)(wsb + WS_DBG);
    hipMemsetAsync(dbg, 0xFF, 4, stream); hipMemsetAsync(dbg + 1, 0, 1024, stream);
    const float* const* in = (const float* const*)a.in; float* outp = (float*)d_out; float* oldp = (float*)(wsb + WS_DBG_OLD);
    bf16* hbuf = (bf16*)(wsb + WS_H); bf16* catb = (bf16*)(wsb + WS_CAT); bf16* projb = (bf16*)(wsb + WS_PROJ); bf16* ffhb = (bf16*)(wsb + WS_FFH);
#endif
    for (int p = 0; p < N_PHASES; ++p) {
        int layer = 0; const int q = phase_kind(p, layer); const int li = layer >> 1; const bool odd = layer & 1; (void)li; (void)odd; (void)q;
#if DBG_CHECK
        const float* modl = (const float*)(wsb + WS_MOD) + (size_t)layer * 2 * 6 * DM; const float* xcur = layer == 0 ? in[0] : outp;
        if (q == K_MIXOUT) hipMemcpyAsync(oldp, xcur, (size_t)M * DM * 4, hipMemcpyDeviceToDevice, stream);
        if (q == K_FFOUT) hipMemcpyAsync(oldp, outp, (size_t)M * DM * 4, hipMemcpyDeviceToDevice, stream);
#endif
        a.ph_lo = p; a.ph_hi = p + 1;
        hipLaunchKernelGGL(trunk_fwd, dim3(grid), dim3(NTHREADS), LDS_BYTES, stream, a);
#if DBG_CHECK
        const unsigned code = 1 + p;
        if (q == K_PRO) dbg_mod<<<16, 256, 0, stream>>>(dbg, code, in[1], in[2], in[3], (const float*)(wsb + WS_MOD));
        if (q == K_NORM1) { dbg_norm<<<16, 256, 0, stream>>>(dbg, code, xcur, in[4] + (size_t)layer * DM, modl, modl + DM, hbuf);
            if (!odd) dbg_small<<<16, 256, 0, stream>>>(dbg, code | 0x100, 1, hbuf, in[6] + (size_t)li * DM * AB_IN + AB_N, AB_IN, in[12] + li * 8, (const float*)(wsb + WS_LOGF));
            else dbg_small<<<16, 256, 0, stream>>>(dbg, code | 0x100, 2, hbuf, in[13] + (size_t)li * DM * C_IN + C_N, C_IN, nullptr, (const float*)(wsb + WS_GLOW)); }
        if (q == K_MIXIN) { if (!odd) dbg_gemm<<<16, 256, 0, stream>>>(dbg, code, 0, hbuf, DM, in[6] + (size_t)li * DM * AB_IN, AB_IN, AB_N, projb, AB_N, nullptr, nullptr, nullptr);
            else dbg_gemm<<<16, 256, 0, stream>>>(dbg, code, 0, hbuf, DM, in[13] + (size_t)li * DM * C_IN, C_IN, C_N, projb, C_N, nullptr, nullptr, nullptr); }
#if DBG_REC
        if (q == K_REC) dbg_cmpbuf<<<256, 256, 0, stream>>>(dbg, code, (const float*)(wsb + WS_O), (const float*)(wsb + 1200 * MiB), odd ? (size_t)M * 2048 : (size_t)M * 1024);
#endif
        if (q == K_MIXOUT) dbg_gemm<<<16, 256, 0, stream>>>(dbg, code, 2, catb, DM, (odd ? in[17] : in[7]) + (size_t)li * DM * DM, DM, DM, outp, DM, oldp, modl + 2 * DM, modl + 6 * DM + 2 * DM);
        if (q == K_NORM2) dbg_norm<<<16, 256, 0, stream>>>(dbg, code, outp, in[5] + (size_t)layer * DM, modl + 3 * DM, modl + 4 * DM, hbuf);
        if (q == K_FFIN) dbg_gemm<<<16, 256, 0, stream>>>(dbg, code, 1, hbuf, DM, in[18] + (size_t)layer * DM * FF2, FF2, FF, ffhb, FF, nullptr, nullptr, nullptr);
        if (q == K_FFOUT) dbg_gemm<<<16, 256, 0, stream>>>(dbg, code, 2, ffhb, FF, in[19] + (size_t)layer * FF * DM, DM, DM, outp, DM, oldp, modl + 5 * DM, modl + 6 * DM + 5 * DM);
#endif
    }
#if DBG_CHECK
    dbg_report<<<1, 64, 0, stream>>>(dbg, outp);
#endif
#endif
}
```

```cpp
#include <hip/hip_runtime.h>
#include <hip/hip_bf16.h>
#include <cstdio>
#include <cstdint>
__device__ __forceinline__ int opq_tid(int wave_s) {
    int t; asm volatile("v_mbcnt_lo_u32_b32 %0, -1, 0\n\tv_mbcnt_hi_u32_b32 %0, -1, %0\n\tv_lshl_add_u32 %0, %1, 6, %0" : "=&v"(t) : "s"(wave_s)); return t; }
__device__ __forceinline__ int opq_bid() { int t = blockIdx.x; asm volatile("" : "+s"(t)); return t; }
template <int MASK> __device__ __forceinline__ float xsum(float v) {
    if constexpr (MASK < 32) { return v + __builtin_bit_cast(float, __builtin_amdgcn_ds_swizzle(__builtin_bit_cast(int, v), (MASK << 10) | 0x1f)); }
    else { auto rr = __builtin_amdgcn_permlane32_swap(__float_as_uint(v), __float_as_uint(v), false, false);
           const unsigned r0 = rr[0], r1 = rr[1];
           return __uint_as_float(r0) + __uint_as_float(r1); }
}
__device__ __forceinline__ float xor1_get(float v) { return __builtin_bit_cast(float, __builtin_amdgcn_ds_swizzle(__builtin_bit_cast(int, v), (1 << 10) | 0x1f)); }
namespace pg8 {
#define PG8_LAS __attribute__((address_space(3)))
typedef unsigned short bf16_t;
typedef short bf16x8 __attribute__((ext_vector_type(8)));
typedef float f32x4 __attribute__((ext_vector_type(4)));
typedef unsigned u32x4 __attribute__((ext_vector_type(4)));
constexpr int BM = 256, BK = 64, HALF = 128, HTB = HALF * BK * 2  , STAGE_BYTES = 8 * HTB, NXCD = 8, WGM = 8;

__host__ __device__ __forceinline__ int lds_byte(int r, int c) { const int st = (r >> 4) * 2 + (c >> 5), rr = r & 15, cc = c & 31, ob = rr * 64 + cc * 2; return st * 1024 + (ob ^ (((ob >> 9) & 1) << 5)); }
__host__ __device__ __forceinline__ void stage_rc(int b, int& R, int& C) { const int st = b / 1024, sb = b % 1024, swz = sb ^ (((sb >> 9) & 1) << 5); R = (st >> 1) * 16 + swz / 64; C = (st & 1) * 32 + (swz % 64) / 2; }
__host__ __device__ __forceinline__ int perm32(int rho) { const int n = rho >> 4, i = rho & 15; return 8 * (i >> 2) + 4 * n + (i & 3); }

struct Unit { int pm, pn; };
struct Gemm { const bf16_t* A; const bf16_t* Bt; int M, N, K; };

struct StaticOrder {
    int nM, nN, nwg, G, c;
    __host__ __device__ void init(int M, int N, int G_, int c_) { nM = M / BM; nN = N / BM; nwg = nM * nN; G = G_; c = c_; }
    __host__ __device__ bool next(int i, Unit& u) const {
        const long L = (long)i * G + c; if (L >= nwg) return false;
        int wgid = (int)L; { const int q = nwg / NXCD, r = nwg % NXCD, xcd = wgid % NXCD, off = wgid / NXCD; wgid = (xcd < r ? xcd * (q + 1) : r * (q + 1) + (xcd - r) * q) + off; }
        const int nig = WGM * nN, gid = wgid / nig, fm = gid * WGM, gsz = (nM - fm) < WGM ? (nM - fm) : WGM;
        u.pm = fm + ((wgid % nig) % gsz); u.pn = (wgid % nig) / gsz; return true;
    }
    __device__ __forceinline__ void a_ready(const Unit&) const {}
    __device__ __forceinline__ void done(const Unit&) const {}
};

__device__ __forceinline__ unsigned cvt_pk_bf16(float lo, float hi) { unsigned r; asm volatile("v_cvt_pk_bf16_f32 %0, %1, %2" : "=v"(r) : "v"(lo), "v"(hi)); return r; }
typedef float f32x2 __attribute__((ext_vector_type(2)));

struct EpiBf16 {
    static constexpr bool PERM = true, AFTER_DRAIN = false;
    bf16_t* O; int ldc;
    __device__ __forceinline__ void operator()(const f32x4 (&acc)[2][2][4][2], const Unit& u, int wr, int wc, int fr, int fq) const {
        const int row0 = u.pm * BM + wr * 64 + fr; const int col0 = u.pn * BM + wc * 32 + 8 * fq;
#pragma unroll
        for (int ai = 0; ai < 2; ++ai)
#pragma unroll
            for (int m = 0; m < 4; ++m) { bf16_t* rowp = O + (size_t)(row0 + ai * HALF + m * 16) * ldc + col0;
#pragma unroll
                for (int bj = 0; bj < 2; ++bj) { const f32x4 v0 = acc[ai][bj][m][0], v1 = acc[ai][bj][m][1];
                    u32x4 w; w.x = cvt_pk_bf16(v0[0], v0[1]); w.y = cvt_pk_bf16(v0[2], v0[3]); w.z = cvt_pk_bf16(v1[0], v1[1]); w.w = cvt_pk_bf16(v1[2], v1[3]);
                    *(u32x4*)(rowp + bj * HALF) = w; } }
    }
};
__device__ __forceinline__ float silu_f(float a) { return a * __builtin_amdgcn_rcpf(1.0f + __builtin_amdgcn_exp2f(-1.4426950408889634f * a)); }
struct EpiSwiglu {
    static constexpr bool PERM = true, AFTER_DRAIN = false;
    bf16_t* O; int ldc;
    __device__ __forceinline__ void operator()(const f32x4 (&acc)[2][2][4][2], const Unit& u, int wr, int wc, int fr, int fq) const {
        const int row0 = u.pm * BM + wr * 64 + fr; const int col0 = u.pn * HALF + wc * 32 + 8 * fq;
#pragma unroll
        for (int ai = 0; ai < 2; ++ai)
#pragma unroll
            for (int m = 0; m < 4; ++m) { bf16_t* rowp = O + (size_t)(row0 + ai * HALF + m * 16) * ldc + col0;
                const f32x4 a0 = acc[ai][0][m][0], a1 = acc[ai][0][m][1], u0 = acc[ai][1][m][0], u1 = acc[ai][1][m][1];
                u32x4 w;
                w.x = cvt_pk_bf16(silu_f(a0[0]) * u0[0], silu_f(a0[1]) * u0[1]); w.y = cvt_pk_bf16(silu_f(a0[2]) * u0[2], silu_f(a0[3]) * u0[3]);
                w.z = cvt_pk_bf16(silu_f(a1[0]) * u1[0], silu_f(a1[1]) * u1[1]); w.w = cvt_pk_bf16(silu_f(a1[2]) * u1[2], silu_f(a1[3]) * u1[3]);
                *(u32x4*)rowp = w; }
    }
};
struct EpiResid {
    static constexpr bool PERM = false, AFTER_DRAIN = false;
    const float* base; float* out; int ldc; const float* gate0; const float* gate1; int pm_split;
    __device__ __forceinline__ void operator()(const f32x4 (&acc)[2][2][4][2], const Unit& u, int wr, int wc, int fr, int fq) const {
        const int col0 = u.pn * BM + wc * 32 + 4 * fq; const float* g = (u.pm >= pm_split) ? gate1 : gate0;
        f32x4 gv[2][2];
#pragma unroll
        for (int bj = 0; bj < 2; ++bj)
#pragma unroll
            for (int n = 0; n < 2; ++n) gv[bj][n] = *(const f32x4*)(g + col0 + bj * HALF + n * 16);
#pragma unroll
        for (int ai = 0; ai < 2; ++ai) { f32x4 bs[4][2][2];
#pragma unroll
            for (int m = 0; m < 4; ++m) { const size_t off = (size_t)(u.pm * BM + ai * HALF + wr * 64 + m * 16 + fr) * ldc + col0;
#pragma unroll
                for (int bj = 0; bj < 2; ++bj)
#pragma unroll
                    for (int n = 0; n < 2; ++n) bs[m][bj][n] = *(const f32x4*)(base + off + bj * HALF + n * 16); }
#pragma unroll
            for (int m = 0; m < 4; ++m) { const size_t off = (size_t)(u.pm * BM + ai * HALF + wr * 64 + m * 16 + fr) * ldc + col0;
#pragma unroll
                for (int bj = 0; bj < 2; ++bj)
#pragma unroll
                    for (int n = 0; n < 2; ++n) *(f32x4*)(out + off + bj * HALF + n * 16) = bs[m][bj][n] + gv[bj][n] * acc[ai][bj][m][n]; }
            asm volatile("" ::: "memory"); }
    }
};
struct EpiResidBf {
    static constexpr bool PERM = false, AFTER_DRAIN = false;
    const bf16_t* xb; float* out; int ldc; const float* gate0; const float* gate1; int pm_split;
    typedef unsigned u32x2 __attribute__((ext_vector_type(2)));
    __device__ __forceinline__ void operator()(const f32x4 (&acc)[2][2][4][2], const Unit& u, int wr, int wc, int fr, int fq) const {
        const int col0 = u.pn * BM + wc * 32 + 4 * fq; const float* g = (u.pm >= pm_split) ? gate1 : gate0;
        f32x4 gv[2][2];
#pragma unroll
        for (int bj = 0; bj < 2; ++bj)
#pragma unroll
            for (int n = 0; n < 2; ++n) gv[bj][n] = *(const f32x4*)(g + col0 + bj * HALF + n * 16);
#pragma unroll
        for (int ai = 0; ai < 2; ++ai) { u32x2 bs[4][2][2];
#pragma unroll
            for (int m = 0; m < 4; ++m) { const size_t off = (size_t)(u.pm * BM + ai * HALF + wr * 64 + m * 16 + fr) * ldc + col0;
#pragma unroll
                for (int bj = 0; bj < 2; ++bj)
#pragma unroll
                    for (int n = 0; n < 2; ++n) bs[m][bj][n] = *(const u32x2*)(xb + off + bj * HALF + n * 16); }
#pragma unroll
            for (int m = 0; m < 4; ++m) { const size_t off = (size_t)(u.pm * BM + ai * HALF + wr * 64 + m * 16 + fr) * ldc + col0;
#pragma unroll
                for (int bj = 0; bj < 2; ++bj)
#pragma unroll
                    for (int n = 0; n < 2; ++n) { const u32x2 b = bs[m][bj][n];
                        const f32x4 xv = {__uint_as_float(b.x << 16), __uint_as_float(b.x & 0xffff0000u), __uint_as_float(b.y << 16), __uint_as_float(b.y & 0xffff0000u)};
                        *(f32x4*)(out + off + bj * HALF + n * 16) = xv + gv[bj][n] * acc[ai][bj][m][n]; } }
            asm volatile("" ::: "memory"); }
    }
};

template <class Epi, class Sched, bool ALIGN_EPI = false, bool SP2 = false>
__device__ __forceinline__ void gemm_phase(PG8_LAS unsigned char* lds, const Gemm g, const Sched& S, const Epi& E, const int tid) {
    const int wid = __builtin_amdgcn_readfirstlane(tid >> 6), lane = tid & 63, wr = wid >> 2, wc = wid & 3, fr = lane & 15, fq = lane >> 4;
    const int K = g.K, nt = K / BK;
    unsigned voffA[2], voffB[2];
#pragma unroll
    for (int i = 0; i < 2; ++i) { int R, C; stage_rc(tid * 16 + i * 8192, R, C); const int Rb = Epi::PERM ? ((R & ~31) + perm32(R & 31)) : R;
        voffA[i] = (unsigned)(R * K + C) * 2u; voffB[i] = (unsigned)(Rb * K + C) * 2u; }
    const size_t kstep = (size_t)(BK * 2);
    const size_t hstep = (size_t)HALF * K * 2;
    const size_t tstep = 2 * hstep;
    const unsigned ldsw = (unsigned)wid * 1024u;
    const int aoff = lds_byte(wr * 64 + fr, fq * 8), boff = lds_byte(wc * 32 + fr, fq * 8);
#define PG8_SA(b, h) (((b) * 2 + (h)) * HTB)
#define PG8_SB(b, h) ((4 + (b) * 2 + (h)) * HTB)
#define PG8_STAGE(bufoff, gbase, voff) do { _Pragma("unroll") for (int _i = 0; _i < 2; ++_i) \
        __builtin_amdgcn_global_load_lds((const unsigned*)((const char*)(gbase) + (voff)[_i]), (PG8_LAS unsigned*)(lds + (bufoff) + ldsw + _i * 8192), 16, 0, 0); } while (0)
#define PG8_LDA(dst, b, h) do { _Pragma("unroll") for (int m = 0; m < 4; ++m) _Pragma("unroll") for (int k = 0; k < 2; ++k) dst[m][k] = *(const PG8_LAS bf16x8*)(lds + PG8_SA(b, h) + aoff + m * 2048 + k * 1024); } while (0)
#define PG8_LDB(dst, b, h) do { _Pragma("unroll") for (int n = 0; n < 2; ++n) _Pragma("unroll") for (int k = 0; k < 2; ++k) dst[n][k] = *(const PG8_LAS bf16x8*)(lds + PG8_SB(b, h) + boff + n * 2048 + k * 1024); } while (0)
#define PG8_MMA(ai, bj, At, Bt) do { __builtin_amdgcn_s_setprio(1); _Pragma("unroll") for (int m = 0; m < 4; ++m) _Pragma("unroll") for (int n = 0; n < 2; ++n) _Pragma("unroll") for (int k = 0; k < 2; ++k) \
        acc[ai][bj][m][n] = __builtin_amdgcn_mfma_f32_16x16x32_bf16(Bt[n][k], At[m][k], acc[ai][bj][m][n], 0, 0, 0); __builtin_amdgcn_s_setprio(0); } while (0)
#define PG8_WAIT_V(n) asm volatile("s_waitcnt vmcnt(" #n ")" ::: "memory")
#define PG8_WAIT_L(n) asm volatile("s_waitcnt lgkmcnt(" #n ")" ::: "memory")
#define PG8_BAR __builtin_amdgcn_s_barrier()
#define PG8_SCHED __builtin_amdgcn_sched_barrier(0)
    Unit cur, nxt; int ui = 0;
    if (!S.next(0, cur)) return;
    f32x4 acc[2][2][4][2];
#pragma unroll
    for (int a = 0; a < 2; ++a)
#pragma unroll
        for (int b = 0; b < 2; ++b)
#pragma unroll
            for (int m = 0; m < 4; ++m)
#pragma unroll
                for (int n = 0; n < 2; ++n) acc[a][b][m][n] = (f32x4){0.f, 0.f, 0.f, 0.f};
    bf16x8 At[4][2], B0[2][2], B1[2][2];
    const char* cA = (const char*)g.A + (size_t)cur.pm * tstep; const char* cB = (const char*)g.Bt + (size_t)cur.pn * tstep;
    S.a_ready(cur);
    if constexpr (SP2) {
        PG8_STAGE(PG8_SB(0, 0), cB, voffB); PG8_STAGE(PG8_SB(0, 1), cB + hstep, voffB); PG8_STAGE(PG8_SA(0, 0), cA, voffA); PG8_STAGE(PG8_SA(0, 1), cA + hstep, voffA);
        if (wr == 1) PG8_BAR;
        PG8_WAIT_V(2); PG8_BAR;
        PG8_STAGE(PG8_SB(1, 0), cB + kstep, voffB); PG8_STAGE(PG8_SA(1, 0), cA + kstep, voffA); PG8_STAGE(PG8_SB(1, 1), cB + hstep + kstep, voffB);
        PG8_WAIT_V(6); PG8_BAR;
    } else {
        PG8_STAGE(PG8_SB(0, 0), cB, voffB); PG8_STAGE(PG8_SA(0, 0), cA, voffA); PG8_STAGE(PG8_SB(0, 1), cB + hstep, voffB); PG8_STAGE(PG8_SA(0, 1), cA + hstep, voffA);
        if (wr == 1) PG8_BAR;
        PG8_WAIT_V(4); PG8_BAR;
        PG8_STAGE(PG8_SB(1, 0), cB + kstep, voffB); PG8_STAGE(PG8_SA(1, 0), cA + kstep, voffA); PG8_STAGE(PG8_SB(1, 1), cB + hstep + kstep, voffB);
        PG8_WAIT_V(6); PG8_BAR;
    }
    for (;;) {
        const bool has_next = S.next(ui + 1, nxt);
        const char* nA = has_next ? (const char*)g.A + (size_t)nxt.pm * tstep : cA; const char* nB = has_next ? (const char*)g.Bt + (size_t)nxt.pn * tstep : cB;
        for (int t = 0; t < nt; t += 2) {
            const bool last = (t == nt - 2);
            const char* a1 = cA + (size_t)(t + 1) * kstep;
            const char* a2 = last ? nA : cA + (size_t)(t + 2) * kstep; const char* b2 = last ? nB : cB + (size_t)(t + 2) * kstep;
            const char* a3 = a2 + kstep; const char* b3 = b2 + kstep;
            if (last && has_next) S.a_ready(nxt);
            if constexpr (SP2) {
            PG8_LDB(B0, 0, 0); PG8_LDB(B1, 0, 1); PG8_SCHED; PG8_LDA(At, 0, 0); PG8_STAGE(PG8_SA(1, 1), a1 + hstep, voffA);
            PG8_WAIT_V(8); PG8_WAIT_L(0); PG8_BAR; PG8_MMA(0, 0, At, B0); PG8_MMA(0, 1, At, B1); PG8_BAR; PG8_SCHED;
            PG8_LDA(At, 0, 1); PG8_STAGE(PG8_SB(0, 0), b2, voffB); PG8_STAGE(PG8_SB(0, 1), b2 + hstep, voffB); PG8_STAGE(PG8_SA(0, 0), a2, voffA);
            PG8_WAIT_V(8); PG8_WAIT_L(0); PG8_BAR; PG8_MMA(1, 0, At, B0); PG8_MMA(1, 1, At, B1); PG8_BAR; PG8_SCHED;
            PG8_LDB(B0, 1, 0); PG8_LDB(B1, 1, 1); PG8_SCHED; PG8_LDA(At, 1, 0); PG8_STAGE(PG8_SA(0, 1), a2 + hstep, voffA);
            PG8_WAIT_V(8); PG8_WAIT_L(0); PG8_BAR; PG8_MMA(0, 0, At, B0); PG8_MMA(0, 1, At, B1); PG8_BAR; PG8_SCHED;
            PG8_LDA(At, 1, 1); PG8_STAGE(PG8_SB(1, 0), b3, voffB); PG8_STAGE(PG8_SB(1, 1), b3 + hstep, voffB); PG8_STAGE(PG8_SA(1, 0), a3, voffA);
            PG8_WAIT_V(8); PG8_WAIT_L(0); PG8_BAR; PG8_MMA(1, 0, At, B0); PG8_MMA(1, 1, At, B1); PG8_BAR; PG8_SCHED;
            } else {
            PG8_LDB(B0, 0, 0); PG8_SCHED; PG8_LDA(At, 0, 0); PG8_STAGE(PG8_SA(1, 1), a1 + hstep, voffA);
            PG8_WAIT_L(8); PG8_BAR; PG8_WAIT_L(0); PG8_MMA(0, 0, At, B0); PG8_BAR; PG8_SCHED;
            PG8_LDB(B1, 0, 1); PG8_STAGE(PG8_SB(0, 0), b2, voffB);
            PG8_BAR; PG8_WAIT_L(0); PG8_MMA(0, 1, At, B1); PG8_BAR;
            PG8_LDA(At, 0, 1); PG8_STAGE(PG8_SA(0, 0), a2, voffA);
            PG8_BAR; PG8_WAIT_L(0); PG8_MMA(1, 0, At, B0); PG8_BAR; PG8_SCHED;
            PG8_STAGE(PG8_SB(0, 1), b2 + hstep, voffB);
            PG8_WAIT_V(6); PG8_BAR; PG8_MMA(1, 1, At, B1); PG8_BAR;
            PG8_LDB(B0, 1, 0); PG8_SCHED; PG8_LDA(At, 1, 0); PG8_STAGE(PG8_SA(0, 1), a2 + hstep, voffA);
            PG8_WAIT_L(8); PG8_BAR; PG8_WAIT_L(0); PG8_MMA(0, 0, At, B0); PG8_BAR; PG8_SCHED;
            PG8_LDB(B1, 1, 1); PG8_STAGE(PG8_SB(1, 0), b3, voffB);
            PG8_BAR; PG8_WAIT_L(0); PG8_MMA(0, 1, At, B1); PG8_BAR;
            PG8_LDA(At, 1, 1); PG8_STAGE(PG8_SA(1, 0), a3, voffA);
            PG8_BAR; PG8_WAIT_L(0); PG8_MMA(1, 0, At, B0); PG8_BAR; PG8_SCHED;
            PG8_STAGE(PG8_SB(1, 1), b3 + hstep, voffB);
            PG8_WAIT_V(6); PG8_BAR; PG8_MMA(1, 1, At, B1); PG8_BAR;
            }
        }
        if constexpr (ALIGN_EPI) { if (wr == 0) PG8_BAR; }
        if constexpr (!Epi::AFTER_DRAIN) { E(acc, cur, wr, wc, fr, fq); S.done(cur); }
        if (!has_next) break;
#pragma unroll
        for (int a = 0; a < 2; ++a)
#pragma unroll
            for (int b = 0; b < 2; ++b)
#pragma unroll
                for (int m = 0; m < 4; ++m)
#pragma unroll
                    for (int n = 0; n < 2; ++n) acc[a][b][m][n] = (f32x4){0.f, 0.f, 0.f, 0.f};
        cur = nxt; cA = nA; cB = nB; ++ui;
        if constexpr (ALIGN_EPI) { if (wr == 1) PG8_BAR; }
    }
    PG8_WAIT_V(0);
    if constexpr (!ALIGN_EPI) { if (wr == 0) PG8_BAR; }
    PG8_BAR;
    if constexpr (Epi::AFTER_DRAIN) { E.fused(acc, cur, wr, wc, fr, fq, lds, wid, lane); S.done(cur); }
#undef PG8_SA
#undef PG8_SB
#undef PG8_STAGE
#undef PG8_LDA
#undef PG8_LDB
#undef PG8_MMA
#undef PG8_WAIT_V
#undef PG8_WAIT_L
#undef PG8_BAR
#undef PG8_SCHED
}
}
namespace fox {
constexpr int D = 128, PITCH = 8192, OPITCH = 2048, SKV = 8192, GATE_OFF = 3072;
constexpr float THR = 8.f;
constexpr float SCALE = 0.08838834764831845f;
constexpr int NW = 8, QBLK = 32, KVBLK = 64, QB = NW * QBLK;
constexpr int SHM_V = KVBLK * D * 2, SHM_K = KVBLK * D * 2;
constexpr int BIAS_OFF = 2 * SHM_V + 2 * SHM_K + NW * 64 * 4;
constexpr int LDS_BYTES = BIAS_OFF + SKV * 4;

using bf16 = __hip_bfloat16;
typedef short bf16x8 __attribute__((ext_vector_type(8)));
typedef short s16x4 __attribute__((ext_vector_type(4)));
typedef float f32x16 __attribute__((ext_vector_type(16)));
typedef float f32x4 __attribute__((ext_vector_type(4)));
typedef unsigned u32x4 __attribute__((ext_vector_type(4)));

#define KSWZ(row, colB) ((row) * 256 + ((colB) ^ (((row) & 7) << 4)))
#define SBAR() __builtin_amdgcn_sched_barrier(0)
__device__ __forceinline__ int v_st(int k, int c) { const int kk = (k & ~0xC) | ((k & 4) << 1) | ((k & 8) >> 1); return ((kk >> 3) * 4 + (c >> 5)) * 512 + ((kk & 7) * 32 + (c & 31)) * 2; }
__device__ __forceinline__ int v_rd_base(int lane) { return ((lane & 3) << 3) | (((lane >> 2) & 3) << 6) | (((lane >> 4) & 1) << 5) | (((lane >> 5) & 1) << 8); }
constexpr int v_rd_off(int d0, int ks, int half) { return d0 * 512 + ks * 4096 + half * 2048; }
__device__ __forceinline__ int crow(int r, int hi) { return (r & 3) + 8 * (r >> 2) + 4 * hi; }
__device__ __forceinline__ unsigned cvtpk(float lo, float hi) {
    unsigned r; asm volatile("v_cvt_pk_bf16_f32 %0, %1, %2" : "=v"(r) : "v"(lo), "v"(hi)); return r;
}
__device__ __forceinline__ bf16x8 load8(const bf16* p) { return *reinterpret_cast<const bf16x8*>(p); }
__device__ __forceinline__ void mask_tile(f32x16& p0, f32x16& p1, int dq, unsigned W) {
    const float NEG = -__builtin_inff();
#pragma unroll
    for (int r = 0; r < 16; ++r) {
        const int c = (r & 3) + 8 * (r >> 2);
        if ((unsigned)(dq - c) >= W) p0[r] = NEG;
        if ((unsigned)(dq - c - 32) >= W) p1[r] = NEG;
    }
}
__device__ __forceinline__ void partialSM(f32x16& p0, f32x16& p1, float& m_reg, float& mn, float& alpha) {
    float pmax = p0[0]; for (int r = 1; r < 16; ++r) pmax = fmaxf(pmax, p0[r]); for (int r = 0; r < 16; ++r) pmax = fmaxf(pmax, p1[r]);
    { auto rr = __builtin_amdgcn_permlane32_swap(__float_as_uint(pmax), __float_as_uint(pmax), false, false);
      pmax = fmaxf(__uint_as_float(rr[0]), __uint_as_float(rr[1])); }
    constexpr float C2 = 1.4426950408889634f * SCALE;
    if (__builtin_expect(__all((pmax - m_reg) * SCALE <= THR), 1)) { mn = m_reg; alpha = 1.f; }
    else { mn = fmaxf(m_reg, pmax); alpha = __builtin_amdgcn_exp2f((m_reg - mn) * C2); m_reg = mn; }
    const float mnL = -mn * C2;
    for (int r = 0; r < 16; ++r) p0[r] = fmaf(p0[r], C2, mnL); for (int r = 0; r < 16; ++r) p1[r] = fmaf(p1[r], C2, mnL);
    for (int r = 0; r < 16; ++r) p0[r] = __builtin_amdgcn_exp2f(p0[r]);
}
__device__ __forceinline__ void finishSM(f32x16& p0, f32x16& p1, float alpha, float& l_reg, bf16x8& pa0, bf16x8& pa1, bf16x8& pa2, bf16x8& pa3) {
    for (int r = 0; r < 16; ++r) p1[r] = __builtin_amdgcn_exp2f(p1[r]);
    float ps = 0; for (int r = 0; r < 16; ++r) ps += p0[r]; for (int r = 0; r < 16; ++r) ps += p1[r];
    { auto rr = __builtin_amdgcn_permlane32_swap(__float_as_uint(ps), __float_as_uint(ps), false, false);
      ps = __uint_as_float(rr[0]) + __uint_as_float(rr[1]); }
    l_reg = l_reg * alpha + ps;
#define PK4(P, B_, OUT) do { unsigned a0 = cvtpk(P[B_+0], P[B_+1]), a1 = cvtpk(P[B_+2], P[B_+3]);                          \
        unsigned b0 = cvtpk(P[B_+4], P[B_+5]), b1 = cvtpk(P[B_+6], P[B_+7]);                                             \
        auto r0 = __builtin_amdgcn_permlane32_swap(a0, b0, false, false); auto r1 = __builtin_amdgcn_permlane32_swap(a1, b1, false, false); \
        u32x4 w = {r0[0], r1[0], r0[1], r1[1]}; OUT = *reinterpret_cast<bf16x8*>(&w); } while (0)
    PK4(p0, 0, pa0); PK4(p0, 8, pa1); PK4(p1, 0, pa2); PK4(p1, 8, pa3);
#undef PK4
}
template <int KB>
__device__ __forceinline__ void qkt(f32x16& p0, f32x16& p1, const char* K_lds, const float* bt, int r32, int hi, const bf16x8* qr) {
#pragma unroll
    for (int j = 0; j < 4; ++j) { const f32x4 a = *(const f32x4*)(bt + 8 * j), b = *(const f32x4*)(bt + 32 + 8 * j);
        p0[4 * j + 0] = a[0]; p0[4 * j + 1] = a[1]; p0[4 * j + 2] = a[2]; p0[4 * j + 3] = a[3];
        p1[4 * j + 0] = b[0]; p1[4 * j + 1] = b[1]; p1[4 * j + 2] = b[2]; p1[4 * j + 3] = b[3]; }
    const char* kb[4];
#pragma unroll
    for (int dd = 0; dd < 4; ++dd) kb[dd] = K_lds + KB * SHM_K + KSWZ(r32, (dd * 16 + hi * 8) * 2);
#pragma unroll
    for (int d0 = 0; d0 < 8; ++d0) { const char* a = kb[d0 & 3] + (d0 >> 2) * 128;
        bf16x8 b0 = *reinterpret_cast<const bf16x8*>(a);
        bf16x8 b1 = *reinterpret_cast<const bf16x8*>(a + 32 * 256);
        p0 = __builtin_amdgcn_mfma_f32_32x32x16_bf16(b0, qr[d0], p0, 0, 0, 0);
        p1 = __builtin_amdgcn_mfma_f32_32x32x16_bf16(b1, qr[d0], p1, 0, 0, 0); }
}
template <int VB>
__device__ __forceinline__ void pv_tile(f32x16* o, int vb0, bf16x8 pa0, bf16x8 pa1, bf16x8 pa2, bf16x8 pa3) {
#define TRRD(dst, off) asm volatile("ds_read_b64_tr_b16 %0, %1 offset:%2" : "=&v"(dst) : "v"(vb0), "i"(off) : "memory")
#define PV_D0(d0) do { s16x4 l0, l1, l2, l3, h0, h1, h2, h3; constexpr int b_ = VB * SHM_V + v_rd_off(d0, 0, 0);     \
        TRRD(l0, b_); TRRD(h0, b_ + 2048); TRRD(l1, b_ + 4096); TRRD(h1, b_ + 6144); TRRD(l2, b_ + 8192); TRRD(h2, b_ + 10240); TRRD(l3, b_ + 12288); TRRD(h3, b_ + 14336); \
        asm volatile("s_waitcnt lgkmcnt(0)" ::: "memory"); SBAR();                 \
        o[d0] = __builtin_amdgcn_mfma_f32_32x32x16_bf16(pa0, (bf16x8){l0[0], l0[1], l0[2], l0[3], h0[0], h0[1], h0[2], h0[3]}, o[d0], 0, 0, 0);   \
        o[d0] = __builtin_amdgcn_mfma_f32_32x32x16_bf16(pa1, (bf16x8){l1[0], l1[1], l1[2], l1[3], h1[0], h1[1], h1[2], h1[3]}, o[d0], 0, 0, 0);   \
        o[d0] = __builtin_amdgcn_mfma_f32_32x32x16_bf16(pa2, (bf16x8){l2[0], l2[1], l2[2], l2[3], h2[0], h2[1], h2[2], h2[3]}, o[d0], 0, 0, 0);   \
        o[d0] = __builtin_amdgcn_mfma_f32_32x32x16_bf16(pa3, (bf16x8){l3[0], l3[1], l3[2], l3[3], h3[0], h3[1], h3[2], h3[3]}, o[d0], 0, 0, 0); } while (0)
    PV_D0(0); PV_D0(1); PV_D0(2); PV_D0(3);
#undef PV_D0
#undef TRRD
}

struct BlockRef { const bf16* Q; const bf16* K; const bf16* V; bf16* O; const float* Bias; int P0; float THp; };
struct Seam { bf16x8 qr[8]; bf16x8 st_v0, st_v1, st_k0, st_k1; };
#define ROW(p, k0, rr) ((const bf16*)((const char*)(p) + (size_t)(k0) * (PITCH * 2) + (unsigned)(voff + (unsigned)(rr) * (PITCH * 2u))))
#define VMW() asm volatile("s_waitcnt vmcnt(0)" ::: "memory")
#define VMWN(n) asm volatile("s_waitcnt vmcnt(%0)" :: "i"(n) : "memory")
#define SLOAD_H(Kp, Vp, k0) do { S.st_v0 = load8(ROW(Vp, k0, 0)); S.st_v1 = load8(ROW(Vp, k0, 32));              \
                         S.st_k0 = load8(ROW(Kp, k0, 0)); S.st_k1 = load8(ROW(Kp, k0, 32)); } while (0)
#define SWRITE_HK(bf) do { *(bf16x8*)(K_lds + (bf) * SHM_K + kws) = S.st_k0; *(bf16x8*)(K_lds + (bf) * SHM_K + kws + 32 * 256) = S.st_k1; } while (0)
#define SWRITE_HV(bf) do { *(bf16x8*)(V_lds + (bf) * SHM_V + vst0) = S.st_v0; *(bf16x8*)(V_lds + (bf) * SHM_V + vst1) = S.st_v1; } while (0)
#define SWRITE_H(bf) do { SWRITE_HV(bf); SWRITE_HK(bf); } while (0)
__device__ __forceinline__ void fox_prime(const BlockRef& cur, char* lds, Seam& S, const int tid) {
    const int wid = __builtin_amdgcn_readfirstlane(tid >> 6), lane = tid & 63, r32 = lane & 31, hi = lane >> 5;
    const int sr = tid >> 4, sc = (tid & 15) * 8, kws = KSWZ(sr, sc * 2); char* K_lds = lds + 2 * SHM_V;
    const unsigned voff = (unsigned)(sr * PITCH + sc) * 2u, qoff = (unsigned)((wid * QBLK + r32) * PITCH + hi * 8) * 2u;
    for (int d0 = 0; d0 < 8; ++d0) S.qr[d0] = load8((const bf16*)((const char*)cur.Q + (qoff + d0 * 32)));
    (void)kws; (void)K_lds; (void)voff;
    __syncthreads();
}
template <class NextF>
__device__ __forceinline__ void fox_block(const BlockRef& cur, NextF& nextf, char* lds, Seam& S, const int tid) {
    const int wid = __builtin_amdgcn_readfirstlane(tid >> 6), lane = tid & 63, r32 = lane & 31, hi = lane >> 5;
    const int W = SKV;
    const int NTF = (cur.P0 + QB - 1) / KVBLK + 1;
    const int qlo = cur.P0 + wid * QBLK, qm = qlo + r32 - 4 * hi;
    char* V_lds = lds; char* K_lds = lds + 2 * SHM_V;
    float* ws = (float*)(lds + 2 * SHM_V + 2 * SHM_K) + wid * 64; float* li_l = ws, * al_l = ws + 32;
    float* biasL = (float*)(lds + BIAS_OFF);
    { const int nk = cur.P0 + QB;
      int t4 = tid * 4; asm volatile("" : "+v"(t4));
      f32x4 bv[4];
#pragma unroll
      for (int k = 0; k < 4; ++k) { const int i = t4 + k * (NW * 64 * 4); if (i < nk) bv[k] = *(const f32x4*)((const char*)cur.Bias + (unsigned)(i * 4)); }
#pragma unroll
      for (int k = 0; k < 4; ++k) { const int i = t4 + k * (NW * 64 * 4); if (i < nk) *(f32x4*)(biasL + i) = bv[k]; }
      __syncthreads(); }
    int j_lo; { int lo_ = 0, hi_ = cur.P0 / KVBLK; const float bref = biasL[cur.P0] - cur.THp;
        while (lo_ < hi_) { const int mid = (lo_ + hi_) >> 1; if (biasL[mid * KVBLK + KVBLK - 1] < bref) lo_ = mid + 1; else hi_ = mid; }
        j_lo = __builtin_amdgcn_readfirstlane(lo_); }
    const int NT = NTF - j_lo;
    const float* bl = biasL + 4 * hi;
    float m_reg = -1e30f, l_reg = 0; f32x16 o[4] = {};
    const int sr = tid >> 4, sc = (tid & 15) * 8, vst0 = v_st(sr, sc), vst1 = v_st(32 + sr, sc), kws = KSWZ(sr, sc * 2);
    const unsigned voff = (unsigned)(sr * PITCH + sc) * 2u, qoff = (unsigned)((wid * QBLK + r32) * PITCH + hi * 8) * 2u;
    const int vb0 = (int)(uintptr_t)V_lds + v_rd_base(lane);
    const bf16* Kh = cur.K; const bf16* Vh = cur.V;
#define RESC(a) do { if (__any((a) < 1.f)) { if (hi == 0) al_l[r32] = (a); asm volatile("s_waitcnt lgkmcnt(0)" ::: "memory");              \
                     for (int d_ = 0; d_ < 4; ++d_) for (int r = 0; r < 16; ++r) o[d_][r] *= al_l[crow(r, hi)]; } } while (0)
#define KBASE(t) ((j_lo + (NT - 1 - (t))) * KVBLK)
#define MASKT(P0_, P1_, t) do { const int kb_ = KBASE(t); if (kb_ + KVBLK - 1 > qlo) mask_tile(P0_, P1_, qm - kb_, (unsigned)W); } while (0)
    constexpr int NQL = 8;
#define SEAM_K0() do { VMWN(NQL); SWRITE_HK(0); SBAR(); } while (0)
    f32x16 pA0, pA1, pB0, pB1; float mnA, mnB, alA, alB; bf16x8 pa0, pa1, pa2, pa3;
    SLOAD_H(Kh, Vh, KBASE(0)); VMW(); SWRITE_HK(0); SWRITE_HV(0); __syncthreads();
    SBAR();
    if (NT > 1) { SLOAD_H(Kh, Vh, KBASE(1)); }
    SBAR(); qkt<0>(pA0, pA1, K_lds, bl + KBASE(0), r32, hi, S.qr);
    MASKT(pA0, pA1, 0); partialSM(pA0, pA1, m_reg, mnA, alA);
    if (NT > 1) { VMW(); SWRITE_H(1); if (NT > 2) SLOAD_H(Kh, Vh, KBASE(2)); }
    __syncthreads();
#define HALF_STEP(PX0, PX1, mnX, alX, PY0, PY1, alY, t, KB, VB, SB) do {                                                      \
        SBAR(); qkt<KB>(PX0, PX1, K_lds, bl + KBASE(t), r32, hi, S.qr);                                             \
        finishSM(PY0, PY1, alY, l_reg, pa0, pa1, pa2, pa3); SBAR();                                                           \
        pv_tile<VB>(o, vb0, pa0, pa1, pa2, pa3); MASKT(PX0, PX1, (t)); partialSM(PX0, PX1, m_reg, mnX, alX);                                        \
        __syncthreads();                                                                                                      \
        if ((t) + 1 < NT) { VMW(); SWRITE_H(SB); if ((t) + 2 < NT) SLOAD_H(Kh, Vh, KBASE((t) + 2)); }                               \
        RESC(alX); __syncthreads(); } while (0)
    for (int t = 1; t + 1 < NT; t += 2) {
        HALF_STEP(pB0, pB1, mnB, alB, pA0, pA1, alA, t, 1, 0, 0);
        HALF_STEP(pA0, pA1, mnA, alA, pB0, pB1, alB, t + 1, 0, 1, 1);
    }
    const bool even = (NT & 1) == 0;
    if (even) { SBAR(); qkt<1>(pB0, pB1, K_lds, bl + KBASE(NT - 1), r32, hi, S.qr); SBAR(); }
    const bf16* nxtQ = nextf();
#pragma unroll
    for (int d0 = 0; d0 < 8; ++d0) S.qr[d0] = load8((const bf16*)((const char*)nxtQ + (qoff + d0 * 32)));
    SBAR();
    finishSM(pA0, pA1, alA, l_reg, pa0, pa1, pa2, pa3); SBAR();
    pv_tile<0>(o, vb0, pa0, pa1, pa2, pa3);
    if (even) { MASKT(pB0, pB1, NT - 1); partialSM(pB0, pB1, m_reg, mnB, alB); __syncthreads(); RESC(alB);
        finishSM(pB0, pB1, alB, l_reg, pa0, pa1, pa2, pa3); SBAR(); pv_tile<1>(o, vb0, pa0, pa1, pa2, pa3); }
    SBAR();
    if (hi == 0) li_l[r32] = l_reg; asm volatile("s_waitcnt lgkmcnt(0)" ::: "memory");
    float rli[16];
#pragma unroll
    for (int r = 0; r < 16; ++r) rli[r] = __builtin_amdgcn_rcpf(li_l[crow(r, hi)]);
    char* Ow = (char*)cur.O; const unsigned ooff = (unsigned)((wid * QBLK + 4 * hi) * OPITCH + r32) * 2u;
    const char* Gq = (const char*)cur.Q + GATE_OFF * 2; const unsigned goff = (unsigned)((wid * QBLK + 4 * hi) * PITCH + r32) * 2u;
    unsigned short gq[16][4];
#pragma unroll
    for (int r = 0; r < 16; ++r)
#pragma unroll
        for (int d0 = 0; d0 < 4; ++d0) gq[r][d0] = *(const unsigned short*)(Gq + (goff + (unsigned)(((r & 3) + 8 * (r >> 2)) * PITCH + d0 * 32) * 2u));
#pragma unroll
    for (int r = 0; r < 16; ++r) {
#pragma unroll
        for (int d0 = 0; d0 < 4; ++d0) { const unsigned short gw = gq[r][d0];
            const float gl = __builtin_bit_cast(float, (unsigned)gw << 16);
            const float v = o[d0][r] * rli[r] * __builtin_amdgcn_rcpf(1.0f + __builtin_amdgcn_exp2f(-1.4426950408889634f * gl));
            const float vn = xor1_get(v);
            if ((r32 & 1) == 0) *(unsigned*)(Ow + (ooff + (unsigned)(((r & 3) + 8 * (r >> 2)) * OPITCH + d0 * 32) * 2u)) = cvtpk(v, vn); } }
    __syncthreads();
#undef RESC
#undef KBASE
#undef MASKT
#undef SEAM_K0
#undef HALF_STEP
}
#undef ROW
#undef VMW
#undef VMWN
#undef SLOAD_H
#undef SWRITE_HK
#undef SWRITE_HV
#undef SWRITE_H
#undef KSWZ
#undef SBAR
}

constexpr int NWAVES = 8, NTHREADS = NWAVES * 64;
constexpr int DM = 2048, BATCH = 2, T = 8192, M = BATCH * T, DEPTH = 4;
constexpr int AB_IN = 8200, AB_N = 8192;
constexpr int C_IN = 6160, C_N = 6144;
constexpr int FF = 5632, FF2 = 2 * FF;
constexpr float EPS = 1e-6f;
enum PhaseKind { K_NORM1 = 0, K_MIXIN, K_PREP, K_REC, K_POST, K_MIXOUT, K_NORM2, K_FFIN, K_FFOUT, K_PRO };
constexpr int phase_base(int layer) { return 1 + 9 * layer; }
constexpr int N_PHASES = phase_base(DEPTH);
constexpr int CW_QUEUE = 8192;
inline int phase_kind(int p, int& layer) { if (p == 0) { layer = 0; return K_PRO; } for (layer = DEPTH - 1; phase_base(layer) > p; --layer) {} return p - phase_base(layer); }
constexpr size_t MiB = 1u << 20;
constexpr size_t WS_CTL = 0, CTL_ZERO_BYTES = 1 * MiB;
constexpr size_t WS_MOD = 1 * MiB;
constexpr size_t WS_LOGF = 2 * MiB;
constexpr size_t WS_BIAS = 3 * MiB;
constexpr size_t WS_GLOW = 4 * MiB;
constexpr size_t WS_W_ABIN = 8 * MiB, WS_W_ABOUT = 72 * MiB, WS_W_GLIN = 88 * MiB, WS_W_GLOUT = 136 * MiB, WS_W_FFIN = 152 * MiB, WS_W_FFOUT = 328 * MiB;
constexpr size_t WS_H = 416 * MiB, WS_CAT = 480 * MiB, WS_PROJ = 544 * MiB, WS_FFH = WS_PROJ, WS_O = 800 * MiB, WS_REC = 928 * MiB, WS_Y = 1064 * MiB, WS_XB = 1128 * MiB, WS_END = 1192 * MiB;
constexpr int CW_BAR = 4096;
constexpr int CW_CONV = 16384;
constexpr int RING_OFF = 0, RING_BYTES = 139264;
constexpr int LDSCTL_OFF = RING_BYTES, MISC_OFF = LDSCTL_OFF + 320;
constexpr int LDS_BYTES = 155648;
static_assert(fox::LDS_BYTES <= RING_BYTES, "attention LDS");

#define GAS __attribute__((address_space(1)))
#define LAS __attribute__((address_space(3)))
typedef unsigned short bf16;
typedef unsigned v4u __attribute__((ext_vector_type(4)));
typedef unsigned v2u __attribute__((ext_vector_type(2)));
typedef float f32x4 __attribute__((ext_vector_type(4)));
typedef GAS unsigned gu32;
#define RLX_AGENT __ATOMIC_RELAXED, __HIP_MEMORY_SCOPE_AGENT
#define LDS_WAIT() asm volatile("s_waitcnt lgkmcnt(0)" ::: "memory")
__device__ __forceinline__ unsigned pk2(float lo, float hi) { unsigned r; asm("v_cvt_pk_bf16_f32 %0, %1, %2" : "=v"(r) : "v"(lo), "v"(hi)); return r; }
__device__ __forceinline__ unsigned f2bf(float f) { return pk2(f, f) & 0xffffu; }
__device__ __forceinline__ float bf_lo(unsigned w) { return __builtin_bit_cast(float, w << 16); }
__device__ __forceinline__ float bf_hi(unsigned w) { return __builtin_bit_cast(float, w & 0xffff0000u); }
__device__ __forceinline__ float bf1(bf16 h) { return __builtin_bit_cast(float, (unsigned)h << 16); }
__device__ __forceinline__ float sigmoid_f(float x) { return __builtin_amdgcn_rcpf(1.0f + __expf(-x)); }
__device__ __forceinline__ float silu_x(float x) { return x * __builtin_amdgcn_rcpf(1.0f + __expf(-x)); }
__device__ __forceinline__ float log_sigmoid_f(float x) { return fminf(x, 0.f) - log1pf(__expf(-fabsf(x))); }
__device__ __forceinline__ float log_sigmoid_fast(float x) { return fminf(x, 0.f) - __logf(1.0f + __expf(-fabsf(x))); }
__device__ __forceinline__ float wave_sum(float v) {
    v = xsum<1>(v); v = xsum<2>(v); v = xsum<4>(v); v = xsum<8>(v); v = xsum<16>(v); v = xsum<32>(v);
    return v;
}

#define XB_TMO      128
#define XB_XCNT(j)  (256  + 64 * (j))
#define XB_XSUB(j)  (1280 + 64 * (j))
#define XB_XGEN(j)  (2304 + 64 * (j))
#define XB_TOP      3328
#define XB_TOPGEN   3392
#define XCD_BAR_WORDS 3456
#define XB_SPIN_CAP (1u << 18)
__device__ __forceinline__ unsigned xb_ld(unsigned* p)              { return __hip_atomic_load(p, __ATOMIC_RELAXED, __HIP_MEMORY_SCOPE_AGENT); }
__device__ __forceinline__ unsigned xb_add(unsigned* p, unsigned v) { return __hip_atomic_fetch_add(p, v, __ATOMIC_RELAXED, __HIP_MEMORY_SCOPE_AGENT); }
__device__ __forceinline__ unsigned xb_xcc_id() { return (unsigned)__builtin_amdgcn_s_getreg((3 << 11) | 20) & 0xFu; }
#define XB_SPIN(cond, bar) do { unsigned _sp = 0; while (cond) { __builtin_amdgcn_s_sleep(1); \
    if ((++_sp & 255u) == 0u) { if (xb_ld(&(bar)[XB_TMO])) break; if (_sp > XB_SPIN_CAP) { atomicAdd(&(bar)[XB_TMO], 1u); break; } } } } while (0)
struct XcdBarrier { unsigned* bar; unsigned x; volatile LAS unsigned* st; };
__device__ __forceinline__ XcdBarrier xcd_barrier_post(unsigned* bar, volatile LAS unsigned* st, bool tid0) {
    XcdBarrier b; b.bar = bar; b.x = xb_xcc_id(); b.st = st;
    if (tid0) (void)xb_add(&bar[XB_XCNT(b.x)], 1u);
    return b;
}
__device__ __forceinline__ void xcd_barrier_complete(unsigned* bar, unsigned x, unsigned& nloc, unsigned& nx) {
    const unsigned G = gridDim.x * gridDim.y * gridDim.z;
    unsigned sum, cnt, mine, sp = 0u;
    for (;;) {
        sum = 0u; cnt = 0u; mine = 0u;
#pragma unroll
        for (unsigned j = 0; j < 16; ++j) { const unsigned c = xb_ld(&bar[XB_XCNT(j)]); sum += c; cnt += (c > 0u) ? 1u : 0u; mine = (j == x) ? c : mine; }
        if (sum == G) break;
        __builtin_amdgcn_s_sleep(1);
        if ((++sp & 255u) == 0u) { if (xb_ld(&bar[XB_TMO])) break; if (sp > XB_SPIN_CAP) { atomicAdd(&bar[XB_TMO], 1u); break; } }
    }
    nloc = mine > 0u ? mine : 1u; nx = cnt > 0u ? cnt : 1u;
}
template <bool FIRST>
__device__ __forceinline__ void xcd_barrier(const XcdBarrier& b, bool tid0) {
    asm volatile("s_waitcnt vmcnt(0)" ::: "memory");
    __syncthreads();
    if (tid0) {
        unsigned* bar = b.bar;
        __builtin_amdgcn_s_waitcnt(0);
        unsigned nloc = b.st[0], nx = b.st[1];
        if (FIRST) { if (nloc == 0u) { xcd_barrier_complete(bar, b.x, nloc, nx); b.st[0] = nloc; b.st[1] = nx; } }
        else { if (nloc == 0u) nloc = 1u; if (nx == 0u) nx = 1u; }
        const unsigned old = xb_add(&bar[XB_XSUB(b.x)], 1u);
        const unsigned gen = old / nloc;
        if (old + 1u == (gen + 1u) * nloc) {
            __builtin_amdgcn_fence(__ATOMIC_RELEASE, "agent");
            asm volatile("s_waitcnt vmcnt(0)" ::: "memory");
            const unsigned og = xb_add(&bar[XB_TOP], 1u);
            const unsigned tg = og / nx;
            if (og + 1u == (tg + 1u) * nx) xb_add(&bar[XB_TOPGEN], 1u);
            else XB_SPIN(xb_ld(&bar[XB_TOPGEN]) == tg, bar);
            __builtin_amdgcn_fence(__ATOMIC_ACQUIRE, "agent");
            xb_add(&bar[XB_XGEN(b.x)], 1u);
            asm volatile("s_waitcnt vmcnt(0)" ::: "memory");
        } else {
            XB_SPIN(xb_ld(&bar[XB_XGEN(b.x)]) == gen, bar);
            __builtin_amdgcn_fence(__ATOMIC_ACQUIRE, "agent");
            asm volatile("s_waitcnt vmcnt(0)" ::: "memory");
        }
    }
    __syncthreads();
}

struct Args { const float* in[20]; float* out; unsigned char* ws; int ph_lo, ph_hi, use_bar, pad; };
typedef const Args __attribute__((address_space(4))) CArgs;
__device__ __forceinline__ CArgs* opq_args() { CArgs* p = (CArgs*)__builtin_amdgcn_kernarg_segment_ptr(); asm volatile("" : "+s"(p)); return p; }
struct Frame {
    LAS unsigned char* lds;
    int tid, lane, wave, G, bid;
};

__device__ __forceinline__ void transpose_item(const float* W, int ldn, int K, bf16* WT, int k0, int n0, int drow0, LAS float* scr, int lane) {
    f32x4 v[16];
    const float* src = W + (size_t)(k0 + (lane >> 4)) * ldn + n0 + 4 * (lane & 15);
#pragma unroll
    for (int i = 0; i < 16; ++i) v[i] = *(const f32x4*)(src + (size_t)(4 * i) * ldn);
#pragma unroll
    for (int i = 0; i < 16; ++i) { LAS float* d = scr + (4 * i + (lane >> 4)) * 65 + 4 * (lane & 15); d[0] = v[i].x; d[1] = v[i].y; d[2] = v[i].z; d[3] = v[i].w; }
    LDS_WAIT(); asm volatile("" ::: "memory");
    const int c = lane & 7, r = lane >> 3;
#pragma unroll
    for (int j = 0; j < 8; ++j) { const int n = r + 8 * j; const LAS float* s = scr + (8 * c) * 65 + n;
        v4u o; o.x = pg8::cvt_pk_bf16(s[0 * 65], s[1 * 65]); o.y = pg8::cvt_pk_bf16(s[2 * 65], s[3 * 65]); o.z = pg8::cvt_pk_bf16(s[4 * 65], s[5 * 65]); o.w = pg8::cvt_pk_bf16(s[6 * 65], s[7 * 65]);
        *(GAS v4u*)(WT + (size_t)(drow0 + n) * K + k0 + 8 * c) = o; }
    LDS_WAIT(); asm volatile("" ::: "memory");
}
template <int MODE>
__device__ __forceinline__ void transpose_matrix(const float* W, int nmat, int K, int ldn, int ncols, bf16* WT, LAS float* scr, int gw, int NGW, int lane, unsigned* ctr = nullptr, int wave = 0, bool tid0 = false, volatile LAS unsigned* slot = nullptr) {
    const int nblk = ncols / 64, kblk = K / 64, per = nblk * kblk, total = per * nmat;
#define TM_ITEM(it) do { const int mat = (it) / per, r = (it) - mat * per, kb = r / nblk, nb = r - kb * nblk, n0 = 64 * nb; int drow0 = n0; \
        if (MODE == 1) { if (n0 < FF) drow0 = (n0 / 128) * 256 + (n0 % 128); else { const int n1 = n0 - FF; drow0 = (n1 / 128) * 256 + 128 + (n1 % 128); } } \
        if (MODE == 2) drow0 = n0 < 3072 ? n0 : (n0 < 4096 ? n0 + 4096 : n0 - 1024); \
        transpose_item(W + (size_t)mat * K * ldn, ldn, K, WT + (size_t)mat * ncols * K, 64 * kb, n0, drow0, scr, lane); } while (0)
    if (ctr == nullptr) { for (int it = gw; it < total; it += NGW) TM_ITEM(it); }
    else {
        unsigned pend = 0u; if (tid0) pend = __hip_atomic_fetch_add(ctr, 16u, __ATOMIC_RELAXED, __HIP_MEMORY_SCOPE_AGENT);
        for (;;) {
            if (tid0) *slot = pend;
            __syncthreads();
            const int base = __builtin_amdgcn_readfirstlane((int)*slot);
            __syncthreads();
            if (base >= total) break;
            if (tid0) pend = __hip_atomic_fetch_add(ctr, 16u, __ATOMIC_RELAXED, __HIP_MEMORY_SCOPE_AGENT);
#pragma unroll 1
            for (int k = 0; k < 2; ++k) { const int it = base + 8 * k + wave; if (it < total) TM_ITEM(it); } } }
#undef TM_ITEM
}
template <int SET>
__device__ __forceinline__ void convert_weights(CArgs* ap, LAS float* scr, int gw, int NGW, int lane, unsigned* ctr = nullptr, int wave = 0, bool tid0 = false, volatile LAS unsigned* slot = nullptr) {
#define CWC(k) (ctr ? ctr + 64 * (k) : nullptr), wave, tid0, slot
    unsigned char* ws = ap->ws;
    bf16* abin = (bf16*)(ws + WS_W_ABIN); bf16* about = (bf16*)(ws + WS_W_ABOUT); bf16* glin = (bf16*)(ws + WS_W_GLIN); bf16* glout = (bf16*)(ws + WS_W_GLOUT); bf16* ffin = (bf16*)(ws + WS_W_FFIN); bf16* ffout = (bf16*)(ws + WS_W_FFOUT);
    constexpr size_t S_ABIN_W = (size_t)DM * AB_IN, S_ABIN_T = (size_t)AB_N * DM, S_SQ = (size_t)DM * DM, S_GLIN_W = (size_t)DM * C_IN, S_GLIN_T = (size_t)C_N * DM, S_FFIN = (size_t)DM * FF2, S_FFOUT = (size_t)FF * DM;
    if (SET == 0) {
        transpose_matrix<2>(ap->in[6], 1, DM, AB_IN, AB_N, abin, scr, gw, NGW, lane);
    } else if (SET == 3) {
        transpose_matrix<0>(ap->in[7], 1, DM, DM, DM, about, scr, gw, NGW, lane, CWC(0));
        transpose_matrix<1>(ap->in[18], 1, DM, FF2, FF2, ffin, scr, gw, NGW, lane, CWC(1));
        transpose_matrix<0>(ap->in[19], 1, FF, DM, DM, ffout, scr, gw, NGW, lane, CWC(2));
        transpose_matrix<0>(ap->in[13], 1, DM, C_IN, C_N, glin, scr, gw, NGW, lane, CWC(3));
    } else if (SET == 1) {
        transpose_matrix<0>(ap->in[17], 1, DM, DM, DM, glout, scr, gw, NGW, lane, CWC(0));
        transpose_matrix<1>(ap->in[18] + S_FFIN, 2, DM, FF2, FF2, ffin + S_FFIN, scr, gw, NGW, lane, CWC(1));
        transpose_matrix<0>(ap->in[19] + S_FFOUT, 2, FF, DM, DM, ffout + S_FFOUT, scr, gw, NGW, lane, CWC(2));
        transpose_matrix<2>(ap->in[6] + S_ABIN_W, 1, DM, AB_IN, AB_N, abin + S_ABIN_T, scr, gw, NGW, lane, CWC(3));
        transpose_matrix<0>(ap->in[7] + S_SQ, 1, DM, DM, DM, about + S_SQ, scr, gw, NGW, lane, CWC(4));
        transpose_matrix<0>(ap->in[13] + S_GLIN_W, 1, DM, C_IN, C_N, glin + S_GLIN_T, scr, gw, NGW, lane, CWC(5));
    } else {
        transpose_matrix<0>(ap->in[17] + S_SQ, 1, DM, DM, DM, glout + S_SQ, scr, gw, NGW, lane, CWC(8));
        transpose_matrix<1>(ap->in[18] + 3 * S_FFIN, 1, DM, FF2, FF2, ffin + 3 * S_FFIN, scr, gw, NGW, lane, CWC(9));
        transpose_matrix<0>(ap->in[19] + 3 * S_FFOUT, 1, FF, DM, DM, ffout + 3 * S_FFOUT, scr, gw, NGW, lane, CWC(10));
    }
#undef CWC
}
__device__ __forceinline__ void mod_setup(Frame& F, CArgs* ap) {
    LAS float* sc = (LAS float*)(F.lds);
    const float* c = ap->in[1];
    for (int i = F.tid; i < 2 * DM; i += NTHREADS) sc[i] = silu_x(c[i]);
    __syncthreads();
}
__device__ __forceinline__ void mod_unit(Frame& F, CArgs* ap, int u) {
    LAS float* sc = (LAS float*)(F.lds);
    LAS float* part = (LAS float*)(F.lds + 16384);
    const float* mw = ap->in[2]; const float* mb = ap->in[3]; float* mod = (float*)(ap->ws + WS_MOD);
    const int layer = u / (6 * DM / 64), colb = (u % (6 * DM / 64)) * 64, kk = F.lane >> 4, c4 = F.lane & 15;
    const float* wp = mw + ((size_t)layer * DM + F.wave * 256 + kk) * (6 * DM) + colb + 4 * c4;
    f32x4 a0 = {0.f, 0.f, 0.f, 0.f}, a1 = {0.f, 0.f, 0.f, 0.f};
    for (int i0 = 0; i0 < 64; i0 += 16) { f32x4 wv[16];
#pragma unroll
        for (int i = 0; i < 16; ++i) wv[i] = *(const f32x4*)(wp + (size_t)(4 * (i0 + i)) * (6 * DM));
#pragma unroll
        for (int i = 0; i < 16; ++i) { const int k = F.wave * 256 + 4 * (i0 + i) + kk; a0 = a0 + wv[i] * sc[k]; a1 = a1 + wv[i] * sc[DM + k]; } }
    a0.x = xsum<16>(a0.x); a0.x = xsum<32>(a0.x); a0.y = xsum<16>(a0.y); a0.y = xsum<32>(a0.y); a0.z = xsum<16>(a0.z); a0.z = xsum<32>(a0.z); a0.w = xsum<16>(a0.w); a0.w = xsum<32>(a0.w);
    a1.x = xsum<16>(a1.x); a1.x = xsum<32>(a1.x); a1.y = xsum<16>(a1.y); a1.y = xsum<32>(a1.y); a1.z = xsum<16>(a1.z); a1.z = xsum<32>(a1.z); a1.w = xsum<16>(a1.w); a1.w = xsum<32>(a1.w);
    if (F.lane < 16) { *(LAS f32x4*)(part + (F.wave * 2 + 0) * 64 + 4 * c4) = a0; *(LAS f32x4*)(part + (F.wave * 2 + 1) * 64 + 4 * c4) = a1; }
    __syncthreads();
    if (F.tid < 128) { const int b = F.tid >> 6, l = F.tid & 63; float s = 0.f;
#pragma unroll
        for (int w = 0; w < 8; ++w) s += part[(w * 2 + b) * 64 + l];
        const int cc = (u % (6 * DM / 64)) * 64 + l;
        mod[((size_t)layer * 2 + b) * (6 * DM) + cc] = s + mb[(size_t)layer * (6 * DM) + cc]; }
    __syncthreads();
}
constexpr int MOD_UPL = 6 * DM / 64;
__device__ __forceinline__ void p0_prologue(Frame& F, CArgs* ap) {
    mod_setup(F, ap);
    for (int u = F.bid; u < MOD_UPL; u += F.G) mod_unit(F, ap, u);
    __syncthreads();
    LAS float* scr = (LAS float*)(F.lds + RING_OFF + F.wave * 16640);
    const int gw = F.bid * NWAVES + F.wave, NGW = F.G * NWAVES;
    convert_weights<0>(ap, scr, gw, NGW, F.lane);
}
__device__ __forceinline__ void p0_deferred(Frame& F, CArgs* ap) {
    unsigned* ctr = (unsigned*)(ap->ws + WS_CTL) + CW_CONV + 64 * 16;
    volatile LAS unsigned* slot = (volatile LAS unsigned*)(F.lds + MISC_OFF) + 32;
    __syncthreads();
    mod_setup(F, ap);
    for (;;) {
        if (F.tid == 0) *slot = __hip_atomic_fetch_add(ctr, 1u, __ATOMIC_RELAXED, __HIP_MEMORY_SCOPE_AGENT);
        __syncthreads();
        const int u = MOD_UPL + __builtin_amdgcn_readfirstlane((int)*slot);
        __syncthreads();
        if (u >= DEPTH * MOD_UPL) break;
        mod_unit(F, ap, u);
    }
    LAS float* scr = (LAS float*)(F.lds + RING_OFF + F.wave * 16640);
    convert_weights<3>(ap, scr, 0, 1, F.lane, ctr + 64, F.wave, F.tid == 0, slot);
}

template <int MASK> __device__ __forceinline__ float xget(float v) { return __builtin_bit_cast(float, __builtin_amdgcn_ds_swizzle(__builtin_bit_cast(int, v), (MASK << 10) | 0x1f)); }
template <int N> __device__ __forceinline__ float rs_reduce(float (&a)[N], int lane) {
    if (N == 16) {
#pragma unroll
        for (int i = 0; i < 8; ++i) { const bool up = lane & 1; const float keep = up ? a[i + 8] : a[i], send = up ? a[i] : a[i + 8]; a[i] = keep + xget<1>(send); } }
    if (N >= 8) {
#pragma unroll
        for (int i = 0; i < 4; ++i) { const bool up = lane & (N == 16 ? 2 : 1); const float keep = up ? a[i + 4] : a[i], send = up ? a[i] : a[i + 4]; a[i] = keep + (N == 16 ? xget<2>(send) : xget<1>(send)); } }
#pragma unroll
    for (int i = 0; i < 2; ++i) { const bool up = lane & (N == 16 ? 4 : 2); const float keep = up ? a[i + 2] : a[i], send = up ? a[i] : a[i + 2]; a[i] = keep + (N == 16 ? xget<4>(send) : xget<2>(send)); }
    { const bool up = lane & (N == 16 ? 8 : 4); const float keep = up ? a[1] : a[0], send = up ? a[0] : a[1]; a[0] = keep + (N == 16 ? xget<8>(send) : xget<4>(send)); }
    float r = a[0];
    if (N == 8) r = xsum<8>(r);
    r = xsum<16>(r); r = xsum<32>(r);
    return r;
}
template <int N> __device__ __forceinline__ int rs_col(int lane) { return N == 16 ? (((lane & 1) << 3) | ((lane & 2) << 1) | ((lane & 4) >> 1) | ((lane & 8) >> 3)) : (((lane & 1) << 2) | (lane & 2) | ((lane & 4) >> 2)); }
template <int NC, int MODE, bool RES, bool XF32>
__device__ __forceinline__ void norm_phase(Frame& F, const void* xin, const float* gain, const float* mod_sh, const float* mod_sc  ,
                                           bf16* hout, const float* Wsm, int ldn, const float* fbias, float* sout, const bf16* yres = nullptr, const float* rgate = nullptr, bf16* xb = nullptr) {
    LAS float* wl = (LAS float*)(F.lds);
    if (NC > 0) {
        for (int i = F.tid; i < NC * DM; i += NTHREADS) { const int k = i / NC, c = i % NC; wl[c * DM + k] = Wsm[(size_t)k * ldn + c]; }
        __syncthreads();
    }
    f32x4 gm[8], shv[8]; int bprev = -1;
    for (int mp = F.bid * NWAVES + F.wave; mp < M / 2; mp += F.G * NWAVES) {
        const int m0 = 2 * mp, b = m0 / T;
        if (b != bprev) { bprev = b; const f32x4* gp = (const f32x4*)gain + F.lane; const f32x4* shp = (const f32x4*)(mod_sh + (size_t)b * 6 * DM) + F.lane; const f32x4* scp = (const f32x4*)(mod_sc + (size_t)b * 6 * DM) + F.lane;
#pragma unroll
            for (int j = 0; j < 8; ++j) { gm[j] = gp[64 * j] * (scp[64 * j] + 1.0f); shv[j] = shp[64 * j]; } }
        f32x4 v[2][8]; float s0 = 0.f, s1 = 0.f;
        v2u yv[2][8];
        if (RES) { const GAS v2u* yr = (const GAS v2u*)(yres + (size_t)m0 * DM) + F.lane;
#pragma unroll
            for (int j = 0; j < 8; ++j) { yv[0][j] = yr[64 * j]; yv[1][j] = yr[512 + 64 * j]; } }
        if (XF32) { const GAS f32x4* xr = (const GAS f32x4*)((const float*)xin + (size_t)m0 * DM) + F.lane;
#pragma unroll
            for (int j = 0; j < 8; ++j) { v[0][j] = xr[64 * j]; v[1][j] = xr[512 + 64 * j]; } }
        else { const GAS v2u* xr = (const GAS v2u*)((const bf16*)xin + (size_t)m0 * DM) + F.lane; v2u xv[2][8];
#pragma unroll
            for (int j = 0; j < 8; ++j) { xv[0][j] = xr[64 * j]; xv[1][j] = xr[512 + 64 * j]; }
#pragma unroll
            for (int j = 0; j < 8; ++j) { v[0][j] = (f32x4){bf_lo(xv[0][j].x), bf_hi(xv[0][j].x), bf_lo(xv[0][j].y), bf_hi(xv[0][j].y)}; v[1][j] = (f32x4){bf_lo(xv[1][j].x), bf_hi(xv[1][j].x), bf_lo(xv[1][j].y), bf_hi(xv[1][j].y)}; } }
        if (RES) { const f32x4* rg = (const f32x4*)(rgate + (size_t)b * 6 * DM) + F.lane; GAS v2u* xo = (GAS v2u*)(xb + (size_t)m0 * DM) + F.lane;
#pragma unroll
            for (int j = 0; j < 8; ++j) { const f32x4 g = rg[64 * j];
                v[0][j] = v[0][j] + g * (f32x4){bf_lo(yv[0][j].x), bf_hi(yv[0][j].x), bf_lo(yv[0][j].y), bf_hi(yv[0][j].y)}; v[1][j] = v[1][j] + g * (f32x4){bf_lo(yv[1][j].x), bf_hi(yv[1][j].x), bf_lo(yv[1][j].y), bf_hi(yv[1][j].y)};
                v2u w; w.x = pk2(v[0][j].x, v[0][j].y); w.y = pk2(v[0][j].z, v[0][j].w); xo[64 * j] = w;
                w.x = pk2(v[1][j].x, v[1][j].y); w.y = pk2(v[1][j].z, v[1][j].w); xo[512 + 64 * j] = w; } }
#pragma unroll
        for (int j = 0; j < 8; ++j) { s0 += (v[0][j].x * v[0][j].x + v[0][j].y * v[0][j].y) + (v[0][j].z * v[0][j].z + v[0][j].w * v[0][j].w);
                                      s1 += (v[1][j].x * v[1][j].x + v[1][j].y * v[1][j].y) + (v[1][j].z * v[1][j].z + v[1][j].w * v[1][j].w); }
        const float rstd0 = __builtin_amdgcn_rsqf(wave_sum(s0) * (1.f / DM) + EPS), rstd1 = __builtin_amdgcn_rsqf(wave_sum(s1) * (1.f / DM) + EPS);
        GAS v2u* o8 = (GAS v2u*)(hout + (size_t)m0 * DM) + F.lane;
#pragma unroll
        for (int j = 0; j < 8; ++j) { const f32x4 g = gm[j], sh = shv[j];
            v[0][j] = (v[0][j] * rstd0) * g + sh; v[1][j] = (v[1][j] * rstd1) * g + sh;
            v2u w; w.x = pk2(v[0][j].x, v[0][j].y); w.y = pk2(v[0][j].z, v[0][j].w); o8[64 * j] = w;
            w.x = pk2(v[1][j].x, v[1][j].y); w.y = pk2(v[1][j].z, v[1][j].w); o8[512 + 64 * j] = w; }
        if constexpr (NC > 0) {
            float a0[NC], a1[NC];
#pragma unroll
            for (int c = 0; c < NC; ++c) { float acc0 = 0.f, acc1 = 0.f;
#pragma unroll
                for (int j = 0; j < 8; ++j) { const f32x4 w = *(const LAS f32x4*)(wl + c * DM + 256 * j + 4 * F.lane);
                    acc0 += (v[0][j].x * w.x + v[0][j].y * w.y) + (v[0][j].z * w.z + v[0][j].w * w.w); acc1 += (v[1][j].x * w.x + v[1][j].y * w.y) + (v[1][j].z * w.z + v[1][j].w * w.w); }
                a0[c] = acc0; a1[c] = acc1; __builtin_amdgcn_sched_barrier(0); }
            const float r0 = rs_reduce<NC>(a0, F.lane), r1 = rs_reduce<NC>(a1, F.lane); const int cc = rs_col<NC>(F.lane);
            if (MODE == 1) { const int t = m0 % T; if (F.lane < NC) { const float fb = fbias[cc]; sout[((size_t)b * 8 + cc) * T + t] = log_sigmoid_f(r0 + fb); sout[((size_t)b * 8 + cc) * T + t + 1] = log_sigmoid_f(r1 + fb); } }
            if (MODE == 2) { if (F.lane < NC) { sout[(size_t)m0 * 16 + cc] = r0; sout[(size_t)m0 * 16 + 16 + cc] = r1; } }
        }
    }
}

__device__ __forceinline__ void resid_final(Frame& F, const bf16* xb, const bf16* yres, const float* rgate, float* xout) {
    for (int mp = F.bid * NWAVES + F.wave; mp < M / 2; mp += F.G * NWAVES) {
        const int m0 = 2 * mp, b = m0 / T;
        const GAS v2u* xr = (const GAS v2u*)(xb + (size_t)m0 * DM) + F.lane; const GAS v2u* yr = (const GAS v2u*)(yres + (size_t)m0 * DM) + F.lane;
        const f32x4* rg = (const f32x4*)(rgate + (size_t)b * 6 * DM) + F.lane; GAS f32x4* xo = (GAS f32x4*)(xout + (size_t)m0 * DM) + F.lane;
        v2u xv[2][8], yv[2][8];
#pragma unroll
        for (int j = 0; j < 8; ++j) { xv[0][j] = xr[64 * j]; xv[1][j] = xr[512 + 64 * j]; yv[0][j] = yr[64 * j]; yv[1][j] = yr[512 + 64 * j]; }
#pragma unroll
        for (int j = 0; j < 8; ++j) { const f32x4 g = rg[64 * j];
            xo[64 * j] = (f32x4){bf_lo(xv[0][j].x), bf_hi(xv[0][j].x), bf_lo(xv[0][j].y), bf_hi(xv[0][j].y)} + g * (f32x4){bf_lo(yv[0][j].x), bf_hi(yv[0][j].x), bf_lo(yv[0][j].y), bf_hi(yv[0][j].y)};
            xo[512 + 64 * j] = (f32x4){bf_lo(xv[1][j].x), bf_hi(xv[1][j].x), bf_lo(xv[1][j].y), bf_hi(xv[1][j].y)} + g * (f32x4){bf_lo(yv[1][j].x), bf_hi(yv[1][j].x), bf_lo(yv[1][j].y), bf_hi(yv[1][j].y)}; }
    }
}

__device__ __forceinline__ void fox_prep(Frame& F, bf16* proj, const float* qg, const float* kg, const float* logf, float* bias) {
    const int gw = F.bid * NWAVES + F.wave, NGW = F.G * NWAVES;
    const f32x4 gq0 = *(const f32x4*)(qg + (F.lane & 15) * 8), gq1 = *(const f32x4*)(qg + (F.lane & 15) * 8 + 4), gk0 = *(const f32x4*)(kg + (F.lane & 15) * 8), gk1 = *(const f32x4*)(kg + (F.lane & 15) * 8 + 4);
    for (int m = gw; m < M; m += NGW) {
        GAS v4u* p = (GAS v4u*)(proj + (size_t)m * AB_N + 3072) + F.lane;
        v4u wv[4];
#pragma unroll
        for (int j = 0; j < 4; ++j) wv[j] = p[64 * j];
#pragma unroll
        for (int j = 0; j < 4; ++j) {
            const v4u w = wv[j];
            float e[8] = {bf_lo(w.x), bf_hi(w.x), bf_lo(w.y), bf_hi(w.y), bf_lo(w.z), bf_hi(w.z), bf_lo(w.w), bf_hi(w.w)};
            float s = 0.f;
#pragma unroll
            for (int i = 0; i < 8; ++i) s += e[i] * e[i];
            s = xsum<1>(s); s = xsum<2>(s); s = xsum<4>(s); s = xsum<8>(s);
            const float rstd = __builtin_amdgcn_rsqf(s * (1.f / 128.f) + EPS);
            const f32x4 g0 = j < 2 ? gq0 : gk0, g1 = j < 2 ? gq1 : gk1;
#pragma unroll
            for (int i = 0; i < 4; ++i) { e[i] = e[i] * rstd * g0[i]; e[4 + i] = e[4 + i] * rstd * g1[i]; }
            v4u o; o.x = pk2(e[0], e[1]); o.y = pk2(e[2], e[3]); o.z = pk2(e[4], e[5]); o.w = pk2(e[6], e[7]);
            p[64 * j] = o;
        }
    }
    if (F.bid < 16) {
        LAS double* tsum = (LAS double*)(F.lds);
        const float* lf = logf + (size_t)F.bid * T; float* bo = bias + (size_t)F.bid * T;
        double v[16]; double run = 0.0;
        const int i0 = F.tid * 16;
#pragma unroll
        for (int i = 0; i < 16; ++i) { run += (double)lf[i0 + i]; v[i] = run; }
        tsum[F.tid] = run;
        __syncthreads();
        LAS double* bsum = tsum + NTHREADS;
        if (F.tid < 8) { double s = 0.0; for (int w = 0; w < 64; ++w) s += tsum[F.tid * 64 + w]; bsum[F.tid] = s; }
        __syncthreads();
        double base = 0.0;
        for (int w = 0; w < F.wave; ++w) base += bsum[w];
        for (int w = 0; w < F.lane; ++w) base += tsum[F.wave * 64 + w];
        const double k = -11.313708498984761;
#pragma unroll
        for (int i = 0; i < 16; ++i) bo[i0 + i] = (float)((base + v[i]) * k);
        __syncthreads();
    }
}

#ifndef DBG_REC
#define DBG_REC 0
#endif
#if DBG_REC
template <bool GLA>
__device__ __forceinline__ void rec_naive(Frame& F, const bf16* proj, float* O, const float* lbl  , int lb_on,
                                          const float* glow, const float* wup  , const float* bgate  ) {
    constexpr int DK = GLA ? 256 : 128, DVH = GLA ? 512 : 128, NH = GLA ? 4 : 8, DVS = 32, NSL = DVH / DVS, TB = GLA ? 16 : 32;
    constexpr int PITCH = GLA ? C_N : AB_N, OPITCH = GLA ? 2048 : 1024;
    constexpr int R = DK / 16;
    constexpr int NPAIR = TB * DK / 2 / NTHREADS;
    constexpr int NUNITS = BATCH * NH * NSL;
    LAS float* sq = (LAS float*)(F.lds); LAS float* sf = sq + TB * DK; LAS float* sk = sf + TB * DK; LAS float* sv = sk + TB * DK; LAS float* part = sv + TB * DVS; LAS float* sgl = part + TB * 4 * DVS;
    const int lane = F.lane, e_l = lane & 15, dsub = lane >> 4, eg = F.wave & 1, dg = F.wave >> 1, e = eg * 16 + e_l, d0 = (dg * 4 + dsub) * R;
    for (int unit = F.bid; unit < NUNITS; unit += F.G) {
        const int sl = unit % NSL, h = (unit / NSL) % NH, b = unit / (NSL * NH);
        const bf16* pq = proj + (size_t)b * T * PITCH + h * DK;
        const bf16* pk = pq + 1024;
        const bf16* pv = proj + (size_t)b * T * PITCH + 2048 + h * DVH + sl * DVS;
        const int dp = 2 * (F.tid % (DK / 2)), tt0 = F.tid / (DK / 2); constexpr int TSTEP = NTHREADS / (DK / 2);
        float lb0 = 0.f, lb1 = 0.f; float wu0[16], wu1[16]; float bg0 = 0.f, bg1 = 0.f;
        if (!GLA) { if (lb_on) { const float l0a = lbl[h * DK + dp], l1a = lbl[1024 + h * DK + dp], l0b = lbl[h * DK + dp + 1], l1b = lbl[1024 + h * DK + dp + 1];
                                 lb0 = fminf(fmaxf(sigmoid_f(l1a - l0a), 0.f), 1.0f - 1e-6f); lb1 = fminf(fmaxf(sigmoid_f(l1b - l0b), 0.f), 1.0f - 1e-6f); } }
        else {
#pragma unroll
            for (int r = 0; r < 16; ++r) { wu0[r] = wup[r * 1024 + h * DK + dp]; wu1[r] = wup[r * 1024 + h * DK + dp + 1]; }
            bg0 = bgate[h * DK + dp]; bg1 = bgate[h * DK + dp + 1]; }
        const int vt = F.tid / 16, ve = 2 * (F.tid % 16); const bool vact = vt < TB;
        float S[R];
#pragma unroll
        for (int j = 0; j < R; ++j) S[j] = 0.f;
        unsigned rq[NPAIR], rk[NPAIR], rv = 0u; float rgl = 0.f;
#define REC_PREFETCH(t0) do { _Pragma("unroll") for (int i = 0; i < NPAIR; ++i) { const size_t row = (size_t)((t0) + tt0 + TSTEP * i); \
            rq[i] = *(const unsigned*)(pq + row * PITCH + dp); rk[i] = *(const unsigned*)(pk + row * PITCH + dp); \
            } \
            if (GLA && F.tid < TB * 16) rgl = glow[((size_t)b * T + (t0)) * 16 + F.tid]; \
            if (vact) rv = *(const unsigned*)(pv + (size_t)((t0) + vt) * PITCH + ve); } while (0)
        REC_PREFETCH(0);
        for (int t0 = 0; t0 < T; t0 += TB) {
            if (GLA) { if (F.tid < TB * 16) sgl[F.tid] = rgl; __syncthreads(); }
#pragma unroll
            for (int i = 0; i < NPAIR; ++i) { const int tt = tt0 + TSTEP * i; const float qa = bf_lo(rq[i]), qb = bf_hi(rq[i]), ka = bf_lo(rk[i]), kb = bf_hi(rk[i]);
                float q0, q1, f0, f1, k0, k1;
                if (!GLA) { q0 = silu_x(qa); q1 = silu_x(qb); const float s0 = sigmoid_f(ka), s1 = sigmoid_f(kb), n0 = sigmoid_f(-ka), n1 = sigmoid_f(-kb);
                    f0 = fmaxf(lb0 + (1.f - lb0) * s0, 1e-30f); f1 = fmaxf(lb1 + (1.f - lb1) * s1, 1e-30f); k0 = (1.f - lb0) * n0; k1 = (1.f - lb1) * n1; }
                else { q0 = qa * 0.0625f; q1 = qb * 0.0625f; k0 = ka; k1 = kb; float x0 = bg0, x1 = bg1;
#pragma unroll
                    for (int r = 0; r < 16; ++r) { const float g = sgl[tt * 16 + r]; x0 += g * wu0[r]; x1 += g * wu1[r]; }
                    f0 = __expf(log_sigmoid_f(x0) * 0.0625f); f1 = __expf(log_sigmoid_f(x1) * 0.0625f); }
                sq[tt * DK + dp] = q0; sq[tt * DK + dp + 1] = q1; sf[tt * DK + dp] = f0; sf[tt * DK + dp + 1] = f1; sk[tt * DK + dp] = k0; sk[tt * DK + dp + 1] = k1; }
            if (vact) { sv[vt * DVS + ve] = bf_lo(rv); sv[vt * DVS + ve + 1] = bf_hi(rv); }
            __syncthreads();
            if (t0 + TB < T) REC_PREFETCH(t0 + TB);
            for (int tt = 0; tt < TB; ++tt) {
                const float v = sv[tt * DVS + e]; float acc = 0.f;
#pragma unroll
                for (int g4 = 0; g4 < R / 4; ++g4) { const f32x4 f4 = *(const LAS f32x4*)(sf + tt * DK + d0 + 4 * g4), k4 = *(const LAS f32x4*)(sk + tt * DK + d0 + 4 * g4), q4 = *(const LAS f32x4*)(sq + tt * DK + d0 + 4 * g4);
#pragma unroll
                    for (int i = 0; i < 4; ++i) { S[4 * g4 + i] = f4[i] * S[4 * g4 + i] + k4[i] * v; acc += q4[i] * S[4 * g4 + i]; } }
                acc = xsum<16>(acc); acc = xsum<32>(acc);
                if (dsub == 0) part[(tt * 4 + dg) * DVS + e] = acc;
            }
            __syncthreads();
            for (int i = F.tid; i < TB * DVS; i += NTHREADS) { const int tt = i / DVS, ee = i % DVS;
                const float o = (part[(tt * 4 + 0) * DVS + ee] + part[(tt * 4 + 1) * DVS + ee]) + (part[(tt * 4 + 2) * DVS + ee] + part[(tt * 4 + 3) * DVS + ee]);
                O[((size_t)b * T + t0 + tt) * OPITCH + h * DVH + sl * DVS + ee] = o; }
        }
#undef REC_PREFETCH
        __syncthreads();
    }
}

#endif
#ifndef DBG_ZERO
#define DBG_ZERO 0
#endif
__device__ __forceinline__ void post_even(Frame& F, const bf16* O, const bf16* proj, const float* gain  , bf16* cat) {
    const int gw = F.bid * NWAVES + F.wave, NGW = F.G * NWAVES;
    f32x4 gn[4];
#pragma unroll
    for (int j = 0; j < 4; ++j) gn[j] = *((const f32x4*)gain + 64 * j + F.lane);
    for (int mp = gw; mp < M / 2; mp += NGW) {
        const int m = 2 * mp;
        const GAS v2u* op = (const GAS v2u*)(O + (size_t)m * 1024) + F.lane;
        const GAS v2u* ga = (const GAS v2u*)(proj + (size_t)m * AB_N + 7168) + F.lane;
        GAS v2u* cp = (GAS v2u*)(cat + (size_t)m * DM) + F.lane;
        v2u vr[2][4], gr[2][4];
#pragma unroll
        for (int r = 0; r < 2; ++r)
#pragma unroll
            for (int j = 0; j < 4; ++j) { vr[r][j] = op[r * 256 + 64 * j]; gr[r][j] = ga[r * (AB_N / 4) + 64 * j]; }
#pragma unroll
        for (int r = 0; r < 2; ++r)
#pragma unroll
        for (int j = 0; j < 4; ++j) {
            const f32x4 v = {bf_lo(vr[r][j].x), bf_hi(vr[r][j].x), bf_lo(vr[r][j].y), bf_hi(vr[r][j].y)}; float s = (v.x * v.x + v.y * v.y) + (v.z * v.z + v.w * v.w);
            s = xsum<1>(s); s = xsum<2>(s); s = xsum<4>(s); s = xsum<8>(s); s = xsum<16>(s);
            const float rstd = __builtin_amdgcn_rsqf(s * (1.f / 128.f) + EPS);
            const f32x4 g = gn[j];
            const v2u gw2 = gr[r][j];
            const float o0 = v.x * rstd * g.x * silu_x(bf_lo(gw2.x)), o1 = v.y * rstd * g.y * silu_x(bf_hi(gw2.x)), o2 = v.z * rstd * g.z * silu_x(bf_lo(gw2.y)), o3 = v.w * rstd * g.w * silu_x(bf_hi(gw2.y));
            v2u w; w.x = pk2(o0, o1); w.y = pk2(o2, o3); cp[r * 512 + 64 * j] = w;
        }
    }
}
__device__ __forceinline__ void post_odd(Frame& F, const bf16* O, const bf16* proj, const float* gain  , bf16* cat) {
    const int gw = F.bid * NWAVES + F.wave, NGW = F.G * NWAVES;
    const f32x4 gn0 = *((const f32x4*)gain + F.lane), gn1 = *((const f32x4*)gain + 64 + F.lane);
    for (int mp = gw; mp < M / 2; mp += NGW) {
        const int m = 2 * mp;
        const GAS v2u* op = (const GAS v2u*)(O + (size_t)m * DM) + F.lane;
        const GAS v2u* gg = (const GAS v2u*)(proj + (size_t)m * C_N + 4096) + F.lane;
        GAS v2u* cp = (GAS v2u*)(cat + (size_t)m * DM) + F.lane;
        v2u vr[2][8], gr[2][8];
#pragma unroll
        for (int r = 0; r < 2; ++r)
#pragma unroll
            for (int j = 0; j < 8; ++j) { vr[r][j] = op[r * 512 + 64 * j]; gr[r][j] = gg[r * (C_N / 4) + 64 * j]; }
#pragma unroll
        for (int r = 0; r < 2; ++r)
#pragma unroll
        for (int hh = 0; hh < 4; ++hh) {
            const v2u r0 = vr[r][2 * hh], r1 = vr[r][2 * hh + 1]; const f32x4 v0 = {bf_lo(r0.x), bf_hi(r0.x), bf_lo(r0.y), bf_hi(r0.y)}, v1 = {bf_lo(r1.x), bf_hi(r1.x), bf_lo(r1.y), bf_hi(r1.y)};
            float s = ((v0.x * v0.x + v0.y * v0.y) + (v0.z * v0.z + v0.w * v0.w)) + ((v1.x * v1.x + v1.y * v1.y) + (v1.z * v1.z + v1.w * v1.w));
            s = wave_sum(s);
            const float rstd = __builtin_amdgcn_rsqf(s * (1.f / 512.f) + EPS);
#pragma unroll
            for (int jj = 0; jj < 2; ++jj) { const f32x4 v = jj ? v1 : v0; const f32x4 g = jj ? gn1 : gn0; const v2u gw2 = gr[r][2 * hh + jj];
                const float o0 = v.x * rstd * g.x * silu_x(bf_lo(gw2.x)), o1 = v.y * rstd * g.y * silu_x(bf_hi(gw2.x)), o2 = v.z * rstd * g.z * silu_x(bf_lo(gw2.y)), o3 = v.w * rstd * g.w * silu_x(bf_hi(gw2.y));
                v2u w; w.x = pk2(o0, o1); w.y = pk2(o2, o3); cp[r * 512 + 64 * (2 * hh + jj)] = w; }
        }
    }
}

__device__ __forceinline__ fox::BlockRef fox_ref(int item, const bf16* proj, bf16* cat, const float* bias, float thp) {
    const int bh = item & 15, qb = 31 - (item >> 4), b = bh >> 3, h = bh & 7;
    fox::BlockRef r;
    const bf16* base = proj + (size_t)b * T * AB_N + h * 128;
    r.Q = (const fox::bf16*)(base + (size_t)qb * 256 * AB_N + 3072); r.K = (const fox::bf16*)(base + 4096); r.V = (const fox::bf16*)(base + 5120);
    r.O = (fox::bf16*)(cat + ((size_t)b * T + (size_t)qb * 256) * DM + 1024 + h * 128);
    r.Bias = bias + (size_t)bh * T; r.P0 = qb * 256; r.THp = thp;
    return r;
}
__device__ __forceinline__ int fox_fetch(Frame& F, unsigned* ctr, volatile LAS unsigned* slot) {
    if (F.tid == 0) *slot = __hip_atomic_fetch_add(ctr, 1u, __ATOMIC_RELAXED, __HIP_MEMORY_SCOPE_AGENT);
    __syncthreads();
    const int v = __builtin_amdgcn_readfirstlane((int)*slot);
    __syncthreads();
    return v;
}
__device__ __forceinline__ void fox_phase(Frame& F, char* lds, const bf16* proj, bf16* cat, const float* bias, unsigned* ctr, const float* qg, const float* kg) {
    constexpr int TOTAL = 512;
    float gqm = 0.f, gkm = 0.f;
    for (int i = 0; i < 128; ++i) { gqm = fmaxf(gqm, fabsf(qg[i])); gkm = fmaxf(gkm, fabsf(kg[i])); }
    const float thp = 2.0f * (128.0f * 1.02f * gqm * gkm) + (128.0f + 12.0f + 6.0f) / (1.4426950408889634f * fox::SCALE);
    volatile LAS unsigned* slot = (volatile LAS unsigned*)(F.lds + MISC_OFF) + 16;
    int ci = fox_fetch(F, ctr, slot); if (ci >= TOTAL) return;
    fox::BlockRef cur = fox_ref(ci, proj, cat, bias, thp);
    fox::Seam S;
    fox::fox_prime(cur, lds, S, F.tid);
    struct Next { Frame& F; unsigned* ctr; volatile LAS unsigned* slot; const bf16* proj; bf16* cat; const float* bias; float thp; fox::BlockRef cur, nxt; bool last;
        __device__ __forceinline__ const fox::bf16* operator()() { const int ni = fox_fetch(F, ctr, slot); last = ni >= 512; nxt = last ? cur : fox_ref(ni, proj, cat, bias, thp); return nxt.Q; } };
    Next nx{F, ctr, slot, proj, cat, bias, thp, cur, cur, false};
    for (;;) {
        fox::fox_block(nx.cur, nx, lds, S, F.tid);
        if (nx.last) break;
        nx.cur = nx.nxt;
    }
}

template <bool GLA> struct RecCfg {
    static constexpr int DK = GLA ? 256 : 128, DVH = GLA ? 512 : 128, NH = GLA ? 4 : 8, CH = 32, NCH = T / CH, PITCH = GLA ? C_N : AB_N, OPITCH = GLA ? 2048 : 1024;
    static constexpr int QP = DK + 16;
    static constexpr int QT_B = ((CH * QP * 2 + 1023) / 1024) * 1024, KT_B = DK * CH * 2, P_B = CH * CH * 2, A_B = 1024, VT_B = DVH * CH * 2;
    static constexpr int OFF_QT = 0, OFF_KT = QT_B, OFF_P = OFF_KT + KT_B, OFF_A = OFF_P + P_B, OFF_VT = OFF_A + A_B, UNIT_B = OFF_VT + VT_B;
    static constexpr int NSL = DVH / 128, BUF_B = OFF_VT + 8192, NP1 = OFF_VT / 1024, NP = NP1 + 8, NR = (NP + 7) / 8;
    static_assert(A_B >= DK * 4 && OFF_VT % 1024 == 0, "rec layout");
};
typedef short rbf16x8 __attribute__((ext_vector_type(8)));
__device__ __forceinline__ rbf16x8 rpack8(f32x4 a, f32x4 b) { v4u w; w.x = pg8::cvt_pk_bf16(a.x, a.y); w.y = pg8::cvt_pk_bf16(a.z, a.w); w.z = pg8::cvt_pk_bf16(b.x, b.y); w.w = pg8::cvt_pk_bf16(b.z, b.w); return __builtin_bit_cast(rbf16x8, w); }

template <bool GLA>
__device__ __forceinline__ void rec_prep(Frame& F, const bf16* proj, unsigned char* rec, const float* lbl, int lb_on, const float* glow, const float* wup, const float* bgate) {
    using C = RecCfg<GLA>;
    constexpr int DK = C::DK, DVH = C::DVH, NH = C::NH, CH = C::CH, NCH = C::NCH, PITCH = C::PITCH, QP = C::QP;
    constexpr int NSEG = NTHREADS / DK, TPS = CH / NSEG;
    constexpr int NSEGV = NTHREADS / DVH, TPV = CH / NSEGV;
    LAS float* segtot = (LAS float*)F.lds;
    LAS bf16* qm = (LAS bf16*)(F.lds + 2048);
    LAS bf16* km = qm + CH * QP;
    LAS float* sgl = (LAS float*)(F.lds + 2048 + 2 * CH * QP * 2);
    const int d = F.tid % DK, seg = F.tid / DK, lane = F.lane, el = lane & 15, q4 = lane >> 4;
    const int x = d & 31, y = x & 15, pos = (d & ~31) + 8 * (y >> 2) + (y & 3) + 4 * (x >> 4);
    constexpr int NUNITS = BATCH * NH * NCH, NBH = BATCH * NH;
    float lb = 0.f, bg = 0.f; float wu[16]; int hprev = -1;
    unsigned short rq[TPS], rk[TPS]; unsigned rvv[TPV / 2]; float rgl = 0.f;
    unsigned short rvr[GLA ? 1 : TPV];
    const int ev = F.tid % DVH, sv = F.tid / DVH;
    const unsigned toff = (unsigned)(seg * TPS) * (unsigned)(PITCH * 2) + (unsigned)d * 2u, voff = (unsigned)(sv * TPV) * (unsigned)(PITCH * 2) + (unsigned)ev * 2u;
#define PREP_LOAD(un) do { const int c_ = (un) / NBH, bh_ = (un) % NBH; const size_t row_ = (size_t)(bh_ / NH) * T + (size_t)c_ * CH; const int h_ = bh_ % NH; \
        const char* ubq_ = (const char*)(proj + row_ * PITCH + h_ * DK); const char* ubv_ = (const char*)(proj + row_ * PITCH + 2048 + h_ * DVH); (void)ubv_; \
        if (GLA) rgl = glow[row_ * 16 + F.tid];     \
        _Pragma("unroll") for (int i = 0; i < TPS; ++i) { const char* rb_ = ubq_ + (size_t)i * (PITCH * 2);     \
            rq[i] = *(const bf16*)(rb_ + toff); rk[i] = *(const bf16*)(rb_ + 2048 + toff); } \
        if (!GLA) { _Pragma("unroll") for (int i = 0; i < TPV; ++i) rvr[i] = *(const bf16*)((ubv_ + (size_t)i * (PITCH * 2)) + voff); } \
        } while (0)
    if (F.bid < NUNITS) PREP_LOAD(F.bid);
    for (int unit = F.bid; unit < NUNITS; unit += F.G) {
        const int c = unit / NBH, bh = unit % NBH, h = bh % NH, b = bh / NH;
        const size_t row0 = (size_t)b * T + (size_t)c * CH;
        if (h != hprev) { hprev = h;
            if (!GLA) { lb = 0.f; if (lb_on) lb = fminf(fmaxf(sigmoid_f(lbl[1024 + h * DK + d] - lbl[h * DK + d]), 0.f), 1.0f - 1e-6f); }
            else {
#pragma unroll
                for (int r = 0; r < 16; ++r) wu[r] = wup[r * 1024 + h * DK + d];
                bg = bgate[h * DK + d]; } }
        if (GLA) { sgl[F.tid] = rgl; __syncthreads(); }
        float qv[TPS], kv[TPS], G[TPS]; float run = 0.f;
#pragma unroll
        for (int i = 0; i < TPS; ++i) { const int t = seg * TPS + i; const float qa = bf1(rq[i]), ka = bf1(rk[i]); float g;
            if (!GLA) { qv[i] = silu_x(qa); const float ez = __expf(-fabsf(ka)), rz = __builtin_amdgcn_rcpf(1.0f + ez), big = rz, small = ez * rz;
                const float sg = ka >= 0.f ? big : small, ng = ka >= 0.f ? small : big; const float f = fmaxf(lb + (1.f - lb) * sg, 1e-30f); g = __logf(f); kv[i] = (1.f - lb) * ng; }
            else { qv[i] = qa * 0.0625f; kv[i] = ka; float xx = bg;
#pragma unroll
                for (int r = 0; r < 16; ++r) xx += sgl[t * 16 + r] * wu[r];
                g = log_sigmoid_fast(xx) * 0.0625f; }
            run += g; G[i] = run; }
        segtot[seg * DK + d] = run;
        __syncthreads();
        float off = 0.f, tot = 0.f, rmid = 0.f;
#pragma unroll
        for (int s = 0; s < NSEG; ++s) { const float v = segtot[s * DK + d]; tot += v; if (s < seg) off += v; if (s < 16 / TPS) rmid += v; }
        unsigned char* ub = rec + (size_t)(bh * NCH + c) * C::UNIT_B;
        bf16* QT = (bf16*)(ub + C::OFF_QT); bf16* KT = (bf16*)(ub + C::OFF_KT); bf16* Pb = (bf16*)(ub + C::OFF_P); float* Ab = (float*)(ub + C::OFF_A); bf16* VT = (bf16*)(ub + C::OFF_VT);
        unsigned kt[TPS / 2];
#pragma unroll
        for (int i = 0; i < TPS; i += 2) { float kh[2];
#pragma unroll
            for (int u = 0; u < 2; ++u) { const int t = seg * TPS + i + u; const float Gt = G[i + u] + off;
                QT[t * QP + pos] = (bf16)f2bf(qv[i + u] * __expf(Gt)); kh[u] = kv[i + u] * __expf(tot - Gt);
                qm[t * QP + d] = (bf16)f2bf(qv[i + u] * __expf(fminf(Gt - rmid, 80.f))); km[t * QP + d] = (bf16)f2bf(kv[i + u] * __expf(fminf(rmid - Gt, 80.f))); }
            kt[i / 2] = pk2(kh[0], kh[1]); }
#pragma unroll
        for (int j = 0; j < TPS / 8; ++j) { v4u w; w.x = kt[4 * j]; w.y = kt[4 * j + 1]; w.z = kt[4 * j + 2]; w.w = kt[4 * j + 3]; *(v4u*)(KT + d * CH + ((seg * TPS + 8 * j) ^ ((d & 8) << 1))) = w; }
        if (seg == NSEG - 1) Ab[d] = __expf(tot);
        { bf16* vt_ = VT + ev * CH;
          if (GLA) { const char* ubv_ = (const char*)(proj + row0 * PITCH + 2048 + h * DVH);
#pragma unroll
              for (int i = 0; i < TPV; i += 2) rvv[i / 2] = (unsigned)*(const bf16*)(ubv_ + (voff + (unsigned)i * (unsigned)(PITCH * 2))) | ((unsigned)*(const bf16*)(ubv_ + (voff + (unsigned)(i + 1) * (unsigned)(PITCH * 2))) << 16); }
          else {
#pragma unroll
              for (int i = 0; i < TPV; i += 2) rvv[i / 2] = (unsigned)rvr[i] | ((unsigned)rvr[i + 1] << 16); }
#pragma unroll
          for (int j = 0; j < TPV / 8; ++j) { v4u w; w.x = rvv[4 * j]; w.y = rvv[4 * j + 1]; w.z = rvv[4 * j + 2]; w.w = rvv[4 * j + 3];
              *(v4u*)(vt_ + ((sv * TPV + 8 * j) ^ ((ev & 8) << 1))) = w; } }
        if (unit + F.G < NUNITS) PREP_LOAD(unit + F.G);
        __syncthreads();
        if (F.wave < 3) { const int tt = F.wave >= 1, st = F.wave == 2; f32x4 acc = {0.f, 0.f, 0.f, 0.f};
#pragma unroll
            for (int i = 0; i < DK / 32; ++i) { const rbf16x8 a = *(const LAS rbf16x8*)(km + (16 * st + el) * QP + 32 * i + 8 * q4), bq = *(const LAS rbf16x8*)(qm + (16 * tt + el) * QP + 32 * i + 8 * q4);
                acc = __builtin_amdgcn_mfma_f32_16x16x32_bf16(a, bq, acc, 0, 0, 0); }
            const int ta = 16 * tt + el, s0 = 16 * st + 4 * q4;
            const float p0 = s0 + 0 <= ta ? acc[0] : 0.f, p1 = s0 + 1 <= ta ? acc[1] : 0.f, p2 = s0 + 2 <= ta ? acc[2] : 0.f, p3 = s0 + 3 <= ta ? acc[3] : 0.f;
            v2u w; w.x = pk2(p0, p1); w.y = pk2(p2, p3); *(v2u*)(Pb + ta * CH + (s0 ^ ((ta & 8) << 1))) = w; }
        else if (F.wave == 3) { v2u w; w.x = 0u; w.y = 0u; *(v2u*)(Pb + el * CH + ((16 + 4 * q4) ^ ((el & 8) << 1))) = w; }
        __syncthreads();
    }
#undef PREP_LOAD
}

template <bool GLA>
__device__ __forceinline__ void rec_seq(Frame& F, const unsigned char* rec, float* O, const bf16* proj, const float* gain, bf16* cat) {
    using C = RecCfg<GLA>;
    constexpr int DK = C::DK, DVH = C::DVH, NH = C::NH, CH = C::CH, NCH = C::NCH, QP = C::QP, NSL = C::NSL, NDT = DK / 16, NKS = DK / 32;
    constexpr int NBUF = 3, PF = NBUF - 1;
    constexpr int BUFG = C::BUF_B + (GLA ? 0 : 8192);
    constexpr int NWAIT = (PF - 1) * ((C::NR - 1) + (GLA ? 0 : 1) + 2);
    static_assert(NBUF * BUFG + 2048 <= RING_BYTES, "rec ring");
    constexpr int NUNITS = BATCH * NH * NSL;
    const int lane = F.lane, el = lane & 15, q4 = lane >> 4, wave = F.wave;
    for (int unit = F.bid; unit < NUNITS; unit += F.G) {
        const int sl = unit % NSL, h = (unit / NSL) % NH, b = unit / (NSL * NH);
        const unsigned char* ubase = rec + (size_t)((b * NH + h) * NCH) * C::UNIT_B;
#define REC_DMA(cc) do { const unsigned char* ub_ = ubase + (size_t)(cc) * C::UNIT_B; const int bufi_ = (cc) % NBUF; _Pragma("unroll") for (int r_ = 0; r_ < C::NR; ++r_) { const int p_ = r_ * 8 + wave; \
            if (p_ < C::NP) { const unsigned char* src_ = ub_ + (p_ < C::NP1 ? p_ * 1024 : C::OFF_VT + sl * 8192 + (p_ - C::NP1) * 1024) + lane * 16; \
                __builtin_amdgcn_global_load_lds((const unsigned*)src_, (LAS unsigned*)(F.lds + bufi_ * BUFG + p_ * 1024), 16, 0, 0); } } \
            if (!GLA) { const unsigned char* gsrc_ = (const unsigned char*)(proj + ((size_t)b * T + (size_t)(cc) * CH + 4 * wave + (lane >> 4)) * AB_N + 3072 + h * DVH) + (lane & 15) * 16; \
                __builtin_amdgcn_global_load_lds((const unsigned*)gsrc_, (LAS unsigned*)(F.lds + bufi_ * BUFG + C::BUF_B + wave * 1024), 16, 0, 0); } } while (0)
        f32x4 S[NDT];
#pragma unroll
        for (int i = 0; i < NDT; ++i) S[i] = (f32x4){0.f, 0.f, 0.f, 0.f};
#pragma unroll
        for (int cc = 0; cc < PF; ++cc) REC_DMA(cc);
        float* Ob = O + ((size_t)b * T) * C::OPITCH + h * DVH + sl * 128 + 16 * wave + 4 * q4;
        LAS float* ssq = (LAS float*)(F.lds + NBUF * BUFG);
        f32x4 oprev[2] = {{0.f, 0.f, 0.f, 0.f}, {0.f, 0.f, 0.f, 0.f}};
        v2u gsave[2] = {{0u, 0u}, {0u, 0u}};
        const unsigned ecol = (unsigned)(h * DVH + 16 * wave + 4 * q4);
        f32x4 gn4 = {1.f, 1.f, 1.f, 1.f}; if (!GLA) gn4 = *(const f32x4*)(gain + ecol);
#define REC_FINISH(cp) do { _Pragma("unroll") for (int tt = 0; tt < 2; ++tt) { const int tl = 16 * tt + el; float tot = 0.f; \
            _Pragma("unroll") for (int w_ = 0; w_ < 8; ++w_) tot += ssq[(((cp) & 1) * 8 + w_) * 32 + tl]; \
            const float rstd = 1.0f / sqrtf(tot * (1.f / 128.f) + EPS); const size_t row_ = (size_t)b * T + (size_t)(cp) * CH + tl; \
            const v2u gw_ = gsave[tt]; const f32x4 ov = oprev[tt]; \
            v2u w_o; w_o.x = pk2(ov.x * rstd * gn4.x * silu_x(bf_lo(gw_.x)), ov.y * rstd * gn4.y * silu_x(bf_hi(gw_.x))); \
            w_o.y = pk2(ov.z * rstd * gn4.z * silu_x(bf_lo(gw_.y)), ov.w * rstd * gn4.w * silu_x(bf_hi(gw_.y))); \
            *(v2u*)(cat + row_ * DM + ecol) = w_o; } } while (0)
        for (int c = 0; c < NCH; ++c) {
            if (c <= PF) asm volatile("s_waitcnt vmcnt(0)" ::: "memory"); else asm volatile("s_waitcnt vmcnt(%0)" :: "i"(NWAIT) : "memory");
            asm volatile("s_waitcnt lgkmcnt(0)" ::: "memory"); __builtin_amdgcn_s_barrier(); asm volatile("" ::: "memory");
            if (!GLA) {
                if (c > 0) REC_FINISH(c - 1);
                else { v2u z; z.x = 0u; z.y = 0u; *(v2u*)(cat + ((size_t)b * T + el) * DM + ecol) = z; *(v2u*)(cat + ((size_t)b * T + 16 + el) * DM + ecol) = z; }
            }
            if (c + PF < NCH) REC_DMA(c + PF); else REC_DMA(NCH - 1);
            const LAS unsigned char* L = F.lds + (c % NBUF) * BUFG;
            rbf16x8 sf[NKS];
#pragma unroll
            for (int i = 0; i < NKS; ++i) sf[i] = rpack8(S[2 * i], S[2 * i + 1]);
            f32x4 o[2];
#pragma unroll
            for (int tt = 0; tt < 2; ++tt) { o[tt] = (f32x4){0.f, 0.f, 0.f, 0.f};
#pragma unroll
                for (int i = 0; i < NKS; ++i) { const rbf16x8 qf = *(const LAS rbf16x8*)(L + C::OFF_QT + ((16 * tt + el) * QP + 32 * i + 8 * q4) * 2);
                    o[tt] = __builtin_amdgcn_mfma_f32_16x16x32_bf16(sf[i], qf, o[tt], 0, 0, 0); } }
            const rbf16x8 vf = *(const LAS rbf16x8*)(L + C::OFF_VT + ((16 * wave + el) * CH + 8 * q4) * 2);
#pragma unroll
            for (int tt = 0; tt < 2; ++tt) { const rbf16x8 pf = *(const LAS rbf16x8*)(L + C::OFF_P + ((16 * tt + el) * CH + 8 * q4) * 2);
                o[tt] = __builtin_amdgcn_mfma_f32_16x16x32_bf16(vf, pf, o[tt], 0, 0, 0); }
#pragma unroll
            for (int dt = 0; dt < NDT; ++dt) { const f32x4 a4 = *(const LAS f32x4*)(L + C::OFF_A + (16 * dt + 4 * q4) * 4); S[dt] = S[dt] * a4;
                const rbf16x8 kf = *(const LAS rbf16x8*)(L + C::OFF_KT + ((16 * dt + el) * CH + 8 * q4) * 2);
                S[dt] = __builtin_amdgcn_mfma_f32_16x16x32_bf16(kf, vf, S[dt], 0, 0, 0); }
            if (GLA) {
#pragma unroll
                for (int tt = 0; tt < 2; ++tt) *(f32x4*)(Ob + (size_t)(c * CH + 16 * tt + el) * C::OPITCH) = o[tt];
            } else {
#pragma unroll
                for (int tt = 0; tt < 2; ++tt) { float p = (o[tt].x * o[tt].x + o[tt].y * o[tt].y) + (o[tt].z * o[tt].z + o[tt].w * o[tt].w); p = xsum<16>(p); p = xsum<32>(p);
                    if (q4 == 0) ssq[((c & 1) * 8 + wave) * 32 + 16 * tt + el] = p; oprev[tt] = o[tt];
                    gsave[tt] = *(const LAS v2u*)(L + C::BUF_B + ((16 * tt + el) * 128 + 16 * wave + 4 * q4) * 2); }
            }
        }
        asm volatile("s_waitcnt vmcnt(0)" ::: "memory"); __syncthreads();
        if (!GLA) { REC_FINISH(NCH - 1); }
        __syncthreads();
#undef REC_FINISH
#undef REC_DMA
    }
}

template <bool GLA>
__device__ __forceinline__ void rec_seq2(Frame& F, const unsigned char* rec, bf16* O) {
    using C = RecCfg<GLA>;
    constexpr int DK = C::DK, DVH = C::DVH, NH = C::NH, CH = C::CH, NCH = C::NCH, QP = C::QP;
    constexpr int NDH = DK / 32, NKH = DK / 64;
    constexpr int ES = 64, NSL = DVH / ES, BUF2 = C::OFF_VT + ES * CH * 2, NP1 = C::OFF_VT / 1024, NP = NP1 + ES * CH * 2 / 1024, NR = NP / 8;
    constexpr int NBUF = GLA ? 3 : 5, PF = NBUF - 1, NWAIT = (PF - 1) * (NR + 1);
    static_assert(NP % 8 == 0 && NBUF * BUF2 + 2 * 8 * 1024 <= RING_BYTES, "rec_seq2 ring");
    constexpr int NUNITS = BATCH * NH * NSL;
    const int lane = F.lane, el = lane & 15, q4 = lane >> 4, wave = F.wave, eg = wave & 3, dg = wave >> 2;
    LAS unsigned char* xch = F.lds + NBUF * BUF2;
    for (int unit = F.bid; unit < NUNITS; unit += F.G) {
        const int sl = unit % NSL, h = (unit / NSL) % NH, b = unit / (NSL * NH);
        const unsigned char* ubase = rec + (size_t)((b * NH + h) * NCH) * C::UNIT_B;
#define G2_DMA(cc) do { const unsigned char* ub_ = ubase + (size_t)(cc) * C::UNIT_B; const int bufi_ = (cc) % NBUF; _Pragma("unroll") for (int r_ = 0; r_ < NR; ++r_) { const int p_ = r_ * 8 + wave; \
            const unsigned char* src_ = ub_ + (p_ < NP1 ? p_ * 1024 : C::OFF_VT + sl * (ES * CH * 2) + (p_ - NP1) * 1024) + lane * 16; \
            __builtin_amdgcn_global_load_lds((const unsigned*)src_, (LAS unsigned*)(F.lds + bufi_ * BUF2 + p_ * 1024), 16, 0, 0); } } while (0)
        f32x4 S[NDH];
#pragma unroll
        for (int i = 0; i < NDH; ++i) S[i] = (f32x4){0.f, 0.f, 0.f, 0.f};
#pragma unroll
        for (int cc = 0; cc < PF; ++cc) G2_DMA(cc);
        bf16* Ob = O + ((size_t)b * T + 16 * dg + el) * C::OPITCH + h * DVH + sl * ES + 16 * eg + 4 * q4;
#define G2_ST(p_, v_) do { const f32x4 v4_ = (v_); v2u w2_; w2_.x = pg8::cvt_pk_bf16(v4_.x, v4_.y); w2_.y = pg8::cvt_pk_bf16(v4_.z, v4_.w); *(v2u*)(p_) = w2_; } while (0)
        f32x4 okeep = {0.f, 0.f, 0.f, 0.f};
        for (int c = 0; c < NCH; ++c) {
            if (c <= PF) asm volatile("s_waitcnt vmcnt(0)" ::: "memory"); else asm volatile("s_waitcnt vmcnt(%0)" :: "i"(NWAIT) : "memory");
            asm volatile("s_waitcnt lgkmcnt(0)" ::: "memory"); __builtin_amdgcn_s_barrier(); asm volatile("" ::: "memory");
            if (c + PF < NCH) G2_DMA(c + PF); else G2_DMA(NCH - 1);
            const LAS unsigned char* L = F.lds + (c % NBUF) * BUF2;
            rbf16x8 qf[2][NKH], kf[NDH]; f32x4 a4[NDH];
#pragma unroll
            for (int tt = 0; tt < 2; ++tt)
#pragma unroll
                for (int i = 0; i < NKH; ++i) qf[tt][i] = *(const LAS rbf16x8*)(L + C::OFF_QT + ((16 * tt + el) * QP + 32 * (NKH * dg + i) + 8 * q4) * 2);
            const int sw8 = (8 * q4) ^ ((el & 8) << 1);
            const rbf16x8 vf = *(const LAS rbf16x8*)(L + C::OFF_VT + ((16 * eg + el) * CH + sw8) * 2);
            const rbf16x8 pf = *(const LAS rbf16x8*)(L + C::OFF_P + ((16 * dg + el) * CH + sw8) * 2);
#pragma unroll
            for (int j = 0; j < NDH; ++j) { kf[j] = *(const LAS rbf16x8*)(L + C::OFF_KT + ((16 * (NDH * dg + j) + el) * CH + sw8) * 2); a4[j] = *(const LAS f32x4*)(L + C::OFF_A + (16 * (NDH * dg + j) + 4 * q4) * 4); }
            rbf16x8 sf[NKH];
#pragma unroll
            for (int i = 0; i < NKH; ++i) sf[i] = rpack8(S[2 * i], S[2 * i + 1]);
            f32x4 o[2];
#pragma unroll
            for (int tt = 0; tt < 2; ++tt) { o[tt] = (f32x4){0.f, 0.f, 0.f, 0.f};
#pragma unroll
                for (int i = 0; i < NKH; ++i) o[tt] = __builtin_amdgcn_mfma_f32_16x16x32_bf16(sf[i], qf[tt][i], o[tt], 0, 0, 0); }
            if (dg == 0) o[0] = __builtin_amdgcn_mfma_f32_16x16x32_bf16(vf, pf, o[0], 0, 0, 0); else o[1] = __builtin_amdgcn_mfma_f32_16x16x32_bf16(vf, pf, o[1], 0, 0, 0);
#pragma unroll
            for (int j = 0; j < NDH; ++j) { S[j] = S[j] * a4[j]; S[j] = __builtin_amdgcn_mfma_f32_16x16x32_bf16(kf[j], vf, S[j], 0, 0, 0); }
            if (c > 0) { const f32x4 pr = *(const LAS f32x4*)(xch + ((((c - 1) & 1) * 8 + (wave ^ 4)) * 64 + lane) * 16);
                         G2_ST(Ob + (size_t)((c - 1) * CH) * C::OPITCH, okeep + pr); }
            else { G2_ST(Ob, okeep); }
            *(LAS f32x4*)(xch + (((c & 1) * 8 + wave) * 64 + lane) * 16) = dg == 0 ? o[1] : o[0];
            okeep = dg == 0 ? o[0] : o[1];
        }
        asm volatile("s_waitcnt vmcnt(0) lgkmcnt(0)" ::: "memory"); __syncthreads();
        { const f32x4 pr = *(const LAS f32x4*)(xch + ((((NCH - 1) & 1) * 8 + (wave ^ 4)) * 64 + lane) * 16); G2_ST(Ob + (size_t)((NCH - 1) * CH) * C::OPITCH, okeep + pr); }
        __syncthreads();
#undef G2_ST
#undef G2_DMA
    }
}

template <bool GLA>
__device__ __forceinline__ void rec_seq3(Frame& F, const unsigned char* rec, bf16* O) {
    using C = RecCfg<GLA>;
    constexpr int DK = C::DK, DVH = C::DVH, NH = C::NH, CH = C::CH, NCH = C::NCH, QP = C::QP;
    constexpr int NDH = DK / 32, NKH = DK / 64;
    constexpr int ES = 64, NSL = DVH / ES, BUF2 = C::OFF_VT + ES * CH * 2, NP1 = C::OFF_VT / 1024, NP = NP1 + ES * CH * 2 / 1024, NRL = NP / 4;
    constexpr int NBUF = GLA ? 3 : 5, PF = NBUF - 1, NWAIT = (PF - 1) * NRL;
    static_assert(NP % 4 == 0 && NBUF * BUF2 + 2 * 8 * 1024 <= RING_BYTES && NWAIT < 64, "rec_seq3 ring");
    constexpr int NUNITS = BATCH * NH * NSL;
    const int lane = F.lane, el = lane & 15, q4 = lane >> 4, wave = F.wave;
    LAS unsigned char* xch = F.lds + NBUF * BUF2;
    for (int unit = F.bid; unit < NUNITS; unit += F.G) {
        const int bh = unit % (BATCH * NH), sl = unit / (BATCH * NH), h = bh % NH, b = bh / NH;
        const unsigned char* ubase = rec + (size_t)((b * NH + h) * NCH) * C::UNIT_B;
        const int eg2 = wave & 1, dg = (wave >> 1) & 1;
        bf16* Ob = O + ((size_t)b * T + 16 * dg + el) * C::OPITCH + h * DVH + sl * ES + 32 * eg2 + 4 * q4;
        f32x4 okeep[2] = {{0.f, 0.f, 0.f, 0.f}, {0.f, 0.f, 0.f, 0.f}};
#define G3_ST(p_, v_) do { const f32x4 v4_ = (v_); v2u w2_; w2_.x = pg8::cvt_pk_bf16(v4_.x, v4_.y); w2_.y = pg8::cvt_pk_bf16(v4_.z, v4_.w); *(v2u*)(p_) = w2_; } while (0)
        if (wave >= 4) {
            const int lw = wave - 4;
#define G3_DMA(cc) do { const unsigned char* ub_ = ubase + (size_t)(cc) * C::UNIT_B; const int bufi_ = (cc) % NBUF; _Pragma("unroll") for (int r_ = 0; r_ < NRL; ++r_) { const int p_ = r_ * 4 + lw; \
            const unsigned char* src_ = ub_ + (p_ < NP1 ? p_ * 1024 : C::OFF_VT + sl * (ES * CH * 2) + (p_ - NP1) * 1024) + lane * 16; \
            __builtin_amdgcn_global_load_lds((const unsigned*)src_, (LAS unsigned*)(F.lds + bufi_ * BUF2 + p_ * 1024), 16, 0, 0); } } while (0)
#pragma unroll
            for (int cc = 0; cc < PF; ++cc) G3_DMA(cc);
            for (int c = 0; c < NCH; ++c) {
                asm volatile("s_waitcnt vmcnt(%0)" :: "i"(NWAIT) : "memory");
                __builtin_amdgcn_s_barrier(); asm volatile("" ::: "memory");
                if (c + PF < NCH) G3_DMA(c + PF); else G3_DMA(NCH - 1);
            }
            asm volatile("s_waitcnt vmcnt(0)" ::: "memory");
#undef G3_DMA
        } else {
            f32x4 S[NDH][2];
#pragma unroll
            for (int i = 0; i < NDH; ++i) { S[i][0] = (f32x4){0.f, 0.f, 0.f, 0.f}; S[i][1] = (f32x4){0.f, 0.f, 0.f, 0.f}; }
            const int sw8 = (8 * q4) ^ ((el & 8) << 1);
            for (int c = 0; c < NCH; ++c) {
                asm volatile("s_waitcnt lgkmcnt(0)" ::: "memory"); __builtin_amdgcn_s_barrier(); asm volatile("" ::: "memory");
                const LAS unsigned char* L = F.lds + (c % NBUF) * BUF2;
                rbf16x8 qf[2][NKH], kf[NDH], vf[2]; f32x4 a4[NDH];
#pragma unroll
                for (int tt = 0; tt < 2; ++tt)
#pragma unroll
                    for (int i = 0; i < NKH; ++i) qf[tt][i] = *(const LAS rbf16x8*)(L + C::OFF_QT + ((16 * tt + el) * QP + 32 * (NKH * dg + i) + 8 * q4) * 2);
#pragma unroll
                for (int et = 0; et < 2; ++et) vf[et] = *(const LAS rbf16x8*)(L + C::OFF_VT + ((32 * eg2 + 16 * et + el) * CH + sw8) * 2);
                const rbf16x8 pf = *(const LAS rbf16x8*)(L + C::OFF_P + ((16 * dg + el) * CH + sw8) * 2);
#pragma unroll
                for (int j = 0; j < NDH; ++j) { kf[j] = *(const LAS rbf16x8*)(L + C::OFF_KT + ((16 * (NDH * dg + j) + el) * CH + sw8) * 2); a4[j] = *(const LAS f32x4*)(L + C::OFF_A + (16 * (NDH * dg + j) + 4 * q4) * 4); }
                f32x4 o[2][2];
#pragma unroll
                for (int et = 0; et < 2; ++et) { rbf16x8 sf[NKH];
#pragma unroll
                    for (int i = 0; i < NKH; ++i) sf[i] = rpack8(S[2 * i][et], S[2 * i + 1][et]);
#pragma unroll
                    for (int tt = 0; tt < 2; ++tt) { o[tt][et] = (f32x4){0.f, 0.f, 0.f, 0.f};
#pragma unroll
                        for (int i = 0; i < NKH; ++i) o[tt][et] = __builtin_amdgcn_mfma_f32_16x16x32_bf16(sf[i], qf[tt][i], o[tt][et], 0, 0, 0); } }
#pragma unroll
                for (int et = 0; et < 2; ++et) { if (dg == 0) o[0][et] = __builtin_amdgcn_mfma_f32_16x16x32_bf16(vf[et], pf, o[0][et], 0, 0, 0); else o[1][et] = __builtin_amdgcn_mfma_f32_16x16x32_bf16(vf[et], pf, o[1][et], 0, 0, 0); }
#pragma unroll
                for (int j = 0; j < NDH; ++j)
#pragma unroll
                    for (int et = 0; et < 2; ++et) { S[j][et] = S[j][et] * a4[j]; S[j][et] = __builtin_amdgcn_mfma_f32_16x16x32_bf16(kf[j], vf[et], S[j][et], 0, 0, 0); }
                if (c > 0) {
#pragma unroll
                    for (int et = 0; et < 2; ++et) { const f32x4 pr = *(const LAS f32x4*)(xch + (((((c - 1) & 1) * 4 + (wave ^ 2)) * 2 + et) * 64 + lane) * 16);
                        G3_ST(Ob + (size_t)((c - 1) * CH) * C::OPITCH + 16 * et, okeep[et] + pr); } }
#pragma unroll
                for (int et = 0; et < 2; ++et) { *(LAS f32x4*)(xch + ((((c & 1) * 4 + wave) * 2 + et) * 64 + lane) * 16) = dg == 0 ? o[1][et] : o[0][et]; okeep[et] = dg == 0 ? o[0][et] : o[1][et]; }
            }
        }
        asm volatile("s_waitcnt vmcnt(0) lgkmcnt(0)" ::: "memory"); __syncthreads();
        if (wave < 4) {
#pragma unroll
            for (int et = 0; et < 2; ++et) { const f32x4 pr = *(const LAS f32x4*)(xch + (((((NCH - 1) & 1) * 4 + (wave ^ 2)) * 2 + et) * 64 + lane) * 16);
                G3_ST(Ob + (size_t)((NCH - 1) * CH) * C::OPITCH + 16 * et, okeep[et] + pr); } }
        __syncthreads();
#undef G3_ST
    }
}
#define WSP(T_, off) ((T_*)(ws + (off)))
#define REFRAME() CArgs* ap = opq_args(); unsigned char* ws = ap->ws; (void)ws; \
    F.lds = (LAS unsigned char*)lds; F.tid = opq_tid(wave_s); F.lane = F.tid & 63; F.wave = __builtin_amdgcn_readfirstlane(F.tid >> 6); F.G = gridDim.x; F.bid = opq_bid()
#ifndef DBG_DOUBLE
#define DBG_DOUBLE 0
#endif
#define NREP(bit) ((DBG_DOUBLE & (bit)) ? 2 : 1)
#define REPBAR(rep, n) do { if ((rep) + 1 < (n)) xcd_barrier<false>(bar, F.tid == 0); } while (0)
#define IN(k) (lo <= (k) && (k) < hi)
#define SEAM(k) do { if (IN(k) && IN((k) + 1)) xcd_barrier<false>(bar, F.tid == 0); } while (0)
template <int layer>
__device__ __forceinline__ void layer_phases(unsigned char* lds, const int wave_s, const int lo, const int hi, const XcdBarrier& bar) {
    Frame F;

        constexpr int pb = phase_base(layer); constexpr bool odd = layer & 1; constexpr int li = layer >> 1;
        constexpr int P_NORM1 = pb, P_MIXIN = pb + 1, P_PREP = pb + 2, P_REC = pb + 3, P_POST = pb + 4, P_MIXOUT = pb + 5, P_NORM2 = P_MIXOUT + 1, P_FFIN = P_MIXOUT + 2, P_FFOUT = P_MIXOUT + 3;
#define MODL (WSP(float, WS_MOD) + (size_t)layer * 2 * 6 * DM)
#define XCUR (layer == 0 ? ap->in[0] : (const float*)ap->out)
        if (IN(P_NORM1)) { REFRAME();
            const float* modl = MODL;
            for (int rep = 0; rep < NREP(2); ++rep) {
            constexpr bool L0 = layer == 0; const float* g2p = WSP(float, WS_MOD) + (size_t)(L0 ? 0 : layer - 1) * 2 * 6 * DM + 5 * DM; const void* xin = L0 ? (const void*)ap->in[0] : (const void*)WSP(const bf16, WS_XB);
            if (!odd) norm_phase<8, 1, !L0, L0>(F, xin, ap->in[4] + (size_t)layer * DM, modl, modl + DM, WSP(bf16, WS_H), ap->in[6] + (size_t)li * DM * AB_IN + AB_N, AB_IN, ap->in[12] + li * 8, WSP(float, WS_LOGF), WSP(const bf16, WS_Y), g2p, WSP(bf16, WS_XB));
            else norm_phase<16, 2, !L0, L0>(F, xin, ap->in[4] + (size_t)layer * DM, modl, modl + DM, WSP(bf16, WS_H), ap->in[13] + (size_t)li * DM * C_IN + C_N, C_IN, nullptr, WSP(float, WS_GLOW), WSP(const bf16, WS_Y), g2p, WSP(bf16, WS_XB));
            REPBAR(rep, NREP(2)); }
            SEAM(P_NORM1);
        }
        if (IN(P_MIXIN)) { REFRAME();
            const int N = odd ? 4096 : AB_N, ldc = odd ? C_N : AB_N;
            const bf16* Wt = odd ? WSP(const bf16, WS_W_GLIN) + (size_t)li * C_N * DM : WSP(const bf16, WS_W_ABIN) + (size_t)li * AB_N * DM;
            pg8::Gemm g{WSP(const bf16, WS_H), Wt, M, N, DM}; pg8::StaticOrder S; S.init(M, N, F.G, F.bid);
            pg8::EpiBf16 E{WSP(bf16, WS_PROJ), ldc};
            for (int rep = 0; rep < NREP(1); ++rep) { pg8::gemm_phase<pg8::EpiBf16, pg8::StaticOrder, true, true>(F.lds + RING_OFF, g, S, E, F.tid); REPBAR(rep, NREP(1)); }
            SEAM(P_MIXIN);
        }
        if (IN(P_PREP)) { REFRAME();
            if (!odd) { fox_prep(F, WSP(bf16, WS_PROJ), ap->in[10] + li * 128, ap->in[11] + li * 128, WSP(float, WS_LOGF), WSP(float, WS_BIAS));
                        __syncthreads();
                        for (int rep = 0; rep < NREP(4); ++rep) { rec_prep<false>(F, WSP(const bf16, WS_PROJ), ws + WS_REC, ap->in[8], li, nullptr, nullptr, nullptr); REPBAR(rep, NREP(4)); } }
            else for (int rep = 0; rep < NREP(4); ++rep) { rec_prep<true>(F, WSP(const bf16, WS_PROJ), ws + WS_REC, nullptr, 0, WSP(float, WS_GLOW), ap->in[14] + (size_t)li * 16 * 1024, ap->in[15] + li * 1024); REPBAR(rep, NREP(4)); }
            SEAM(P_PREP);
        }
        if (IN(P_REC)) { REFRAME();
            for (int rep = 0; rep < (odd ? NREP(8) : 1); ++rep) {
            if (!odd) { rec_seq3<false>(F, ws + WS_REC, WSP(bf16, WS_O));
                        fox_phase(F, (char*)lds + RING_OFF, WSP(const bf16, WS_PROJ), WSP(bf16, WS_CAT), WSP(float, WS_BIAS), (unsigned*)(ws + WS_CTL) + CW_QUEUE + 64 * (li + 2 * rep), ap->in[10] + li * 128, ap->in[11] + li * 128);
                        if constexpr (layer == 0) p0_deferred(F, ap); }
            else { rec_seq3<true>(F, ws + WS_REC, WSP(bf16, WS_O));
                   if (F.bid < 64 && rep == 0) { LAS float* scr = (LAS float*)(F.lds + RING_OFF + F.wave * 16640);
                       convert_weights<(layer == 1 ? 1 : 2)>(ap, scr, 0, 1, F.lane, (unsigned*)(ws + WS_CTL) + CW_CONV, F.wave, F.tid == 0, (volatile LAS unsigned*)(F.lds + MISC_OFF) + 32); }
                   if (F.bid >= 64 && rep == 0) {
                       { pg8::Gemm g{WSP(const bf16, WS_H), WSP(const bf16, WS_W_GLIN) + (size_t)li * C_N * DM + (size_t)4096 * DM, M, 2048, DM}; pg8::StaticOrder S; S.init(M, 2048, F.G - 64, F.bid - 64);
                         pg8::EpiBf16 E{WSP(bf16, WS_PROJ) + 4096, C_N};
                         pg8::gemm_phase<pg8::EpiBf16, pg8::StaticOrder, true, true>(F.lds + RING_OFF, g, S, E, F.tid); }
                       LAS float* scr = (LAS float*)(F.lds + RING_OFF + F.wave * 16640);
                       convert_weights<(layer == 1 ? 1 : 2)>(ap, scr, 0, 1, F.lane, (unsigned*)(ws + WS_CTL) + CW_CONV, F.wave, F.tid == 0, (volatile LAS unsigned*)(F.lds + MISC_OFF) + 32); } }
            REPBAR(rep, (odd ? NREP(8) : 1)); }
            SEAM(P_REC);
        }
        if (IN(P_POST)) { REFRAME();
            if (!odd) post_even(F, WSP(const bf16, WS_O), WSP(const bf16, WS_PROJ), ap->in[9] + li * 1024, WSP(bf16, WS_CAT));
            else for (int rep = 0; rep < NREP(16); ++rep) { post_odd(F, WSP(const bf16, WS_O), WSP(const bf16, WS_PROJ), ap->in[16] + li * 512, WSP(bf16, WS_CAT)); REPBAR(rep, NREP(16)); }
            SEAM(P_POST);
        }
        if (IN(P_MIXOUT)) { REFRAME();
            const float* modl = MODL;
            const bf16* Wt = odd ? WSP(const bf16, WS_W_GLOUT) + (size_t)li * DM * DM : WSP(const bf16, WS_W_ABOUT) + (size_t)li * DM * DM;
            pg8::Gemm g{WSP(const bf16, WS_CAT), Wt, M, DM, DM}; pg8::StaticOrder S; S.init(M, DM, F.G, F.bid);
            pg8::EpiBf16 E{WSP(bf16, WS_Y), DM};
            pg8::gemm_phase<pg8::EpiBf16, pg8::StaticOrder, true, true>(F.lds + RING_OFF, g, S, E, F.tid);
            SEAM(P_MIXOUT);
        }
        if (IN(P_NORM2)) { REFRAME();
            const float* modl = MODL;
            { constexpr bool L0 = layer == 0; const void* xin = L0 ? (const void*)ap->in[0] : (const void*)WSP(const bf16, WS_XB);
              norm_phase<0, 0, true, L0>(F, xin, ap->in[5] + (size_t)layer * DM, modl + 3 * DM, modl + 4 * DM, WSP(bf16, WS_H), nullptr, 0, nullptr, nullptr, WSP(const bf16, WS_Y), modl + 2 * DM, WSP(bf16, WS_XB)); }
            SEAM(P_NORM2);
        }
        if (IN(P_FFIN)) { REFRAME();
            pg8::Gemm g{WSP(const bf16, WS_H), WSP(const bf16, WS_W_FFIN) + (size_t)layer * FF2 * DM, M, FF2, DM}; pg8::StaticOrder S; S.init(M, FF2, F.G, F.bid);
            pg8::EpiSwiglu E{WSP(bf16, WS_FFH), FF};
            for (int rep = 0; rep < NREP(1 | 128); ++rep) { pg8::gemm_phase<pg8::EpiSwiglu, pg8::StaticOrder, true, true>(F.lds + RING_OFF, g, S, E, F.tid); REPBAR(rep, NREP(1 | 128)); }
            SEAM(P_FFIN);
        }
        if (IN(P_FFOUT)) { REFRAME();
            const float* modl = MODL;
            pg8::Gemm g{WSP(const bf16, WS_FFH), WSP(const bf16, WS_W_FFOUT) + (size_t)layer * DM * FF, M, DM, FF}; pg8::StaticOrder S; S.init(M, DM, F.G, F.bid);
            if constexpr (layer == DEPTH - 1) {
                const float* g2 = WSP(float, WS_MOD) + (size_t)(DEPTH - 1) * 2 * 6 * DM + 5 * DM;
                pg8::EpiResidBf E{(const pg8::bf16_t*)WSP(const bf16, WS_XB), ap->out, DM, g2, g2 + 6 * DM, (int)(T / pg8::BM)};
                pg8::gemm_phase<pg8::EpiResidBf, pg8::StaticOrder, true, true>(F.lds + RING_OFF, g, S, E, F.tid);
            } else {
            pg8::EpiBf16 E{WSP(bf16, WS_Y), DM};
            pg8::gemm_phase<pg8::EpiBf16, pg8::StaticOrder, true, true>(F.lds + RING_OFF, g, S, E, F.tid); }
            SEAM(P_FFOUT);
        }
    }
__global__ void __launch_bounds__(NTHREADS, 2) trunk_fwd(Args args_unused) {
    extern __shared__ __attribute__((aligned(16))) unsigned char lds[];
    Frame F;
    const int wave_s = __builtin_amdgcn_readfirstlane(threadIdx.x >> 6);
    int lo, hi, use_bar; XcdBarrier bar;
    {
        REFRAME();
        volatile LAS unsigned* MISC = (volatile LAS unsigned*)(F.lds + MISC_OFF);
        for (int u = F.tid; u < (LDS_BYTES - LDSCTL_OFF) / 4; u += NTHREADS) ((LAS unsigned*)(F.lds + LDSCTL_OFF))[u] = 0u;
        __syncthreads();
        lo = ap->ph_lo; hi = ap->ph_hi; use_bar = ap->use_bar;
        bar.bar = (unsigned*)(ws + WS_CTL) + CW_BAR; bar.x = 0; bar.st = MISC + 8;
        if (use_bar) bar = xcd_barrier_post((unsigned*)(ws + WS_CTL) + CW_BAR, MISC + 8, F.tid == 0);
    }

    if (IN(0)) { REFRAME(); p0_prologue(F, ap); if (IN(1)) xcd_barrier<true>(bar, F.tid == 0);
        if (DBG_DOUBLE & 32) { p0_prologue(F, ap); xcd_barrier<false>(bar, F.tid == 0); } }

    layer_phases<0>(lds, wave_s, lo, hi, bar);
    layer_phases<1>(lds, wave_s, lo, hi, bar);
    layer_phases<2>(lds, wave_s, lo, hi, bar);
    layer_phases<3>(lds, wave_s, lo, hi, bar);
#undef IN
#undef SEAM
}

#ifndef DBG_CHECK
#define DBG_CHECK 0
#endif
#if DBG_CHECK
#ifndef DBG_REPORT_ERR
#define DBG_REPORT_ERR 1
#endif
constexpr size_t WS_DBG = 5 * MiB;
constexpr size_t WS_DBG_OLD = 1072 * MiB;
__device__ __forceinline__ unsigned dbg_hash(unsigned x) { x ^= x >> 16; x *= 0x7feb352dU; x ^= x >> 15; x *= 0x846ca68bU; x ^= x >> 16; return x; }
__device__ __forceinline__ float dbg_bfr(float f) { return __builtin_bit_cast(float, f2bf(f) << 16); }
__device__ __forceinline__ void dbg_cmp(unsigned* dbg, unsigned code, float got, float ref, float rtol, float atol) {
    const float err = fabsf(got - ref); const bool bad = !(err <= atol + rtol * fabsf(ref));
    if (bad) { atomicMin(dbg, code); atomicMax(dbg + 1 + (code & 255u), __float_as_uint(err)); }
}
__global__ void dbg_gemm(unsigned* dbg, unsigned code, int mode, const bf16* A, int K, const float* W, int ldw, int N, const void* C, int ldc, const float* old, const float* gate0, const float* gate1) {
    const unsigned s = blockIdx.x * blockDim.x + threadIdx.x; const unsigned hsh = dbg_hash(s * 2654435761u + code);
    const int m = hsh % M, n = dbg_hash(hsh) % N;
    float d0 = 0.f, d1 = 0.f;
    for (int k = 0; k < K; ++k) { const float a = bf1(A[(size_t)m * K + k]); d0 += a * dbg_bfr(W[(size_t)k * ldw + n]); if (mode == 1) d1 += a * dbg_bfr(W[(size_t)k * ldw + FF + n]); }
    float got, ref;
    if (mode == 0) { got = bf1(((const bf16*)C)[(size_t)m * ldc + n]); ref = d0; }
    else if (mode == 1) { got = bf1(((const bf16*)C)[(size_t)m * ldc + n]); ref = d0 / (1.f + expf(-d0)) * d1; }
    else { got = ((const float*)C)[(size_t)m * ldc + n]; ref = old[(size_t)m * ldc + n] + (m >= T ? gate1 : gate0)[n] * d0; }
    dbg_cmp(dbg, code, got, ref, 0.02f, 0.03f);
}
__global__ void dbg_norm(unsigned* dbg, unsigned code, const float* x, const float* gain, const float* sh, const float* sc, const bf16* h) {
    const unsigned s = blockIdx.x * blockDim.x + threadIdx.x; const unsigned hsh = dbg_hash(s * 2654435761u + code);
    const int m = hsh % M, k = dbg_hash(hsh) % DM, b = m / T;
    double ss = 0.0; for (int i = 0; i < DM; ++i) { const double v = x[(size_t)m * DM + i]; ss += v * v; }
    const float rstd = (float)(1.0 / sqrt(ss / DM + 1e-6));
    const float ref = x[(size_t)m * DM + k] * rstd * gain[k] * (1.f + sc[(size_t)b * 6 * DM + k]) + sh[(size_t)b * 6 * DM + k];
    dbg_cmp(dbg, code, bf1(h[(size_t)m * DM + k]), ref, 0.01f, 0.01f);
}
__global__ void dbg_mod(unsigned* dbg, unsigned code, const float* c, const float* mw, const float* mb, const float* mod) {
    const unsigned s = blockIdx.x * blockDim.x + threadIdx.x; const unsigned hsh = dbg_hash(s * 2654435761u + code);
    const int layer = hsh % DEPTH, b = (hsh >> 8) & 1, j = dbg_hash(hsh) % (6 * DM);
    double acc = mb[(size_t)layer * 6 * DM + j];
    for (int k = 0; k < DM; ++k) { const double cv = c[b * DM + k]; acc += cv / (1.0 + exp(-cv)) * mw[((size_t)layer * DM + k) * (6 * DM) + j]; }
    dbg_cmp(dbg, code, mod[((size_t)layer * 2 + b) * 6 * DM + j], (float)acc, 1e-3f, 1e-4f);
}
__global__ void dbg_small(unsigned* dbg, unsigned code, int mode, const bf16* h, const float* W, int ldw, const float* fbias, const float* sout) {
    const unsigned s = blockIdx.x * blockDim.x + threadIdx.x; const unsigned hsh = dbg_hash(s * 2654435761u + code);
    const int m = hsh % M, cc = dbg_hash(hsh) % (mode == 1 ? 8 : 16), b = m / T, t = m % T;
    double acc = 0.0; for (int k = 0; k < DM; ++k) acc += (double)bf1(h[(size_t)m * DM + k]) * W[(size_t)k * ldw + cc];
    if (mode == 1) { const double xx = acc + fbias[cc]; const double ref = (xx < 0 ? xx : 0.0) - log1p(exp(-fabs(xx))); dbg_cmp(dbg, code, sout[((size_t)b * 8 + cc) * T + t], (float)ref, 0.02f, 0.02f); }
    else dbg_cmp(dbg, code, sout[(size_t)m * 16 + cc], (float)acc, 0.02f, 0.02f);
}
__global__ void dbg_cmpbuf(unsigned* dbg, unsigned code, const float* a, const float* b, size_t n) {
    for (size_t i = (size_t)blockIdx.x * blockDim.x + threadIdx.x; i < n; i += (size_t)gridDim.x * blockDim.x * 61) dbg_cmp(dbg, code, b[i], a[i], 0.05f, 0.1f);
}
__global__ void dbg_report(const unsigned* dbg, float* out) {
    if (threadIdx.x == 0 && blockIdx.x == 0) { const unsigned code = dbg[0]; if (code != 0xffffffffu) { out[0] = DBG_REPORT_ERR ? 1000.f * __uint_as_float(dbg[1 + (code & 255u)]) : 1000.f * (float)(code & 255u); } }
}
#endif
#ifndef N_LAUNCH_MODE
#define N_LAUNCH_MODE 1
#endif
extern "C" void kernel_launch(void* const* d_in, const int* in_sizes, int n_in, void* d_out, int out_size, void* d_ws, size_t ws_size, hipStream_t stream) {
    static int grid = 0;
    if (grid == 0) {
        if (n_in != 20 || out_size != M * DM || ws_size < WS_END) { fprintf(stderr, "kernel_launch: unexpected shapes (n_in %d out %d ws %zu)\n", n_in, out_size, ws_size); grid = -1; return; }
        int dev = 0, cus = 0, per_cu = 0;
        if (hipGetDevice(&dev) != hipSuccess || hipDeviceGetAttribute(&cus, hipDeviceAttributeMultiprocessorCount, dev) != hipSuccess) { grid = -1; return; }
        if (hipFuncSetAttribute((const void*)trunk_fwd, hipFuncAttributeMaxDynamicSharedMemorySize, LDS_BYTES) != hipSuccess) { fprintf(stderr, "kernel_launch: hipFuncSetAttribute failed\n"); grid = -1; return; }
        if (hipOccupancyMaxActiveBlocksPerMultiprocessor(&per_cu, (const void*)trunk_fwd, NTHREADS, LDS_BYTES) != hipSuccess || per_cu < 1)
            fprintf(stderr, "kernel_launch: occupancy query reports %d workgroups per CU\n", per_cu);
        (void)hipGetLastError();
        grid = cus;
    }
    if (grid < 0) return;
    if (hipMemsetAsync((char*)d_ws + WS_CTL, 0, CTL_ZERO_BYTES, stream) != hipSuccess) return;
    Args a{};
    for (int i = 0; i < 20; ++i) a.in[i] = (const float*)d_in[i];
    a.out = (float*)d_out; a.ws = (unsigned char*)d_ws; a.pad = 0;
#if N_LAUNCH_MODE == 1
    a.ph_lo = 0; a.ph_hi = N_PHASES; a.use_bar = 1;
    hipLaunchKernelGGL(trunk_fwd, dim3(grid), dim3(NTHREADS), LDS_BYTES, stream, a);
#else
    a.use_bar = 0;
#if DBG_CHECK
    unsigned char* wsb = (unsigned char*)d_ws; unsigned* dbg = (unsigned*)(wsb + WS_DBG);
    hipMemsetAsync(dbg, 0xFF, 4, stream); hipMemsetAsync(dbg + 1, 0, 1024, stream);
    const float* const* in = (const float* const*)a.in; float* outp = (float*)d_out; float* oldp = (float*)(wsb + WS_DBG_OLD);
    bf16* hbuf = (bf16*)(wsb + WS_H); bf16* catb = (bf16*)(wsb + WS_CAT); bf16* projb = (bf16*)(wsb + WS_PROJ); bf16* ffhb = (bf16*)(wsb + WS_FFH);
#endif
    for (int p = 0; p < N_PHASES; ++p) {
        int layer = 0; const int q = phase_kind(p, layer); const int li = layer >> 1; const bool odd = layer & 1; (void)li; (void)odd; (void)q;
#if DBG_CHECK
        const float* modl = (const float*)(wsb + WS_MOD) + (size_t)layer * 2 * 6 * DM; const float* xcur = layer == 0 ? in[0] : outp;
        if (q == K_MIXOUT) hipMemcpyAsync(oldp, xcur, (size_t)M * DM * 4, hipMemcpyDeviceToDevice, stream);
        if (q == K_FFOUT) hipMemcpyAsync(oldp, outp, (size_t)M * DM * 4, hipMemcpyDeviceToDevice, stream);
#endif
        a.ph_lo = p; a.ph_hi = p + 1;
        hipLaunchKernelGGL(trunk_fwd, dim3(grid), dim3(NTHREADS), LDS_BYTES, stream, a);
#if DBG_CHECK
        const unsigned code = 1 + p;
        if (q == K_PRO) dbg_mod<<<16, 256, 0, stream>>>(dbg, code, in[1], in[2], in[3], (const float*)(wsb + WS_MOD));
        if (q == K_NORM1) { dbg_norm<<<16, 256, 0, stream>>>(dbg, code, xcur, in[4] + (size_t)layer * DM, modl, modl + DM, hbuf);
            if (!odd) dbg_small<<<16, 256, 0, stream>>>(dbg, code | 0x100, 1, hbuf, in[6] + (size_t)li * DM * AB_IN + AB_N, AB_IN, in[12] + li * 8, (const float*)(wsb + WS_LOGF));
            else dbg_small<<<16, 256, 0, stream>>>(dbg, code | 0x100, 2, hbuf, in[13] + (size_t)li * DM * C_IN + C_N, C_IN, nullptr, (const float*)(wsb + WS_GLOW)); }
        if (q == K_MIXIN) { if (!odd) dbg_gemm<<<16, 256, 0, stream>>>(dbg, code, 0, hbuf, DM, in[6] + (size_t)li * DM * AB_IN, AB_IN, AB_N, projb, AB_N, nullptr, nullptr, nullptr);
            else dbg_gemm<<<16, 256, 0, stream>>>(dbg, code, 0, hbuf, DM, in[13] + (size_t)li * DM * C_IN, C_IN, C_N, projb, C_N, nullptr, nullptr, nullptr); }
#if DBG_REC
        if (q == K_REC) dbg_cmpbuf<<<256, 256, 0, stream>>>(dbg, code, (const float*)(wsb + WS_O), (const float*)(wsb + 1200 * MiB), odd ? (size_t)M * 2048 : (size_t)M * 1024);
#endif
        if (q == K_MIXOUT) dbg_gemm<<<16, 256, 0, stream>>>(dbg, code, 2, catb, DM, (odd ? in[17] : in[7]) + (size_t)li * DM * DM, DM, DM, outp, DM, oldp, modl + 2 * DM, modl + 6 * DM + 2 * DM);
        if (q == K_NORM2) dbg_norm<<<16, 256, 0, stream>>>(dbg, code, outp, in[5] + (size_t)layer * DM, modl + 3 * DM, modl + 4 * DM, hbuf);
        if (q == K_FFIN) dbg_gemm<<<16, 256, 0, stream>>>(dbg, code, 1, hbuf, DM, in[18] + (size_t)layer * DM * FF2, FF2, FF, ffhb, FF, nullptr, nullptr, nullptr);
        if (q == K_FFOUT) dbg_gemm<<<16, 256, 0, stream>>>(dbg, code, 2, ffhb, FF, in[19] + (size_t)layer * FF * DM, DM, DM, outp, DM, oldp, modl + 5 * DM, modl + 6 * DM + 5 * DM);
#endif
    }
#if DBG_CHECK
    dbg_report<<<1, 64, 0, stream>>>(dbg, outp);
#endif
#endif
}
```
